# Optimizing an MI355X kernel written in HIP

```python
import jax
import jax.numpy as jnp
from jax import lax
import numpy as np

D_MODEL = 1024
BATCH = 8
SEQ = 4096
DEPTH = 4

GRID_W = 64
CTX_LEN = 256

RET_HEADS = 4
RET_DK = 64
RET_DV = 128
RET_CHUNK = 128
RET_W = RET_HEADS * RET_DV
MLA_HEADS = 8
MLA_Q_RANK = 256
MLA_KV_RANK = 128
MLA_NOPE = 64
MLA_ROPE = 32
MLA_DV = 64
MLA_QK = MLA_NOPE + MLA_ROPE
MLA_W = MLA_HEADS * MLA_DV
ATTN_BLOCK = 128
RWKV_HEADS = 8
RWKV_HD = 64
RWKV_W = RWKV_HEADS * RWKV_HD
RWKV_DECAY_LORA = 64
RWKV_A_LORA = 64
RWKV_GATE_LORA = 128
RWKV_GN_EPS = 64e-5
N_EXPERTS = 32
TOP_K = 4
D_EXPERT = D_MODEL
SWIGLU_LIMIT = 7.0
SWIGLU_ALPHA = 1.702
MOE_BLOCK = 128

ROPE_BASE = 10000.0
NORM_EPS = 1e-6
HEAD_NORM_EPS = 1e-5

RET_SEGS = (RET_HEADS * RET_DK, RET_HEADS * RET_DK, RET_W, RET_W, RET_W)
MLA_SEGS = (MLA_Q_RANK, MLA_KV_RANK, MLA_ROPE)
RWKV_SEGS = (RWKV_W, RWKV_W, RWKV_W, RWKV_DECAY_LORA, RWKV_DECAY_LORA,
             RWKV_A_LORA, RWKV_A_LORA, RWKV_GATE_LORA)
RET_IN = 2 * RET_HEADS * RET_DK + 3 * RET_W
MLA_IN = MLA_Q_RANK + MLA_KV_RANK + MLA_ROPE
RWKV_IN = 3 * RWKV_W + 2 * RWKV_DECAY_LORA + 2 * RWKV_A_LORA + RWKV_GATE_LORA
D_IN = RET_IN + MLA_IN + RWKV_IN + 3 * D_MODEL

kernel_name = 'hybrid_ret_mla_rwkv7_moe_dit'


def _split_cols(t, sizes):
    cuts, acc = [], 0
    for sz in sizes[:-1]:
        acc += sz
        cuts.append(acc)
    return jnp.split(t, cuts, axis=-1)


def _rmsnorm(x, g):
    x32 = x.astype(jnp.float32)
    y = x32 * lax.rsqrt(jnp.mean(x32 * x32, axis=-1, keepdims=True) + NORM_EPS)
    return (y * g.astype(jnp.float32)).astype(x.dtype)


def _layernorm_last(x, eps):
    x32 = x.astype(jnp.float32)
    xc = x32 - jnp.mean(x32, axis=-1, keepdims=True)
    return xc * lax.rsqrt(jnp.mean(xc * xc, axis=-1, keepdims=True) + eps)


def _rope_angles(pos, dim):
    inv = ROPE_BASE ** (-jnp.arange(0, dim, 2, dtype=jnp.float32) / dim)
    return pos.astype(jnp.float32)[:, None] * inv[None, :]


def _rotate(x, ang):
    cos = jnp.cos(ang)[:, None, :].astype(x.dtype)
    sin = jnp.sin(ang)[:, None, :].astype(x.dtype)
    x1, x2 = jnp.split(x, 2, axis=-1)
    return jnp.concatenate([x1 * cos - x2 * sin, x1 * sin + x2 * cos], axis=-1)


def _axial_rope(x, row_ang, col_ang):
    xr, xc = jnp.split(x, 2, axis=-1)
    return jnp.concatenate([_rotate(xr, row_ang), _rotate(xc, col_ang)], axis=-1)


def _bidir(scan_fn, s0, ctx_f, ctx_b, lat_f, lat_b):
    flip = lambda ts: [jnp.flip(t, axis=1) for t in ts]
    sc_f, yc_f = scan_fn(s0, *ctx_f)
    sc_b, yc_b = scan_fn(s0, *flip(ctx_b))
    _, y_f = scan_fn(sc_f, *lat_f)
    _, y_b = scan_fn(sc_b, *flip(lat_b))
    return y_f, jnp.flip(y_b, axis=1), yc_f, jnp.flip(yc_b, axis=1)


def _retention_scan(s0, q, k, v, gamma):
    b, l, h, _ = q.shape
    dv = v.shape[-1]
    n = l // RET_CHUNK
    idx = jnp.arange(RET_CHUNK, dtype=jnp.float32)
    lg = jnp.log(gamma)
    diff = idx[:, None] - idx[None, :]
    dmat = jnp.where(diff >= 0, jnp.exp(lg[:, None, None] * jnp.maximum(diff, 0.0)), 0.0)
    q_dec = jnp.exp((idx + 1.0)[:, None] * lg[None, :])
    k_dec = jnp.exp((RET_CHUNK - 1.0 - idx)[:, None] * lg[None, :])
    c_dec = jnp.exp(RET_CHUNK * lg)

    def chunks(t):
        return t.reshape(b, n, RET_CHUNK, h, t.shape[-1]).swapaxes(0, 1)

    def step(s, inp):
        qb, kb, vb = inp
        att = jnp.einsum('bchd,bshd->bhcs', qb, kb) * dmat
        o = jnp.einsum('bhcs,bshv->bchv', att, vb)
        o = o + jnp.einsum('bchd,bhdv->bchv', qb, s) * q_dec[None, :, :, None]
        s = s * c_dec[None, :, None, None] + jnp.einsum('bshd,bshv->bhdv', kb * k_dec[None, :, :, None], vb)
        return s, o

    s, o = lax.scan(step, s0, (chunks(q), chunks(k), chunks(v)))
    return s, o.swapaxes(0, 1).reshape(b, l, h, dv)


def _retention_branch(p, pc, ang, gamma, need_ctx):
    def prep(t, rotate):
        b, l, _ = t.shape
        q, k, v, gf, gb = _split_cols(t, RET_SEGS)
        q = q.reshape(b, l, RET_HEADS, RET_DK)
        k = k.reshape(b, l, RET_HEADS, RET_DK)
        if rotate:
            q, k = _rotate(q, ang), _rotate(k, ang)
        qkv = (q.astype(jnp.float32), k.astype(jnp.float32) * RET_DK ** -0.5,
               v.reshape(b, l, RET_HEADS, RET_DV).astype(jnp.float32))
        return qkv, gf, gb

    lat, gf, gb = prep(p, True)
    ctx, gfc, gbc = prep(pc, False)
    s0 = jnp.zeros((p.shape[0], RET_HEADS, RET_DK, RET_DV), jnp.float32)
    scan = lambda s, q, k, v: _retention_scan(s, q, k, v, gamma)
    o_f, o_b, oc_f, oc_b = _bidir(scan, s0, ctx, ctx, lat, lat)

    def finish(o_f, o_b, gf, gb):
        b, l = gf.shape[:2]
        swish = lambda g: jax.nn.silu(g.astype(jnp.float32)).reshape(b, l, RET_HEADS, RET_DV)
        y = (_layernorm_last(o_f, HEAD_NORM_EPS) * swish(gf)
             + _layernorm_last(o_b, HEAD_NORM_EPS) * swish(gb))
        return y.reshape(b, l, RET_W).astype(p.dtype)

    out = finish(o_f, o_b, gf, gb)
    out_c = finish(oc_f, oc_b, gfc, gbc) if need_ctx else None
    return out, out_c


def _softmax_attend(q, k, v):
    s = jnp.einsum('bqhd,bkhd->bhqk', q, k, preferred_element_type=jnp.float32) * MLA_QK ** -0.5
    p = jax.nn.softmax(s, axis=-1).astype(v.dtype)
    return jnp.einsum('bhqk,bkhd->bqhd', p, v)


def _mla_branch(p, pc, row_ang, col_ang, q_norm_g, w_uq, kv_norm_g, w_ukv, qk_q_g, qk_k_g, need_ctx):
    def prep(t, rotate):
        b, l, _ = t.shape
        cq, ckv, kpe = _split_cols(t, MLA_SEGS)
        q = (_rmsnorm(cq, q_norm_g) @ w_uq).reshape(b, l, MLA_HEADS, MLA_QK)
        kv = (_rmsnorm(ckv, kv_norm_g) @ w_ukv).reshape(b, l, MLA_HEADS, MLA_NOPE + MLA_DV)
        k_nope, v = jnp.split(kv, [MLA_NOPE], axis=-1)
        k_pe = jnp.broadcast_to(kpe[:, :, None, :], (b, l, MLA_HEADS, MLA_ROPE))
        q = _rmsnorm(q, qk_q_g)
        k = _rmsnorm(jnp.concatenate([k_nope, k_pe], axis=-1), qk_k_g)
        if rotate:
            q = jnp.concatenate([q[..., :MLA_NOPE], _axial_rope(q[..., MLA_NOPE:], row_ang, col_ang)], axis=-1)
            k = jnp.concatenate([k[..., :MLA_NOPE], _axial_rope(k[..., MLA_NOPE:], row_ang, col_ang)], axis=-1)
        return q, k, v

    q, k, v = prep(p, True)
    qc, kc, vc = prep(pc, False)
    b, s = p.shape[:2]
    k_all = jnp.concatenate([kc, k], axis=1)
    v_all = jnp.concatenate([vc, v], axis=1)
    qb = q.reshape(b, s // ATTN_BLOCK, ATTN_BLOCK, MLA_HEADS, MLA_QK).swapaxes(0, 1)
    o = lax.map(lambda qq: _softmax_attend(qq, k_all, v_all), qb)
    out = o.swapaxes(0, 1).reshape(b, s, MLA_W)
    out_c = _softmax_attend(qc, kc, vc).reshape(b, pc.shape[1], MLA_W) if need_ctx else None
    return out, out_c


def _token_shift(t, mu_prev, mu_next):
    prev = jnp.pad(t, ((0, 0), (1, 0), (0, 0)))[:, :-1]
    nxt = jnp.pad(t, ((0, 0), (0, 1), (0, 0)))[:, 1:]
    return t + mu_prev * (prev - t) + mu_next * (nxt - t)


def _rwkv_scan(s0, r, decay, k, v, kk, a):
    def step(s, inp):
        rt, wt, kt, vt, kkt, at = inp
        sa = jnp.einsum('bhij,bhj->bhi', s, -kkt)
        s = (s * wt[:, :, None, :] + sa[..., None] * (kkt * at)[:, :, None, :]
             + vt[..., None] * kt[:, :, None, :])
        return s, jnp.einsum('bhij,bhj->bhi', s, rt)

    s, y = lax.scan(step, s0, tuple(t.swapaxes(0, 1) for t in (r, decay, k, v, kk, a)))
    return s, y.swapaxes(0, 1)


def _rwkv_branch(p, pc, mu_prev, mu_next, w0, w2, a0, a2, g2, k_k, k_a, r_k, lnx_g, lnx_b, need_ctx):
    def prep(t):
        b, l, _ = t.shape
        t = _token_shift(t, mu_prev, mu_next).astype(jnp.float32)
        r, k, v, whf, whb, ahf, ahb, gh = _split_cols(t, RWKV_SEGS)
        heads = lambda z: z.reshape(b, l, RWKV_HEADS, RWKV_HD)
        kk = heads(k * k_k)
        kk = kk * lax.rsqrt(jnp.maximum(jnp.sum(kk * kk, axis=-1, keepdims=True), 1e-24))
        dirs = []
        for d, (wh, ah) in enumerate(((whf, ahf), (whb, ahb))):
            w = -jax.nn.softplus(-(w0[d] + jnp.tanh(wh) @ w2[d])) - 0.5
            a = jax.nn.sigmoid(a0[d] + ah @ a2[d])
            kd = k * (1.0 + (a - 1.0) * k_a)
            dirs.append((heads(jnp.exp(-jnp.exp(w))), heads(kd), heads(a)))
        g = jax.nn.sigmoid(gh) @ g2
        return heads(r), heads(v), kk, dirs, g

    r, v, kk, dirs, g = prep(p)
    rc, vc, kkc, dirsc, gc = prep(pc)
    lat = [(r, dw, dk, v, kk, da) for dw, dk, da in dirs]
    ctx = [(rc, dw, dk, vc, kkc, da) for dw, dk, da in dirsc]
    s0 = jnp.zeros((p.shape[0], RWKV_HEADS, RWKV_HD, RWKV_HD), jnp.float32)
    y_f, y_b, yc_f, yc_b = _bidir(_rwkv_scan, s0, ctx[0], ctx[1], lat[0], lat[1])
    gn_g = lnx_g.reshape(RWKV_HEADS, RWKV_HD)
    gn_b = lnx_b.reshape(RWKV_HEADS, RWKV_HD)

    def finish(y_f, y_b, r, v, dirs, g):
        b, l = g.shape[:2]
        y = _layernorm_last(y_f + y_b, RWKV_GN_EPS) * gn_g + gn_b
        for _, kd, _ in dirs:
            y = y + jnp.sum(r * kd * r_k, axis=-1, keepdims=True) * v
        return (y.reshape(b, l, RWKV_W) * g).astype(p.dtype)

    out = finish(y_f, y_b, r, v, dirs, g)
    out_c = finish(yc_f, yc_b, rc, vc, dirsc, gc) if need_ctx else None
    return out, out_c


def _mixer(h, hc, row_ang, col_ang, ret_ang, gamma, w_in,
           mla_q_norm_g, mla_w_uq, mla_kv_norm_g, mla_w_ukv, mla_qk_q_g, mla_qk_k_g,
           rwkv_mu_prev, rwkv_mu_next, rwkv_w0, rwkv_w2, rwkv_a0, rwkv_a2, rwkv_g2,
           rwkv_k_k, rwkv_k_a, rwkv_r_k, rwkv_lnx_g, rwkv_lnx_b,
           w_br_ret, w_br_mla, w_br_rwkv, w_out, need_ctx):
    segs = (RET_IN, MLA_IN, RWKV_IN, 3 * h.shape[-1])
    p_ret, p_mla, p_rwkv, p_gate = _split_cols(h @ w_in, segs)
    c_ret, c_mla, c_rwkv, c_gate = _split_cols(hc @ w_in, segs)
    ret, ret_c = _retention_branch(p_ret, c_ret, ret_ang, gamma, need_ctx)
    mla, mla_c = _mla_branch(p_mla, c_mla, row_ang, col_ang, mla_q_norm_g, mla_w_uq, mla_kv_norm_g,
                             mla_w_ukv, mla_qk_q_g, mla_qk_k_g, need_ctx)
    rwk, rwk_c = _rwkv_branch(p_rwkv, c_rwkv, rwkv_mu_prev, rwkv_mu_next, rwkv_w0, rwkv_w2, rwkv_a0,
                              rwkv_a2, rwkv_g2, rwkv_k_k, rwkv_k_a, rwkv_r_k, rwkv_lnx_g, rwkv_lnx_b,
                              need_ctx)

    def merge(a, m, r, gate_logits):
        g_a, g_m, g_r = jnp.split(jax.nn.sigmoid(gate_logits), 3, axis=-1)
        return (g_a * (a @ w_br_ret) + g_m * (m @ w_br_mla) + g_r * (r @ w_br_rwkv)) @ w_out

    out = merge(ret, mla, rwk, p_gate)
    out_c = merge(ret_c, mla_c, rwk_c, c_gate) if need_ctx else None
    return out, out_c


def _moe(h, w_router, b_router, w_gu, b_gu, w_down, b_down):
    n, d = h.shape
    logits = jnp.einsum('nd,de->ne', h, w_router, preferred_element_type=jnp.float32) + b_router.astype(jnp.float32)
    top_val, top_idx = lax.top_k(logits, TOP_K)
    gate = jax.nn.softmax(top_val, axis=-1)
    nk = n * TOP_K
    flat_e = top_idx.reshape(-1)
    flat_tok = jnp.arange(nk, dtype=jnp.int32) // TOP_K
    order = jnp.argsort(flat_e)
    e_sorted = flat_e[order]
    counts = jnp.bincount(flat_e, length=N_EXPERTS)
    padded = (counts + MOE_BLOCK - 1) // MOE_BLOCK * MOE_BLOCK
    pad_end = jnp.cumsum(padded)
    start = jnp.cumsum(counts) - counts
    dest = (pad_end - padded)[e_sorted] + jnp.arange(nk, dtype=jnp.int32) - start[e_sorted]
    n_blocks = -(-nk // MOE_BLOCK) + N_EXPERTS
    tok_buf = jnp.full((n_blocks * MOE_BLOCK,), n, jnp.int32).at[dest].set(flat_tok[order])
    gate_buf = jnp.zeros((n_blocks * MOE_BLOCK,), jnp.float32).at[dest].set(gate.reshape(-1)[order])
    block_expert = jnp.minimum(
        jnp.searchsorted(pad_end // MOE_BLOCK, jnp.arange(n_blocks), side='right'), N_EXPERTS - 1)
    h_pad = jnp.concatenate([h, jnp.zeros((1, d), h.dtype)], axis=0)

    def expert_block(args):
        tok, e = args
        gu = h_pad[tok] @ w_gu[e] + b_gu[e]
        g_lin, up = jnp.split(gu, 2, axis=-1)
        g_lin = jnp.minimum(g_lin, SWIGLU_LIMIT)
        up = jnp.clip(up, -SWIGLU_LIMIT, SWIGLU_LIMIT)
        act = g_lin * jax.nn.sigmoid(SWIGLU_ALPHA * g_lin) * (up + 1.0)
        return act @ w_down[e] + b_down[e]

    y = lax.map(expert_block, (tok_buf.reshape(n_blocks, MOE_BLOCK), block_expert))
    y = y.reshape(-1, d) * gate_buf[:, None].astype(y.dtype)
    return jax.ops.segment_sum(y, tok_buf, num_segments=n + 1)[:n]


def setup_inputs(seed: int = 0) -> dict:
    key = jax.random.key(seed)
    keys = list(jax.random.split(key, 64))

    def nrm(shape, scale):
        return jax.random.normal(keys.pop(), shape, jnp.float32) * scale

    def uni(shape, lo, hi):
        return jax.random.uniform(keys.pop(), shape, jnp.float32, lo, hi)

    L, D, E, F = DEPTH, D_MODEL, N_EXPERTS, D_EXPERT
    return {
        'x': nrm((BATCH, SEQ, D), 1.0),
        'c': nrm((BATCH, D), 1.0),
        'ctx': nrm((BATCH, CTX_LEN, D), 1.0),
        'c_ctx': nrm((D,), 1.0),
        'ada_w': nrm((L, D, 6 * D), 0.5 * D ** -0.5),
        'ada_b': nrm((L, 6 * D), 0.01),
        'norm1_g': 1.0 + nrm((L, D), 0.02),
        'norm2_g': 1.0 + nrm((L, D), 0.02),
        'w_in': nrm((L, D, D_IN), D ** -0.5),
        'mla_q_norm_g': 1.0 + nrm((L, MLA_Q_RANK), 0.02),
        'mla_w_uq': nrm((L, MLA_Q_RANK, MLA_HEADS * MLA_QK), MLA_Q_RANK ** -0.5),
        'mla_kv_norm_g': 1.0 + nrm((L, MLA_KV_RANK), 0.02),
        'mla_w_ukv': nrm((L, MLA_KV_RANK, MLA_HEADS * (MLA_NOPE + MLA_DV)), MLA_KV_RANK ** -0.5),
        'mla_qk_q_g': 1.0 + nrm((L, MLA_QK), 0.02),
        'mla_qk_k_g': 1.0 + nrm((L, MLA_QK), 0.02),
        'rwkv_mu_prev': uni((L, RWKV_IN), 0.0, 0.5),
        'rwkv_mu_next': uni((L, RWKV_IN), 0.0, 0.5),
        'rwkv_w0': uni((L, 2, RWKV_W), -6.0, -1.0),
        'rwkv_w2': nrm((L, 2, RWKV_DECAY_LORA, RWKV_W), 0.5 * RWKV_DECAY_LORA ** -0.5),
        'rwkv_a0': nrm((L, 2, RWKV_W), 0.1),
        'rwkv_a2': nrm((L, 2, RWKV_A_LORA, RWKV_W), 0.5 * RWKV_A_LORA ** -0.5),
        'rwkv_g2': nrm((L, RWKV_GATE_LORA, RWKV_W), RWKV_GATE_LORA ** -0.5),
        'rwkv_k_k': 1.0 + nrm((L, RWKV_W), 0.1),
        'rwkv_k_a': 1.0 + nrm((L, RWKV_W), 0.1),
        'rwkv_r_k': nrm((L, RWKV_HEADS, RWKV_HD), 0.1),
        'rwkv_lnx_g': 1.0 + nrm((L, RWKV_W), 0.02),
        'rwkv_lnx_b': nrm((L, RWKV_W), 0.01),
        'w_br_ret': nrm((L, RET_W, D), RET_W ** -0.5),
        'w_br_mla': nrm((L, MLA_W, D), MLA_W ** -0.5),
        'w_br_rwkv': nrm((L, RWKV_W, D), RWKV_W ** -0.5),
        'w_out': nrm((L, D, D), D ** -0.5),
        'w_router': nrm((L, D, E), D ** -0.5),
        'b_router': nrm((L, E), 0.01),
        'w_gu': nrm((L, E, D, 2 * F), D ** -0.5),
        'b_gu': nrm((L, E, 2 * F), 0.01),
        'w_down': nrm((L, E, F, D), F ** -0.5),
        'b_down': nrm((L, E, D), 0.01),
    }


def reference(x, c, ctx, c_ctx, ada_w, ada_b, norm1_g, norm2_g, w_in,
              mla_q_norm_g, mla_w_uq, mla_kv_norm_g, mla_w_ukv, mla_qk_q_g, mla_qk_k_g,
              rwkv_mu_prev, rwkv_mu_next, rwkv_w0, rwkv_w2, rwkv_a0, rwkv_a2, rwkv_g2,
              rwkv_k_k, rwkv_k_a, rwkv_r_k, rwkv_lnx_g, rwkv_lnx_b,
              w_br_ret, w_br_mla, w_br_rwkv, w_out,
              w_router, b_router, w_gu, b_gu, w_down, b_down):
    b, s, d = x.shape
    rows = s // GRID_W
    row = jnp.repeat(jnp.arange(rows, dtype=jnp.int32), GRID_W)
    col = jnp.tile(jnp.arange(GRID_W, dtype=jnp.int32), rows)
    row_ang = _rope_angles(row, MLA_ROPE // 2)
    col_ang = _rope_angles(col, MLA_ROPE // 2)
    ret_ang = _rope_angles(jnp.arange(s, dtype=jnp.int32), RET_DK)
    gamma = 1.0 - jnp.exp2(-5.0 - jnp.arange(RET_HEADS, dtype=jnp.float32))

    for l in range(DEPTH):
        last = l == DEPTH - 1
        mod = jax.nn.silu(c) @ ada_w[l] + ada_b[l]
        sh1, sc1, g1, sh2, sc2, g2 = jnp.split(mod[:, None, :], 6, axis=-1)
        csh1, csc1, cg1, csh2, csc2, cg2 = jnp.split(jax.nn.silu(c_ctx) @ ada_w[l] + ada_b[l], 6)
        h = _rmsnorm(x, norm1_g[l]) * (1.0 + sc1) + sh1
        hc = _rmsnorm(ctx, norm1_g[l]) * (1.0 + csc1) + csh1
        mix, mix_c = _mixer(h, hc, row_ang, col_ang, ret_ang, gamma, w_in[l],
                            mla_q_norm_g[l], mla_w_uq[l], mla_kv_norm_g[l], mla_w_ukv[l],
                            mla_qk_q_g[l], mla_qk_k_g[l],
                            rwkv_mu_prev[l], rwkv_mu_next[l], rwkv_w0[l], rwkv_w2[l], rwkv_a0[l],
                            rwkv_a2[l], rwkv_g2[l], rwkv_k_k[l], rwkv_k_a[l], rwkv_r_k[l],
                            rwkv_lnx_g[l], rwkv_lnx_b[l],
                            w_br_ret[l], w_br_mla[l], w_br_rwkv[l], w_out[l], not last)
        x = x + g1 * mix
        h2 = _rmsnorm(x, norm2_g[l]) * (1.0 + sc2) + sh2
        moe_args = (w_router[l], b_router[l], w_gu[l], b_gu[l], w_down[l], b_down[l])
        if last:
            x = x + g2 * _moe(h2.reshape(b * s, d), *moe_args).reshape(b, s, d)
        else:
            ctx = ctx + cg1 * mix_c
            hc2 = _rmsnorm(ctx, norm2_g[l]) * (1.0 + csc2) + csh2
            f = _moe(jnp.concatenate([h2.reshape(b * s, d), hc2.reshape(-1, d)], axis=0), *moe_args)
            x = x + g2 * f[: b * s].reshape(b, s, d)
            ctx = ctx + cg2 * f[b * s:].reshape(ctx.shape)
    return x
```

```cpp
#include <hip/hip_runtime.h>
#include <cstdio>
#include <cstdint>

#ifndef MK_ONE_LAUNCH
#define MK_ONE_LAUNCH 0
#endif

#define GAS __attribute__((address_space(1)))
#define LAS __attribute__((address_space(3)))
typedef unsigned short bf16;
typedef short bf16x8 __attribute__((ext_vector_type(8)));
typedef float f32x2 __attribute__((ext_vector_type(2)));
typedef float f32x4 __attribute__((ext_vector_type(4)));
typedef float f32x16 __attribute__((ext_vector_type(16)));
typedef unsigned u32x2 __attribute__((ext_vector_type(2)));
typedef unsigned u32x4 __attribute__((ext_vector_type(4)));
typedef __bf16 bf16v2 __attribute__((ext_vector_type(2)));
#define DI __device__ __forceinline__

constexpr int D = 1024, BATCH = 8, SEQ = 4096, CTX = 256, LTOT = SEQ + CTX  , NT = BATCH * LTOT  , DEPTH = 4;
constexpr int DIN = 7456, DINP = 7680;
constexpr int NEXP = 32, TOPK = 4, DEXP = 1024;
constexpr int NSLOT = NT * TOPK + NEXP * 256;
constexpr int PC_RQ = 0, PC_RK = 256, PC_RV = 512, PC_RGF = 1024, PC_RGB = 1536, PC_MQ = 2048, PC_MKV = 2304, PC_MPE = 2432,
              PC_RW = 2464, PC_WR = 2464, PC_WK = 2976, PC_WV = 3488, PC_WHF = 4000, PC_WHB = 4064, PC_AHF = 4128, PC_AHB = 4192, PC_GH = 4256, PC_GATE = 4384;
enum { I_X = 0, I_C, I_CTX, I_CCTX, I_ADAW, I_ADAB, I_N1G, I_N2G, I_WIN, I_MQNG, I_WUQ, I_MKVNG, I_WUKV, I_QKQG, I_QKKG, I_MUP, I_MUN, I_W0, I_W2, I_A0, I_A2, I_G2,
       I_KK, I_KA, I_RK, I_LNXG, I_LNXB, I_BRRET, I_BRMLA, I_BRRWKV, I_WOUT, I_WROUTER, I_BROUTER, I_WGU, I_BGU, I_WDOWN, I_BDOWN, N_IN };

constexpr size_t MiB = 1u << 20;
constexpr size_t WS_CTL = 0, CTL_ZERO_BYTES = 1 * MiB;
constexpr size_t WS_MOD = 1 * MiB;
constexpr size_t WS_ROPE = 2 * MiB;
constexpr size_t WS_ROPE_AX = 3 * MiB;
constexpr size_t WS_SMALLW = 4 * MiB;
constexpr size_t SW_UQ = 0, SW_UKV = 393216, SW_W2 = 655360, SW_A2 = 786432, SW_G2 = 917504;
constexpr size_t WS_WBR = 8 * MiB;
constexpr size_t WS_WOUT = 20 * MiB;
constexpr size_t WS_WIN = 28 * MiB;
constexpr size_t WS_WGU = 88 * MiB;
constexpr size_t WS_WDN = 600 * MiB;
constexpr size_t WS_X = 856 * MiB;
constexpr size_t WS_H = 992 * MiB;
constexpr size_t WS_P = 1062 * MiB;
constexpr size_t WS_QB = 1572 * MiB;
constexpr size_t WS_KB = 1623 * MiB;
constexpr size_t WS_VT = 1674 * MiB;
constexpr size_t WS_RW = 1708 * MiB;
constexpr size_t RW_STRIDE = (size_t)NT * 512 * 2;
constexpr size_t WS_LW = 1980 * MiB;
constexpr size_t WS_YF = 2116 * MiB;
constexpr size_t WS_OF = 2252 * MiB;
constexpr size_t WS_ABR = 2388 * MiB;
constexpr size_t WS_MRG = 2490 * MiB;
constexpr size_t WS_TOPK = 2558 * MiB;
constexpr size_t WS_LIST = 2560 * MiB;
constexpr size_t WS_ACT = 2565 * MiB;
constexpr size_t WS_Y = 2853 * MiB;
constexpr size_t WS_END = 3141 * MiB;
constexpr int CW_TMO = 0, CW_BAR = 4096, CW_CNT = 8192  , CW_Q = 12288  ;

DI unsigned pk2(float lo, float hi) { f32x2 v = {lo, hi}; bf16v2 r = __builtin_convertvector(v, bf16v2); return __builtin_bit_cast(unsigned, r); }
DI bf16 f2bf(float f) { return (bf16)(pk2(f, 0.f) & 0xffffu); }
DI float bf2f(unsigned short b) { return __uint_as_float(((unsigned)b) << 16); }
DI float bflo(unsigned w) { return __uint_as_float(w << 16); }
DI float bfhi(unsigned w) { return __uint_as_float(w & 0xffff0000u); }
DI bf16x8 pack8(const float* v) { u32x4 x; x.x = pk2(v[0], v[1]); x.y = pk2(v[2], v[3]); x.z = pk2(v[4], v[5]); x.w = pk2(v[6], v[7]); return __builtin_bit_cast(bf16x8, x); }
DI float wave_sum(float v) {
#pragma unroll
    for (int o = 1; o < 64; o <<= 1) v += __shfl_xor(v, o);
    return v;
}
DI float sigmoidf_(float x) { return 1.f / (1.f + __expf(-x)); }
#define LDS_WAIT() asm volatile("s_waitcnt lgkmcnt(0)" ::: "memory")
#define VM_WAIT() asm volatile("s_waitcnt vmcnt(0)" ::: "memory")

#define XB_TMO      128
#define XB_XCNT(j)  (256  + 64 * (j))
#define XB_XSUB(j)  (1280 + 64 * (j))
#define XB_XGEN(j)  (2304 + 64 * (j))
#define XB_TOP      3328
#define XB_TOPGEN   3392
#define XCD_BAR_WORDS 3456
#define XB_SPIN_CAP (1u << 22)

__device__ __forceinline__ unsigned xb_ld(unsigned* p)              { return __hip_atomic_load(p, __ATOMIC_RELAXED, __HIP_MEMORY_SCOPE_AGENT); }
__device__ __forceinline__ unsigned xb_add(unsigned* p, unsigned v) { return __hip_atomic_fetch_add(p, v, __ATOMIC_RELAXED, __HIP_MEMORY_SCOPE_AGENT); }
__device__ __forceinline__ unsigned xb_xcc_id() { return (unsigned)__builtin_amdgcn_s_getreg((3 << 11) | 20) & 0xFu; }
#define XB_SPIN(cond, bar) do { unsigned _sp = 0; while (cond) { __builtin_amdgcn_s_sleep(1); \
    if ((++_sp & 255u) == 0u) { if (xb_ld(&(bar)[XB_TMO])) break; if (_sp > XB_SPIN_CAP) { atomicAdd(&(bar)[XB_TMO], 1u); break; } } } } while (0)

struct XcdBarrier { unsigned* bar; unsigned x; volatile LAS unsigned* st; };

__device__ __forceinline__ XcdBarrier xcd_barrier_post(unsigned* bar, volatile LAS unsigned* st) {
    XcdBarrier b; b.bar = bar; b.x = xb_xcc_id(); b.st = st;
    if (threadIdx.x == 0) (void)xb_add(&bar[XB_XCNT(b.x)], 1u);
    return b;
}
__device__ __forceinline__ void xcd_barrier_complete(unsigned* bar, unsigned x, unsigned& nloc, unsigned& nx) {
    const unsigned G = gridDim.x * gridDim.y * gridDim.z;
    unsigned sum, cnt, mine, sp = 0u;
    for (;;) {
        sum = 0u; cnt = 0u; mine = 0u;
#pragma unroll
        for (unsigned j = 0; j < 16; ++j) { const unsigned c = xb_ld(&bar[XB_XCNT(j)]); sum += c; cnt += (c > 0u) ? 1u : 0u; mine = (j == x) ? c : mine; }
        if (sum == G) break;
        __builtin_amdgcn_s_sleep(1);
        if ((++sp & 255u) == 0u) { if (xb_ld(&bar[XB_TMO])) break; if (sp > XB_SPIN_CAP) { atomicAdd(&bar[XB_TMO], 1u); break; } }
    }
    nloc = mine > 0u ? mine : 1u; nx = cnt > 0u ? cnt : 1u;
}
__device__ __forceinline__ void xcd_barrier(const XcdBarrier& b) {
    asm volatile("s_waitcnt vmcnt(0)" ::: "memory");
    __syncthreads();
    if (threadIdx.x == 0) {
        unsigned* bar = b.bar;
        __builtin_amdgcn_s_waitcnt(0);
        unsigned nloc = b.st[0], nx = b.st[1];
        if (nloc == 0u) { xcd_barrier_complete(bar, b.x, nloc, nx); b.st[0] = nloc; b.st[1] = nx; }
        const unsigned old = xb_add(&bar[XB_XSUB(b.x)], 1u);
        const unsigned gen = old / nloc;
        if (old + 1u == (gen + 1u) * nloc) {
            __builtin_amdgcn_fence(__ATOMIC_RELEASE, "agent");
            asm volatile("s_waitcnt vmcnt(0)" ::: "memory");
            const unsigned og = xb_add(&bar[XB_TOP], 1u);
            const unsigned tg = og / nx;
            if (og + 1u == (tg + 1u) * nx) xb_add(&bar[XB_TOPGEN], 1u);
            else XB_SPIN(xb_ld(&bar[XB_TOPGEN]) == tg, bar);
            __builtin_amdgcn_fence(__ATOMIC_ACQUIRE, "agent");
            xb_add(&bar[XB_XGEN(b.x)], 1u);
            asm volatile("s_waitcnt vmcnt(0)" ::: "memory");
        } else {
            XB_SPIN(xb_ld(&bar[XB_XGEN(b.x)]) == gen, bar);
            __builtin_amdgcn_fence(__ATOMIC_ACQUIRE, "agent");
            asm volatile("s_waitcnt vmcnt(0)" ::: "memory");
        }
    }
    __syncthreads();
}

namespace pg8 {
constexpr int BM = 256, BK = 64, HALF = 128, HTB = HALF * BK * 2, STAGE_BYTES = 8 * HTB;
__host__ __device__ __forceinline__ int lds_byte(int r, int c) { const int st = (r >> 4) * 2 + (c >> 5), rr = r & 15, cc = c & 31, ob = rr * 64 + cc * 2; return st * 1024 + (ob ^ (((ob >> 9) & 1) << 5)); }
__host__ __device__ __forceinline__ void stage_rc(int b, int& R, int& C) { const int st = b / 1024, sb = b % 1024, swz = sb ^ (((sb >> 9) & 1) << 5); R = (st >> 1) * 16 + swz / 64; C = (st & 1) * 32 + (swz % 64) / 2; }
__host__ __device__ __forceinline__ int perm32(int rho) { const int n = rho >> 4, i = rho & 15; return 8 * (i >> 2) + 4 * n + (i & 3); }

struct Unit { const char* pa; const char* pb; int x, y, z; };

struct TileOrder {
    int nM, nN, nwg, G, c;
    DI void init(int nM_, int nN_, int G_, int c_) { nM = nM_; nN = nN_; nwg = nM * nN; G = G_; c = c_; }
    DI bool tile(int i, int& pm, int& pn) const {
        const long L = (long)i * G + c; if (L >= nwg) return false;
        int wgid = (int)L; { const int q = nwg / 8, r = nwg % 8, xcd = wgid % 8, off = wgid / 8; wgid = (xcd < r ? xcd * (q + 1) : r * (q + 1) + (xcd - r) * q) + off; }
        const int nig = 8 * nN, gid = wgid / nig, fm = gid * 8, gsz = (nM - fm) < 8 ? (nM - fm) : 8;
        pm = fm + ((wgid % nig) % gsz); pn = (wgid % nig) / gsz; return true;
    }
};

DI unsigned cvt_pk_bf16(float lo, float hi) { return pk2(lo, hi); }

template <class Epi, class Sched, bool GATHER>
__device__ __forceinline__ void gemm_phase(LAS unsigned char* lds, const int K, const Sched& S, const Epi& E, const int tid) {
    const int wid = __builtin_amdgcn_readfirstlane(tid >> 6), lane = tid & 63, wr = wid >> 2, wc = wid & 3, fr = lane & 15, fq = lane >> 4;
    const int nt = K / BK;
    unsigned voffA[2], voffB[2]; int stR[2];
#pragma unroll
    for (int i = 0; i < 2; ++i) { int R, C; stage_rc(tid * 16 + i * 8192, R, C); const int Rb = Epi::PERM ? ((R & ~31) + perm32(R & 31)) : R;
        voffA[i] = GATHER ? (unsigned)(C * 2) : (unsigned)(R * K + C) * 2u; voffB[i] = (unsigned)(Rb * K + C) * 2u; stR[i] = R; }
    const size_t kstep = (size_t)(BK * 2);
    const size_t hstep = (size_t)HALF * K * 2;
    const unsigned ldsw = (unsigned)wid * 1024u;
    const int aoff = lds_byte(wr * 64 + fr, fq * 8), boff = lds_byte(wc * 32 + fr, fq * 8);
#define PG8_SA(b, h) (((b) * 2 + (h)) * HTB)
#define PG8_SB(b, h) ((4 + (b) * 2 + (h)) * HTB)
#define PG8_STAGE(bufoff, gbase, voff) do { _Pragma("unroll") for (int _i = 0; _i < 2; ++_i) \
        __builtin_amdgcn_global_load_lds((const unsigned*)((const char*)(gbase) + (voff)[_i]), (LAS unsigned*)(lds + (bufoff) + ldsw + _i * 8192), 16, 0, 0); } while (0)
#define PG8_STAGE_A(bufoff, gbase, h, rw) do { if constexpr (GATHER) { _Pragma("unroll") for (int _i = 0; _i < 2; ++_i) { \
            const unsigned _row = ((rw)[h] >> (16 * _i)) & 0xffffu; \
            __builtin_amdgcn_global_load_lds((const unsigned*)((const char*)(gbase) + (size_t)_row * (size_t)(K * 2) + voffA[_i]), (LAS unsigned*)(lds + (bufoff) + ldsw + _i * 8192), 16, 0, 0); } } \
        else { PG8_STAGE(bufoff, (const char*)(gbase) + (h) * hstep, voffA); } } while (0)
#define PG8_LDA(dst, b, h) do { _Pragma("unroll") for (int m = 0; m < 4; ++m) _Pragma("unroll") for (int k = 0; k < 2; ++k) dst[m][k] = *(const LAS bf16x8*)(lds + PG8_SA(b, h) + aoff + m * 2048 + k * 1024); } while (0)
#define PG8_LDB(dst, b, h) do { _Pragma("unroll") for (int n = 0; n < 2; ++n) _Pragma("unroll") for (int k = 0; k < 2; ++k) dst[n][k] = *(const LAS bf16x8*)(lds + PG8_SB(b, h) + boff + n * 2048 + k * 1024); } while (0)
#define PG8_MMA(ai, bj, At, Bt) do { __builtin_amdgcn_s_setprio(1); _Pragma("unroll") for (int m = 0; m < 4; ++m) _Pragma("unroll") for (int n = 0; n < 2; ++n) _Pragma("unroll") for (int k = 0; k < 2; ++k) \
        acc[ai][bj][m][n] = __builtin_amdgcn_mfma_f32_16x16x32_bf16(Bt[n][k], At[m][k], acc[ai][bj][m][n], 0, 0, 0); __builtin_amdgcn_s_setprio(0); } while (0)
#define PG8_WAIT_V(n) asm volatile("s_waitcnt vmcnt(" #n ")" ::: "memory")
#define PG8_WAIT_L(n) asm volatile("s_waitcnt lgkmcnt(" #n ")" ::: "memory")
#define PG8_BAR __builtin_amdgcn_s_barrier()
#define PG8_SCHED __builtin_amdgcn_sched_barrier(0)
    Unit cur, nxt; int ui = 0;
    if (!S.next(0, cur)) return;
    f32x4 acc[2][2][4][2];
#pragma unroll
    for (int a = 0; a < 2; ++a)
#pragma unroll
        for (int b = 0; b < 2; ++b)
#pragma unroll
            for (int m = 0; m < 4; ++m)
#pragma unroll
                for (int n = 0; n < 2; ++n) acc[a][b][m][n] = (f32x4){0.f, 0.f, 0.f, 0.f};
    bf16x8 At[4][2], B0[2][2], B1[2][2];
    const char* cA = cur.pa; const char* cB = cur.pb;
    unsigned rwc[2] = {0u, 0u}, rwn[2] = {0u, 0u};
    if constexpr (GATHER) S.rows(cur, stR[0], stR[1], rwc);
    PG8_STAGE(PG8_SB(0, 0), cB, voffB); PG8_STAGE(PG8_SB(0, 1), cB + hstep, voffB); PG8_STAGE_A(PG8_SA(0, 0), cA, 0, rwc); PG8_STAGE_A(PG8_SA(0, 1), cA, 1, rwc);
    if (wr == 1) PG8_BAR;
    PG8_WAIT_V(2); PG8_BAR;
    PG8_STAGE(PG8_SB(1, 0), cB + kstep, voffB); PG8_STAGE_A(PG8_SA(1, 0), cA + kstep, 0, rwc); PG8_STAGE(PG8_SB(1, 1), cB + hstep + kstep, voffB);
    PG8_WAIT_V(6); PG8_BAR;
    for (;;) {
        const bool has_next = S.next(ui + 1, nxt);
        const char* nA = has_next ? nxt.pa : cA; const char* nB = has_next ? nxt.pb : cB;
        if constexpr (GATHER) { if (has_next) S.rows(nxt, stR[0], stR[1], rwn); else { rwn[0] = rwc[0]; rwn[1] = rwc[1]; } }
        for (int t = 0; t < nt; t += 2) {
            const bool last = (t == nt - 2);
            const char* a1 = cA + (size_t)(t + 1) * kstep;
            const char* a2 = last ? nA : cA + (size_t)(t + 2) * kstep; const char* b2 = last ? nB : cB + (size_t)(t + 2) * kstep;
            const char* a3 = a2 + kstep; const char* b3 = b2 + kstep;
            unsigned rw2[2]; rw2[0] = last ? rwn[0] : rwc[0]; rw2[1] = last ? rwn[1] : rwc[1];
            PG8_LDB(B0, 0, 0); PG8_LDB(B1, 0, 1); PG8_SCHED; PG8_LDA(At, 0, 0); PG8_STAGE_A(PG8_SA(1, 1), a1, 1, rwc);
            PG8_WAIT_V(8); PG8_WAIT_L(0); PG8_BAR; PG8_MMA(0, 0, At, B0); PG8_MMA(0, 1, At, B1); PG8_BAR; PG8_SCHED;
            PG8_LDA(At, 0, 1); PG8_STAGE(PG8_SB(0, 0), b2, voffB); PG8_STAGE(PG8_SB(0, 1), b2 + hstep, voffB); PG8_STAGE_A(PG8_SA(0, 0), a2, 0, rw2);
            PG8_WAIT_V(8); PG8_WAIT_L(0); PG8_BAR; PG8_MMA(1, 0, At, B0); PG8_MMA(1, 1, At, B1); PG8_BAR; PG8_SCHED;
            PG8_LDB(B0, 1, 0); PG8_LDB(B1, 1, 1); PG8_SCHED; PG8_LDA(At, 1, 0); PG8_STAGE_A(PG8_SA(0, 1), a2, 1, rw2);
            PG8_WAIT_V(8); PG8_WAIT_L(0); PG8_BAR; PG8_MMA(0, 0, At, B0); PG8_MMA(0, 1, At, B1); PG8_BAR; PG8_SCHED;
            PG8_LDA(At, 1, 1); PG8_STAGE(PG8_SB(1, 0), b3, voffB); PG8_STAGE(PG8_SB(1, 1), b3 + hstep, voffB); PG8_STAGE_A(PG8_SA(1, 0), a3, 0, rw2);
            PG8_WAIT_V(8); PG8_WAIT_L(0); PG8_BAR; PG8_MMA(1, 0, At, B0); PG8_MMA(1, 1, At, B1); PG8_BAR; PG8_SCHED;
        }
        if (wr == 0) PG8_BAR;
        { int l2_; asm volatile("v_mbcnt_lo_u32_b32 %0, -1, 0\n\tv_mbcnt_hi_u32_b32 %0, -1, %0" : "=v"(l2_));
          E(acc, cur, wr, wc, l2_ & 15, l2_ >> 4); }
        if (!has_next) break;
        cur = nxt; cA = nA; cB = nB; ++ui;
        if constexpr (GATHER) { rwc[0] = rwn[0]; rwc[1] = rwn[1]; }
        if (wr == 1) PG8_BAR;
    }
    PG8_WAIT_V(0);
    PG8_BAR;
#undef PG8_SA
#undef PG8_SB
#undef PG8_STAGE
#undef PG8_STAGE_A
#undef PG8_LDA
#undef PG8_LDB
#undef PG8_MMA
#undef PG8_WAIT_V
#undef PG8_WAIT_L
#undef PG8_BAR
#undef PG8_SCHED
}
#define ACC_ZERO(acc) do { _Pragma("unroll") for (int a_ = 0; a_ < 2; ++a_) _Pragma("unroll") for (int b_ = 0; b_ < 2; ++b_) _Pragma("unroll") for (int m_ = 0; m_ < 4; ++m_) _Pragma("unroll") for (int n_ = 0; n_ < 2; ++n_) \
        acc[a_][b_][m_][n_] = (f32x4){0.f, 0.f, 0.f, 0.f}; } while (0)
}

constexpr int NWAVES = 8, NTHREADS = 512;
constexpr int RING_BYTES = 131072;
constexpr int LDS_TAB_OFF = RING_BYTES;
constexpr int LDS_MISC_OFF = RING_BYTES + 8192;
constexpr int LDS_BYTES = 147456;

struct Args { const float* in[N_IN]; float* out; unsigned char* ws; int ph_lo, ph_hi; };

#define CAS __attribute__((address_space(4)))
struct KA { const CAS char* kp;
    DI const float* in(int i) const { return *(const float* const CAS*)(kp + 8 * i); }
    DI float* out() const { return *(float* const CAS*)(kp + 8 * N_IN); }
    DI unsigned char* ws() const { return *(unsigned char* const CAS*)(kp + 8 * N_IN + 8); } };
struct Frame {
    LAS unsigned char* lds;
    volatile LAS unsigned* MISC;
    unsigned* ctl;
    unsigned char* ws;
    int tid, lane, wave, G, bid;
};

DI int row_modrow(int r) { const int b = r / LTOT, p = r - b * LTOT; return p < CTX ? 8 : b; }

struct SchedInproj {
    pg8::TileOrder T; const char* A; const char* B;
    DI bool next(int i, pg8::Unit& u) const { int pm, pn; if (!T.tile(i, pm, pn)) return false; u.pa = A + (size_t)pm * (256 * 1024 * 2); u.pb = B + (size_t)pn * (256 * 1024 * 2); u.x = pm; u.y = pn; u.z = 0; return true; }
};
struct EpiStoreBf16 {
    static constexpr bool PERM = true;
    bf16* O; int ldc;
    DI void operator()(f32x4 (&acc)[2][2][4][2], const pg8::Unit& u, int wr, int wc, int fr, int fq) const {
        const int row0 = u.x * 256 + wr * 64 + fr, col0 = u.y * 256 + wc * 32 + 8 * fq;
#pragma unroll
        for (int ai = 0; ai < 2; ++ai)
#pragma unroll
            for (int m = 0; m < 4; ++m) { bf16* rowp = O + (size_t)(row0 + ai * 128 + m * 16) * ldc + col0;
#pragma unroll
                for (int bj = 0; bj < 2; ++bj) { const f32x4 v0 = acc[ai][bj][m][0], v1 = acc[ai][bj][m][1];
                    u32x4 w; w.x = pk2(v0[0], v0[1]); w.y = pk2(v0[2], v0[3]); w.z = pk2(v1[0], v1[1]); w.w = pk2(v1[2], v1[3]);
                    *(u32x4*)(rowp + bj * 128) = w; } }
        ACC_ZERO(acc);
    }
};
struct SchedMerge {
    pg8::TileOrder T; const char* A; const char* B;
    DI bool next(int i, pg8::Unit& u) const { const int ti = i / 3, br = i - ti * 3; int pm, pn; if (!T.tile(ti, pm, pn)) return false;
        u.pa = A + (size_t)br * ((size_t)NT * 512 * 2) + (size_t)pm * (256 * 512 * 2); u.pb = B + (size_t)br * (1024 * 512 * 2) + (size_t)pn * (256 * 512 * 2); u.x = pm; u.y = pn; u.z = br; return true; }
};
struct EpiMerge {
    static constexpr bool PERM = true;
    const bf16* P; bf16* O;
    DI void operator()(f32x4 (&acc)[2][2][4][2], const pg8::Unit& u, int wr, int wc, int fr, int fq) const {
        const int row0 = u.x * 256 + wr * 64 + fr, col0 = u.y * 256 + wc * 32 + 8 * fq, br = u.z;
#pragma unroll
        for (int ai = 0; ai < 2; ++ai)
#pragma unroll
            for (int m = 0; m < 4; ++m) { const size_t row = (size_t)(row0 + ai * 128 + m * 16);
#pragma unroll
                for (int bj = 0; bj < 2; ++bj) {
                    const bf16* gp = P + row * DINP + PC_GATE + br * 1024 + col0 + bj * 128;
                    const u32x4 gc = *(const u32x4*)gp;
                    float lc[8] = {bflo(gc.x), bfhi(gc.x), bflo(gc.y), bfhi(gc.y), bflo(gc.z), bfhi(gc.z), bflo(gc.w), bfhi(gc.w)};
                    float f[8];
                    if (br < 2) { const u32x4 gn = *(const u32x4*)(gp + 1024);
                        float ln[8] = {bflo(gn.x), bfhi(gn.x), bflo(gn.y), bfhi(gn.y), bflo(gn.z), bfhi(gn.z), bflo(gn.w), bfhi(gn.w)};
#pragma unroll
                        for (int j = 0; j < 8; ++j) { const float a = fminf(fmaxf(lc[j], -30.f), 30.f), b = fminf(fmaxf(ln[j], -30.f), 30.f); f[j] = (1.f + __expf(-b)) / (1.f + __expf(-a)); }
                    } else {
#pragma unroll
                        for (int j = 0; j < 8; ++j) { const float a = fminf(fmaxf(lc[j], -30.f), 30.f); f[j] = 1.f / (1.f + __expf(-a)); }
                    }
                    f32x4 v0 = acc[ai][bj][m][0], v1 = acc[ai][bj][m][1];
                    v0[0] *= f[0]; v0[1] *= f[1]; v0[2] *= f[2]; v0[3] *= f[3]; v1[0] *= f[4]; v1[1] *= f[5]; v1[2] *= f[6]; v1[3] *= f[7];
                    if (br == 2) { u32x4 w; w.x = pk2(v0[0], v0[1]); w.y = pk2(v0[2], v0[3]); w.z = pk2(v1[0], v1[1]); w.w = pk2(v1[2], v1[3]);
                        *(u32x4*)(O + row * 1024 + col0 + bj * 128) = w; v0 = (f32x4){0.f, 0.f, 0.f, 0.f}; v1 = v0; }
                    acc[ai][bj][m][0] = v0; acc[ai][bj][m][1] = v1; } }
    }
};
struct SchedPlain {
    pg8::TileOrder T; const char* A; const char* B; int K;
    DI bool next(int i, pg8::Unit& u) const { int pm, pn; if (!T.tile(i, pm, pn)) return false; u.pa = A + (size_t)pm * ((size_t)256 * K * 2); u.pb = B + (size_t)pn * ((size_t)256 * K * 2); u.x = pm; u.y = pn; u.z = 0; return true; }
};
struct EpiResid {
    static constexpr bool PERM = false;
    float* X; const float* mod;
    DI void operator()(f32x4 (&acc)[2][2][4][2], const pg8::Unit& u, int wr, int wc, int fr, int fq) const {
        const int row0 = u.x * 256 + wr * 64 + fr, col0 = u.y * 256 + wc * 32 + 4 * fq;
        const float* g1 = mod + (size_t)row_modrow(u.x * 256) * 6144 + 2048 + col0;
        f32x4 gv[2][2];
#pragma unroll
        for (int bj = 0; bj < 2; ++bj)
#pragma unroll
            for (int n = 0; n < 2; ++n) gv[bj][n] = *(const f32x4*)(g1 + bj * 128 + n * 16);
#pragma unroll
        for (int ai = 0; ai < 2; ++ai)
#pragma unroll
            for (int m = 0; m < 4; ++m) { float* rowp = X + (size_t)(row0 + ai * 128 + m * 16) * 1024 + col0;
#pragma unroll
                for (int bj = 0; bj < 2; ++bj)
#pragma unroll
                    for (int n = 0; n < 2; ++n) { f32x4* p = (f32x4*)(rowp + bj * 128 + n * 16); *p = *p + gv[bj][n] * acc[ai][bj][m][n]; } }
        ACC_ZERO(acc);
    }
};
struct SchedMoe {
    const LAS int* tab; const char* A; const char* B; const int* list; int nN, c, G; size_t a_tile_bytes, b_exp_bytes; bool gather;
    DI bool next(int i, pg8::Unit& u) const {
        const int T = tab[96], Tq = (T + 7) >> 3, xcd = c & 7, q = i * (G >> 3) + (c >> 3), tl = q / nN, pn = q - tl * nN, t = xcd * Tq + tl;
        if (tl >= Tq || t >= T) return false;
        const int e = tab[128 + t], j = t - tab[64 + e], slot0 = tab[32 + e] + 256 * j;
        u.pa = gather ? A : A + (size_t)slot0 * 2048; u.pb = B + (size_t)e * b_exp_bytes + (size_t)pn * (256 * 1024 * 2); u.x = slot0; u.y = pn; u.z = e | (j << 8); return true;
    }
    DI void rows(const pg8::Unit& u, int R0, int R1, unsigned (&rw)[2]) const {
        const int e = u.z & 255, j = u.z >> 8, cnt = tab[e]; const int* le = list + (size_t)e * NT;
#pragma unroll
        for (int h = 0; h < 2; ++h) { const int i0 = j * 256 + h * 128 + R0, i1 = j * 256 + h * 128 + R1;
            const unsigned r0 = i0 < cnt ? (unsigned)(le[i0] >> 2) : (unsigned)NT, r1 = i1 < cnt ? (unsigned)(le[i1] >> 2) : (unsigned)NT; rw[h] = r0 | (r1 << 16); }
    }
};
struct EpiSwiglu {
    static constexpr bool PERM = true;
    bf16* ACT; const float* bgu;
    DI void operator()(f32x4 (&acc)[2][2][4][2], const pg8::Unit& u, int wr, int wc, int fr, int fq) const {
        const int row0 = u.x + wr * 64 + fr, ch0 = u.y * 128 + wc * 32 + 8 * fq, e = u.z & 255;
        const float* bg = bgu + (size_t)e * 2048 + ch0;
        const f32x4 bg0 = *(const f32x4*)bg, bg1 = *(const f32x4*)(bg + 4), bu0 = *(const f32x4*)(bg + 1024), bu1 = *(const f32x4*)(bg + 1028);
#pragma unroll
        for (int ai = 0; ai < 2; ++ai)
#pragma unroll
            for (int m = 0; m < 4; ++m) {
                const f32x4 g0 = acc[ai][0][m][0] + bg0, g1 = acc[ai][0][m][1] + bg1, u0 = acc[ai][1][m][0] + bu0, u1 = acc[ai][1][m][1] + bu1;
                float o[8];
#pragma unroll
                for (int j = 0; j < 8; ++j) { const float g = fminf(j < 4 ? g0[j & 3] : g1[j & 3], 7.f); const float up = fminf(fmaxf(j < 4 ? u0[j & 3] : u1[j & 3], -7.f), 7.f);
                    o[j] = g * (1.f / (1.f + __expf(-1.702f * g))) * (up + 1.f); }
                u32x4 w; w.x = pk2(o[0], o[1]); w.y = pk2(o[2], o[3]); w.z = pk2(o[4], o[5]); w.w = pk2(o[6], o[7]);
                *(u32x4*)(ACT + (size_t)(row0 + ai * 128 + m * 16) * 1024 + ch0) = w; }
        ACC_ZERO(acc);
    }
};
struct EpiDown {
    static constexpr bool PERM = true;
    bf16* Y; const float* bd;
    DI void operator()(f32x4 (&acc)[2][2][4][2], const pg8::Unit& u, int wr, int wc, int fr, int fq) const {
        const int row0 = u.x + wr * 64 + fr, col0 = u.y * 256 + wc * 32 + 8 * fq, e = u.z & 255;
        f32x4 bv[2][2];
#pragma unroll
        for (int bj = 0; bj < 2; ++bj)
#pragma unroll
            for (int n = 0; n < 2; ++n) bv[bj][n] = *(const f32x4*)(bd + (size_t)e * 1024 + col0 + bj * 128 + 4 * n);
#pragma unroll
        for (int ai = 0; ai < 2; ++ai)
#pragma unroll
            for (int m = 0; m < 4; ++m) { bf16* rowp = Y + (size_t)(row0 + ai * 128 + m * 16) * 1024 + col0;
#pragma unroll
                for (int bj = 0; bj < 2; ++bj) { const f32x4 v0 = acc[ai][bj][m][0] + bv[bj][0], v1 = acc[ai][bj][m][1] + bv[bj][1];
                    u32x4 w; w.x = pk2(v0[0], v0[1]); w.y = pk2(v0[2], v0[3]); w.z = pk2(v1[0], v1[1]); w.w = pk2(v1[2], v1[3]);
                    *(u32x4*)(rowp + bj * 128) = w; } }
        ACC_ZERO(acc);
    }
};
DI void moe_build_table(Frame& F, const unsigned* cnt  ) {
    LAS int* tab = (LAS int*)(F.lds + LDS_TAB_OFF);
    if (F.tid < 32) tab[F.tid] = (int)__hip_atomic_load(cnt + F.tid * 16, __ATOMIC_RELAXED, __HIP_MEMORY_SCOPE_AGENT);
    __syncthreads();
    if (F.tid == 0) { int pb = 0, tb = 0; for (int e = 0; e < 32; ++e) { const int nt_ = (tab[e] + 255) >> 8; tab[32 + e] = pb; tab[64 + e] = tb; pb += nt_ * 256; tb += nt_; } tab[96] = tb; }
    __syncthreads();
    for (int e = 0; e < 32; ++e) { const int tb = tab[64 + e], nt_ = (tab[e] + 255) >> 8; for (int j = F.tid; j < nt_; j += NTHREADS) tab[128 + tb + j] = e; }
    __syncthreads();
}

DI void transpose_item(const float* W, int K, int N, bf16* WT, int mode, const float* gk, LAS float* scr, int item, int lane) {
    const int nblk = N / 32, kb = item / nblk, nb = item % nblk, k0 = 64 * kb, n0 = 32 * nb;
#pragma unroll 8
    for (int i = 0; i < 32; ++i) { const int kk = 2 * i + (lane >> 5); float v = W[(size_t)(k0 + kk) * N + n0 + (lane & 31)]; if (gk) v *= gk[k0 + kk]; scr[kk * 33 + (lane & 31)] = v; }
    LDS_WAIT(); asm volatile("" ::: "memory");
    int drow0 = n0;
    if (mode == 1) { const int up = n0 >= 1024, ch = n0 - (up ? 1024 : 0); drow0 = (ch >> 7) * 256 + (up ? 128 : 0) + (ch & 127); }
    const int c = lane & 7;
#pragma unroll
    for (int j = 0; j < 4; ++j) { const int n = (lane >> 3) + 8 * j; const LAS float* s = scr + (8 * c) * 33 + n;
        u32x4 o; o.x = pk2(s[0 * 33], s[1 * 33]); o.y = pk2(s[2 * 33], s[3 * 33]); o.z = pk2(s[4 * 33], s[5 * 33]); o.w = pk2(s[6 * 33], s[7 * 33]);
        *(u32x4*)(WT + (size_t)(drow0 + n) * K + k0 + 8 * c) = o; }
    LDS_WAIT(); asm volatile("" ::: "memory");
}
DI void transpose_batch(Frame& F, const float* W, size_t ss, int K, int N, bf16* WT, size_t ds, int nb, int mode, const float* gk, size_t gks) {
    LAS float* scr = (LAS float*)(F.lds + F.wave * 16384);
    const int gw = F.bid * NWAVES + F.wave, NGW = F.G * NWAVES;
    const int per = (K / 64) * (N / 32), total = per * nb;
    for (int it = gw; it < total; it += NGW) { const int b = it / per, r = it - b * per;
        transpose_item(W + (size_t)b * ss, K, N, WT + (size_t)b * ds, mode, gk ? gk + (size_t)b * gks : nullptr, scr, r, F.lane); }
}
DI void phase_prologue(Frame& F, const KA& a) {
    unsigned char* ws = F.ws;
    transpose_batch(F, a.in(I_WIN), (size_t)1024 * DIN, 1024, DIN, (bf16*)(ws + WS_WIN), (size_t)DINP * 1024, 4, 0, nullptr, 0);
    transpose_batch(F, a.in(I_WGU), (size_t)1024 * 2048, 1024, 2048, (bf16*)(ws + WS_WGU), (size_t)2048 * 1024, 128, 1, nullptr, 0);
    transpose_batch(F, a.in(I_WDOWN), (size_t)1024 * 1024, 1024, 1024, (bf16*)(ws + WS_WDN), (size_t)1024 * 1024, 128, 0, nullptr, 0);
    transpose_batch(F, a.in(I_WOUT), (size_t)1024 * 1024, 1024, 1024, (bf16*)(ws + WS_WOUT), (size_t)1024 * 1024, 4, 0, nullptr, 0);
    transpose_batch(F, a.in(I_BRRET), (size_t)512 * 1024, 512, 1024, (bf16*)(ws + WS_WBR), (size_t)3 * 1024 * 512, 4, 0, nullptr, 0);
    transpose_batch(F, a.in(I_BRMLA), (size_t)512 * 1024, 512, 1024, (bf16*)(ws + WS_WBR) + (size_t)1024 * 512, (size_t)3 * 1024 * 512, 4, 0, nullptr, 0);
    transpose_batch(F, a.in(I_BRRWKV), (size_t)512 * 1024, 512, 1024, (bf16*)(ws + WS_WBR) + (size_t)2 * 1024 * 512, (size_t)3 * 1024 * 512, 4, 0, nullptr, 0);
    transpose_batch(F, a.in(I_WUQ), (size_t)256 * 768, 256, 768, (bf16*)(ws + WS_SMALLW + SW_UQ), MiB / 2, 4, 0, a.in(I_MQNG), 256);
    transpose_batch(F, a.in(I_WUKV), (size_t)128 * 1024, 128, 1024, (bf16*)(ws + WS_SMALLW + SW_UKV), MiB / 2, 4, 0, a.in(I_MKVNG), 128);
    for (int l = 0; l < 4; ++l) {
        transpose_batch(F, a.in(I_W2) + (size_t)l * 2 * 64 * 512, (size_t)64 * 512, 64, 512, (bf16*)(ws + WS_SMALLW + l * MiB + SW_W2), (size_t)512 * 64, 2, 0, nullptr, 0);
        transpose_batch(F, a.in(I_A2) + (size_t)l * 2 * 64 * 512, (size_t)64 * 512, 64, 512, (bf16*)(ws + WS_SMALLW + l * MiB + SW_A2), (size_t)512 * 64, 2, 0, nullptr, 0);
    }
    transpose_batch(F, a.in(I_G2), (size_t)128 * 512, 128, 512, (bf16*)(ws + WS_SMALLW + SW_G2), MiB / 2, 4, 0, nullptr, 0);
    const int gt = F.bid * NTHREADS + F.tid, NGT = F.G * NTHREADS;
    for (int i = gt; i < 4 * (DINP - DIN) * 1024 / 8; i += NGT) { const int l = i / ((DINP - DIN) * 128), r = i - l * ((DINP - DIN) * 128);
        *(u32x4*)((bf16*)(ws + WS_WIN) + (size_t)l * DINP * 1024 + (size_t)DIN * 1024 + (size_t)r * 8) = (u32x4){0u, 0u, 0u, 0u}; }
    for (int i = gt; i < 128; i += NGT) *(u32x4*)((bf16*)(ws + WS_H) + (size_t)NT * 1024 + i * 8) = (u32x4){0u, 0u, 0u, 0u};
    { float2* rt = (float2*)(ws + WS_ROPE);
      for (int i = gt; i < 4096 * 32; i += NGT) { const int pos = i >> 5, f = i & 31; const float inv = powf(10000.f, -(float)(2 * f) / 64.f); const float ang = (float)pos * inv; float s, c; sincosf(ang, &s, &c); rt[i] = make_float2(c, s); }
      float2* ax = (float2*)(ws + WS_ROPE_AX);
      for (int i = gt; i < 64 * 8; i += NGT) { const int pos = i >> 3, f = i & 7; const float inv = powf(10000.f, -(float)(2 * f) / 16.f); const float ang = (float)pos * inv; float s, c; sincosf(ang, &s, &c); ax[i] = make_float2(c, s); } }
    { LAS float* sc = (LAS float*)(F.lds);
      LAS float* red = (LAS float*)(F.lds + 65536);
      __syncthreads();
      for (int i = F.tid; i < 9 * 1024; i += NTHREADS) { const int r = i >> 10, k = i & 1023; const float v = r < 8 ? a.in(I_C)[r * 1024 + k] : a.in(I_CCTX)[k]; sc[i] = v / (1.f + __expf(-v)); }
      __syncthreads();
      float* mod = (float*)(ws + WS_MOD);
      for (int it = F.bid; it < 4 * 96; it += F.G) { const int l = it / 96, n = (it - l * 96) * 64 + F.lane;
          const float* w = a.in(I_ADAW) + (size_t)l * 1024 * 6144 + n; float acc[9];
#pragma unroll
          for (int r = 0; r < 9; ++r) acc[r] = 0.f;
          const int kb = F.wave * 128;
#pragma unroll 8
          for (int k = 0; k < 128; ++k) { const float wv = w[(size_t)(kb + k) * 6144];
#pragma unroll
              for (int r = 0; r < 9; ++r) acc[r] += sc[r * 1024 + kb + k] * wv; }
#pragma unroll
          for (int r = 0; r < 9; ++r) red[(F.wave * 9 + r) * 64 + F.lane] = acc[r];
          __syncthreads();
          for (int i = F.tid; i < 9 * 64; i += NTHREADS) { const int r = i >> 6, c = i & 63; float s = 0.f;
#pragma unroll
              for (int w8 = 0; w8 < 8; ++w8) s += red[(w8 * 9 + r) * 64 + c];
              const int nn = (it - l * 96) * 64 + c; mod[((size_t)l * 9 + r) * 6144 + nn] = s + a.in(I_ADAB)[l * 6144 + nn]; }
          __syncthreads(); } }
}

DI void norm_mod_store(const f32x4 (&v)[4], const float* gain, const float* sc, const float* sh, bf16* hrow, int lane) {
    float s = 0.f;
#pragma unroll
    for (int j = 0; j < 4; ++j) s += (v[j].x * v[j].x + v[j].y * v[j].y) + (v[j].z * v[j].z + v[j].w * v[j].w);
    const float rinv = rsqrtf(wave_sum(s) * (1.f / 1024.f) + 1e-6f);
#pragma unroll
    for (int j = 0; j < 4; ++j) { const int c = 256 * j + 4 * lane; const f32x4 g = *(const f32x4*)(gain + c), a = *(const f32x4*)(sc + c), b = *(const f32x4*)(sh + c);
        const f32x4 y = v[j] * rinv * g * (a + 1.f) + b; u32x2 o; o.x = pk2(y.x, y.y); o.y = pk2(y.z, y.w); *(u32x2*)(hrow + c) = o; }
}
DI void phase_init_rows(Frame& F, const KA& a) {
    const int gw = F.bid * NWAVES + F.wave, NGW = F.G * NWAVES;
    float* X = (float*)(F.ws + WS_X); bf16* H = (bf16*)(F.ws + WS_H); const float* mod = (const float*)(F.ws + WS_MOD);
    for (int r = gw; r < NT; r += NGW) { const int b = r / LTOT, p = r - b * LTOT;
        const float* src = p < CTX ? a.in(I_CTX) + ((size_t)b * CTX + p) * 1024 : a.in(I_X) + ((size_t)b * SEQ + (p - CTX)) * 1024;
        f32x4 v[4];
#pragma unroll
        for (int j = 0; j < 4; ++j) { v[j] = *(const f32x4*)(src + 256 * j + 4 * F.lane); *(f32x4*)(X + (size_t)r * 1024 + 256 * j + 4 * F.lane) = v[j]; }
        const float* m = mod + (size_t)(p < CTX ? 8 : b) * 6144;
        norm_mod_store(v, a.in(I_N1G), m + 1024, m, H + (size_t)r * 1024, F.lane); }
}

DI void phase_router(Frame& F, const KA& a, int l) {
    LAS float* T = (LAS float*)(F.lds);
    LAS float* part = (LAS float*)(F.lds + 16 * 1028 * 4);
    LAS float* logit = (LAS float*)(F.lds + 16 * 1028 * 4 + 16384);
    LAS int* lcnt = (LAS int*)(F.lds + 16 * 1028 * 4 + 16384 + 2048);
    LAS int* gbase = lcnt + 32;
    const float* X = (const float*)(F.ws + WS_X); bf16* H = (bf16*)(F.ws + WS_H);
    const float* mod = (const float*)(F.ws + WS_MOD) + (size_t)l * 9 * 6144;
    const float* gain = a.in(I_N2G) + l * 1024; const float* wr = a.in(I_WROUTER) + (size_t)l * 1024 * 32; const float* br = a.in(I_BROUTER) + l * 32;
    int* eidx = (int*)(F.ws + WS_TOPK); float* gw = (float*)(F.ws + WS_TOPK) + (size_t)NT * 4; int* rank = (int*)(F.ws + WS_TOPK) + (size_t)NT * 8;
    int* list = (int*)(F.ws + WS_LIST); unsigned* cnt = F.ctl + CW_CNT + l * 32 * 16;
    const int lane = F.lane, w = F.wave;
    for (int it = F.bid; it < NT / 16; it += F.G) {
        const int r0 = it * 16;
        __syncthreads();
        if (F.tid < 32) lcnt[F.tid] = 0;
#pragma unroll
        for (int rr = 0; rr < 2; ++rr) { const int lr = w * 2 + rr, r = r0 + lr; const int b = r / LTOT, p = r - b * LTOT; const float* m = mod + (size_t)(p < CTX ? 8 : b) * 6144;
            f32x4 v[4]; float s = 0.f;
#pragma unroll
            for (int j = 0; j < 4; ++j) { v[j] = *(const f32x4*)(X + (size_t)r * 1024 + 256 * j + 4 * lane); s += (v[j].x * v[j].x + v[j].y * v[j].y) + (v[j].z * v[j].z + v[j].w * v[j].w); }
            const float rinv = rsqrtf(wave_sum(s) * (1.f / 1024.f) + 1e-6f);
#pragma unroll
            for (int j = 0; j < 4; ++j) { const int c = 256 * j + 4 * lane; const f32x4 g = *(const f32x4*)(gain + c), sc = *(const f32x4*)(m + 4096 + c), sh = *(const f32x4*)(m + 3072 + c);
                const f32x4 y = v[j] * rinv * g * (sc + 1.f) + sh; *(LAS f32x4*)(T + lr * 1028 + c) = y;
                u32x2 o; o.x = pk2(y.x, y.y); o.y = pk2(y.z, y.w); *(u32x2*)(H + (size_t)r * 1024 + c) = o; } }
        __syncthreads();
        { const int i = lane & 15, q = lane >> 4; f32x4 acc0 = {0.f, 0.f, 0.f, 0.f}, acc1 = acc0;
          const LAS float* tp = T + i * 1028 + 128 * w + 32 * q; const float* wp = wr + (size_t)(128 * w + 32 * q) * 32 + i;
#pragma unroll 8
          for (int s = 0; s < 32; ++s) { const float av = tp[s]; const float b0 = wp[s * 32], b1 = wp[s * 32 + 16];
              acc0 = __builtin_amdgcn_mfma_f32_16x16x4f32(av, b0, acc0, 0, 0, 0); acc1 = __builtin_amdgcn_mfma_f32_16x16x4f32(av, b1, acc1, 0, 0, 0); }
#pragma unroll
          for (int rg = 0; rg < 4; ++rg) { part[(w * 16 + 4 * q + rg) * 32 + i] = acc0[rg]; part[(w * 16 + 4 * q + rg) * 32 + 16 + i] = acc1[rg]; } }
        __syncthreads();
        { const int row = F.tid >> 5, e = F.tid & 31; float s = br[e];
#pragma unroll
          for (int w8 = 0; w8 < 8; ++w8) s += part[(w8 * 16 + row) * 32 + e];
          logit[row * 32 + e] = s; }
        __syncthreads();
        int te[4] = {0, 0, 0, 0}; float tv[4] = {0.f, 0.f, 0.f, 0.f}; int lr_[4] = {0, 0, 0, 0};
        if (F.tid < 16) { const LAS float* lg = logit + F.tid * 32; unsigned used = 0u;
#pragma unroll
            for (int k = 0; k < 4; ++k) { float best = -3.0e38f; int bi = 0;
                for (int e = 0; e < 32; ++e) { const float v = lg[e]; if (!((used >> e) & 1u) && v > best) { best = v; bi = e; } }
                used |= 1u << bi; te[k] = bi; tv[k] = best; }
            const float mx = tv[0]; float den = 0.f;
#pragma unroll
            for (int k = 0; k < 4; ++k) { tv[k] = __expf(tv[k] - mx); den += tv[k]; }
#pragma unroll
            for (int k = 0; k < 4; ++k) { tv[k] /= den; lr_[k] = atomicAdd((int*)&lcnt[te[k]], 1); } }
        __syncthreads();
        if (F.tid < 32) { const int c = lcnt[F.tid]; gbase[F.tid] = c ? (int)__hip_atomic_fetch_add(cnt + F.tid * 16, (unsigned)c, __ATOMIC_RELAXED, __HIP_MEMORY_SCOPE_AGENT) : 0; }
        __syncthreads();
        if (F.tid < 16) { const int r = r0 + F.tid;
#pragma unroll
            for (int k = 0; k < 4; ++k) { const int rk = gbase[te[k]] + lr_[k]; eidx[r * 4 + k] = te[k]; gw[r * 4 + k] = tv[k]; rank[r * 4 + k] = rk; list[(size_t)te[k] * NT + rk] = r * 4 + k; } }
    }
}

DI void phase_combine(Frame& F, const KA& a, int l) {
    moe_build_table(F, F.ctl + CW_CNT + l * 32 * 16);
    const LAS int* tab = (const LAS int*)(F.lds + LDS_TAB_OFF);
    const int gw_ = F.bid * NWAVES + F.wave, NGW = F.G * NWAVES;
    float* X = (float*)(F.ws + WS_X); bf16* H = (bf16*)(F.ws + WS_H); const bf16* Y = (const bf16*)(F.ws + WS_Y);
    const float* mod = (const float*)(F.ws + WS_MOD) + (size_t)l * 9 * 6144;
    const int* eidx = (const int*)(F.ws + WS_TOPK); const float* gw = (const float*)(F.ws + WS_TOPK) + (size_t)NT * 4; const int* rank = (const int*)(F.ws + WS_TOPK) + (size_t)NT * 8;
    for (int r = gw_; r < NT; r += NGW) { const int b = r / LTOT, p = r - b * LTOT; const int mr = p < CTX ? 8 : b;
        if (l == DEPTH - 1 && p < CTX) continue;
        const float* g2 = mod + (size_t)mr * 6144 + 5120;
        f32x4 v[4], acc[4];
#pragma unroll
        for (int j = 0; j < 4; ++j) { v[j] = *(const f32x4*)(X + (size_t)r * 1024 + 256 * j + 4 * F.lane); acc[j] = (f32x4){0.f, 0.f, 0.f, 0.f}; }
#pragma unroll
        for (int k = 0; k < 4; ++k) { const int e = eidx[r * 4 + k]; const float g = gw[r * 4 + k]; const size_t slot = (size_t)(tab[32 + e] + rank[r * 4 + k]);
#pragma unroll
            for (int j = 0; j < 4; ++j) { const u32x2 y = *(const u32x2*)(Y + slot * 1024 + 256 * j + 4 * F.lane);
                acc[j].x += g * bflo(y.x); acc[j].y += g * bfhi(y.x); acc[j].z += g * bflo(y.y); acc[j].w += g * bfhi(y.y); } }
#pragma unroll
        for (int j = 0; j < 4; ++j) v[j] = v[j] + *(const f32x4*)(g2 + 256 * j + 4 * F.lane) * acc[j];
        if (l == DEPTH - 1) {
            float* o = a.out() + ((size_t)b * SEQ + (p - CTX)) * 1024;
#pragma unroll
            for (int j = 0; j < 4; ++j) *(f32x4*)(o + 256 * j + 4 * F.lane) = v[j];
        } else {
#pragma unroll
            for (int j = 0; j < 4; ++j) *(f32x4*)(X + (size_t)r * 1024 + 256 * j + 4 * F.lane) = v[j];
            const float* m = (const float*)(F.ws + WS_MOD) + (size_t)(l + 1) * 9 * 6144 + (size_t)mr * 6144;
            norm_mod_store(v, a.in(I_N1G) + (l + 1) * 1024, m + 1024, m, H + (size_t)r * 1024, F.lane);
        }
    }
}

DI int crow16(int i, int h) { return (i & 3) + 8 * (i >> 2) + 4 * h; }
DI int permpos(int p) { return (p & ~12) | ((p & 4) << 1) | ((p & 8) >> 1); }
DI void phase_mla_prep(Frame& F, const KA& a, int l) {
    const bf16* P = (const bf16*)(F.ws + WS_P);
    const bf16* WUQ = (const bf16*)(F.ws + WS_SMALLW + (size_t)l * MiB + SW_UQ); const bf16* WUKV = (const bf16*)(F.ws + WS_SMALLW + (size_t)l * MiB + SW_UKV);
    bf16* QB = (bf16*)(F.ws + WS_QB); bf16* KB = (bf16*)(F.ws + WS_KB); bf16* VT = (bf16*)(F.ws + WS_VT);
    const float* gq = a.in(I_QKQG) + l * 96; const float* gk = a.in(I_QKKG) + l * 96;
    const float2* ax = (const float2*)(F.ws + WS_ROPE_AX);
    const int gw = F.bid * NWAVES + F.wave, NGW = F.G * NWAVES, lane = F.lane;
    for (int tt = gw; tt < NT / 32; tt += NGW) {
        int lane_o = lane; asm volatile("" : "+v"(lane_o));
        const int tok = lane_o & 31, h_ = lane_o >> 5, h = h_; const int r = tt * 32 + tok, b = r / LTOT, p = r - b * LTOT; const bool lat = p >= CTX; const int sl = p - CTX;
        const bf16* prow = P + (size_t)r * DINP;
        bf16x8 cq[16]; float ssq = 0.f;
#pragma unroll
        for (int s = 0; s < 16; ++s) { const u32x4 w = *(const u32x4*)(prow + PC_MQ + 16 * s + 8 * h); cq[s] = __builtin_bit_cast(bf16x8, w);
            ssq += bflo(w.x) * bflo(w.x) + bfhi(w.x) * bfhi(w.x) + bflo(w.y) * bflo(w.y) + bfhi(w.y) * bfhi(w.y) + bflo(w.z) * bflo(w.z) + bfhi(w.z) * bfhi(w.z) + bflo(w.w) * bflo(w.w) + bfhi(w.w) * bfhi(w.w); }
        ssq += __shfl_xor(ssq, 32);
        const float rinq = rsqrtf(ssq * (1.f / 256.f) + 1e-6f);
        float2 cr[4], cc[4];
#pragma unroll
        for (int f = 0; f < 4; ++f) { cr[f] = lat ? ax[(sl >> 6) * 8 + 4 * h + f] : make_float2(1.f, 0.f); cc[f] = lat ? ax[(sl & 63) * 8 + 4 * h + f] : make_float2(1.f, 0.f); }
#pragma unroll 1
        for (int hd = 0; hd < 8; ++hd) {
            int h = h_; asm volatile("" : "+v"(h));
            const size_t tokbase = (size_t)(b * 8 + hd) * LTOT + p;
            f32x16 acc[3];
#pragma unroll
            for (int cb = 0; cb < 3; ++cb) { f32x16 z; for (int i = 0; i < 16; ++i) z[i] = 0.f; const bf16* wrow = WUQ + (size_t)(hd * 96 + cb * 32 + tok) * 256 + 8 * h;
#pragma unroll
                for (int s = 0; s < 16; ++s) { const bf16x8 af = *(const bf16x8*)(wrow + 16 * s); z = __builtin_amdgcn_mfma_f32_32x32x16_bf16(af, cq[s], z, 0, 0, 0); }
                acc[cb] = z; }
            float ss = 0.f;
#pragma unroll
            for (int cb = 0; cb < 3; ++cb)
#pragma unroll
                for (int i = 0; i < 16; ++i) { acc[cb][i] *= rinq; ss += acc[cb][i] * acc[cb][i]; }
            ss += __shfl_xor(ss, 32);
            const float rq = rsqrtf(ss * (1.f / 96.f) + 1e-6f);
#pragma unroll
            for (int cb = 0; cb < 3; ++cb)
#pragma unroll
                for (int i = 0; i < 16; ++i) acc[cb][i] *= rq * gq[cb * 32 + crow16(i, h)];
#pragma unroll
            for (int i = 0; i < 4; ++i) { const float2 c1 = cr[i]; const float x1 = acc[2][i], x2 = acc[2][i + 4]; acc[2][i] = x1 * c1.x - x2 * c1.y; acc[2][i + 4] = x1 * c1.y + x2 * c1.x;
                const float2 c2 = cc[i]; const float y1 = acc[2][8 + i], y2 = acc[2][12 + i]; acc[2][8 + i] = y1 * c2.x - y2 * c2.y; acc[2][12 + i] = y1 * c2.y + y2 * c2.x; }
            bf16* qrow = QB + tokbase * 96;
#pragma unroll
            for (int cb = 0; cb < 3; ++cb)
#pragma unroll
                for (int g = 0; g < 4; ++g) { u32x2 o; o.x = pk2(acc[cb][4 * g], acc[cb][4 * g + 1]); o.y = pk2(acc[cb][4 * g + 2], acc[cb][4 * g + 3]); *(u32x2*)(qrow + cb * 32 + 8 * g + 4 * h) = o; }
        }
    }
    for (int tt = gw; tt < NT / 32; tt += NGW) {
        int lane_o = lane; asm volatile("" : "+v"(lane_o));
        const int tok = lane_o & 31, h_ = lane_o >> 5, h = h_; const int r = tt * 32 + tok, b = r / LTOT, p = r - b * LTOT; const bool lat = p >= CTX; const int sl = p - CTX;
        const bf16* prow = P + (size_t)r * DINP;
        bf16x8 ckv[8]; float ssk = 0.f;
#pragma unroll
        for (int s = 0; s < 8; ++s) { const u32x4 w = *(const u32x4*)(prow + PC_MKV + 16 * s + 8 * h); ckv[s] = __builtin_bit_cast(bf16x8, w);
            ssk += bflo(w.x) * bflo(w.x) + bfhi(w.x) * bfhi(w.x) + bflo(w.y) * bflo(w.y) + bfhi(w.y) * bfhi(w.y) + bflo(w.z) * bflo(w.z) + bfhi(w.z) * bfhi(w.z) + bflo(w.w) * bflo(w.w) + bfhi(w.w) * bfhi(w.w); }
        ssk += __shfl_xor(ssk, 32);
        const float rinkv = rsqrtf(ssk * (1.f / 128.f) + 1e-6f);
        float pe1[8], pe2[8]; float sspe = 0.f;
        { const u32x4 w0 = *(const u32x4*)(prow + PC_MPE + 16 * h), w1 = *(const u32x4*)(prow + PC_MPE + 16 * h + 8);
          pe1[0] = bflo(w0.x); pe1[1] = bfhi(w0.x); pe1[2] = bflo(w0.y); pe1[3] = bfhi(w0.y); pe1[4] = bflo(w0.z); pe1[5] = bfhi(w0.z); pe1[6] = bflo(w0.w); pe1[7] = bfhi(w0.w);
          pe2[0] = bflo(w1.x); pe2[1] = bfhi(w1.x); pe2[2] = bflo(w1.y); pe2[3] = bfhi(w1.y); pe2[4] = bflo(w1.z); pe2[5] = bfhi(w1.z); pe2[6] = bflo(w1.w); pe2[7] = bfhi(w1.w);
#pragma unroll
          for (int j = 0; j < 8; ++j) sspe += pe1[j] * pe1[j] + pe2[j] * pe2[j];
          sspe += __shfl_xor(sspe, 32); }
        float2 cs[8];
#pragma unroll
        for (int f = 0; f < 8; ++f) cs[f] = lat ? ax[(h ? (sl & 63) : (sl >> 6)) * 8 + f] : make_float2(1.f, 0.f);
#pragma unroll 1
        for (int hd = 0; hd < 8; ++hd) {
            int h = h_; asm volatile("" : "+v"(h));
            const size_t tokbase = (size_t)(b * 8 + hd) * LTOT + p;
            f32x16 acc[4];
#pragma unroll
            for (int cb = 0; cb < 4; ++cb) { f32x16 z; for (int i = 0; i < 16; ++i) z[i] = 0.f; const bf16* wrow = WUKV + (size_t)(hd * 128 + cb * 32 + tok) * 128 + 8 * h;
#pragma unroll
                for (int s = 0; s < 8; ++s) { const bf16x8 af = *(const bf16x8*)(wrow + 16 * s); z = __builtin_amdgcn_mfma_f32_32x32x16_bf16(af, ckv[s], z, 0, 0, 0); }
                acc[cb] = z; }
            float ss = 0.f;
#pragma unroll
            for (int cb = 0; cb < 4; ++cb)
#pragma unroll
                for (int i = 0; i < 16; ++i) { acc[cb][i] *= rinkv; if (cb < 2) ss += acc[cb][i] * acc[cb][i]; }
            ss += __shfl_xor(ss, 32);
            const float rk = rsqrtf((ss + sspe) * (1.f / 96.f) + 1e-6f);
            bf16* krow = KB + tokbase * 96;
#pragma unroll
            for (int cb = 0; cb < 2; ++cb)
#pragma unroll
                for (int g = 0; g < 4; ++g) { float o4[4];
#pragma unroll
                    for (int j = 0; j < 4; ++j) o4[j] = acc[cb][4 * g + j] * rk * gk[cb * 32 + 8 * g + 4 * h + j];
                    u32x2 o; o.x = pk2(o4[0], o4[1]); o.y = pk2(o4[2], o4[3]); *(u32x2*)(krow + cb * 32 + 8 * g + 4 * h) = o; }
            { float pe[16];
#pragma unroll
              for (int f = 0; f < 8; ++f) { const float x1 = pe1[f] * rk * gk[64 + 16 * h + f], x2 = pe2[f] * rk * gk[64 + 16 * h + 8 + f];
                  pe[f] = x1 * cs[f].x - x2 * cs[f].y; pe[8 + f] = x1 * cs[f].y + x2 * cs[f].x; }
              *(bf16x8*)(krow + 64 + 16 * h) = pack8(pe); *(bf16x8*)(krow + 64 + 16 * h + 8) = pack8(pe + 8); }
            bf16* vt = VT + (size_t)(b * 8 + hd) * 64 * LTOT + permpos(p);
#pragma unroll
            for (int cb = 2; cb < 4; ++cb)
#pragma unroll
                for (int i = 0; i < 16; ++i) vt[(size_t)((cb - 2) * 32 + crow16(i, h)) * LTOT] = f2bf(acc[cb][i]);
        }
    }
}

constexpr int ATT_KP = 104, ATT_VP = 72;
constexpr int ATT_KBYTES = 64 * ATT_KP * 2, ATT_VBYTES = 64 * ATT_VP * 2;
DI void attn_unit(Frame& F, int b, int hd, int qblk) {
    const bf16* QB = (const bf16*)(F.ws + WS_QB); const bf16* KB = (const bf16*)(F.ws + WS_KB); const bf16* VT = (const bf16*)(F.ws + WS_VT);
    bf16* O = (bf16*)(F.ws + WS_ABR) + (size_t)NT * 512;
    const int q0 = qblk == 0 ? 0 : CTX + 256 * (qblk - 1), ntiles = qblk == 0 ? CTX / 64 : LTOT / 64;
    const int lane = F.lane, ql = lane & 31, h = lane >> 5, w = F.wave, tid = F.tid;
    const size_t bh = (size_t)(b * 8 + hd);
    LAS bf16* Kt = (LAS bf16*)(F.lds); LAS bf16* Vt = (LAS bf16*)(F.lds + 2 * ATT_KBYTES);
    bf16x8 qf[6];
    { const bf16* qrow = QB + (bh * LTOT + q0 + 32 * w + ql) * 96 + 8 * h;
#pragma unroll
      for (int s = 0; s < 6; ++s) qf[s] = *(const bf16x8*)(qrow + 16 * s); }
    const bf16* kbase = KB + bh * LTOT * 96; const bf16* vbase = VT + bh * 64 * LTOT;
    const int k1 = tid / 12, c1 = tid - k1 * 12, k2 = (512 + tid) / 12, c2 = (512 + tid) - k2 * 12, vd = tid >> 3, vc = tid & 7;
    u32x4 rk1, rk2 = {0u, 0u, 0u, 0u}, rv;
    rk1 = *(const u32x4*)(kbase + (size_t)k1 * 96 + 8 * c1); if (tid < 256) rk2 = *(const u32x4*)(kbase + (size_t)k2 * 96 + 8 * c2); rv = *(const u32x4*)(vbase + (size_t)vd * LTOT + 8 * vc);
    __syncthreads();
    *(LAS u32x4*)(Kt + k1 * ATT_KP + 8 * c1) = rk1; if (tid < 256) *(LAS u32x4*)(Kt + k2 * ATT_KP + 8 * c2) = rk2; *(LAS u32x4*)(Vt + vd * ATT_VP + 8 * vc) = rv;
    __syncthreads();
    float m = -1.0e30f, lsum = 0.f; f32x16 o0, o1;
#pragma unroll
    for (int i = 0; i < 16; ++i) { o0[i] = 0.f; o1[i] = 0.f; }
    const float sc = 0.10206207261596577f * 1.4426950408889634f;
    for (int t = 0; t < ntiles; ++t) {
        const int buf = t & 1; const bool more = t + 1 < ntiles;
        if (more) { const size_t ko = (size_t)(t + 1) * 64; rk1 = *(const u32x4*)(kbase + (ko + k1) * 96 + 8 * c1); if (tid < 256) rk2 = *(const u32x4*)(kbase + (ko + k2) * 96 + 8 * c2); rv = *(const u32x4*)(vbase + (size_t)vd * LTOT + ko + 8 * vc); }
        const LAS bf16* kt = Kt + buf * (64 * ATT_KP); const LAS bf16* vt = Vt + buf * (64 * ATT_VP);
        f32x16 s0, s1;
#pragma unroll
        for (int i = 0; i < 16; ++i) { s0[i] = 0.f; s1[i] = 0.f; }
#pragma unroll
        for (int s = 0; s < 6; ++s) { const bf16x8 a0 = *(const LAS bf16x8*)(kt + ql * ATT_KP + 16 * s + 8 * h), a1 = *(const LAS bf16x8*)(kt + (32 + ql) * ATT_KP + 16 * s + 8 * h);
            s0 = __builtin_amdgcn_mfma_f32_32x32x16_bf16(a0, qf[s], s0, 0, 0, 0); s1 = __builtin_amdgcn_mfma_f32_32x32x16_bf16(a1, qf[s], s1, 0, 0, 0); }
        float mt = -1.0e30f;
#pragma unroll
        for (int i = 0; i < 16; ++i) { s0[i] *= sc; s1[i] *= sc; mt = fmaxf(mt, fmaxf(s0[i], s1[i])); }
        mt = fmaxf(mt, __shfl_xor(mt, 32));
        const float mn = fmaxf(m, mt), alpha = __builtin_amdgcn_exp2f(m - mn); m = mn;
        float rs = 0.f;
#pragma unroll
        for (int i = 0; i < 16; ++i) { s0[i] = __builtin_amdgcn_exp2f(s0[i] - mn); s1[i] = __builtin_amdgcn_exp2f(s1[i] - mn); rs += s0[i] + s1[i]; }
        lsum = lsum * alpha + rs;
#pragma unroll
        for (int i = 0; i < 16; ++i) { o0[i] *= alpha; o1[i] *= alpha; }
        bf16x8 pf[4];
        { u32x4 x;
          x.x = pk2(s0[0], s0[1]); x.y = pk2(s0[2], s0[3]); x.z = pk2(s0[4], s0[5]); x.w = pk2(s0[6], s0[7]); pf[0] = __builtin_bit_cast(bf16x8, x);
          x.x = pk2(s0[8], s0[9]); x.y = pk2(s0[10], s0[11]); x.z = pk2(s0[12], s0[13]); x.w = pk2(s0[14], s0[15]); pf[1] = __builtin_bit_cast(bf16x8, x);
          x.x = pk2(s1[0], s1[1]); x.y = pk2(s1[2], s1[3]); x.z = pk2(s1[4], s1[5]); x.w = pk2(s1[6], s1[7]); pf[2] = __builtin_bit_cast(bf16x8, x);
          x.x = pk2(s1[8], s1[9]); x.y = pk2(s1[10], s1[11]); x.z = pk2(s1[12], s1[13]); x.w = pk2(s1[14], s1[15]); pf[3] = __builtin_bit_cast(bf16x8, x); }
#pragma unroll
        for (int ks = 0; ks < 4; ++ks) { const bf16x8 v0 = *(const LAS bf16x8*)(vt + ql * ATT_VP + 16 * ks + 8 * h), v1 = *(const LAS bf16x8*)(vt + (32 + ql) * ATT_VP + 16 * ks + 8 * h);
            o0 = __builtin_amdgcn_mfma_f32_32x32x16_bf16(v0, pf[ks], o0, 0, 0, 0); o1 = __builtin_amdgcn_mfma_f32_32x32x16_bf16(v1, pf[ks], o1, 0, 0, 0); }
        if (more) { const int nb = buf ^ 1; LAS bf16* kn = Kt + nb * (64 * ATT_KP); LAS bf16* vn = Vt + nb * (64 * ATT_VP);
            *(LAS u32x4*)(kn + k1 * ATT_KP + 8 * c1) = rk1; if (tid < 256) *(LAS u32x4*)(kn + k2 * ATT_KP + 8 * c2) = rk2; *(LAS u32x4*)(vn + vd * ATT_VP + 8 * vc) = rv; }
        __syncthreads();
    }
    lsum += __shfl_xor(lsum, 32);
    const float inv = 1.f / lsum;
    bf16* orow = O + ((size_t)b * LTOT + q0 + 32 * w + ql) * 512 + hd * 64 + 4 * h;
#pragma unroll
    for (int g = 0; g < 4; ++g) { u32x2 x; x.x = pk2(o0[4 * g] * inv, o0[4 * g + 1] * inv); x.y = pk2(o0[4 * g + 2] * inv, o0[4 * g + 3] * inv); *(u32x2*)(orow + 8 * g) = x;
        x.x = pk2(o1[4 * g] * inv, o1[4 * g + 1] * inv); x.y = pk2(o1[4 * g + 2] * inv, o1[4 * g + 3] * inv); *(u32x2*)(orow + 32 + 8 * g) = x; }
}

DI void shift_n(const bf16* prow, bool first, bool last, int col, const float* mup, const float* mun, float* out, int n  ) {
    const bf16* pp = first ? prow : prow - DINP; const bf16* pn = last ? prow : prow + DINP; const float fm = first ? 0.f : 1.f, lm = last ? 0.f : 1.f;
    if (n == 8) {
        const u32x4 c = *(const u32x4*)(prow + col), pv = *(const u32x4*)(pp + col), nx = *(const u32x4*)(pn + col);
        const f32x4 mp0 = *(const f32x4*)(mup + col - PC_RW), mp1 = *(const f32x4*)(mup + col - PC_RW + 4), mn0 = *(const f32x4*)(mun + col - PC_RW), mn1 = *(const f32x4*)(mun + col - PC_RW + 4);
        const unsigned cw[4] = {c.x, c.y, c.z, c.w}, pw[4] = {pv.x, pv.y, pv.z, pv.w}, nw[4] = {nx.x, nx.y, nx.z, nx.w};
        const float mp[8] = {mp0.x, mp0.y, mp0.z, mp0.w, mp1.x, mp1.y, mp1.z, mp1.w}, mn[8] = {mn0.x, mn0.y, mn0.z, mn0.w, mn1.x, mn1.y, mn1.z, mn1.w};
#pragma unroll
        for (int j = 0; j < 4; ++j) { const float t0 = bflo(cw[j]), t1 = bfhi(cw[j]);
            out[2 * j] = t0 + mp[2 * j] * (fm * bflo(pw[j]) - t0) + mn[2 * j] * (lm * bflo(nw[j]) - t0);
            out[2 * j + 1] = t1 + mp[2 * j + 1] * (fm * bfhi(pw[j]) - t1) + mn[2 * j + 1] * (lm * bfhi(nw[j]) - t1); }
    } else {
        const u32x2 c = *(const u32x2*)(prow + col), pv = *(const u32x2*)(pp + col), nx = *(const u32x2*)(pn + col);
        const f32x4 mp0 = *(const f32x4*)(mup + col - PC_RW), mn0 = *(const f32x4*)(mun + col - PC_RW);
        const unsigned cw[2] = {c.x, c.y}, pw[2] = {pv.x, pv.y}, nw[2] = {nx.x, nx.y};
        const float mp[4] = {mp0.x, mp0.y, mp0.z, mp0.w}, mn[4] = {mn0.x, mn0.y, mn0.z, mn0.w};
#pragma unroll
        for (int j = 0; j < 2; ++j) { const float t0 = bflo(cw[j]), t1 = bfhi(cw[j]);
            out[2 * j] = t0 + mp[2 * j] * (fm * bflo(pw[j]) - t0) + mn[2 * j] * (lm * bflo(nw[j]) - t0);
            out[2 * j + 1] = t1 + mp[2 * j + 1] * (fm * bfhi(pw[j]) - t1) + mn[2 * j + 1] * (lm * bfhi(nw[j]) - t1); }
    }
}
DI void phase_rwkv_prep(Frame& F, const KA& a, int l) {
    const bf16* P = (const bf16*)(F.ws + WS_P);
    const bf16* W2T = (const bf16*)(F.ws + WS_SMALLW + (size_t)l * MiB + SW_W2); const bf16* A2T = (const bf16*)(F.ws + WS_SMALLW + (size_t)l * MiB + SW_A2); const bf16* G2T = (const bf16*)(F.ws + WS_SMALLW + (size_t)l * MiB + SW_G2);
    const float* mup = a.in(I_MUP) + l * 1920; const float* mun = a.in(I_MUN) + l * 1920;
    const float* w0 = a.in(I_W0) + l * 1024; const float* a0 = a.in(I_A0) + l * 1024; const float* kkw = a.in(I_KK) + l * 512; const float* kaw = a.in(I_KA) + l * 512;
    bf16* RW = (bf16*)(F.ws + WS_RW); float* LW = (float*)(F.ws + WS_LW);
    const size_t TS = (size_t)NT * 512;
    const int gw = F.bid * NWAVES + F.wave, NGW = F.G * NWAVES, lane = F.lane;
    for (int tt = gw; tt < NT / 32; tt += NGW) {
        int lane_o = lane; asm volatile("" : "+v"(lane_o));
        const int tok = lane_o & 31, h = lane_o >> 5;
        const int r = tt * 32 + tok, b = r / LTOT, p = r - b * LTOT; const bool first = (p == 0) || (p == CTX), last = (p == CTX - 1) || (p == LTOT - 1);
        const bf16* prow = P + (size_t)r * DINP;
        bf16x8 fwf[4], fwb[4];
#pragma unroll
        for (int s = 0; s < 4; ++s) { float v[8];
            shift_n(prow, first, last, PC_WHF + 16 * s + 8 * h, mup, mun, v, 8);
#pragma unroll
            for (int j = 0; j < 8; ++j) v[j] = 2.f * sigmoidf_(2.f * v[j]) - 1.f;
            fwf[s] = pack8(v); asm volatile("" : "+v"(fwf[s]) :: "memory");
            shift_n(prow, first, last, PC_WHB + 16 * s + 8 * h, mup, mun, v, 8);
#pragma unroll
            for (int j = 0; j < 8; ++j) v[j] = 2.f * sigmoidf_(2.f * v[j]) - 1.f;
            fwb[s] = pack8(v); asm volatile("" : "+v"(fwb[s]) :: "memory"); }
#pragma unroll 1
        for (int blk = 0; blk < 16; ++blk) {
            const int wrow = blk * 32 + tok; const size_t o = (size_t)r * 512 + blk * 32 + 4 * h;
            { f32x16 c; for (int i = 0; i < 16; ++i) c[i] = 0.f;
#pragma unroll
              for (int s = 0; s < 4; ++s) c = __builtin_amdgcn_mfma_f32_32x32x16_bf16(*(const bf16x8*)(W2T + (size_t)wrow * 64 + 16 * s + 8 * h), fwf[s], c, 0, 0, 0);
#pragma unroll
              for (int g = 0; g < 4; ++g) { const f32x4 w4 = *(const f32x4*)(w0 + blk * 32 + 8 * g + 4 * h);
                  *(f32x4*)(LW + o + 8 * g) = (f32x4){-0.6065306597f * sigmoidf_(w4.x + c[4 * g]), -0.6065306597f * sigmoidf_(w4.y + c[4 * g + 1]), -0.6065306597f * sigmoidf_(w4.z + c[4 * g + 2]), -0.6065306597f * sigmoidf_(w4.w + c[4 * g + 3])}; } }
            { f32x16 c; for (int i = 0; i < 16; ++i) c[i] = 0.f;
#pragma unroll
              for (int s = 0; s < 4; ++s) c = __builtin_amdgcn_mfma_f32_32x32x16_bf16(*(const bf16x8*)(W2T + (size_t)(512 + wrow) * 64 + 16 * s + 8 * h), fwb[s], c, 0, 0, 0);
#pragma unroll
              for (int g = 0; g < 4; ++g) { const f32x4 w4 = *(const f32x4*)(w0 + 512 + blk * 32 + 8 * g + 4 * h);
                  *(f32x4*)(LW + TS + o + 8 * g) = (f32x4){-0.6065306597f * sigmoidf_(w4.x + c[4 * g]), -0.6065306597f * sigmoidf_(w4.y + c[4 * g + 1]), -0.6065306597f * sigmoidf_(w4.z + c[4 * g + 2]), -0.6065306597f * sigmoidf_(w4.w + c[4 * g + 3])}; } }
        }
    }
    for (int tt = gw; tt < NT / 32; tt += NGW) {
        int lane_o = lane; asm volatile("" : "+v"(lane_o));
        const int tok = lane_o & 31, h = lane_o >> 5;
        const int r = tt * 32 + tok, b = r / LTOT, p = r - b * LTOT; const bool first = (p == 0) || (p == CTX), last = (p == CTX - 1) || (p == LTOT - 1);
        const bf16* prow = P + (size_t)r * DINP;
        bf16x8 fg[8];
#pragma unroll
        for (int s = 0; s < 8; ++s) { float v[8]; shift_n(prow, first, last, PC_GH + 16 * s + 8 * h, mup, mun, v, 8);
#pragma unroll
            for (int j = 0; j < 8; ++j) v[j] = sigmoidf_(v[j]);
            fg[s] = pack8(v); asm volatile("" : "+v"(fg[s]) :: "memory"); }
#pragma unroll 1
        for (int blk = 0; blk < 16; ++blk) {
            const int wrow = blk * 32 + tok; const size_t o = (size_t)r * 512 + blk * 32 + 4 * h;
            { f32x16 c; for (int i = 0; i < 16; ++i) c[i] = 0.f;
#pragma unroll
              for (int s = 0; s < 8; ++s) c = __builtin_amdgcn_mfma_f32_32x32x16_bf16(*(const bf16x8*)(G2T + (size_t)wrow * 128 + 16 * s + 8 * h), fg[s], c, 0, 0, 0);
#pragma unroll
              for (int g = 0; g < 4; ++g) { u32x2 w_; w_[0] = pk2(c[4 * g], c[4 * g + 1]); w_[1] = pk2(c[4 * g + 2], c[4 * g + 3]); *(u32x2*)(RW + 7 * TS + o + 8 * g) = w_; } }
        }
    }
    for (int tt = gw; tt < NT / 32; tt += NGW) {
        int lane_o = lane; asm volatile("" : "+v"(lane_o));
        const int tok = lane_o & 31, h = lane_o >> 5;
        const int r = tt * 32 + tok, b = r / LTOT, p = r - b * LTOT; const bool first = (p == 0) || (p == CTX), last = (p == CTX - 1) || (p == LTOT - 1);
        const bf16* prow = P + (size_t)r * DINP;
        bf16x8 faf[4], fab[4];
#pragma unroll
        for (int s = 0; s < 4; ++s) { float v[8];
            shift_n(prow, first, last, PC_AHF + 16 * s + 8 * h, mup, mun, v, 8); faf[s] = pack8(v); asm volatile("" : "+v"(faf[s]) :: "memory");
            shift_n(prow, first, last, PC_AHB + 16 * s + 8 * h, mup, mun, v, 8); fab[s] = pack8(v); asm volatile("" : "+v"(fab[s]) :: "memory"); }
#pragma unroll 1
        for (int hd = 0; hd < 8; ++hd) {
            float kraw[2][16]; float ss = 0.f;
#pragma unroll
            for (int cb = 0; cb < 2; ++cb)
#pragma unroll
                for (int g = 0; g < 4; ++g) { const int ch = hd * 64 + cb * 32 + 8 * g + 4 * h; shift_n(prow, first, last, PC_WK + ch, mup, mun, &kraw[cb][4 * g], 4);
#pragma unroll
                    for (int j = 0; j < 4; ++j) { const float t = kraw[cb][4 * g + j] * kkw[ch + j]; ss += t * t; }
                    asm volatile("" : "+v"(kraw[cb][4 * g]), "+v"(kraw[cb][4 * g + 1]), "+v"(kraw[cb][4 * g + 2]), "+v"(kraw[cb][4 * g + 3]) :: "memory"); }
            ss += __shfl_xor(ss, 32);
            const float rkk = rsqrtf(fmaxf(ss, 1e-24f));
#pragma unroll
            for (int cb = 0; cb < 2; ++cb) {
                f32x16 caf, cab;
#pragma unroll
                for (int i = 0; i < 16; ++i) { caf[i] = 0.f; cab[i] = 0.f; }
                const int wrow = hd * 64 + cb * 32 + tok;
#pragma unroll
                for (int s = 0; s < 4; ++s) {
                    caf = __builtin_amdgcn_mfma_f32_32x32x16_bf16(*(const bf16x8*)(A2T + (size_t)wrow * 64 + 16 * s + 8 * h), faf[s], caf, 0, 0, 0);
                    cab = __builtin_amdgcn_mfma_f32_32x32x16_bf16(*(const bf16x8*)(A2T + (size_t)(512 + wrow) * 64 + 16 * s + 8 * h), fab[s], cab, 0, 0, 0); }
#pragma unroll
                for (int g = 0; g < 4; ++g) { const int ch = hd * 64 + cb * 32 + 8 * g + 4 * h; float rv[4], vv[4];
                    shift_n(prow, first, last, PC_WR + ch, mup, mun, rv, 4); shift_n(prow, first, last, PC_WV + ch, mup, mun, vv, 4);
                    float kf[4], kb_[4], kk[4], af[4], ab[4];
#pragma unroll
                    for (int j = 0; j < 4; ++j) { const int i = 4 * g + j; const float k = kraw[cb][i];
                        af[j] = sigmoidf_(a0[ch + j] + caf[i]); ab[j] = sigmoidf_(a0[512 + ch + j] + cab[i]);
                        kf[j] = k * (1.f + (af[j] - 1.f) * kaw[ch + j]); kb_[j] = k * (1.f + (ab[j] - 1.f) * kaw[ch + j]);
                        kk[j] = k * kkw[ch + j] * rkk; }
                    const size_t o = (size_t)r * 512 + ch;
#define ST4(idx, ARR) do { u32x2 w_; w_[0] = pk2(ARR[0], ARR[1]); w_[1] = pk2(ARR[2], ARR[3]); *(u32x2*)(RW + (size_t)(idx) * TS + o) = w_; } while (0)
                    ST4(0, rv); ST4(1, kf); ST4(2, kb_); ST4(3, vv); ST4(4, kk); ST4(5, af); ST4(6, ab);
#undef ST4
                    asm volatile("" ::: "memory");
                }
            }
        }
    }
}

DI void phase_rwkv_scan_naive(Frame& F, const KA& a, int l, int bi) {
    const bf16* RW = (const bf16*)(F.ws + WS_RW); const float* LW = (const float*)(F.ws + WS_LW); float* YF = (float*)(F.ws + WS_YF);
    const size_t TS = (size_t)NT * 512;
    const int lane = F.lane, w = F.wave, chain = bi * 8 + w, dir = chain & 1, bh = chain >> 1, b = bh >> 3, hd = bh & 7;
    LAS float* vec = (LAS float*)(F.lds + w * 2048);
    const bf16* Rr = RW; const bf16* Rk = RW + (size_t)(1 + dir) * TS; const bf16* Rv = RW + (size_t)3 * TS; const bf16* Rkk = RW + (size_t)4 * TS; const bf16* Ra = RW + (size_t)(5 + dir) * TS;
    const float* Rlw = LW + (size_t)dir * TS; float* Ry = YF + (size_t)dir * TS;
    const int base = b * LTOT * 512 + hd * 64 + lane;
    float S[64];
#pragma unroll
    for (int j = 0; j < 64; ++j) S[j] = 0.f;
#define POSOF(n) (dir == 0 ? (n) : ((n) < CTX ? CTX - 1 - (n) : LTOT - 1 - ((n) - CTX)))
    int off = base + POSOF(0) * 512;
    float cr = bf2f(Rr[off]), ck = bf2f(Rk[off]), cv = bf2f(Rv[off]), ckk = bf2f(Rkk[off]), ca = bf2f(Ra[off]), clw = Rlw[off];
#pragma unroll 1
    for (int n = 0; n < LTOT; ++n) {
        vec[lane] = __expf(clw); vec[64 + lane] = ckk; vec[128 + lane] = ckk * ca; vec[192 + lane] = ck; vec[256 + lane] = cr;
        const float vi = cv; const int ocur = off;
        if (n + 1 < LTOT) { off = base + POSOF(n + 1) * 512;
            cr = bf2f(Rr[off]); ck = bf2f(Rk[off]); cv = bf2f(Rv[off]); ckk = bf2f(Rkk[off]); ca = bf2f(Ra[off]); clw = Rlw[off]; }
        float sa0 = 0.f, sa1 = 0.f, sa2 = 0.f, sa3 = 0.f;
#pragma unroll
        for (int j = 0; j < 64; j += 4) { const f32x4 kk4 = *(const LAS f32x4*)(vec + 64 + j); sa0 += S[j] * kk4.x; sa1 += S[j + 1] * kk4.y; sa2 += S[j + 2] * kk4.z; sa3 += S[j + 3] * kk4.w; if ((j & 15) == 12) asm volatile("" ::: "memory"); }
        const float sa = -((sa0 + sa1) + (sa2 + sa3));
        float y0 = 0.f, y1 = 0.f, y2 = 0.f, y3 = 0.f;
#pragma unroll
        for (int j = 0; j < 64; j += 4) { const f32x4 w4 = *(const LAS f32x4*)(vec + j), ka4 = *(const LAS f32x4*)(vec + 128 + j), k4 = *(const LAS f32x4*)(vec + 192 + j), r4 = *(const LAS f32x4*)(vec + 256 + j);
            S[j] = S[j] * w4.x + (sa * ka4.x + vi * k4.x); S[j + 1] = S[j + 1] * w4.y + (sa * ka4.y + vi * k4.y); S[j + 2] = S[j + 2] * w4.z + (sa * ka4.z + vi * k4.z); S[j + 3] = S[j + 3] * w4.w + (sa * ka4.w + vi * k4.w);
            y0 += S[j] * r4.x; y1 += S[j + 1] * r4.y; y2 += S[j + 2] * r4.z; y3 += S[j + 3] * r4.w; if ((j & 7) == 4) asm volatile("" ::: "memory"); }
        Ry[ocur] = (y0 + y1) + (y2 + y3);
    }
#undef POSOF
    VM_WAIT(); __syncthreads(); __builtin_amdgcn_fence(__ATOMIC_ACQUIRE, "agent");
    const float* lng = a.in(I_LNXG) + l * 512; const float* lnb = a.in(I_LNXB) + l * 512; const float* rkw = a.in(I_RK) + l * 512;
    bf16* O = (bf16*)(F.ws + WS_ABR) + (size_t)2 * NT * 512;
    for (int pair = 0; pair < 4; ++pair) { const int bh2 = bi * 4 + pair, b2 = bh2 >> 3, hd2 = bh2 & 7; const int c = hd2 * 64 + lane;
        const float g_ = lng[c], b_ = lnb[c], rk_ = rkw[c];
        for (int pp = w; pp < LTOT; pp += NWAVES) { const size_t o = ((size_t)b2 * LTOT + pp) * 512 + c;
            const float s = YF[o] + YF[TS + o]; const float mean = wave_sum(s) * (1.f / 64.f); const float d = s - mean; const float var = wave_sum(d * d) * (1.f / 64.f);
            const float rr = bf2f(RW[o]), kf = bf2f(RW[TS + o]), kb_ = bf2f(RW[2 * TS + o]), vv = bf2f(RW[3 * TS + o]), gg = bf2f(RW[7 * TS + o]);
            const float bonus = wave_sum(rr * (kf + kb_) * rk_);
            const float y = d * rsqrtf(var + 64e-5f) * g_ + b_ + bonus * vv;
            O[o] = f2bf(y * gg); } }
}

constexpr int RT_QP = 72, RT_TP = 136;
constexpr int RT_QS = 0, RT_KS = 128 * RT_QP * 2, RT_KT = 2 * 128 * RT_QP * 2, RT_VT = RT_KT + 64 * RT_TP * 2, RT_ST = RT_VT + 128 * RT_TP * 2;
DI void phase_retention_item(Frame& F, const KA& a, int item) {
    const int b = item >> 2, hh = item & 3, tid = F.tid, lane = F.lane, w = F.wave, ql = lane & 31, h = lane >> 5;
    const bf16* P = (const bf16*)(F.ws + WS_P); const float2* rt = (const float2*)(F.ws + WS_ROPE);
    float* OFB = (float*)(F.ws + WS_OF); const size_t TS = (size_t)NT * 512;
    LAS bf16* Qs = (LAS bf16*)(F.lds + RT_QS); LAS bf16* Ks = (LAS bf16*)(F.lds + RT_KS); LAS bf16* KsT = (LAS bf16*)(F.lds + RT_KT); LAS bf16* VsT = (LAS bf16*)(F.lds + RT_VT); LAS bf16* SsT = (LAS bf16*)(F.lds + RT_ST);
    const float lg2g = log2f(1.f - exp2f(-5.f - (float)hh));
    const float gam = exp2f(lg2g), g127 = exp2f(127.f * lg2g), cdec = exp2f(128.f * lg2g);
    const int rb = w >> 1, cbp = w & 1, db = w >> 2, vb = w & 3;
    for (int dir = 0; dir < 2; ++dir) {
        f32x16 Sreg;
#pragma unroll
        for (int i = 0; i < 16; ++i) Sreg[i] = 0.f;
        __syncthreads();
        for (int i = tid; i < 128 * RT_QP / 2; i += NTHREADS) ((LAS unsigned*)SsT)[i] = 0u;
        for (int cn = 0; cn < 34; ++cn) {
            int p0; if (cn < 2) p0 = 128 * (dir ? 1 - cn : cn); else p0 = CTX + 128 * (dir ? 33 - cn : cn - 2);
            const bool lat = p0 >= CTX;
            { const int tok = tid >> 2, c = tid & 3; const int e = dir ? 127 - tok : tok; const size_t row = (size_t)b * LTOT + p0 + tok; const bf16* prow = P + row * DINP;
              const float sq = exp2f((float)e * lg2g), sk = 0.125f * exp2f(-(float)e * lg2g);
              const u32x4 ql_ = *(const u32x4*)(prow + PC_RQ + hh * 64 + 8 * c), qh_ = *(const u32x4*)(prow + PC_RQ + hh * 64 + 32 + 8 * c);
              const u32x4 kl_ = *(const u32x4*)(prow + PC_RK + hh * 64 + 8 * c), kh_ = *(const u32x4*)(prow + PC_RK + hh * 64 + 32 + 8 * c);
              float qlo[8] = {bflo(ql_.x), bfhi(ql_.x), bflo(ql_.y), bfhi(ql_.y), bflo(ql_.z), bfhi(ql_.z), bflo(ql_.w), bfhi(ql_.w)}, qhi[8] = {bflo(qh_.x), bfhi(qh_.x), bflo(qh_.y), bfhi(qh_.y), bflo(qh_.z), bfhi(qh_.z), bflo(qh_.w), bfhi(qh_.w)};
              float klo[8] = {bflo(kl_.x), bfhi(kl_.x), bflo(kl_.y), bfhi(kl_.y), bflo(kl_.z), bfhi(kl_.z), bflo(kl_.w), bfhi(kl_.w)}, khi[8] = {bflo(kh_.x), bfhi(kh_.x), bflo(kh_.y), bfhi(kh_.y), bflo(kh_.z), bfhi(kh_.z), bflo(kh_.w), bfhi(kh_.w)};
              if (lat) { const float2* ang = rt + (size_t)(p0 - CTX + tok) * 32 + 8 * c;
#pragma unroll
                  for (int j = 0; j < 8; ++j) { const float2 cs = ang[j]; const float a0 = qlo[j], a1 = qhi[j], b0 = klo[j], b1 = khi[j];
                      qlo[j] = a0 * cs.x - a1 * cs.y; qhi[j] = a0 * cs.y + a1 * cs.x; klo[j] = b0 * cs.x - b1 * cs.y; khi[j] = b0 * cs.y + b1 * cs.x; } }
#pragma unroll
              for (int j = 0; j < 8; ++j) { qlo[j] *= sq; qhi[j] *= sq; klo[j] *= sk; khi[j] *= sk; }
              *(LAS bf16x8*)(Qs + tok * RT_QP + 8 * c) = pack8(qlo); *(LAS bf16x8*)(Qs + tok * RT_QP + 32 + 8 * c) = pack8(qhi);
              *(LAS bf16x8*)(Ks + tok * RT_QP + 8 * c) = pack8(klo); *(LAS bf16x8*)(Ks + tok * RT_QP + 32 + 8 * c) = pack8(khi);
              const int pt = permpos(tok);
#pragma unroll
              for (int j = 0; j < 8; ++j) { KsT[(8 * c + j) * RT_TP + pt] = f2bf(klo[j]); KsT[(32 + 8 * c + j) * RT_TP + pt] = f2bf(khi[j]); }
#pragma unroll
              for (int q4 = 0; q4 < 4; ++q4) { const u32x4 vv = *(const u32x4*)(prow + PC_RV + hh * 128 + 32 * c + 8 * q4); const unsigned vw[4] = {vv.x, vv.y, vv.z, vv.w};
#pragma unroll
                  for (int j = 0; j < 4; ++j) { VsT[(32 * c + 8 * q4 + 2 * j) * RT_TP + pt] = (bf16)(vw[j] & 0xffffu); VsT[(32 * c + 8 * q4 + 2 * j + 1) * RT_TP + pt] = (bf16)(vw[j] >> 16); } } }
            __syncthreads();
            f32x16 o0, o1;
#pragma unroll
            for (int i = 0; i < 16; ++i) { o0[i] = 0.f; o1[i] = 0.f; }
            for (int kb = 0; kb < 4; ++kb) {
                if (dir == 0 ? kb > rb : kb < rb) continue;
                f32x16 x;
#pragma unroll
                for (int i = 0; i < 16; ++i) x[i] = 0.f;
#pragma unroll
                for (int s = 0; s < 4; ++s) x = __builtin_amdgcn_mfma_f32_32x32x16_bf16(*(const LAS bf16x8*)(Ks + (kb * 32 + ql) * RT_QP + 16 * s + 8 * h), *(const LAS bf16x8*)(Qs + (rb * 32 + ql) * RT_QP + 16 * s + 8 * h), x, 0, 0, 0);
                if (kb == rb) {
#pragma unroll
                    for (int i = 0; i < 16; ++i) { const int key = crow16(i, h); const bool keep = dir == 0 ? key <= ql : key >= ql; x[i] = keep ? x[i] : 0.f; } }
                float xv[16];
#pragma unroll
                for (int i = 0; i < 16; ++i) xv[i] = x[i];
                const bf16x8 xa0 = pack8(xv), xa1 = pack8(xv + 8);
                const LAS bf16* v0 = VsT + ((2 * cbp) * 32 + ql) * RT_TP + kb * 32 + 8 * h; const LAS bf16* v1 = VsT + ((2 * cbp + 1) * 32 + ql) * RT_TP + kb * 32 + 8 * h;
                o0 = __builtin_amdgcn_mfma_f32_32x32x16_bf16(xa0, *(const LAS bf16x8*)(v0), o0, 0, 0, 0); o0 = __builtin_amdgcn_mfma_f32_32x32x16_bf16(xa1, *(const LAS bf16x8*)(v0 + 16), o0, 0, 0, 0);
                o1 = __builtin_amdgcn_mfma_f32_32x32x16_bf16(xa0, *(const LAS bf16x8*)(v1), o1, 0, 0, 0); o1 = __builtin_amdgcn_mfma_f32_32x32x16_bf16(xa1, *(const LAS bf16x8*)(v1 + 16), o1, 0, 0, 0);
            }
#pragma unroll
            for (int s = 0; s < 4; ++s) { const bf16x8 qa = *(const LAS bf16x8*)(Qs + (rb * 32 + ql) * RT_QP + 16 * s + 8 * h);
                o0 = __builtin_amdgcn_mfma_f32_32x32x16_bf16(qa, *(const LAS bf16x8*)(SsT + ((2 * cbp) * 32 + ql) * RT_QP + 16 * s + 8 * h), o0, 0, 0, 0);
                o1 = __builtin_amdgcn_mfma_f32_32x32x16_bf16(qa, *(const LAS bf16x8*)(SsT + ((2 * cbp + 1) * 32 + ql) * RT_QP + 16 * s + 8 * h), o1, 0, 0, 0); }
            { float* op = OFB + (size_t)dir * TS + ((size_t)b * LTOT + p0 + rb * 32) * 512 + hh * 128 + (2 * cbp) * 32 + ql;
#pragma unroll
              for (int i = 0; i < 16; ++i) { op[(size_t)crow16(i, h) * 512] = o0[i]; op[(size_t)crow16(i, h) * 512 + 32] = o1[i]; } }
            f32x16 u;
#pragma unroll
            for (int i = 0; i < 16; ++i) u[i] = 0.f;
#pragma unroll
            for (int s = 0; s < 8; ++s) u = __builtin_amdgcn_mfma_f32_32x32x16_bf16(*(const LAS bf16x8*)(KsT + (db * 32 + ql) * RT_TP + 16 * s + 8 * h), *(const LAS bf16x8*)(VsT + (vb * 32 + ql) * RT_TP + 16 * s + 8 * h), u, 0, 0, 0);
#pragma unroll
            for (int i = 0; i < 16; ++i) Sreg[i] = cdec * Sreg[i] + g127 * u[i];
            __syncthreads();
#pragma unroll
            for (int g = 0; g < 4; ++g) { u32x2 x; x.x = pk2(gam * Sreg[4 * g], gam * Sreg[4 * g + 1]); x.y = pk2(gam * Sreg[4 * g + 2], gam * Sreg[4 * g + 3]);
                *(LAS u32x2*)(SsT + (vb * 32 + ql) * RT_QP + db * 32 + 8 * g + 4 * h) = x; }
        }
    }
    VM_WAIT(); __syncthreads(); __builtin_amdgcn_fence(__ATOMIC_ACQUIRE, "agent");
    bf16* O = (bf16*)(F.ws + WS_ABR);
    for (int pp = w; pp < LTOT; pp += NWAVES) { const size_t row = (size_t)b * LTOT + pp; const size_t o = row * 512 + hh * 128 + 2 * lane;
        const f32x2 f = *(const f32x2*)(OFB + o), bk = *(const f32x2*)(OFB + TS + o);
        const float mf = wave_sum(f.x + f.y) * (1.f / 128.f), mb = wave_sum(bk.x + bk.y) * (1.f / 128.f);
        const float f0 = f.x - mf, f1 = f.y - mf, b0 = bk.x - mb, b1 = bk.y - mb;
        const float vf = wave_sum(f0 * f0 + f1 * f1) * (1.f / 128.f), vbk = wave_sum(b0 * b0 + b1 * b1) * (1.f / 128.f);
        const float rf = rsqrtf(vf + 1e-5f), rbk = rsqrtf(vbk + 1e-5f);
        const unsigned gfw = *(const unsigned*)(P + row * DINP + PC_RGF + hh * 128 + 2 * lane), gbw = *(const unsigned*)(P + row * DINP + PC_RGB + hh * 128 + 2 * lane);
        const float gf0 = bflo(gfw), gf1 = bfhi(gfw), gb0 = bflo(gbw), gb1 = bfhi(gbw);
        const float y0 = f0 * rf * (gf0 * sigmoidf_(gf0)) + b0 * rbk * (gb0 * sigmoidf_(gb0)), y1 = f1 * rf * (gf1 * sigmoidf_(gf1)) + b1 * rbk * (gb1 * sigmoidf_(gb1));
        *(unsigned*)(O + o) = pk2(y0, y1); }
}

constexpr int N_PHASES = 2 + 9 * DEPTH;
__global__ void __launch_bounds__(NTHREADS, 2) fwd_kernel(Args args) {
    extern __shared__ __attribute__((aligned(16))) unsigned char lds_raw[];
    Frame F;
    F.lds = (LAS unsigned char*)lds_raw;
    F.MISC = (volatile LAS unsigned*)(F.lds + LDS_MISC_OFF);
    F.tid = threadIdx.x; F.lane = F.tid & 63; F.wave = __builtin_amdgcn_readfirstlane(F.tid >> 6);
    F.G = gridDim.x; F.bid = blockIdx.x;
    F.ws = args.ws; F.ctl = (unsigned*)(args.ws + WS_CTL);
    if (F.tid < 32) F.MISC[F.tid] = 0u;
    __syncthreads();
    const int lo = args.ph_lo, hi = args.ph_hi;
    KA ka; ka.kp = (const CAS char*)__builtin_amdgcn_kernarg_segment_ptr();
    const bool multi = (hi - lo) > 1;
    XcdBarrier bar; bar.bar = F.ctl + CW_BAR; bar.x = 0; bar.st = nullptr;
    if (multi) bar = xcd_barrier_post(F.ctl + CW_BAR, F.MISC + 8);
#define IN(k) (lo <= (k) && (k) < hi)
#define OPQ() do { int l_; asm volatile("v_mbcnt_lo_u32_b32 %0, -1, 0\n\tv_mbcnt_hi_u32_b32 %0, -1, %0" : "=v"(l_)); { int b_ = F.bid, w_ = F.wave, g_ = F.G; asm volatile("" : "+s"(b_), "+s"(w_), "+s"(g_)); F.bid = b_; F.wave = w_; F.G = g_; } F.lane = l_; F.tid = F.wave * 64 + l_; \
        const CAS char* kp_ = (const CAS char*)__builtin_amdgcn_kernarg_segment_ptr(); asm volatile("" : "+s"(kp_)); ka.kp = kp_; F.ws = ka.ws(); F.ctl = (unsigned*)(F.ws + WS_CTL); } while (0)
#define SEAM(k) do { if (IN(k) && IN((k) + 1)) xcd_barrier(bar); } while (0)

    if (IN(0)) { OPQ(); phase_prologue(F, ka); } SEAM(0);
    if (IN(1)) { OPQ(); phase_init_rows(F, ka); } SEAM(1);

    for (int l = 0; l < DEPTH; ++l) {
        const int pb = 2 + 9 * l;
        if (IN(pb + 0)) { OPQ(); unsigned char* ws = F.ws;
            SchedInproj S; S.T.init(NT / 256, DINP / 256, F.G, F.bid); S.A = (const char*)(ws + WS_H); S.B = (const char*)(ws + WS_WIN + (size_t)l * 15 * MiB);
            EpiStoreBf16 E{(bf16*)(ws + WS_P), DINP};
            pg8::gemm_phase<EpiStoreBf16, SchedInproj, false>(F.lds, 1024, S, E, F.tid);
        }
        SEAM(pb + 0);
        if (IN(pb + 1)) { OPQ(); phase_mla_prep(F, ka, l); phase_rwkv_prep(F, ka, l); }
        SEAM(pb + 1);
        if (IN(pb + 2)) { OPQ();
            if (F.bid >= 16 && F.bid < 48) phase_retention_item(F, ka, F.bid - 16);
            const int nunits = (l == DEPTH - 1) ? 1024 : 1088;
            for (;;) {
                __syncthreads();
                if (F.tid == 0) F.MISC[0] = __hip_atomic_fetch_add(F.ctl + CW_Q + l * 64, 1u, __ATOMIC_RELAXED, __HIP_MEMORY_SCOPE_AGENT);
                __syncthreads();
                const int u = (int)F.MISC[0];
                if (u >= nunits) break;
                if (u < 1024) attn_unit(F, u >> 7, (u >> 4) & 7, 1 + (u & 15)); else attn_unit(F, (u - 1024) >> 3, (u - 1024) & 7, 0);
            }
        }
        SEAM(pb + 2);
        if (IN(pb + 3)) { OPQ(); unsigned char* ws = F.ws;
            SchedMerge S; S.T.init(NT / 256, 4, F.G, F.bid); S.A = (const char*)(ws + WS_ABR); S.B = (const char*)(ws + WS_WBR + (size_t)l * 3 * MiB);
            EpiMerge E{(const bf16*)(ws + WS_P), (bf16*)(ws + WS_MRG)};
            pg8::gemm_phase<EpiMerge, SchedMerge, false>(F.lds, 512, S, E, F.tid);
        }
        SEAM(pb + 3);
        if (IN(pb + 4)) { OPQ(); unsigned char* ws = F.ws;
            SchedPlain S; S.T.init(NT / 256, 4, F.G, F.bid); S.A = (const char*)(ws + WS_MRG); S.B = (const char*)(ws + WS_WOUT + (size_t)l * 2 * MiB); S.K = 1024;
            EpiResid E{(float*)(ws + WS_X), (const float*)(ws + WS_MOD) + (size_t)l * 9 * 6144};
            pg8::gemm_phase<EpiResid, SchedPlain, false>(F.lds, 1024, S, E, F.tid);
        }
        SEAM(pb + 4);
        if (IN(pb + 5)) { OPQ(); phase_router(F, ka, l); }
        SEAM(pb + 5);
        if (IN(pb + 6)) { OPQ(); unsigned char* ws = F.ws;
            moe_build_table(F, F.ctl + CW_CNT + l * 32 * 16);
            SchedMoe S{(const LAS int*)(F.lds + LDS_TAB_OFF), (const char*)(ws + WS_H), (const char*)(ws + WS_WGU + (size_t)l * 128 * MiB), (const int*)(ws + WS_LIST), 8, F.bid, F.G, 0, (size_t)2048 * 1024 * 2, true};
            EpiSwiglu E{(bf16*)(ws + WS_ACT), ka.in(I_BGU) + (size_t)l * 32 * 2048};
            pg8::gemm_phase<EpiSwiglu, SchedMoe, true>(F.lds, 1024, S, E, F.tid);
        }
        SEAM(pb + 6);
        if (IN(pb + 7)) { OPQ(); unsigned char* ws = F.ws;
            moe_build_table(F, F.ctl + CW_CNT + l * 32 * 16);
            SchedMoe S{(const LAS int*)(F.lds + LDS_TAB_OFF), (const char*)(ws + WS_ACT), (const char*)(ws + WS_WDN + (size_t)l * 64 * MiB), (const int*)(ws + WS_LIST), 4, F.bid, F.G, 0, (size_t)1024 * 1024 * 2, false};
            EpiDown E{(bf16*)(ws + WS_Y), ka.in(I_BDOWN) + (size_t)l * 32 * 1024};
            pg8::gemm_phase<EpiDown, SchedMoe, false>(F.lds, 1024, S, E, F.tid);
        }
        SEAM(pb + 7);
        if (IN(pb + 8)) { OPQ(); phase_combine(F, ka, l); }
        SEAM(pb + 8);
    }
#undef IN
#undef SEAM
}

__global__ void __launch_bounds__(NTHREADS, 2) rwkv_naive_kernel(Args args, int l) {
    extern __shared__ __attribute__((aligned(16))) unsigned char lds_raw[];
    Frame F; F.lds = (LAS unsigned char*)lds_raw; F.MISC = (volatile LAS unsigned*)(F.lds + LDS_MISC_OFF);
    F.tid = threadIdx.x; F.lane = F.tid & 63; F.wave = __builtin_amdgcn_readfirstlane(F.tid >> 6); F.G = gridDim.x; F.bid = blockIdx.x; F.ws = args.ws; F.ctl = (unsigned*)(args.ws + WS_CTL);
    KA ka; ka.kp = (const CAS char*)__builtin_amdgcn_kernarg_segment_ptr();
    phase_rwkv_scan_naive(F, ka, l, F.bid);
}

extern "C" void kernel_launch(void* const* d_in, const int* in_sizes, int n_in, void* d_out, int out_size, void* d_ws, size_t ws_size, hipStream_t stream) {
    static int grid = 0;
    if (grid == 0) {
        if (n_in != N_IN || ws_size < WS_END) { fprintf(stderr, "kernel_launch: unexpected n_in %d or ws_size %zu (need %zu)\n", n_in, ws_size, (size_t)WS_END); grid = -1; return; }
        int dev = 0, cus = 0, per_cu = 0;
        hipGetDevice(&dev); hipDeviceGetAttribute(&cus, hipDeviceAttributeMultiprocessorCount, dev);
        if (hipFuncSetAttribute((const void*)fwd_kernel, hipFuncAttributeMaxDynamicSharedMemorySize, LDS_BYTES) != hipSuccess) { fprintf(stderr, "kernel_launch: hipFuncSetAttribute failed\n"); grid = -1; return; }
        if (hipOccupancyMaxActiveBlocksPerMultiprocessor(&per_cu, (const void*)fwd_kernel, NTHREADS, LDS_BYTES) != hipSuccess || per_cu < 1) { fprintf(stderr, "kernel_launch: occupancy query says %d\n", per_cu); }
        (void)hipGetLastError();
        grid = cus > 0 ? cus : 256;
        if (grid > 256) grid = 256;
    }
    if (grid < 0) return;
    (void)in_sizes; (void)out_size;
    hipMemsetAsync((char*)d_ws + WS_CTL, 0, CTL_ZERO_BYTES, stream);
    Args a{};
    for (int i = 0; i < N_IN; ++i) a.in[i] = (const float*)d_in[i];
    a.out = (float*)d_out; a.ws = (unsigned char*)d_ws;
#if MK_ONE_LAUNCH
    a.ph_lo = 0; a.ph_hi = N_PHASES;
    hipLaunchKernelGGL(fwd_kernel, dim3(grid), dim3(NTHREADS), LDS_BYTES, stream, a);
#else
    for (int ph = 0; ph < N_PHASES; ++ph) { a.ph_lo = ph; a.ph_hi = ph + 1; hipLaunchKernelGGL(fwd_kernel, dim3(grid), dim3(NTHREADS), LDS_BYTES, stream, a);
        if (ph >= 2 && (ph - 2) % 9 == 2) hipLaunchKernelGGL(rwkv_naive_kernel, dim3(16), dim3(NTHREADS), 16384, stream, a, (ph - 2) / 9); }
#endif
    hipError_t le = hipGetLastError();
    if (le != hipSuccess) fprintf(stderr, "kernel_launch: launch failed: %s\n", hipGetErrorName(le));
}
```

```cpp
#include <hip/hip_runtime.h>
#include <cstdio>
#include <cstdint>

#ifndef MK_ONE_LAUNCH
#define MK_ONE_LAUNCH 1
#endif

#define GAS __attribute__((address_space(1)))
#define LAS __attribute__((address_space(3)))
typedef unsigned short bf16;
typedef short bf16x8 __attribute__((ext_vector_type(8)));
typedef float f32x2 __attribute__((ext_vector_type(2)));
typedef float f32x4 __attribute__((ext_vector_type(4)));
typedef float f32x16 __attribute__((ext_vector_type(16)));
typedef unsigned u32x2 __attribute__((ext_vector_type(2)));
typedef unsigned u32x4 __attribute__((ext_vector_type(4)));
typedef __bf16 bf16v2 __attribute__((ext_vector_type(2)));
#define DI __device__ __forceinline__

constexpr int D = 1024, BATCH = 8, SEQ = 4096, CTX = 256, LTOT = SEQ + CTX  , NT = BATCH * LTOT  , DEPTH = 4;
constexpr int DIN = 7456, DINP = 7680;
constexpr int NEXP = 32, TOPK = 4, DEXP = 1024;
constexpr int NSLOT = NT * TOPK + NEXP * 256;
constexpr int PC_RQ = 0, PC_RK = 256, PC_RV = 512, PC_RGF = 1024, PC_RGB = 1536, PC_MQ = 2048, PC_MKV = 2304, PC_MPE = 2432,
              PC_RW = 2464, PC_WR = 2464, PC_WK = 2976, PC_WV = 3488, PC_WHF = 4000, PC_WHB = 4064, PC_AHF = 4128, PC_AHB = 4192, PC_GH = 4256, PC_GATE = 4384;
enum { I_X = 0, I_C, I_CTX, I_CCTX, I_ADAW, I_ADAB, I_N1G, I_N2G, I_WIN, I_MQNG, I_WUQ, I_MKVNG, I_WUKV, I_QKQG, I_QKKG, I_MUP, I_MUN, I_W0, I_W2, I_A0, I_A2, I_G2,
       I_KK, I_KA, I_RK, I_LNXG, I_LNXB, I_BRRET, I_BRMLA, I_BRRWKV, I_WOUT, I_WROUTER, I_BROUTER, I_WGU, I_BGU, I_WDOWN, I_BDOWN, N_IN };

constexpr size_t MiB = 1u << 20;
constexpr size_t WS_CTL = 0, CTL_ZERO_BYTES = 1 * MiB;
constexpr size_t WS_MOD = 1 * MiB;
constexpr size_t WS_ROPE = 2 * MiB;
constexpr size_t WS_ROPE_AX = 3 * MiB;
constexpr size_t WS_SMALLW = 4 * MiB;
constexpr size_t SW_UQ = 0, SW_UKV = 393216, SW_W2 = 655360, SW_A2 = 786432, SW_G2 = 917504;
constexpr size_t WS_WBR = 8 * MiB;
constexpr size_t WS_WOUT = 20 * MiB;
constexpr size_t WS_WIN = 28 * MiB;
constexpr size_t WS_WGU = 88 * MiB;
constexpr size_t WS_WDN = 600 * MiB;
constexpr size_t WS_X = 856 * MiB;
constexpr size_t WS_H = 992 * MiB;
constexpr size_t WS_P = 1062 * MiB;
constexpr size_t WS_QB = 1572 * MiB;
constexpr size_t WS_KB = 1623 * MiB;
constexpr size_t WS_VT = 1674 * MiB;
constexpr size_t WS_RW = 1708 * MiB;
constexpr size_t RW_STRIDE = (size_t)NT * 512 * 2;
constexpr size_t WS_LW = 1980 * MiB;
constexpr size_t WS_YF = 2116 * MiB;
constexpr size_t WS_OF = 2252 * MiB;
constexpr size_t WS_ABR = 2388 * MiB;
constexpr size_t WS_MRG = 2490 * MiB;
constexpr size_t WS_TOPK = 2558 * MiB;
constexpr size_t WS_LIST = 2560 * MiB;
constexpr size_t WS_ACT = 2565 * MiB;
constexpr size_t WS_Y = 2853 * MiB;
constexpr size_t WS_RCH = 3141 * MiB;
constexpr size_t WS_END = 3413 * MiB;
constexpr int CW_TMO = 0, CW_BAR = 4096, CW_CNT = 8192  , CW_Q = 12288  ;

DI unsigned pk2(float lo, float hi) { f32x2 v = {lo, hi}; bf16v2 r = __builtin_convertvector(v, bf16v2); return __builtin_bit_cast(unsigned, r); }
DI bf16 f2bf(float f) { return (bf16)(pk2(f, 0.f) & 0xffffu); }
DI float bf2f(unsigned short b) { return __uint_as_float(((unsigned)b) << 16); }
DI float bflo(unsigned w) { return __uint_as_float(w << 16); }
DI float bfhi(unsigned w) { return __uint_as_float(w & 0xffff0000u); }
DI bf16x8 pack8(const float* v) { u32x4 x; x.x = pk2(v[0], v[1]); x.y = pk2(v[2], v[3]); x.z = pk2(v[4], v[5]); x.w = pk2(v[6], v[7]); return __builtin_bit_cast(bf16x8, x); }
DI float wave_sum(float v) {
#pragma unroll
    for (int o = 1; o < 64; o <<= 1) v += __shfl_xor(v, o);
    return v;
}
DI float sigmoidf_(float x) { return 1.f / (1.f + __expf(-x)); }
#define LDS_WAIT() asm volatile("s_waitcnt lgkmcnt(0)" ::: "memory")
#define VM_WAIT() asm volatile("s_waitcnt vmcnt(0)" ::: "memory")

#define XB_TMO      128
#define XB_XCNT(j)  (256  + 64 * (j))
#define XB_XSUB(j)  (1280 + 64 * (j))
#define XB_XGEN(j)  (2304 + 64 * (j))
#define XB_TOP      3328
#define XB_TOPGEN   3392
#define XCD_BAR_WORDS 3456
#define XB_SPIN_CAP (1u << 22)

__device__ __forceinline__ unsigned xb_ld(unsigned* p)              { return __hip_atomic_load(p, __ATOMIC_RELAXED, __HIP_MEMORY_SCOPE_AGENT); }
__device__ __forceinline__ unsigned xb_add(unsigned* p, unsigned v) { return __hip_atomic_fetch_add(p, v, __ATOMIC_RELAXED, __HIP_MEMORY_SCOPE_AGENT); }
__device__ __forceinline__ unsigned xb_xcc_id() { return (unsigned)__builtin_amdgcn_s_getreg((3 << 11) | 20) & 0xFu; }
#define XB_SPIN(cond, bar) do { unsigned _sp = 0; while (cond) { __builtin_amdgcn_s_sleep(1); \
    if ((++_sp & 255u) == 0u) { if (xb_ld(&(bar)[XB_TMO])) break; if (_sp > XB_SPIN_CAP) { atomicAdd(&(bar)[XB_TMO], 1u); break; } } } } while (0)

struct XcdBarrier { unsigned* bar; unsigned x; volatile LAS unsigned* st; };

__device__ __forceinline__ XcdBarrier xcd_barrier_post(unsigned* bar, volatile LAS unsigned* st) {
    XcdBarrier b; b.bar = bar; b.x = xb_xcc_id(); b.st = st;
    if (threadIdx.x == 0) (void)xb_add(&bar[XB_XCNT(b.x)], 1u);
    return b;
}
__device__ __forceinline__ void xcd_barrier_complete(unsigned* bar, unsigned x, unsigned& nloc, unsigned& nx) {
    const unsigned G = gridDim.x * gridDim.y * gridDim.z;
    unsigned sum, cnt, mine, sp = 0u;
    for (;;) {
        sum = 0u; cnt = 0u; mine = 0u;
#pragma unroll
        for (unsigned j = 0; j < 16; ++j) { const unsigned c = xb_ld(&bar[XB_XCNT(j)]); sum += c; cnt += (c > 0u) ? 1u : 0u; mine = (j == x) ? c : mine; }
        if (sum == G) break;
        __builtin_amdgcn_s_sleep(1);
        if ((++sp & 255u) == 0u) { if (xb_ld(&bar[XB_TMO])) break; if (sp > XB_SPIN_CAP) { atomicAdd(&bar[XB_TMO], 1u); break; } }
    }
    nloc = mine > 0u ? mine : 1u; nx = cnt > 0u ? cnt : 1u;
}
__device__ __forceinline__ void xcd_barrier(const XcdBarrier& b) {
    asm volatile("s_waitcnt vmcnt(0)" ::: "memory");
    __syncthreads();
    if (threadIdx.x == 0) {
        unsigned* bar = b.bar;
        __builtin_amdgcn_s_waitcnt(0);
        unsigned nloc = b.st[0], nx = b.st[1];
        if (nloc == 0u) { xcd_barrier_complete(bar, b.x, nloc, nx); b.st[0] = nloc; b.st[1] = nx; }
        const unsigned old = xb_add(&bar[XB_XSUB(b.x)], 1u);
        const unsigned gen = old / nloc;
        if (old + 1u == (gen + 1u) * nloc) {
            __builtin_amdgcn_fence(__ATOMIC_RELEASE, "agent");
            asm volatile("s_waitcnt vmcnt(0)" ::: "memory");
            const unsigned og = xb_add(&bar[XB_TOP], 1u);
            const unsigned tg = og / nx;
            if (og + 1u == (tg + 1u) * nx) xb_add(&bar[XB_TOPGEN], 1u);
            else XB_SPIN(xb_ld(&bar[XB_TOPGEN]) == tg, bar);
            __builtin_amdgcn_fence(__ATOMIC_ACQUIRE, "agent");
            xb_add(&bar[XB_XGEN(b.x)], 1u);
            asm volatile("s_waitcnt vmcnt(0)" ::: "memory");
        } else {
            XB_SPIN(xb_ld(&bar[XB_XGEN(b.x)]) == gen, bar);
            __builtin_amdgcn_fence(__ATOMIC_ACQUIRE, "agent");
            asm volatile("s_waitcnt vmcnt(0)" ::: "memory");
        }
    }
    __syncthreads();
}

namespace pg8 {
constexpr int BM = 256, BK = 64, HALF = 128, HTB = HALF * BK * 2, STAGE_BYTES = 8 * HTB;
__host__ __device__ __forceinline__ int lds_byte(int r, int c) { const int st = (r >> 4) * 2 + (c >> 5), rr = r & 15, cc = c & 31, ob = rr * 64 + cc * 2; return st * 1024 + (ob ^ (((ob >> 9) & 1) << 5)); }
__host__ __device__ __forceinline__ void stage_rc(int b, int& R, int& C) { const int st = b / 1024, sb = b % 1024, swz = sb ^ (((sb >> 9) & 1) << 5); R = (st >> 1) * 16 + swz / 64; C = (st & 1) * 32 + (swz % 64) / 2; }
__host__ __device__ __forceinline__ int perm32(int rho) { const int n = rho >> 4, i = rho & 15; return 8 * (i >> 2) + 4 * n + (i & 3); }

struct Unit { const char* pa; const char* pb; int x, y, z; };

struct TileOrder {
    int nM, nN, nwg, G, c;
    DI void init(int nM_, int nN_, int G_, int c_) { nM = nM_; nN = nN_; nwg = nM * nN; G = G_; c = c_; }
    DI bool tile(int i, int& pm, int& pn) const {
        const long L = (long)i * G + c; if (L >= nwg) return false;
        int wgid = (int)L; { const int q = nwg / 8, r = nwg % 8, xcd = wgid % 8, off = wgid / 8; wgid = (xcd < r ? xcd * (q + 1) : r * (q + 1) + (xcd - r) * q) + off; }
        const int nig = 8 * nN, gid = wgid / nig, fm = gid * 8, gsz = (nM - fm) < 8 ? (nM - fm) : 8;
        pm = fm + ((wgid % nig) % gsz); pn = (wgid % nig) / gsz; return true;
    }
};

DI unsigned cvt_pk_bf16(float lo, float hi) { return pk2(lo, hi); }

template <class Epi, class Sched, bool GATHER>
__device__ __forceinline__ void gemm_phase(LAS unsigned char* lds, const int K, const Sched& S, const Epi& E, const int tid) {
    const int wid = __builtin_amdgcn_readfirstlane(tid >> 6), lane = tid & 63, wr = wid >> 2, wc = wid & 3, fr = lane & 15, fq = lane >> 4;
    const int nt = K / BK;
    unsigned voffA[2], voffB[2]; int stR[2];
#pragma unroll
    for (int i = 0; i < 2; ++i) { int R, C; stage_rc(tid * 16 + i * 8192, R, C); const int Rb = Epi::PERM ? ((R & ~31) + perm32(R & 31)) : R;
        voffA[i] = GATHER ? (unsigned)(C * 2) : (unsigned)(R * K + C) * 2u; voffB[i] = (unsigned)(Rb * K + C) * 2u; stR[i] = R; }
    const size_t kstep = (size_t)(BK * 2);
    const size_t hstep = (size_t)HALF * K * 2;
    const unsigned ldsw = (unsigned)wid * 1024u;
    const int aoff = lds_byte(wr * 64 + fr, fq * 8), boff = lds_byte(wc * 32 + fr, fq * 8);
#define PG8_SA(b, h) (((b) * 2 + (h)) * HTB)
#define PG8_SB(b, h) ((4 + (b) * 2 + (h)) * HTB)
#define PG8_STAGE(bufoff, gbase, voff) do { _Pragma("unroll") for (int _i = 0; _i < 2; ++_i) \
        __builtin_amdgcn_global_load_lds((const unsigned*)((const char*)(gbase) + (voff)[_i]), (LAS unsigned*)(lds + (bufoff) + ldsw + _i * 8192), 16, 0, 0); } while (0)
#define PG8_STAGE_A(bufoff, gbase, h, rw) do { if constexpr (GATHER) { _Pragma("unroll") for (int _i = 0; _i < 2; ++_i) { \
            const unsigned _row = ((rw)[h] >> (16 * _i)) & 0xffffu; \
            __builtin_amdgcn_global_load_lds((const unsigned*)((const char*)(gbase) + (size_t)_row * (size_t)(K * 2) + voffA[_i]), (LAS unsigned*)(lds + (bufoff) + ldsw + _i * 8192), 16, 0, 0); } } \
        else { PG8_STAGE(bufoff, (const char*)(gbase) + (h) * hstep, voffA); } } while (0)
#define PG8_LDA(dst, b, h) do { _Pragma("unroll") for (int m = 0; m < 4; ++m) _Pragma("unroll") for (int k = 0; k < 2; ++k) dst[m][k] = *(const LAS bf16x8*)(lds + PG8_SA(b, h) + aoff + m * 2048 + k * 1024); } while (0)
#define PG8_LDB(dst, b, h) do { _Pragma("unroll") for (int n = 0; n < 2; ++n) _Pragma("unroll") for (int k = 0; k < 2; ++k) dst[n][k] = *(const LAS bf16x8*)(lds + PG8_SB(b, h) + boff + n * 2048 + k * 1024); } while (0)
#define PG8_MMA(ai, bj, At, Bt) do { __builtin_amdgcn_s_setprio(1); _Pragma("unroll") for (int m = 0; m < 4; ++m) _Pragma("unroll") for (int n = 0; n < 2; ++n) _Pragma("unroll") for (int k = 0; k < 2; ++k) \
        acc[ai][bj][m][n] = __builtin_amdgcn_mfma_f32_16x16x32_bf16(Bt[n][k], At[m][k], acc[ai][bj][m][n], 0, 0, 0); __builtin_amdgcn_s_setprio(0); } while (0)
#define PG8_WAIT_V(n) asm volatile("s_waitcnt vmcnt(" #n ")" ::: "memory")
#define PG8_WAIT_L(n) asm volatile("s_waitcnt lgkmcnt(" #n ")" ::: "memory")
#define PG8_BAR __builtin_amdgcn_s_barrier()
#define PG8_SCHED __builtin_amdgcn_sched_barrier(0)
    Unit cur, nxt; int ui = 0;
    if (!S.next(0, cur)) return;
    f32x4 acc[2][2][4][2];
#pragma unroll
    for (int a = 0; a < 2; ++a)
#pragma unroll
        for (int b = 0; b < 2; ++b)
#pragma unroll
            for (int m = 0; m < 4; ++m)
#pragma unroll
                for (int n = 0; n < 2; ++n) acc[a][b][m][n] = (f32x4){0.f, 0.f, 0.f, 0.f};
    bf16x8 At[4][2], B0[2][2], B1[2][2];
    const char* cA = cur.pa; const char* cB = cur.pb;
    unsigned rwc[2] = {0u, 0u}, rwn[2] = {0u, 0u};
    if constexpr (GATHER) S.rows(cur, stR[0], stR[1], rwc);
    PG8_STAGE(PG8_SB(0, 0), cB, voffB); PG8_STAGE(PG8_SB(0, 1), cB + hstep, voffB); PG8_STAGE_A(PG8_SA(0, 0), cA, 0, rwc); PG8_STAGE_A(PG8_SA(0, 1), cA, 1, rwc);
    if (wr == 1) PG8_BAR;
    PG8_WAIT_V(2); PG8_BAR;
    PG8_STAGE(PG8_SB(1, 0), cB + kstep, voffB); PG8_STAGE_A(PG8_SA(1, 0), cA + kstep, 0, rwc); PG8_STAGE(PG8_SB(1, 1), cB + hstep + kstep, voffB);
    PG8_WAIT_V(6); PG8_BAR;
    for (;;) {
        const bool has_next = S.next(ui + 1, nxt);
        const char* nA = has_next ? nxt.pa : cA; const char* nB = has_next ? nxt.pb : cB;
        if constexpr (GATHER) { if (has_next) S.rows(nxt, stR[0], stR[1], rwn); else { rwn[0] = rwc[0]; rwn[1] = rwc[1]; } }
        for (int t = 0; t < nt; t += 2) {
            const bool last = (t == nt - 2);
            const char* a1 = cA + (size_t)(t + 1) * kstep;
            const char* a2 = last ? nA : cA + (size_t)(t + 2) * kstep; const char* b2 = last ? nB : cB + (size_t)(t + 2) * kstep;
            const char* a3 = a2 + kstep; const char* b3 = b2 + kstep;
            unsigned rw2[2]; rw2[0] = last ? rwn[0] : rwc[0]; rw2[1] = last ? rwn[1] : rwc[1];
            PG8_LDB(B0, 0, 0); PG8_LDB(B1, 0, 1); PG8_SCHED; PG8_LDA(At, 0, 0); PG8_STAGE_A(PG8_SA(1, 1), a1, 1, rwc);
            PG8_WAIT_V(8); PG8_WAIT_L(0); PG8_BAR; PG8_MMA(0, 0, At, B0); PG8_MMA(0, 1, At, B1); PG8_BAR; PG8_SCHED;
            PG8_LDA(At, 0, 1); PG8_STAGE(PG8_SB(0, 0), b2, voffB); PG8_STAGE(PG8_SB(0, 1), b2 + hstep, voffB); PG8_STAGE_A(PG8_SA(0, 0), a2, 0, rw2);
            PG8_WAIT_V(8); PG8_WAIT_L(0); PG8_BAR; PG8_MMA(1, 0, At, B0); PG8_MMA(1, 1, At, B1); PG8_BAR; PG8_SCHED;
            PG8_LDB(B0, 1, 0); PG8_LDB(B1, 1, 1); PG8_SCHED; PG8_LDA(At, 1, 0); PG8_STAGE_A(PG8_SA(0, 1), a2, 1, rw2);
            PG8_WAIT_V(8); PG8_WAIT_L(0); PG8_BAR; PG8_MMA(0, 0, At, B0); PG8_MMA(0, 1, At, B1); PG8_BAR; PG8_SCHED;
            PG8_LDA(At, 1, 1); PG8_STAGE(PG8_SB(1, 0), b3, voffB); PG8_STAGE(PG8_SB(1, 1), b3 + hstep, voffB); PG8_STAGE_A(PG8_SA(1, 0), a3, 0, rw2);
            PG8_WAIT_V(8); PG8_WAIT_L(0); PG8_BAR; PG8_MMA(1, 0, At, B0); PG8_MMA(1, 1, At, B1); PG8_BAR; PG8_SCHED;
        }
        if (wr == 0) PG8_BAR;
        { int l2_; asm volatile("v_mbcnt_lo_u32_b32 %0, -1, 0\n\tv_mbcnt_hi_u32_b32 %0, -1, %0" : "=v"(l2_));
          E(acc, cur, wr, wc, l2_ & 15, l2_ >> 4); }
        if (!has_next) break;
        cur = nxt; cA = nA; cB = nB; ++ui;
        if constexpr (GATHER) { rwc[0] = rwn[0]; rwc[1] = rwn[1]; }
        if (wr == 1) PG8_BAR;
    }
    PG8_WAIT_V(0);
    PG8_BAR;
#undef PG8_SA
#undef PG8_SB
#undef PG8_STAGE
#undef PG8_STAGE_A
#undef PG8_LDA
#undef PG8_LDB
#undef PG8_MMA
#undef PG8_WAIT_V
#undef PG8_WAIT_L
#undef PG8_BAR
#undef PG8_SCHED
}
#define ACC_ZERO(acc) do { _Pragma("unroll") for (int a_ = 0; a_ < 2; ++a_) _Pragma("unroll") for (int b_ = 0; b_ < 2; ++b_) _Pragma("unroll") for (int m_ = 0; m_ < 4; ++m_) _Pragma("unroll") for (int n_ = 0; n_ < 2; ++n_) \
        acc[a_][b_][m_][n_] = (f32x4){0.f, 0.f, 0.f, 0.f}; } while (0)
}

constexpr int NWAVES = 8, NTHREADS = 512;
constexpr int RING_BYTES = 131072;
constexpr int LDS_TAB_OFF = RING_BYTES;
constexpr int LDS_MISC_OFF = RING_BYTES + 8192;
constexpr int LDS_BYTES = 147456;

struct Args { const float* in[N_IN]; float* out; unsigned char* ws; int ph_lo, ph_hi; };

#define CAS __attribute__((address_space(4)))
struct KA { const CAS char* kp;
    DI const float* in(int i) const { return *(const float* const CAS*)(kp + 8 * i); }
    DI float* out() const { return *(float* const CAS*)(kp + 8 * N_IN); }
    DI unsigned char* ws() const { return *(unsigned char* const CAS*)(kp + 8 * N_IN + 8); } };
struct Frame {
    LAS unsigned char* lds;
    volatile LAS unsigned* MISC;
    unsigned* ctl;
    unsigned char* ws;
    int tid, lane, wave, G, bid;
};

DI int row_modrow(int r) { const int b = r / LTOT, p = r - b * LTOT; return p < CTX ? 8 : b; }

struct SchedInproj {
    pg8::TileOrder T; const char* A; const char* B;
    DI bool next(int i, pg8::Unit& u) const { int pm, pn; if (!T.tile(i, pm, pn)) return false; u.pa = A + (size_t)pm * (256 * 1024 * 2); u.pb = B + (size_t)pn * (256 * 1024 * 2); u.x = pm; u.y = pn; u.z = 0; return true; }
};
struct EpiStoreBf16 {
    static constexpr bool PERM = true;
    bf16* O; int ldc;
    DI void operator()(f32x4 (&acc)[2][2][4][2], const pg8::Unit& u, int wr, int wc, int fr, int fq) const {
        const int row0 = u.x * 256 + wr * 64 + fr, col0 = u.y * 256 + wc * 32 + 8 * fq;
#pragma unroll
        for (int ai = 0; ai < 2; ++ai)
#pragma unroll
            for (int m = 0; m < 4; ++m) { bf16* rowp = O + (size_t)(row0 + ai * 128 + m * 16) * ldc + col0;
#pragma unroll
                for (int bj = 0; bj < 2; ++bj) { const f32x4 v0 = acc[ai][bj][m][0], v1 = acc[ai][bj][m][1];
                    u32x4 w; w.x = pk2(v0[0], v0[1]); w.y = pk2(v0[2], v0[3]); w.z = pk2(v1[0], v1[1]); w.w = pk2(v1[2], v1[3]);
                    *(u32x4*)(rowp + bj * 128) = w; } }
        ACC_ZERO(acc);
    }
};
struct SchedMerge {
    pg8::TileOrder T; const char* A; const char* B;
    DI bool next(int i, pg8::Unit& u) const { const int ti = i / 3, br = i - ti * 3; int pm, pn; if (!T.tile(ti, pm, pn)) return false;
        u.pa = A + (size_t)br * ((size_t)NT * 512 * 2) + (size_t)pm * (256 * 512 * 2); u.pb = B + (size_t)br * (1024 * 512 * 2) + (size_t)pn * (256 * 512 * 2); u.x = pm; u.y = pn; u.z = br; return true; }
};
struct EpiMerge {
    static constexpr bool PERM = true;
    const bf16* P; bf16* O;
    DI void operator()(f32x4 (&acc)[2][2][4][2], const pg8::Unit& u, int wr, int wc, int fr, int fq) const {
        const int row0 = u.x * 256 + wr * 64 + fr, col0 = u.y * 256 + wc * 32 + 8 * fq, br = u.z;
#pragma unroll
        for (int ai = 0; ai < 2; ++ai)
#pragma unroll
            for (int m = 0; m < 4; ++m) { const size_t row = (size_t)(row0 + ai * 128 + m * 16);
#pragma unroll
                for (int bj = 0; bj < 2; ++bj) {
                    const bf16* gp = P + row * DINP + PC_GATE + br * 1024 + col0 + bj * 128;
                    const u32x4 gc = *(const u32x4*)gp;
                    float lc[8] = {bflo(gc.x), bfhi(gc.x), bflo(gc.y), bfhi(gc.y), bflo(gc.z), bfhi(gc.z), bflo(gc.w), bfhi(gc.w)};
                    float f[8];
                    if (br < 2) { const u32x4 gn = *(const u32x4*)(gp + 1024);
                        float ln[8] = {bflo(gn.x), bfhi(gn.x), bflo(gn.y), bfhi(gn.y), bflo(gn.z), bfhi(gn.z), bflo(gn.w), bfhi(gn.w)};
#pragma unroll
                        for (int j = 0; j < 8; ++j) { const float a = fminf(fmaxf(lc[j], -30.f), 30.f), b = fminf(fmaxf(ln[j], -30.f), 30.f); f[j] = (1.f + __expf(-b)) / (1.f + __expf(-a)); }
                    } else {
#pragma unroll
                        for (int j = 0; j < 8; ++j) { const float a = fminf(fmaxf(lc[j], -30.f), 30.f); f[j] = 1.f / (1.f + __expf(-a)); }
                    }
                    f32x4 v0 = acc[ai][bj][m][0], v1 = acc[ai][bj][m][1];
                    v0[0] *= f[0]; v0[1] *= f[1]; v0[2] *= f[2]; v0[3] *= f[3]; v1[0] *= f[4]; v1[1] *= f[5]; v1[2] *= f[6]; v1[3] *= f[7];
                    if (br == 2) { u32x4 w; w.x = pk2(v0[0], v0[1]); w.y = pk2(v0[2], v0[3]); w.z = pk2(v1[0], v1[1]); w.w = pk2(v1[2], v1[3]);
                        *(u32x4*)(O + row * 1024 + col0 + bj * 128) = w; v0 = (f32x4){0.f, 0.f, 0.f, 0.f}; v1 = v0; }
                    acc[ai][bj][m][0] = v0; acc[ai][bj][m][1] = v1; } }
    }
};
struct SchedPlain {
    pg8::TileOrder T; const char* A; const char* B; int K;
    DI bool next(int i, pg8::Unit& u) const { int pm, pn; if (!T.tile(i, pm, pn)) return false; u.pa = A + (size_t)pm * ((size_t)256 * K * 2); u.pb = B + (size_t)pn * ((size_t)256 * K * 2); u.x = pm; u.y = pn; u.z = 0; return true; }
};
struct EpiResid {
    static constexpr bool PERM = false;
    float* X; const float* mod;
    DI void operator()(f32x4 (&acc)[2][2][4][2], const pg8::Unit& u, int wr, int wc, int fr, int fq) const {
        const int row0 = u.x * 256 + wr * 64 + fr, col0 = u.y * 256 + wc * 32 + 4 * fq;
        const float* g1 = mod + (size_t)row_modrow(u.x * 256) * 6144 + 2048 + col0;
        f32x4 gv[2][2];
#pragma unroll
        for (int bj = 0; bj < 2; ++bj)
#pragma unroll
            for (int n = 0; n < 2; ++n) gv[bj][n] = *(const f32x4*)(g1 + bj * 128 + n * 16);
#pragma unroll
        for (int ai = 0; ai < 2; ++ai)
#pragma unroll
            for (int m = 0; m < 4; ++m) { float* rowp = X + (size_t)(row0 + ai * 128 + m * 16) * 1024 + col0;
#pragma unroll
                for (int bj = 0; bj < 2; ++bj)
#pragma unroll
                    for (int n = 0; n < 2; ++n) { f32x4* p = (f32x4*)(rowp + bj * 128 + n * 16); *p = *p + gv[bj][n] * acc[ai][bj][m][n]; } }
        ACC_ZERO(acc);
    }
};
struct SchedMoe {
    const LAS int* tab; const char* A; const char* B; const int* list; int nN, c, G; size_t a_tile_bytes, b_exp_bytes; bool gather;
    DI bool next(int i, pg8::Unit& u) const {
        const int T = tab[96], Tq = (T + 7) >> 3, xcd = c & 7, q = i * (G >> 3) + (c >> 3), tl = q / nN, pn = q - tl * nN, t = xcd * Tq + tl;
        if (tl >= Tq || t >= T) return false;
        const int e = tab[128 + t], j = t - tab[64 + e], slot0 = tab[32 + e] + 256 * j;
        u.pa = gather ? A : A + (size_t)slot0 * 2048; u.pb = B + (size_t)e * b_exp_bytes + (size_t)pn * (256 * 1024 * 2); u.x = slot0; u.y = pn; u.z = e | (j << 8); return true;
    }
    DI void rows(const pg8::Unit& u, int R0, int R1, unsigned (&rw)[2]) const {
        const int e = u.z & 255, j = u.z >> 8, cnt = tab[e]; const int* le = list + (size_t)e * NT;
#pragma unroll
        for (int h = 0; h < 2; ++h) { const int i0 = j * 256 + h * 128 + R0, i1 = j * 256 + h * 128 + R1;
            const unsigned r0 = i0 < cnt ? (unsigned)(le[i0] >> 2) : (unsigned)NT, r1 = i1 < cnt ? (unsigned)(le[i1] >> 2) : (unsigned)NT; rw[h] = r0 | (r1 << 16); }
    }
};
struct EpiSwiglu {
    static constexpr bool PERM = true;
    bf16* ACT; const float* bgu;
    DI void operator()(f32x4 (&acc)[2][2][4][2], const pg8::Unit& u, int wr, int wc, int fr, int fq) const {
        const int row0 = u.x + wr * 64 + fr, ch0 = u.y * 128 + wc * 32 + 8 * fq, e = u.z & 255;
        const float* bg = bgu + (size_t)e * 2048 + ch0;
        const f32x4 bg0 = *(const f32x4*)bg, bg1 = *(const f32x4*)(bg + 4), bu0 = *(const f32x4*)(bg + 1024), bu1 = *(const f32x4*)(bg + 1028);
#pragma unroll
        for (int ai = 0; ai < 2; ++ai)
#pragma unroll
            for (int m = 0; m < 4; ++m) {
                const f32x4 g0 = acc[ai][0][m][0] + bg0, g1 = acc[ai][0][m][1] + bg1, u0 = acc[ai][1][m][0] + bu0, u1 = acc[ai][1][m][1] + bu1;
                float o[8];
#pragma unroll
                for (int j = 0; j < 8; ++j) { const float g = fminf(j < 4 ? g0[j & 3] : g1[j & 3], 7.f); const float up = fminf(fmaxf(j < 4 ? u0[j & 3] : u1[j & 3], -7.f), 7.f);
                    o[j] = g * (1.f / (1.f + __expf(-1.702f * g))) * (up + 1.f); }
                u32x4 w; w.x = pk2(o[0], o[1]); w.y = pk2(o[2], o[3]); w.z = pk2(o[4], o[5]); w.w = pk2(o[6], o[7]);
                *(u32x4*)(ACT + (size_t)(row0 + ai * 128 + m * 16) * 1024 + ch0) = w; }
        ACC_ZERO(acc);
    }
};
struct EpiDown {
    static constexpr bool PERM = true;
    bf16* Y; const float* bd;
    DI void operator()(f32x4 (&acc)[2][2][4][2], const pg8::Unit& u, int wr, int wc, int fr, int fq) const {
        const int row0 = u.x + wr * 64 + fr, col0 = u.y * 256 + wc * 32 + 8 * fq, e = u.z & 255;
        f32x4 bv[2][2];
#pragma unroll
        for (int bj = 0; bj < 2; ++bj)
#pragma unroll
            for (int n = 0; n < 2; ++n) bv[bj][n] = *(const f32x4*)(bd + (size_t)e * 1024 + col0 + bj * 128 + 4 * n);
#pragma unroll
        for (int ai = 0; ai < 2; ++ai)
#pragma unroll
            for (int m = 0; m < 4; ++m) { bf16* rowp = Y + (size_t)(row0 + ai * 128 + m * 16) * 1024 + col0;
#pragma unroll
                for (int bj = 0; bj < 2; ++bj) { const f32x4 v0 = acc[ai][bj][m][0] + bv[bj][0], v1 = acc[ai][bj][m][1] + bv[bj][1];
                    u32x4 w; w.x = pk2(v0[0], v0[1]); w.y = pk2(v0[2], v0[3]); w.z = pk2(v1[0], v1[1]); w.w = pk2(v1[2], v1[3]);
                    *(u32x4*)(rowp + bj * 128) = w; } }
        ACC_ZERO(acc);
    }
};
DI void moe_build_table(Frame& F, const unsigned* cnt  ) {
    LAS int* tab = (LAS int*)(F.lds + LDS_TAB_OFF);
    if (F.tid < 32) tab[F.tid] = (int)__hip_atomic_load(cnt + F.tid * 16, __ATOMIC_RELAXED, __HIP_MEMORY_SCOPE_AGENT);
    __syncthreads();
    if (F.tid == 0) { int pb = 0, tb = 0; for (int e = 0; e < 32; ++e) { const int nt_ = (tab[e] + 255) >> 8; tab[32 + e] = pb; tab[64 + e] = tb; pb += nt_ * 256; tb += nt_; } tab[96] = tb; }
    __syncthreads();
    for (int e = 0; e < 32; ++e) { const int tb = tab[64 + e], nt_ = (tab[e] + 255) >> 8; for (int j = F.tid; j < nt_; j += NTHREADS) tab[128 + tb + j] = e; }
    __syncthreads();
}

DI void transpose_item(const float* W, int K, int N, bf16* WT, int mode, const float* gk, LAS float* scr, int item, int lane) {
    const int nblk = N / 32, kb = item / nblk, nb = item % nblk, k0 = 64 * kb, n0 = 32 * nb;
#pragma unroll 8
    for (int i = 0; i < 32; ++i) { const int kk = 2 * i + (lane >> 5); float v = W[(size_t)(k0 + kk) * N + n0 + (lane & 31)]; if (gk) v *= gk[k0 + kk]; scr[kk * 33 + (lane & 31)] = v; }
    LDS_WAIT(); asm volatile("" ::: "memory");
    int drow0 = n0;
    if (mode == 1) { const int up = n0 >= 1024, ch = n0 - (up ? 1024 : 0); drow0 = (ch >> 7) * 256 + (up ? 128 : 0) + (ch & 127); }
    const int c = lane & 7;
#pragma unroll
    for (int j = 0; j < 4; ++j) { const int n = (lane >> 3) + 8 * j; const LAS float* s = scr + (8 * c) * 33 + n;
        u32x4 o; o.x = pk2(s[0 * 33], s[1 * 33]); o.y = pk2(s[2 * 33], s[3 * 33]); o.z = pk2(s[4 * 33], s[5 * 33]); o.w = pk2(s[6 * 33], s[7 * 33]);
        *(u32x4*)(WT + (size_t)(drow0 + n) * K + k0 + 8 * c) = o; }
    LDS_WAIT(); asm volatile("" ::: "memory");
}
DI void transpose_batch(Frame& F, const float* W, size_t ss, int K, int N, bf16* WT, size_t ds, int nb, int mode, const float* gk, size_t gks) {
    LAS float* scr = (LAS float*)(F.lds + F.wave * 16384);
    const int gw = F.bid * NWAVES + F.wave, NGW = F.G * NWAVES;
    const int per = (K / 64) * (N / 32), total = per * nb;
    for (int it = gw; it < total; it += NGW) { const int b = it / per, r = it - b * per;
        transpose_item(W + (size_t)b * ss, K, N, WT + (size_t)b * ds, mode, gk ? gk + (size_t)b * gks : nullptr, scr, r, F.lane); }
}
DI void phase_prologue(Frame& F, const KA& a) {
    unsigned char* ws = F.ws;
    transpose_batch(F, a.in(I_WIN), (size_t)1024 * DIN, 1024, DIN, (bf16*)(ws + WS_WIN), (size_t)DINP * 1024, 4, 0, nullptr, 0);
    transpose_batch(F, a.in(I_WGU), (size_t)1024 * 2048, 1024, 2048, (bf16*)(ws + WS_WGU), (size_t)2048 * 1024, 128, 1, nullptr, 0);
    transpose_batch(F, a.in(I_WDOWN), (size_t)1024 * 1024, 1024, 1024, (bf16*)(ws + WS_WDN), (size_t)1024 * 1024, 128, 0, nullptr, 0);
    transpose_batch(F, a.in(I_WOUT), (size_t)1024 * 1024, 1024, 1024, (bf16*)(ws + WS_WOUT), (size_t)1024 * 1024, 4, 0, nullptr, 0);
    transpose_batch(F, a.in(I_BRRET), (size_t)512 * 1024, 512, 1024, (bf16*)(ws + WS_WBR), (size_t)3 * 1024 * 512, 4, 0, nullptr, 0);
    transpose_batch(F, a.in(I_BRMLA), (size_t)512 * 1024, 512, 1024, (bf16*)(ws + WS_WBR) + (size_t)1024 * 512, (size_t)3 * 1024 * 512, 4, 0, nullptr, 0);
    transpose_batch(F, a.in(I_BRRWKV), (size_t)512 * 1024, 512, 1024, (bf16*)(ws + WS_WBR) + (size_t)2 * 1024 * 512, (size_t)3 * 1024 * 512, 4, 0, nullptr, 0);
    transpose_batch(F, a.in(I_WUQ), (size_t)256 * 768, 256, 768, (bf16*)(ws + WS_SMALLW + SW_UQ), MiB / 2, 4, 0, a.in(I_MQNG), 256);
    transpose_batch(F, a.in(I_WUKV), (size_t)128 * 1024, 128, 1024, (bf16*)(ws + WS_SMALLW + SW_UKV), MiB / 2, 4, 0, a.in(I_MKVNG), 128);
    for (int l = 0; l < 4; ++l) {
        transpose_batch(F, a.in(I_W2) + (size_t)l * 2 * 64 * 512, (size_t)64 * 512, 64, 512, (bf16*)(ws + WS_SMALLW + l * MiB + SW_W2), (size_t)512 * 64, 2, 0, nullptr, 0);
        transpose_batch(F, a.in(I_A2) + (size_t)l * 2 * 64 * 512, (size_t)64 * 512, 64, 512, (bf16*)(ws + WS_SMALLW + l * MiB + SW_A2), (size_t)512 * 64, 2, 0, nullptr, 0);
    }
    transpose_batch(F, a.in(I_G2), (size_t)128 * 512, 128, 512, (bf16*)(ws + WS_SMALLW + SW_G2), MiB / 2, 4, 0, nullptr, 0);
    const int gt = F.bid * NTHREADS + F.tid, NGT = F.G * NTHREADS;
    for (int i = gt; i < 4 * (DINP - DIN) * 1024 / 8; i += NGT) { const int l = i / ((DINP - DIN) * 128), r = i - l * ((DINP - DIN) * 128);
        *(u32x4*)((bf16*)(ws + WS_WIN) + (size_t)l * DINP * 1024 + (size_t)DIN * 1024 + (size_t)r * 8) = (u32x4){0u, 0u, 0u, 0u}; }
    for (int i = gt; i < 128; i += NGT) *(u32x4*)((bf16*)(ws + WS_H) + (size_t)NT * 1024 + i * 8) = (u32x4){0u, 0u, 0u, 0u};
    { float2* rt = (float2*)(ws + WS_ROPE);
      for (int i = gt; i < 4096 * 32; i += NGT) { const int pos = i >> 5, f = i & 31; const float inv = powf(10000.f, -(float)(2 * f) / 64.f); const float ang = (float)pos * inv; float s, c; sincosf(ang, &s, &c); rt[i] = make_float2(c, s); }
      float2* ax = (float2*)(ws + WS_ROPE_AX);
      for (int i = gt; i < 64 * 8; i += NGT) { const int pos = i >> 3, f = i & 7; const float inv = powf(10000.f, -(float)(2 * f) / 16.f); const float ang = (float)pos * inv; float s, c; sincosf(ang, &s, &c); ax[i] = make_float2(c, s); } }
    { LAS float* sc = (LAS float*)(F.lds);
      LAS float* red = (LAS float*)(F.lds + 65536);
      __syncthreads();
      for (int i = F.tid; i < 9 * 1024; i += NTHREADS) { const int r = i >> 10, k = i & 1023; const float v = r < 8 ? a.in(I_C)[r * 1024 + k] : a.in(I_CCTX)[k]; sc[i] = v / (1.f + __expf(-v)); }
      __syncthreads();
      float* mod = (float*)(ws + WS_MOD);
      for (int it = F.bid; it < 4 * 96; it += F.G) { const int l = it / 96, n = (it - l * 96) * 64 + F.lane;
          const float* w = a.in(I_ADAW) + (size_t)l * 1024 * 6144 + n; float acc[9];
#pragma unroll
          for (int r = 0; r < 9; ++r) acc[r] = 0.f;
          const int kb = F.wave * 128;
#pragma unroll 8
          for (int k = 0; k < 128; ++k) { const float wv = w[(size_t)(kb + k) * 6144];
#pragma unroll
              for (int r = 0; r < 9; ++r) acc[r] += sc[r * 1024 + kb + k] * wv; }
#pragma unroll
          for (int r = 0; r < 9; ++r) red[(F.wave * 9 + r) * 64 + F.lane] = acc[r];
          __syncthreads();
          for (int i = F.tid; i < 9 * 64; i += NTHREADS) { const int r = i >> 6, c = i & 63; float s = 0.f;
#pragma unroll
              for (int w8 = 0; w8 < 8; ++w8) s += red[(w8 * 9 + r) * 64 + c];
              const int nn = (it - l * 96) * 64 + c; mod[((size_t)l * 9 + r) * 6144 + nn] = s + a.in(I_ADAB)[l * 6144 + nn]; }
          __syncthreads(); } }
}

DI void norm_mod_store(const f32x4 (&v)[4], const float* gain, const float* sc, const float* sh, bf16* hrow, int lane) {
    float s = 0.f;
#pragma unroll
    for (int j = 0; j < 4; ++j) s += (v[j].x * v[j].x + v[j].y * v[j].y) + (v[j].z * v[j].z + v[j].w * v[j].w);
    const float rinv = rsqrtf(wave_sum(s) * (1.f / 1024.f) + 1e-6f);
#pragma unroll
    for (int j = 0; j < 4; ++j) { const int c = 256 * j + 4 * lane; const f32x4 g = *(const f32x4*)(gain + c), a = *(const f32x4*)(sc + c), b = *(const f32x4*)(sh + c);
        const f32x4 y = v[j] * rinv * g * (a + 1.f) + b; u32x2 o; o.x = pk2(y.x, y.y); o.y = pk2(y.z, y.w); *(u32x2*)(hrow + c) = o; }
}
DI void phase_init_rows(Frame& F, const KA& a) {
    const int gw = F.bid * NWAVES + F.wave, NGW = F.G * NWAVES;
    float* X = (float*)(F.ws + WS_X); bf16* H = (bf16*)(F.ws + WS_H); const float* mod = (const float*)(F.ws + WS_MOD);
    for (int r = gw; r < NT; r += NGW) { const int b = r / LTOT, p = r - b * LTOT;
        const float* src = p < CTX ? a.in(I_CTX) + ((size_t)b * CTX + p) * 1024 : a.in(I_X) + ((size_t)b * SEQ + (p - CTX)) * 1024;
        f32x4 v[4];
#pragma unroll
        for (int j = 0; j < 4; ++j) { v[j] = *(const f32x4*)(src + 256 * j + 4 * F.lane); *(f32x4*)(X + (size_t)r * 1024 + 256 * j + 4 * F.lane) = v[j]; }
        const float* m = mod + (size_t)(p < CTX ? 8 : b) * 6144;
        norm_mod_store(v, a.in(I_N1G), m + 1024, m, H + (size_t)r * 1024, F.lane); }
}

DI void phase_router(Frame& F, const KA& a, int l) {
    LAS float* T = (LAS float*)(F.lds);
    LAS float* part = (LAS float*)(F.lds + 16 * 1028 * 4);
    LAS float* logit = (LAS float*)(F.lds + 16 * 1028 * 4 + 16384);
    LAS int* lcnt = (LAS int*)(F.lds + 16 * 1028 * 4 + 16384 + 2048);
    LAS int* gbase = lcnt + 32;
    const float* X = (const float*)(F.ws + WS_X); bf16* H = (bf16*)(F.ws + WS_H);
    const float* mod = (const float*)(F.ws + WS_MOD) + (size_t)l * 9 * 6144;
    const float* gain = a.in(I_N2G) + l * 1024; const float* wr = a.in(I_WROUTER) + (size_t)l * 1024 * 32; const float* br = a.in(I_BROUTER) + l * 32;
    int* eidx = (int*)(F.ws + WS_TOPK); float* gw = (float*)(F.ws + WS_TOPK) + (size_t)NT * 4; int* rank = (int*)(F.ws + WS_TOPK) + (size_t)NT * 8;
    int* list = (int*)(F.ws + WS_LIST); unsigned* cnt = F.ctl + CW_CNT + l * 32 * 16;
    const int lane = F.lane, w = F.wave;
    for (int it = F.bid; it < NT / 16; it += F.G) {
        const int r0 = it * 16;
        __syncthreads();
        if (F.tid < 32) lcnt[F.tid] = 0;
#pragma unroll
        for (int rr = 0; rr < 2; ++rr) { const int lr = w * 2 + rr, r = r0 + lr; const int b = r / LTOT, p = r - b * LTOT; const float* m = mod + (size_t)(p < CTX ? 8 : b) * 6144;
            f32x4 v[4]; float s = 0.f;
#pragma unroll
            for (int j = 0; j < 4; ++j) { v[j] = *(const f32x4*)(X + (size_t)r * 1024 + 256 * j + 4 * lane); s += (v[j].x * v[j].x + v[j].y * v[j].y) + (v[j].z * v[j].z + v[j].w * v[j].w); }
            const float rinv = rsqrtf(wave_sum(s) * (1.f / 1024.f) + 1e-6f);
#pragma unroll
            for (int j = 0; j < 4; ++j) { const int c = 256 * j + 4 * lane; const f32x4 g = *(const f32x4*)(gain + c), sc = *(const f32x4*)(m + 4096 + c), sh = *(const f32x4*)(m + 3072 + c);
                const f32x4 y = v[j] * rinv * g * (sc + 1.f) + sh; *(LAS f32x4*)(T + lr * 1028 + c) = y;
                u32x2 o; o.x = pk2(y.x, y.y); o.y = pk2(y.z, y.w); *(u32x2*)(H + (size_t)r * 1024 + c) = o; } }
        __syncthreads();
        { const int i = lane & 15, q = lane >> 4; f32x4 acc0 = {0.f, 0.f, 0.f, 0.f}, acc1 = acc0;
          const LAS float* tp = T + i * 1028 + 128 * w + 32 * q; const float* wp = wr + (size_t)(128 * w + 32 * q) * 32 + i;
#pragma unroll 8
          for (int s = 0; s < 32; ++s) { const float av = tp[s]; const float b0 = wp[s * 32], b1 = wp[s * 32 + 16];
              acc0 = __builtin_amdgcn_mfma_f32_16x16x4f32(av, b0, acc0, 0, 0, 0); acc1 = __builtin_amdgcn_mfma_f32_16x16x4f32(av, b1, acc1, 0, 0, 0); }
#pragma unroll
          for (int rg = 0; rg < 4; ++rg) { part[(w * 16 + 4 * q + rg) * 32 + i] = acc0[rg]; part[(w * 16 + 4 * q + rg) * 32 + 16 + i] = acc1[rg]; } }
        __syncthreads();
        { const int row = F.tid >> 5, e = F.tid & 31; float s = br[e];
#pragma unroll
          for (int w8 = 0; w8 < 8; ++w8) s += part[(w8 * 16 + row) * 32 + e];
          logit[row * 32 + e] = s; }
        __syncthreads();
        int te[4] = {0, 0, 0, 0}; float tv[4] = {0.f, 0.f, 0.f, 0.f}; int lr_[4] = {0, 0, 0, 0};
        if (F.tid < 16) { const LAS float* lg = logit + F.tid * 32; unsigned used = 0u;
#pragma unroll
            for (int k = 0; k < 4; ++k) { float best = -3.0e38f; int bi = 0;
                for (int e = 0; e < 32; ++e) { const float v = lg[e]; if (!((used >> e) & 1u) && v > best) { best = v; bi = e; } }
                used |= 1u << bi; te[k] = bi; tv[k] = best; }
            const float mx = tv[0]; float den = 0.f;
#pragma unroll
            for (int k = 0; k < 4; ++k) { tv[k] = __expf(tv[k] - mx); den += tv[k]; }
#pragma unroll
            for (int k = 0; k < 4; ++k) { tv[k] /= den; lr_[k] = atomicAdd((int*)&lcnt[te[k]], 1); } }
        __syncthreads();
        if (F.tid < 32) { const int c = lcnt[F.tid]; gbase[F.tid] = c ? (int)__hip_atomic_fetch_add(cnt + F.tid * 16, (unsigned)c, __ATOMIC_RELAXED, __HIP_MEMORY_SCOPE_AGENT) : 0; }
        __syncthreads();
        if (F.tid < 16) { const int r = r0 + F.tid;
#pragma unroll
            for (int k = 0; k < 4; ++k) { const int rk = gbase[te[k]] + lr_[k]; eidx[r * 4 + k] = te[k]; gw[r * 4 + k] = tv[k]; rank[r * 4 + k] = rk; list[(size_t)te[k] * NT + rk] = r * 4 + k; } }
    }
}

DI void phase_combine(Frame& F, const KA& a, int l) {
    moe_build_table(F, F.ctl + CW_CNT + l * 32 * 16);
    const LAS int* tab = (const LAS int*)(F.lds + LDS_TAB_OFF);
    const int gw_ = F.bid * NWAVES + F.wave, NGW = F.G * NWAVES;
    float* X = (float*)(F.ws + WS_X); bf16* H = (bf16*)(F.ws + WS_H); const bf16* Y = (const bf16*)(F.ws + WS_Y);
    const float* mod = (const float*)(F.ws + WS_MOD) + (size_t)l * 9 * 6144;
    const int* eidx = (const int*)(F.ws + WS_TOPK); const float* gw = (const float*)(F.ws + WS_TOPK) + (size_t)NT * 4; const int* rank = (const int*)(F.ws + WS_TOPK) + (size_t)NT * 8;
    for (int r = gw_; r < NT; r += NGW) { const int b = r / LTOT, p = r - b * LTOT; const int mr = p < CTX ? 8 : b;
        if (l == DEPTH - 1 && p < CTX) continue;
        const float* g2 = mod + (size_t)mr * 6144 + 5120;
        f32x4 v[4], acc[4];
#pragma unroll
        for (int j = 0; j < 4; ++j) { v[j] = *(const f32x4*)(X + (size_t)r * 1024 + 256 * j + 4 * F.lane); acc[j] = (f32x4){0.f, 0.f, 0.f, 0.f}; }
#pragma unroll
        for (int k = 0; k < 4; ++k) { const int e = eidx[r * 4 + k]; const float g = gw[r * 4 + k]; const size_t slot = (size_t)(tab[32 + e] + rank[r * 4 + k]);
#pragma unroll
            for (int j = 0; j < 4; ++j) { const u32x2 y = *(const u32x2*)(Y + slot * 1024 + 256 * j + 4 * F.lane);
                acc[j].x += g * bflo(y.x); acc[j].y += g * bfhi(y.x); acc[j].z += g * bflo(y.y); acc[j].w += g * bfhi(y.y); } }
#pragma unroll
        for (int j = 0; j < 4; ++j) v[j] = v[j] + *(const f32x4*)(g2 + 256 * j + 4 * F.lane) * acc[j];
        if (l == DEPTH - 1) {
            float* o = a.out() + ((size_t)b * SEQ + (p - CTX)) * 1024;
#pragma unroll
            for (int j = 0; j < 4; ++j) *(f32x4*)(o + 256 * j + 4 * F.lane) = v[j];
        } else {
#pragma unroll
            for (int j = 0; j < 4; ++j) *(f32x4*)(X + (size_t)r * 1024 + 256 * j + 4 * F.lane) = v[j];
            const float* m = (const float*)(F.ws + WS_MOD) + (size_t)(l + 1) * 9 * 6144 + (size_t)mr * 6144;
            norm_mod_store(v, a.in(I_N1G) + (l + 1) * 1024, m + 1024, m, H + (size_t)r * 1024, F.lane);
        }
    }
}

DI int crow16(int i, int h) { return (i & 3) + 8 * (i >> 2) + 4 * h; }
DI int permpos(int p) { return (p & ~12) | ((p & 4) << 1) | ((p & 8) >> 1); }
DI void phase_mla_prep(Frame& F, const KA& a, int l) {
    const bf16* P = (const bf16*)(F.ws + WS_P);
    const bf16* WUQ = (const bf16*)(F.ws + WS_SMALLW + (size_t)l * MiB + SW_UQ); const bf16* WUKV = (const bf16*)(F.ws + WS_SMALLW + (size_t)l * MiB + SW_UKV);
    bf16* QB = (bf16*)(F.ws + WS_QB); bf16* KB = (bf16*)(F.ws + WS_KB); bf16* VT = (bf16*)(F.ws + WS_VT);
    const float* gq = a.in(I_QKQG) + l * 96; const float* gk = a.in(I_QKKG) + l * 96;
    const float2* ax = (const float2*)(F.ws + WS_ROPE_AX);
    const int gw = F.bid * NWAVES + F.wave, NGW = F.G * NWAVES, lane = F.lane;
    for (int tt = gw; tt < NT / 32; tt += NGW) {
        int lane_o = lane; asm volatile("" : "+v"(lane_o));
        const int tok = lane_o & 31, h_ = lane_o >> 5, h = h_; const int r = tt * 32 + tok, b = r / LTOT, p = r - b * LTOT; const bool lat = p >= CTX; const int sl = p - CTX;
        const bf16* prow = P + (size_t)r * DINP;
        bf16x8 cq[16]; float ssq = 0.f;
#pragma unroll
        for (int s = 0; s < 16; ++s) { const u32x4 w = *(const u32x4*)(prow + PC_MQ + 16 * s + 8 * h); cq[s] = __builtin_bit_cast(bf16x8, w);
            ssq += bflo(w.x) * bflo(w.x) + bfhi(w.x) * bfhi(w.x) + bflo(w.y) * bflo(w.y) + bfhi(w.y) * bfhi(w.y) + bflo(w.z) * bflo(w.z) + bfhi(w.z) * bfhi(w.z) + bflo(w.w) * bflo(w.w) + bfhi(w.w) * bfhi(w.w); }
        ssq += __shfl_xor(ssq, 32);
        const float rinq = rsqrtf(ssq * (1.f / 256.f) + 1e-6f);
        float2 cr[4], cc[4];
#pragma unroll
        for (int f = 0; f < 4; ++f) { cr[f] = lat ? ax[(sl >> 6) * 8 + 4 * h + f] : make_float2(1.f, 0.f); cc[f] = lat ? ax[(sl & 63) * 8 + 4 * h + f] : make_float2(1.f, 0.f); }
#pragma unroll 1
        for (int hd = 0; hd < 8; ++hd) {
            int h = h_; asm volatile("" : "+v"(h));
            const size_t tokbase = (size_t)(b * 8 + hd) * LTOT + p;
            f32x16 acc[3];
#pragma unroll
            for (int cb = 0; cb < 3; ++cb) { f32x16 z; for (int i = 0; i < 16; ++i) z[i] = 0.f; const bf16* wrow = WUQ + (size_t)(hd * 96 + cb * 32 + tok) * 256 + 8 * h;
#pragma unroll
                for (int s = 0; s < 16; ++s) { const bf16x8 af = *(const bf16x8*)(wrow + 16 * s); z = __builtin_amdgcn_mfma_f32_32x32x16_bf16(af, cq[s], z, 0, 0, 0); }
                acc[cb] = z; }
            float ss = 0.f;
#pragma unroll
            for (int cb = 0; cb < 3; ++cb)
#pragma unroll
                for (int i = 0; i < 16; ++i) { acc[cb][i] *= rinq; ss += acc[cb][i] * acc[cb][i]; }
            ss += __shfl_xor(ss, 32);
            const float rq = rsqrtf(ss * (1.f / 96.f) + 1e-6f);
#pragma unroll
            for (int cb = 0; cb < 3; ++cb)
#pragma unroll
                for (int i = 0; i < 16; ++i) acc[cb][i] *= rq * gq[cb * 32 + crow16(i, h)];
#pragma unroll
            for (int i = 0; i < 4; ++i) { const float2 c1 = cr[i]; const float x1 = acc[2][i], x2 = acc[2][i + 4]; acc[2][i] = x1 * c1.x - x2 * c1.y; acc[2][i + 4] = x1 * c1.y + x2 * c1.x;
                const float2 c2 = cc[i]; const float y1 = acc[2][8 + i], y2 = acc[2][12 + i]; acc[2][8 + i] = y1 * c2.x - y2 * c2.y; acc[2][12 + i] = y1 * c2.y + y2 * c2.x; }
            bf16* qrow = QB + tokbase * 96;
#pragma unroll
            for (int cb = 0; cb < 3; ++cb)
#pragma unroll
                for (int g = 0; g < 4; ++g) { u32x2 o; o.x = pk2(acc[cb][4 * g], acc[cb][4 * g + 1]); o.y = pk2(acc[cb][4 * g + 2], acc[cb][4 * g + 3]); *(u32x2*)(qrow + cb * 32 + 8 * g + 4 * h) = o; }
        }
    }
    for (int tt = gw; tt < NT / 32; tt += NGW) {
        int lane_o = lane; asm volatile("" : "+v"(lane_o));
        const int tok = lane_o & 31, h_ = lane_o >> 5, h = h_; const int r = tt * 32 + tok, b = r / LTOT, p = r - b * LTOT; const bool lat = p >= CTX; const int sl = p - CTX;
        const bf16* prow = P + (size_t)r * DINP;
        bf16x8 ckv[8]; float ssk = 0.f;
#pragma unroll
        for (int s = 0; s < 8; ++s) { const u32x4 w = *(const u32x4*)(prow + PC_MKV + 16 * s + 8 * h); ckv[s] = __builtin_bit_cast(bf16x8, w);
            ssk += bflo(w.x) * bflo(w.x) + bfhi(w.x) * bfhi(w.x) + bflo(w.y) * bflo(w.y) + bfhi(w.y) * bfhi(w.y) + bflo(w.z) * bflo(w.z) + bfhi(w.z) * bfhi(w.z) + bflo(w.w) * bflo(w.w) + bfhi(w.w) * bfhi(w.w); }
        ssk += __shfl_xor(ssk, 32);
        const float rinkv = rsqrtf(ssk * (1.f / 128.f) + 1e-6f);
        float pe1[8], pe2[8]; float sspe = 0.f;
        { const u32x4 w0 = *(const u32x4*)(prow + PC_MPE + 16 * h), w1 = *(const u32x4*)(prow + PC_MPE + 16 * h + 8);
          pe1[0] = bflo(w0.x); pe1[1] = bfhi(w0.x); pe1[2] = bflo(w0.y); pe1[3] = bfhi(w0.y); pe1[4] = bflo(w0.z); pe1[5] = bfhi(w0.z); pe1[6] = bflo(w0.w); pe1[7] = bfhi(w0.w);
          pe2[0] = bflo(w1.x); pe2[1] = bfhi(w1.x); pe2[2] = bflo(w1.y); pe2[3] = bfhi(w1.y); pe2[4] = bflo(w1.z); pe2[5] = bfhi(w1.z); pe2[6] = bflo(w1.w); pe2[7] = bfhi(w1.w);
#pragma unroll
          for (int j = 0; j < 8; ++j) sspe += pe1[j] * pe1[j] + pe2[j] * pe2[j];
          sspe += __shfl_xor(sspe, 32); }
        float2 cs[8];
#pragma unroll
        for (int f = 0; f < 8; ++f) cs[f] = lat ? ax[(h ? (sl & 63) : (sl >> 6)) * 8 + f] : make_float2(1.f, 0.f);
#pragma unroll 1
        for (int hd = 0; hd < 8; ++hd) {
            int h = h_; asm volatile("" : "+v"(h));
            const size_t tokbase = (size_t)(b * 8 + hd) * LTOT + p;
            f32x16 acc[4];
#pragma unroll
            for (int cb = 0; cb < 4; ++cb) { f32x16 z; for (int i = 0; i < 16; ++i) z[i] = 0.f; const bf16* wrow = WUKV + (size_t)(hd * 128 + cb * 32 + tok) * 128 + 8 * h;
#pragma unroll
                for (int s = 0; s < 8; ++s) { const bf16x8 af = *(const bf16x8*)(wrow + 16 * s); z = __builtin_amdgcn_mfma_f32_32x32x16_bf16(af, ckv[s], z, 0, 0, 0); }
                acc[cb] = z; }
            float ss = 0.f;
#pragma unroll
            for (int cb = 0; cb < 4; ++cb)
#pragma unroll
                for (int i = 0; i < 16; ++i) { acc[cb][i] *= rinkv; if (cb < 2) ss += acc[cb][i] * acc[cb][i]; }
            ss += __shfl_xor(ss, 32);
            const float rk = rsqrtf((ss + sspe) * (1.f / 96.f) + 1e-6f);
            bf16* krow = KB + tokbase * 96;
#pragma unroll
            for (int cb = 0; cb < 2; ++cb)
#pragma unroll
                for (int g = 0; g < 4; ++g) { float o4[4];
#pragma unroll
                    for (int j = 0; j < 4; ++j) o4[j] = acc[cb][4 * g + j] * rk * gk[cb * 32 + 8 * g + 4 * h + j];
                    u32x2 o; o.x = pk2(o4[0], o4[1]); o.y = pk2(o4[2], o4[3]); *(u32x2*)(krow + cb * 32 + 8 * g + 4 * h) = o; }
            { float pe[16];
#pragma unroll
              for (int f = 0; f < 8; ++f) { const float x1 = pe1[f] * rk * gk[64 + 16 * h + f], x2 = pe2[f] * rk * gk[64 + 16 * h + 8 + f];
                  pe[f] = x1 * cs[f].x - x2 * cs[f].y; pe[8 + f] = x1 * cs[f].y + x2 * cs[f].x; }
              *(bf16x8*)(krow + 64 + 16 * h) = pack8(pe); *(bf16x8*)(krow + 64 + 16 * h + 8) = pack8(pe + 8); }
            bf16* vt = VT + (size_t)(b * 8 + hd) * 64 * LTOT + permpos(p);
#pragma unroll
            for (int cb = 2; cb < 4; ++cb)
#pragma unroll
                for (int i = 0; i < 16; ++i) vt[(size_t)((cb - 2) * 32 + crow16(i, h)) * LTOT] = f2bf(acc[cb][i]);
        }
    }
}

constexpr int ATT_KP = 104, ATT_VP = 72;
constexpr int ATT_KBYTES = 64 * ATT_KP * 2, ATT_VBYTES = 64 * ATT_VP * 2;
DI void attn_unit(Frame& F, int b, int hd, int qblk) {
    const bf16* QB = (const bf16*)(F.ws + WS_QB); const bf16* KB = (const bf16*)(F.ws + WS_KB); const bf16* VT = (const bf16*)(F.ws + WS_VT);
    bf16* O = (bf16*)(F.ws + WS_ABR) + (size_t)NT * 512;
    const int q0 = qblk == 0 ? 0 : CTX + 256 * (qblk - 1), ntiles = qblk == 0 ? CTX / 64 : LTOT / 64;
    const int lane = F.lane, ql = lane & 31, h = lane >> 5, w = F.wave, tid = F.tid;
    const size_t bh = (size_t)(b * 8 + hd);
    LAS bf16* Kt = (LAS bf16*)(F.lds); LAS bf16* Vt = (LAS bf16*)(F.lds + 2 * ATT_KBYTES);
    bf16x8 qf[6];
    { const bf16* qrow = QB + (bh * LTOT + q0 + 32 * w + ql) * 96 + 8 * h;
#pragma unroll
      for (int s = 0; s < 6; ++s) qf[s] = *(const bf16x8*)(qrow + 16 * s); }
    const bf16* kbase = KB + bh * LTOT * 96; const bf16* vbase = VT + bh * 64 * LTOT;
    const int k1 = tid / 12, c1 = tid - k1 * 12, k2 = (512 + tid) / 12, c2 = (512 + tid) - k2 * 12, vd = tid >> 3, vc = tid & 7;
    u32x4 rk1, rk2 = {0u, 0u, 0u, 0u}, rv;
    rk1 = *(const u32x4*)(kbase + (size_t)k1 * 96 + 8 * c1); if (tid < 256) rk2 = *(const u32x4*)(kbase + (size_t)k2 * 96 + 8 * c2); rv = *(const u32x4*)(vbase + (size_t)vd * LTOT + 8 * vc);
    __syncthreads();
    *(LAS u32x4*)(Kt + k1 * ATT_KP + 8 * c1) = rk1; if (tid < 256) *(LAS u32x4*)(Kt + k2 * ATT_KP + 8 * c2) = rk2; *(LAS u32x4*)(Vt + vd * ATT_VP + 8 * vc) = rv;
    __syncthreads();
    float m = -1.0e30f, lsum = 0.f; f32x16 o0, o1;
#pragma unroll
    for (int i = 0; i < 16; ++i) { o0[i] = 0.f; o1[i] = 0.f; }
    const float sc = 0.10206207261596577f * 1.4426950408889634f;
    for (int t = 0; t < ntiles; ++t) {
        const int buf = t & 1; const bool more = t + 1 < ntiles;
        if (more) { const size_t ko = (size_t)(t + 1) * 64; rk1 = *(const u32x4*)(kbase + (ko + k1) * 96 + 8 * c1); if (tid < 256) rk2 = *(const u32x4*)(kbase + (ko + k2) * 96 + 8 * c2); rv = *(const u32x4*)(vbase + (size_t)vd * LTOT + ko + 8 * vc); }
        const LAS bf16* kt = Kt + buf * (64 * ATT_KP); const LAS bf16* vt = Vt + buf * (64 * ATT_VP);
        f32x16 s0, s1;
#pragma unroll
        for (int i = 0; i < 16; ++i) { s0[i] = 0.f; s1[i] = 0.f; }
#pragma unroll
        for (int s = 0; s < 6; ++s) { const bf16x8 a0 = *(const LAS bf16x8*)(kt + ql * ATT_KP + 16 * s + 8 * h), a1 = *(const LAS bf16x8*)(kt + (32 + ql) * ATT_KP + 16 * s + 8 * h);
            s0 = __builtin_amdgcn_mfma_f32_32x32x16_bf16(a0, qf[s], s0, 0, 0, 0); s1 = __builtin_amdgcn_mfma_f32_32x32x16_bf16(a1, qf[s], s1, 0, 0, 0); }
        float mt = -1.0e30f;
#pragma unroll
        for (int i = 0; i < 16; ++i) { s0[i] *= sc; s1[i] *= sc; mt = fmaxf(mt, fmaxf(s0[i], s1[i])); }
        mt = fmaxf(mt, __shfl_xor(mt, 32));
        const float mn = fmaxf(m, mt), alpha = __builtin_amdgcn_exp2f(m - mn); m = mn;
        float rs = 0.f;
#pragma unroll
        for (int i = 0; i < 16; ++i) { s0[i] = __builtin_amdgcn_exp2f(s0[i] - mn); s1[i] = __builtin_amdgcn_exp2f(s1[i] - mn); rs += s0[i] + s1[i]; }
        lsum = lsum * alpha + rs;
#pragma unroll
        for (int i = 0; i < 16; ++i) { o0[i] *= alpha; o1[i] *= alpha; }
        bf16x8 pf[4];
        { u32x4 x;
          x.x = pk2(s0[0], s0[1]); x.y = pk2(s0[2], s0[3]); x.z = pk2(s0[4], s0[5]); x.w = pk2(s0[6], s0[7]); pf[0] = __builtin_bit_cast(bf16x8, x);
          x.x = pk2(s0[8], s0[9]); x.y = pk2(s0[10], s0[11]); x.z = pk2(s0[12], s0[13]); x.w = pk2(s0[14], s0[15]); pf[1] = __builtin_bit_cast(bf16x8, x);
          x.x = pk2(s1[0], s1[1]); x.y = pk2(s1[2], s1[3]); x.z = pk2(s1[4], s1[5]); x.w = pk2(s1[6], s1[7]); pf[2] = __builtin_bit_cast(bf16x8, x);
          x.x = pk2(s1[8], s1[9]); x.y = pk2(s1[10], s1[11]); x.z = pk2(s1[12], s1[13]); x.w = pk2(s1[14], s1[15]); pf[3] = __builtin_bit_cast(bf16x8, x); }
#pragma unroll
        for (int ks = 0; ks < 4; ++ks) { const bf16x8 v0 = *(const LAS bf16x8*)(vt + ql * ATT_VP + 16 * ks + 8 * h), v1 = *(const LAS bf16x8*)(vt + (32 + ql) * ATT_VP + 16 * ks + 8 * h);
            o0 = __builtin_amdgcn_mfma_f32_32x32x16_bf16(v0, pf[ks], o0, 0, 0, 0); o1 = __builtin_amdgcn_mfma_f32_32x32x16_bf16(v1, pf[ks], o1, 0, 0, 0); }
        if (more) { const int nb = buf ^ 1; LAS bf16* kn = Kt + nb * (64 * ATT_KP); LAS bf16* vn = Vt + nb * (64 * ATT_VP);
            *(LAS u32x4*)(kn + k1 * ATT_KP + 8 * c1) = rk1; if (tid < 256) *(LAS u32x4*)(kn + k2 * ATT_KP + 8 * c2) = rk2; *(LAS u32x4*)(vn + vd * ATT_VP + 8 * vc) = rv; }
        __syncthreads();
    }
    lsum += __shfl_xor(lsum, 32);
    const float inv = 1.f / lsum;
    bf16* orow = O + ((size_t)b * LTOT + q0 + 32 * w + ql) * 512 + hd * 64 + 4 * h;
#pragma unroll
    for (int g = 0; g < 4; ++g) { u32x2 x; x.x = pk2(o0[4 * g] * inv, o0[4 * g + 1] * inv); x.y = pk2(o0[4 * g + 2] * inv, o0[4 * g + 3] * inv); *(u32x2*)(orow + 8 * g) = x;
        x.x = pk2(o1[4 * g] * inv, o1[4 * g + 1] * inv); x.y = pk2(o1[4 * g + 2] * inv, o1[4 * g + 3] * inv); *(u32x2*)(orow + 32 + 8 * g) = x; }
}

DI void shift_n(const bf16* prow, bool first, bool last, int col, const float* mup, const float* mun, float* out, int n  ) {
    const bf16* pp = first ? prow : prow - DINP; const bf16* pn = last ? prow : prow + DINP; const float fm = first ? 0.f : 1.f, lm = last ? 0.f : 1.f;
    if (n == 8) {
        const u32x4 c = *(const u32x4*)(prow + col), pv = *(const u32x4*)(pp + col), nx = *(const u32x4*)(pn + col);
        const f32x4 mp0 = *(const f32x4*)(mup + col - PC_RW), mp1 = *(const f32x4*)(mup + col - PC_RW + 4), mn0 = *(const f32x4*)(mun + col - PC_RW), mn1 = *(const f32x4*)(mun + col - PC_RW + 4);
        const unsigned cw[4] = {c.x, c.y, c.z, c.w}, pw[4] = {pv.x, pv.y, pv.z, pv.w}, nw[4] = {nx.x, nx.y, nx.z, nx.w};
        const float mp[8] = {mp0.x, mp0.y, mp0.z, mp0.w, mp1.x, mp1.y, mp1.z, mp1.w}, mn[8] = {mn0.x, mn0.y, mn0.z, mn0.w, mn1.x, mn1.y, mn1.z, mn1.w};
#pragma unroll
        for (int j = 0; j < 4; ++j) { const float t0 = bflo(cw[j]), t1 = bfhi(cw[j]);
            out[2 * j] = t0 + mp[2 * j] * (fm * bflo(pw[j]) - t0) + mn[2 * j] * (lm * bflo(nw[j]) - t0);
            out[2 * j + 1] = t1 + mp[2 * j + 1] * (fm * bfhi(pw[j]) - t1) + mn[2 * j + 1] * (lm * bfhi(nw[j]) - t1); }
    } else {
        const u32x2 c = *(const u32x2*)(prow + col), pv = *(const u32x2*)(pp + col), nx = *(const u32x2*)(pn + col);
        const f32x4 mp0 = *(const f32x4*)(mup + col - PC_RW), mn0 = *(const f32x4*)(mun + col - PC_RW);
        const unsigned cw[2] = {c.x, c.y}, pw[2] = {pv.x, pv.y}, nw[2] = {nx.x, nx.y};
        const float mp[4] = {mp0.x, mp0.y, mp0.z, mp0.w}, mn[4] = {mn0.x, mn0.y, mn0.z, mn0.w};
#pragma unroll
        for (int j = 0; j < 2; ++j) { const float t0 = bflo(cw[j]), t1 = bfhi(cw[j]);
            out[2 * j] = t0 + mp[2 * j] * (fm * bflo(pw[j]) - t0) + mn[2 * j] * (lm * bflo(nw[j]) - t0);
            out[2 * j + 1] = t1 + mp[2 * j + 1] * (fm * bfhi(pw[j]) - t1) + mn[2 * j + 1] * (lm * bfhi(nw[j]) - t1); }
    }
}
DI void phase_rwkv_prep(Frame& F, const KA& a, int l) {
    const bf16* P = (const bf16*)(F.ws + WS_P);
    const bf16* W2T = (const bf16*)(F.ws + WS_SMALLW + (size_t)l * MiB + SW_W2); const bf16* A2T = (const bf16*)(F.ws + WS_SMALLW + (size_t)l * MiB + SW_A2); const bf16* G2T = (const bf16*)(F.ws + WS_SMALLW + (size_t)l * MiB + SW_G2);
    const float* mup = a.in(I_MUP) + l * 1920; const float* mun = a.in(I_MUN) + l * 1920;
    const float* w0 = a.in(I_W0) + l * 1024; const float* a0 = a.in(I_A0) + l * 1024; const float* kkw = a.in(I_KK) + l * 512; const float* kaw = a.in(I_KA) + l * 512;
    bf16* RW = (bf16*)(F.ws + WS_RW); float* LW = (float*)(F.ws + WS_LW);
    const size_t TS = (size_t)NT * 512;
    const int gw = F.bid * NWAVES + F.wave, NGW = F.G * NWAVES, lane = F.lane;
    for (int tt = gw; tt < NT / 32; tt += NGW) {
        int lane_o = lane; asm volatile("" : "+v"(lane_o));
        const int tok = lane_o & 31, h = lane_o >> 5;
        const int r = tt * 32 + tok, b = r / LTOT, p = r - b * LTOT; const bool first = (p == 0) || (p == CTX), last = (p == CTX - 1) || (p == LTOT - 1);
        const bf16* prow = P + (size_t)r * DINP;
        bf16x8 fwf[4], fwb[4];
#pragma unroll
        for (int s = 0; s < 4; ++s) { float v[8];
            shift_n(prow, first, last, PC_WHF + 16 * s + 8 * h, mup, mun, v, 8);
#pragma unroll
            for (int j = 0; j < 8; ++j) v[j] = 2.f * sigmoidf_(2.f * v[j]) - 1.f;
            fwf[s] = pack8(v); asm volatile("" : "+v"(fwf[s]) :: "memory");
            shift_n(prow, first, last, PC_WHB + 16 * s + 8 * h, mup, mun, v, 8);
#pragma unroll
            for (int j = 0; j < 8; ++j) v[j] = 2.f * sigmoidf_(2.f * v[j]) - 1.f;
            fwb[s] = pack8(v); asm volatile("" : "+v"(fwb[s]) :: "memory"); }
#pragma unroll 1
        for (int blk = 0; blk < 16; ++blk) {
            const int wrow = blk * 32 + tok; const size_t o = (size_t)r * 512 + blk * 32 + 4 * h;
            { f32x16 c; for (int i = 0; i < 16; ++i) c[i] = 0.f;
#pragma unroll
              for (int s = 0; s < 4; ++s) c = __builtin_amdgcn_mfma_f32_32x32x16_bf16(*(const bf16x8*)(W2T + (size_t)wrow * 64 + 16 * s + 8 * h), fwf[s], c, 0, 0, 0);
#pragma unroll
              for (int g = 0; g < 4; ++g) { const f32x4 w4 = *(const f32x4*)(w0 + blk * 32 + 8 * g + 4 * h);
                  *(f32x4*)(LW + o + 8 * g) = (f32x4){-0.6065306597f * sigmoidf_(w4.x + c[4 * g]), -0.6065306597f * sigmoidf_(w4.y + c[4 * g + 1]), -0.6065306597f * sigmoidf_(w4.z + c[4 * g + 2]), -0.6065306597f * sigmoidf_(w4.w + c[4 * g + 3])}; } }
            { f32x16 c; for (int i = 0; i < 16; ++i) c[i] = 0.f;
#pragma unroll
              for (int s = 0; s < 4; ++s) c = __builtin_amdgcn_mfma_f32_32x32x16_bf16(*(const bf16x8*)(W2T + (size_t)(512 + wrow) * 64 + 16 * s + 8 * h), fwb[s], c, 0, 0, 0);
#pragma unroll
              for (int g = 0; g < 4; ++g) { const f32x4 w4 = *(const f32x4*)(w0 + 512 + blk * 32 + 8 * g + 4 * h);
                  *(f32x4*)(LW + TS + o + 8 * g) = (f32x4){-0.6065306597f * sigmoidf_(w4.x + c[4 * g]), -0.6065306597f * sigmoidf_(w4.y + c[4 * g + 1]), -0.6065306597f * sigmoidf_(w4.z + c[4 * g + 2]), -0.6065306597f * sigmoidf_(w4.w + c[4 * g + 3])}; } }
        }
    }
    for (int tt = gw; tt < NT / 32; tt += NGW) {
        int lane_o = lane; asm volatile("" : "+v"(lane_o));
        const int tok = lane_o & 31, h = lane_o >> 5;
        const int r = tt * 32 + tok, b = r / LTOT, p = r - b * LTOT; const bool first = (p == 0) || (p == CTX), last = (p == CTX - 1) || (p == LTOT - 1);
        const bf16* prow = P + (size_t)r * DINP;
        bf16x8 fg[8];
#pragma unroll
        for (int s = 0; s < 8; ++s) { float v[8]; shift_n(prow, first, last, PC_GH + 16 * s + 8 * h, mup, mun, v, 8);
#pragma unroll
            for (int j = 0; j < 8; ++j) v[j] = sigmoidf_(v[j]);
            fg[s] = pack8(v); asm volatile("" : "+v"(fg[s]) :: "memory"); }
#pragma unroll 1
        for (int blk = 0; blk < 16; ++blk) {
            const int wrow = blk * 32 + tok; const size_t o = (size_t)r * 512 + blk * 32 + 4 * h;
            { f32x16 c; for (int i = 0; i < 16; ++i) c[i] = 0.f;
#pragma unroll
              for (int s = 0; s < 8; ++s) c = __builtin_amdgcn_mfma_f32_32x32x16_bf16(*(const bf16x8*)(G2T + (size_t)wrow * 128 + 16 * s + 8 * h), fg[s], c, 0, 0, 0);
#pragma unroll
              for (int g = 0; g < 4; ++g) { u32x2 w_; w_[0] = pk2(c[4 * g], c[4 * g + 1]); w_[1] = pk2(c[4 * g + 2], c[4 * g + 3]); *(u32x2*)(RW + 7 * TS + o + 8 * g) = w_; } }
        }
    }
    for (int tt = gw; tt < NT / 32; tt += NGW) {
        int lane_o = lane; asm volatile("" : "+v"(lane_o));
        const int tok = lane_o & 31, h = lane_o >> 5;
        const int r = tt * 32 + tok, b = r / LTOT, p = r - b * LTOT; const bool first = (p == 0) || (p == CTX), last = (p == CTX - 1) || (p == LTOT - 1);
        const bf16* prow = P + (size_t)r * DINP;
        bf16x8 faf[4], fab[4];
#pragma unroll
        for (int s = 0; s < 4; ++s) { float v[8];
            shift_n(prow, first, last, PC_AHF + 16 * s + 8 * h, mup, mun, v, 8); faf[s] = pack8(v); asm volatile("" : "+v"(faf[s]) :: "memory");
            shift_n(prow, first, last, PC_AHB + 16 * s + 8 * h, mup, mun, v, 8); fab[s] = pack8(v); asm volatile("" : "+v"(fab[s]) :: "memory"); }
#pragma unroll 1
        for (int hd = 0; hd < 8; ++hd) {
            float kraw[2][16]; float ss = 0.f;
#pragma unroll
            for (int cb = 0; cb < 2; ++cb)
#pragma unroll
                for (int g = 0; g < 4; ++g) { const int ch = hd * 64 + cb * 32 + 8 * g + 4 * h; shift_n(prow, first, last, PC_WK + ch, mup, mun, &kraw[cb][4 * g], 4);
#pragma unroll
                    for (int j = 0; j < 4; ++j) { const float t = kraw[cb][4 * g + j] * kkw[ch + j]; ss += t * t; }
                    asm volatile("" : "+v"(kraw[cb][4 * g]), "+v"(kraw[cb][4 * g + 1]), "+v"(kraw[cb][4 * g + 2]), "+v"(kraw[cb][4 * g + 3]) :: "memory"); }
            ss += __shfl_xor(ss, 32);
            const float rkk = rsqrtf(fmaxf(ss, 1e-24f));
#pragma unroll
            for (int cb = 0; cb < 2; ++cb) {
                f32x16 caf, cab;
#pragma unroll
                for (int i = 0; i < 16; ++i) { caf[i] = 0.f; cab[i] = 0.f; }
                const int wrow = hd * 64 + cb * 32 + tok;
#pragma unroll
                for (int s = 0; s < 4; ++s) {
                    caf = __builtin_amdgcn_mfma_f32_32x32x16_bf16(*(const bf16x8*)(A2T + (size_t)wrow * 64 + 16 * s + 8 * h), faf[s], caf, 0, 0, 0);
                    cab = __builtin_amdgcn_mfma_f32_32x32x16_bf16(*(const bf16x8*)(A2T + (size_t)(512 + wrow) * 64 + 16 * s + 8 * h), fab[s], cab, 0, 0, 0); }
#pragma unroll
                for (int g = 0; g < 4; ++g) { const int ch = hd * 64 + cb * 32 + 8 * g + 4 * h; float rv[4], vv[4];
                    shift_n(prow, first, last, PC_WR + ch, mup, mun, rv, 4); shift_n(prow, first, last, PC_WV + ch, mup, mun, vv, 4);
                    float kf[4], kb_[4], kk[4], af[4], ab[4];
#pragma unroll
                    for (int j = 0; j < 4; ++j) { const int i = 4 * g + j; const float k = kraw[cb][i];
                        af[j] = sigmoidf_(a0[ch + j] + caf[i]); ab[j] = sigmoidf_(a0[512 + ch + j] + cab[i]);
                        kf[j] = k * (1.f + (af[j] - 1.f) * kaw[ch + j]); kb_[j] = k * (1.f + (ab[j] - 1.f) * kaw[ch + j]);
                        kk[j] = k * kkw[ch + j] * rkk; }
                    const size_t o = (size_t)r * 512 + ch;
#define ST4(idx, ARR) do { u32x2 w_; w_[0] = pk2(ARR[0], ARR[1]); w_[1] = pk2(ARR[2], ARR[3]); *(u32x2*)(RW + (size_t)(idx) * TS + o) = w_; } while (0)
                    ST4(0, rv); ST4(1, kf); ST4(2, kb_); ST4(3, vv); ST4(4, kk); ST4(5, af); ST4(6, ab);
#undef ST4
                    asm volatile("" ::: "memory");
                }
            }
        }
    }
}

DI void phase_rwkv_scan_naive(Frame& F, const KA& a, int l, int bi) {
    const bf16* RW = (const bf16*)(F.ws + WS_RW); const float* LW = (const float*)(F.ws + WS_LW); float* YF = (float*)(F.ws + WS_YF);
    const size_t TS = (size_t)NT * 512;
    const int lane = F.lane, w = F.wave, chain = bi * 8 + w, dir = chain & 1, bh = chain >> 1, b = bh >> 3, hd = bh & 7;
    LAS float* vec = (LAS float*)(F.lds + w * 2048);
    const bf16* Rr = RW; const bf16* Rk = RW + (size_t)(1 + dir) * TS; const bf16* Rv = RW + (size_t)3 * TS; const bf16* Rkk = RW + (size_t)4 * TS; const bf16* Ra = RW + (size_t)(5 + dir) * TS;
    const float* Rlw = LW + (size_t)dir * TS; float* Ry = YF + (size_t)dir * TS;
    const int base = b * LTOT * 512 + hd * 64 + lane;
    float S[64];
#pragma unroll
    for (int j = 0; j < 64; ++j) S[j] = 0.f;
#define POSOF(n) (dir == 0 ? (n) : ((n) < CTX ? CTX - 1 - (n) : LTOT - 1 - ((n) - CTX)))
    int off = base + POSOF(0) * 512;
    float cr = bf2f(Rr[off]), ck = bf2f(Rk[off]), cv = bf2f(Rv[off]), ckk = bf2f(Rkk[off]), ca = bf2f(Ra[off]), clw = Rlw[off];
#pragma unroll 1
    for (int n = 0; n < LTOT; ++n) {
        vec[lane] = __expf(clw); vec[64 + lane] = ckk; vec[128 + lane] = ckk * ca; vec[192 + lane] = ck; vec[256 + lane] = cr;
        const float vi = cv; const int ocur = off;
        if (n + 1 < LTOT) { off = base + POSOF(n + 1) * 512;
            cr = bf2f(Rr[off]); ck = bf2f(Rk[off]); cv = bf2f(Rv[off]); ckk = bf2f(Rkk[off]); ca = bf2f(Ra[off]); clw = Rlw[off]; }
        float sa0 = 0.f, sa1 = 0.f, sa2 = 0.f, sa3 = 0.f;
#pragma unroll
        for (int j = 0; j < 64; j += 4) { const f32x4 kk4 = *(const LAS f32x4*)(vec + 64 + j); sa0 += S[j] * kk4.x; sa1 += S[j + 1] * kk4.y; sa2 += S[j + 2] * kk4.z; sa3 += S[j + 3] * kk4.w; if ((j & 15) == 12) asm volatile("" ::: "memory"); }
        const float sa = -((sa0 + sa1) + (sa2 + sa3));
        float y0 = 0.f, y1 = 0.f, y2 = 0.f, y3 = 0.f;
#pragma unroll
        for (int j = 0; j < 64; j += 4) { const f32x4 w4 = *(const LAS f32x4*)(vec + j), ka4 = *(const LAS f32x4*)(vec + 128 + j), k4 = *(const LAS f32x4*)(vec + 192 + j), r4 = *(const LAS f32x4*)(vec + 256 + j);
            S[j] = S[j] * w4.x + (sa * ka4.x + vi * k4.x); S[j + 1] = S[j + 1] * w4.y + (sa * ka4.y + vi * k4.y); S[j + 2] = S[j + 2] * w4.z + (sa * ka4.z + vi * k4.z); S[j + 3] = S[j + 3] * w4.w + (sa * ka4.w + vi * k4.w);
            y0 += S[j] * r4.x; y1 += S[j + 1] * r4.y; y2 += S[j + 2] * r4.z; y3 += S[j + 3] * r4.w; if ((j & 7) == 4) asm volatile("" ::: "memory"); }
        Ry[ocur] = (y0 + y1) + (y2 + y3);
    }
#undef POSOF
    VM_WAIT(); __syncthreads(); __builtin_amdgcn_fence(__ATOMIC_ACQUIRE, "agent");
    const float* lng = a.in(I_LNXG) + l * 512; const float* lnb = a.in(I_LNXB) + l * 512; const float* rkw = a.in(I_RK) + l * 512;
    bf16* O = (bf16*)(F.ws + WS_ABR) + (size_t)2 * NT * 512;
    for (int pair = 0; pair < 4; ++pair) { const int bh2 = bi * 4 + pair, b2 = bh2 >> 3, hd2 = bh2 & 7; const int c = hd2 * 64 + lane;
        const float g_ = lng[c], b_ = lnb[c], rk_ = rkw[c];
        for (int pp = w; pp < LTOT; pp += NWAVES) { const size_t o = ((size_t)b2 * LTOT + pp) * 512 + c;
            const float s = YF[o] + YF[TS + o]; const float mean = wave_sum(s) * (1.f / 64.f); const float d = s - mean; const float var = wave_sum(d * d) * (1.f / 64.f);
            const float rr = bf2f(RW[o]), kf = bf2f(RW[TS + o]), kb_ = bf2f(RW[2 * TS + o]), vv = bf2f(RW[3 * TS + o]), gg = bf2f(RW[7 * TS + o]);
            const float bonus = wave_sum(rr * (kf + kb_) * rk_);
            const float y = d * rsqrtf(var + 64e-5f) * g_ + b_ + bonus * vv;
            O[o] = f2bf(y * gg); } }
}

constexpr int NCHUNK = LTOT / 64;
constexpr int NCHAIN = BATCH * 8 * 2;
constexpr int RC_P = 72;
constexpr int RC_TILE = 64 * RC_P * 2;
constexpr int RC_LTF = 13 * RC_TILE, RC_EC = RC_LTF + 64 * 65 * 4;
DI int chain_pos(int dir, int n) { return dir == 0 ? n : (n < CTX ? CTX - 1 - n : LTOT - 1 - (n - CTX)); }
DI f32x16 mm_blk(const LAS bf16* A, int mb, const LAS bf16* Bt, int nb, int k0, int ksteps, int lane, f32x16 acc) {
    const int r = lane & 31, h = lane >> 5;
#pragma unroll
    for (int q = 0; q < 4; ++q) if (q < ksteps) { const bf16x8 a = *(const LAS bf16x8*)(A + (mb * 32 + r) * RC_P + k0 + 16 * q + 8 * h), b = *(const LAS bf16x8*)(Bt + (nb * 32 + r) * RC_P + k0 + 16 * q + 8 * h);
        acc = __builtin_amdgcn_mfma_f32_32x32x16_bf16(a, b, acc, 0, 0, 0); }
    return acc;
}
DI void st_tile_T(LAS bf16* tile, int mb, int nb, const f32x16& d, int lane) {
    const int r = lane & 31, h = lane >> 5;
#pragma unroll
    for (int g = 0; g < 4; ++g) { u32x2 x; x.x = pk2(d[4 * g], d[4 * g + 1]); x.y = pk2(d[4 * g + 2], d[4 * g + 3]); *(LAS u32x2*)(tile + (nb * 32 + r) * RC_P + mb * 32 + 8 * g + 4 * h) = x; }
}
DI f32x16 zero16() { f32x16 z; for (int i = 0; i < 16; ++i) z[i] = 0.f; return z; }
DI void rwkv_chunk_item(Frame& F, int cid) {
    int lane = F.lane; asm volatile("" : "+v"(lane));
    int w = F.wave; asm volatile("" : "+s"(w));
    const int chain = cid / NCHUNK, c = cid - chain * NCHUNK, dir = chain & 1, bh = chain >> 1, b = bh >> 3, hd = bh & 7;
    const bf16* RW = (const bf16*)(F.ws + WS_RW); const float* LW = (const float*)(F.ws + WS_LW); const size_t TS = (size_t)NT * 512;
    LAS bf16* tiles = (LAS bf16*)F.lds;
#define TILE(i) (tiles + (i) * (RC_TILE / 2))
    LAS float* LTf = (LAS float*)(F.lds + RC_LTF); LAS float* EC = (LAS float*)(F.lds + RC_EC);
    { const int p = chain_pos(dir, 64 * c + lane); const size_t off = ((size_t)b * LTOT + p) * 512 + hd * 64 + 8 * w;
      const f32x4 l0 = *(const f32x4*)(LW + (size_t)dir * TS + off), l1 = *(const f32x4*)(LW + (size_t)dir * TS + off + 4);
      const u32x4 ur = *(const u32x4*)(RW + off), uk = *(const u32x4*)(RW + (size_t)(1 + dir) * TS + off), uv = *(const u32x4*)(RW + 3 * TS + off), ukk = *(const u32x4*)(RW + 4 * TS + off), ua = *(const u32x4*)(RW + (size_t)(5 + dir) * TS + off);
      float lw[8] = {l0.x, l0.y, l0.z, l0.w, l1.x, l1.y, l1.z, l1.w}, cw[8];
#pragma unroll
      for (int j = 0; j < 8; ++j) cw[j] = lw[j];
#pragma unroll
      for (int o = 1; o < 64; o <<= 1)
#pragma unroll
          for (int j = 0; j < 8; ++j) { const float t = __shfl_up(cw[j], o); cw[j] += lane >= o ? t : 0.f; }
      const unsigned rw_[4] = {ur.x, ur.y, ur.z, ur.w}, kw_[4] = {uk.x, uk.y, uk.z, uk.w}, kkw_[4] = {ukk.x, ukk.y, ukk.z, ukk.w}, aw_[4] = {ua.x, ua.y, ua.z, ua.w};
      float At[8], Rt[8], Bt[8], Kt[8];
#pragma unroll
      for (int j = 0; j < 8; ++j) { const float rr = (j & 1) ? bfhi(rw_[j >> 1]) : bflo(rw_[j >> 1]), kk = (j & 1) ? bfhi(kkw_[j >> 1]) : bflo(kkw_[j >> 1]), k = (j & 1) ? bfhi(kw_[j >> 1]) : bflo(kw_[j >> 1]), aa = (j & 1) ? bfhi(aw_[j >> 1]) : bflo(aw_[j >> 1]);
          const float ep = __expf(cw[j]), em = __expf(-cw[j]), epv = __expf(cw[j] - lw[j]);
          At[j] = -kk * epv; Rt[j] = rr * ep; Bt[j] = kk * aa * em; Kt[j] = k * em;
          if (lane == 63) EC[8 * w + j] = ep; }
      const bf16x8 fa = pack8(At), fr_ = pack8(Rt), fb = pack8(Bt), fk = pack8(Kt);
      *(LAS bf16x8*)(TILE(0) + lane * RC_P + 8 * w) = fa; *(LAS bf16x8*)(TILE(1) + lane * RC_P + 8 * w) = fr_; *(LAS bf16x8*)(TILE(2) + lane * RC_P + 8 * w) = fb; *(LAS bf16x8*)(TILE(3) + lane * RC_P + 8 * w) = fk;
      const unsigned vw_[4] = {uv.x, uv.y, uv.z, uv.w};
#pragma unroll
      for (int j = 0; j < 8; ++j) { TILE(4)[(8 * w + j) * RC_P + lane] = (bf16)fa[j]; TILE(5)[(8 * w + j) * RC_P + lane] = (bf16)fb[j]; TILE(6)[(8 * w + j) * RC_P + lane] = (bf16)fk[j];
          TILE(7)[(8 * w + j) * RC_P + lane] = (bf16)((j & 1) ? (vw_[j >> 1] >> 16) : (vw_[j >> 1] & 0xffffu)); } }
    __syncthreads();
    { const int pi = w >> 1, nb = w & 1, r = lane & 31, h = lane >> 5;
      const LAS bf16* Aop = (pi == 0 || pi == 2) ? TILE(2) : TILE(3);
      const LAS bf16* Bop = pi < 2 ? TILE(0) : TILE(1);
      LAS bf16* dst = TILE(8 + pi);
#pragma unroll
      for (int mb = 0; mb < 2; ++mb) { f32x16 d = zero16();
          if (mb <= nb) d = mm_blk(Aop, mb, Bop, nb, 0, 4, lane, d);
#pragma unroll
          for (int i = 0; i < 16; ++i) { const int m = mb * 32 + crow16(i, h), n = nb * 32 + r; const bool keep = pi < 2 ? m < n : m <= n; d[i] = keep ? d[i] : 0.f; }
          st_tile_T(dst, mb, nb, d, lane);
          if (pi == 0) {
#pragma unroll
              for (int i = 0; i < 16; ++i) LTf[(mb * 32 + crow16(i, h)) * 65 + nb * 32 + r] = d[i]; } } }
    __syncthreads();
    if (w == 0) {
        const int tl = lane & 31, blk = lane >> 5;
        float Tr[32];
#pragma unroll
        for (int i = 0; i < 32; ++i) Tr[i] = 0.f;
#pragma unroll
        for (int cc = 31; cc >= 0; --cc) { float a0 = (cc == tl) ? 1.f : 0.f, a1 = 0.f;
            const LAS float* lrow = LTf + (blk * 32 + cc) * 65 + blk * 32;
#pragma unroll
            for (int s2 = cc + 1; s2 < 32; ++s2) { if (s2 & 1) a1 += Tr[s2] * lrow[s2]; else a0 += Tr[s2] * lrow[s2]; }
            Tr[cc] = a0 + a1; if ((cc & 1) == 0) asm volatile("" ::: "memory"); }
        { LAS bf16* trow = TILE(12) + (blk * 32 + tl) * RC_P; unsigned z0; asm volatile("v_mov_b32 %0, 0" : "=v"(z0));
#pragma unroll
          for (int g = 0; g < 4; ++g) { *(LAS bf16x8*)(trow + blk * 32 + 8 * g) = pack8(Tr + 8 * g); if (blk == 0) *(LAS u32x4*)(trow + 32 + 8 * g) = (u32x4){z0, z0, z0, z0}; }
          if (blk == 0) {
#pragma unroll
              for (int i = 0; i < 32; ++i) TILE(0)[i * RC_P + tl] = f2bf(Tr[i]); } }
        LDS_WAIT();
        f32x16 m1 = mm_blk(TILE(8), 1, TILE(0), 0, 0, 2, lane, zero16());
        st_tile_T(TILE(2), 0, 0, m1, lane);
        LDS_WAIT();
        { const int r = lane & 31, h = lane >> 5; f32x16 d = zero16();
#pragma unroll
          for (int q = 0; q < 2; ++q) { const bf16x8 a = *(const LAS bf16x8*)(TILE(2) + r * RC_P + 16 * q + 8 * h), bb = *(const LAS bf16x8*)(TILE(12) + (32 + r) * RC_P + 32 + 16 * q + 8 * h);
              d = __builtin_amdgcn_mfma_f32_32x32x16_bf16(a, bb, d, 0, 0, 0); }
#pragma unroll
          for (int g = 0; g < 4; ++g) { u32x2 x; x.x = pk2(d[4 * g], d[4 * g + 1]); x.y = pk2(d[4 * g + 2], d[4 * g + 3]); *(LAS u32x2*)(TILE(12) + (32 + r) * RC_P + 8 * g + 4 * h) = x; } }
    } else if (w <= 4) {
        const int mb = (w - 1) >> 1, nb = (w - 1) & 1;
        const f32x16 u = mm_blk(TILE(9), mb, TILE(7), nb, 0, 4, lane, zero16());
        st_tile_T(TILE(3), mb, nb, u, lane);
    }
    __syncthreads();
    { const int mb = (w >> 1) & 1, nb = w & 1;
      if (w < 4) { const f32x16 d = mm_blk(TILE(12), mb, TILE(4), nb, 0, 4, lane, zero16()); st_tile_T(TILE(2), mb, nb, d, lane); }
      else { const f32x16 d = mm_blk(TILE(12), mb, TILE(3), nb, 0, 4, lane, zero16()); st_tile_T(TILE(0), mb, nb, d, lane); } }
    __syncthreads();
    { const int mb = (w >> 1) & 1, nb = w & 1, r = lane & 31, h = lane >> 5;
      bf16* PM = (bf16*)(F.ws + WS_RCH) + (size_t)cid * 4096; bf16* QM = (bf16*)(F.ws + WS_RCH + 68 * MiB) + (size_t)cid * 4096;
      bf16* GM = (bf16*)(F.ws + WS_RCH + 136 * MiB) + (size_t)cid * 4096; bf16* YL = (bf16*)(F.ws + WS_RCH + 204 * MiB) + (size_t)cid * 4096;
      if (w < 4) {
          f32x16 d = mm_blk(TILE(5), mb, TILE(2), nb, 0, 4, lane, zero16());
#pragma unroll
          for (int i = 0; i < 16; ++i) { const int j = mb * 32 + crow16(i, h), j2 = nb * 32 + r; const float v = (d[i] + (j == j2 ? 1.f : 0.f)) * EC[j]; PM[j * 64 + j2] = f2bf(v); }
          f32x16 q = mm_blk(TILE(5), mb, TILE(0), nb, 0, 4, lane, zero16()); q = mm_blk(TILE(6), mb, TILE(7), nb, 0, 4, lane, q);
#pragma unroll
          for (int g = 0; g < 4; ++g) { const int j0 = mb * 32 + 8 * g + 4 * h; u32x2 x; x.x = pk2(q[4 * g] * EC[j0], q[4 * g + 1] * EC[j0 + 1]); x.y = pk2(q[4 * g + 2] * EC[j0 + 2], q[4 * g + 3] * EC[j0 + 3]);
              *(u32x2*)(QM + (nb * 32 + r) * 64 + j0) = x; }
      } else {
          f32x16 d = mm_blk(TILE(10), mb, TILE(2), nb, 0, 4, lane, zero16());
#pragma unroll
          for (int i = 0; i < 16; ++i) { const int t = mb * 32 + crow16(i, h), j2 = nb * 32 + r; GM[t * 64 + j2] = f2bf(d[i] + bf2f(TILE(1)[t * RC_P + j2])); }
          f32x16 y = mm_blk(TILE(10), mb, TILE(0), nb, 0, 4, lane, zero16()); y = mm_blk(TILE(11), mb, TILE(7), nb, 0, 4, lane, y);
#pragma unroll
          for (int g = 0; g < 4; ++g) { u32x2 x; x.x = pk2(y[4 * g], y[4 * g + 1]); x.y = pk2(y[4 * g + 2], y[4 * g + 3]); *(u32x2*)(YL + (nb * 32 + r) * 64 + mb * 32 + 8 * g + 4 * h) = x; }
      } }
    __syncthreads();
#undef TILE
}
DI void rwkv_scan_block(Frame& F, const KA& a, int l, int bi) {
    const int lane = F.lane, w = F.wave, r = lane & 31, h = lane >> 5;
    const size_t TS = (size_t)NT * 512;
    { const int bh = bi * 2 + (w >> 2), dir = (w >> 1) & 1, ib = w & 1, b = bh >> 3, hd = bh & 7, chain = bh * 2 + dir;
      const bf16* PM = (const bf16*)(F.ws + WS_RCH); const bf16* QM = (const bf16*)(F.ws + WS_RCH + 68 * MiB); const bf16* GM = (const bf16*)(F.ws + WS_RCH + 136 * MiB); const bf16* YL = (const bf16*)(F.ws + WS_RCH + 204 * MiB);
      float* Y = (float*)(F.ws + WS_YF) + (size_t)dir * TS;
      f32x16 s0 = zero16(), s1 = zero16();
#pragma unroll 1
      for (int c = 0; c < NCHUNK; ++c) {
          const size_t cb = ((size_t)chain * NCHUNK + c) * 4096;
          float t0[16], t1[16];
#pragma unroll
          for (int i = 0; i < 16; ++i) { t0[i] = s0[i]; t1[i] = s1[i]; }
          const bf16x8 bf0 = pack8(t0), bf1 = pack8(t0 + 8), bf2 = pack8(t1), bf3 = pack8(t1 + 8);
          f32x16 n0, n1, y0, y1;
          { const bf16* q0 = QM + cb + (size_t)(ib * 32 + r) * 64 + 4 * h; const bf16* yl = YL + cb + (size_t)(ib * 32 + r) * 64 + 4 * h;
#pragma unroll
            for (int g = 0; g < 4; ++g) { const u32x2 x0 = *(const u32x2*)(q0 + 8 * g), x1 = *(const u32x2*)(q0 + 32 + 8 * g), x2 = *(const u32x2*)(yl + 8 * g), x3 = *(const u32x2*)(yl + 32 + 8 * g);
                n0[4 * g] = bflo(x0.x); n0[4 * g + 1] = bfhi(x0.x); n0[4 * g + 2] = bflo(x0.y); n0[4 * g + 3] = bfhi(x0.y);
                n1[4 * g] = bflo(x1.x); n1[4 * g + 1] = bfhi(x1.x); n1[4 * g + 2] = bflo(x1.y); n1[4 * g + 3] = bfhi(x1.y);
                y0[4 * g] = bflo(x2.x); y0[4 * g + 1] = bfhi(x2.x); y0[4 * g + 2] = bflo(x2.y); y0[4 * g + 3] = bfhi(x2.y);
                y1[4 * g] = bflo(x3.x); y1[4 * g + 1] = bfhi(x3.x); y1[4 * g + 2] = bflo(x3.y); y1[4 * g + 3] = bfhi(x3.y); } }
#define FRAG(base, row, kq) ({ const bf16* p_ = (base) + (size_t)(row) * 64 + ((kq) >> 1) * 32 + ((kq) & 1) * 16 + 4 * h; const u32x2 lo_ = *(const u32x2*)p_, hi_ = *(const u32x2*)(p_ + 8); \
            u32x4 f_; f_.x = lo_.x; f_.y = lo_.y; f_.z = hi_.x; f_.w = hi_.y; __builtin_bit_cast(bf16x8, f_); })
#pragma unroll
          for (int kq = 0; kq < 4; ++kq) { const bf16x8 bq = kq == 0 ? bf0 : kq == 1 ? bf1 : kq == 2 ? bf2 : bf3;
              n0 = __builtin_amdgcn_mfma_f32_32x32x16_bf16(FRAG(PM + cb, r, kq), bq, n0, 0, 0, 0);
              n1 = __builtin_amdgcn_mfma_f32_32x32x16_bf16(FRAG(PM + cb, 32 + r, kq), bq, n1, 0, 0, 0);
              y0 = __builtin_amdgcn_mfma_f32_32x32x16_bf16(FRAG(GM + cb, r, kq), bq, y0, 0, 0, 0);
              y1 = __builtin_amdgcn_mfma_f32_32x32x16_bf16(FRAG(GM + cb, 32 + r, kq), bq, y1, 0, 0, 0); }
#undef FRAG
          s0 = n0; s1 = n1;
          float* yb = Y + (size_t)b * LTOT * 512 + hd * 64 + ib * 32 + r;
#pragma unroll
          for (int i = 0; i < 16; ++i) { const int p0 = chain_pos(dir, 64 * c + crow16(i, h)), p1 = chain_pos(dir, 64 * c + 32 + crow16(i, h)); yb[(size_t)p0 * 512] = y0[i]; yb[(size_t)p1 * 512] = y1[i]; }
      } }
    VM_WAIT(); __syncthreads(); __builtin_amdgcn_fence(__ATOMIC_ACQUIRE, "agent");
    const float* lng = a.in(I_LNXG) + l * 512; const float* lnb = a.in(I_LNXB) + l * 512; const float* rkw = a.in(I_RK) + l * 512;
    const bf16* RW = (const bf16*)(F.ws + WS_RW); const float* YF = (const float*)(F.ws + WS_YF);
    bf16* O = (bf16*)(F.ws + WS_ABR) + (size_t)2 * NT * 512;
    for (int pair = 0; pair < 2; ++pair) { const int bh2 = bi * 2 + pair, b2 = bh2 >> 3, hd2 = bh2 & 7; const int ch = hd2 * 64 + lane;
        const float g_ = lng[ch], b_ = lnb[ch], rk_ = rkw[ch];
        for (int pp = w; pp < LTOT; pp += NWAVES) { const size_t o = ((size_t)b2 * LTOT + pp) * 512 + ch;
            const float s = YF[o] + YF[TS + o]; const float mean = wave_sum(s) * (1.f / 64.f); const float d = s - mean; const float var = wave_sum(d * d) * (1.f / 64.f);
            const float rr = bf2f(RW[o]), kf = bf2f(RW[TS + o]), kb_ = bf2f(RW[2 * TS + o]), vv = bf2f(RW[3 * TS + o]), gg = bf2f(RW[7 * TS + o]);
            const float bonus = wave_sum(rr * (kf + kb_) * rk_);
            const float y = d * rsqrtf(var + 64e-5f) * g_ + b_ + bonus * vv;
            O[o] = f2bf(y * gg); } }
}

constexpr int RT_QP = 72, RT_TP = 136;
constexpr int RT_QS = 0, RT_KS = 128 * RT_QP * 2, RT_KT = 2 * 128 * RT_QP * 2, RT_VT = RT_KT + 64 * RT_TP * 2, RT_ST = RT_VT + 128 * RT_TP * 2;
DI void phase_retention_item(Frame& F, const KA& a, int item) {
    const int b = item >> 2, hh = item & 3, w = F.wave;
    const bf16* P = (const bf16*)(F.ws + WS_P); const float2* rt = (const float2*)(F.ws + WS_ROPE);
    float* OFB = (float*)(F.ws + WS_OF); const size_t TS = (size_t)NT * 512;
    LAS bf16* Qs = (LAS bf16*)(F.lds + RT_QS); LAS bf16* Ks = (LAS bf16*)(F.lds + RT_KS); LAS bf16* KsT = (LAS bf16*)(F.lds + RT_KT); LAS bf16* VsT = (LAS bf16*)(F.lds + RT_VT); LAS bf16* SsT = (LAS bf16*)(F.lds + RT_ST);
    const float lg2g = log2f(1.f - exp2f(-5.f - (float)hh));
    const float gam = exp2f(lg2g), g127 = exp2f(127.f * lg2g), cdec = exp2f(128.f * lg2g);
    const int rb = w >> 1, cbp = w & 1, db = w >> 2, vb = w & 3;
    for (int dir = 0; dir < 2; ++dir) {
        int lane = F.lane; asm volatile("" : "+v"(lane)); const int tid = w * 64 + lane, ql = lane & 31, h = lane >> 5;
        f32x16 Sreg;
#pragma unroll
        for (int i = 0; i < 16; ++i) Sreg[i] = 0.f;
        __syncthreads();
        for (int i = tid; i < 128 * RT_QP / 2; i += NTHREADS) ((LAS unsigned*)SsT)[i] = 0u;
        for (int cn = 0; cn < 34; ++cn) {
            int p0; if (cn < 2) p0 = 128 * (dir ? 1 - cn : cn); else p0 = CTX + 128 * (dir ? 33 - cn : cn - 2);
            const bool lat = p0 >= CTX;
            { int tid_o = tid; asm volatile("" : "+v"(tid_o)); const int tok = tid_o >> 2, c = tid_o & 3; const int e = dir ? 127 - tok : tok; const size_t row = (size_t)b * LTOT + p0 + tok; const bf16* prow = P + row * DINP;
              const float sq = exp2f((float)e * lg2g), sk = 0.125f * exp2f(-(float)e * lg2g);
              const u32x4 ql_ = *(const u32x4*)(prow + PC_RQ + hh * 64 + 8 * c), qh_ = *(const u32x4*)(prow + PC_RQ + hh * 64 + 32 + 8 * c);
              const u32x4 kl_ = *(const u32x4*)(prow + PC_RK + hh * 64 + 8 * c), kh_ = *(const u32x4*)(prow + PC_RK + hh * 64 + 32 + 8 * c);
              float qlo[8] = {bflo(ql_.x), bfhi(ql_.x), bflo(ql_.y), bfhi(ql_.y), bflo(ql_.z), bfhi(ql_.z), bflo(ql_.w), bfhi(ql_.w)}, qhi[8] = {bflo(qh_.x), bfhi(qh_.x), bflo(qh_.y), bfhi(qh_.y), bflo(qh_.z), bfhi(qh_.z), bflo(qh_.w), bfhi(qh_.w)};
              float klo[8] = {bflo(kl_.x), bfhi(kl_.x), bflo(kl_.y), bfhi(kl_.y), bflo(kl_.z), bfhi(kl_.z), bflo(kl_.w), bfhi(kl_.w)}, khi[8] = {bflo(kh_.x), bfhi(kh_.x), bflo(kh_.y), bfhi(kh_.y), bflo(kh_.z), bfhi(kh_.z), bflo(kh_.w), bfhi(kh_.w)};
              if (lat) { const float2* ang = rt + (size_t)(p0 - CTX + tok) * 32 + 8 * c;
#pragma unroll
                  for (int j = 0; j < 8; ++j) { const float2 cs = ang[j]; const float a0 = qlo[j], a1 = qhi[j], b0 = klo[j], b1 = khi[j];
                      qlo[j] = a0 * cs.x - a1 * cs.y; qhi[j] = a0 * cs.y + a1 * cs.x; klo[j] = b0 * cs.x - b1 * cs.y; khi[j] = b0 * cs.y + b1 * cs.x; } }
#pragma unroll
              for (int j = 0; j < 8; ++j) { qlo[j] *= sq; qhi[j] *= sq; klo[j] *= sk; khi[j] *= sk; }
              *(LAS bf16x8*)(Qs + tok * RT_QP + 8 * c) = pack8(qlo); *(LAS bf16x8*)(Qs + tok * RT_QP + 32 + 8 * c) = pack8(qhi);
              *(LAS bf16x8*)(Ks + tok * RT_QP + 8 * c) = pack8(klo); *(LAS bf16x8*)(Ks + tok * RT_QP + 32 + 8 * c) = pack8(khi);
              const int pt = permpos(tok);
#pragma unroll
              for (int j = 0; j < 8; ++j) { KsT[(8 * c + j) * RT_TP + pt] = f2bf(klo[j]); KsT[(32 + 8 * c + j) * RT_TP + pt] = f2bf(khi[j]); }
#pragma unroll
              for (int q4 = 0; q4 < 4; ++q4) { const u32x4 vv = *(const u32x4*)(prow + PC_RV + hh * 128 + 32 * c + 8 * q4); const unsigned vw[4] = {vv.x, vv.y, vv.z, vv.w};
#pragma unroll
                  for (int j = 0; j < 4; ++j) { VsT[(32 * c + 8 * q4 + 2 * j) * RT_TP + pt] = (bf16)(vw[j] & 0xffffu); VsT[(32 * c + 8 * q4 + 2 * j + 1) * RT_TP + pt] = (bf16)(vw[j] >> 16); } } }
            __syncthreads();
            f32x16 o0, o1;
#pragma unroll
            for (int i = 0; i < 16; ++i) { o0[i] = 0.f; o1[i] = 0.f; }
            for (int kb = 0; kb < 4; ++kb) {
                if (dir == 0 ? kb > rb : kb < rb) continue;
                f32x16 x;
#pragma unroll
                for (int i = 0; i < 16; ++i) x[i] = 0.f;
#pragma unroll
                for (int s = 0; s < 4; ++s) x = __builtin_amdgcn_mfma_f32_32x32x16_bf16(*(const LAS bf16x8*)(Ks + (kb * 32 + ql) * RT_QP + 16 * s + 8 * h), *(const LAS bf16x8*)(Qs + (rb * 32 + ql) * RT_QP + 16 * s + 8 * h), x, 0, 0, 0);
                if (kb == rb) {
#pragma unroll
                    for (int i = 0; i < 16; ++i) { const int key = crow16(i, h); const bool keep = dir == 0 ? key <= ql : key >= ql; x[i] = keep ? x[i] : 0.f; } }
                float xv[16];
#pragma unroll
                for (int i = 0; i < 16; ++i) xv[i] = x[i];
                const bf16x8 xa0 = pack8(xv), xa1 = pack8(xv + 8);
                const LAS bf16* v0 = VsT + ((2 * cbp) * 32 + ql) * RT_TP + kb * 32 + 8 * h; const LAS bf16* v1 = VsT + ((2 * cbp + 1) * 32 + ql) * RT_TP + kb * 32 + 8 * h;
                o0 = __builtin_amdgcn_mfma_f32_32x32x16_bf16(xa0, *(const LAS bf16x8*)(v0), o0, 0, 0, 0); o0 = __builtin_amdgcn_mfma_f32_32x32x16_bf16(xa1, *(const LAS bf16x8*)(v0 + 16), o0, 0, 0, 0);
                o1 = __builtin_amdgcn_mfma_f32_32x32x16_bf16(xa0, *(const LAS bf16x8*)(v1), o1, 0, 0, 0); o1 = __builtin_amdgcn_mfma_f32_32x32x16_bf16(xa1, *(const LAS bf16x8*)(v1 + 16), o1, 0, 0, 0);
            }
#pragma unroll
            for (int s = 0; s < 4; ++s) { const bf16x8 qa = *(const LAS bf16x8*)(Qs + (rb * 32 + ql) * RT_QP + 16 * s + 8 * h);
                o0 = __builtin_amdgcn_mfma_f32_32x32x16_bf16(qa, *(const LAS bf16x8*)(SsT + ((2 * cbp) * 32 + ql) * RT_QP + 16 * s + 8 * h), o0, 0, 0, 0);
                o1 = __builtin_amdgcn_mfma_f32_32x32x16_bf16(qa, *(const LAS bf16x8*)(SsT + ((2 * cbp + 1) * 32 + ql) * RT_QP + 16 * s + 8 * h), o1, 0, 0, 0); }
            { float* op = OFB + (size_t)dir * TS + ((size_t)b * LTOT + p0 + rb * 32) * 512 + hh * 128 + (2 * cbp) * 32 + ql;
#pragma unroll
              for (int i = 0; i < 16; ++i) { op[(size_t)crow16(i, h) * 512] = o0[i]; op[(size_t)crow16(i, h) * 512 + 32] = o1[i]; } }
            f32x16 u;
#pragma unroll
            for (int i = 0; i < 16; ++i) u[i] = 0.f;
#pragma unroll
            for (int s = 0; s < 8; ++s) u = __builtin_amdgcn_mfma_f32_32x32x16_bf16(*(const LAS bf16x8*)(KsT + (db * 32 + ql) * RT_TP + 16 * s + 8 * h), *(const LAS bf16x8*)(VsT + (vb * 32 + ql) * RT_TP + 16 * s + 8 * h), u, 0, 0, 0);
#pragma unroll
            for (int i = 0; i < 16; ++i) Sreg[i] = cdec * Sreg[i] + g127 * u[i];
            __syncthreads();
#pragma unroll
            for (int g = 0; g < 4; ++g) { u32x2 x; x.x = pk2(gam * Sreg[4 * g], gam * Sreg[4 * g + 1]); x.y = pk2(gam * Sreg[4 * g + 2], gam * Sreg[4 * g + 3]);
                *(LAS u32x2*)(SsT + (vb * 32 + ql) * RT_QP + db * 32 + 8 * g + 4 * h) = x; }
        }
    }
    VM_WAIT(); __syncthreads(); __builtin_amdgcn_fence(__ATOMIC_ACQUIRE, "agent");
    const int lane = F.lane;
    bf16* O = (bf16*)(F.ws + WS_ABR);
    for (int pp = w; pp < LTOT; pp += NWAVES) { const size_t row = (size_t)b * LTOT + pp; const size_t o = row * 512 + hh * 128 + 2 * lane;
        const f32x2 f = *(const f32x2*)(OFB + o), bk = *(const f32x2*)(OFB + TS + o);
        const float mf = wave_sum(f.x + f.y) * (1.f / 128.f), mb = wave_sum(bk.x + bk.y) * (1.f / 128.f);
        const float f0 = f.x - mf, f1 = f.y - mf, b0 = bk.x - mb, b1 = bk.y - mb;
        const float vf = wave_sum(f0 * f0 + f1 * f1) * (1.f / 128.f), vbk = wave_sum(b0 * b0 + b1 * b1) * (1.f / 128.f);
        const float rf = rsqrtf(vf + 1e-5f), rbk = rsqrtf(vbk + 1e-5f);
        const unsigned gfw = *(const unsigned*)(P + row * DINP + PC_RGF + hh * 128 + 2 * lane), gbw = *(const unsigned*)(P + row * DINP + PC_RGB + hh * 128 + 2 * lane);
        const float gf0 = bflo(gfw), gf1 = bfhi(gfw), gb0 = bflo(gbw), gb1 = bfhi(gbw);
        const float y0 = f0 * rf * (gf0 * sigmoidf_(gf0)) + b0 * rbk * (gb0 * sigmoidf_(gb0)), y1 = f1 * rf * (gf1 * sigmoidf_(gf1)) + b1 * rbk * (gb1 * sigmoidf_(gb1));
        *(unsigned*)(O + o) = pk2(y0, y1); }
}

constexpr int N_PHASES = 2 + 10 * DEPTH;
constexpr int ATT_SPLIT = 256;
__global__ void __launch_bounds__(NTHREADS, 2) fwd_kernel(Args args) {
    extern __shared__ __attribute__((aligned(16))) unsigned char lds_raw[];
    Frame F;
    F.lds = (LAS unsigned char*)lds_raw;
    F.MISC = (volatile LAS unsigned*)(F.lds + LDS_MISC_OFF);
    F.tid = threadIdx.x; F.lane = F.tid & 63; F.wave = __builtin_amdgcn_readfirstlane(F.tid >> 6);
    F.G = gridDim.x; F.bid = blockIdx.x;
    F.ws = args.ws; F.ctl = (unsigned*)(args.ws + WS_CTL);
    if (F.tid < 32) F.MISC[F.tid] = 0u;
    __syncthreads();
    const int lo = args.ph_lo, hi = args.ph_hi;
    KA ka; ka.kp = (const CAS char*)__builtin_amdgcn_kernarg_segment_ptr();
    const bool multi = (hi - lo) > 1;
    XcdBarrier bar; bar.bar = F.ctl + CW_BAR; bar.x = 0; bar.st = nullptr;
    if (multi) bar = xcd_barrier_post(F.ctl + CW_BAR, F.MISC + 8);
#define IN(k) (lo <= (k) && (k) < hi)
#define OPQ() do { int l_; asm volatile("v_mbcnt_lo_u32_b32 %0, -1, 0\n\tv_mbcnt_hi_u32_b32 %0, -1, %0" : "=v"(l_)); { int b_ = F.bid, w_ = F.wave, g_ = F.G; asm volatile("" : "+s"(b_), "+s"(w_), "+s"(g_)); F.bid = b_; F.wave = w_; F.G = g_; } F.lane = l_; F.tid = F.wave * 64 + l_; \
        const CAS char* kp_ = (const CAS char*)__builtin_amdgcn_kernarg_segment_ptr(); asm volatile("" : "+s"(kp_)); ka.kp = kp_; F.ws = ka.ws(); F.ctl = (unsigned*)(F.ws + WS_CTL); } while (0)
#define SEAM(k) do { if (IN(k) && IN((k) + 1)) xcd_barrier(bar); } while (0)

    if (IN(0)) { OPQ(); phase_prologue(F, ka); } SEAM(0);
    if (IN(1)) { OPQ(); phase_init_rows(F, ka); } SEAM(1);

    for (int l = 0; l < DEPTH; ++l) {
        const int pb = 2 + 10 * l;
        if (IN(pb + 0)) { OPQ(); unsigned char* ws = F.ws;
            SchedInproj S; S.T.init(NT / 256, DINP / 256, F.G, F.bid); S.A = (const char*)(ws + WS_H); S.B = (const char*)(ws + WS_WIN + (size_t)l * 15 * MiB);
            EpiStoreBf16 E{(bf16*)(ws + WS_P), DINP};
            pg8::gemm_phase<EpiStoreBf16, SchedInproj, false>(F.lds, 1024, S, E, F.tid);
        }
        SEAM(pb + 0);
        if (IN(pb + 1)) { OPQ(); phase_mla_prep(F, ka, l); phase_rwkv_prep(F, ka, l); }
        SEAM(pb + 1);
#define ATTN_QUEUE(qword, ubeg, uend) do { for (;;) { __syncthreads(); \
            if (F.tid == 0) F.MISC[0] = (unsigned)(ubeg) + __hip_atomic_fetch_add(F.ctl + (qword), 1u, __ATOMIC_RELAXED, __HIP_MEMORY_SCOPE_AGENT); \
            __syncthreads(); const int u = (int)F.MISC[0]; if (u >= (uend)) break; \
            if (u < 1024) attn_unit(F, u >> 7, (u >> 4) & 7, 1 + (u & 15)); else attn_unit(F, (u - 1024) >> 3, (u - 1024) & 7, 0); } } while (0)
        const int nunits = (l == DEPTH - 1) ? 1024 : 1088;
        if (IN(pb + 2)) { OPQ();
            if (F.bid < 32) phase_retention_item(F, ka, F.bid);
            else { for (int cid = F.bid - 32; cid < NCHAIN * NCHUNK; cid += F.G - 32) rwkv_chunk_item(F, cid); }
            ATTN_QUEUE(CW_Q + l * 64, 0, ATT_SPLIT);
        }
        SEAM(pb + 2);
        if (IN(pb + 3)) { OPQ();
            if (F.bid < 32) rwkv_scan_block(F, ka, l, F.bid);
            ATTN_QUEUE(CW_Q + l * 64 + 32, ATT_SPLIT, nunits);
        }
        SEAM(pb + 3);
        if (IN(pb + 4)) { OPQ(); unsigned char* ws = F.ws;
            SchedMerge S; S.T.init(NT / 256, 4, F.G, F.bid); S.A = (const char*)(ws + WS_ABR); S.B = (const char*)(ws + WS_WBR + (size_t)l * 3 * MiB);
            EpiMerge E{(const bf16*)(ws + WS_P), (bf16*)(ws + WS_MRG)};
            pg8::gemm_phase<EpiMerge, SchedMerge, false>(F.lds, 512, S, E, F.tid);
        }
        SEAM(pb + 4);
        if (IN(pb + 5)) { OPQ(); unsigned char* ws = F.ws;
            SchedPlain S; S.T.init(NT / 256, 4, F.G, F.bid); S.A = (const char*)(ws + WS_MRG); S.B = (const char*)(ws + WS_WOUT + (size_t)l * 2 * MiB); S.K = 1024;
            EpiResid E{(float*)(ws + WS_X), (const float*)(ws + WS_MOD) + (size_t)l * 9 * 6144};
            pg8::gemm_phase<EpiResid, SchedPlain, false>(F.lds, 1024, S, E, F.tid);
        }
        SEAM(pb + 5);
        if (IN(pb + 6)) { OPQ(); phase_router(F, ka, l); }
        SEAM(pb + 6);
        if (IN(pb + 7)) { OPQ(); unsigned char* ws = F.ws;
            moe_build_table(F, F.ctl + CW_CNT + l * 32 * 16);
            SchedMoe S{(const LAS int*)(F.lds + LDS_TAB_OFF), (const char*)(ws + WS_H), (const char*)(ws + WS_WGU + (size_t)l * 128 * MiB), (const int*)(ws + WS_LIST), 8, F.bid, F.G, 0, (size_t)2048 * 1024 * 2, true};
            EpiSwiglu E{(bf16*)(ws + WS_ACT), ka.in(I_BGU) + (size_t)l * 32 * 2048};
            pg8::gemm_phase<EpiSwiglu, SchedMoe, true>(F.lds, 1024, S, E, F.tid);
        }
        SEAM(pb + 7);
        if (IN(pb + 8)) { OPQ(); unsigned char* ws = F.ws;
            moe_build_table(F, F.ctl + CW_CNT + l * 32 * 16);
            SchedMoe S{(const LAS int*)(F.lds + LDS_TAB_OFF), (const char*)(ws + WS_ACT), (const char*)(ws + WS_WDN + (size_t)l * 64 * MiB), (const int*)(ws + WS_LIST), 4, F.bid, F.G, 0, (size_t)1024 * 1024 * 2, false};
            EpiDown E{(bf16*)(ws + WS_Y), ka.in(I_BDOWN) + (size_t)l * 32 * 1024};
            pg8::gemm_phase<EpiDown, SchedMoe, false>(F.lds, 1024, S, E, F.tid);
        }
        SEAM(pb + 8);
        if (IN(pb + 9)) { OPQ(); phase_combine(F, ka, l); }
        SEAM(pb + 9);
    }
#undef IN
#undef SEAM
}

extern "C" void kernel_launch(void* const* d_in, const int* in_sizes, int n_in, void* d_out, int out_size, void* d_ws, size_t ws_size, hipStream_t stream) {
    static int grid = 0;
    if (grid == 0) {
        if (n_in != N_IN || ws_size < WS_END) { fprintf(stderr, "kernel_launch: unexpected n_in %d or ws_size %zu (need %zu)\n", n_in, ws_size, (size_t)WS_END); grid = -1; return; }
        int dev = 0, cus = 0, per_cu = 0;
        hipGetDevice(&dev); hipDeviceGetAttribute(&cus, hipDeviceAttributeMultiprocessorCount, dev);
        if (hipFuncSetAttribute((const void*)fwd_kernel, hipFuncAttributeMaxDynamicSharedMemorySize, LDS_BYTES) != hipSuccess) { fprintf(stderr, "kernel_launch: hipFuncSetAttribute failed\n"); grid = -1; return; }
        if (hipOccupancyMaxActiveBlocksPerMultiprocessor(&per_cu, (const void*)fwd_kernel, NTHREADS, LDS_BYTES) != hipSuccess || per_cu < 1) { fprintf(stderr, "kernel_launch: occupancy query says %d\n", per_cu); }
        (void)hipGetLastError();
        grid = cus > 0 ? cus : 256;
        if (grid > 256) grid = 256;
    }
    if (grid < 0) return;
    (void)in_sizes; (void)out_size;
    hipMemsetAsync((char*)d_ws + WS_CTL, 0, CTL_ZERO_BYTES, stream);
    Args a{};
    for (int i = 0; i < N_IN; ++i) a.in[i] = (const float*)d_in[i];
    a.out = (float*)d_out; a.ws = (unsigned char*)d_ws;
#if MK_ONE_LAUNCH
    a.ph_lo = 0; a.ph_hi = N_PHASES;
    hipLaunchKernelGGL(fwd_kernel, dim3(grid), dim3(NTHREADS), LDS_BYTES, stream, a);
#else
    for (int ph = 0; ph < N_PHASES; ++ph) { a.ph_lo = ph; a.ph_hi = ph + 1; hipLaunchKernelGGL(fwd_kernel, dim3(grid), dim3(NTHREADS), LDS_BYTES, stream, a); }
#endif
    hipError_t le = hipGetLastError();
    if (le != hipSuccess) fprintf(stderr, "kernel_launch: launch failed: %s\n", hipGetErrorName(le));
}
```

```cpp
#include <hip/hip_runtime.h>
#include <cstdio>
#include <cstdint>

#ifndef MK_ONE_LAUNCH
#define MK_ONE_LAUNCH 1
#endif

#define GAS __attribute__((address_space(1)))
#define LAS __attribute__((address_space(3)))
typedef unsigned short bf16;
typedef short bf16x8 __attribute__((ext_vector_type(8)));
typedef float f32x2 __attribute__((ext_vector_type(2)));
typedef float f32x4 __attribute__((ext_vector_type(4)));
typedef float f32x16 __attribute__((ext_vector_type(16)));
typedef unsigned u32x2 __attribute__((ext_vector_type(2)));
typedef unsigned u32x4 __attribute__((ext_vector_type(4)));
typedef __bf16 bf16v2 __attribute__((ext_vector_type(2)));
#define DI __device__ __forceinline__

constexpr int D = 1024, BATCH = 8, SEQ = 4096, CTX = 256, LTOT = SEQ + CTX  , NT = BATCH * LTOT  , DEPTH = 4;
constexpr int DIN = 7456, DINP = 7680;
constexpr int NEXP = 32, TOPK = 4, DEXP = 1024;
constexpr int NSLOT = NT * TOPK + NEXP * 256;
constexpr int PC_RQ = 0, PC_RK = 256, PC_RV = 512, PC_RGF = 1024, PC_RGB = 1536, PC_MQ = 2048, PC_MKV = 2304, PC_MPE = 2432,
              PC_RW = 2464, PC_WR = 2464, PC_WK = 2976, PC_WV = 3488, PC_WHF = 4000, PC_WHB = 4064, PC_AHF = 4128, PC_AHB = 4192, PC_GH = 4256, PC_GATE = 4384;
enum { I_X = 0, I_C, I_CTX, I_CCTX, I_ADAW, I_ADAB, I_N1G, I_N2G, I_WIN, I_MQNG, I_WUQ, I_MKVNG, I_WUKV, I_QKQG, I_QKKG, I_MUP, I_MUN, I_W0, I_W2, I_A0, I_A2, I_G2,
       I_KK, I_KA, I_RK, I_LNXG, I_LNXB, I_BRRET, I_BRMLA, I_BRRWKV, I_WOUT, I_WROUTER, I_BROUTER, I_WGU, I_BGU, I_WDOWN, I_BDOWN, N_IN };

constexpr size_t MiB = 1u << 20;
constexpr size_t WS_CTL = 0, CTL_ZERO_BYTES = 1 * MiB;
constexpr size_t WS_MOD = 1 * MiB;
constexpr size_t WS_ROPE = 2 * MiB;
constexpr size_t WS_ROPE_AX = 3 * MiB;
constexpr size_t WS_SMALLW = 4 * MiB;
constexpr size_t SW_UQ = 0, SW_UKV = 393216, SW_W2 = 655360, SW_A2 = 786432, SW_G2 = 917504;
constexpr size_t WS_WBR = 8 * MiB;
constexpr size_t WS_WOUT = 20 * MiB;
constexpr size_t WS_WIN = 28 * MiB;
constexpr size_t WS_WGU = 88 * MiB;
constexpr size_t WS_WDN = 600 * MiB;
constexpr size_t WS_X = 856 * MiB;
constexpr size_t WS_H = 992 * MiB;
constexpr size_t WS_P = 1062 * MiB;
constexpr size_t WS_QB = 1572 * MiB;
constexpr size_t WS_KB = 1623 * MiB;
constexpr size_t WS_VT = 1674 * MiB;
constexpr size_t WS_RW = 1708 * MiB;
constexpr size_t RW_STRIDE = (size_t)NT * 512 * 2;
constexpr size_t WS_LW = 1980 * MiB;
constexpr size_t WS_YF = 2116 * MiB;
constexpr size_t WS_OF = 2252 * MiB;
constexpr size_t WS_ABR = 2388 * MiB;
constexpr size_t WS_MRG = 2490 * MiB;
constexpr size_t WS_TOPK = 2558 * MiB;
constexpr size_t WS_LIST = 2560 * MiB;
constexpr size_t WS_ACT = 2565 * MiB;
constexpr size_t WS_Y = 2853 * MiB;
constexpr size_t WS_END = 3141 * MiB;
constexpr int CW_TMO = 0, CW_BAR = 4096, CW_CNT = 8192  , CW_Q = 12288  ;

DI unsigned pk2(float lo, float hi) { f32x2 v = {lo, hi}; bf16v2 r = __builtin_convertvector(v, bf16v2); return __builtin_bit_cast(unsigned, r); }
DI bf16 f2bf(float f) { return (bf16)(pk2(f, 0.f) & 0xffffu); }
DI float bf2f(unsigned short b) { return __uint_as_float(((unsigned)b) << 16); }
DI float bflo(unsigned w) { return __uint_as_float(w << 16); }
DI float bfhi(unsigned w) { return __uint_as_float(w & 0xffff0000u); }
DI int fresh_lane() { int l_; asm volatile("v_mbcnt_lo_u32_b32 %0, -1, 0\n\tv_mbcnt_hi_u32_b32 %0, -1, %0" : "=v"(l_)); return l_; }
DI bf16x8 pack8(const float* v) { u32x4 x; x.x = pk2(v[0], v[1]); x.y = pk2(v[2], v[3]); x.z = pk2(v[4], v[5]); x.w = pk2(v[6], v[7]); return __builtin_bit_cast(bf16x8, x); }
DI float sx(float v, int mask) { const int l = fresh_lane(); return __int_as_float(__builtin_amdgcn_ds_bpermute((l ^ mask) << 2, __float_as_int(v))); }
DI float sup(float v, int d) { const int l = fresh_lane(); return __int_as_float(__builtin_amdgcn_ds_bpermute((l - d) << 2, __float_as_int(v))); }
DI float dpp_scan64(float x) {
    float t;
    t = __int_as_float(__builtin_amdgcn_update_dpp(0, __float_as_int(x), 0x111, 0xf, 0xf, false)); x += t;
    t = __int_as_float(__builtin_amdgcn_update_dpp(0, __float_as_int(x), 0x112, 0xf, 0xf, false)); x += t;
    t = __int_as_float(__builtin_amdgcn_update_dpp(0, __float_as_int(x), 0x114, 0xf, 0xf, false)); x += t;
    t = __int_as_float(__builtin_amdgcn_update_dpp(0, __float_as_int(x), 0x118, 0xf, 0xf, false)); x += t;
    t = __int_as_float(__builtin_amdgcn_update_dpp(0, __float_as_int(x), 0x142, 0xa, 0xf, false)); x += t;
    t = __int_as_float(__builtin_amdgcn_update_dpp(0, __float_as_int(x), 0x143, 0xc, 0xf, false)); x += t;
    return x;
}
DI float wave_sum(float v) {
#pragma unroll
    for (int o = 1; o < 64; o <<= 1) v += sx(v, o);
    return v;
}
DI void unpack8(const u32x4& w, float* o) { o[0] = bflo(w.x); o[1] = bfhi(w.x); o[2] = bflo(w.y); o[3] = bfhi(w.y); o[4] = bflo(w.z); o[5] = bfhi(w.z); o[6] = bflo(w.w); o[7] = bfhi(w.w); }
DI f32x16 zero16() { f32x16 z; for (int i = 0; i < 16; ++i) z[i] = 0.f; return z; }
DI float sigmoidf_(float x) { return __builtin_amdgcn_rcpf(1.f + __expf(-x)); }
#define LDS_WAIT() asm volatile("s_waitcnt lgkmcnt(0)" ::: "memory")
#define VM_WAIT() asm volatile("s_waitcnt vmcnt(0)" ::: "memory")
#define LDS_BARRIER() do { asm volatile("s_waitcnt lgkmcnt(0)" ::: "memory"); __builtin_amdgcn_s_barrier(); asm volatile("" ::: "memory"); } while (0)

#define XB_TMO      128
#define XB_XCNT(j)  (256  + 64 * (j))
#define XB_XSUB(j)  (1280 + 64 * (j))
#define XB_XGEN(j)  (2304 + 64 * (j))
#define XB_TOP      3328
#define XB_TOPGEN   3392
#define XCD_BAR_WORDS 3456
#define XB_SPIN_CAP (1u << 22)

__device__ __forceinline__ unsigned xb_ld(unsigned* p)              { return __hip_atomic_load(p, __ATOMIC_RELAXED, __HIP_MEMORY_SCOPE_AGENT); }
__device__ __forceinline__ unsigned xb_add(unsigned* p, unsigned v) { return __hip_atomic_fetch_add(p, v, __ATOMIC_RELAXED, __HIP_MEMORY_SCOPE_AGENT); }
__device__ __forceinline__ unsigned xb_xcc_id() { return (unsigned)__builtin_amdgcn_s_getreg((3 << 11) | 20) & 0xFu; }
#define XB_SPIN(cond, bar) do { unsigned _sp = 0; while (cond) { __builtin_amdgcn_s_sleep(1); \
    if ((++_sp & 255u) == 0u) { if (xb_ld(&(bar)[XB_TMO])) break; if (_sp > XB_SPIN_CAP) { atomicAdd(&(bar)[XB_TMO], 1u); break; } } } } while (0)

struct XcdBarrier { unsigned* bar; unsigned x; volatile LAS unsigned* st; };

__device__ __forceinline__ XcdBarrier xcd_barrier_post(unsigned* bar, volatile LAS unsigned* st) {
    XcdBarrier b; b.bar = bar; b.x = xb_xcc_id(); b.st = st;
    if (threadIdx.x == 0) (void)xb_add(&bar[XB_XCNT(b.x)], 1u);
    return b;
}
__device__ __forceinline__ void xcd_barrier_complete(unsigned* bar, unsigned x, unsigned& nloc, unsigned& nx) {
    const unsigned G = gridDim.x * gridDim.y * gridDim.z;
    unsigned sum, cnt, mine, sp = 0u;
    for (;;) {
        sum = 0u; cnt = 0u; mine = 0u;
#pragma unroll
        for (unsigned j = 0; j < 16; ++j) { const unsigned c = xb_ld(&bar[XB_XCNT(j)]); sum += c; cnt += (c > 0u) ? 1u : 0u; mine = (j == x) ? c : mine; }
        if (sum == G) break;
        __builtin_amdgcn_s_sleep(1);
        if ((++sp & 255u) == 0u) { if (xb_ld(&bar[XB_TMO])) break; if (sp > XB_SPIN_CAP) { atomicAdd(&bar[XB_TMO], 1u); break; } }
    }
    nloc = mine > 0u ? mine : 1u; nx = cnt > 0u ? cnt : 1u;
}
__device__ __forceinline__ void xcd_barrier(const XcdBarrier& b) {
    asm volatile("s_waitcnt vmcnt(0)" ::: "memory");
    __syncthreads();
    if (threadIdx.x == 0) {
        unsigned* bar = b.bar;
        __builtin_amdgcn_s_waitcnt(0);
        unsigned nloc = b.st[0], nx = b.st[1];
        if (nloc == 0u) { xcd_barrier_complete(bar, b.x, nloc, nx); b.st[0] = nloc; b.st[1] = nx; }
        const unsigned old = xb_add(&bar[XB_XSUB(b.x)], 1u);
        const unsigned gen = old / nloc;
        if (old + 1u == (gen + 1u) * nloc) {
            __builtin_amdgcn_fence(__ATOMIC_RELEASE, "agent");
            asm volatile("s_waitcnt vmcnt(0)" ::: "memory");
            const unsigned og = xb_add(&bar[XB_TOP], 1u);
            const unsigned tg = og / nx;
            if (og + 1u == (tg + 1u) * nx) xb_add(&bar[XB_TOPGEN], 1u);
            else XB_SPIN(xb_ld(&bar[XB_TOPGEN]) == tg, bar);
            __builtin_amdgcn_fence(__ATOMIC_ACQUIRE, "agent");
            xb_add(&bar[XB_XGEN(b.x)], 1u);
            asm volatile("s_waitcnt vmcnt(0)" ::: "memory");
        } else {
            XB_SPIN(xb_ld(&bar[XB_XGEN(b.x)]) == gen, bar);
            __builtin_amdgcn_fence(__ATOMIC_ACQUIRE, "agent");
            asm volatile("s_waitcnt vmcnt(0)" ::: "memory");
        }
    }
    __syncthreads();
}

namespace pg8 {
constexpr int BM = 256, BK = 64, HALF = 128, HTB = HALF * BK * 2, STAGE_BYTES = 8 * HTB;
__host__ __device__ __forceinline__ int lds_byte(int r, int c) { const int st = (r >> 4) * 2 + (c >> 5), rr = r & 15, cc = c & 31, ob = rr * 64 + cc * 2; return st * 1024 + (ob ^ (((ob >> 9) & 1) << 5)); }
__host__ __device__ __forceinline__ void stage_rc(int b, int& R, int& C) { const int st = b / 1024, sb = b % 1024, swz = sb ^ (((sb >> 9) & 1) << 5); R = (st >> 1) * 16 + swz / 64; C = (st & 1) * 32 + (swz % 64) / 2; }
__host__ __device__ __forceinline__ int perm32(int rho) { const int n = rho >> 4, i = rho & 15; return 8 * (i >> 2) + 4 * n + (i & 3); }

struct Unit { const char* pa; const char* pb; int x, y, z; };

struct TileOrder {
    int nM, nN, nwg, G, c;
    DI void init(int nM_, int nN_, int G_, int c_) { nM = nM_; nN = nN_; nwg = nM * nN; G = G_; c = c_; }
    DI bool tile(int i, int& pm, int& pn) const {
        const long L = (long)i * G + c; if (L >= nwg) return false;
        int wgid = (int)L; { const int q = nwg / 8, r = nwg % 8, xcd = wgid % 8, off = wgid / 8; wgid = (xcd < r ? xcd * (q + 1) : r * (q + 1) + (xcd - r) * q) + off; }
        const int nig = 8 * nN, gid = wgid / nig, fm = gid * 8, gsz = (nM - fm) < 8 ? (nM - fm) : 8;
        pm = fm + ((wgid % nig) % gsz); pn = (wgid % nig) / gsz; return true;
    }
};

DI unsigned cvt_pk_bf16(float lo, float hi) { return pk2(lo, hi); }

template <class Epi, class Sched, bool GATHER>
__device__ __forceinline__ void gemm_phase(LAS unsigned char* lds, const int K, const Sched& S, const Epi& E, const int tid) {
    const int wid = __builtin_amdgcn_readfirstlane(tid >> 6), lane = tid & 63, wr = wid >> 2, wc = wid & 3, fr = lane & 15, fq = lane >> 4;
    const int nt = K / BK;
    unsigned voffA[2], voffB[2]; int stR[2];
#pragma unroll
    for (int i = 0; i < 2; ++i) { int R, C; stage_rc(tid * 16 + i * 8192, R, C); const int Rb = Epi::PERM ? ((R & ~31) + perm32(R & 31)) : R;
        voffA[i] = GATHER ? (unsigned)(C * 2) : (unsigned)(R * K + C) * 2u; voffB[i] = (unsigned)(Rb * K + C) * 2u; stR[i] = R; }
    const size_t kstep = (size_t)(BK * 2);
    const size_t hstep = (size_t)HALF * K * 2;
    const unsigned ldsw = (unsigned)wid * 1024u;
    const int aoff = lds_byte(wr * 64 + fr, fq * 8), boff = lds_byte(wc * 32 + fr, fq * 8);
#define PG8_SA(b, h) (((b) * 2 + (h)) * HTB)
#define PG8_SB(b, h) ((4 + (b) * 2 + (h)) * HTB)
#define PG8_STAGE(bufoff, gbase, voff) do { _Pragma("unroll") for (int _i = 0; _i < 2; ++_i) \
        __builtin_amdgcn_global_load_lds((const unsigned*)((const char*)(gbase) + (voff)[_i]), (LAS unsigned*)(lds + (bufoff) + ldsw + _i * 8192), 16, 0, 0); } while (0)
#define PG8_STAGE_A(bufoff, gbase, h, rw) do { if constexpr (GATHER) { _Pragma("unroll") for (int _i = 0; _i < 2; ++_i) { \
            const unsigned _row = ((rw)[h] >> (16 * _i)) & 0xffffu; \
            __builtin_amdgcn_global_load_lds((const unsigned*)((const char*)(gbase) + (size_t)_row * (size_t)(K * 2) + voffA[_i]), (LAS unsigned*)(lds + (bufoff) + ldsw + _i * 8192), 16, 0, 0); } } \
        else { PG8_STAGE(bufoff, (const char*)(gbase) + (h) * hstep, voffA); } } while (0)
#define PG8_LDA(dst, b, h) do { _Pragma("unroll") for (int m = 0; m < 4; ++m) _Pragma("unroll") for (int k = 0; k < 2; ++k) dst[m][k] = *(const LAS bf16x8*)(lds + PG8_SA(b, h) + aoff + m * 2048 + k * 1024); } while (0)
#define PG8_LDB(dst, b, h) do { _Pragma("unroll") for (int n = 0; n < 2; ++n) _Pragma("unroll") for (int k = 0; k < 2; ++k) dst[n][k] = *(const LAS bf16x8*)(lds + PG8_SB(b, h) + boff + n * 2048 + k * 1024); } while (0)
#define PG8_MMA(ai, bj, At, Bt) do { __builtin_amdgcn_s_setprio(1); _Pragma("unroll") for (int m = 0; m < 4; ++m) _Pragma("unroll") for (int n = 0; n < 2; ++n) _Pragma("unroll") for (int k = 0; k < 2; ++k) \
        acc[ai][bj][m][n] = __builtin_amdgcn_mfma_f32_16x16x32_bf16(Bt[n][k], At[m][k], acc[ai][bj][m][n], 0, 0, 0); __builtin_amdgcn_s_setprio(0); } while (0)
#define PG8_WAIT_V(n) asm volatile("s_waitcnt vmcnt(" #n ")" ::: "memory")
#define PG8_WAIT_L(n) asm volatile("s_waitcnt lgkmcnt(" #n ")" ::: "memory")
#define PG8_BAR __builtin_amdgcn_s_barrier()
#define PG8_SCHED __builtin_amdgcn_sched_barrier(0)
    Unit cur, nxt; int ui = 0;
    if (!S.next(0, cur)) return;
    f32x4 acc[2][2][4][2];
#pragma unroll
    for (int a = 0; a < 2; ++a)
#pragma unroll
        for (int b = 0; b < 2; ++b)
#pragma unroll
            for (int m = 0; m < 4; ++m)
#pragma unroll
                for (int n = 0; n < 2; ++n) acc[a][b][m][n] = (f32x4){0.f, 0.f, 0.f, 0.f};
    bf16x8 At[4][2], B0[2][2], B1[2][2];
    const char* cA = cur.pa; const char* cB = cur.pb;
    unsigned rwc[2] = {0u, 0u}, rwn[2] = {0u, 0u};
    if constexpr (GATHER) S.rows(cur, stR[0], stR[1], rwc);
    PG8_STAGE(PG8_SB(0, 0), cB, voffB); PG8_STAGE(PG8_SB(0, 1), cB + hstep, voffB); PG8_STAGE_A(PG8_SA(0, 0), cA, 0, rwc); PG8_STAGE_A(PG8_SA(0, 1), cA, 1, rwc);
    if (wr == 1) PG8_BAR;
    PG8_WAIT_V(2); PG8_BAR;
    PG8_STAGE(PG8_SB(1, 0), cB + kstep, voffB); PG8_STAGE_A(PG8_SA(1, 0), cA + kstep, 0, rwc); PG8_STAGE(PG8_SB(1, 1), cB + hstep + kstep, voffB);
    PG8_WAIT_V(6); PG8_BAR;
    for (;;) {
        const bool has_next = S.next(ui + 1, nxt);
        const char* nA = has_next ? nxt.pa : cA; const char* nB = has_next ? nxt.pb : cB;
        if constexpr (GATHER) { if (has_next) S.rows(nxt, stR[0], stR[1], rwn); else { rwn[0] = rwc[0]; rwn[1] = rwc[1]; } }
        for (int t = 0; t < nt; t += 2) {
            const bool last = (t == nt - 2);
            const char* a1 = cA + (size_t)(t + 1) * kstep;
            const char* a2 = last ? nA : cA + (size_t)(t + 2) * kstep; const char* b2 = last ? nB : cB + (size_t)(t + 2) * kstep;
            const char* a3 = a2 + kstep; const char* b3 = b2 + kstep;
            unsigned rw2[2]; rw2[0] = last ? rwn[0] : rwc[0]; rw2[1] = last ? rwn[1] : rwc[1];
            PG8_LDB(B0, 0, 0); PG8_LDB(B1, 0, 1); PG8_SCHED; PG8_LDA(At, 0, 0); PG8_STAGE_A(PG8_SA(1, 1), a1, 1, rwc);
            PG8_WAIT_V(8); PG8_WAIT_L(0); PG8_BAR; PG8_MMA(0, 0, At, B0); PG8_MMA(0, 1, At, B1); PG8_BAR; PG8_SCHED;
            PG8_LDA(At, 0, 1); PG8_STAGE(PG8_SB(0, 0), b2, voffB); PG8_STAGE(PG8_SB(0, 1), b2 + hstep, voffB); PG8_STAGE_A(PG8_SA(0, 0), a2, 0, rw2);
            PG8_WAIT_V(8); PG8_WAIT_L(0); PG8_BAR; PG8_MMA(1, 0, At, B0); PG8_MMA(1, 1, At, B1); PG8_BAR; PG8_SCHED;
            PG8_LDB(B0, 1, 0); PG8_LDB(B1, 1, 1); PG8_SCHED; PG8_LDA(At, 1, 0); PG8_STAGE_A(PG8_SA(0, 1), a2, 1, rw2);
            PG8_WAIT_V(8); PG8_WAIT_L(0); PG8_BAR; PG8_MMA(0, 0, At, B0); PG8_MMA(0, 1, At, B1); PG8_BAR; PG8_SCHED;
            PG8_LDA(At, 1, 1); PG8_STAGE(PG8_SB(1, 0), b3, voffB); PG8_STAGE(PG8_SB(1, 1), b3 + hstep, voffB); PG8_STAGE_A(PG8_SA(1, 0), a3, 0, rw2);
            PG8_WAIT_V(8); PG8_WAIT_L(0); PG8_BAR; PG8_MMA(1, 0, At, B0); PG8_MMA(1, 1, At, B1); PG8_BAR; PG8_SCHED;
        }
        if (wr == 0) PG8_BAR;
        { int l2_; asm volatile("v_mbcnt_lo_u32_b32 %0, -1, 0\n\tv_mbcnt_hi_u32_b32 %0, -1, %0" : "=v"(l2_));
          E(acc, cur, wr, wc, l2_ & 15, l2_ >> 4); }
        if (!has_next) break;
        cur = nxt; cA = nA; cB = nB; ++ui;
        if constexpr (GATHER) { rwc[0] = rwn[0]; rwc[1] = rwn[1]; }
        if (wr == 1) PG8_BAR;
    }
    PG8_WAIT_V(0);
    PG8_BAR;
#undef PG8_SA
#undef PG8_SB
#undef PG8_STAGE
#undef PG8_STAGE_A
#undef PG8_LDA
#undef PG8_LDB
#undef PG8_MMA
#undef PG8_WAIT_V
#undef PG8_WAIT_L
#undef PG8_BAR
#undef PG8_SCHED
}
#define ACC_ZERO(acc) do { _Pragma("unroll") for (int a_ = 0; a_ < 2; ++a_) _Pragma("unroll") for (int b_ = 0; b_ < 2; ++b_) _Pragma("unroll") for (int m_ = 0; m_ < 4; ++m_) _Pragma("unroll") for (int n_ = 0; n_ < 2; ++n_) \
        acc[a_][b_][m_][n_] = (f32x4){0.f, 0.f, 0.f, 0.f}; } while (0)
}

constexpr int NWAVES = 8, NTHREADS = 512;
constexpr int RING_BYTES = 131072;
constexpr int LDS_TAB_OFF = RING_BYTES;
constexpr int LDS_MISC_OFF = RING_BYTES + 8192;
constexpr int LDS_BYTES = 147456;

struct Args { const float* in[N_IN]; float* out; unsigned char* ws; int ph_lo, ph_hi; };

#define CAS __attribute__((address_space(4)))
struct KA { const CAS char* kp;
    DI const float* in(int i) const { return *(const float* const CAS*)(kp + 8 * i); }
    DI float* out() const { return *(float* const CAS*)(kp + 8 * N_IN); }
    DI unsigned char* ws() const { return *(unsigned char* const CAS*)(kp + 8 * N_IN + 8); } };
struct Frame {
    LAS unsigned char* lds;
    volatile LAS unsigned* MISC;
    unsigned* ctl;
    unsigned char* ws;
    int tid, lane, wave, G, bid;
};

DI int row_modrow(int r) { const int b = r / LTOT, p = r - b * LTOT; return p < CTX ? 8 : b; }

struct SchedInproj {
    pg8::TileOrder T; const char* A; const char* B;
    DI bool next(int i, pg8::Unit& u) const { int pm, pn; if (!T.tile(i, pm, pn)) return false; u.pa = A + (size_t)pm * (256 * 1024 * 2); u.pb = B + (size_t)pn * (256 * 1024 * 2); u.x = pm; u.y = pn; u.z = 0; return true; }
};
struct EpiStoreBf16 {
    static constexpr bool PERM = true;
    bf16* O; int ldc;
    DI void operator()(f32x4 (&acc)[2][2][4][2], const pg8::Unit& u, int wr, int wc, int fr, int fq) const {
        const int row0 = u.x * 256 + wr * 64 + fr, col0 = u.y * 256 + wc * 32 + 8 * fq;
#pragma unroll
        for (int ai = 0; ai < 2; ++ai)
#pragma unroll
            for (int m = 0; m < 4; ++m) { bf16* rowp = O + (size_t)(row0 + ai * 128 + m * 16) * ldc + col0;
#pragma unroll
                for (int bj = 0; bj < 2; ++bj) { const f32x4 v0 = acc[ai][bj][m][0], v1 = acc[ai][bj][m][1];
                    u32x4 w; w.x = pk2(v0[0], v0[1]); w.y = pk2(v0[2], v0[3]); w.z = pk2(v1[0], v1[1]); w.w = pk2(v1[2], v1[3]);
                    *(u32x4*)(rowp + bj * 128) = w; } }
        ACC_ZERO(acc);
    }
};
struct SchedMerge {
    pg8::TileOrder T; const char* A; const char* B;
    DI bool next(int i, pg8::Unit& u) const { const int ti = i / 3, br = i - ti * 3; int pm, pn; if (!T.tile(ti, pm, pn)) return false;
        u.pa = A + (size_t)br * ((size_t)NT * 512 * 2) + (size_t)pm * (256 * 512 * 2); u.pb = B + (size_t)br * (1024 * 512 * 2) + (size_t)pn * (256 * 512 * 2); u.x = pm; u.y = pn; u.z = br; return true; }
};
struct EpiMerge {
    static constexpr bool PERM = true;
    const bf16* P; bf16* O;
    DI void operator()(f32x4 (&acc)[2][2][4][2], const pg8::Unit& u, int wr, int wc, int fr, int fq) const {
        const int row0 = u.x * 256 + wr * 64 + fr, col0 = u.y * 256 + wc * 32 + 8 * fq, br = u.z;
#pragma unroll
        for (int ai = 0; ai < 2; ++ai)
#pragma unroll
            for (int m = 0; m < 4; ++m) { const size_t row = (size_t)(row0 + ai * 128 + m * 16);
#pragma unroll
                for (int bj = 0; bj < 2; ++bj) {
                    const bf16* gp = P + row * DINP + PC_GATE + br * 1024 + col0 + bj * 128;
                    const u32x4 gc = *(const u32x4*)gp;
                    float lc[8] = {bflo(gc.x), bfhi(gc.x), bflo(gc.y), bfhi(gc.y), bflo(gc.z), bfhi(gc.z), bflo(gc.w), bfhi(gc.w)};
                    float f[8];
                    if (br < 2) { const u32x4 gn = *(const u32x4*)(gp + 1024);
                        float ln[8] = {bflo(gn.x), bfhi(gn.x), bflo(gn.y), bfhi(gn.y), bflo(gn.z), bfhi(gn.z), bflo(gn.w), bfhi(gn.w)};
#pragma unroll
                        for (int j = 0; j < 8; ++j) { const float a = fminf(fmaxf(lc[j], -30.f), 30.f), b = fminf(fmaxf(ln[j], -30.f), 30.f); f[j] = (1.f + __expf(-b)) * __builtin_amdgcn_rcpf(1.f + __expf(-a)); }
                    } else {
#pragma unroll
                        for (int j = 0; j < 8; ++j) { const float a = fminf(fmaxf(lc[j], -30.f), 30.f); f[j] = __builtin_amdgcn_rcpf(1.f + __expf(-a)); }
                    }
                    f32x4 v0 = acc[ai][bj][m][0], v1 = acc[ai][bj][m][1];
                    v0[0] *= f[0]; v0[1] *= f[1]; v0[2] *= f[2]; v0[3] *= f[3]; v1[0] *= f[4]; v1[1] *= f[5]; v1[2] *= f[6]; v1[3] *= f[7];
                    if (br == 2) { u32x4 w; w.x = pk2(v0[0], v0[1]); w.y = pk2(v0[2], v0[3]); w.z = pk2(v1[0], v1[1]); w.w = pk2(v1[2], v1[3]);
                        *(u32x4*)(O + row * 1024 + col0 + bj * 128) = w; v0 = (f32x4){0.f, 0.f, 0.f, 0.f}; v1 = v0; }
                    acc[ai][bj][m][0] = v0; acc[ai][bj][m][1] = v1; } }
    }
};
struct SchedPlain {
    pg8::TileOrder T; const char* A; const char* B; int K;
    DI bool next(int i, pg8::Unit& u) const { int pm, pn; if (!T.tile(i, pm, pn)) return false; u.pa = A + (size_t)pm * ((size_t)256 * K * 2); u.pb = B + (size_t)pn * ((size_t)256 * K * 2); u.x = pm; u.y = pn; u.z = 0; return true; }
};
struct EpiResid {
    static constexpr bool PERM = false;
    float* X; const float* mod;
    DI void operator()(f32x4 (&acc)[2][2][4][2], const pg8::Unit& u, int wr, int wc, int fr, int fq) const {
        const int row0 = u.x * 256 + wr * 64 + fr, col0 = u.y * 256 + wc * 32 + 4 * fq;
        const float* g1 = mod + (size_t)row_modrow(u.x * 256) * 6144 + 2048 + col0;
        f32x4 gv[2][2];
#pragma unroll
        for (int bj = 0; bj < 2; ++bj)
#pragma unroll
            for (int n = 0; n < 2; ++n) gv[bj][n] = *(const f32x4*)(g1 + bj * 128 + n * 16);
#pragma unroll
        for (int ai = 0; ai < 2; ++ai)
#pragma unroll
            for (int m = 0; m < 4; ++m) { float* rowp = X + (size_t)(row0 + ai * 128 + m * 16) * 1024 + col0;
#pragma unroll
                for (int bj = 0; bj < 2; ++bj)
#pragma unroll
                    for (int n = 0; n < 2; ++n) { f32x4* p = (f32x4*)(rowp + bj * 128 + n * 16); *p = *p + gv[bj][n] * acc[ai][bj][m][n]; } }
        ACC_ZERO(acc);
    }
};
struct SchedMoe {
    const LAS int* tab; const char* A; const char* B; const int* list; int nN, c, G; size_t a_tile_bytes, b_exp_bytes; bool gather;
    DI bool next(int i, pg8::Unit& u) const {
        const int T = tab[96], Tq = (T + 7) >> 3, xcd = c & 7, q = i * (G >> 3) + (c >> 3), tl = q / nN, pn = q - tl * nN, t = xcd * Tq + tl;
        if (tl >= Tq || t >= T) return false;
        const int e = tab[128 + t], j = t - tab[64 + e], slot0 = tab[32 + e] + 256 * j;
        u.pa = gather ? A : A + (size_t)slot0 * 2048; u.pb = B + (size_t)e * b_exp_bytes + (size_t)pn * (256 * 1024 * 2); u.x = slot0; u.y = pn; u.z = e | (j << 8); return true;
    }
    DI void rows(const pg8::Unit& u, int R0, int R1, unsigned (&rw)[2]) const {
        const int e = u.z & 255, j = u.z >> 8, cnt = tab[e]; const int* le = list + (size_t)e * NT;
#pragma unroll
        for (int h = 0; h < 2; ++h) { const int i0 = j * 256 + h * 128 + R0, i1 = j * 256 + h * 128 + R1;
            const unsigned r0 = i0 < cnt ? (unsigned)(le[i0] >> 2) : (unsigned)NT, r1 = i1 < cnt ? (unsigned)(le[i1] >> 2) : (unsigned)NT; rw[h] = r0 | (r1 << 16); }
    }
};
struct EpiSwiglu {
    static constexpr bool PERM = true;
    bf16* ACT; const float* bgu;
    DI void operator()(f32x4 (&acc)[2][2][4][2], const pg8::Unit& u, int wr, int wc, int fr, int fq) const {
        const int row0 = u.x + wr * 64 + fr, ch0 = u.y * 128 + wc * 32 + 8 * fq, e = u.z & 255;
        const float* bg = bgu + (size_t)e * 2048 + ch0;
        const f32x4 bg0 = *(const f32x4*)bg, bg1 = *(const f32x4*)(bg + 4), bu0 = *(const f32x4*)(bg + 1024), bu1 = *(const f32x4*)(bg + 1028);
#pragma unroll
        for (int ai = 0; ai < 2; ++ai)
#pragma unroll
            for (int m = 0; m < 4; ++m) {
                const f32x4 g0 = acc[ai][0][m][0] + bg0, g1 = acc[ai][0][m][1] + bg1, u0 = acc[ai][1][m][0] + bu0, u1 = acc[ai][1][m][1] + bu1;
                float o[8];
#pragma unroll
                for (int j = 0; j < 8; ++j) { const float g = fminf(j < 4 ? g0[j & 3] : g1[j & 3], 7.f); const float up = fminf(fmaxf(j < 4 ? u0[j & 3] : u1[j & 3], -7.f), 7.f);
                    o[j] = g * __builtin_amdgcn_rcpf(1.f + __expf(-1.702f * g)) * (up + 1.f); }
                u32x4 w; w.x = pk2(o[0], o[1]); w.y = pk2(o[2], o[3]); w.z = pk2(o[4], o[5]); w.w = pk2(o[6], o[7]);
                *(u32x4*)(ACT + (size_t)(row0 + ai * 128 + m * 16) * 1024 + ch0) = w; }
        ACC_ZERO(acc);
    }
};
struct EpiDown {
    static constexpr bool PERM = true;
    bf16* Y; const float* bd;
    DI void operator()(f32x4 (&acc)[2][2][4][2], const pg8::Unit& u, int wr, int wc, int fr, int fq) const {
        const int row0 = u.x + wr * 64 + fr, col0 = u.y * 256 + wc * 32 + 8 * fq, e = u.z & 255;
        f32x4 bv[2][2];
#pragma unroll
        for (int bj = 0; bj < 2; ++bj)
#pragma unroll
            for (int n = 0; n < 2; ++n) bv[bj][n] = *(const f32x4*)(bd + (size_t)e * 1024 + col0 + bj * 128 + 4 * n);
#pragma unroll
        for (int ai = 0; ai < 2; ++ai)
#pragma unroll
            for (int m = 0; m < 4; ++m) { bf16* rowp = Y + (size_t)(row0 + ai * 128 + m * 16) * 1024 + col0;
#pragma unroll
                for (int bj = 0; bj < 2; ++bj) { const f32x4 v0 = acc[ai][bj][m][0] + bv[bj][0], v1 = acc[ai][bj][m][1] + bv[bj][1];
                    u32x4 w; w.x = pk2(v0[0], v0[1]); w.y = pk2(v0[2], v0[3]); w.z = pk2(v1[0], v1[1]); w.w = pk2(v1[2], v1[3]);
                    *(u32x4*)(rowp + bj * 128) = w; } }
        ACC_ZERO(acc);
    }
};
DI void moe_build_table(Frame& F, const unsigned* cnt  ) {
    LAS int* tab = (LAS int*)(F.lds + LDS_TAB_OFF);
    if (F.tid < 32) tab[F.tid] = (int)__hip_atomic_load(cnt + F.tid * 16, __ATOMIC_RELAXED, __HIP_MEMORY_SCOPE_AGENT);
    __syncthreads();
    if (F.tid == 0) { int pb = 0, tb = 0; for (int e = 0; e < 32; ++e) { const int nt_ = (tab[e] + 255) >> 8; tab[32 + e] = pb; tab[64 + e] = tb; pb += nt_ * 256; tb += nt_; } tab[96] = tb; }
    __syncthreads();
    for (int e = 0; e < 32; ++e) { const int tb = tab[64 + e], nt_ = (tab[e] + 255) >> 8; for (int j = F.tid; j < nt_; j += NTHREADS) tab[128 + tb + j] = e; }
    __syncthreads();
}

DI void transpose_item(const float* W, int K, int N, bf16* WT, int mode, const float* gk, LAS float* scr, int item, int lane) {
    const int nblk = N / 32, kb = item / nblk, nb = item % nblk, k0 = 64 * kb, n0 = 32 * nb;
#pragma unroll 8
    for (int i = 0; i < 32; ++i) { const int kk = 2 * i + (lane >> 5); float v = W[(size_t)(k0 + kk) * N + n0 + (lane & 31)]; if (gk) v *= gk[k0 + kk]; scr[kk * 33 + (lane & 31)] = v; }
    LDS_WAIT(); asm volatile("" ::: "memory");
    int drow0 = n0;
    if (mode == 1) { const int up = n0 >= 1024, ch = n0 - (up ? 1024 : 0); drow0 = (ch >> 7) * 256 + (up ? 128 : 0) + (ch & 127); }
    const int c = lane & 7;
#pragma unroll
    for (int j = 0; j < 4; ++j) { const int n = (lane >> 3) + 8 * j; const LAS float* s = scr + (8 * c) * 33 + n;
        u32x4 o; o.x = pk2(s[0 * 33], s[1 * 33]); o.y = pk2(s[2 * 33], s[3 * 33]); o.z = pk2(s[4 * 33], s[5 * 33]); o.w = pk2(s[6 * 33], s[7 * 33]);
        *(u32x4*)(WT + (size_t)(drow0 + n) * K + k0 + 8 * c) = o; }
    LDS_WAIT(); asm volatile("" ::: "memory");
}
DI void transpose_batch(Frame& F, const float* W, size_t ss, int K, int N, bf16* WT, size_t ds, int nb, int mode, const float* gk, size_t gks) {
    LAS float* scr = (LAS float*)(F.lds + F.wave * 16384);
    const int gw = F.bid * NWAVES + F.wave, NGW = F.G * NWAVES;
    const int per = (K / 64) * (N / 32), total = per * nb;
    for (int it = gw; it < total; it += NGW) { const int b = it / per, r = it - b * per;
        transpose_item(W + (size_t)b * ss, K, N, WT + (size_t)b * ds, mode, gk ? gk + (size_t)b * gks : nullptr, scr, r, F.lane); }
}
DI void phase_prologue(Frame& F, const KA& a) {
    unsigned char* ws = F.ws;
    transpose_batch(F, a.in(I_WIN), (size_t)1024 * DIN, 1024, DIN, (bf16*)(ws + WS_WIN), (size_t)DINP * 1024, 4, 0, nullptr, 0);
    transpose_batch(F, a.in(I_WGU), (size_t)1024 * 2048, 1024, 2048, (bf16*)(ws + WS_WGU), (size_t)2048 * 1024, 128, 1, nullptr, 0);
    transpose_batch(F, a.in(I_WDOWN), (size_t)1024 * 1024, 1024, 1024, (bf16*)(ws + WS_WDN), (size_t)1024 * 1024, 128, 0, nullptr, 0);
    transpose_batch(F, a.in(I_WOUT), (size_t)1024 * 1024, 1024, 1024, (bf16*)(ws + WS_WOUT), (size_t)1024 * 1024, 4, 0, nullptr, 0);
    transpose_batch(F, a.in(I_BRRET), (size_t)512 * 1024, 512, 1024, (bf16*)(ws + WS_WBR), (size_t)3 * 1024 * 512, 4, 0, nullptr, 0);
    transpose_batch(F, a.in(I_BRMLA), (size_t)512 * 1024, 512, 1024, (bf16*)(ws + WS_WBR) + (size_t)1024 * 512, (size_t)3 * 1024 * 512, 4, 0, nullptr, 0);
    transpose_batch(F, a.in(I_BRRWKV), (size_t)512 * 1024, 512, 1024, (bf16*)(ws + WS_WBR) + (size_t)2 * 1024 * 512, (size_t)3 * 1024 * 512, 4, 0, nullptr, 0);
    transpose_batch(F, a.in(I_WUQ), (size_t)256 * 768, 256, 768, (bf16*)(ws + WS_SMALLW + SW_UQ), MiB / 2, 4, 0, a.in(I_MQNG), 256);
    transpose_batch(F, a.in(I_WUKV), (size_t)128 * 1024, 128, 1024, (bf16*)(ws + WS_SMALLW + SW_UKV), MiB / 2, 4, 0, a.in(I_MKVNG), 128);
    for (int l = 0; l < 4; ++l) {
        transpose_batch(F, a.in(I_W2) + (size_t)l * 2 * 64 * 512, (size_t)64 * 512, 64, 512, (bf16*)(ws + WS_SMALLW + l * MiB + SW_W2), (size_t)512 * 64, 2, 0, nullptr, 0);
        transpose_batch(F, a.in(I_A2) + (size_t)l * 2 * 64 * 512, (size_t)64 * 512, 64, 512, (bf16*)(ws + WS_SMALLW + l * MiB + SW_A2), (size_t)512 * 64, 2, 0, nullptr, 0);
    }
    transpose_batch(F, a.in(I_G2), (size_t)128 * 512, 128, 512, (bf16*)(ws + WS_SMALLW + SW_G2), MiB / 2, 4, 0, nullptr, 0);
    const int gt = F.bid * NTHREADS + F.tid, NGT = F.G * NTHREADS;
    for (int i = gt; i < 4 * (DINP - DIN) * 1024 / 8; i += NGT) { const int l = i / ((DINP - DIN) * 128), r = i - l * ((DINP - DIN) * 128);
        *(u32x4*)((bf16*)(ws + WS_WIN) + (size_t)l * DINP * 1024 + (size_t)DIN * 1024 + (size_t)r * 8) = (u32x4){0u, 0u, 0u, 0u}; }
    for (int i = gt; i < 128; i += NGT) *(u32x4*)((bf16*)(ws + WS_H) + (size_t)NT * 1024 + i * 8) = (u32x4){0u, 0u, 0u, 0u};
    { float2* rt = (float2*)(ws + WS_ROPE);
      for (int i = gt; i < 4096 * 32; i += NGT) { const int pos = i >> 5, f = i & 31; const float inv = powf(10000.f, -(float)(2 * f) / 64.f); const float ang = (float)pos * inv; float s, c; sincosf(ang, &s, &c); rt[i] = make_float2(c, s); }
      float2* ax = (float2*)(ws + WS_ROPE_AX);
      for (int i = gt; i < 64 * 8; i += NGT) { const int pos = i >> 3, f = i & 7; const float inv = powf(10000.f, -(float)(2 * f) / 16.f); const float ang = (float)pos * inv; float s, c; sincosf(ang, &s, &c); ax[i] = make_float2(c, s); } }
    { LAS float* sc = (LAS float*)(F.lds);
      LAS float* red = (LAS float*)(F.lds + 65536);
      __syncthreads();
      for (int i = F.tid; i < 9 * 1024; i += NTHREADS) { const int r = i >> 10, k = i & 1023; const float v = r < 8 ? a.in(I_C)[r * 1024 + k] : a.in(I_CCTX)[k]; sc[i] = v / (1.f + __expf(-v)); }
      __syncthreads();
      float* mod = (float*)(ws + WS_MOD);
      for (int it = F.bid; it < 4 * 96; it += F.G) { const int l = it / 96, n = (it - l * 96) * 64 + F.lane;
          const float* w = a.in(I_ADAW) + (size_t)l * 1024 * 6144 + n; float acc[9];
#pragma unroll
          for (int r = 0; r < 9; ++r) acc[r] = 0.f;
          const int kb = F.wave * 128;
#pragma unroll 8
          for (int k = 0; k < 128; ++k) { const float wv = w[(size_t)(kb + k) * 6144];
#pragma unroll
              for (int r = 0; r < 9; ++r) acc[r] += sc[r * 1024 + kb + k] * wv; }
#pragma unroll
          for (int r = 0; r < 9; ++r) red[(F.wave * 9 + r) * 64 + F.lane] = acc[r];
          __syncthreads();
          for (int i = F.tid; i < 9 * 64; i += NTHREADS) { const int r = i >> 6, c = i & 63; float s = 0.f;
#pragma unroll
              for (int w8 = 0; w8 < 8; ++w8) s += red[(w8 * 9 + r) * 64 + c];
              const int nn = (it - l * 96) * 64 + c; mod[((size_t)l * 9 + r) * 6144 + nn] = s + a.in(I_ADAB)[l * 6144 + nn]; }
          __syncthreads(); } }
}

DI void norm_mod_store(const f32x4 (&v)[4], const float* gain, const float* sc, const float* sh, bf16* hrow, int lane) {
    float s = 0.f;
#pragma unroll
    for (int j = 0; j < 4; ++j) s += (v[j].x * v[j].x + v[j].y * v[j].y) + (v[j].z * v[j].z + v[j].w * v[j].w);
    const float rinv = rsqrtf(wave_sum(s) * (1.f / 1024.f) + 1e-6f);
#pragma unroll
    for (int j = 0; j < 4; ++j) { const int c = 256 * j + 4 * lane; const f32x4 g = *(const f32x4*)(gain + c), a = *(const f32x4*)(sc + c), b = *(const f32x4*)(sh + c);
        const f32x4 y = v[j] * rinv * g * (a + 1.f) + b; u32x2 o; o.x = pk2(y.x, y.y); o.y = pk2(y.z, y.w); *(u32x2*)(hrow + c) = o; }
}
DI void phase_init_rows(Frame& F, const KA& a) {
    const int gw = F.bid * NWAVES + F.wave, NGW = F.G * NWAVES;
    float* X = (float*)(F.ws + WS_X); bf16* H = (bf16*)(F.ws + WS_H); const float* mod = (const float*)(F.ws + WS_MOD);
    for (int r = gw; r < NT; r += NGW) { const int b = r / LTOT, p = r - b * LTOT;
        const float* src = p < CTX ? a.in(I_CTX) + ((size_t)b * CTX + p) * 1024 : a.in(I_X) + ((size_t)b * SEQ + (p - CTX)) * 1024;
        f32x4 v[4];
#pragma unroll
        for (int j = 0; j < 4; ++j) { v[j] = *(const f32x4*)(src + 256 * j + 4 * F.lane); *(f32x4*)(X + (size_t)r * 1024 + 256 * j + 4 * F.lane) = v[j]; }
        const float* m = mod + (size_t)(p < CTX ? 8 : b) * 6144;
        norm_mod_store(v, a.in(I_N1G), m + 1024, m, H + (size_t)r * 1024, F.lane); }
}

DI void phase_router(Frame& F, const KA& a, int l) {
    LAS float* T = (LAS float*)(F.lds);
    LAS float* part = (LAS float*)(F.lds + 16 * 1028 * 4);
    LAS float* logit = (LAS float*)(F.lds + 16 * 1028 * 4 + 16384);
    LAS int* lcnt = (LAS int*)(F.lds + 16 * 1028 * 4 + 16384 + 2048);
    LAS int* gbase = lcnt + 32;
    const float* X = (const float*)(F.ws + WS_X); bf16* H = (bf16*)(F.ws + WS_H);
    const float* mod = (const float*)(F.ws + WS_MOD) + (size_t)l * 9 * 6144;
    const float* gain = a.in(I_N2G) + l * 1024; const float* wr = a.in(I_WROUTER) + (size_t)l * 1024 * 32; const float* br = a.in(I_BROUTER) + l * 32;
    int* eidx = (int*)(F.ws + WS_TOPK); float* gw = (float*)(F.ws + WS_TOPK) + (size_t)NT * 4; int* rank = (int*)(F.ws + WS_TOPK) + (size_t)NT * 8;
    int* list = (int*)(F.ws + WS_LIST); unsigned* cnt = F.ctl + CW_CNT + l * 32 * 16;
    const int lane = F.lane, w = F.wave;
    for (int it = F.bid; it < NT / 16; it += F.G) {
        const int r0 = it * 16;
        __syncthreads();
        if (F.tid < 32) lcnt[F.tid] = 0;
#pragma unroll
        for (int rr = 0; rr < 2; ++rr) { const int lr = w * 2 + rr, r = r0 + lr; const int b = r / LTOT, p = r - b * LTOT; const float* m = mod + (size_t)(p < CTX ? 8 : b) * 6144;
            f32x4 v[4]; float s = 0.f;
#pragma unroll
            for (int j = 0; j < 4; ++j) { v[j] = *(const f32x4*)(X + (size_t)r * 1024 + 256 * j + 4 * lane); s += (v[j].x * v[j].x + v[j].y * v[j].y) + (v[j].z * v[j].z + v[j].w * v[j].w); }
            const float rinv = rsqrtf(wave_sum(s) * (1.f / 1024.f) + 1e-6f);
#pragma unroll
            for (int j = 0; j < 4; ++j) { const int c = 256 * j + 4 * lane; const f32x4 g = *(const f32x4*)(gain + c), sc = *(const f32x4*)(m + 4096 + c), sh = *(const f32x4*)(m + 3072 + c);
                const f32x4 y = v[j] * rinv * g * (sc + 1.f) + sh; *(LAS f32x4*)(T + lr * 1028 + c) = y;
                u32x2 o; o.x = pk2(y.x, y.y); o.y = pk2(y.z, y.w); *(u32x2*)(H + (size_t)r * 1024 + c) = o; } }
        __syncthreads();
        { const int i = lane & 15, q = lane >> 4; f32x4 acc0 = {0.f, 0.f, 0.f, 0.f}, acc1 = acc0;
          const LAS float* tp = T + i * 1028 + 128 * w + 32 * q; const float* wp = wr + (size_t)(128 * w + 32 * q) * 32 + i;
          float b0[32], b1[32];
#pragma unroll
          for (int s = 0; s < 32; ++s) { b0[s] = wp[s * 32]; b1[s] = wp[s * 32 + 16]; }
          f32x4 a4[8];
#pragma unroll
          for (int s = 0; s < 8; ++s) a4[s] = *(const LAS f32x4*)(tp + 4 * s);
          __builtin_amdgcn_sched_barrier(0);
#pragma unroll
          for (int s = 0; s < 32; ++s) { const float av = a4[s >> 2][s & 3];
              acc0 = __builtin_amdgcn_mfma_f32_16x16x4f32(av, b0[s], acc0, 0, 0, 0); acc1 = __builtin_amdgcn_mfma_f32_16x16x4f32(av, b1[s], acc1, 0, 0, 0); }
#pragma unroll
          for (int rg = 0; rg < 4; ++rg) { part[(w * 16 + 4 * q + rg) * 32 + i] = acc0[rg]; part[(w * 16 + 4 * q + rg) * 32 + 16 + i] = acc1[rg]; } }
        __syncthreads();
        { const int row = F.tid >> 5, e = F.tid & 31; float v = br[e];
#pragma unroll
          for (int w8 = 0; w8 < 8; ++w8) v += part[(w8 * 16 + row) * 32 + e];
          int te[4]; float tv[4];
#pragma unroll
          for (int k = 0; k < 4; ++k) { float bv = v; int bi = e;
#pragma unroll
              for (int o = 1; o < 32; o <<= 1) { const float ov = sx(bv, o); const int oi = __float_as_int(sx(__int_as_float(bi), o)); const bool take = ov > bv || (ov == bv && oi < bi); bv = take ? ov : bv; bi = take ? oi : bi; }
              te[k] = bi; tv[k] = bv; if (e == bi) v = -3.0e38f; }
          const float mx = tv[0]; float den = 0.f;
#pragma unroll
          for (int k = 0; k < 4; ++k) { tv[k] = __expf(tv[k] - mx); den += tv[k]; }
          const float rden = 1.f / den;
          int myk_e = te[0]; float myk_g = tv[0] * rden;
#pragma unroll
          for (int k = 1; k < 4; ++k) { if (e == k) { myk_e = te[k]; myk_g = tv[k] * rden; } }
          int lr = 0;
          if (e < 4) lr = atomicAdd((int*)&lcnt[myk_e], 1);
          __syncthreads();
          if (F.tid < 32) { const int c = lcnt[F.tid]; gbase[F.tid] = c ? (int)__hip_atomic_fetch_add(cnt + F.tid * 16, (unsigned)c, __ATOMIC_RELAXED, __HIP_MEMORY_SCOPE_AGENT) : 0; }
          __syncthreads();
          if (e < 4) { const int r = r0 + row, rk = gbase[myk_e] + lr; eidx[r * 4 + e] = myk_e; gw[r * 4 + e] = myk_g; rank[r * 4 + e] = rk; list[(size_t)myk_e * NT + rk] = r * 4 + e; } }
    }
}

DI void phase_combine(Frame& F, const KA& a, int l) {
    moe_build_table(F, F.ctl + CW_CNT + l * 32 * 16);
    const LAS int* tab = (const LAS int*)(F.lds + LDS_TAB_OFF);
    const int lane = fresh_lane();
    const int gw_ = F.bid * NWAVES + F.wave, NGW = F.G * NWAVES;
    float* X = (float*)(F.ws + WS_X); bf16* H = (bf16*)(F.ws + WS_H); const bf16* Y = (const bf16*)(F.ws + WS_Y);
    const float* mod = (const float*)(F.ws + WS_MOD) + (size_t)l * 9 * 6144;
    const int* eidx = (const int*)(F.ws + WS_TOPK); const float* gw = (const float*)(F.ws + WS_TOPK) + (size_t)NT * 4; const int* rank = (const int*)(F.ws + WS_TOPK) + (size_t)NT * 8;
#pragma unroll 1
    for (int r0 = gw_; r0 < NT; r0 += 2 * NGW) {
        int rr[2], bb[2], pp[2]; bool act[2]; size_t slot[2][4]; float gk[2][4];
#pragma unroll
        for (int u = 0; u < 2; ++u) { rr[u] = r0 + u * NGW; act[u] = rr[u] < NT; if (!act[u]) rr[u] = r0; bb[u] = rr[u] / LTOT; pp[u] = rr[u] - bb[u] * LTOT; if (l == DEPTH - 1 && pp[u] < CTX) act[u] = false;
#pragma unroll
            for (int k = 0; k < 4; ++k) { const int e = eidx[rr[u] * 4 + k]; gk[u][k] = gw[rr[u] * 4 + k]; slot[u][k] = (size_t)(tab[32 + e] + rank[rr[u] * 4 + k]); } }
        f32x4 v[2][4]; u32x2 yv[2][4][4];
#pragma unroll
        for (int u = 0; u < 2; ++u) {
#pragma unroll
            for (int j = 0; j < 4; ++j) v[u][j] = *(const f32x4*)(X + (size_t)rr[u] * 1024 + 256 * j + 4 * lane);
#pragma unroll
            for (int k = 0; k < 4; ++k)
#pragma unroll
                for (int j = 0; j < 4; ++j) yv[u][k][j] = *(const u32x2*)(Y + slot[u][k] * 1024 + 256 * j + 4 * lane); }
#pragma unroll
        for (int u = 0; u < 2; ++u) { if (!act[u]) continue;
            const int mr = pp[u] < CTX ? 8 : bb[u]; const float* g2 = mod + (size_t)mr * 6144 + 5120;
#pragma unroll
            for (int j = 0; j < 4; ++j) { f32x4 acc = {0.f, 0.f, 0.f, 0.f};
#pragma unroll
                for (int k = 0; k < 4; ++k) { const float g = gk[u][k]; const u32x2 y = yv[u][k][j]; acc.x += g * bflo(y.x); acc.y += g * bfhi(y.x); acc.z += g * bflo(y.y); acc.w += g * bfhi(y.y); }
                v[u][j] = v[u][j] + *(const f32x4*)(g2 + 256 * j + 4 * lane) * acc; }
            if (l == DEPTH - 1) {
                float* o = a.out() + ((size_t)bb[u] * SEQ + (pp[u] - CTX)) * 1024;
#pragma unroll
                for (int j = 0; j < 4; ++j) *(f32x4*)(o + 256 * j + 4 * lane) = v[u][j];
            } else {
#pragma unroll
                for (int j = 0; j < 4; ++j) *(f32x4*)(X + (size_t)rr[u] * 1024 + 256 * j + 4 * lane) = v[u][j];
                const float* m = (const float*)(F.ws + WS_MOD) + (size_t)(l + 1) * 9 * 6144 + (size_t)mr * 6144;
                norm_mod_store(v[u], a.in(I_N1G) + (l + 1) * 1024, m + 1024, m, H + (size_t)rr[u] * 1024, lane);
            } }
    }
}

DI int crow16(int i, int h) { return (i & 3) + 8 * (i >> 2) + 4 * h; }
DI int permpos(int p) { return (p & ~12) | ((p & 4) << 1) | ((p & 8) >> 1); }
constexpr int MP_P = 424;
constexpr int MP_SP = 104;
constexpr int MP_SCR = 32 * MP_P * 2;
DI void phase_mla_prep2(Frame& F, const KA& a, int l) {
    const bf16* P = (const bf16*)(F.ws + WS_P);
    const bf16* WUQ = (const bf16*)(F.ws + WS_SMALLW + (size_t)l * MiB + SW_UQ); const bf16* WUKV = (const bf16*)(F.ws + WS_SMALLW + (size_t)l * MiB + SW_UKV);
    bf16* QB = (bf16*)(F.ws + WS_QB); bf16* KB = (bf16*)(F.ws + WS_KB); bf16* VT = (bf16*)(F.ws + WS_VT);
    const float* gq = a.in(I_QKQG) + l * 96; const float* gk = a.in(I_QKKG) + l * 96;
    const float2* ax = (const float2*)(F.ws + WS_ROPE_AX);
    LAS bf16* T = (LAS bf16*)F.lds;
#pragma unroll 1
    for (int it = F.bid; it < NT / 32; it += F.G) {
        const int lane = fresh_lane(); int w = F.wave; asm volatile("" : "+s"(w)); const int tid = w * 64 + lane;
        const int r0 = it * 32, b = r0 / LTOT, p0 = r0 - b * LTOT;
        __syncthreads();
#pragma unroll 1
        for (int q = tid; q < 32 * 52; q += NTHREADS) { const int row = q / 52, pc = q - row * 52; *(LAS u32x4*)(T + row * MP_P + 8 * pc) = *(const u32x4*)(P + (size_t)(r0 + row) * DINP + PC_MQ + 8 * pc); }
        __syncthreads();
        const int hd = w, tok = lane & 31, h = lane >> 5, p = p0 + tok; const bool lat = p >= CTX; const int sl = p - CTX;
        const LAS bf16* trow = T + tok * MP_P;
        LAS bf16* scr = (LAS bf16*)(F.lds + MP_SCR + w * 6656);
        const size_t bhbase = (size_t)(b * 8 + hd) * LTOT + p0;
        { bf16x8 cq[16]; float ssq = 0.f;
#pragma unroll
          for (int s2 = 0; s2 < 16; ++s2) { const u32x4 x = *(const LAS u32x4*)(trow + 16 * s2 + 8 * h); cq[s2] = __builtin_bit_cast(bf16x8, x);
              ssq += bflo(x.x) * bflo(x.x) + bfhi(x.x) * bfhi(x.x) + bflo(x.y) * bflo(x.y) + bfhi(x.y) * bfhi(x.y) + bflo(x.z) * bflo(x.z) + bfhi(x.z) * bfhi(x.z) + bflo(x.w) * bflo(x.w) + bfhi(x.w) * bfhi(x.w); }
          ssq += sx(ssq, 32);
          const float rinq = rsqrtf(ssq * (1.f / 256.f) + 1e-6f);
          float2 cr[4], cc[4];
#pragma unroll
          for (int f = 0; f < 4; ++f) { cr[f] = lat ? ax[(sl >> 6) * 8 + 4 * h + f] : make_float2(1.f, 0.f); cc[f] = lat ? ax[(sl & 63) * 8 + 4 * h + f] : make_float2(1.f, 0.f); }
          f32x16 acc[3];
#pragma unroll
          for (int cb = 0; cb < 3; ++cb) { f32x16 z = zero16(); const bf16* wrow = WUQ + (size_t)(hd * 96 + cb * 32 + tok) * 256 + 8 * h;
              bf16x8 wf[16];
#pragma unroll
              for (int s2 = 0; s2 < 16; ++s2) wf[s2] = *(const bf16x8*)(wrow + 16 * s2);
              __builtin_amdgcn_sched_barrier(0);
#pragma unroll
              for (int s2 = 0; s2 < 16; ++s2) z = __builtin_amdgcn_mfma_f32_32x32x16_bf16(wf[s2], cq[s2], z, 0, 0, 0);
              __builtin_amdgcn_sched_barrier(0);
              acc[cb] = z; }
          float ss = 0.f;
#pragma unroll
          for (int cb = 0; cb < 3; ++cb)
#pragma unroll
              for (int i = 0; i < 16; ++i) { acc[cb][i] *= rinq; ss += acc[cb][i] * acc[cb][i]; }
          ss += sx(ss, 32);
          const float rq = rsqrtf(ss * (1.f / 96.f) + 1e-6f);
#pragma unroll
          for (int cb = 0; cb < 3; ++cb)
#pragma unroll
              for (int i = 0; i < 16; ++i) acc[cb][i] *= rq * gq[cb * 32 + crow16(i, h)];
#pragma unroll
          for (int i = 0; i < 4; ++i) { const float2 c1 = cr[i]; const float x1 = acc[2][i], x2 = acc[2][i + 4]; acc[2][i] = x1 * c1.x - x2 * c1.y; acc[2][i + 4] = x1 * c1.y + x2 * c1.x;
              const float2 c2 = cc[i]; const float y1 = acc[2][8 + i], y2 = acc[2][12 + i]; acc[2][8 + i] = y1 * c2.x - y2 * c2.y; acc[2][12 + i] = y1 * c2.y + y2 * c2.x; }
#pragma unroll
          for (int cb = 0; cb < 3; ++cb)
#pragma unroll
              for (int g = 0; g < 4; ++g) { u32x2 o; o.x = pk2(acc[cb][4 * g], acc[cb][4 * g + 1]); o.y = pk2(acc[cb][4 * g + 2], acc[cb][4 * g + 3]); *(LAS u32x2*)(scr + tok * MP_SP + cb * 32 + 8 * g + 4 * h) = o; }
          LDS_WAIT();
#pragma unroll
          for (int i = 0; i < 6; ++i) { const int q = lane + 64 * i, row = q / 12, pc = q - row * 12; *(u32x4*)(QB + (bhbase + row) * 96 + 8 * pc) = *(const LAS u32x4*)(scr + row * MP_SP + 8 * pc); }
          LDS_WAIT(); }
        { bf16x8 ckv[8]; float ssk = 0.f;
#pragma unroll
          for (int s2 = 0; s2 < 8; ++s2) { const u32x4 x = *(const LAS u32x4*)(trow + 256 + 16 * s2 + 8 * h); ckv[s2] = __builtin_bit_cast(bf16x8, x);
              ssk += bflo(x.x) * bflo(x.x) + bfhi(x.x) * bfhi(x.x) + bflo(x.y) * bflo(x.y) + bfhi(x.y) * bfhi(x.y) + bflo(x.z) * bflo(x.z) + bfhi(x.z) * bfhi(x.z) + bflo(x.w) * bflo(x.w) + bfhi(x.w) * bfhi(x.w); }
          ssk += sx(ssk, 32);
          const float rinkv = rsqrtf(ssk * (1.f / 128.f) + 1e-6f);
          float pe1[8], pe2[8]; float sspe = 0.f;
          { const u32x4 w0 = *(const LAS u32x4*)(trow + 384 + 16 * h), w1 = *(const LAS u32x4*)(trow + 384 + 16 * h + 8);
            unpack8(w0, pe1); unpack8(w1, pe2);
#pragma unroll
            for (int j = 0; j < 8; ++j) sspe += pe1[j] * pe1[j] + pe2[j] * pe2[j];
            sspe += sx(sspe, 32); }
          float2 cs[8];
#pragma unroll
          for (int f = 0; f < 8; ++f) cs[f] = lat ? ax[(h ? (sl & 63) : (sl >> 6)) * 8 + f] : make_float2(1.f, 0.f);
          f32x16 acc[4];
#pragma unroll
          for (int cb = 0; cb < 4; cb += 2) { f32x16 z0 = zero16(), z1 = zero16(); const bf16* wrow = WUKV + (size_t)(hd * 128 + cb * 32 + tok) * 128 + 8 * h;
              bf16x8 wf0[8], wf1[8];
#pragma unroll
              for (int s2 = 0; s2 < 8; ++s2) { wf0[s2] = *(const bf16x8*)(wrow + 16 * s2); wf1[s2] = *(const bf16x8*)(wrow + 32 * 128 + 16 * s2); }
              __builtin_amdgcn_sched_barrier(0);
#pragma unroll
              for (int s2 = 0; s2 < 8; ++s2) { z0 = __builtin_amdgcn_mfma_f32_32x32x16_bf16(wf0[s2], ckv[s2], z0, 0, 0, 0); z1 = __builtin_amdgcn_mfma_f32_32x32x16_bf16(wf1[s2], ckv[s2], z1, 0, 0, 0); }
              __builtin_amdgcn_sched_barrier(0);
              acc[cb] = z0; acc[cb + 1] = z1; }
          float ss = 0.f;
#pragma unroll
          for (int cb = 0; cb < 4; ++cb)
#pragma unroll
              for (int i = 0; i < 16; ++i) { acc[cb][i] *= rinkv; if (cb < 2) ss += acc[cb][i] * acc[cb][i]; }
          ss += sx(ss, 32);
          const float rk = rsqrtf((ss + sspe) * (1.f / 96.f) + 1e-6f);
#pragma unroll
          for (int cb = 0; cb < 2; ++cb)
#pragma unroll
              for (int g = 0; g < 4; ++g) { float o4[4];
#pragma unroll
                  for (int j = 0; j < 4; ++j) o4[j] = acc[cb][4 * g + j] * rk * gk[cb * 32 + 8 * g + 4 * h + j];
                  u32x2 o; o.x = pk2(o4[0], o4[1]); o.y = pk2(o4[2], o4[3]); *(LAS u32x2*)(scr + tok * MP_SP + cb * 32 + 8 * g + 4 * h) = o; }
          { float pe[16];
#pragma unroll
            for (int f = 0; f < 8; ++f) { const float x1 = pe1[f] * rk * gk[64 + 16 * h + f], x2 = pe2[f] * rk * gk[64 + 16 * h + 8 + f];
                pe[f] = x1 * cs[f].x - x2 * cs[f].y; pe[8 + f] = x1 * cs[f].y + x2 * cs[f].x; }
            *(LAS bf16x8*)(scr + tok * MP_SP + 64 + 16 * h) = pack8(pe); *(LAS bf16x8*)(scr + tok * MP_SP + 64 + 16 * h + 8) = pack8(pe + 8); }
          LDS_WAIT();
#pragma unroll
          for (int i = 0; i < 6; ++i) { const int q = lane + 64 * i, row = q / 12, pc = q - row * 12; *(u32x4*)(KB + (bhbase + row) * 96 + 8 * pc) = *(const LAS u32x4*)(scr + row * MP_SP + 8 * pc); }
          LDS_WAIT();
          { const int pt = permpos(tok);
#pragma unroll
            for (int cb = 2; cb < 4; ++cb)
#pragma unroll
                for (int i = 0; i < 16; ++i) scr[((cb - 2) * 32 + crow16(i, h)) * 40 + pt] = f2bf(acc[cb][i]);
            LDS_WAIT();
            bf16* vt = VT + (size_t)(b * 8 + hd) * 64 * LTOT + p0;
#pragma unroll
            for (int i = 0; i < 4; ++i) { const int q = lane + 64 * i, d = q >> 2, pc = q & 3; *(u32x4*)(vt + (size_t)d * LTOT + 8 * pc) = *(const LAS u32x4*)(scr + d * 40 + 8 * pc); }
            LDS_WAIT(); } }
    }
}

constexpr int ATT_KP = 104, ATT_VP = 72;
constexpr int ATT_KBYTES = 64 * ATT_KP * 2, ATT_VBYTES = 64 * ATT_VP * 2;
DI void attn_unit(Frame& F, int b, int hd, int qblk) {
    const bf16* QB = (const bf16*)(F.ws + WS_QB); const bf16* KB = (const bf16*)(F.ws + WS_KB); const bf16* VT = (const bf16*)(F.ws + WS_VT);
    bf16* O = (bf16*)(F.ws + WS_ABR) + (size_t)NT * 512;
    const int q0 = qblk == 0 ? 0 : CTX + 256 * (qblk - 1), ntiles = qblk == 0 ? CTX / 64 : LTOT / 64;
    const int lane = fresh_lane(), ql = lane & 31, h = lane >> 5, w = F.wave, tid = w * 64 + lane;
    const size_t bh = (size_t)(b * 8 + hd);
    LAS bf16* Kt = (LAS bf16*)(F.lds); LAS bf16* Vt = (LAS bf16*)(F.lds + 2 * ATT_KBYTES);
    bf16x8 qf[6];
    { const bf16* qrow = QB + (bh * LTOT + q0 + 32 * w + ql) * 96 + 8 * h;
#pragma unroll
      for (int s = 0; s < 6; ++s) qf[s] = *(const bf16x8*)(qrow + 16 * s); }
    const bf16* kbase = KB + bh * LTOT * 96; const bf16* vbase = VT + bh * 64 * LTOT;
    const int k1 = tid / 12, c1 = tid - k1 * 12, k2 = (512 + tid) / 12, c2 = (512 + tid) - k2 * 12, vd = tid >> 3, vc = tid & 7;
    u32x4 rk1, rk2 = {0u, 0u, 0u, 0u}, rv;
    rk1 = *(const u32x4*)(kbase + (size_t)k1 * 96 + 8 * c1); if (tid < 256) rk2 = *(const u32x4*)(kbase + (size_t)k2 * 96 + 8 * c2); rv = *(const u32x4*)(vbase + (size_t)vd * LTOT + 8 * vc);
    __syncthreads();
    *(LAS u32x4*)(Kt + k1 * ATT_KP + 8 * c1) = rk1; if (tid < 256) *(LAS u32x4*)(Kt + k2 * ATT_KP + 8 * c2) = rk2; *(LAS u32x4*)(Vt + vd * ATT_VP + 8 * vc) = rv;
    __syncthreads();
    float m = -1.0e30f, lsum = 0.f; f32x16 o0, o1;
#pragma unroll
    for (int i = 0; i < 16; ++i) { o0[i] = 0.f; o1[i] = 0.f; }
    const float sc = 0.10206207261596577f * 1.4426950408889634f;
    for (int t = 0; t < ntiles; ++t) {
        const int buf = t & 1; const bool more = t + 1 < ntiles;
        if (more) { const size_t ko = (size_t)(t + 1) * 64; rk1 = *(const u32x4*)(kbase + (ko + k1) * 96 + 8 * c1); if (tid < 256) rk2 = *(const u32x4*)(kbase + (ko + k2) * 96 + 8 * c2); rv = *(const u32x4*)(vbase + (size_t)vd * LTOT + ko + 8 * vc); }
        const LAS bf16* kt = Kt + buf * (64 * ATT_KP); const LAS bf16* vt = Vt + buf * (64 * ATT_VP);
        f32x16 s0, s1;
#pragma unroll
        for (int i = 0; i < 16; ++i) { s0[i] = 0.f; s1[i] = 0.f; }
        bf16x8 kf0[6], kf1[6];
#pragma unroll
        for (int s = 0; s < 6; ++s) { kf0[s] = *(const LAS bf16x8*)(kt + ql * ATT_KP + 16 * s + 8 * h); kf1[s] = *(const LAS bf16x8*)(kt + (32 + ql) * ATT_KP + 16 * s + 8 * h); }
        __builtin_amdgcn_sched_barrier(0);
#pragma unroll
        for (int s = 0; s < 6; ++s) { s0 = __builtin_amdgcn_mfma_f32_32x32x16_bf16(kf0[s], qf[s], s0, 0, 0, 0); s1 = __builtin_amdgcn_mfma_f32_32x32x16_bf16(kf1[s], qf[s], s1, 0, 0, 0); }
        bf16x8 vf0[4], vf1[4];
#pragma unroll
        for (int ks = 0; ks < 4; ++ks) { vf0[ks] = *(const LAS bf16x8*)(vt + ql * ATT_VP + 16 * ks + 8 * h); vf1[ks] = *(const LAS bf16x8*)(vt + (32 + ql) * ATT_VP + 16 * ks + 8 * h); }
        __builtin_amdgcn_sched_barrier(0);
        float mr = -1.0e30f;
#pragma unroll
        for (int i = 0; i < 16; ++i) mr = fmaxf(mr, fmaxf(s0[i], s1[i]));
        mr = fmaxf(mr, sx(mr, 32));
        const float mn = fmaxf(m, mr * sc), alpha = __builtin_amdgcn_exp2f(m - mn); m = mn;
        float rs = 0.f;
#pragma unroll
        for (int i = 0; i < 16; ++i) { s0[i] = __builtin_amdgcn_exp2f(__builtin_fmaf(s0[i], sc, -mn)); s1[i] = __builtin_amdgcn_exp2f(__builtin_fmaf(s1[i], sc, -mn)); rs += s0[i] + s1[i]; }
        lsum = lsum * alpha + rs;
#pragma unroll
        for (int i = 0; i < 16; ++i) { o0[i] *= alpha; o1[i] *= alpha; }
        bf16x8 pf[4];
        { u32x4 x;
          x.x = pk2(s0[0], s0[1]); x.y = pk2(s0[2], s0[3]); x.z = pk2(s0[4], s0[5]); x.w = pk2(s0[6], s0[7]); pf[0] = __builtin_bit_cast(bf16x8, x);
          x.x = pk2(s0[8], s0[9]); x.y = pk2(s0[10], s0[11]); x.z = pk2(s0[12], s0[13]); x.w = pk2(s0[14], s0[15]); pf[1] = __builtin_bit_cast(bf16x8, x);
          x.x = pk2(s1[0], s1[1]); x.y = pk2(s1[2], s1[3]); x.z = pk2(s1[4], s1[5]); x.w = pk2(s1[6], s1[7]); pf[2] = __builtin_bit_cast(bf16x8, x);
          x.x = pk2(s1[8], s1[9]); x.y = pk2(s1[10], s1[11]); x.z = pk2(s1[12], s1[13]); x.w = pk2(s1[14], s1[15]); pf[3] = __builtin_bit_cast(bf16x8, x); }
        __builtin_amdgcn_sched_barrier(0);
#pragma unroll
        for (int ks = 0; ks < 4; ++ks) { o0 = __builtin_amdgcn_mfma_f32_32x32x16_bf16(vf0[ks], pf[ks], o0, 0, 0, 0); o1 = __builtin_amdgcn_mfma_f32_32x32x16_bf16(vf1[ks], pf[ks], o1, 0, 0, 0); }
        if (more) { const int nb = buf ^ 1; LAS bf16* kn = Kt + nb * (64 * ATT_KP); LAS bf16* vn = Vt + nb * (64 * ATT_VP);
            *(LAS u32x4*)(kn + k1 * ATT_KP + 8 * c1) = rk1; if (tid < 256) *(LAS u32x4*)(kn + k2 * ATT_KP + 8 * c2) = rk2; *(LAS u32x4*)(vn + vd * ATT_VP + 8 * vc) = rv; }
        __syncthreads();
    }
    lsum += sx(lsum, 32);
    const float inv = 1.f / lsum;
    bf16* orow = O + ((size_t)b * LTOT + q0 + 32 * w + ql) * 512 + hd * 64 + 4 * h;
#pragma unroll
    for (int g = 0; g < 4; ++g) { u32x2 x; x.x = pk2(o0[4 * g] * inv, o0[4 * g + 1] * inv); x.y = pk2(o0[4 * g + 2] * inv, o0[4 * g + 3] * inv); *(u32x2*)(orow + 8 * g) = x;
        x.x = pk2(o1[4 * g] * inv, o1[4 * g + 1] * inv); x.y = pk2(o1[4 * g + 2] * inv, o1[4 * g + 3] * inv); *(u32x2*)(orow + 32 + 8 * g) = x; }
}

DI void shift_n(const bf16* prow, bool first, bool last, int col, const float* mup, const float* mun, float* out, int n  ) {
    const bf16* pp = first ? prow : prow - DINP; const bf16* pn = last ? prow : prow + DINP; const float fm = first ? 0.f : 1.f, lm = last ? 0.f : 1.f;
    if (n == 8) {
        const u32x4 c = *(const u32x4*)(prow + col), pv = *(const u32x4*)(pp + col), nx = *(const u32x4*)(pn + col);
        const f32x4 mp0 = *(const f32x4*)(mup + col - PC_RW), mp1 = *(const f32x4*)(mup + col - PC_RW + 4), mn0 = *(const f32x4*)(mun + col - PC_RW), mn1 = *(const f32x4*)(mun + col - PC_RW + 4);
        const unsigned cw[4] = {c.x, c.y, c.z, c.w}, pw[4] = {pv.x, pv.y, pv.z, pv.w}, nw[4] = {nx.x, nx.y, nx.z, nx.w};
        const float mp[8] = {mp0.x, mp0.y, mp0.z, mp0.w, mp1.x, mp1.y, mp1.z, mp1.w}, mn[8] = {mn0.x, mn0.y, mn0.z, mn0.w, mn1.x, mn1.y, mn1.z, mn1.w};
#pragma unroll
        for (int j = 0; j < 4; ++j) { const float t0 = bflo(cw[j]), t1 = bfhi(cw[j]);
            out[2 * j] = t0 + mp[2 * j] * (fm * bflo(pw[j]) - t0) + mn[2 * j] * (lm * bflo(nw[j]) - t0);
            out[2 * j + 1] = t1 + mp[2 * j + 1] * (fm * bfhi(pw[j]) - t1) + mn[2 * j + 1] * (lm * bfhi(nw[j]) - t1); }
    } else {
        const u32x2 c = *(const u32x2*)(prow + col), pv = *(const u32x2*)(pp + col), nx = *(const u32x2*)(pn + col);
        const f32x4 mp0 = *(const f32x4*)(mup + col - PC_RW), mn0 = *(const f32x4*)(mun + col - PC_RW);
        const unsigned cw[2] = {c.x, c.y}, pw[2] = {pv.x, pv.y}, nw[2] = {nx.x, nx.y};
        const float mp[4] = {mp0.x, mp0.y, mp0.z, mp0.w}, mn[4] = {mn0.x, mn0.y, mn0.z, mn0.w};
#pragma unroll
        for (int j = 0; j < 2; ++j) { const float t0 = bflo(cw[j]), t1 = bfhi(cw[j]);
            out[2 * j] = t0 + mp[2 * j] * (fm * bflo(pw[j]) - t0) + mn[2 * j] * (lm * bflo(nw[j]) - t0);
            out[2 * j + 1] = t1 + mp[2 * j + 1] * (fm * bfhi(pw[j]) - t1) + mn[2 * j + 1] * (lm * bfhi(nw[j]) - t1); }
    }
}
constexpr int RP_P = 1928;
DI void phase_rwkv_prep2(Frame& F, const KA& a, int l) {
    const bf16* P = (const bf16*)(F.ws + WS_P);
    const bf16* W2T = (const bf16*)(F.ws + WS_SMALLW + (size_t)l * MiB + SW_W2); const bf16* A2T = (const bf16*)(F.ws + WS_SMALLW + (size_t)l * MiB + SW_A2); const bf16* G2T = (const bf16*)(F.ws + WS_SMALLW + (size_t)l * MiB + SW_G2);
    const float* mup = a.in(I_MUP) + l * 1920; const float* mun = a.in(I_MUN) + l * 1920;
    const float* w0 = a.in(I_W0) + l * 1024; const float* a0 = a.in(I_A0) + l * 1024; const float* kkw = a.in(I_KK) + l * 512; const float* kaw = a.in(I_KA) + l * 512;
    bf16* RW = (bf16*)(F.ws + WS_RW); float* LW = (float*)(F.ws + WS_LW);
    const size_t TS = (size_t)NT * 512;
    LAS bf16* T = (LAS bf16*)F.lds;
#pragma unroll 1
    for (int it = (F.bid + 64) % F.G; it < NT / 32; it += F.G) {
        const int lane = fresh_lane(); int w = F.wave; asm volatile("" : "+s"(w)); const int tid = w * 64 + lane;
        const int r0 = it * 32;
        __syncthreads();
        if (tid < 480) { const int pc = tid % 240, rh = tid / 240, row0 = rh * 16, col = PC_RW + 8 * pc;
            const int ra = r0 + row0, ba = ra / LTOT, pa = ra - ba * LTOT;
            u32x4 rowv[18];
#pragma unroll
            for (int j = 0; j < 18; ++j) { const int p = pa - 1 + j; const bool valid = (p >= 0) && (p < LTOT) && ((p < CTX) == (pa < CTX));
                const int pcl = valid ? p : pa; rowv[j] = *(const u32x4*)(P + ((size_t)ba * LTOT + pcl) * DINP + col); if (!valid) rowv[j] = (u32x4){0u, 0u, 0u, 0u}; }
            const f32x4 mp0 = *(const f32x4*)(mup + 8 * pc), mp1 = *(const f32x4*)(mup + 8 * pc + 4), mn0 = *(const f32x4*)(mun + 8 * pc), mn1 = *(const f32x4*)(mun + 8 * pc + 4);
            const float mp[8] = {mp0.x, mp0.y, mp0.z, mp0.w, mp1.x, mp1.y, mp1.z, mp1.w}, mn[8] = {mn0.x, mn0.y, mn0.z, mn0.w, mn1.x, mn1.y, mn1.z, mn1.w};
#pragma unroll
            for (int j = 0; j < 16; ++j) { float pv[8], cv[8], nv[8], v[8]; unpack8(rowv[j], pv); unpack8(rowv[j + 1], cv); unpack8(rowv[j + 2], nv);
#pragma unroll
                for (int e = 0; e < 8; ++e) v[e] = cv[e] + mp[e] * (pv[e] - cv[e]) + mn[e] * (nv[e] - cv[e]);
                if (pc >= 192 && pc < 208) {
#pragma unroll
                    for (int e = 0; e < 8; ++e) v[e] = 2.f * sigmoidf_(2.f * v[e]) - 1.f; }
                else if (pc >= 224) {
#pragma unroll
                    for (int e = 0; e < 8; ++e) v[e] = sigmoidf_(v[e]); }
                *(LAS bf16x8*)(T + (row0 + j) * RP_P + 8 * pc) = pack8(v); } }
        __syncthreads();
        const int hd = w, tok = lane & 31, h = lane >> 5;
        const LAS bf16* trow = T + tok * RP_P;
#define RP_OUT(c0, dst) do { _Pragma("unroll") for (int i_ = 0; i_ < 4; ++i_) { const int row_ = 8 * i_ + (lane >> 3), pc_ = lane & 7; \
            *(u32x4*)((dst) + (size_t)(r0 + row_) * 512 + hd * 64 + 8 * pc_) = *(const LAS u32x4*)(T + row_ * RP_P + (c0) + 8 * pc_); } } while (0)
        bf16x8 wa[2][8], wg[16], wl[2][8];
#define RP_LDW_A(d_) do { _Pragma("unroll") for (int cb_ = 0; cb_ < 2; ++cb_) _Pragma("unroll") for (int s_ = 0; s_ < 4; ++s_) wa[d_][cb_ * 4 + s_] = *(const bf16x8*)(A2T + (size_t)((d_) * 512 + hd * 64 + cb_ * 32 + tok) * 64 + 16 * s_ + 8 * h); } while (0)
#define RP_LDW_L(d_) do { _Pragma("unroll") for (int cb_ = 0; cb_ < 2; ++cb_) _Pragma("unroll") for (int s_ = 0; s_ < 4; ++s_) wl[d_][cb_ * 4 + s_] = *(const bf16x8*)(W2T + (size_t)((d_) * 512 + hd * 64 + cb_ * 32 + tok) * 64 + 16 * s_ + 8 * h); } while (0)
#define RP_LDW_G() do { _Pragma("unroll") for (int cb_ = 0; cb_ < 2; ++cb_) _Pragma("unroll") for (int s_ = 0; s_ < 8; ++s_) wg[cb_ * 8 + s_] = *(const bf16x8*)(G2T + (size_t)(hd * 64 + cb_ * 32 + tok) * 128 + 16 * s_ + 8 * h); } while (0)
        RP_LDW_A(0);
        RP_OUT(hd * 64, RW); RP_OUT(1024 + hd * 64, RW + 3 * TS);
        float kraw[2][16]; float ss = 0.f;
#pragma unroll
        for (int cb = 0; cb < 2; ++cb)
#pragma unroll
            for (int g = 0; g < 4; ++g) { const int ch = hd * 64 + cb * 32 + 8 * g + 4 * h; const u32x2 kw = *(const LAS u32x2*)(trow + 512 + ch);
                kraw[cb][4 * g] = bflo(kw.x); kraw[cb][4 * g + 1] = bfhi(kw.x); kraw[cb][4 * g + 2] = bflo(kw.y); kraw[cb][4 * g + 3] = bfhi(kw.y);
                const f32x4 kk4 = *(const f32x4*)(kkw + ch);
                ss += kraw[cb][4 * g] * kk4.x * kraw[cb][4 * g] * kk4.x + kraw[cb][4 * g + 1] * kk4.y * kraw[cb][4 * g + 1] * kk4.y + kraw[cb][4 * g + 2] * kk4.z * kraw[cb][4 * g + 2] * kk4.z + kraw[cb][4 * g + 3] * kk4.w * kraw[cb][4 * g + 3] * kk4.w; }
        ss += sx(ss, 32);
        const float rkk = rsqrtf(fmaxf(ss, 1e-24f));
        LDS_WAIT();
        LAS bf16* scr3[3] = {T + hd * 64, T + 1024 + hd * 64, T + 512 + hd * 64};
#define RP_TILE_OUT(vals  , dst, NN) do { LAS bf16* scr = scr3[(NN) % 3]; const int sc0_ = ((NN) % 3 == 0 ? 0 : (NN) % 3 == 1 ? 1024 : 512) + hd * 64; _Pragma("unroll") for (int cb_ = 0; cb_ < 2; ++cb_) _Pragma("unroll") for (int g_ = 0; g_ < 4; ++g_) { u32x2 x_; x_[0] = pk2(vals[cb_][4 * g_], vals[cb_][4 * g_ + 1]); x_[1] = pk2(vals[cb_][4 * g_ + 2], vals[cb_][4 * g_ + 3]); \
            *(LAS u32x2*)(scr + tok * RP_P + cb_ * 32 + 8 * g_ + 4 * h) = x_; } LDS_WAIT(); RP_OUT(sc0_, dst); } while (0)
        { float av[2][16], o[2][16];
#pragma unroll
          for (int d = 0; d < 2; ++d) {
              if (d == 0) RP_LDW_A(1); else RP_LDW_G();
#pragma unroll
              for (int cb = 0; cb < 2; ++cb) { f32x16 c = zero16();
                  bf16x8 xf[4];
#pragma unroll
                  for (int s2 = 0; s2 < 4; ++s2) xf[s2] = *(const LAS bf16x8*)(trow + 1664 + 64 * d + 16 * s2 + 8 * h);
                  __builtin_amdgcn_sched_barrier(0);
#pragma unroll
                  for (int s2 = 0; s2 < 4; ++s2) c = __builtin_amdgcn_mfma_f32_32x32x16_bf16(wa[d][cb * 4 + s2], xf[s2], c, 0, 0, 0);
#pragma unroll
                  for (int g = 0; g < 4; ++g) { const f32x4 a4 = *(const f32x4*)(a0 + d * 512 + hd * 64 + cb * 32 + 8 * g + 4 * h);
                      av[cb][4 * g] = sigmoidf_(a4.x + c[4 * g]); av[cb][4 * g + 1] = sigmoidf_(a4.y + c[4 * g + 1]); av[cb][4 * g + 2] = sigmoidf_(a4.z + c[4 * g + 2]); av[cb][4 * g + 3] = sigmoidf_(a4.w + c[4 * g + 3]); } }
              RP_TILE_OUT(av, RW + (size_t)(5 + d) * TS, 2 * d);
#pragma unroll
              for (int cb = 0; cb < 2; ++cb)
#pragma unroll
                  for (int g = 0; g < 4; ++g) { const f32x4 ka4 = *(const f32x4*)(kaw + hd * 64 + cb * 32 + 8 * g + 4 * h);
                      o[cb][4 * g] = kraw[cb][4 * g] * (1.f + (av[cb][4 * g] - 1.f) * ka4.x); o[cb][4 * g + 1] = kraw[cb][4 * g + 1] * (1.f + (av[cb][4 * g + 1] - 1.f) * ka4.y);
                      o[cb][4 * g + 2] = kraw[cb][4 * g + 2] * (1.f + (av[cb][4 * g + 2] - 1.f) * ka4.z); o[cb][4 * g + 3] = kraw[cb][4 * g + 3] * (1.f + (av[cb][4 * g + 3] - 1.f) * ka4.w); }
              RP_TILE_OUT(o, RW + (size_t)(1 + d) * TS, 2 * d + 1); }
#pragma unroll
          for (int cb = 0; cb < 2; ++cb)
#pragma unroll
              for (int g = 0; g < 4; ++g) { const f32x4 kk4 = *(const f32x4*)(kkw + hd * 64 + cb * 32 + 8 * g + 4 * h);
                  o[cb][4 * g] = kraw[cb][4 * g] * kk4.x * rkk; o[cb][4 * g + 1] = kraw[cb][4 * g + 1] * kk4.y * rkk; o[cb][4 * g + 2] = kraw[cb][4 * g + 2] * kk4.z * rkk; o[cb][4 * g + 3] = kraw[cb][4 * g + 3] * kk4.w * rkk; }
          RP_TILE_OUT(o, RW + 4 * TS, 4); }
        { float o[2][16];
#pragma unroll
          for (int cb = 0; cb < 2; ++cb) { f32x16 c = zero16();
              if (cb == 0) RP_LDW_L(0);
              bf16x8 xf[8];
#pragma unroll
              for (int s2 = 0; s2 < 8; ++s2) xf[s2] = *(const LAS bf16x8*)(trow + 1792 + 16 * s2 + 8 * h);
              __builtin_amdgcn_sched_barrier(0);
#pragma unroll
              for (int s2 = 0; s2 < 8; ++s2) c = __builtin_amdgcn_mfma_f32_32x32x16_bf16(wg[cb * 8 + s2], xf[s2], c, 0, 0, 0);
#pragma unroll
              for (int i = 0; i < 16; ++i) o[cb][i] = c[i]; }
          RP_TILE_OUT(o, RW + 7 * TS, 5); }
#pragma unroll
        for (int d = 0; d < 2; ++d)
#pragma unroll
            for (int cb = 0; cb < 2; ++cb) { f32x16 c = zero16();
                if (d == 0 && cb == 0) RP_LDW_L(1);
                bf16x8 xf[4];
#pragma unroll
                for (int s2 = 0; s2 < 4; ++s2) xf[s2] = *(const LAS bf16x8*)(trow + 1536 + 64 * d + 16 * s2 + 8 * h);
                __builtin_amdgcn_sched_barrier(0);
#pragma unroll
                for (int s2 = 0; s2 < 4; ++s2) c = __builtin_amdgcn_mfma_f32_32x32x16_bf16(wl[d][cb * 4 + s2], xf[s2], c, 0, 0, 0);
                LAS float* fs = (LAS float*)scr3[(6 + 2 * d + cb) % 3];
#pragma unroll
                for (int g = 0; g < 4; ++g) { const f32x4 w4 = *(const f32x4*)(w0 + d * 512 + hd * 64 + cb * 32 + 8 * g + 4 * h);
                    *(LAS f32x4*)(fs + tok * (RP_P / 2) + 8 * g + 4 * h) = (f32x4){-0.6065306597f * sigmoidf_(w4.x + c[4 * g]), -0.6065306597f * sigmoidf_(w4.y + c[4 * g + 1]), -0.6065306597f * sigmoidf_(w4.z + c[4 * g + 2]), -0.6065306597f * sigmoidf_(w4.w + c[4 * g + 3])}; }
                LDS_WAIT();
#pragma unroll
                for (int i_ = 0; i_ < 4; ++i_) { const int row_ = 8 * i_ + (lane >> 3), pc_ = lane & 7;
                    *(f32x4*)(LW + (size_t)d * TS + (size_t)(r0 + row_) * 512 + hd * 64 + cb * 32 + 4 * pc_) = *(const LAS f32x4*)(fs + row_ * (RP_P / 2) + 4 * pc_); } }
        LDS_WAIT();
#undef RP_OUT
#undef RP_TILE_OUT
#undef RP_LDW_A
#undef RP_LDW_L
#undef RP_LDW_G
    }
}

constexpr int NCHUNK = LTOT / 64;
constexpr int NCHAIN = BATCH * 8 * 2;
constexpr int RC_P = 72;
constexpr int RC_TILE = 64 * RC_P * 2;
constexpr int RC_LTF = 13 * RC_TILE, RC_EC = RC_LTF + 64 * 65 * 4;
DI int chain_pos(int dir, int n) { return dir == 0 ? n : (n < CTX ? CTX - 1 - n : LTOT - 1 - (n - CTX)); }
DI f32x16 mm_blk(const LAS bf16* A, int mb, const LAS bf16* Bt, int nb, int k0, int ksteps, int lane, f32x16 acc) {
    const int r = lane & 31, h = lane >> 5;
    bf16x8 fa[4], fb[4];
#pragma unroll
    for (int q = 0; q < 4; ++q) if (q < ksteps) { fa[q] = *(const LAS bf16x8*)(A + (mb * 32 + r) * RC_P + k0 + 16 * q + 8 * h); fb[q] = *(const LAS bf16x8*)(Bt + (nb * 32 + r) * RC_P + k0 + 16 * q + 8 * h); }
    __builtin_amdgcn_sched_barrier(0);
#pragma unroll
    for (int q = 0; q < 4; ++q) if (q < ksteps) acc = __builtin_amdgcn_mfma_f32_32x32x16_bf16(fa[q], fb[q], acc, 0, 0, 0);
    return acc;
}
DI void st_tile_T(LAS bf16* tile, int mb, int nb, const f32x16& d, int lane) {
    const int r = lane & 31, h = lane >> 5;
#pragma unroll
    for (int g = 0; g < 4; ++g) { u32x2 x; x.x = pk2(d[4 * g], d[4 * g + 1]); x.y = pk2(d[4 * g + 2], d[4 * g + 3]); *(LAS u32x2*)(tile + (nb * 32 + r) * RC_P + mb * 32 + 8 * g + 4 * h) = x; }
}
constexpr int RC_LTF2 = 13 * RC_TILE, RC_EC2 = RC_LTF2 + 2 * 32 * 36 * 4, RC_ST = RC_EC2 + 256;
static_assert(RC_ST + RC_TILE <= LDS_MISC_OFF, "rwkv chain LDS map");
DI void rwkv_chain_block(Frame& F, int chain) {
    const int w_ = F.wave;
    const int dir = chain & 1, bh = chain >> 1, b = bh >> 3, hd = bh & 7;
    const bf16* RW = (const bf16*)(F.ws + WS_RW); const float* LW = (const float*)(F.ws + WS_LW); const size_t TS = (size_t)NT * 512;
    bf16* Yg = (bf16*)(F.ws + WS_YF) + (size_t)dir * TS + (size_t)b * LTOT * 512 + hd * 64;
    LAS bf16* tiles = (LAS bf16*)F.lds;
#define TILE(i) (tiles + (i) * (RC_TILE / 2))
    LAS float* LTf = (LAS float*)(F.lds + RC_LTF2); LAS float* EC = (LAS float*)(F.lds + RC_EC2); LAS bf16* ST = (LAS bf16*)(F.lds + RC_ST);
    __syncthreads();
    { const int lane0 = fresh_lane(); for (int i = w_ * 64 + lane0; i < RC_TILE / 4; i += NTHREADS) ((LAS unsigned*)ST)[i] = 0u; }
    f32x4 nl0, nl1; u32x4 nr, nk, nv, nkk, na;
#define RC_LOAD(cc) do { const int lane_ = fresh_lane(); const int p_ = chain_pos(dir, 64 * (cc) + lane_); const size_t off_ = ((size_t)b * LTOT + p_) * 512 + hd * 64 + 8 * w; \
        nl0 = *(const f32x4*)(LW + (size_t)dir * TS + off_); nl1 = *(const f32x4*)(LW + (size_t)dir * TS + off_ + 4); nr = *(const u32x4*)(RW + off_); nk = *(const u32x4*)(RW + (size_t)(1 + dir) * TS + off_); \
        nv = *(const u32x4*)(RW + 3 * TS + off_); nkk = *(const u32x4*)(RW + 4 * TS + off_); na = *(const u32x4*)(RW + (size_t)(5 + dir) * TS + off_); } while (0)
    { const int w = w_; RC_LOAD(0); }
#pragma unroll 1
    for (int c = 0; c < NCHUNK; ++c) {
        const int lane = fresh_lane(); int w = w_; asm volatile("" : "+s"(w));
        { const f32x4 l0 = nl0, l1 = nl1; const u32x4 ur = nr, uk = nk, uv = nv, ukk = nkk, ua = na;
          float lw[8] = {l0.x, l0.y, l0.z, l0.w, l1.x, l1.y, l1.z, l1.w}, cw[8];
#pragma unroll
          for (int j = 0; j < 8; ++j) cw[j] = lw[j];
#pragma unroll
          for (int j = 0; j < 8; ++j) cw[j] = dpp_scan64(cw[j]);
          const unsigned rw_[4] = {ur.x, ur.y, ur.z, ur.w}, kw_[4] = {uk.x, uk.y, uk.z, uk.w}, kkw_[4] = {ukk.x, ukk.y, ukk.z, ukk.w}, aw_[4] = {ua.x, ua.y, ua.z, ua.w};
          float At[8], Rt[8], Bt[8], Kt[8];
#pragma unroll
          for (int j = 0; j < 8; ++j) { const float rr = (j & 1) ? bfhi(rw_[j >> 1]) : bflo(rw_[j >> 1]), kk = (j & 1) ? bfhi(kkw_[j >> 1]) : bflo(kkw_[j >> 1]), k = (j & 1) ? bfhi(kw_[j >> 1]) : bflo(kw_[j >> 1]), aa = (j & 1) ? bfhi(aw_[j >> 1]) : bflo(aw_[j >> 1]);
              const float ep = __expf(cw[j]), em = __expf(-cw[j]), epv = __expf(cw[j] - lw[j]);
              At[j] = -kk * epv; Rt[j] = rr * ep; Bt[j] = kk * aa * em; Kt[j] = k * em;
              if (lane == 63) EC[8 * w + j] = ep; }
          const bf16x8 fa = pack8(At), fr_ = pack8(Rt), fb = pack8(Bt), fk = pack8(Kt);
          *(LAS bf16x8*)(TILE(0) + lane * RC_P + 8 * w) = fa; *(LAS bf16x8*)(TILE(1) + lane * RC_P + 8 * w) = fr_; *(LAS bf16x8*)(TILE(2) + lane * RC_P + 8 * w) = fb; *(LAS bf16x8*)(TILE(3) + lane * RC_P + 8 * w) = fk;
          const unsigned vw_[4] = {uv.x, uv.y, uv.z, uv.w};
#pragma unroll
          for (int j = 0; j < 8; ++j) { TILE(4)[(8 * w + j) * RC_P + lane] = (bf16)fa[j]; TILE(5)[(8 * w + j) * RC_P + lane] = (bf16)fb[j]; TILE(6)[(8 * w + j) * RC_P + lane] = (bf16)fk[j];
              TILE(7)[(8 * w + j) * RC_P + lane] = (bf16)((j & 1) ? (vw_[j >> 1] >> 16) : (vw_[j >> 1] & 0xffffu)); } }
        LDS_BARRIER();
        if (c + 1 < NCHUNK) RC_LOAD(c + 1);
        { const int pi = w >> 1, nb = w & 1, r = lane & 31, h = lane >> 5;
          const LAS bf16* Aop = (pi == 0 || pi == 2) ? TILE(2) : TILE(3);
          const LAS bf16* Bop = pi < 2 ? TILE(0) : TILE(1);
          LAS bf16* dst = TILE(8 + pi);
#pragma unroll
          for (int mb = 0; mb < 2; ++mb) { f32x16 d = zero16();
              if (mb <= nb) d = mm_blk(Aop, mb, Bop, nb, 0, 4, lane, d);
#pragma unroll
              for (int i = 0; i < 16; ++i) { const int m = mb * 32 + crow16(i, h), n = nb * 32 + r; const bool keep = pi < 2 ? m < n : m <= n; d[i] = keep ? d[i] : 0.f; }
              st_tile_T(dst, mb, nb, d, lane);
              if (pi == 0 && mb == nb) {
#pragma unroll
                  for (int i = 0; i < 16; ++i) LTf[(mb * 32 + crow16(i, h)) * 36 + r] = d[i]; } } }
        LDS_BARRIER();
        if (w == 0) {
            { const int k = lane >> 4, tl = lane & 15, blk = k >> 1, o16 = (k & 1) * 16;
              float Tr[16];
#pragma unroll
              for (int i = 0; i < 16; ++i) Tr[i] = 0.f;
#pragma unroll
              for (int cc = 15; cc >= 0; --cc) { float a0 = (cc == tl) ? 1.f : 0.f, a1 = 0.f;
                  const LAS float* lrow = LTf + (blk * 32 + o16 + cc) * 36 + o16;
#pragma unroll
                  for (int q4 = (cc + 1) >> 2; q4 < 4; ++q4) { const f32x4 l4 = *(const LAS f32x4*)(lrow + 4 * q4);
#pragma unroll
                      for (int e = 0; e < 4; ++e) { const int s2 = 4 * q4 + e; if (s2 > cc) { if (e & 1) a1 += Tr[s2] * l4[e]; else a0 += Tr[s2] * l4[e]; } } }
                  Tr[cc] = a0 + a1; if ((cc & 3) == 0) asm volatile("" ::: "memory"); }
              unsigned z0; asm volatile("v_mov_b32 %0, 0" : "=v"(z0)); const u32x4 zz = {z0, z0, z0, z0};
              LAS bf16* trow = TILE(12) + lane * RC_P; LAS bf16* ttrow = TILE(0) + lane * RC_P;
#pragma unroll
              for (int g = 0; g < 8; ++g) { *(LAS u32x4*)(trow + 8 * g) = zz; *(LAS u32x4*)(ttrow + 8 * g) = zz; }
              *(LAS bf16x8*)(trow + 16 * k) = pack8(Tr); *(LAS bf16x8*)(trow + 16 * k + 8) = pack8(Tr + 8);
#pragma unroll
              for (int i = 0; i < 16; ++i) TILE(0)[(16 * k + i) * RC_P + lane] = f2bf(Tr[i]); }
            LDS_WAIT();
            { const int r = lane & 31, h = lane >> 5;
#pragma unroll
              for (int blk = 0; blk < 2; ++blk) {
                  f32x16 x = zero16();
                  x = __builtin_amdgcn_mfma_f32_32x32x16_bf16(*(const LAS bf16x8*)(TILE(8) + (32 * blk + r) * RC_P + 32 * blk + 8 * h), *(const LAS bf16x8*)(TILE(0) + (32 * blk + r) * RC_P + 32 * blk + 8 * h), x, 0, 0, 0);
                  st_tile_T(TILE(2), 0, blk, x, lane);
                  LDS_WAIT();
                  f32x16 d = zero16();
                  d = __builtin_amdgcn_mfma_f32_32x32x16_bf16(*(const LAS bf16x8*)(TILE(12) + (32 * blk + r) * RC_P + 32 * blk + 16 + 8 * h), *(const LAS bf16x8*)(TILE(2) + (32 * blk + r) * RC_P + 16 + 8 * h), d, 0, 0, 0);
                  if (r < 16) {
#pragma unroll
                      for (int i = 8; i < 16; ++i) TILE(12)[(32 * blk + crow16(i, h)) * RC_P + 32 * blk + r] = f2bf(d[i]);
                      { u32x2 y0, y1; y0.x = pk2(d[8], d[9]); y0.y = pk2(d[10], d[11]); y1.x = pk2(d[12], d[13]); y1.y = pk2(d[14], d[15]);
                        *(LAS u32x2*)(TILE(0) + (32 * blk + r) * RC_P + 32 * blk + 16 + 4 * h) = y0; *(LAS u32x2*)(TILE(0) + (32 * blk + r) * RC_P + 32 * blk + 24 + 4 * h) = y1; } }
                  LDS_WAIT(); } }
            LDS_WAIT();
            f32x16 m1 = mm_blk(TILE(8), 1, TILE(0), 0, 0, 2, lane, zero16());
            st_tile_T(TILE(2), 0, 0, m1, lane);
            LDS_WAIT();
            { const int r = lane & 31, h = lane >> 5; f32x16 d = zero16();
#pragma unroll
              for (int q = 0; q < 2; ++q) { const bf16x8 a = *(const LAS bf16x8*)(TILE(2) + r * RC_P + 16 * q + 8 * h), bb = *(const LAS bf16x8*)(TILE(12) + (32 + r) * RC_P + 32 + 16 * q + 8 * h);
                  d = __builtin_amdgcn_mfma_f32_32x32x16_bf16(a, bb, d, 0, 0, 0); }
#pragma unroll
              for (int g = 0; g < 4; ++g) { u32x2 x; x.x = pk2(d[4 * g], d[4 * g + 1]); x.y = pk2(d[4 * g + 2], d[4 * g + 3]); *(LAS u32x2*)(TILE(12) + (32 + r) * RC_P + 8 * g + 4 * h) = x; } }
        } else if (w <= 4) {
            const int mb = (w - 1) >> 1, nb = (w - 1) & 1;
            const f32x16 u = mm_blk(TILE(9), mb, TILE(7), nb, 0, 4, lane, zero16());
            st_tile_T(TILE(3), mb, nb, u, lane);
        }
        LDS_BARRIER();
        { const int mb = (w >> 1) & 1, nb = w & 1;
          if (w < 4) { const f32x16 d = mm_blk(TILE(12), mb, TILE(4), nb, 0, 4, lane, zero16()); st_tile_T(TILE(2), mb, nb, d, lane); }
          else { const f32x16 d = mm_blk(TILE(12), mb, TILE(3), nb, 0, 4, lane, zero16()); st_tile_T(TILE(0), mb, nb, d, lane); } }
        LDS_BARRIER();
        const int mb = (w >> 1) & 1, nb = w & 1, r = lane & 31, h = lane >> 5;
        f32x16 cin;
        if (w < 4) {
            f32x16 d = mm_blk(TILE(2), mb, TILE(5), nb, 0, 4, lane, zero16());
#pragma unroll
            for (int i = 0; i < 16; ++i) { const int m = mb * 32 + crow16(i, h), n = nb * 32 + r; d[i] = (d[i] + (m == n ? 1.f : 0.f)) * EC[n]; }
            st_tile_T(TILE(8), mb, nb, d, lane);
            cin = mm_blk(TILE(5), mb, TILE(0), nb, 0, 4, lane, zero16()); cin = mm_blk(TILE(6), mb, TILE(7), nb, 0, 4, lane, cin);
#pragma unroll
            for (int i = 0; i < 16; ++i) cin[i] *= EC[mb * 32 + crow16(i, h)];
        } else {
            f32x16 d = mm_blk(TILE(2), mb, TILE(10), nb, 0, 4, lane, zero16());
#pragma unroll
            for (int i = 0; i < 16; ++i) { const int m = mb * 32 + crow16(i, h), n = nb * 32 + r; d[i] += bf2f(TILE(1)[n * RC_P + m]); }
            st_tile_T(TILE(9), mb, nb, d, lane);
            cin = mm_blk(TILE(10), mb, TILE(0), nb, 0, 4, lane, zero16()); cin = mm_blk(TILE(11), mb, TILE(7), nb, 0, 4, lane, cin);
        }
        LDS_BARRIER();
        if (w < 4) cin = mm_blk(TILE(8), mb, ST, nb, 0, 4, lane, cin);
        else { cin = mm_blk(TILE(9), mb, ST, nb, 0, 4, lane, cin);
#pragma unroll
            for (int i = 0; i < 16; ++i) { const int p = chain_pos(dir, 64 * c + mb * 32 + crow16(i, h)); Yg[(size_t)p * 512 + nb * 32 + r] = f2bf(cin[i]); } }
        LDS_BARRIER();
        if (w < 4) st_tile_T(ST, mb, nb, cin, lane);
    }
#undef RC_LOAD
#undef TILE
}
constexpr int RT_QP = 72, RT_TP = 136;
constexpr int RT_QS = 0, RT_KS = 128 * RT_QP * 2, RT_KT = 2 * 128 * RT_QP * 2, RT_VT = RT_KT + 64 * RT_TP * 2, RT_ST = RT_VT + 128 * RT_TP * 2;
DI void phase_retention_item(Frame& F, const KA& a, int item) {
    const int b = item >> 2, hh = item & 3, w = F.wave;
    const bf16* P = (const bf16*)(F.ws + WS_P); const float2* rt = (const float2*)(F.ws + WS_ROPE);
    bf16* OFB = (bf16*)(F.ws + WS_OF); const size_t TS = (size_t)NT * 512;
    LAS bf16* Qs = (LAS bf16*)(F.lds + RT_QS); LAS bf16* Ks = (LAS bf16*)(F.lds + RT_KS); LAS bf16* KsT = (LAS bf16*)(F.lds + RT_KT); LAS bf16* VsT = (LAS bf16*)(F.lds + RT_VT); LAS bf16* SsT = (LAS bf16*)(F.lds + RT_ST);
    const float lg2g = log2f(1.f - exp2f(-5.f - (float)hh));
    const float gam = exp2f(lg2g), g127 = exp2f(127.f * lg2g), cdec = exp2f(128.f * lg2g);
    const int rb = w >> 1, cbp = w & 1, db = w >> 2, vb = w & 3;
    for (int dir = 0; dir < 2; ++dir) {
        const int lane = fresh_lane(); const int tid = w * 64 + lane, ql = lane & 31, h = lane >> 5;
        f32x16 Sreg;
#pragma unroll
        for (int i = 0; i < 16; ++i) Sreg[i] = 0.f;
        __syncthreads();
        for (int i = tid; i < 128 * RT_QP / 2; i += NTHREADS) ((LAS unsigned*)SsT)[i] = 0u;
        for (int cn = 0; cn < 34; ++cn) {
            int p0; if (cn < 2) p0 = 128 * (dir ? 1 - cn : cn); else p0 = CTX + 128 * (dir ? 33 - cn : cn - 2);
            const bool lat = p0 >= CTX;
            { int tid_o = tid; asm volatile("" : "+v"(tid_o)); const int tok = tid_o >> 2, c = tid_o & 3; const int e = dir ? 127 - tok : tok; const size_t row = (size_t)b * LTOT + p0 + tok; const bf16* prow = P + row * DINP;
              const float sq = exp2f((float)e * lg2g), sk = 0.125f * exp2f(-(float)e * lg2g);
              const u32x4 ql_ = *(const u32x4*)(prow + PC_RQ + hh * 64 + 8 * c), qh_ = *(const u32x4*)(prow + PC_RQ + hh * 64 + 32 + 8 * c);
              const u32x4 kl_ = *(const u32x4*)(prow + PC_RK + hh * 64 + 8 * c), kh_ = *(const u32x4*)(prow + PC_RK + hh * 64 + 32 + 8 * c);
              float qlo[8] = {bflo(ql_.x), bfhi(ql_.x), bflo(ql_.y), bfhi(ql_.y), bflo(ql_.z), bfhi(ql_.z), bflo(ql_.w), bfhi(ql_.w)}, qhi[8] = {bflo(qh_.x), bfhi(qh_.x), bflo(qh_.y), bfhi(qh_.y), bflo(qh_.z), bfhi(qh_.z), bflo(qh_.w), bfhi(qh_.w)};
              float klo[8] = {bflo(kl_.x), bfhi(kl_.x), bflo(kl_.y), bfhi(kl_.y), bflo(kl_.z), bfhi(kl_.z), bflo(kl_.w), bfhi(kl_.w)}, khi[8] = {bflo(kh_.x), bfhi(kh_.x), bflo(kh_.y), bfhi(kh_.y), bflo(kh_.z), bfhi(kh_.z), bflo(kh_.w), bfhi(kh_.w)};
              if (lat) { const float2* ang = rt + (size_t)(p0 - CTX + tok) * 32 + 8 * c;
#pragma unroll
                  for (int j = 0; j < 8; ++j) { const float2 cs = ang[j]; const float a0 = qlo[j], a1 = qhi[j], b0 = klo[j], b1 = khi[j];
                      qlo[j] = a0 * cs.x - a1 * cs.y; qhi[j] = a0 * cs.y + a1 * cs.x; klo[j] = b0 * cs.x - b1 * cs.y; khi[j] = b0 * cs.y + b1 * cs.x; } }
#pragma unroll
              for (int j = 0; j < 8; ++j) { qlo[j] *= sq; qhi[j] *= sq; klo[j] *= sk; khi[j] *= sk; }
              *(LAS bf16x8*)(Qs + tok * RT_QP + 8 * c) = pack8(qlo); *(LAS bf16x8*)(Qs + tok * RT_QP + 32 + 8 * c) = pack8(qhi);
              *(LAS bf16x8*)(Ks + tok * RT_QP + 8 * c) = pack8(klo); *(LAS bf16x8*)(Ks + tok * RT_QP + 32 + 8 * c) = pack8(khi);
              const int pt = permpos(tok);
#pragma unroll
              for (int j = 0; j < 8; ++j) { KsT[(8 * c + j) * RT_TP + pt] = f2bf(klo[j]); KsT[(32 + 8 * c + j) * RT_TP + pt] = f2bf(khi[j]); }
#pragma unroll
              for (int q4 = 0; q4 < 4; ++q4) { const u32x4 vv = *(const u32x4*)(prow + PC_RV + hh * 128 + 32 * c + 8 * q4); const unsigned vw[4] = {vv.x, vv.y, vv.z, vv.w};
#pragma unroll
                  for (int j = 0; j < 4; ++j) { VsT[(32 * c + 8 * q4 + 2 * j) * RT_TP + pt] = (bf16)(vw[j] & 0xffffu); VsT[(32 * c + 8 * q4 + 2 * j + 1) * RT_TP + pt] = (bf16)(vw[j] >> 16); } } }
            __syncthreads();
            f32x16 o0, o1;
#pragma unroll
            for (int i = 0; i < 16; ++i) { o0[i] = 0.f; o1[i] = 0.f; }
            for (int kb = 0; kb < 4; ++kb) {
                if (dir == 0 ? kb > rb : kb < rb) continue;
                f32x16 x;
#pragma unroll
                for (int i = 0; i < 16; ++i) x[i] = 0.f;
#pragma unroll
                for (int s = 0; s < 4; ++s) x = __builtin_amdgcn_mfma_f32_32x32x16_bf16(*(const LAS bf16x8*)(Ks + (kb * 32 + ql) * RT_QP + 16 * s + 8 * h), *(const LAS bf16x8*)(Qs + (rb * 32 + ql) * RT_QP + 16 * s + 8 * h), x, 0, 0, 0);
                if (kb == rb) {
#pragma unroll
                    for (int i = 0; i < 16; ++i) { const int key = crow16(i, h); const bool keep = dir == 0 ? key <= ql : key >= ql; x[i] = keep ? x[i] : 0.f; } }
                float xv[16];
#pragma unroll
                for (int i = 0; i < 16; ++i) xv[i] = x[i];
                const bf16x8 xa0 = pack8(xv), xa1 = pack8(xv + 8);
                const LAS bf16* v0 = VsT + ((2 * cbp) * 32 + ql) * RT_TP + kb * 32 + 8 * h; const LAS bf16* v1 = VsT + ((2 * cbp + 1) * 32 + ql) * RT_TP + kb * 32 + 8 * h;
                o0 = __builtin_amdgcn_mfma_f32_32x32x16_bf16(xa0, *(const LAS bf16x8*)(v0), o0, 0, 0, 0); o0 = __builtin_amdgcn_mfma_f32_32x32x16_bf16(xa1, *(const LAS bf16x8*)(v0 + 16), o0, 0, 0, 0);
                o1 = __builtin_amdgcn_mfma_f32_32x32x16_bf16(xa0, *(const LAS bf16x8*)(v1), o1, 0, 0, 0); o1 = __builtin_amdgcn_mfma_f32_32x32x16_bf16(xa1, *(const LAS bf16x8*)(v1 + 16), o1, 0, 0, 0);
            }
#pragma unroll
            for (int s = 0; s < 4; ++s) { const bf16x8 qa = *(const LAS bf16x8*)(Qs + (rb * 32 + ql) * RT_QP + 16 * s + 8 * h);
                o0 = __builtin_amdgcn_mfma_f32_32x32x16_bf16(qa, *(const LAS bf16x8*)(SsT + ((2 * cbp) * 32 + ql) * RT_QP + 16 * s + 8 * h), o0, 0, 0, 0);
                o1 = __builtin_amdgcn_mfma_f32_32x32x16_bf16(qa, *(const LAS bf16x8*)(SsT + ((2 * cbp + 1) * 32 + ql) * RT_QP + 16 * s + 8 * h), o1, 0, 0, 0); }
            { bf16* op = OFB + (size_t)dir * TS + ((size_t)b * LTOT + p0 + rb * 32) * 512 + hh * 128 + (2 * cbp) * 32 + ql;
#pragma unroll
              for (int i = 0; i < 16; ++i) { op[(size_t)crow16(i, h) * 512] = f2bf(o0[i]); op[(size_t)crow16(i, h) * 512 + 32] = f2bf(o1[i]); } }
            f32x16 u;
#pragma unroll
            for (int i = 0; i < 16; ++i) u[i] = 0.f;
#pragma unroll
            for (int s = 0; s < 8; ++s) u = __builtin_amdgcn_mfma_f32_32x32x16_bf16(*(const LAS bf16x8*)(KsT + (db * 32 + ql) * RT_TP + 16 * s + 8 * h), *(const LAS bf16x8*)(VsT + (vb * 32 + ql) * RT_TP + 16 * s + 8 * h), u, 0, 0, 0);
#pragma unroll
            for (int i = 0; i < 16; ++i) Sreg[i] = cdec * Sreg[i] + g127 * u[i];
            __syncthreads();
#pragma unroll
            for (int g = 0; g < 4; ++g) { u32x2 x; x.x = pk2(gam * Sreg[4 * g], gam * Sreg[4 * g + 1]); x.y = pk2(gam * Sreg[4 * g + 2], gam * Sreg[4 * g + 3]);
                *(LAS u32x2*)(SsT + (vb * 32 + ql) * RT_QP + db * 32 + 8 * g + 4 * h) = x; }
        }
    }
}

DI void phase_mixer_finish(Frame& F, const KA& a, int l) {
    const int lane = fresh_lane(), gw = F.bid * NWAVES + F.wave, NGW = F.G * NWAVES;
    const size_t TS = (size_t)NT * 512;
    const bf16* P = (const bf16*)(F.ws + WS_P); const bf16* OFB = (const bf16*)(F.ws + WS_OF); const bf16* YF = (const bf16*)(F.ws + WS_YF); const bf16* RW = (const bf16*)(F.ws + WS_RW);
    bf16* O0 = (bf16*)(F.ws + WS_ABR); bf16* O2 = O0 + 2 * TS;
    const float* lng = a.in(I_LNXG) + l * 512 + 8 * lane; const float* lnb = a.in(I_LNXB) + l * 512 + 8 * lane; const float* rkw = a.in(I_RK) + l * 512 + 8 * lane;
    float g_[8], b_[8], rk_[8];
    { const f32x4 x0 = *(const f32x4*)lng, x1 = *(const f32x4*)(lng + 4), y0 = *(const f32x4*)lnb, y1 = *(const f32x4*)(lnb + 4), z0 = *(const f32x4*)rkw, z1 = *(const f32x4*)(rkw + 4);
      g_[0] = x0.x; g_[1] = x0.y; g_[2] = x0.z; g_[3] = x0.w; g_[4] = x1.x; g_[5] = x1.y; g_[6] = x1.z; g_[7] = x1.w;
      b_[0] = y0.x; b_[1] = y0.y; b_[2] = y0.z; b_[3] = y0.w; b_[4] = y1.x; b_[5] = y1.y; b_[6] = y1.z; b_[7] = y1.w;
      rk_[0] = z0.x; rk_[1] = z0.y; rk_[2] = z0.z; rk_[3] = z0.w; rk_[4] = z1.x; rk_[5] = z1.y; rk_[6] = z1.z; rk_[7] = z1.w; }
#pragma unroll 2
    for (int r = gw; r < NT; r += NGW) {
        const size_t o = (size_t)r * 512 + 8 * lane;
        { float yfv[8], ybv[8]; { const u32x4 uf = *(const u32x4*)(YF + o), ub = *(const u32x4*)(YF + TS + o); unpack8(uf, yfv); unpack8(ub, ybv); }
          const u32x4 ur = *(const u32x4*)(RW + o), ukf = *(const u32x4*)(RW + TS + o), ukb = *(const u32x4*)(RW + 2 * TS + o), uv = *(const u32x4*)(RW + 3 * TS + o), ug = *(const u32x4*)(RW + 7 * TS + o);
          float s[8];
#pragma unroll
          for (int j = 0; j < 8; ++j) s[j] = yfv[j] + ybv[j];
          float rr[8], kf[8], kb[8], vv[8], gg[8]; unpack8(ur, rr); unpack8(ukf, kf); unpack8(ukb, kb); unpack8(uv, vv); unpack8(ug, gg);
          float sm = 0.f, bn = 0.f;
#pragma unroll
          for (int j = 0; j < 8; ++j) { sm += s[j]; bn += rr[j] * (kf[j] + kb[j]) * rk_[j]; }
          sm += sx(sm, 1); sm += sx(sm, 2); sm += sx(sm, 4); bn += sx(bn, 1); bn += sx(bn, 2); bn += sx(bn, 4);
          const float mean = sm * (1.f / 64.f); float vs = 0.f;
#pragma unroll
          for (int j = 0; j < 8; ++j) { s[j] -= mean; vs += s[j] * s[j]; }
          vs += sx(vs, 1); vs += sx(vs, 2); vs += sx(vs, 4);
          const float rstd = rsqrtf(vs * (1.f / 64.f) + 64e-5f);
          float y[8];
#pragma unroll
          for (int j = 0; j < 8; ++j) y[j] = (s[j] * rstd * g_[j] + b_[j] + bn * vv[j]) * gg[j];
          *(bf16x8*)(O2 + o) = pack8(y); }
        { float ff[8], bb[8]; { const u32x4 uf = *(const u32x4*)(OFB + o), ub = *(const u32x4*)(OFB + TS + o); unpack8(uf, ff); unpack8(ub, bb); }
          const u32x4 ugf = *(const u32x4*)(P + (size_t)r * DINP + PC_RGF + 8 * lane), ugb = *(const u32x4*)(P + (size_t)r * DINP + PC_RGB + 8 * lane);
          float gf[8], gb[8]; unpack8(ugf, gf); unpack8(ugb, gb);
          float sf = 0.f, sb = 0.f;
#pragma unroll
          for (int j = 0; j < 8; ++j) { sf += ff[j]; sb += bb[j]; }
#pragma unroll
          for (int o2 = 1; o2 < 16; o2 <<= 1) { sf += sx(sf, o2); sb += sx(sb, o2); }
          const float mf = sf * (1.f / 128.f), mb = sb * (1.f / 128.f); float vf = 0.f, vb = 0.f;
#pragma unroll
          for (int j = 0; j < 8; ++j) { ff[j] -= mf; bb[j] -= mb; vf += ff[j] * ff[j]; vb += bb[j] * bb[j]; }
#pragma unroll
          for (int o2 = 1; o2 < 16; o2 <<= 1) { vf += sx(vf, o2); vb += sx(vb, o2); }
          const float rf = rsqrtf(vf * (1.f / 128.f) + 1e-5f), rb = rsqrtf(vb * (1.f / 128.f) + 1e-5f);
          float y[8];
#pragma unroll
          for (int j = 0; j < 8; ++j) y[j] = ff[j] * rf * (gf[j] * sigmoidf_(gf[j])) + bb[j] * rb * (gb[j] * sigmoidf_(gb[j]));
          *(bf16x8*)(O0 + o) = pack8(y); }
    }
}

constexpr int N_PHASES = 2 + 10 * DEPTH;
__global__ void __launch_bounds__(NTHREADS, 2) fwd_kernel(Args args) {
    extern __shared__ __attribute__((aligned(16))) unsigned char lds_raw[];
    Frame F;
    F.lds = (LAS unsigned char*)lds_raw;
    F.MISC = (volatile LAS unsigned*)(F.lds + LDS_MISC_OFF);
    F.tid = threadIdx.x; F.lane = F.tid & 63; F.wave = __builtin_amdgcn_readfirstlane(F.tid >> 6);
    F.G = gridDim.x; F.bid = blockIdx.x;
    F.ws = args.ws; F.ctl = (unsigned*)(args.ws + WS_CTL);
    if (F.tid < 32) F.MISC[F.tid] = 0u;
    __syncthreads();
    const int lo = args.ph_lo, hi = args.ph_hi;
    KA ka; ka.kp = (const CAS char*)__builtin_amdgcn_kernarg_segment_ptr();
    const bool multi = (hi - lo) > 1;
    XcdBarrier bar; bar.bar = F.ctl + CW_BAR; bar.x = 0; bar.st = nullptr;
    if (multi) bar = xcd_barrier_post(F.ctl + CW_BAR, F.MISC + 8);
#define IN(k) (lo <= (k) && (k) < hi)
#define OPQ() do { int l_; asm volatile("v_mbcnt_lo_u32_b32 %0, -1, 0\n\tv_mbcnt_hi_u32_b32 %0, -1, %0" : "=v"(l_)); { int b_ = F.bid, w_ = F.wave, g_ = F.G; asm volatile("" : "+s"(b_), "+s"(w_), "+s"(g_)); F.bid = b_; F.wave = w_; F.G = g_; } F.lane = l_; F.tid = F.wave * 64 + l_; \
        const CAS char* kp_ = (const CAS char*)__builtin_amdgcn_kernarg_segment_ptr(); asm volatile("" : "+s"(kp_)); ka.kp = kp_; F.ws = ka.ws(); F.ctl = (unsigned*)(F.ws + WS_CTL); } while (0)
#define SEAM(k) do { if (IN(k) && IN((k) + 1)) xcd_barrier(bar); } while (0)

    if (IN(0)) { OPQ(); phase_prologue(F, ka); } SEAM(0);
    if (IN(1)) { OPQ(); phase_init_rows(F, ka); } SEAM(1);

    for (int l = 0; l < DEPTH; ++l) {
        const int pb = 2 + 10 * l;
        if (IN(pb + 0)) { OPQ(); unsigned char* ws = F.ws;
            SchedInproj S; S.T.init(NT / 256, DINP / 256, F.G, F.bid); S.A = (const char*)(ws + WS_H); S.B = (const char*)(ws + WS_WIN + (size_t)l * 15 * MiB);
            EpiStoreBf16 E{(bf16*)(ws + WS_P), DINP};
            pg8::gemm_phase<EpiStoreBf16, SchedInproj, false>(F.lds, 1024, S, E, F.tid);
        }
        SEAM(pb + 0);
        if (IN(pb + 1)) { OPQ(); phase_mla_prep2(F, ka, l); OPQ(); phase_rwkv_prep2(F, ka, l); }
        SEAM(pb + 1);
#define ATTN_QUEUE(qword, ubeg, uend) do { const int xq_ = F.bid & 7; for (;;) { __syncthreads(); \
            if (F.wave == 0 && fresh_lane() == 0) F.MISC[0] = (unsigned)(ubeg) + __hip_atomic_fetch_add(F.ctl + (qword) + xq_, 1u, __ATOMIC_RELAXED, __HIP_MEMORY_SCOPE_AGENT); \
            __syncthreads(); const int u = (int)F.MISC[0]; if (u >= (uend)) break; \
            if (u < 128) attn_unit(F, u >> 4, xq_, 1 + (u & 15)); else attn_unit(F, u - 128, xq_, 0); } } while (0)
        const int nunits = (l == DEPTH - 1) ? 128 : 136;
        if (IN(pb + 2)) { OPQ();
            if (F.bid < NCHAIN) rwkv_chain_block(F, F.bid);
            else if (F.bid < NCHAIN + 32) phase_retention_item(F, ka, F.bid - NCHAIN);
            OPQ(); ATTN_QUEUE(CW_Q + l * 64, 0, nunits);
        }
        SEAM(pb + 2);
        if (IN(pb + 3)) { OPQ(); phase_mixer_finish(F, ka, l); }
        SEAM(pb + 3);
        if (IN(pb + 4)) { OPQ(); unsigned char* ws = F.ws;
            SchedMerge S; S.T.init(NT / 256, 4, F.G, F.bid); S.A = (const char*)(ws + WS_ABR); S.B = (const char*)(ws + WS_WBR + (size_t)l * 3 * MiB);
            EpiMerge E{(const bf16*)(ws + WS_P), (bf16*)(ws + WS_MRG)};
            pg8::gemm_phase<EpiMerge, SchedMerge, false>(F.lds, 512, S, E, F.tid);
        }
        SEAM(pb + 4);
        if (IN(pb + 5)) { OPQ(); unsigned char* ws = F.ws;
            SchedPlain S; S.T.init(NT / 256, 4, F.G, F.bid); S.A = (const char*)(ws + WS_MRG); S.B = (const char*)(ws + WS_WOUT + (size_t)l * 2 * MiB); S.K = 1024;
            EpiResid E{(float*)(ws + WS_X), (const float*)(ws + WS_MOD) + (size_t)l * 9 * 6144};
            pg8::gemm_phase<EpiResid, SchedPlain, false>(F.lds, 1024, S, E, F.tid);
        }
        SEAM(pb + 5);
        if (IN(pb + 6)) { OPQ(); phase_router(F, ka, l); }
        SEAM(pb + 6);
        if (IN(pb + 7)) { OPQ(); unsigned char* ws = F.ws;
            moe_build_table(F, F.ctl + CW_CNT + l * 32 * 16);
            SchedMoe S{(const LAS int*)(F.lds + LDS_TAB_OFF), (const char*)(ws + WS_H), (const char*)(ws + WS_WGU + (size_t)l * 128 * MiB), (const int*)(ws + WS_LIST), 8, F.bid, F.G, 0, (size_t)2048 * 1024 * 2, true};
            EpiSwiglu E{(bf16*)(ws + WS_ACT), ka.in(I_BGU) + (size_t)l * 32 * 2048};
            pg8::gemm_phase<EpiSwiglu, SchedMoe, true>(F.lds, 1024, S, E, F.tid);
        }
        SEAM(pb + 7);
        if (IN(pb + 8)) { OPQ(); unsigned char* ws = F.ws;
            moe_build_table(F, F.ctl + CW_CNT + l * 32 * 16);
            SchedMoe S{(const LAS int*)(F.lds + LDS_TAB_OFF), (const char*)(ws + WS_ACT), (const char*)(ws + WS_WDN + (size_t)l * 64 * MiB), (const int*)(ws + WS_LIST), 4, F.bid, F.G, 0, (size_t)1024 * 1024 * 2, false};
            EpiDown E{(bf16*)(ws + WS_Y), ka.in(I_BDOWN) + (size_t)l * 32 * 1024};
            pg8::gemm_phase<EpiDown, SchedMoe, false>(F.lds, 1024, S, E, F.tid);
        }
        SEAM(pb + 8);
        if (IN(pb + 9)) { OPQ(); phase_combine(F, ka, l); }
        SEAM(pb + 9);

    }
#undef IN
#undef SEAM
}

extern "C" void kernel_launch(void* const* d_in, const int* in_sizes, int n_in, void* d_out, int out_size, void* d_ws, size_t ws_size, hipStream_t stream) {
    static int grid = 0;
    if (grid == 0) {
        if (n_in != N_IN || ws_size < WS_END) { fprintf(stderr, "kernel_launch: unexpected n_in %d or ws_size %zu (need %zu)\n", n_in, ws_size, (size_t)WS_END); grid = -1; return; }
        int dev = 0, cus = 0, per_cu = 0;
        hipGetDevice(&dev); hipDeviceGetAttribute(&cus, hipDeviceAttributeMultiprocessorCount, dev);
        if (hipFuncSetAttribute((const void*)fwd_kernel, hipFuncAttributeMaxDynamicSharedMemorySize, LDS_BYTES) != hipSuccess) { fprintf(stderr, "kernel_launch: hipFuncSetAttribute failed\n"); grid = -1; return; }
        if (hipOccupancyMaxActiveBlocksPerMultiprocessor(&per_cu, (const void*)fwd_kernel, NTHREADS, LDS_BYTES) != hipSuccess || per_cu < 1) { fprintf(stderr, "kernel_launch: occupancy query says %d\n", per_cu); }
        (void)hipGetLastError();
        grid = cus > 0 ? cus : 256;
        if (grid > 256) grid = 256;
    }
    if (grid < 0) return;
    (void)in_sizes; (void)out_size;
    hipMemsetAsync((char*)d_ws + WS_CTL, 0, CTL_ZERO_BYTES, stream);
    Args a{};
    for (int i = 0; i < N_IN; ++i) a.in[i] = (const float*)d_in[i];
    a.out = (float*)d_out; a.ws = (unsigned char*)d_ws;
#if MK_ONE_LAUNCH
    a.ph_lo = 0; a.ph_hi = N_PHASES;
    hipLaunchKernelGGL(fwd_kernel, dim3(grid), dim3(NTHREADS), LDS_BYTES, stream, a);
#else
    for (int ph = 0; ph < N_PHASES; ++ph) { a.ph_lo = ph; a.ph_hi = ph + 1; hipLaunchKernelGGL(fwd_kernel, dim3(grid), dim3(NTHREADS), LDS_BYTES, stream, a); }
#endif
    hipError_t le = hipGetLastError();
    if (le != hipSuccess) fprintf(stderr, "kernel_launch: launch failed: %s\n", hipGetErrorName(le));
}
```

```cpp
#include <hip/hip_runtime.h>
#include <cstdio>
#include <cstdint>

#ifndef MK_ONE_LAUNCH
#define MK_ONE_LAUNCH 1
#endif

#define GAS __attribute__((address_space(1)))
#define LAS __attribute__((address_space(3)))
typedef unsigned short bf16;
typedef short bf16x8 __attribute__((ext_vector_type(8)));
typedef float f32x2 __attribute__((ext_vector_type(2)));
typedef float f32x4 __attribute__((ext_vector_type(4)));
typedef float f32x16 __attribute__((ext_vector_type(16)));
typedef unsigned u32x2 __attribute__((ext_vector_type(2)));
typedef unsigned u32x4 __attribute__((ext_vector_type(4)));
typedef __bf16 bf16v2 __attribute__((ext_vector_type(2)));
#define DI __device__ __forceinline__

constexpr int D = 1024, BATCH = 8, SEQ = 4096, CTX = 256, LTOT = SEQ + CTX  , NT = BATCH * LTOT  , DEPTH = 4;
constexpr int DIN = 7456, DINP = 7680;
constexpr int NEXP = 32, TOPK = 4, DEXP = 1024;
constexpr int NSLOT = NT * TOPK + NEXP * 256;
constexpr int PC_RQ = 0, PC_RK = 256, PC_RV = 512, PC_RGF = 1024, PC_RGB = 1536, PC_MQ = 2048, PC_MKV = 2304, PC_MPE = 2432,
              PC_RW = 2464, PC_WR = 2464, PC_WK = 2976, PC_WV = 3488, PC_WHF = 4000, PC_WHB = 4064, PC_AHF = 4128, PC_AHB = 4192, PC_GH = 4256, PC_GATE = 4384;
enum { I_X = 0, I_C, I_CTX, I_CCTX, I_ADAW, I_ADAB, I_N1G, I_N2G, I_WIN, I_MQNG, I_WUQ, I_MKVNG, I_WUKV, I_QKQG, I_QKKG, I_MUP, I_MUN, I_W0, I_W2, I_A0, I_A2, I_G2,
       I_KK, I_KA, I_RK, I_LNXG, I_LNXB, I_BRRET, I_BRMLA, I_BRRWKV, I_WOUT, I_WROUTER, I_BROUTER, I_WGU, I_BGU, I_WDOWN, I_BDOWN, N_IN };

constexpr size_t MiB = 1u << 20;
constexpr size_t WS_CTL = 0, CTL_ZERO_BYTES = 1 * MiB;
constexpr size_t WS_MOD = 1 * MiB;
constexpr size_t WS_ROPE = 2 * MiB;
constexpr size_t WS_ROPE_AX = 3 * MiB;
constexpr size_t WS_SMALLW = 4 * MiB;
constexpr size_t SW_UQ = 0, SW_UKV = 393216, SW_W2 = 655360, SW_A2 = 786432, SW_G2 = 917504;
constexpr size_t WS_WBR = 8 * MiB;
constexpr size_t WS_WOUT = 20 * MiB;
constexpr size_t WS_WIN = 28 * MiB;
constexpr size_t WS_WGU = 88 * MiB;
constexpr size_t WS_WDN = 600 * MiB;
constexpr size_t WS_X = 856 * MiB;
constexpr size_t WS_H = 992 * MiB;
constexpr size_t WS_P = 1062 * MiB;
constexpr size_t WS_QB = 1572 * MiB;
constexpr size_t WS_KB = 1623 * MiB;
constexpr size_t WS_VT = 1674 * MiB;
constexpr size_t WS_RW = 1708 * MiB;
constexpr size_t RW_STRIDE = (size_t)NT * 512 * 2;
constexpr size_t WS_LW = 1980 * MiB;
constexpr size_t WS_YF = 2116 * MiB;
constexpr size_t WS_OF = 2252 * MiB;
constexpr size_t WS_ABR = 2388 * MiB;
constexpr size_t WS_MRG = 2490 * MiB;
constexpr size_t WS_TOPK = 2558 * MiB;
constexpr size_t WS_LIST = 2560 * MiB;
constexpr size_t WS_ACT = 2565 * MiB;
constexpr size_t WS_Y = 2853 * MiB;
constexpr size_t WS_END = 3141 * MiB;
constexpr int CW_TMO = 0, CW_BAR = 4096, CW_CNT = 8192  , CW_Q = 12288  ;

DI unsigned pk2(float lo, float hi) { f32x2 v = {lo, hi}; bf16v2 r = __builtin_convertvector(v, bf16v2); return __builtin_bit_cast(unsigned, r); }
DI bf16 f2bf(float f) { return (bf16)(pk2(f, 0.f) & 0xffffu); }
DI float bf2f(unsigned short b) { return __uint_as_float(((unsigned)b) << 16); }
DI float bflo(unsigned w) { return __uint_as_float(w << 16); }
DI float bfhi(unsigned w) { return __uint_as_float(w & 0xffff0000u); }
DI int fresh_lane() { int l_; asm volatile("v_mbcnt_lo_u32_b32 %0, -1, 0\n\tv_mbcnt_hi_u32_b32 %0, -1, %0" : "=v"(l_)); return l_; }
DI bf16x8 pack8(const float* v) { u32x4 x; x.x = pk2(v[0], v[1]); x.y = pk2(v[2], v[3]); x.z = pk2(v[4], v[5]); x.w = pk2(v[6], v[7]); return __builtin_bit_cast(bf16x8, x); }
DI float sx(float v, int mask) { const int l = fresh_lane(); return __int_as_float(__builtin_amdgcn_ds_bpermute((l ^ mask) << 2, __float_as_int(v))); }
DI float sup(float v, int d) { const int l = fresh_lane(); return __int_as_float(__builtin_amdgcn_ds_bpermute((l - d) << 2, __float_as_int(v))); }
DI float dpp_scan64(float x) {
    float t;
    t = __int_as_float(__builtin_amdgcn_update_dpp(0, __float_as_int(x), 0x111, 0xf, 0xf, false)); x += t;
    t = __int_as_float(__builtin_amdgcn_update_dpp(0, __float_as_int(x), 0x112, 0xf, 0xf, false)); x += t;
    t = __int_as_float(__builtin_amdgcn_update_dpp(0, __float_as_int(x), 0x114, 0xf, 0xf, false)); x += t;
    t = __int_as_float(__builtin_amdgcn_update_dpp(0, __float_as_int(x), 0x118, 0xf, 0xf, false)); x += t;
    t = __int_as_float(__builtin_amdgcn_update_dpp(0, __float_as_int(x), 0x142, 0xa, 0xf, false)); x += t;
    t = __int_as_float(__builtin_amdgcn_update_dpp(0, __float_as_int(x), 0x143, 0xc, 0xf, false)); x += t;
    return x;
}
DI float wave_sum(float v) {
#pragma unroll
    for (int o = 1; o < 64; o <<= 1) v += sx(v, o);
    return v;
}
DI void unpack8(const u32x4& w, float* o) { o[0] = bflo(w.x); o[1] = bfhi(w.x); o[2] = bflo(w.y); o[3] = bfhi(w.y); o[4] = bflo(w.z); o[5] = bfhi(w.z); o[6] = bflo(w.w); o[7] = bfhi(w.w); }
DI f32x16 zero16() { f32x16 z; for (int i = 0; i < 16; ++i) z[i] = 0.f; return z; }
DI float sigmoidf_(float x) { return __builtin_amdgcn_rcpf(1.f + __expf(-x)); }
#define LDS_WAIT() asm volatile("s_waitcnt lgkmcnt(0)" ::: "memory")
#define VM_WAIT() asm volatile("s_waitcnt vmcnt(0)" ::: "memory")
#define LDS_BARRIER() do { asm volatile("s_waitcnt lgkmcnt(0)" ::: "memory"); __builtin_amdgcn_s_barrier(); asm volatile("" ::: "memory"); } while (0)

#define XB_TMO      128
#define XB_XCNT(j)  (256  + 64 * (j))
#define XB_XSUB(j)  (1280 + 64 * (j))
#define XB_XGEN(j)  (2304 + 64 * (j))
#define XB_TOP      3328
#define XB_TOPGEN   3392
#define XCD_BAR_WORDS 3456
#define XB_SPIN_CAP (1u << 22)

__device__ __forceinline__ unsigned xb_ld(unsigned* p)              { return __hip_atomic_load(p, __ATOMIC_RELAXED, __HIP_MEMORY_SCOPE_AGENT); }
__device__ __forceinline__ unsigned xb_add(unsigned* p, unsigned v) { return __hip_atomic_fetch_add(p, v, __ATOMIC_RELAXED, __HIP_MEMORY_SCOPE_AGENT); }
__device__ __forceinline__ unsigned xb_xcc_id() { return (unsigned)__builtin_amdgcn_s_getreg((3 << 11) | 20) & 0xFu; }
#define XB_SPIN(cond, bar) do { unsigned _sp = 0; while (cond) { __builtin_amdgcn_s_sleep(1); \
    if ((++_sp & 255u) == 0u) { if (xb_ld(&(bar)[XB_TMO])) break; if (_sp > XB_SPIN_CAP) { atomicAdd(&(bar)[XB_TMO], 1u); break; } } } } while (0)

struct XcdBarrier { unsigned* bar; unsigned x; volatile LAS unsigned* st; };

__device__ __forceinline__ XcdBarrier xcd_barrier_post(unsigned* bar, volatile LAS unsigned* st) {
    XcdBarrier b; b.bar = bar; b.x = xb_xcc_id(); b.st = st;
    if (threadIdx.x == 0) (void)xb_add(&bar[XB_XCNT(b.x)], 1u);
    return b;
}
__device__ __forceinline__ void xcd_barrier_complete(unsigned* bar, unsigned x, unsigned& nloc, unsigned& nx) {
    const unsigned G = gridDim.x * gridDim.y * gridDim.z;
    unsigned sum, cnt, mine, sp = 0u;
    for (;;) {
        sum = 0u; cnt = 0u; mine = 0u;
#pragma unroll
        for (unsigned j = 0; j < 16; ++j) { const unsigned c = xb_ld(&bar[XB_XCNT(j)]); sum += c; cnt += (c > 0u) ? 1u : 0u; mine = (j == x) ? c : mine; }
        if (sum == G) break;
        __builtin_amdgcn_s_sleep(1);
        if ((++sp & 255u) == 0u) { if (xb_ld(&bar[XB_TMO])) break; if (sp > XB_SPIN_CAP) { atomicAdd(&bar[XB_TMO], 1u); break; } }
    }
    nloc = mine > 0u ? mine : 1u; nx = cnt > 0u ? cnt : 1u;
}
__device__ __forceinline__ void xcd_barrier(const XcdBarrier& b) {
    asm volatile("s_waitcnt vmcnt(0)" ::: "memory");
    __syncthreads();
    if (threadIdx.x == 0) {
        unsigned* bar = b.bar;
        __builtin_amdgcn_s_waitcnt(0);
        unsigned nloc = b.st[0], nx = b.st[1];
        if (nloc == 0u) { xcd_barrier_complete(bar, b.x, nloc, nx); b.st[0] = nloc; b.st[1] = nx; }
        const unsigned old = xb_add(&bar[XB_XSUB(b.x)], 1u);
        const unsigned gen = old / nloc;
        if (old + 1u == (gen + 1u) * nloc) {
            __builtin_amdgcn_fence(__ATOMIC_RELEASE, "agent");
            asm volatile("s_waitcnt vmcnt(0)" ::: "memory");
            const unsigned og = xb_add(&bar[XB_TOP], 1u);
            const unsigned tg = og / nx;
            if (og + 1u == (tg + 1u) * nx) xb_add(&bar[XB_TOPGEN], 1u);
            else XB_SPIN(xb_ld(&bar[XB_TOPGEN]) == tg, bar);
            __builtin_amdgcn_fence(__ATOMIC_ACQUIRE, "agent");
            xb_add(&bar[XB_XGEN(b.x)], 1u);
            asm volatile("s_waitcnt vmcnt(0)" ::: "memory");
        } else {
            XB_SPIN(xb_ld(&bar[XB_XGEN(b.x)]) == gen, bar);
            __builtin_amdgcn_fence(__ATOMIC_ACQUIRE, "agent");
            asm volatile("s_waitcnt vmcnt(0)" ::: "memory");
        }
    }
    __syncthreads();
}

namespace pg8 {
constexpr int BM = 256, BK = 64, HALF = 128, HTB = HALF * BK * 2, STAGE_BYTES = 8 * HTB;
__host__ __device__ __forceinline__ int lds_byte(int r, int c) { const int st = (r >> 4) * 2 + (c >> 5), rr = r & 15, cc = c & 31, ob = rr * 64 + cc * 2; return st * 1024 + (ob ^ (((ob >> 9) & 1) << 5)); }
__host__ __device__ __forceinline__ void stage_rc(int b, int& R, int& C) { const int st = b / 1024, sb = b % 1024, swz = sb ^ (((sb >> 9) & 1) << 5); R = (st >> 1) * 16 + swz / 64; C = (st & 1) * 32 + (swz % 64) / 2; }
__host__ __device__ __forceinline__ int perm32(int rho) { const int n = rho >> 4, i = rho & 15; return 8 * (i >> 2) + 4 * n + (i & 3); }

struct Unit { const char* pa; const char* pb; int x, y, z; };

struct TileOrder {
    int nM, nN, nwg, G, c; bool skipctx;
    DI void init(int nM_, int nN_, int G_, int c_, bool skipctx_ = false) { skipctx = skipctx_; nM = skipctx_ ? nM_ - BATCH : nM_; nN = nN_; nwg = nM * nN; G = G_; c = c_; }
    DI bool tile(int i, int& pm, int& pn) const {
        const long L = (long)i * G + c; if (L >= nwg) return false;
        int wgid = (int)L; { const int q = nwg / 8, r = nwg % 8, xcd = wgid % 8, off = wgid / 8; wgid = (xcd < r ? xcd * (q + 1) : r * (q + 1) + (xcd - r) * q) + off; }
        const int nig = 8 * nN, gid = wgid / nig, fm = gid * 8, gsz = (nM - fm) < 8 ? (nM - fm) : 8;
        pm = fm + ((wgid % nig) % gsz); pn = (wgid % nig) / gsz; if (skipctx) pm = pm + pm / 16 + 1; return true;
    }
};

DI unsigned cvt_pk_bf16(float lo, float hi) { return pk2(lo, hi); }

template <class Epi, class Sched, bool GATHER>
__device__ __forceinline__ void gemm_phase(LAS unsigned char* lds, const int K, const Sched& S, const Epi& E, const int tid) {
    const int wid = __builtin_amdgcn_readfirstlane(tid >> 6), lane = tid & 63, wr = wid >> 2, wc = wid & 3, fr = lane & 15, fq = lane >> 4;
    const int nt = K / BK;
    unsigned voffA[2], voffB[2]; int stR[2];
#pragma unroll
    for (int i = 0; i < 2; ++i) { int R, C; stage_rc(tid * 16 + i * 8192, R, C); const int Rb = Epi::PERM ? ((R & ~31) + perm32(R & 31)) : R;
        voffA[i] = GATHER ? (unsigned)(C * 2) : (unsigned)(R * K + C) * 2u; voffB[i] = (unsigned)(Rb * K + C) * 2u; stR[i] = R; }
    const size_t kstep = (size_t)(BK * 2);
    const size_t hstep = (size_t)HALF * K * 2;
    const unsigned ldsw = (unsigned)wid * 1024u;
    const int aoff = lds_byte(wr * 64 + fr, fq * 8), boff = lds_byte(wc * 32 + fr, fq * 8);
#define PG8_SA(b, h) (((b) * 2 + (h)) * HTB)
#define PG8_SB(b, h) ((4 + (b) * 2 + (h)) * HTB)
#define PG8_STAGE(bufoff, gbase, voff) do { _Pragma("unroll") for (int _i = 0; _i < 2; ++_i) \
        __builtin_amdgcn_global_load_lds((const unsigned*)((const char*)(gbase) + (voff)[_i]), (LAS unsigned*)(lds + (bufoff) + ldsw + _i * 8192), 16, 0, 0); } while (0)
#define PG8_STAGE_A(bufoff, gbase, h, rw) do { if constexpr (GATHER) { _Pragma("unroll") for (int _i = 0; _i < 2; ++_i) { \
            const unsigned _row = ((rw)[h] >> (16 * _i)) & 0xffffu; \
            __builtin_amdgcn_global_load_lds((const unsigned*)((const char*)(gbase) + (size_t)_row * (size_t)(K * 2) + voffA[_i]), (LAS unsigned*)(lds + (bufoff) + ldsw + _i * 8192), 16, 0, 0); } } \
        else { PG8_STAGE(bufoff, (const char*)(gbase) + (h) * hstep, voffA); } } while (0)
#define PG8_LDA(dst, b, h) do { _Pragma("unroll") for (int m = 0; m < 4; ++m) _Pragma("unroll") for (int k = 0; k < 2; ++k) dst[m][k] = *(const LAS bf16x8*)(lds + PG8_SA(b, h) + aoff + m * 2048 + k * 1024); } while (0)
#define PG8_LDB(dst, b, h) do { _Pragma("unroll") for (int n = 0; n < 2; ++n) _Pragma("unroll") for (int k = 0; k < 2; ++k) dst[n][k] = *(const LAS bf16x8*)(lds + PG8_SB(b, h) + boff + n * 2048 + k * 1024); } while (0)
#define PG8_MMA(ai, bj, At, Bt) do { __builtin_amdgcn_s_setprio(1); _Pragma("unroll") for (int m = 0; m < 4; ++m) _Pragma("unroll") for (int n = 0; n < 2; ++n) _Pragma("unroll") for (int k = 0; k < 2; ++k) \
        acc[ai][bj][m][n] = __builtin_amdgcn_mfma_f32_16x16x32_bf16(Bt[n][k], At[m][k], acc[ai][bj][m][n], 0, 0, 0); __builtin_amdgcn_s_setprio(0); } while (0)
#define PG8_WAIT_V(n) asm volatile("s_waitcnt vmcnt(" #n ")" ::: "memory")
#define PG8_WAIT_L(n) asm volatile("s_waitcnt lgkmcnt(" #n ")" ::: "memory")
#define PG8_BAR __builtin_amdgcn_s_barrier()
#define PG8_SCHED __builtin_amdgcn_sched_barrier(0)
    Unit cur, nxt; int ui = 0;
    if (!S.next(0, cur)) return;
    f32x4 acc[2][2][4][2];
#pragma unroll
    for (int a = 0; a < 2; ++a)
#pragma unroll
        for (int b = 0; b < 2; ++b)
#pragma unroll
            for (int m = 0; m < 4; ++m)
#pragma unroll
                for (int n = 0; n < 2; ++n) acc[a][b][m][n] = (f32x4){0.f, 0.f, 0.f, 0.f};
    bf16x8 At[4][2], B0[2][2], B1[2][2];
    const char* cA = cur.pa; const char* cB = cur.pb;
    unsigned rwc[2] = {0u, 0u}, rwn[2] = {0u, 0u};
    if constexpr (GATHER) S.rows(cur, stR[0], stR[1], rwc);
    PG8_STAGE(PG8_SB(0, 0), cB, voffB); PG8_STAGE(PG8_SB(0, 1), cB + hstep, voffB); PG8_STAGE_A(PG8_SA(0, 0), cA, 0, rwc); PG8_STAGE_A(PG8_SA(0, 1), cA, 1, rwc);
    if (wr == 1) PG8_BAR;
    PG8_WAIT_V(2); PG8_BAR;
    PG8_STAGE(PG8_SB(1, 0), cB + kstep, voffB); PG8_STAGE_A(PG8_SA(1, 0), cA + kstep, 0, rwc); PG8_STAGE(PG8_SB(1, 1), cB + hstep + kstep, voffB);
    PG8_WAIT_V(6); PG8_BAR;
    for (;;) {
        const bool has_next = S.next(ui + 1, nxt);
        const char* nA = has_next ? nxt.pa : cA; const char* nB = has_next ? nxt.pb : cB;
        if constexpr (GATHER) { if (has_next) S.rows(nxt, stR[0], stR[1], rwn); else { rwn[0] = rwc[0]; rwn[1] = rwc[1]; } }
        for (int t = 0; t < nt; t += 2) {
            const bool last = (t == nt - 2);
            const char* a1 = cA + (size_t)(t + 1) * kstep;
            const char* a2 = last ? nA : cA + (size_t)(t + 2) * kstep; const char* b2 = last ? nB : cB + (size_t)(t + 2) * kstep;
            const char* a3 = a2 + kstep; const char* b3 = b2 + kstep;
            unsigned rw2[2]; rw2[0] = last ? rwn[0] : rwc[0]; rw2[1] = last ? rwn[1] : rwc[1];
            PG8_LDB(B0, 0, 0); PG8_LDB(B1, 0, 1); PG8_SCHED; PG8_LDA(At, 0, 0); PG8_STAGE_A(PG8_SA(1, 1), a1, 1, rwc);
            PG8_WAIT_V(8); PG8_WAIT_L(0); PG8_BAR; PG8_MMA(0, 0, At, B0); PG8_MMA(0, 1, At, B1); PG8_BAR; PG8_SCHED;
            PG8_LDA(At, 0, 1); PG8_STAGE(PG8_SB(0, 0), b2, voffB); PG8_STAGE(PG8_SB(0, 1), b2 + hstep, voffB); PG8_STAGE_A(PG8_SA(0, 0), a2, 0, rw2);
            PG8_WAIT_V(8); PG8_WAIT_L(0); PG8_BAR; PG8_MMA(1, 0, At, B0); PG8_MMA(1, 1, At, B1); PG8_BAR; PG8_SCHED;
            PG8_LDB(B0, 1, 0); PG8_LDB(B1, 1, 1); PG8_SCHED; PG8_LDA(At, 1, 0); PG8_STAGE_A(PG8_SA(0, 1), a2, 1, rw2);
            PG8_WAIT_V(8); PG8_WAIT_L(0); PG8_BAR; PG8_MMA(0, 0, At, B0); PG8_MMA(0, 1, At, B1); PG8_BAR; PG8_SCHED;
            PG8_LDA(At, 1, 1); PG8_STAGE(PG8_SB(1, 0), b3, voffB); PG8_STAGE(PG8_SB(1, 1), b3 + hstep, voffB); PG8_STAGE_A(PG8_SA(1, 0), a3, 0, rw2);
            PG8_WAIT_V(8); PG8_WAIT_L(0); PG8_BAR; PG8_MMA(1, 0, At, B0); PG8_MMA(1, 1, At, B1); PG8_BAR; PG8_SCHED;
        }
        if (wr == 0) PG8_BAR;
        { int l2_; asm volatile("v_mbcnt_lo_u32_b32 %0, -1, 0\n\tv_mbcnt_hi_u32_b32 %0, -1, %0" : "=v"(l2_));
          E(acc, cur, wr, wc, l2_ & 15, l2_ >> 4); }
        if (!has_next) break;
        cur = nxt; cA = nA; cB = nB; ++ui;
        if constexpr (GATHER) { rwc[0] = rwn[0]; rwc[1] = rwn[1]; }
        if (wr == 1) PG8_BAR;
    }
    PG8_WAIT_V(0);
    PG8_BAR;
#undef PG8_SA
#undef PG8_SB
#undef PG8_STAGE
#undef PG8_STAGE_A
#undef PG8_LDA
#undef PG8_LDB
#undef PG8_MMA
#undef PG8_WAIT_V
#undef PG8_WAIT_L
#undef PG8_BAR
#undef PG8_SCHED
}
#define ACC_ZERO(acc) do { _Pragma("unroll") for (int a_ = 0; a_ < 2; ++a_) _Pragma("unroll") for (int b_ = 0; b_ < 2; ++b_) _Pragma("unroll") for (int m_ = 0; m_ < 4; ++m_) _Pragma("unroll") for (int n_ = 0; n_ < 2; ++n_) \
        acc[a_][b_][m_][n_] = (f32x4){0.f, 0.f, 0.f, 0.f}; } while (0)
}

constexpr int NWAVES = 8, NTHREADS = 512;
constexpr int RING_BYTES = 131072;
constexpr int LDS_TAB_OFF = RING_BYTES;
constexpr int LDS_MISC_OFF = RING_BYTES + 8192;
constexpr int LDS_BYTES = 147456;

struct Args { const float* in[N_IN]; float* out; unsigned char* ws; int ph_lo, ph_hi; };

#define CAS __attribute__((address_space(4)))
struct KA { const CAS char* kp;
    DI const float* in(int i) const { return *(const float* const CAS*)(kp + 8 * i); }
    DI float* out() const { return *(float* const CAS*)(kp + 8 * N_IN); }
    DI unsigned char* ws() const { return *(unsigned char* const CAS*)(kp + 8 * N_IN + 8); } };
struct Frame {
    LAS unsigned char* lds;
    volatile LAS unsigned* MISC;
    unsigned* ctl;
    unsigned char* ws;
    int tid, lane, wave, G, bid;
};

DI int row_modrow(int r) { const int b = r / LTOT, p = r - b * LTOT; return p < CTX ? 8 : b; }

struct SchedInproj {
    pg8::TileOrder T; const char* A; const char* B;
    DI bool next(int i, pg8::Unit& u) const { int pm, pn; if (!T.tile(i, pm, pn)) return false; u.pa = A + (size_t)pm * (256 * 1024 * 2); u.pb = B + (size_t)pn * (256 * 1024 * 2); u.x = pm; u.y = pn; u.z = 0; return true; }
};
struct EpiStoreBf16 {
    static constexpr bool PERM = true;
    bf16* O; int ldc;
    DI void operator()(f32x4 (&acc)[2][2][4][2], const pg8::Unit& u, int wr, int wc, int fr, int fq) const {
        const int row0 = u.x * 256 + wr * 64 + fr, col0 = u.y * 256 + wc * 32 + 8 * fq;
#pragma unroll
        for (int ai = 0; ai < 2; ++ai)
#pragma unroll
            for (int m = 0; m < 4; ++m) { bf16* rowp = O + (size_t)(row0 + ai * 128 + m * 16) * ldc + col0;
#pragma unroll
                for (int bj = 0; bj < 2; ++bj) { const f32x4 v0 = acc[ai][bj][m][0], v1 = acc[ai][bj][m][1];
                    u32x4 w; w.x = pk2(v0[0], v0[1]); w.y = pk2(v0[2], v0[3]); w.z = pk2(v1[0], v1[1]); w.w = pk2(v1[2], v1[3]);
                    *(u32x4*)(rowp + bj * 128) = w; } }
        ACC_ZERO(acc);
    }
};
struct SchedMerge {
    pg8::TileOrder T; const char* A; const char* B;
    DI bool next(int i, pg8::Unit& u) const { const int ti = i / 3, br = i - ti * 3; int pm, pn; if (!T.tile(ti, pm, pn)) return false;
        u.pa = A + (size_t)br * ((size_t)NT * 512 * 2) + (size_t)pm * (256 * 512 * 2); u.pb = B + (size_t)br * (1024 * 512 * 2) + (size_t)pn * (256 * 512 * 2); u.x = pm; u.y = pn; u.z = br; return true; }
};
struct EpiMerge {
    static constexpr bool PERM = true;
    const bf16* P; bf16* O;
    static DI float en(float x) { return __builtin_amdgcn_exp2f(fminf(x * -1.4426950408889634f, 43.28f)); }
    DI void operator()(f32x4 (&acc)[2][2][4][2], const pg8::Unit& u, int wr, int wc, int fr, int fq) const {
        const int row0 = u.x * 256 + wr * 64 + fr, col0 = u.y * 256 + wc * 32 + 8 * fq, br = u.z;
#pragma unroll
        for (int ai = 0; ai < 2; ++ai) {
            u32x4 gc[4][2], gn[4][2];
#pragma unroll
            for (int m = 0; m < 4; ++m)
#pragma unroll
                for (int bj = 0; bj < 2; ++bj) { const bf16* gp = P + (size_t)(row0 + ai * 128 + m * 16) * DINP + PC_GATE + br * 1024 + col0 + bj * 128;
                    gc[m][bj] = *(const u32x4*)gp; gn[m][bj] = br < 2 ? *(const u32x4*)(gp + 1024) : (u32x4){0u, 0u, 0u, 0u}; }
            __builtin_amdgcn_sched_barrier(0);
#pragma unroll
            for (int m = 0; m < 4; ++m) { const size_t row = (size_t)(row0 + ai * 128 + m * 16);
#pragma unroll
                for (int bj = 0; bj < 2; ++bj) {
                    float lc[8], f[8]; unpack8(gc[m][bj], lc);
                    if (br < 2) { float ln[8]; unpack8(gn[m][bj], ln);
#pragma unroll
                        for (int j = 0; j < 8; ++j) f[j] = (1.f + en(ln[j])) * __builtin_amdgcn_rcpf(1.f + en(lc[j]));
                    } else {
#pragma unroll
                        for (int j = 0; j < 8; ++j) f[j] = __builtin_amdgcn_rcpf(1.f + en(lc[j]));
                    }
                    f32x4 v0 = acc[ai][bj][m][0], v1 = acc[ai][bj][m][1];
                    v0[0] *= f[0]; v0[1] *= f[1]; v0[2] *= f[2]; v0[3] *= f[3]; v1[0] *= f[4]; v1[1] *= f[5]; v1[2] *= f[6]; v1[3] *= f[7];
                    if (br == 2) { u32x4 w; w.x = pk2(v0[0], v0[1]); w.y = pk2(v0[2], v0[3]); w.z = pk2(v1[0], v1[1]); w.w = pk2(v1[2], v1[3]);
                        *(u32x4*)(O + row * 1024 + col0 + bj * 128) = w; v0 = (f32x4){0.f, 0.f, 0.f, 0.f}; v1 = v0; }
                    acc[ai][bj][m][0] = v0; acc[ai][bj][m][1] = v1; } }
            __builtin_amdgcn_sched_barrier(0); }
    }
};
struct SchedPlain {
    pg8::TileOrder T; const char* A; const char* B; int K;
    DI bool next(int i, pg8::Unit& u) const { int pm, pn; if (!T.tile(i, pm, pn)) return false; u.pa = A + (size_t)pm * ((size_t)256 * K * 2); u.pb = B + (size_t)pn * ((size_t)256 * K * 2); u.x = pm; u.y = pn; u.z = 0; return true; }
};
struct EpiResid {
    static constexpr bool PERM = false;
    float* X; const float* mod;
    DI void operator()(f32x4 (&acc)[2][2][4][2], const pg8::Unit& u, int wr, int wc, int fr, int fq) const {
        const int row0 = u.x * 256 + wr * 64 + fr, col0 = u.y * 256 + wc * 32 + 4 * fq;
        const float* g1 = mod + (size_t)row_modrow(u.x * 256) * 6144 + 2048 + col0;
        f32x4 gv[2][2];
#pragma unroll
        for (int bj = 0; bj < 2; ++bj)
#pragma unroll
            for (int n = 0; n < 2; ++n) gv[bj][n] = *(const f32x4*)(g1 + bj * 128 + n * 16);
#pragma unroll
        for (int ai = 0; ai < 2; ++ai) {
            f32x4 xv[4][2][2];
#pragma unroll
            for (int m = 0; m < 4; ++m)
#pragma unroll
                for (int bj = 0; bj < 2; ++bj)
#pragma unroll
                    for (int n = 0; n < 2; ++n) xv[m][bj][n] = *(const f32x4*)(X + (size_t)(row0 + ai * 128 + m * 16) * 1024 + col0 + bj * 128 + n * 16);
            __builtin_amdgcn_sched_barrier(0);
#pragma unroll
            for (int m = 0; m < 4; ++m)
#pragma unroll
                for (int bj = 0; bj < 2; ++bj)
#pragma unroll
                    for (int n = 0; n < 2; ++n) *(f32x4*)(X + (size_t)(row0 + ai * 128 + m * 16) * 1024 + col0 + bj * 128 + n * 16) = xv[m][bj][n] + gv[bj][n] * acc[ai][bj][m][n];
            __builtin_amdgcn_sched_barrier(0); }
        ACC_ZERO(acc);
    }
};
struct SchedMoe {
    const LAS int* tab; const char* A; const char* B; const int* list; int nN, c, G; size_t a_tile_bytes, b_exp_bytes; bool gather;
    DI bool next(int i, pg8::Unit& u) const {
        const int T = tab[96], Tq = (T + 7) >> 3, xcd = c & 7, q = i * (G >> 3) + (c >> 3), tl = q / nN, pn = q - tl * nN, t = xcd * Tq + tl;
        if (tl >= Tq || t >= T) return false;
        const int e = tab[128 + t], j = t - tab[64 + e], slot0 = tab[32 + e] + 256 * j;
        u.pa = gather ? A : A + (size_t)slot0 * 2048; u.pb = B + (size_t)e * b_exp_bytes + (size_t)pn * (256 * 1024 * 2); u.x = slot0; u.y = pn; u.z = e | (j << 8); return true;
    }
    DI void rows(const pg8::Unit& u, int R0, int R1, unsigned (&rw)[2]) const {
        const int e = u.z & 255, j = u.z >> 8, cnt = tab[e]; const int* le = list + (size_t)e * NT;
#pragma unroll
        for (int h = 0; h < 2; ++h) { const int i0 = j * 256 + h * 128 + R0, i1 = j * 256 + h * 128 + R1;
            const unsigned r0 = i0 < cnt ? (unsigned)(le[i0] >> 2) : (unsigned)NT, r1 = i1 < cnt ? (unsigned)(le[i1] >> 2) : (unsigned)NT; rw[h] = r0 | (r1 << 16); }
    }
};
struct EpiSwiglu {
    static constexpr bool PERM = true;
    bf16* ACT; const float* bgu;
    DI void operator()(f32x4 (&acc)[2][2][4][2], const pg8::Unit& u, int wr, int wc, int fr, int fq) const {
        const int row0 = u.x + wr * 64 + fr, ch0 = u.y * 128 + wc * 32 + 8 * fq, e = u.z & 255;
        const float* bg = bgu + (size_t)e * 2048 + ch0;
        const f32x4 bg0 = *(const f32x4*)bg, bg1 = *(const f32x4*)(bg + 4), bu0 = *(const f32x4*)(bg + 1024), bu1 = *(const f32x4*)(bg + 1028);
#pragma unroll
        for (int ai = 0; ai < 2; ++ai)
#pragma unroll
            for (int m = 0; m < 4; ++m) {
                const f32x4 g0 = acc[ai][0][m][0] + bg0, g1 = acc[ai][0][m][1] + bg1, u0 = acc[ai][1][m][0] + bu0, u1 = acc[ai][1][m][1] + bu1;
                float o[8];
#pragma unroll
                for (int j = 0; j < 8; ++j) { const float g = fminf(j < 4 ? g0[j & 3] : g1[j & 3], 7.f); const float up = fminf(fmaxf(j < 4 ? u0[j & 3] : u1[j & 3], -7.f), 7.f);
                    o[j] = g * __builtin_amdgcn_rcpf(1.f + __expf(-1.702f * g)) * (up + 1.f); }
                u32x4 w; w.x = pk2(o[0], o[1]); w.y = pk2(o[2], o[3]); w.z = pk2(o[4], o[5]); w.w = pk2(o[6], o[7]);
                *(u32x4*)(ACT + (size_t)(row0 + ai * 128 + m * 16) * 1024 + ch0) = w; }
        ACC_ZERO(acc);
    }
};
struct EpiDown {
    static constexpr bool PERM = true;
    bf16* Y; const float* bd;
    DI void operator()(f32x4 (&acc)[2][2][4][2], const pg8::Unit& u, int wr, int wc, int fr, int fq) const {
        const int row0 = u.x + wr * 64 + fr, col0 = u.y * 256 + wc * 32 + 8 * fq, e = u.z & 255;
        f32x4 bv[2][2];
#pragma unroll
        for (int bj = 0; bj < 2; ++bj)
#pragma unroll
            for (int n = 0; n < 2; ++n) bv[bj][n] = *(const f32x4*)(bd + (size_t)e * 1024 + col0 + bj * 128 + 4 * n);
#pragma unroll
        for (int ai = 0; ai < 2; ++ai)
#pragma unroll
            for (int m = 0; m < 4; ++m) { bf16* rowp = Y + (size_t)(row0 + ai * 128 + m * 16) * 1024 + col0;
#pragma unroll
                for (int bj = 0; bj < 2; ++bj) { const f32x4 v0 = acc[ai][bj][m][0] + bv[bj][0], v1 = acc[ai][bj][m][1] + bv[bj][1];
                    u32x4 w; w.x = pk2(v0[0], v0[1]); w.y = pk2(v0[2], v0[3]); w.z = pk2(v1[0], v1[1]); w.w = pk2(v1[2], v1[3]);
                    *(u32x4*)(rowp + bj * 128) = w; } }
        ACC_ZERO(acc);
    }
};
DI void moe_build_table(Frame& F, const unsigned* cnt  ) {
    LAS int* tab = (LAS int*)(F.lds + LDS_TAB_OFF);
    if (F.tid < 32) tab[F.tid] = (int)__hip_atomic_load(cnt + F.tid * 16, __ATOMIC_RELAXED, __HIP_MEMORY_SCOPE_AGENT);
    __syncthreads();
    if (F.tid == 0) { int pb = 0, tb = 0; for (int e = 0; e < 32; ++e) { const int nt_ = (tab[e] + 255) >> 8; tab[32 + e] = pb; tab[64 + e] = tb; pb += nt_ * 256; tb += nt_; } tab[96] = tb; }
    __syncthreads();
    for (int e = 0; e < 32; ++e) { const int tb = tab[64 + e], nt_ = (tab[e] + 255) >> 8; for (int j = F.tid; j < nt_; j += NTHREADS) tab[128 + tb + j] = e; }
    __syncthreads();
}

DI void transpose_item(const float* W, int K, int N, bf16* WT, int mode, const float* gk, LAS float* scr, int item, int lane) {
    const int nblk = N / 32, kb = item / nblk, nb = item % nblk, k0 = 64 * kb, n0 = 32 * nb;
#pragma unroll 8
    for (int i = 0; i < 32; ++i) { const int kk = 2 * i + (lane >> 5); float v = W[(size_t)(k0 + kk) * N + n0 + (lane & 31)]; if (gk) v *= gk[k0 + kk]; scr[kk * 33 + (lane & 31)] = v; }
    LDS_WAIT(); asm volatile("" ::: "memory");
    int drow0 = n0;
    if (mode == 1) { const int up = n0 >= 1024, ch = n0 - (up ? 1024 : 0); drow0 = (ch >> 7) * 256 + (up ? 128 : 0) + (ch & 127); }
    const int c = lane & 7;
#pragma unroll
    for (int j = 0; j < 4; ++j) { const int n = (lane >> 3) + 8 * j; const LAS float* s = scr + (8 * c) * 33 + n;
        u32x4 o; o.x = pk2(s[0 * 33], s[1 * 33]); o.y = pk2(s[2 * 33], s[3 * 33]); o.z = pk2(s[4 * 33], s[5 * 33]); o.w = pk2(s[6 * 33], s[7 * 33]);
        *(u32x4*)(WT + (size_t)(drow0 + n) * K + k0 + 8 * c) = o; }
    LDS_WAIT(); asm volatile("" ::: "memory");
}
DI void transpose_batch(Frame& F, const float* W, size_t ss, int K, int N, bf16* WT, size_t ds, int nb, int mode, const float* gk, size_t gks) {
    LAS float* scr = (LAS float*)(F.lds + F.wave * 16384);
    const int gw = F.bid * NWAVES + F.wave, NGW = F.G * NWAVES;
    const int per = (K / 64) * (N / 32), total = per * nb;
    for (int it = gw; it < total; it += NGW) { const int b = it / per, r = it - b * per;
        transpose_item(W + (size_t)b * ss, K, N, WT + (size_t)b * ds, mode, gk ? gk + (size_t)b * gks : nullptr, scr, r, F.lane); }
}
DI void phase_prologue(Frame& F, const KA& a) {
    unsigned char* ws = F.ws;
    transpose_batch(F, a.in(I_WIN), (size_t)1024 * DIN, 1024, DIN, (bf16*)(ws + WS_WIN), (size_t)DINP * 1024, 4, 0, nullptr, 0);
    transpose_batch(F, a.in(I_WGU), (size_t)1024 * 2048, 1024, 2048, (bf16*)(ws + WS_WGU), (size_t)2048 * 1024, 128, 1, nullptr, 0);
    transpose_batch(F, a.in(I_WDOWN), (size_t)1024 * 1024, 1024, 1024, (bf16*)(ws + WS_WDN), (size_t)1024 * 1024, 128, 0, nullptr, 0);
    transpose_batch(F, a.in(I_WOUT), (size_t)1024 * 1024, 1024, 1024, (bf16*)(ws + WS_WOUT), (size_t)1024 * 1024, 4, 0, nullptr, 0);
    transpose_batch(F, a.in(I_BRRET), (size_t)512 * 1024, 512, 1024, (bf16*)(ws + WS_WBR), (size_t)3 * 1024 * 512, 4, 0, nullptr, 0);
    transpose_batch(F, a.in(I_BRMLA), (size_t)512 * 1024, 512, 1024, (bf16*)(ws + WS_WBR) + (size_t)1024 * 512, (size_t)3 * 1024 * 512, 4, 0, nullptr, 0);
    transpose_batch(F, a.in(I_BRRWKV), (size_t)512 * 1024, 512, 1024, (bf16*)(ws + WS_WBR) + (size_t)2 * 1024 * 512, (size_t)3 * 1024 * 512, 4, 0, nullptr, 0);
    transpose_batch(F, a.in(I_WUQ), (size_t)256 * 768, 256, 768, (bf16*)(ws + WS_SMALLW + SW_UQ), MiB / 2, 4, 0, a.in(I_MQNG), 256);
    transpose_batch(F, a.in(I_WUKV), (size_t)128 * 1024, 128, 1024, (bf16*)(ws + WS_SMALLW + SW_UKV), MiB / 2, 4, 0, a.in(I_MKVNG), 128);
    for (int l = 0; l < 4; ++l) {
        transpose_batch(F, a.in(I_W2) + (size_t)l * 2 * 64 * 512, (size_t)64 * 512, 64, 512, (bf16*)(ws + WS_SMALLW + l * MiB + SW_W2), (size_t)512 * 64, 2, 0, nullptr, 0);
        transpose_batch(F, a.in(I_A2) + (size_t)l * 2 * 64 * 512, (size_t)64 * 512, 64, 512, (bf16*)(ws + WS_SMALLW + l * MiB + SW_A2), (size_t)512 * 64, 2, 0, nullptr, 0);
    }
    transpose_batch(F, a.in(I_G2), (size_t)128 * 512, 128, 512, (bf16*)(ws + WS_SMALLW + SW_G2), MiB / 2, 4, 0, nullptr, 0);
    const int gt = F.bid * NTHREADS + F.tid, NGT = F.G * NTHREADS;
    for (int i = gt; i < 4 * (DINP - DIN) * 1024 / 8; i += NGT) { const int l = i / ((DINP - DIN) * 128), r = i - l * ((DINP - DIN) * 128);
        *(u32x4*)((bf16*)(ws + WS_WIN) + (size_t)l * DINP * 1024 + (size_t)DIN * 1024 + (size_t)r * 8) = (u32x4){0u, 0u, 0u, 0u}; }
    for (int i = gt; i < 128; i += NGT) *(u32x4*)((bf16*)(ws + WS_H) + (size_t)NT * 1024 + i * 8) = (u32x4){0u, 0u, 0u, 0u};
    { float2* rt = (float2*)(ws + WS_ROPE);
      for (int i = gt; i < 4096 * 32; i += NGT) { const int pos = i >> 5, f = i & 31; const float inv = powf(10000.f, -(float)(2 * f) / 64.f); const float ang = (float)pos * inv; float s, c; sincosf(ang, &s, &c); rt[i] = make_float2(c, s); }
      float2* ax = (float2*)(ws + WS_ROPE_AX);
      for (int i = gt; i < 64 * 8; i += NGT) { const int pos = i >> 3, f = i & 7; const float inv = powf(10000.f, -(float)(2 * f) / 16.f); const float ang = (float)pos * inv; float s, c; sincosf(ang, &s, &c); ax[i] = make_float2(c, s); } }
    { LAS float* sc = (LAS float*)(F.lds);
      LAS float* red = (LAS float*)(F.lds + 65536);
      __syncthreads();
      for (int i = F.tid; i < 9 * 1024; i += NTHREADS) { const int r = i >> 10, k = i & 1023; const float v = r < 8 ? a.in(I_C)[r * 1024 + k] : a.in(I_CCTX)[k]; sc[i] = v / (1.f + __expf(-v)); }
      __syncthreads();
      float* mod = (float*)(ws + WS_MOD);
      for (int it = F.bid; it < 4 * 96; it += F.G) { const int l = it / 96, n = (it - l * 96) * 64 + F.lane;
          const float* w = a.in(I_ADAW) + (size_t)l * 1024 * 6144 + n; float acc[9];
#pragma unroll
          for (int r = 0; r < 9; ++r) acc[r] = 0.f;
          const int kb = F.wave * 128;
#pragma unroll 8
          for (int k = 0; k < 128; ++k) { const float wv = w[(size_t)(kb + k) * 6144];
#pragma unroll
              for (int r = 0; r < 9; ++r) acc[r] += sc[r * 1024 + kb + k] * wv; }
#pragma unroll
          for (int r = 0; r < 9; ++r) red[(F.wave * 9 + r) * 64 + F.lane] = acc[r];
          __syncthreads();
          for (int i = F.tid; i < 9 * 64; i += NTHREADS) { const int r = i >> 6, c = i & 63; float s = 0.f;
#pragma unroll
              for (int w8 = 0; w8 < 8; ++w8) s += red[(w8 * 9 + r) * 64 + c];
              const int nn = (it - l * 96) * 64 + c; mod[((size_t)l * 9 + r) * 6144 + nn] = s + a.in(I_ADAB)[l * 6144 + nn]; }
          __syncthreads(); } }
}

DI void norm_mod_store(const f32x4 (&v)[4], const float* gain, const float* sc, const float* sh, bf16* hrow, int lane) {
    float s = 0.f;
#pragma unroll
    for (int j = 0; j < 4; ++j) s += (v[j].x * v[j].x + v[j].y * v[j].y) + (v[j].z * v[j].z + v[j].w * v[j].w);
    const float rinv = rsqrtf(wave_sum(s) * (1.f / 1024.f) + 1e-6f);
#pragma unroll
    for (int j = 0; j < 4; ++j) { const int c = 256 * j + 4 * lane; const f32x4 g = *(const f32x4*)(gain + c), a = *(const f32x4*)(sc + c), b = *(const f32x4*)(sh + c);
        const f32x4 y = v[j] * rinv * g * (a + 1.f) + b; u32x2 o; o.x = pk2(y.x, y.y); o.y = pk2(y.z, y.w); *(u32x2*)(hrow + c) = o; }
}
DI void phase_init_rows(Frame& F, const KA& a) {
    const int gw = F.bid * NWAVES + F.wave, NGW = F.G * NWAVES;
    float* X = (float*)(F.ws + WS_X); bf16* H = (bf16*)(F.ws + WS_H); const float* mod = (const float*)(F.ws + WS_MOD);
    for (int r = gw; r < NT; r += NGW) { const int b = r / LTOT, p = r - b * LTOT;
        const float* src = p < CTX ? a.in(I_CTX) + ((size_t)b * CTX + p) * 1024 : a.in(I_X) + ((size_t)b * SEQ + (p - CTX)) * 1024;
        f32x4 v[4];
#pragma unroll
        for (int j = 0; j < 4; ++j) { v[j] = *(const f32x4*)(src + 256 * j + 4 * F.lane); *(f32x4*)(X + (size_t)r * 1024 + 256 * j + 4 * F.lane) = v[j]; }
        const float* m = mod + (size_t)(p < CTX ? 8 : b) * 6144;
        norm_mod_store(v, a.in(I_N1G), m + 1024, m, H + (size_t)r * 1024, F.lane); }
}

DI void phase_router(Frame& F, const KA& a, int l) {
    LAS float* T = (LAS float*)(F.lds);
    LAS float* part = (LAS float*)(F.lds + 16 * 1028 * 4);
    LAS float* logit = (LAS float*)(F.lds + 16 * 1028 * 4 + 16384);
    LAS int* lcnt = (LAS int*)(F.lds + 16 * 1028 * 4 + 16384 + 2048);
    LAS int* gbase = lcnt + 32;
    const float* X = (const float*)(F.ws + WS_X); bf16* H = (bf16*)(F.ws + WS_H);
    const float* mod = (const float*)(F.ws + WS_MOD) + (size_t)l * 9 * 6144;
    const float* gain = a.in(I_N2G) + l * 1024; const float* wr = a.in(I_WROUTER) + (size_t)l * 1024 * 32; const float* br = a.in(I_BROUTER) + l * 32;
    int* eidx = (int*)(F.ws + WS_TOPK); float* gw = (float*)(F.ws + WS_TOPK) + (size_t)NT * 4; int* rank = (int*)(F.ws + WS_TOPK) + (size_t)NT * 8;
    int* list = (int*)(F.ws + WS_LIST); unsigned* cnt = F.ctl + CW_CNT + l * 32 * 16;
    const int lane = F.lane, w = F.wave;
    const bool lastl = l == DEPTH - 1;
    for (int it = F.bid; it < (lastl ? BATCH * SEQ / 16 : NT / 16); it += F.G) {
        const int r0 = lastl ? (it >> 8) * LTOT + CTX + 16 * (it & 255) : it * 16;
        __syncthreads();
        if (F.tid < 32) lcnt[F.tid] = 0;
#pragma unroll
        for (int rr = 0; rr < 2; ++rr) { const int lr = w * 2 + rr, r = r0 + lr; const int b = r / LTOT, p = r - b * LTOT; const float* m = mod + (size_t)(p < CTX ? 8 : b) * 6144;
            f32x4 v[4]; float s = 0.f;
#pragma unroll
            for (int j = 0; j < 4; ++j) { v[j] = *(const f32x4*)(X + (size_t)r * 1024 + 256 * j + 4 * lane); s += (v[j].x * v[j].x + v[j].y * v[j].y) + (v[j].z * v[j].z + v[j].w * v[j].w); }
            const float rinv = rsqrtf(wave_sum(s) * (1.f / 1024.f) + 1e-6f);
#pragma unroll
            for (int j = 0; j < 4; ++j) { const int c = 256 * j + 4 * lane; const f32x4 g = *(const f32x4*)(gain + c), sc = *(const f32x4*)(m + 4096 + c), sh = *(const f32x4*)(m + 3072 + c);
                const f32x4 y = v[j] * rinv * g * (sc + 1.f) + sh; *(LAS f32x4*)(T + lr * 1028 + c) = y;
                u32x2 o; o.x = pk2(y.x, y.y); o.y = pk2(y.z, y.w); *(u32x2*)(H + (size_t)r * 1024 + c) = o; } }
        __syncthreads();
        { const int i = lane & 15, q = lane >> 4; f32x4 acc0 = {0.f, 0.f, 0.f, 0.f}, acc1 = acc0;
          const LAS float* tp = T + i * 1028 + 128 * w + 32 * q; const float* wp = wr + (size_t)(128 * w + 32 * q) * 32 + i;
          float b0[32], b1[32];
#pragma unroll
          for (int s = 0; s < 32; ++s) { b0[s] = wp[s * 32]; b1[s] = wp[s * 32 + 16]; }
          f32x4 a4[8];
#pragma unroll
          for (int s = 0; s < 8; ++s) a4[s] = *(const LAS f32x4*)(tp + 4 * s);
          __builtin_amdgcn_sched_barrier(0);
#pragma unroll
          for (int s = 0; s < 32; ++s) { const float av = a4[s >> 2][s & 3];
              acc0 = __builtin_amdgcn_mfma_f32_16x16x4f32(av, b0[s], acc0, 0, 0, 0); acc1 = __builtin_amdgcn_mfma_f32_16x16x4f32(av, b1[s], acc1, 0, 0, 0); }
#pragma unroll
          for (int rg = 0; rg < 4; ++rg) { part[(w * 16 + 4 * q + rg) * 32 + i] = acc0[rg]; part[(w * 16 + 4 * q + rg) * 32 + 16 + i] = acc1[rg]; } }
        __syncthreads();
        { const int row = F.tid >> 5, e = F.tid & 31; float v = br[e];
#pragma unroll
          for (int w8 = 0; w8 < 8; ++w8) v += part[(w8 * 16 + row) * 32 + e];
          int te[4]; float tv[4];
#pragma unroll
          for (int k = 0; k < 4; ++k) { float bv = v; int bi = e;
#pragma unroll
              for (int o = 1; o < 32; o <<= 1) { const float ov = sx(bv, o); const int oi = __float_as_int(sx(__int_as_float(bi), o)); const bool take = ov > bv || (ov == bv && oi < bi); bv = take ? ov : bv; bi = take ? oi : bi; }
              te[k] = bi; tv[k] = bv; if (e == bi) v = -3.0e38f; }
          const float mx = tv[0]; float den = 0.f;
#pragma unroll
          for (int k = 0; k < 4; ++k) { tv[k] = __expf(tv[k] - mx); den += tv[k]; }
          const float rden = 1.f / den;
          int myk_e = te[0]; float myk_g = tv[0] * rden;
#pragma unroll
          for (int k = 1; k < 4; ++k) { if (e == k) { myk_e = te[k]; myk_g = tv[k] * rden; } }
          int lr = 0;
          if (e < 4) lr = atomicAdd((int*)&lcnt[myk_e], 1);
          __syncthreads();
          if (F.tid < 32) { const int c = lcnt[F.tid]; gbase[F.tid] = c ? (int)__hip_atomic_fetch_add(cnt + F.tid * 16, (unsigned)c, __ATOMIC_RELAXED, __HIP_MEMORY_SCOPE_AGENT) : 0; }
          __syncthreads();
          if (e < 4) { const int r = r0 + row, rk = gbase[myk_e] + lr; eidx[r * 4 + e] = myk_e; gw[r * 4 + e] = myk_g; rank[r * 4 + e] = rk; list[(size_t)myk_e * NT + rk] = r * 4 + e; } }
    }
}

DI void phase_combine(Frame& F, const KA& a, int l) {
    moe_build_table(F, F.ctl + CW_CNT + l * 32 * 16);
    const LAS int* tab = (const LAS int*)(F.lds + LDS_TAB_OFF);
    const int lane = fresh_lane();
    const int gw_ = F.bid * NWAVES + F.wave, NGW = F.G * NWAVES;
    float* X = (float*)(F.ws + WS_X); bf16* H = (bf16*)(F.ws + WS_H); const bf16* Y = (const bf16*)(F.ws + WS_Y);
    const float* mod = (const float*)(F.ws + WS_MOD) + (size_t)l * 9 * 6144;
    const int* eidx = (const int*)(F.ws + WS_TOPK); const float* gw = (const float*)(F.ws + WS_TOPK) + (size_t)NT * 4; const int* rank = (const int*)(F.ws + WS_TOPK) + (size_t)NT * 8;
#pragma unroll 1
    for (int r0 = gw_; r0 < NT; r0 += 2 * NGW) {
        int rr[2], bb[2], pp[2]; bool act[2]; size_t slot[2][4]; float gk[2][4];
#pragma unroll
        for (int u = 0; u < 2; ++u) { rr[u] = r0 + u * NGW; act[u] = rr[u] < NT; if (!act[u]) rr[u] = r0; bb[u] = rr[u] / LTOT; pp[u] = rr[u] - bb[u] * LTOT; if (l == DEPTH - 1 && pp[u] < CTX) act[u] = false;
#pragma unroll
            for (int k = 0; k < 4; ++k) { const int e = eidx[rr[u] * 4 + k]; gk[u][k] = gw[rr[u] * 4 + k]; slot[u][k] = (size_t)(tab[32 + e] + rank[rr[u] * 4 + k]); } }
        f32x4 v[2][4]; u32x2 yv[2][4][4];
#pragma unroll
        for (int u = 0; u < 2; ++u) {
#pragma unroll
            for (int j = 0; j < 4; ++j) v[u][j] = *(const f32x4*)(X + (size_t)rr[u] * 1024 + 256 * j + 4 * lane);
#pragma unroll
            for (int k = 0; k < 4; ++k)
#pragma unroll
                for (int j = 0; j < 4; ++j) yv[u][k][j] = *(const u32x2*)(Y + slot[u][k] * 1024 + 256 * j + 4 * lane); }
#pragma unroll
        for (int u = 0; u < 2; ++u) { if (!act[u]) continue;
            const int mr = pp[u] < CTX ? 8 : bb[u]; const float* g2 = mod + (size_t)mr * 6144 + 5120;
#pragma unroll
            for (int j = 0; j < 4; ++j) { f32x4 acc = {0.f, 0.f, 0.f, 0.f};
#pragma unroll
                for (int k = 0; k < 4; ++k) { const float g = gk[u][k]; const u32x2 y = yv[u][k][j]; acc.x += g * bflo(y.x); acc.y += g * bfhi(y.x); acc.z += g * bflo(y.y); acc.w += g * bfhi(y.y); }
                v[u][j] = v[u][j] + *(const f32x4*)(g2 + 256 * j + 4 * lane) * acc; }
            if (l == DEPTH - 1) {
                float* o = a.out() + ((size_t)bb[u] * SEQ + (pp[u] - CTX)) * 1024;
#pragma unroll
                for (int j = 0; j < 4; ++j) *(f32x4*)(o + 256 * j + 4 * lane) = v[u][j];
            } else {
#pragma unroll
                for (int j = 0; j < 4; ++j) *(f32x4*)(X + (size_t)rr[u] * 1024 + 256 * j + 4 * lane) = v[u][j];
                const float* m = (const float*)(F.ws + WS_MOD) + (size_t)(l + 1) * 9 * 6144 + (size_t)mr * 6144;
                norm_mod_store(v[u], a.in(I_N1G) + (l + 1) * 1024, m + 1024, m, H + (size_t)rr[u] * 1024, lane);
            } }
    }
}

DI int crow16(int i, int h) { return (i & 3) + 8 * (i >> 2) + 4 * h; }
DI int permpos(int p) { return (p & ~12) | ((p & 4) << 1) | ((p & 8) >> 1); }
constexpr int MP_P = 424;
constexpr int MP_SP = 104;
constexpr int MP_SCR = 32 * MP_P * 2;
DI void phase_mla_prep2(Frame& F, const KA& a, int l) {
    const bf16* P = (const bf16*)(F.ws + WS_P);
    const bf16* WUQ = (const bf16*)(F.ws + WS_SMALLW + (size_t)l * MiB + SW_UQ); const bf16* WUKV = (const bf16*)(F.ws + WS_SMALLW + (size_t)l * MiB + SW_UKV);
    bf16* QB = (bf16*)(F.ws + WS_QB); bf16* KB = (bf16*)(F.ws + WS_KB); bf16* VT = (bf16*)(F.ws + WS_VT);
    const float* gq = a.in(I_QKQG) + l * 96; const float* gk = a.in(I_QKKG) + l * 96;
    const float2* ax = (const float2*)(F.ws + WS_ROPE_AX);
    LAS bf16* T = (LAS bf16*)F.lds;
#pragma unroll 1
    for (int it = F.bid; it < NT / 32; it += F.G) {
        const int lane = fresh_lane(); int w = F.wave; asm volatile("" : "+s"(w)); const int tid = w * 64 + lane;
        const int r0 = it * 32, b = r0 / LTOT, p0 = r0 - b * LTOT;
        __syncthreads();
#pragma unroll 1
        for (int q = tid; q < 32 * 52; q += NTHREADS) { const int row = q / 52, pc = q - row * 52; *(LAS u32x4*)(T + row * MP_P + 8 * pc) = *(const u32x4*)(P + (size_t)(r0 + row) * DINP + PC_MQ + 8 * pc); }
        __syncthreads();
        const int hd = w, tok = lane & 31, h = lane >> 5, p = p0 + tok; const bool lat = p >= CTX; const int sl = p - CTX;
        const LAS bf16* trow = T + tok * MP_P;
        LAS bf16* scr = (LAS bf16*)(F.lds + MP_SCR + w * 6656);
        const size_t bhbase = (size_t)(b * 8 + hd) * LTOT + p0;
        { bf16x8 cq[16]; float ssq = 0.f;
#pragma unroll
          for (int s2 = 0; s2 < 16; ++s2) { const u32x4 x = *(const LAS u32x4*)(trow + 16 * s2 + 8 * h); cq[s2] = __builtin_bit_cast(bf16x8, x);
              ssq += bflo(x.x) * bflo(x.x) + bfhi(x.x) * bfhi(x.x) + bflo(x.y) * bflo(x.y) + bfhi(x.y) * bfhi(x.y) + bflo(x.z) * bflo(x.z) + bfhi(x.z) * bfhi(x.z) + bflo(x.w) * bflo(x.w) + bfhi(x.w) * bfhi(x.w); }
          ssq += sx(ssq, 32);
          const float rinq = rsqrtf(ssq * (1.f / 256.f) + 1e-6f);
          float2 cr[4], cc[4];
#pragma unroll
          for (int f = 0; f < 4; ++f) { cr[f] = lat ? ax[(sl >> 6) * 8 + 4 * h + f] : make_float2(1.f, 0.f); cc[f] = lat ? ax[(sl & 63) * 8 + 4 * h + f] : make_float2(1.f, 0.f); }
          f32x16 acc[3];
#pragma unroll
          for (int cb = 0; cb < 3; ++cb) { f32x16 z = zero16(); const bf16* wrow = WUQ + (size_t)(hd * 96 + cb * 32 + tok) * 256 + 8 * h;
              bf16x8 wf[16];
#pragma unroll
              for (int s2 = 0; s2 < 16; ++s2) wf[s2] = *(const bf16x8*)(wrow + 16 * s2);
              __builtin_amdgcn_sched_barrier(0);
#pragma unroll
              for (int s2 = 0; s2 < 16; ++s2) z = __builtin_amdgcn_mfma_f32_32x32x16_bf16(wf[s2], cq[s2], z, 0, 0, 0);
              __builtin_amdgcn_sched_barrier(0);
              acc[cb] = z; }
          float ss = 0.f;
#pragma unroll
          for (int cb = 0; cb < 3; ++cb)
#pragma unroll
              for (int i = 0; i < 16; ++i) { acc[cb][i] *= rinq; ss += acc[cb][i] * acc[cb][i]; }
          ss += sx(ss, 32);
          const float rq = rsqrtf(ss * (1.f / 96.f) + 1e-6f);
#pragma unroll
          for (int cb = 0; cb < 3; ++cb)
#pragma unroll
              for (int i = 0; i < 16; ++i) acc[cb][i] *= rq * gq[cb * 32 + crow16(i, h)];
#pragma unroll
          for (int i = 0; i < 4; ++i) { const float2 c1 = cr[i]; const float x1 = acc[2][i], x2 = acc[2][i + 4]; acc[2][i] = x1 * c1.x - x2 * c1.y; acc[2][i + 4] = x1 * c1.y + x2 * c1.x;
              const float2 c2 = cc[i]; const float y1 = acc[2][8 + i], y2 = acc[2][12 + i]; acc[2][8 + i] = y1 * c2.x - y2 * c2.y; acc[2][12 + i] = y1 * c2.y + y2 * c2.x; }
#pragma unroll
          for (int cb = 0; cb < 3; ++cb)
#pragma unroll
              for (int g = 0; g < 4; ++g) { u32x2 o; o.x = pk2(acc[cb][4 * g], acc[cb][4 * g + 1]); o.y = pk2(acc[cb][4 * g + 2], acc[cb][4 * g + 3]); *(LAS u32x2*)(scr + tok * MP_SP + cb * 32 + 8 * g + 4 * h) = o; }
          LDS_WAIT();
#pragma unroll
          for (int i = 0; i < 6; ++i) { const int q = lane + 64 * i, row = q / 12, pc = q - row * 12; *(u32x4*)(QB + (bhbase + row) * 96 + 8 * pc) = *(const LAS u32x4*)(scr + row * MP_SP + 8 * pc); }
          LDS_WAIT(); }
        { bf16x8 ckv[8]; float ssk = 0.f;
#pragma unroll
          for (int s2 = 0; s2 < 8; ++s2) { const u32x4 x = *(const LAS u32x4*)(trow + 256 + 16 * s2 + 8 * h); ckv[s2] = __builtin_bit_cast(bf16x8, x);
              ssk += bflo(x.x) * bflo(x.x) + bfhi(x.x) * bfhi(x.x) + bflo(x.y) * bflo(x.y) + bfhi(x.y) * bfhi(x.y) + bflo(x.z) * bflo(x.z) + bfhi(x.z) * bfhi(x.z) + bflo(x.w) * bflo(x.w) + bfhi(x.w) * bfhi(x.w); }
          ssk += sx(ssk, 32);
          const float rinkv = rsqrtf(ssk * (1.f / 128.f) + 1e-6f);
          float pe1[8], pe2[8]; float sspe = 0.f;
          { const u32x4 w0 = *(const LAS u32x4*)(trow + 384 + 16 * h), w1 = *(const LAS u32x4*)(trow + 384 + 16 * h + 8);
            unpack8(w0, pe1); unpack8(w1, pe2);
#pragma unroll
            for (int j = 0; j < 8; ++j) sspe += pe1[j] * pe1[j] + pe2[j] * pe2[j];
            sspe += sx(sspe, 32); }
          float2 cs[8];
#pragma unroll
          for (int f = 0; f < 8; ++f) cs[f] = lat ? ax[(h ? (sl & 63) : (sl >> 6)) * 8 + f] : make_float2(1.f, 0.f);
          f32x16 acc[4];
#pragma unroll
          for (int cb = 0; cb < 4; cb += 2) { f32x16 z0 = zero16(), z1 = zero16(); const bf16* wrow = WUKV + (size_t)(hd * 128 + cb * 32 + tok) * 128 + 8 * h;
              bf16x8 wf0[8], wf1[8];
#pragma unroll
              for (int s2 = 0; s2 < 8; ++s2) { wf0[s2] = *(const bf16x8*)(wrow + 16 * s2); wf1[s2] = *(const bf16x8*)(wrow + 32 * 128 + 16 * s2); }
              __builtin_amdgcn_sched_barrier(0);
#pragma unroll
              for (int s2 = 0; s2 < 8; ++s2) { z0 = __builtin_amdgcn_mfma_f32_32x32x16_bf16(wf0[s2], ckv[s2], z0, 0, 0, 0); z1 = __builtin_amdgcn_mfma_f32_32x32x16_bf16(wf1[s2], ckv[s2], z1, 0, 0, 0); }
              __builtin_amdgcn_sched_barrier(0);
              acc[cb] = z0; acc[cb + 1] = z1; }
          float ss = 0.f;
#pragma unroll
          for (int cb = 0; cb < 4; ++cb)
#pragma unroll
              for (int i = 0; i < 16; ++i) { acc[cb][i] *= rinkv; if (cb < 2) ss += acc[cb][i] * acc[cb][i]; }
          ss += sx(ss, 32);
          const float rk = rsqrtf((ss + sspe) * (1.f / 96.f) + 1e-6f);
#pragma unroll
          for (int cb = 0; cb < 2; ++cb)
#pragma unroll
              for (int g = 0; g < 4; ++g) { float o4[4];
#pragma unroll
                  for (int j = 0; j < 4; ++j) o4[j] = acc[cb][4 * g + j] * rk * gk[cb * 32 + 8 * g + 4 * h + j];
                  u32x2 o; o.x = pk2(o4[0], o4[1]); o.y = pk2(o4[2], o4[3]); *(LAS u32x2*)(scr + tok * MP_SP + cb * 32 + 8 * g + 4 * h) = o; }
          { float pe[16];
#pragma unroll
            for (int f = 0; f < 8; ++f) { const float x1 = pe1[f] * rk * gk[64 + 16 * h + f], x2 = pe2[f] * rk * gk[64 + 16 * h + 8 + f];
                pe[f] = x1 * cs[f].x - x2 * cs[f].y; pe[8 + f] = x1 * cs[f].y + x2 * cs[f].x; }
            *(LAS bf16x8*)(scr + tok * MP_SP + 64 + 16 * h) = pack8(pe); *(LAS bf16x8*)(scr + tok * MP_SP + 64 + 16 * h + 8) = pack8(pe + 8); }
          LDS_WAIT();
#pragma unroll
          for (int i = 0; i < 6; ++i) { const int q = lane + 64 * i, row = q / 12, pc = q - row * 12; *(u32x4*)(KB + (bhbase + row) * 96 + 8 * pc) = *(const LAS u32x4*)(scr + row * MP_SP + 8 * pc); }
          LDS_WAIT();
          { const int pt = permpos(tok);
#pragma unroll
            for (int cb = 2; cb < 4; ++cb)
#pragma unroll
                for (int i = 0; i < 16; ++i) scr[((cb - 2) * 32 + crow16(i, h)) * 40 + pt] = f2bf(acc[cb][i]);
            LDS_WAIT();
            bf16* vt = VT + (size_t)(b * 8 + hd) * 64 * LTOT + p0;
#pragma unroll
            for (int i = 0; i < 4; ++i) { const int q = lane + 64 * i, d = q >> 2, pc = q & 3; *(u32x4*)(vt + (size_t)d * LTOT + 8 * pc) = *(const LAS u32x4*)(scr + d * 40 + 8 * pc); }
            LDS_WAIT(); } }
    }
}

constexpr int ATT_KP = 104, ATT_VP = 72;
constexpr int ATT_KBYTES = 64 * ATT_KP * 2, ATT_VBYTES = 64 * ATT_VP * 2;
DI void attn_unit(Frame& F, int b, int hd, int qblk) {
    const bf16* QB = (const bf16*)(F.ws + WS_QB); const bf16* KB = (const bf16*)(F.ws + WS_KB); const bf16* VT = (const bf16*)(F.ws + WS_VT);
    bf16* O = (bf16*)(F.ws + WS_ABR) + (size_t)NT * 512;
    const int q0 = qblk == 0 ? 0 : CTX + 256 * (qblk - 1), ntiles = qblk == 0 ? CTX / 64 : LTOT / 64;
    const int lane = fresh_lane(), ql = lane & 31, h = lane >> 5, w = F.wave, tid = w * 64 + lane;
    const size_t bh = (size_t)(b * 8 + hd);
    LAS bf16* Kt = (LAS bf16*)(F.lds); LAS bf16* Vt = (LAS bf16*)(F.lds + 2 * ATT_KBYTES);
    bf16x8 qf[6];
    { const bf16* qrow = QB + (bh * LTOT + q0 + 32 * w + ql) * 96 + 8 * h;
#pragma unroll
      for (int s = 0; s < 6; ++s) qf[s] = *(const bf16x8*)(qrow + 16 * s); }
    const bf16* kbase = KB + bh * LTOT * 96; const bf16* vbase = VT + bh * 64 * LTOT;
    const int k1 = tid / 12, c1 = tid - k1 * 12, k2 = (512 + tid) / 12, c2 = (512 + tid) - k2 * 12, vd = tid >> 3, vc = tid & 7;
    u32x4 rk1, rk2 = {0u, 0u, 0u, 0u}, rv;
    rk1 = *(const u32x4*)(kbase + (size_t)k1 * 96 + 8 * c1); if (tid < 256) rk2 = *(const u32x4*)(kbase + (size_t)k2 * 96 + 8 * c2); rv = *(const u32x4*)(vbase + (size_t)vd * LTOT + 8 * vc);
    __syncthreads();
    *(LAS u32x4*)(Kt + k1 * ATT_KP + 8 * c1) = rk1; if (tid < 256) *(LAS u32x4*)(Kt + k2 * ATT_KP + 8 * c2) = rk2; *(LAS u32x4*)(Vt + vd * ATT_VP + 8 * vc) = rv;
    __syncthreads();
    float m = -1.0e30f, lsum = 0.f; f32x16 o0, o1;
#pragma unroll
    for (int i = 0; i < 16; ++i) { o0[i] = 0.f; o1[i] = 0.f; }
    const float sc = 0.10206207261596577f * 1.4426950408889634f;
    for (int t = 0; t < ntiles; ++t) {
        const int buf = t & 1; const bool more = t + 1 < ntiles;
        if (more) { const size_t ko = (size_t)(t + 1) * 64; rk1 = *(const u32x4*)(kbase + (ko + k1) * 96 + 8 * c1); if (tid < 256) rk2 = *(const u32x4*)(kbase + (ko + k2) * 96 + 8 * c2); rv = *(const u32x4*)(vbase + (size_t)vd * LTOT + ko + 8 * vc); }
        const LAS bf16* kt = Kt + buf * (64 * ATT_KP); const LAS bf16* vt = Vt + buf * (64 * ATT_VP);
        f32x16 s0, s1;
#pragma unroll
        for (int i = 0; i < 16; ++i) { s0[i] = 0.f; s1[i] = 0.f; }
        bf16x8 kf0[6], kf1[6];
#pragma unroll
        for (int s = 0; s < 6; ++s) { kf0[s] = *(const LAS bf16x8*)(kt + ql * ATT_KP + 16 * s + 8 * h); kf1[s] = *(const LAS bf16x8*)(kt + (32 + ql) * ATT_KP + 16 * s + 8 * h); }
        __builtin_amdgcn_sched_barrier(0);
#pragma unroll
        for (int s = 0; s < 6; ++s) { s0 = __builtin_amdgcn_mfma_f32_32x32x16_bf16(kf0[s], qf[s], s0, 0, 0, 0); s1 = __builtin_amdgcn_mfma_f32_32x32x16_bf16(kf1[s], qf[s], s1, 0, 0, 0); }
        bf16x8 vf0[4], vf1[4];
#pragma unroll
        for (int ks = 0; ks < 4; ++ks) { vf0[ks] = *(const LAS bf16x8*)(vt + ql * ATT_VP + 16 * ks + 8 * h); vf1[ks] = *(const LAS bf16x8*)(vt + (32 + ql) * ATT_VP + 16 * ks + 8 * h); }
        __builtin_amdgcn_sched_barrier(0);
        float mr = -1.0e30f;
#pragma unroll
        for (int i = 0; i < 16; ++i) mr = fmaxf(mr, fmaxf(s0[i], s1[i]));
        mr = fmaxf(mr, sx(mr, 32));
        const float mn = fmaxf(m, mr * sc), alpha = __builtin_amdgcn_exp2f(m - mn); m = mn;
        float rs = 0.f;
#pragma unroll
        for (int i = 0; i < 16; ++i) { s0[i] = __builtin_amdgcn_exp2f(__builtin_fmaf(s0[i], sc, -mn)); s1[i] = __builtin_amdgcn_exp2f(__builtin_fmaf(s1[i], sc, -mn)); rs += s0[i] + s1[i]; }
        lsum = lsum * alpha + rs;
#pragma unroll
        for (int i = 0; i < 16; ++i) { o0[i] *= alpha; o1[i] *= alpha; }
        bf16x8 pf[4];
        { u32x4 x;
          x.x = pk2(s0[0], s0[1]); x.y = pk2(s0[2], s0[3]); x.z = pk2(s0[4], s0[5]); x.w = pk2(s0[6], s0[7]); pf[0] = __builtin_bit_cast(bf16x8, x);
          x.x = pk2(s0[8], s0[9]); x.y = pk2(s0[10], s0[11]); x.z = pk2(s0[12], s0[13]); x.w = pk2(s0[14], s0[15]); pf[1] = __builtin_bit_cast(bf16x8, x);
          x.x = pk2(s1[0], s1[1]); x.y = pk2(s1[2], s1[3]); x.z = pk2(s1[4], s1[5]); x.w = pk2(s1[6], s1[7]); pf[2] = __builtin_bit_cast(bf16x8, x);
          x.x = pk2(s1[8], s1[9]); x.y = pk2(s1[10], s1[11]); x.z = pk2(s1[12], s1[13]); x.w = pk2(s1[14], s1[15]); pf[3] = __builtin_bit_cast(bf16x8, x); }
        __builtin_amdgcn_sched_barrier(0);
#pragma unroll
        for (int ks = 0; ks < 4; ++ks) { o0 = __builtin_amdgcn_mfma_f32_32x32x16_bf16(vf0[ks], pf[ks], o0, 0, 0, 0); o1 = __builtin_amdgcn_mfma_f32_32x32x16_bf16(vf1[ks], pf[ks], o1, 0, 0, 0); }
        if (more) { const int nb = buf ^ 1; LAS bf16* kn = Kt + nb * (64 * ATT_KP); LAS bf16* vn = Vt + nb * (64 * ATT_VP);
            *(LAS u32x4*)(kn + k1 * ATT_KP + 8 * c1) = rk1; if (tid < 256) *(LAS u32x4*)(kn + k2 * ATT_KP + 8 * c2) = rk2; *(LAS u32x4*)(vn + vd * ATT_VP + 8 * vc) = rv; }
        __syncthreads();
    }
    lsum += sx(lsum, 32);
    const float inv = 1.f / lsum;
    bf16* orow = O + ((size_t)b * LTOT + q0 + 32 * w + ql) * 512 + hd * 64 + 4 * h;
#pragma unroll
    for (int g = 0; g < 4; ++g) { u32x2 x; x.x = pk2(o0[4 * g] * inv, o0[4 * g + 1] * inv); x.y = pk2(o0[4 * g + 2] * inv, o0[4 * g + 3] * inv); *(u32x2*)(orow + 8 * g) = x;
        x.x = pk2(o1[4 * g] * inv, o1[4 * g + 1] * inv); x.y = pk2(o1[4 * g + 2] * inv, o1[4 * g + 3] * inv); *(u32x2*)(orow + 32 + 8 * g) = x; }
}

DI void shift_n(const bf16* prow, bool first, bool last, int col, const float* mup, const float* mun, float* out, int n  ) {
    const bf16* pp = first ? prow : prow - DINP; const bf16* pn = last ? prow : prow + DINP; const float fm = first ? 0.f : 1.f, lm = last ? 0.f : 1.f;
    if (n == 8) {
        const u32x4 c = *(const u32x4*)(prow + col), pv = *(const u32x4*)(pp + col), nx = *(const u32x4*)(pn + col);
        const f32x4 mp0 = *(const f32x4*)(mup + col - PC_RW), mp1 = *(const f32x4*)(mup + col - PC_RW + 4), mn0 = *(const f32x4*)(mun + col - PC_RW), mn1 = *(const f32x4*)(mun + col - PC_RW + 4);
        const unsigned cw[4] = {c.x, c.y, c.z, c.w}, pw[4] = {pv.x, pv.y, pv.z, pv.w}, nw[4] = {nx.x, nx.y, nx.z, nx.w};
        const float mp[8] = {mp0.x, mp0.y, mp0.z, mp0.w, mp1.x, mp1.y, mp1.z, mp1.w}, mn[8] = {mn0.x, mn0.y, mn0.z, mn0.w, mn1.x, mn1.y, mn1.z, mn1.w};
#pragma unroll
        for (int j = 0; j < 4; ++j) { const float t0 = bflo(cw[j]), t1 = bfhi(cw[j]);
            out[2 * j] = t0 + mp[2 * j] * (fm * bflo(pw[j]) - t0) + mn[2 * j] * (lm * bflo(nw[j]) - t0);
            out[2 * j + 1] = t1 + mp[2 * j + 1] * (fm * bfhi(pw[j]) - t1) + mn[2 * j + 1] * (lm * bfhi(nw[j]) - t1); }
    } else {
        const u32x2 c = *(const u32x2*)(prow + col), pv = *(const u32x2*)(pp + col), nx = *(const u32x2*)(pn + col);
        const f32x4 mp0 = *(const f32x4*)(mup + col - PC_RW), mn0 = *(const f32x4*)(mun + col - PC_RW);
        const unsigned cw[2] = {c.x, c.y}, pw[2] = {pv.x, pv.y}, nw[2] = {nx.x, nx.y};
        const float mp[4] = {mp0.x, mp0.y, mp0.z, mp0.w}, mn[4] = {mn0.x, mn0.y, mn0.z, mn0.w};
#pragma unroll
        for (int j = 0; j < 2; ++j) { const float t0 = bflo(cw[j]), t1 = bfhi(cw[j]);
            out[2 * j] = t0 + mp[2 * j] * (fm * bflo(pw[j]) - t0) + mn[2 * j] * (lm * bflo(nw[j]) - t0);
            out[2 * j + 1] = t1 + mp[2 * j + 1] * (fm * bfhi(pw[j]) - t1) + mn[2 * j + 1] * (lm * bfhi(nw[j]) - t1); }
    }
}
constexpr int RP_P = 1928;
DI void phase_rwkv_prep2(Frame& F, const KA& a, int l) {
    const bf16* P = (const bf16*)(F.ws + WS_P);
    const bf16* W2T = (const bf16*)(F.ws + WS_SMALLW + (size_t)l * MiB + SW_W2); const bf16* A2T = (const bf16*)(F.ws + WS_SMALLW + (size_t)l * MiB + SW_A2); const bf16* G2T = (const bf16*)(F.ws + WS_SMALLW + (size_t)l * MiB + SW_G2);
    const float* mup = a.in(I_MUP) + l * 1920; const float* mun = a.in(I_MUN) + l * 1920;
    const float* w0 = a.in(I_W0) + l * 1024; const float* a0 = a.in(I_A0) + l * 1024; const float* kkw = a.in(I_KK) + l * 512; const float* kaw = a.in(I_KA) + l * 512;
    bf16* RW = (bf16*)(F.ws + WS_RW); float* LW = (float*)(F.ws + WS_LW);
    const size_t TS = (size_t)NT * 512;
    LAS bf16* T = (LAS bf16*)F.lds;
#pragma unroll 1
    for (int it = (F.bid + 64) % F.G; it < NT / 32; it += F.G) {
        const int lane = fresh_lane(); int w = F.wave; asm volatile("" : "+s"(w)); const int tid = w * 64 + lane;
        const int r0 = it * 32;
        __syncthreads();
        if (tid < 480) { const int pc = tid % 240, rh = tid / 240, row0 = rh * 16, col = PC_RW + 8 * pc;
            const int ra = r0 + row0, ba = ra / LTOT, pa = ra - ba * LTOT;
            u32x4 rowv[18];
#pragma unroll
            for (int j = 0; j < 18; ++j) { const int p = pa - 1 + j; const bool valid = (p >= 0) && (p < LTOT) && ((p < CTX) == (pa < CTX));
                const int pcl = valid ? p : pa; rowv[j] = *(const u32x4*)(P + ((size_t)ba * LTOT + pcl) * DINP + col); if (!valid) rowv[j] = (u32x4){0u, 0u, 0u, 0u}; }
            const f32x4 mp0 = *(const f32x4*)(mup + 8 * pc), mp1 = *(const f32x4*)(mup + 8 * pc + 4), mn0 = *(const f32x4*)(mun + 8 * pc), mn1 = *(const f32x4*)(mun + 8 * pc + 4);
            const float mp[8] = {mp0.x, mp0.y, mp0.z, mp0.w, mp1.x, mp1.y, mp1.z, mp1.w}, mn[8] = {mn0.x, mn0.y, mn0.z, mn0.w, mn1.x, mn1.y, mn1.z, mn1.w};
#pragma unroll
            for (int j = 0; j < 16; ++j) { float pv[8], cv[8], nv[8], v[8]; unpack8(rowv[j], pv); unpack8(rowv[j + 1], cv); unpack8(rowv[j + 2], nv);
#pragma unroll
                for (int e = 0; e < 8; ++e) v[e] = cv[e] + mp[e] * (pv[e] - cv[e]) + mn[e] * (nv[e] - cv[e]);
                if (pc >= 192 && pc < 208) {
#pragma unroll
                    for (int e = 0; e < 8; ++e) v[e] = 2.f * sigmoidf_(2.f * v[e]) - 1.f; }
                else if (pc >= 224) {
#pragma unroll
                    for (int e = 0; e < 8; ++e) v[e] = sigmoidf_(v[e]); }
                *(LAS bf16x8*)(T + (row0 + j) * RP_P + 8 * pc) = pack8(v); } }
        __syncthreads();
        const int hd = w, tok = lane & 31, h = lane >> 5;
        const LAS bf16* trow = T + tok * RP_P;
#define RP_OUT(c0, dst) do { _Pragma("unroll") for (int i_ = 0; i_ < 4; ++i_) { const int row_ = 8 * i_ + (lane >> 3), pc_ = lane & 7; \
            *(u32x4*)((dst) + (size_t)(r0 + row_) * 512 + hd * 64 + 8 * pc_) = *(const LAS u32x4*)(T + row_ * RP_P + (c0) + 8 * pc_); } } while (0)
        bf16x8 wa[2][8], wg[16], wl[2][8];
#define RP_LDW_A(d_) do { _Pragma("unroll") for (int cb_ = 0; cb_ < 2; ++cb_) _Pragma("unroll") for (int s_ = 0; s_ < 4; ++s_) wa[d_][cb_ * 4 + s_] = *(const bf16x8*)(A2T + (size_t)((d_) * 512 + hd * 64 + cb_ * 32 + tok) * 64 + 16 * s_ + 8 * h); } while (0)
#define RP_LDW_L(d_) do { _Pragma("unroll") for (int cb_ = 0; cb_ < 2; ++cb_) _Pragma("unroll") for (int s_ = 0; s_ < 4; ++s_) wl[d_][cb_ * 4 + s_] = *(const bf16x8*)(W2T + (size_t)((d_) * 512 + hd * 64 + cb_ * 32 + tok) * 64 + 16 * s_ + 8 * h); } while (0)
#define RP_LDW_G() do { _Pragma("unroll") for (int cb_ = 0; cb_ < 2; ++cb_) _Pragma("unroll") for (int s_ = 0; s_ < 8; ++s_) wg[cb_ * 8 + s_] = *(const bf16x8*)(G2T + (size_t)(hd * 64 + cb_ * 32 + tok) * 128 + 16 * s_ + 8 * h); } while (0)
        RP_LDW_A(0);
        RP_OUT(hd * 64, RW); RP_OUT(1024 + hd * 64, RW + 3 * TS);
        float kraw[2][16]; float ss = 0.f;
#pragma unroll
        for (int cb = 0; cb < 2; ++cb)
#pragma unroll
            for (int g = 0; g < 4; ++g) { const int ch = hd * 64 + cb * 32 + 8 * g + 4 * h; const u32x2 kw = *(const LAS u32x2*)(trow + 512 + ch);
                kraw[cb][4 * g] = bflo(kw.x); kraw[cb][4 * g + 1] = bfhi(kw.x); kraw[cb][4 * g + 2] = bflo(kw.y); kraw[cb][4 * g + 3] = bfhi(kw.y);
                const f32x4 kk4 = *(const f32x4*)(kkw + ch);
                ss += kraw[cb][4 * g] * kk4.x * kraw[cb][4 * g] * kk4.x + kraw[cb][4 * g + 1] * kk4.y * kraw[cb][4 * g + 1] * kk4.y + kraw[cb][4 * g + 2] * kk4.z * kraw[cb][4 * g + 2] * kk4.z + kraw[cb][4 * g + 3] * kk4.w * kraw[cb][4 * g + 3] * kk4.w; }
        ss += sx(ss, 32);
        const float rkk = rsqrtf(fmaxf(ss, 1e-24f));
        LDS_WAIT();
        LAS bf16* scr3[3] = {T + hd * 64, T + 1024 + hd * 64, T + 512 + hd * 64};
#define RP_TILE_OUT(vals  , dst, NN) do { LAS bf16* scr = scr3[(NN) % 3]; const int sc0_ = ((NN) % 3 == 0 ? 0 : (NN) % 3 == 1 ? 1024 : 512) + hd * 64; _Pragma("unroll") for (int cb_ = 0; cb_ < 2; ++cb_) _Pragma("unroll") for (int g_ = 0; g_ < 4; ++g_) { u32x2 x_; x_[0] = pk2(vals[cb_][4 * g_], vals[cb_][4 * g_ + 1]); x_[1] = pk2(vals[cb_][4 * g_ + 2], vals[cb_][4 * g_ + 3]); \
            *(LAS u32x2*)(scr + tok * RP_P + cb_ * 32 + 8 * g_ + 4 * h) = x_; } LDS_WAIT(); RP_OUT(sc0_, dst); } while (0)
        { float av[2][16], o[2][16];
#pragma unroll
          for (int d = 0; d < 2; ++d) {
              if (d == 0) RP_LDW_A(1); else RP_LDW_G();
#pragma unroll
              for (int cb = 0; cb < 2; ++cb) { f32x16 c = zero16();
                  bf16x8 xf[4];
#pragma unroll
                  for (int s2 = 0; s2 < 4; ++s2) xf[s2] = *(const LAS bf16x8*)(trow + 1664 + 64 * d + 16 * s2 + 8 * h);
                  __builtin_amdgcn_sched_barrier(0);
#pragma unroll
                  for (int s2 = 0; s2 < 4; ++s2) c = __builtin_amdgcn_mfma_f32_32x32x16_bf16(wa[d][cb * 4 + s2], xf[s2], c, 0, 0, 0);
#pragma unroll
                  for (int g = 0; g < 4; ++g) { const f32x4 a4 = *(const f32x4*)(a0 + d * 512 + hd * 64 + cb * 32 + 8 * g + 4 * h);
                      av[cb][4 * g] = sigmoidf_(a4.x + c[4 * g]); av[cb][4 * g + 1] = sigmoidf_(a4.y + c[4 * g + 1]); av[cb][4 * g + 2] = sigmoidf_(a4.z + c[4 * g + 2]); av[cb][4 * g + 3] = sigmoidf_(a4.w + c[4 * g + 3]); } }
              RP_TILE_OUT(av, RW + (size_t)(5 + d) * TS, 2 * d);
#pragma unroll
              for (int cb = 0; cb < 2; ++cb)
#pragma unroll
                  for (int g = 0; g < 4; ++g) { const f32x4 ka4 = *(const f32x4*)(kaw + hd * 64 + cb * 32 + 8 * g + 4 * h);
                      o[cb][4 * g] = kraw[cb][4 * g] * (1.f + (av[cb][4 * g] - 1.f) * ka4.x); o[cb][4 * g + 1] = kraw[cb][4 * g + 1] * (1.f + (av[cb][4 * g + 1] - 1.f) * ka4.y);
                      o[cb][4 * g + 2] = kraw[cb][4 * g + 2] * (1.f + (av[cb][4 * g + 2] - 1.f) * ka4.z); o[cb][4 * g + 3] = kraw[cb][4 * g + 3] * (1.f + (av[cb][4 * g + 3] - 1.f) * ka4.w); }
              RP_TILE_OUT(o, RW + (size_t)(1 + d) * TS, 2 * d + 1); }
#pragma unroll
          for (int cb = 0; cb < 2; ++cb)
#pragma unroll
              for (int g = 0; g < 4; ++g) { const f32x4 kk4 = *(const f32x4*)(kkw + hd * 64 + cb * 32 + 8 * g + 4 * h);
                  o[cb][4 * g] = kraw[cb][4 * g] * kk4.x * rkk; o[cb][4 * g + 1] = kraw[cb][4 * g + 1] * kk4.y * rkk; o[cb][4 * g + 2] = kraw[cb][4 * g + 2] * kk4.z * rkk; o[cb][4 * g + 3] = kraw[cb][4 * g + 3] * kk4.w * rkk; }
          RP_TILE_OUT(o, RW + 4 * TS, 4); }
        { float o[2][16];
#pragma unroll
          for (int cb = 0; cb < 2; ++cb) { f32x16 c = zero16();
              if (cb == 0) RP_LDW_L(0);
              bf16x8 xf[8];
#pragma unroll
              for (int s2 = 0; s2 < 8; ++s2) xf[s2] = *(const LAS bf16x8*)(trow + 1792 + 16 * s2 + 8 * h);
              __builtin_amdgcn_sched_barrier(0);
#pragma unroll
              for (int s2 = 0; s2 < 8; ++s2) c = __builtin_amdgcn_mfma_f32_32x32x16_bf16(wg[cb * 8 + s2], xf[s2], c, 0, 0, 0);
#pragma unroll
              for (int i = 0; i < 16; ++i) o[cb][i] = c[i]; }
          RP_TILE_OUT(o, RW + 7 * TS, 5); }
#pragma unroll
        for (int d = 0; d < 2; ++d)
#pragma unroll
            for (int cb = 0; cb < 2; ++cb) { f32x16 c = zero16();
                if (d == 0 && cb == 0) RP_LDW_L(1);
                bf16x8 xf[4];
#pragma unroll
                for (int s2 = 0; s2 < 4; ++s2) xf[s2] = *(const LAS bf16x8*)(trow + 1536 + 64 * d + 16 * s2 + 8 * h);
                __builtin_amdgcn_sched_barrier(0);
#pragma unroll
                for (int s2 = 0; s2 < 4; ++s2) c = __builtin_amdgcn_mfma_f32_32x32x16_bf16(wl[d][cb * 4 + s2], xf[s2], c, 0, 0, 0);
                LAS float* fs = (LAS float*)scr3[(6 + 2 * d + cb) % 3];
#pragma unroll
                for (int g = 0; g < 4; ++g) { const f32x4 w4 = *(const f32x4*)(w0 + d * 512 + hd * 64 + cb * 32 + 8 * g + 4 * h);
                    *(LAS f32x4*)(fs + tok * (RP_P / 2) + 8 * g + 4 * h) = (f32x4){-0.6065306597f * sigmoidf_(w4.x + c[4 * g]), -0.6065306597f * sigmoidf_(w4.y + c[4 * g + 1]), -0.6065306597f * sigmoidf_(w4.z + c[4 * g + 2]), -0.6065306597f * sigmoidf_(w4.w + c[4 * g + 3])}; }
                LDS_WAIT();
#pragma unroll
                for (int i_ = 0; i_ < 4; ++i_) { const int row_ = 8 * i_ + (lane >> 3), pc_ = lane & 7;
                    *(f32x4*)(LW + (size_t)d * TS + (size_t)(r0 + row_) * 512 + hd * 64 + cb * 32 + 4 * pc_) = *(const LAS f32x4*)(fs + row_ * (RP_P / 2) + 4 * pc_); } }
        LDS_WAIT();
#undef RP_OUT
#undef RP_TILE_OUT
#undef RP_LDW_A
#undef RP_LDW_L
#undef RP_LDW_G
    }
}

constexpr int NCHUNK = LTOT / 64;
constexpr int NCHAIN = BATCH * 8 * 2;
constexpr int RC_P = 72;
constexpr int RC_TILE = 64 * RC_P * 2;
constexpr int RC_LTF = 13 * RC_TILE, RC_EC = RC_LTF + 64 * 65 * 4;
DI int chain_pos(int dir, int n) { return dir == 0 ? n : (n < CTX ? CTX - 1 - n : LTOT - 1 - (n - CTX)); }
DI f32x16 mm_blk(const LAS bf16* A, int mb, const LAS bf16* Bt, int nb, int k0, int ksteps, int lane, f32x16 acc) {
    const int r = lane & 31, h = lane >> 5;
    bf16x8 fa[4], fb[4];
#pragma unroll
    for (int q = 0; q < 4; ++q) if (q < ksteps) { fa[q] = *(const LAS bf16x8*)(A + (mb * 32 + r) * RC_P + k0 + 16 * q + 8 * h); fb[q] = *(const LAS bf16x8*)(Bt + (nb * 32 + r) * RC_P + k0 + 16 * q + 8 * h); }
    __builtin_amdgcn_sched_barrier(0);
#pragma unroll
    for (int q = 0; q < 4; ++q) if (q < ksteps) acc = __builtin_amdgcn_mfma_f32_32x32x16_bf16(fa[q], fb[q], acc, 0, 0, 0);
    return acc;
}
DI void st_tile_T(LAS bf16* tile, int mb, int nb, const f32x16& d, int lane) {
    const int r = lane & 31, h = lane >> 5;
#pragma unroll
    for (int g = 0; g < 4; ++g) { u32x2 x; x.x = pk2(d[4 * g], d[4 * g + 1]); x.y = pk2(d[4 * g + 2], d[4 * g + 3]); *(LAS u32x2*)(tile + (nb * 32 + r) * RC_P + mb * 32 + 8 * g + 4 * h) = x; }
}
constexpr int RC_LTF2 = 13 * RC_TILE, RC_EC2 = RC_LTF2 + 2 * 32 * 36 * 4, RC_ST = RC_EC2 + 256;
static_assert(RC_ST + RC_TILE <= LDS_MISC_OFF, "rwkv chain LDS map");
DI void rwkv_chain_block(Frame& F, int chain) {
    const int w_ = F.wave;
    const int dir = chain & 1, bh = chain >> 1, b = bh >> 3, hd = bh & 7;
    const bf16* RW = (const bf16*)(F.ws + WS_RW); const float* LW = (const float*)(F.ws + WS_LW); const size_t TS = (size_t)NT * 512;
    bf16* Yg = (bf16*)(F.ws + WS_YF) + (size_t)dir * TS + (size_t)b * LTOT * 512 + hd * 64;
    LAS bf16* tiles = (LAS bf16*)F.lds;
#define TILE(i) (tiles + (i) * (RC_TILE / 2))
    LAS float* LTf = (LAS float*)(F.lds + RC_LTF2); LAS float* EC = (LAS float*)(F.lds + RC_EC2); LAS bf16* ST = (LAS bf16*)(F.lds + RC_ST);
    __syncthreads();
    { const int lane0 = fresh_lane(); for (int i = w_ * 64 + lane0; i < RC_TILE / 4; i += NTHREADS) ((LAS unsigned*)ST)[i] = 0u; }
    f32x4 nl0, nl1; u32x4 nr, nk, nv, nkk, na;
#define RC_LOAD(cc) do { const int lane_ = fresh_lane(); const int p_ = chain_pos(dir, 64 * (cc) + lane_); const size_t off_ = ((size_t)b * LTOT + p_) * 512 + hd * 64 + 8 * w; \
        nl0 = *(const f32x4*)(LW + (size_t)dir * TS + off_); nl1 = *(const f32x4*)(LW + (size_t)dir * TS + off_ + 4); nr = *(const u32x4*)(RW + off_); nk = *(const u32x4*)(RW + (size_t)(1 + dir) * TS + off_); \
        nv = *(const u32x4*)(RW + 3 * TS + off_); nkk = *(const u32x4*)(RW + 4 * TS + off_); na = *(const u32x4*)(RW + (size_t)(5 + dir) * TS + off_); } while (0)
    { const int w = w_; RC_LOAD(0); }
#pragma unroll 1
    for (int c = 0; c < NCHUNK; ++c) {
        const int lane = fresh_lane(); int w = w_; asm volatile("" : "+s"(w));
        { const f32x4 l0 = nl0, l1 = nl1; const u32x4 ur = nr, uk = nk, uv = nv, ukk = nkk, ua = na;
          float lw[8] = {l0.x, l0.y, l0.z, l0.w, l1.x, l1.y, l1.z, l1.w}, cw[8];
#pragma unroll
          for (int j = 0; j < 8; ++j) cw[j] = lw[j];
#pragma unroll
          for (int j = 0; j < 8; ++j) cw[j] = dpp_scan64(cw[j]);
          const unsigned rw_[4] = {ur.x, ur.y, ur.z, ur.w}, kw_[4] = {uk.x, uk.y, uk.z, uk.w}, kkw_[4] = {ukk.x, ukk.y, ukk.z, ukk.w}, aw_[4] = {ua.x, ua.y, ua.z, ua.w};
          float At[8], Rt[8], Bt[8], Kt[8];
#pragma unroll
          for (int j = 0; j < 8; ++j) { const float rr = (j & 1) ? bfhi(rw_[j >> 1]) : bflo(rw_[j >> 1]), kk = (j & 1) ? bfhi(kkw_[j >> 1]) : bflo(kkw_[j >> 1]), k = (j & 1) ? bfhi(kw_[j >> 1]) : bflo(kw_[j >> 1]), aa = (j & 1) ? bfhi(aw_[j >> 1]) : bflo(aw_[j >> 1]);
              const float ep = __expf(cw[j]), em = __expf(-cw[j]), epv = __expf(cw[j] - lw[j]);
              At[j] = -kk * epv; Rt[j] = rr * ep; Bt[j] = kk * aa * em; Kt[j] = k * em;
              if (lane == 63) EC[8 * w + j] = ep; }
          const bf16x8 fa = pack8(At), fr_ = pack8(Rt), fb = pack8(Bt), fk = pack8(Kt);
          *(LAS bf16x8*)(TILE(0) + lane * RC_P + 8 * w) = fa; *(LAS bf16x8*)(TILE(1) + lane * RC_P + 8 * w) = fr_; *(LAS bf16x8*)(TILE(2) + lane * RC_P + 8 * w) = fb; *(LAS bf16x8*)(TILE(3) + lane * RC_P + 8 * w) = fk;
          const unsigned vw_[4] = {uv.x, uv.y, uv.z, uv.w};
#pragma unroll
          for (int j = 0; j < 8; ++j) { TILE(4)[(8 * w + j) * RC_P + lane] = (bf16)fa[j]; TILE(5)[(8 * w + j) * RC_P + lane] = (bf16)fb[j]; TILE(6)[(8 * w + j) * RC_P + lane] = (bf16)fk[j];
              TILE(7)[(8 * w + j) * RC_P + lane] = (bf16)((j & 1) ? (vw_[j >> 1] >> 16) : (vw_[j >> 1] & 0xffffu)); } }
        LDS_BARRIER();
        if (c + 1 < NCHUNK) RC_LOAD(c + 1);
        { const int pi = w >> 1, nb = w & 1, r = lane & 31, h = lane >> 5;
          const LAS bf16* Aop = (pi == 0 || pi == 2) ? TILE(2) : TILE(3);
          const LAS bf16* Bop = pi < 2 ? TILE(0) : TILE(1);
          LAS bf16* dst = TILE(8 + pi);
#pragma unroll
          for (int mb = 0; mb < 2; ++mb) { f32x16 d = zero16();
              if (mb <= nb) d = mm_blk(Aop, mb, Bop, nb, 0, 4, lane, d);
#pragma unroll
              for (int i = 0; i < 16; ++i) { const int m = mb * 32 + crow16(i, h), n = nb * 32 + r; const bool keep = pi < 2 ? m < n : m <= n; d[i] = keep ? d[i] : 0.f; }
              st_tile_T(dst, mb, nb, d, lane);
              if (pi == 0 && mb == nb) {
#pragma unroll
                  for (int i = 0; i < 16; ++i) LTf[(mb * 32 + crow16(i, h)) * 36 + r] = d[i]; } } }
        LDS_BARRIER();
        if (w == 0) {
            { const int k = lane >> 4, tl = lane & 15, blk = k >> 1, o16 = (k & 1) * 16;
              float Tr[16];
#pragma unroll
              for (int i = 0; i < 16; ++i) Tr[i] = 0.f;
#pragma unroll
              for (int cc = 15; cc >= 0; --cc) { float a0 = (cc == tl) ? 1.f : 0.f, a1 = 0.f;
                  const LAS float* lrow = LTf + (blk * 32 + o16 + cc) * 36 + o16;
#pragma unroll
                  for (int q4 = (cc + 1) >> 2; q4 < 4; ++q4) { const f32x4 l4 = *(const LAS f32x4*)(lrow + 4 * q4);
#pragma unroll
                      for (int e = 0; e < 4; ++e) { const int s2 = 4 * q4 + e; if (s2 > cc) { if (e & 1) a1 += Tr[s2] * l4[e]; else a0 += Tr[s2] * l4[e]; } } }
                  Tr[cc] = a0 + a1; if ((cc & 3) == 0) asm volatile("" ::: "memory"); }
              unsigned z0; asm volatile("v_mov_b32 %0, 0" : "=v"(z0)); const u32x4 zz = {z0, z0, z0, z0};
              LAS bf16* trow = TILE(12) + lane * RC_P; LAS bf16* ttrow = TILE(0) + lane * RC_P;
#pragma unroll
              for (int g = 0; g < 8; ++g) { *(LAS u32x4*)(trow + 8 * g) = zz; *(LAS u32x4*)(ttrow + 8 * g) = zz; }
              *(LAS bf16x8*)(trow + 16 * k) = pack8(Tr); *(LAS bf16x8*)(trow + 16 * k + 8) = pack8(Tr + 8);
#pragma unroll
              for (int i = 0; i < 16; ++i) TILE(0)[(16 * k + i) * RC_P + lane] = f2bf(Tr[i]); }
            LDS_WAIT();
            { const int r = lane & 31, h = lane >> 5;
#pragma unroll
              for (int blk = 0; blk < 2; ++blk) {
                  f32x16 x = zero16();
                  x = __builtin_amdgcn_mfma_f32_32x32x16_bf16(*(const LAS bf16x8*)(TILE(8) + (32 * blk + r) * RC_P + 32 * blk + 8 * h), *(const LAS bf16x8*)(TILE(0) + (32 * blk + r) * RC_P + 32 * blk + 8 * h), x, 0, 0, 0);
                  st_tile_T(TILE(2), 0, blk, x, lane);
                  LDS_WAIT();
                  f32x16 d = zero16();
                  d = __builtin_amdgcn_mfma_f32_32x32x16_bf16(*(const LAS bf16x8*)(TILE(12) + (32 * blk + r) * RC_P + 32 * blk + 16 + 8 * h), *(const LAS bf16x8*)(TILE(2) + (32 * blk + r) * RC_P + 16 + 8 * h), d, 0, 0, 0);
                  if (r < 16) {
#pragma unroll
                      for (int i = 8; i < 16; ++i) TILE(12)[(32 * blk + crow16(i, h)) * RC_P + 32 * blk + r] = f2bf(d[i]);
                      { u32x2 y0, y1; y0.x = pk2(d[8], d[9]); y0.y = pk2(d[10], d[11]); y1.x = pk2(d[12], d[13]); y1.y = pk2(d[14], d[15]);
                        *(LAS u32x2*)(TILE(0) + (32 * blk + r) * RC_P + 32 * blk + 16 + 4 * h) = y0; *(LAS u32x2*)(TILE(0) + (32 * blk + r) * RC_P + 32 * blk + 24 + 4 * h) = y1; } }
                  LDS_WAIT(); } }
            LDS_WAIT();
            f32x16 m1 = mm_blk(TILE(8), 1, TILE(0), 0, 0, 2, lane, zero16());
            st_tile_T(TILE(2), 0, 0, m1, lane);
            LDS_WAIT();
            { const int r = lane & 31, h = lane >> 5; f32x16 d = zero16();
#pragma unroll
              for (int q = 0; q < 2; ++q) { const bf16x8 a = *(const LAS bf16x8*)(TILE(2) + r * RC_P + 16 * q + 8 * h), bb = *(const LAS bf16x8*)(TILE(12) + (32 + r) * RC_P + 32 + 16 * q + 8 * h);
                  d = __builtin_amdgcn_mfma_f32_32x32x16_bf16(a, bb, d, 0, 0, 0); }
#pragma unroll
              for (int g = 0; g < 4; ++g) { u32x2 x; x.x = pk2(d[4 * g], d[4 * g + 1]); x.y = pk2(d[4 * g + 2], d[4 * g + 3]); *(LAS u32x2*)(TILE(12) + (32 + r) * RC_P + 8 * g + 4 * h) = x; } }
        } else if (w <= 4) {
            const int mb = (w - 1) >> 1, nb = (w - 1) & 1;
            const f32x16 u = mm_blk(TILE(9), mb, TILE(7), nb, 0, 4, lane, zero16());
            st_tile_T(TILE(3), mb, nb, u, lane);
        }
        LDS_BARRIER();
        { const int mb = (w >> 1) & 1, nb = w & 1;
          if (w < 4) { const f32x16 d = mm_blk(TILE(12), mb, TILE(4), nb, 0, 4, lane, zero16()); st_tile_T(TILE(2), mb, nb, d, lane); }
          else { const f32x16 d = mm_blk(TILE(12), mb, TILE(3), nb, 0, 4, lane, zero16()); st_tile_T(TILE(0), mb, nb, d, lane); } }
        LDS_BARRIER();
        const int mb = (w >> 1) & 1, nb = w & 1, r = lane & 31, h = lane >> 5;
        f32x16 cin;
        if (w < 4) {
            f32x16 d = mm_blk(TILE(2), mb, TILE(5), nb, 0, 4, lane, zero16());
#pragma unroll
            for (int i = 0; i < 16; ++i) { const int m = mb * 32 + crow16(i, h), n = nb * 32 + r; d[i] = (d[i] + (m == n ? 1.f : 0.f)) * EC[n]; }
            st_tile_T(TILE(8), mb, nb, d, lane);
            cin = mm_blk(TILE(5), mb, TILE(0), nb, 0, 4, lane, zero16()); cin = mm_blk(TILE(6), mb, TILE(7), nb, 0, 4, lane, cin);
#pragma unroll
            for (int i = 0; i < 16; ++i) cin[i] *= EC[mb * 32 + crow16(i, h)];
        } else {
            f32x16 d = mm_blk(TILE(2), mb, TILE(10), nb, 0, 4, lane, zero16());
#pragma unroll
            for (int i = 0; i < 16; ++i) { const int m = mb * 32 + crow16(i, h), n = nb * 32 + r; d[i] += bf2f(TILE(1)[n * RC_P + m]); }
            st_tile_T(TILE(9), mb, nb, d, lane);
            cin = mm_blk(TILE(10), mb, TILE(0), nb, 0, 4, lane, zero16()); cin = mm_blk(TILE(11), mb, TILE(7), nb, 0, 4, lane, cin);
        }
        LDS_BARRIER();
        if (w < 4) cin = mm_blk(TILE(8), mb, ST, nb, 0, 4, lane, cin);
        else { cin = mm_blk(TILE(9), mb, ST, nb, 0, 4, lane, cin);
#pragma unroll
            for (int i = 0; i < 16; ++i) { const int p = chain_pos(dir, 64 * c + mb * 32 + crow16(i, h)); Yg[(size_t)p * 512 + nb * 32 + r] = f2bf(cin[i]); } }
        LDS_BARRIER();
        if (w < 4) st_tile_T(ST, mb, nb, cin, lane);
    }
#undef RC_LOAD
#undef TILE
}
constexpr int RT_QP = 72, RT_TP = 136;
constexpr int RT_QS = 0, RT_KS = 128 * RT_QP * 2, RT_KT = 2 * 128 * RT_QP * 2, RT_VT = RT_KT + 64 * RT_TP * 2, RT_ST = RT_VT + 128 * RT_TP * 2;
DI void phase_retention_item(Frame& F, const KA& a, int item) {
    const int b = item >> 2, hh = item & 3, w = F.wave;
    const bf16* P = (const bf16*)(F.ws + WS_P); const float2* rt = (const float2*)(F.ws + WS_ROPE);
    bf16* OFB = (bf16*)(F.ws + WS_OF); const size_t TS = (size_t)NT * 512;
    LAS bf16* Qs = (LAS bf16*)(F.lds + RT_QS); LAS bf16* Ks = (LAS bf16*)(F.lds + RT_KS); LAS bf16* KsT = (LAS bf16*)(F.lds + RT_KT); LAS bf16* VsT = (LAS bf16*)(F.lds + RT_VT); LAS bf16* SsT = (LAS bf16*)(F.lds + RT_ST);
    const float lg2g = log2f(1.f - exp2f(-5.f - (float)hh));
    const float gam = exp2f(lg2g), g127 = exp2f(127.f * lg2g), cdec = exp2f(128.f * lg2g);
    const int rb = w >> 1, cbp = w & 1, db = w >> 2, vb = w & 3;
    for (int dir = 0; dir < 2; ++dir) {
        const int lane = fresh_lane(); const int tid = w * 64 + lane, ql = lane & 31, h = lane >> 5;
        f32x16 Sreg;
#pragma unroll
        for (int i = 0; i < 16; ++i) Sreg[i] = 0.f;
        __syncthreads();
        for (int i = tid; i < 128 * RT_QP / 2; i += NTHREADS) ((LAS unsigned*)SsT)[i] = 0u;
        for (int cn = 0; cn < 34; ++cn) {
            int p0; if (cn < 2) p0 = 128 * (dir ? 1 - cn : cn); else p0 = CTX + 128 * (dir ? 33 - cn : cn - 2);
            const bool lat = p0 >= CTX;
            { int tid_o = tid; asm volatile("" : "+v"(tid_o)); const int tok = tid_o >> 2, c = tid_o & 3; const int e = dir ? 127 - tok : tok; const size_t row = (size_t)b * LTOT + p0 + tok; const bf16* prow = P + row * DINP;
              const float sq = exp2f((float)e * lg2g), sk = 0.125f * exp2f(-(float)e * lg2g);
              const u32x4 ql_ = *(const u32x4*)(prow + PC_RQ + hh * 64 + 8 * c), qh_ = *(const u32x4*)(prow + PC_RQ + hh * 64 + 32 + 8 * c);
              const u32x4 kl_ = *(const u32x4*)(prow + PC_RK + hh * 64 + 8 * c), kh_ = *(const u32x4*)(prow + PC_RK + hh * 64 + 32 + 8 * c);
              float qlo[8] = {bflo(ql_.x), bfhi(ql_.x), bflo(ql_.y), bfhi(ql_.y), bflo(ql_.z), bfhi(ql_.z), bflo(ql_.w), bfhi(ql_.w)}, qhi[8] = {bflo(qh_.x), bfhi(qh_.x), bflo(qh_.y), bfhi(qh_.y), bflo(qh_.z), bfhi(qh_.z), bflo(qh_.w), bfhi(qh_.w)};
              float klo[8] = {bflo(kl_.x), bfhi(kl_.x), bflo(kl_.y), bfhi(kl_.y), bflo(kl_.z), bfhi(kl_.z), bflo(kl_.w), bfhi(kl_.w)}, khi[8] = {bflo(kh_.x), bfhi(kh_.x), bflo(kh_.y), bfhi(kh_.y), bflo(kh_.z), bfhi(kh_.z), bflo(kh_.w), bfhi(kh_.w)};
              if (lat) { const float2* ang = rt + (size_t)(p0 - CTX + tok) * 32 + 8 * c;
#pragma unroll
                  for (int j = 0; j < 8; ++j) { const float2 cs = ang[j]; const float a0 = qlo[j], a1 = qhi[j], b0 = klo[j], b1 = khi[j];
                      qlo[j] = a0 * cs.x - a1 * cs.y; qhi[j] = a0 * cs.y + a1 * cs.x; klo[j] = b0 * cs.x - b1 * cs.y; khi[j] = b0 * cs.y + b1 * cs.x; } }
#pragma unroll
              for (int j = 0; j < 8; ++j) { qlo[j] *= sq; qhi[j] *= sq; klo[j] *= sk; khi[j] *= sk; }
              *(LAS bf16x8*)(Qs + tok * RT_QP + 8 * c) = pack8(qlo); *(LAS bf16x8*)(Qs + tok * RT_QP + 32 + 8 * c) = pack8(qhi);
              *(LAS bf16x8*)(Ks + tok * RT_QP + 8 * c) = pack8(klo); *(LAS bf16x8*)(Ks + tok * RT_QP + 32 + 8 * c) = pack8(khi);
              const int pt = permpos(tok);
#pragma unroll
              for (int j = 0; j < 8; ++j) { KsT[(8 * c + j) * RT_TP + pt] = f2bf(klo[j]); KsT[(32 + 8 * c + j) * RT_TP + pt] = f2bf(khi[j]); }
#pragma unroll
              for (int q4 = 0; q4 < 4; ++q4) { const u32x4 vv = *(const u32x4*)(prow + PC_RV + hh * 128 + 32 * c + 8 * q4); const unsigned vw[4] = {vv.x, vv.y, vv.z, vv.w};
#pragma unroll
                  for (int j = 0; j < 4; ++j) { VsT[(32 * c + 8 * q4 + 2 * j) * RT_TP + pt] = (bf16)(vw[j] & 0xffffu); VsT[(32 * c + 8 * q4 + 2 * j + 1) * RT_TP + pt] = (bf16)(vw[j] >> 16); } } }
            __syncthreads();
            f32x16 o0, o1;
#pragma unroll
            for (int i = 0; i < 16; ++i) { o0[i] = 0.f; o1[i] = 0.f; }
            for (int kb = 0; kb < 4; ++kb) {
                if (dir == 0 ? kb > rb : kb < rb) continue;
                f32x16 x;
#pragma unroll
                for (int i = 0; i < 16; ++i) x[i] = 0.f;
#pragma unroll
                for (int s = 0; s < 4; ++s) x = __builtin_amdgcn_mfma_f32_32x32x16_bf16(*(const LAS bf16x8*)(Ks + (kb * 32 + ql) * RT_QP + 16 * s + 8 * h), *(const LAS bf16x8*)(Qs + (rb * 32 + ql) * RT_QP + 16 * s + 8 * h), x, 0, 0, 0);
                if (kb == rb) {
#pragma unroll
                    for (int i = 0; i < 16; ++i) { const int key = crow16(i, h); const bool keep = dir == 0 ? key <= ql : key >= ql; x[i] = keep ? x[i] : 0.f; } }
                float xv[16];
#pragma unroll
                for (int i = 0; i < 16; ++i) xv[i] = x[i];
                const bf16x8 xa0 = pack8(xv), xa1 = pack8(xv + 8);
                const LAS bf16* v0 = VsT + ((2 * cbp) * 32 + ql) * RT_TP + kb * 32 + 8 * h; const LAS bf16* v1 = VsT + ((2 * cbp + 1) * 32 + ql) * RT_TP + kb * 32 + 8 * h;
                o0 = __builtin_amdgcn_mfma_f32_32x32x16_bf16(xa0, *(const LAS bf16x8*)(v0), o0, 0, 0, 0); o0 = __builtin_amdgcn_mfma_f32_32x32x16_bf16(xa1, *(const LAS bf16x8*)(v0 + 16), o0, 0, 0, 0);
                o1 = __builtin_amdgcn_mfma_f32_32x32x16_bf16(xa0, *(const LAS bf16x8*)(v1), o1, 0, 0, 0); o1 = __builtin_amdgcn_mfma_f32_32x32x16_bf16(xa1, *(const LAS bf16x8*)(v1 + 16), o1, 0, 0, 0);
            }
#pragma unroll
            for (int s = 0; s < 4; ++s) { const bf16x8 qa = *(const LAS bf16x8*)(Qs + (rb * 32 + ql) * RT_QP + 16 * s + 8 * h);
                o0 = __builtin_amdgcn_mfma_f32_32x32x16_bf16(qa, *(const LAS bf16x8*)(SsT + ((2 * cbp) * 32 + ql) * RT_QP + 16 * s + 8 * h), o0, 0, 0, 0);
                o1 = __builtin_amdgcn_mfma_f32_32x32x16_bf16(qa, *(const LAS bf16x8*)(SsT + ((2 * cbp + 1) * 32 + ql) * RT_QP + 16 * s + 8 * h), o1, 0, 0, 0); }
            { bf16* op = OFB + (size_t)dir * TS + ((size_t)b * LTOT + p0 + rb * 32) * 512 + hh * 128 + (2 * cbp) * 32 + ql;
#pragma unroll
              for (int i = 0; i < 16; ++i) { op[(size_t)crow16(i, h) * 512] = f2bf(o0[i]); op[(size_t)crow16(i, h) * 512 + 32] = f2bf(o1[i]); } }
            f32x16 u;
#pragma unroll
            for (int i = 0; i < 16; ++i) u[i] = 0.f;
#pragma unroll
            for (int s = 0; s < 8; ++s) u = __builtin_amdgcn_mfma_f32_32x32x16_bf16(*(const LAS bf16x8*)(KsT + (db * 32 + ql) * RT_TP + 16 * s + 8 * h), *(const LAS bf16x8*)(VsT + (vb * 32 + ql) * RT_TP + 16 * s + 8 * h), u, 0, 0, 0);
#pragma unroll
            for (int i = 0; i < 16; ++i) Sreg[i] = cdec * Sreg[i] + g127 * u[i];
            __syncthreads();
#pragma unroll
            for (int g = 0; g < 4; ++g) { u32x2 x; x.x = pk2(gam * Sreg[4 * g], gam * Sreg[4 * g + 1]); x.y = pk2(gam * Sreg[4 * g + 2], gam * Sreg[4 * g + 3]);
                *(LAS u32x2*)(SsT + (vb * 32 + ql) * RT_QP + db * 32 + 8 * g + 4 * h) = x; }
        }
    }
}

DI void phase_mixer_finish(Frame& F, const KA& a, int l) {
    const int lane = fresh_lane(), gw = F.bid * NWAVES + F.wave, NGW = F.G * NWAVES;
    const size_t TS = (size_t)NT * 512;
    const bf16* P = (const bf16*)(F.ws + WS_P); const bf16* OFB = (const bf16*)(F.ws + WS_OF); const bf16* YF = (const bf16*)(F.ws + WS_YF); const bf16* RW = (const bf16*)(F.ws + WS_RW);
    bf16* O0 = (bf16*)(F.ws + WS_ABR); bf16* O2 = O0 + 2 * TS;
    const float* lng = a.in(I_LNXG) + l * 512 + 8 * lane; const float* lnb = a.in(I_LNXB) + l * 512 + 8 * lane; const float* rkw = a.in(I_RK) + l * 512 + 8 * lane;
    float g_[8], b_[8], rk_[8];
    { const f32x4 x0 = *(const f32x4*)lng, x1 = *(const f32x4*)(lng + 4), y0 = *(const f32x4*)lnb, y1 = *(const f32x4*)(lnb + 4), z0 = *(const f32x4*)rkw, z1 = *(const f32x4*)(rkw + 4);
      g_[0] = x0.x; g_[1] = x0.y; g_[2] = x0.z; g_[3] = x0.w; g_[4] = x1.x; g_[5] = x1.y; g_[6] = x1.z; g_[7] = x1.w;
      b_[0] = y0.x; b_[1] = y0.y; b_[2] = y0.z; b_[3] = y0.w; b_[4] = y1.x; b_[5] = y1.y; b_[6] = y1.z; b_[7] = y1.w;
      rk_[0] = z0.x; rk_[1] = z0.y; rk_[2] = z0.z; rk_[3] = z0.w; rk_[4] = z1.x; rk_[5] = z1.y; rk_[6] = z1.z; rk_[7] = z1.w; }
#pragma unroll 1
    for (int r0 = gw; r0 < NT; r0 += 2 * NGW) {
        u32x4 uyf[2], uyb[2], ur[2], ukf[2], ukb[2], uv[2], ug[2], uof[2], uob[2], ugf[2], ugb[2]; size_t oo[2]; bool act[2];
#pragma unroll
        for (int u = 0; u < 2; ++u) { int r = r0 + u * NGW; act[u] = r < NT; if (!act[u]) r = r0; const size_t o = (size_t)r * 512 + 8 * lane; oo[u] = o;
            uyf[u] = *(const u32x4*)(YF + o); uyb[u] = *(const u32x4*)(YF + TS + o); ur[u] = *(const u32x4*)(RW + o); ukf[u] = *(const u32x4*)(RW + TS + o); ukb[u] = *(const u32x4*)(RW + 2 * TS + o);
            uv[u] = *(const u32x4*)(RW + 3 * TS + o); ug[u] = *(const u32x4*)(RW + 7 * TS + o); uof[u] = *(const u32x4*)(OFB + o); uob[u] = *(const u32x4*)(OFB + TS + o);
            ugf[u] = *(const u32x4*)(P + (size_t)r * DINP + PC_RGF + 8 * lane); ugb[u] = *(const u32x4*)(P + (size_t)r * DINP + PC_RGB + 8 * lane); }
        __builtin_amdgcn_sched_barrier(0);
#pragma unroll
        for (int u = 0; u < 2; ++u) { if (!act[u]) continue; const size_t o = oo[u];
            { float yfv[8], ybv[8], s[8]; unpack8(uyf[u], yfv); unpack8(uyb[u], ybv);
#pragma unroll
              for (int j = 0; j < 8; ++j) s[j] = yfv[j] + ybv[j];
              float rr[8], kf[8], kb[8], vv[8], gg[8]; unpack8(ur[u], rr); unpack8(ukf[u], kf); unpack8(ukb[u], kb); unpack8(uv[u], vv); unpack8(ug[u], gg);
              float sm = 0.f, bn = 0.f;
#pragma unroll
              for (int j = 0; j < 8; ++j) { sm += s[j]; bn += rr[j] * (kf[j] + kb[j]) * rk_[j]; }
              sm += sx(sm, 1); sm += sx(sm, 2); sm += sx(sm, 4); bn += sx(bn, 1); bn += sx(bn, 2); bn += sx(bn, 4);
              const float mean = sm * (1.f / 64.f); float vs = 0.f;
#pragma unroll
              for (int j = 0; j < 8; ++j) { s[j] -= mean; vs += s[j] * s[j]; }
              vs += sx(vs, 1); vs += sx(vs, 2); vs += sx(vs, 4);
              const float rstd = rsqrtf(vs * (1.f / 64.f) + 64e-5f);
              float y[8];
#pragma unroll
              for (int j = 0; j < 8; ++j) y[j] = (s[j] * rstd * g_[j] + b_[j] + bn * vv[j]) * gg[j];
              *(bf16x8*)(O2 + o) = pack8(y); }
            { float ff[8], bb[8], gf[8], gb[8]; unpack8(uof[u], ff); unpack8(uob[u], bb); unpack8(ugf[u], gf); unpack8(ugb[u], gb);
              float sf = 0.f, sb = 0.f;
#pragma unroll
              for (int j = 0; j < 8; ++j) { sf += ff[j]; sb += bb[j]; }
#pragma unroll
              for (int o2 = 1; o2 < 16; o2 <<= 1) { sf += sx(sf, o2); sb += sx(sb, o2); }
              const float mf = sf * (1.f / 128.f), mb = sb * (1.f / 128.f); float vf = 0.f, vb = 0.f;
#pragma unroll
              for (int j = 0; j < 8; ++j) { ff[j] -= mf; bb[j] -= mb; vf += ff[j] * ff[j]; vb += bb[j] * bb[j]; }
#pragma unroll
              for (int o2 = 1; o2 < 16; o2 <<= 1) { vf += sx(vf, o2); vb += sx(vb, o2); }
              const float rf = rsqrtf(vf * (1.f / 128.f) + 1e-5f), rb = rsqrtf(vb * (1.f / 128.f) + 1e-5f);
              float y[8];
#pragma unroll
              for (int j = 0; j < 8; ++j) y[j] = ff[j] * rf * (gf[j] * sigmoidf_(gf[j])) + bb[j] * rb * (gb[j] * sigmoidf_(gb[j]));
              *(bf16x8*)(O0 + o) = pack8(y); } }
    }
}

constexpr int N_PHASES = 2 + 10 * DEPTH;
__global__ void __launch_bounds__(NTHREADS, 2) fwd_kernel(Args args) {
    extern __shared__ __attribute__((aligned(16))) unsigned char lds_raw[];
    Frame F;
    F.lds = (LAS unsigned char*)lds_raw;
    F.MISC = (volatile LAS unsigned*)(F.lds + LDS_MISC_OFF);
    F.tid = threadIdx.x; F.lane = F.tid & 63; F.wave = __builtin_amdgcn_readfirstlane(F.tid >> 6);
    F.G = gridDim.x; F.bid = blockIdx.x;
    F.ws = args.ws; F.ctl = (unsigned*)(args.ws + WS_CTL);
    if (F.tid < 32) F.MISC[F.tid] = 0u;
    __syncthreads();
    const int lo = args.ph_lo, hi = args.ph_hi;
    KA ka; ka.kp = (const CAS char*)__builtin_amdgcn_kernarg_segment_ptr();
    const bool multi = (hi - lo) > 1;
    XcdBarrier bar; bar.bar = F.ctl + CW_BAR; bar.x = 0; bar.st = nullptr;
    if (multi) bar = xcd_barrier_post(F.ctl + CW_BAR, F.MISC + 8);
#define IN(k) (lo <= (k) && (k) < hi)
#define OPQ() do { int l_; asm volatile("v_mbcnt_lo_u32_b32 %0, -1, 0\n\tv_mbcnt_hi_u32_b32 %0, -1, %0" : "=v"(l_)); { int b_ = F.bid, w_ = F.wave, g_ = F.G; asm volatile("" : "+s"(b_), "+s"(w_), "+s"(g_)); F.bid = b_; F.wave = w_; F.G = g_; } F.lane = l_; F.tid = F.wave * 64 + l_; \
        const CAS char* kp_ = (const CAS char*)__builtin_amdgcn_kernarg_segment_ptr(); asm volatile("" : "+s"(kp_)); ka.kp = kp_; F.ws = ka.ws(); F.ctl = (unsigned*)(F.ws + WS_CTL); } while (0)
#define SEAM(k) do { if (IN(k) && IN((k) + 1)) xcd_barrier(bar); } while (0)

    if (IN(0)) { OPQ(); phase_prologue(F, ka); } SEAM(0);
    if (IN(1)) { OPQ(); phase_init_rows(F, ka); } SEAM(1);

    for (int l = 0; l < DEPTH; ++l) {
        const int pb = 2 + 10 * l;
        if (IN(pb + 0)) { OPQ(); unsigned char* ws = F.ws;
            SchedInproj S; S.T.init(NT / 256, DINP / 256, F.G, F.bid); S.A = (const char*)(ws + WS_H); S.B = (const char*)(ws + WS_WIN + (size_t)l * 15 * MiB);
            EpiStoreBf16 E{(bf16*)(ws + WS_P), DINP};
            pg8::gemm_phase<EpiStoreBf16, SchedInproj, false>(F.lds, 1024, S, E, F.tid);
        }
        SEAM(pb + 0);
        if (IN(pb + 1)) { OPQ(); phase_mla_prep2(F, ka, l); OPQ(); phase_rwkv_prep2(F, ka, l); }
        SEAM(pb + 1);
#define ATTN_QUEUE(qword, ubeg, uend) do { const int xq_ = F.bid & 7; for (;;) { __syncthreads(); \
            if (F.wave == 0 && fresh_lane() == 0) F.MISC[0] = (unsigned)(ubeg) + __hip_atomic_fetch_add(F.ctl + (qword) + xq_, 1u, __ATOMIC_RELAXED, __HIP_MEMORY_SCOPE_AGENT); \
            __syncthreads(); const int u = (int)F.MISC[0]; if (u >= (uend)) break; \
            if (u < 128) attn_unit(F, u >> 4, xq_, 1 + (u & 15)); else attn_unit(F, u - 128, xq_, 0); } } while (0)
        const int nunits = (l == DEPTH - 1) ? 128 : 136;
        if (IN(pb + 2)) { OPQ();
            if (F.bid < NCHAIN) rwkv_chain_block(F, F.bid);
            else if (F.bid < NCHAIN + 32) phase_retention_item(F, ka, F.bid - NCHAIN);
            OPQ(); ATTN_QUEUE(CW_Q + l * 64, 0, nunits);
        }
        SEAM(pb + 2);
        if (IN(pb + 3)) { OPQ(); phase_mixer_finish(F, ka, l); }
        SEAM(pb + 3);
        if (IN(pb + 4)) { OPQ(); unsigned char* ws = F.ws;
            SchedMerge S; S.T.init(NT / 256, 4, F.G, F.bid, l == DEPTH - 1); S.A = (const char*)(ws + WS_ABR); S.B = (const char*)(ws + WS_WBR + (size_t)l * 3 * MiB);
            EpiMerge E{(const bf16*)(ws + WS_P), (bf16*)(ws + WS_MRG)};
            pg8::gemm_phase<EpiMerge, SchedMerge, false>(F.lds, 512, S, E, F.tid);
        }
        SEAM(pb + 4);
        if (IN(pb + 5)) { OPQ(); unsigned char* ws = F.ws;
            SchedPlain S; S.T.init(NT / 256, 4, F.G, F.bid, l == DEPTH - 1); S.A = (const char*)(ws + WS_MRG); S.B = (const char*)(ws + WS_WOUT + (size_t)l * 2 * MiB); S.K = 1024;
            EpiResid E{(float*)(ws + WS_X), (const float*)(ws + WS_MOD) + (size_t)l * 9 * 6144};
            pg8::gemm_phase<EpiResid, SchedPlain, false>(F.lds, 1024, S, E, F.tid);
        }
        SEAM(pb + 5);
        if (IN(pb + 6)) { OPQ(); phase_router(F, ka, l); }
        SEAM(pb + 6);
        if (IN(pb + 7)) { OPQ(); unsigned char* ws = F.ws;
            moe_build_table(F, F.ctl + CW_CNT + l * 32 * 16);
            SchedMoe S{(const LAS int*)(F.lds + LDS_TAB_OFF), (const char*)(ws + WS_H), (const char*)(ws + WS_WGU + (size_t)l * 128 * MiB), (const int*)(ws + WS_LIST), 8, F.bid, F.G, 0, (size_t)2048 * 1024 * 2, true};
            EpiSwiglu E{(bf16*)(ws + WS_ACT), ka.in(I_BGU) + (size_t)l * 32 * 2048};
            pg8::gemm_phase<EpiSwiglu, SchedMoe, true>(F.lds, 1024, S, E, F.tid);
        }
        SEAM(pb + 7);
        if (IN(pb + 8)) { OPQ(); unsigned char* ws = F.ws;
            moe_build_table(F, F.ctl + CW_CNT + l * 32 * 16);
            SchedMoe S{(const LAS int*)(F.lds + LDS_TAB_OFF), (const char*)(ws + WS_ACT), (const char*)(ws + WS_WDN + (size_t)l * 64 * MiB), (const int*)(ws + WS_LIST), 4, F.bid, F.G, 0, (size_t)1024 * 1024 * 2, false};
            EpiDown E{(bf16*)(ws + WS_Y), ka.in(I_BDOWN) + (size_t)l * 32 * 1024};
            pg8::gemm_phase<EpiDown, SchedMoe, false>(F.lds, 1024, S, E, F.tid);
        }
        SEAM(pb + 8);
        if (IN(pb + 9)) { OPQ(); phase_combine(F, ka, l); }
        SEAM(pb + 9);

    }
#undef IN
#undef SEAM
}

extern "C" void kernel_launch(void* const* d_in, const int* in_sizes, int n_in, void* d_out, int out_size, void* d_ws, size_t ws_size, hipStream_t stream) {
    static int grid = 0;
    if (grid == 0) {
        if (n_in != N_IN || ws_size < WS_END) { fprintf(stderr, "kernel_launch: unexpected n_in %d or ws_size %zu (need %zu)\n", n_in, ws_size, (size_t)WS_END); grid = -1; return; }
        int dev = 0, cus = 0, per_cu = 0;
        hipGetDevice(&dev); hipDeviceGetAttribute(&cus, hipDeviceAttributeMultiprocessorCount, dev);
        if (hipFuncSetAttribute((const void*)fwd_kernel, hipFuncAttributeMaxDynamicSharedMemorySize, LDS_BYTES) != hipSuccess) { fprintf(stderr, "kernel_launch: hipFuncSetAttribute failed\n"); grid = -1; return; }
        if (hipOccupancyMaxActiveBlocksPerMultiprocessor(&per_cu, (const void*)fwd_kernel, NTHREADS, LDS_BYTES) != hipSuccess || per_cu < 1) { fprintf(stderr, "kernel_launch: occupancy query says %d\n", per_cu); }
        (void)hipGetLastError();
        grid = cus > 0 ? cus : 256;
        if (grid > 256) grid = 256;
    }
    if (grid < 0) return;
    (void)in_sizes; (void)out_size;
    hipMemsetAsync((char*)d_ws + WS_CTL, 0, CTL_ZERO_BYTES, stream);
    Args a{};
    for (int i = 0; i < N_IN; ++i) a.in[i] = (const float*)d_in[i];
    a.out = (float*)d_out; a.ws = (unsigned char*)d_ws;
#if MK_ONE_LAUNCH
    a.ph_lo = 0; a.ph_hi = N_PHASES;
    hipLaunchKernelGGL(fwd_kernel, dim3(grid), dim3(NTHREADS), LDS_BYTES, stream, a);
#else
    for (int ph = 0; ph < N_PHASES; ++ph) { a.ph_lo = ph; a.ph_hi = ph + 1; hipLaunchKernelGGL(fwd_kernel, dim3(grid), dim3(NTHREADS), LDS_BYTES, stream, a); }
#endif
    hipError_t le = hipGetLastError();
    if (le != hipSuccess) fprintf(stderr, "kernel_launch: launch failed: %s\n", hipGetErrorName(le));
}
```

```cpp
#include <hip/hip_runtime.h>
#include <cstdio>
#include <cstdint>

#ifndef MK_ONE_LAUNCH
#define MK_ONE_LAUNCH 1
#endif

#define GAS __attribute__((address_space(1)))
#define LAS __attribute__((address_space(3)))
typedef unsigned short bf16;
typedef short bf16x8 __attribute__((ext_vector_type(8)));
typedef float f32x2 __attribute__((ext_vector_type(2)));
typedef float f32x4 __attribute__((ext_vector_type(4)));
typedef float f32x16 __attribute__((ext_vector_type(16)));
typedef unsigned u32x2 __attribute__((ext_vector_type(2)));
typedef unsigned u32x4 __attribute__((ext_vector_type(4)));
typedef __bf16 bf16v2 __attribute__((ext_vector_type(2)));
#define DI __device__ __forceinline__

constexpr int D = 1024, BATCH = 8, SEQ = 4096, CTX = 256, LTOT = SEQ + CTX  , NT = BATCH * LTOT  , DEPTH = 4;
constexpr int DIN = 7456, DINP = 7680;
constexpr int NEXP = 32, TOPK = 4, DEXP = 1024;
constexpr int NSLOT = NT * TOPK + NEXP * 256;
constexpr int PC_RQ = 0, PC_RK = 256, PC_RV = 512, PC_RGF = 1024, PC_RGB = 1536, PC_MQ = 2048, PC_MKV = 2304, PC_MPE = 2432,
              PC_RW = 2464, PC_WR = 2464, PC_WK = 2976, PC_WV = 3488, PC_WHF = 4000, PC_WHB = 4064, PC_AHF = 4128, PC_AHB = 4192, PC_GH = 4256, PC_GATE = 4384;
enum { I_X = 0, I_C, I_CTX, I_CCTX, I_ADAW, I_ADAB, I_N1G, I_N2G, I_WIN, I_MQNG, I_WUQ, I_MKVNG, I_WUKV, I_QKQG, I_QKKG, I_MUP, I_MUN, I_W0, I_W2, I_A0, I_A2, I_G2,
       I_KK, I_KA, I_RK, I_LNXG, I_LNXB, I_BRRET, I_BRMLA, I_BRRWKV, I_WOUT, I_WROUTER, I_BROUTER, I_WGU, I_BGU, I_WDOWN, I_BDOWN, N_IN };

constexpr size_t MiB = 1u << 20;
constexpr size_t WS_CTL = 0, CTL_ZERO_BYTES = 1 * MiB;
constexpr size_t WS_MOD = 1 * MiB;
constexpr size_t WS_ROPE = 2 * MiB;
constexpr size_t WS_ROPE_AX = 3 * MiB;
constexpr size_t WS_SMALLW = 4 * MiB;
constexpr size_t SW_UQ = 0, SW_UKV = 393216, SW_W2 = 655360, SW_A2 = 786432, SW_G2 = 917504;
constexpr size_t WS_WBR = 8 * MiB;
constexpr size_t WS_WOUT = 20 * MiB;
constexpr size_t WS_WIN = 28 * MiB;
constexpr size_t WS_WGU = 88 * MiB;
constexpr size_t WS_WDN = 600 * MiB;
constexpr size_t WS_X = 856 * MiB;
constexpr size_t WS_H = 992 * MiB;
constexpr size_t WS_P = 1062 * MiB;
constexpr size_t WS_QB = 1572 * MiB;
constexpr size_t WS_KB = 1623 * MiB;
constexpr size_t WS_VT = 1674 * MiB;
constexpr size_t WS_RW = 1708 * MiB;
constexpr size_t RW_STRIDE = (size_t)NT * 512 * 2;
constexpr size_t WS_LW = 1980 * MiB;
constexpr size_t WS_YF = 2116 * MiB;
constexpr size_t WS_OF = 2252 * MiB;
constexpr size_t WS_ABR = 2388 * MiB;
constexpr size_t WS_MRG = 2490 * MiB;
constexpr size_t WS_TOPK = 2558 * MiB;
constexpr size_t WS_LIST = 2560 * MiB;
constexpr size_t WS_ACT = 2565 * MiB;
constexpr size_t WS_Y = 2853 * MiB;
constexpr size_t WS_END = 3141 * MiB;
constexpr int CW_TMO = 0, CW_BAR = 4096, CW_CNT = 8192  , CW_Q = 12288  ;

DI unsigned pk2(float lo, float hi) { f32x2 v = {lo, hi}; bf16v2 r = __builtin_convertvector(v, bf16v2); return __builtin_bit_cast(unsigned, r); }
DI bf16 f2bf(float f) { return (bf16)(pk2(f, 0.f) & 0xffffu); }
DI float bf2f(unsigned short b) { return __uint_as_float(((unsigned)b) << 16); }
DI float bflo(unsigned w) { return __uint_as_float(w << 16); }
DI float bfhi(unsigned w) { return __uint_as_float(w & 0xffff0000u); }
DI int fresh_lane() { int l_; asm volatile("v_mbcnt_lo_u32_b32 %0, -1, 0\n\tv_mbcnt_hi_u32_b32 %0, -1, %0" : "=v"(l_)); return l_; }
DI bf16x8 pack8(const float* v) { u32x4 x; x.x = pk2(v[0], v[1]); x.y = pk2(v[2], v[3]); x.z = pk2(v[4], v[5]); x.w = pk2(v[6], v[7]); return __builtin_bit_cast(bf16x8, x); }
DI float sx(float v, int mask) { const int l = fresh_lane(); return __int_as_float(__builtin_amdgcn_ds_bpermute((l ^ mask) << 2, __float_as_int(v))); }
DI float sup(float v, int d) { const int l = fresh_lane(); return __int_as_float(__builtin_amdgcn_ds_bpermute((l - d) << 2, __float_as_int(v))); }
DI float dpp_scan64(float x) {
    float t;
    t = __int_as_float(__builtin_amdgcn_update_dpp(0, __float_as_int(x), 0x111, 0xf, 0xf, false)); x += t;
    t = __int_as_float(__builtin_amdgcn_update_dpp(0, __float_as_int(x), 0x112, 0xf, 0xf, false)); x += t;
    t = __int_as_float(__builtin_amdgcn_update_dpp(0, __float_as_int(x), 0x114, 0xf, 0xf, false)); x += t;
    t = __int_as_float(__builtin_amdgcn_update_dpp(0, __float_as_int(x), 0x118, 0xf, 0xf, false)); x += t;
    t = __int_as_float(__builtin_amdgcn_update_dpp(0, __float_as_int(x), 0x142, 0xa, 0xf, false)); x += t;
    t = __int_as_float(__builtin_amdgcn_update_dpp(0, __float_as_int(x), 0x143, 0xc, 0xf, false)); x += t;
    return x;
}
DI float wave_sum(float v) {
#pragma unroll
    for (int o = 1; o < 64; o <<= 1) v += sx(v, o);
    return v;
}
DI void unpack8(const u32x4& w, float* o) { o[0] = bflo(w.x); o[1] = bfhi(w.x); o[2] = bflo(w.y); o[3] = bfhi(w.y); o[4] = bflo(w.z); o[5] = bfhi(w.z); o[6] = bflo(w.w); o[7] = bfhi(w.w); }
DI f32x16 zero16() { f32x16 z; for (int i = 0; i < 16; ++i) z[i] = 0.f; return z; }
DI float sigmoidf_(float x) { return __builtin_amdgcn_rcpf(1.f + __expf(-x)); }
#define LDS_WAIT() asm volatile("s_waitcnt lgkmcnt(0)" ::: "memory")
#define VM_WAIT() asm volatile("s_waitcnt vmcnt(0)" ::: "memory")
#define LDS_BARRIER() do { asm volatile("s_waitcnt lgkmcnt(0)" ::: "memory"); __builtin_amdgcn_s_barrier(); asm volatile("" ::: "memory"); } while (0)

#define XB_TMO      128
#define XB_XCNT(j)  (256  + 64 * (j))
#define XB_XSUB(j)  (1280 + 64 * (j))
#define XB_XGEN(j)  (2304 + 64 * (j))
#define XB_TOP      3328
#define XB_TOPGEN   3392
#define XCD_BAR_WORDS 3456
#define XB_SPIN_CAP (1u << 22)

__device__ __forceinline__ unsigned xb_ld(unsigned* p)              { return __hip_atomic_load(p, __ATOMIC_RELAXED, __HIP_MEMORY_SCOPE_AGENT); }
__device__ __forceinline__ unsigned xb_add(unsigned* p, unsigned v) { return __hip_atomic_fetch_add(p, v, __ATOMIC_RELAXED, __HIP_MEMORY_SCOPE_AGENT); }
__device__ __forceinline__ unsigned xb_xcc_id() { return (unsigned)__builtin_amdgcn_s_getreg((3 << 11) | 20) & 0xFu; }
#define XB_SPIN(cond, bar) do { unsigned _sp = 0; while (cond) { __builtin_amdgcn_s_sleep(1); \
    if ((++_sp & 255u) == 0u) { if (xb_ld(&(bar)[XB_TMO])) break; if (_sp > XB_SPIN_CAP) { atomicAdd(&(bar)[XB_TMO], 1u); break; } } } } while (0)

struct XcdBarrier { unsigned* bar; unsigned x; volatile LAS unsigned* st; };

__device__ __forceinline__ XcdBarrier xcd_barrier_post(unsigned* bar, volatile LAS unsigned* st) {
    XcdBarrier b; b.bar = bar; b.x = xb_xcc_id(); b.st = st;
    if (threadIdx.x == 0) (void)xb_add(&bar[XB_XCNT(b.x)], 1u);
    return b;
}
__device__ __forceinline__ void xcd_barrier_complete(unsigned* bar, unsigned x, unsigned& nloc, unsigned& nx) {
    const unsigned G = gridDim.x * gridDim.y * gridDim.z;
    unsigned sum, cnt, mine, sp = 0u;
    for (;;) {
        sum = 0u; cnt = 0u; mine = 0u;
#pragma unroll
        for (unsigned j = 0; j < 16; ++j) { const unsigned c = xb_ld(&bar[XB_XCNT(j)]); sum += c; cnt += (c > 0u) ? 1u : 0u; mine = (j == x) ? c : mine; }
        if (sum == G) break;
        __builtin_amdgcn_s_sleep(1);
        if ((++sp & 255u) == 0u) { if (xb_ld(&bar[XB_TMO])) break; if (sp > XB_SPIN_CAP) { atomicAdd(&bar[XB_TMO], 1u); break; } }
    }
    nloc = mine > 0u ? mine : 1u; nx = cnt > 0u ? cnt : 1u;
}
__device__ __forceinline__ void xcd_barrier(const XcdBarrier& b) {
    asm volatile("s_waitcnt vmcnt(0)" ::: "memory");
    __syncthreads();
    if (threadIdx.x == 0) {
        unsigned* bar = b.bar;
        __builtin_amdgcn_s_waitcnt(0);
        unsigned nloc = b.st[0], nx = b.st[1];
        if (nloc == 0u) { xcd_barrier_complete(bar, b.x, nloc, nx); b.st[0] = nloc; b.st[1] = nx; }
        const unsigned old = xb_add(&bar[XB_XSUB(b.x)], 1u);
        const unsigned gen = old / nloc;
        if (old + 1u == (gen + 1u) * nloc) {
            __builtin_amdgcn_fence(__ATOMIC_RELEASE, "agent");
            asm volatile("s_waitcnt vmcnt(0)" ::: "memory");
            const unsigned og = xb_add(&bar[XB_TOP], 1u);
            const unsigned tg = og / nx;
            if (og + 1u == (tg + 1u) * nx) xb_add(&bar[XB_TOPGEN], 1u);
            else XB_SPIN(xb_ld(&bar[XB_TOPGEN]) == tg, bar);
            __builtin_amdgcn_fence(__ATOMIC_ACQUIRE, "agent");
            xb_add(&bar[XB_XGEN(b.x)], 1u);
            asm volatile("s_waitcnt vmcnt(0)" ::: "memory");
        } else {
            XB_SPIN(xb_ld(&bar[XB_XGEN(b.x)]) == gen, bar);
            __builtin_amdgcn_fence(__ATOMIC_ACQUIRE, "agent");
            asm volatile("s_waitcnt vmcnt(0)" ::: "memory");
        }
    }
    __syncthreads();
}

namespace pg8 {
constexpr int BM = 256, BK = 64, HALF = 128, HTB = HALF * BK * 2, STAGE_BYTES = 8 * HTB;
__host__ __device__ __forceinline__ int lds_byte(int r, int c) { const int st = (r >> 4) * 2 + (c >> 5), rr = r & 15, cc = c & 31, ob = rr * 64 + cc * 2; return st * 1024 + (ob ^ (((ob >> 9) & 1) << 5)); }
__host__ __device__ __forceinline__ void stage_rc(int b, int& R, int& C) { const int st = b / 1024, sb = b % 1024, swz = sb ^ (((sb >> 9) & 1) << 5); R = (st >> 1) * 16 + swz / 64; C = (st & 1) * 32 + (swz % 64) / 2; }
__host__ __device__ __forceinline__ int perm32(int rho) { const int n = rho >> 4, i = rho & 15; return 8 * (i >> 2) + 4 * n + (i & 3); }

struct Unit { const char* pa; const char* pb; int x, y, z; };

struct TileOrder {
    int nM, nN, nwg, G, c; bool skipctx;
    DI void init(int nM_, int nN_, int G_, int c_, bool skipctx_ = false) { skipctx = skipctx_; nM = skipctx_ ? nM_ - BATCH : nM_; nN = nN_; nwg = nM * nN; G = G_; c = c_; }
    DI bool tile(int i, int& pm, int& pn) const {
        const long L = (long)i * G + c; if (L >= nwg) return false;
        int wgid = (int)L; { const int q = nwg / 8, r = nwg % 8, xcd = wgid % 8, off = wgid / 8; wgid = (xcd < r ? xcd * (q + 1) : r * (q + 1) + (xcd - r) * q) + off; }
        const int nig = 8 * nN, gid = wgid / nig, fm = gid * 8, gsz = (nM - fm) < 8 ? (nM - fm) : 8;
        pm = fm + ((wgid % nig) % gsz); pn = (wgid % nig) / gsz; if (skipctx) pm = pm + pm / 16 + 1; return true;
    }
};

DI unsigned cvt_pk_bf16(float lo, float hi) { return pk2(lo, hi); }

template <class Epi, class Sched, bool GATHER>
__device__ __forceinline__ void gemm_phase(LAS unsigned char* lds, const int K, const Sched& S, const Epi& E, const int tid) {
    const int wid = __builtin_amdgcn_readfirstlane(tid >> 6), lane = tid & 63, wr = wid >> 2, wc = wid & 3, fr = lane & 15, fq = lane >> 4;
    const int nt = K / BK;
    unsigned voffA[2], voffB[2]; int stR[2];
#pragma unroll
    for (int i = 0; i < 2; ++i) { int R, C; stage_rc(tid * 16 + i * 8192, R, C); const int Rb = Epi::PERM ? ((R & ~31) + perm32(R & 31)) : R;
        voffA[i] = GATHER ? (unsigned)(C * 2) : (unsigned)(R * K + C) * 2u; voffB[i] = (unsigned)(Rb * K + C) * 2u; stR[i] = R; }
    const size_t kstep = (size_t)(BK * 2);
    const size_t hstep = (size_t)HALF * K * 2;
    const unsigned ldsw = (unsigned)wid * 1024u;
    const int aoff = lds_byte(wr * 64 + fr, fq * 8), boff = lds_byte(wc * 32 + fr, fq * 8);
#define PG8_SA(b, h) (((b) * 2 + (h)) * HTB)
#define PG8_SB(b, h) ((4 + (b) * 2 + (h)) * HTB)
#define PG8_STAGE(bufoff, gbase, voff) do { _Pragma("unroll") for (int _i = 0; _i < 2; ++_i) \
        __builtin_amdgcn_global_load_lds((const unsigned*)((const char*)(gbase) + (voff)[_i]), (LAS unsigned*)(lds + (bufoff) + ldsw + _i * 8192), 16, 0, 0); } while (0)
#define PG8_STAGE_A(bufoff, gbase, h, rw) do { if constexpr (GATHER) { _Pragma("unroll") for (int _i = 0; _i < 2; ++_i) { \
            const unsigned _row = ((rw)[h] >> (16 * _i)) & 0xffffu; \
            __builtin_amdgcn_global_load_lds((const unsigned*)((const char*)(gbase) + (size_t)_row * (size_t)(K * 2) + voffA[_i]), (LAS unsigned*)(lds + (bufoff) + ldsw + _i * 8192), 16, 0, 0); } } \
        else { PG8_STAGE(bufoff, (const char*)(gbase) + (h) * hstep, voffA); } } while (0)
#define PG8_LDA(dst, b, h) do { _Pragma("unroll") for (int m = 0; m < 4; ++m) _Pragma("unroll") for (int k = 0; k < 2; ++k) dst[m][k] = *(const LAS bf16x8*)(lds + PG8_SA(b, h) + aoff + m * 2048 + k * 1024); } while (0)
#define PG8_LDB(dst, b, h) do { _Pragma("unroll") for (int n = 0; n < 2; ++n) _Pragma("unroll") for (int k = 0; k < 2; ++k) dst[n][k] = *(const LAS bf16x8*)(lds + PG8_SB(b, h) + boff + n * 2048 + k * 1024); } while (0)
#define PG8_MMA(ai, bj, At, Bt) do { __builtin_amdgcn_s_setprio(1); _Pragma("unroll") for (int m = 0; m < 4; ++m) _Pragma("unroll") for (int n = 0; n < 2; ++n) _Pragma("unroll") for (int k = 0; k < 2; ++k) \
        acc[ai][bj][m][n] = __builtin_amdgcn_mfma_f32_16x16x32_bf16(Bt[n][k], At[m][k], acc[ai][bj][m][n], 0, 0, 0); __builtin_amdgcn_s_setprio(0); } while (0)
#define PG8_WAIT_V(n) asm volatile("s_waitcnt vmcnt(" #n ")" ::: "memory")
#define PG8_WAIT_L(n) asm volatile("s_waitcnt lgkmcnt(" #n ")" ::: "memory")
#define PG8_BAR __builtin_amdgcn_s_barrier()
#define PG8_SCHED __builtin_amdgcn_sched_barrier(0)
    Unit cur, nxt; int ui = 0;
    if (!S.next(0, cur)) return;
    f32x4 acc[2][2][4][2];
#pragma unroll
    for (int a = 0; a < 2; ++a)
#pragma unroll
        for (int b = 0; b < 2; ++b)
#pragma unroll
            for (int m = 0; m < 4; ++m)
#pragma unroll
                for (int n = 0; n < 2; ++n) acc[a][b][m][n] = (f32x4){0.f, 0.f, 0.f, 0.f};
    bf16x8 At[4][2], B0[2][2], B1[2][2];
    const char* cA = cur.pa; const char* cB = cur.pb;
    unsigned rwc[2] = {0u, 0u}, rwn[2] = {0u, 0u};
    if constexpr (GATHER) S.rows(cur, stR[0], stR[1], rwc);
    PG8_STAGE(PG8_SB(0, 0), cB, voffB); PG8_STAGE(PG8_SB(0, 1), cB + hstep, voffB); PG8_STAGE_A(PG8_SA(0, 0), cA, 0, rwc); PG8_STAGE_A(PG8_SA(0, 1), cA, 1, rwc);
    if (wr == 1) PG8_BAR;
    PG8_WAIT_V(2); PG8_BAR;
    PG8_STAGE(PG8_SB(1, 0), cB + kstep, voffB); PG8_STAGE_A(PG8_SA(1, 0), cA + kstep, 0, rwc); PG8_STAGE(PG8_SB(1, 1), cB + hstep + kstep, voffB);
    PG8_WAIT_V(6); PG8_BAR;
    for (;;) {
        const bool has_next = S.next(ui + 1, nxt);
        const char* nA = has_next ? nxt.pa : cA; const char* nB = has_next ? nxt.pb : cB;
        if constexpr (GATHER) { if (has_next) S.rows(nxt, stR[0], stR[1], rwn); else { rwn[0] = rwc[0]; rwn[1] = rwc[1]; } }
        for (int t = 0; t < nt; t += 2) {
            const bool last = (t == nt - 2);
            const char* a1 = cA + (size_t)(t + 1) * kstep;
            const char* a2 = last ? nA : cA + (size_t)(t + 2) * kstep; const char* b2 = last ? nB : cB + (size_t)(t + 2) * kstep;
            const char* a3 = a2 + kstep; const char* b3 = b2 + kstep;
            unsigned rw2[2]; rw2[0] = last ? rwn[0] : rwc[0]; rw2[1] = last ? rwn[1] : rwc[1];
            PG8_LDB(B0, 0, 0); PG8_LDB(B1, 0, 1); PG8_SCHED; PG8_LDA(At, 0, 0); PG8_STAGE_A(PG8_SA(1, 1), a1, 1, rwc);
            PG8_WAIT_V(8); PG8_WAIT_L(0); PG8_BAR; PG8_MMA(0, 0, At, B0); PG8_MMA(0, 1, At, B1); PG8_BAR; PG8_SCHED;
            PG8_LDA(At, 0, 1); PG8_STAGE(PG8_SB(0, 0), b2, voffB); PG8_STAGE(PG8_SB(0, 1), b2 + hstep, voffB); PG8_STAGE_A(PG8_SA(0, 0), a2, 0, rw2);
            PG8_WAIT_V(8); PG8_WAIT_L(0); PG8_BAR; PG8_MMA(1, 0, At, B0); PG8_MMA(1, 1, At, B1); PG8_BAR; PG8_SCHED;
            PG8_LDB(B0, 1, 0); PG8_LDB(B1, 1, 1); PG8_SCHED; PG8_LDA(At, 1, 0); PG8_STAGE_A(PG8_SA(0, 1), a2, 1, rw2);
            PG8_WAIT_V(8); PG8_WAIT_L(0); PG8_BAR; PG8_MMA(0, 0, At, B0); PG8_MMA(0, 1, At, B1); PG8_BAR; PG8_SCHED;
            PG8_LDA(At, 1, 1); PG8_STAGE(PG8_SB(1, 0), b3, voffB); PG8_STAGE(PG8_SB(1, 1), b3 + hstep, voffB); PG8_STAGE_A(PG8_SA(1, 0), a3, 0, rw2);
            PG8_WAIT_V(8); PG8_WAIT_L(0); PG8_BAR; PG8_MMA(1, 0, At, B0); PG8_MMA(1, 1, At, B1); PG8_BAR; PG8_SCHED;
        }
        if (wr == 0) PG8_BAR;
        { int l2_; asm volatile("v_mbcnt_lo_u32_b32 %0, -1, 0\n\tv_mbcnt_hi_u32_b32 %0, -1, %0" : "=v"(l2_));
          E(acc, cur, wr, wc, l2_ & 15, l2_ >> 4); }
        if (!has_next) break;
        cur = nxt; cA = nA; cB = nB; ++ui;
        if constexpr (GATHER) { rwc[0] = rwn[0]; rwc[1] = rwn[1]; }
        if (wr == 1) PG8_BAR;
    }
    PG8_WAIT_V(0);
    PG8_BAR;
#undef PG8_SA
#undef PG8_SB
#undef PG8_STAGE
#undef PG8_STAGE_A
#undef PG8_LDA
#undef PG8_LDB
#undef PG8_MMA
#undef PG8_WAIT_V
#undef PG8_WAIT_L
#undef PG8_BAR
#undef PG8_SCHED
}
#define ACC_ZERO(acc) do { _Pragma("unroll") for (int a_ = 0; a_ < 2; ++a_) _Pragma("unroll") for (int b_ = 0; b_ < 2; ++b_) _Pragma("unroll") for (int m_ = 0; m_ < 4; ++m_) _Pragma("unroll") for (int n_ = 0; n_ < 2; ++n_) \
        acc[a_][b_][m_][n_] = (f32x4){0.f, 0.f, 0.f, 0.f}; } while (0)
}

constexpr int NWAVES = 8, NTHREADS = 512;
constexpr int RING_BYTES = 131072;
constexpr int LDS_TAB_OFF = RING_BYTES;
constexpr int LDS_MISC_OFF = RING_BYTES + 8192;
constexpr int LDS_BYTES = 147456;

struct Args { const float* in[N_IN]; float* out; unsigned char* ws; int ph_lo, ph_hi; };

#define CAS __attribute__((address_space(4)))
struct KA { const CAS char* kp;
    DI const float* in(int i) const { return *(const float* const CAS*)(kp + 8 * i); }
    DI float* out() const { return *(float* const CAS*)(kp + 8 * N_IN); }
    DI unsigned char* ws() const { return *(unsigned char* const CAS*)(kp + 8 * N_IN + 8); } };
struct Frame {
    LAS unsigned char* lds;
    volatile LAS unsigned* MISC;
    unsigned* ctl;
    unsigned char* ws;
    int tid, lane, wave, G, bid;
};

DI int row_modrow(int r) { const int b = r / LTOT, p = r - b * LTOT; return p < CTX ? 8 : b; }

struct SchedInproj {
    pg8::TileOrder T; const char* A; const char* B;
    DI bool next(int i, pg8::Unit& u) const { int pm, pn; if (!T.tile(i, pm, pn)) return false; u.pa = A + (size_t)pm * (256 * 1024 * 2); u.pb = B + (size_t)pn * (256 * 1024 * 2); u.x = pm; u.y = pn; u.z = 0; return true; }
};
struct EpiStoreBf16 {
    static constexpr bool PERM = true;
    bf16* O; int ldc;
    DI void operator()(f32x4 (&acc)[2][2][4][2], const pg8::Unit& u, int wr, int wc, int fr, int fq) const {
        const int row0 = u.x * 256 + wr * 64 + fr, col0 = u.y * 256 + wc * 32 + 8 * fq;
#pragma unroll
        for (int ai = 0; ai < 2; ++ai)
#pragma unroll
            for (int m = 0; m < 4; ++m) { bf16* rowp = O + (size_t)(row0 + ai * 128 + m * 16) * ldc + col0;
#pragma unroll
                for (int bj = 0; bj < 2; ++bj) { const f32x4 v0 = acc[ai][bj][m][0], v1 = acc[ai][bj][m][1];
                    u32x4 w; w.x = pk2(v0[0], v0[1]); w.y = pk2(v0[2], v0[3]); w.z = pk2(v1[0], v1[1]); w.w = pk2(v1[2], v1[3]);
                    *(u32x4*)(rowp + bj * 128) = w; } }
        ACC_ZERO(acc);
    }
};
struct SchedMerge {
    pg8::TileOrder T; const char* A; const char* B;
    DI bool next(int i, pg8::Unit& u) const { const int ti = i / 3, br = i - ti * 3; int pm, pn; if (!T.tile(ti, pm, pn)) return false;
        u.pa = A + (size_t)br * ((size_t)NT * 512 * 2) + (size_t)pm * (256 * 512 * 2); u.pb = B + (size_t)br * (1024 * 512 * 2) + (size_t)pn * (256 * 512 * 2); u.x = pm; u.y = pn; u.z = br; return true; }
};
struct EpiMerge {
    static constexpr bool PERM = true;
    const bf16* P; bf16* O;
    static DI float en(float x) { return __builtin_amdgcn_exp2f(fminf(x * -1.4426950408889634f, 43.28f)); }
    DI void operator()(f32x4 (&acc)[2][2][4][2], const pg8::Unit& u, int wr, int wc, int fr, int fq) const {
        const int row0 = u.x * 256 + wr * 64 + fr, col0 = u.y * 256 + wc * 32 + 8 * fq, br = u.z;
#pragma unroll
        for (int ai = 0; ai < 2; ++ai) {
            u32x4 gc[4][2], gn[4][2];
#pragma unroll
            for (int m = 0; m < 4; ++m)
#pragma unroll
                for (int bj = 0; bj < 2; ++bj) { const bf16* gp = P + (size_t)(row0 + ai * 128 + m * 16) * DINP + PC_GATE + br * 1024 + col0 + bj * 128;
                    gc[m][bj] = *(const u32x4*)gp; gn[m][bj] = br < 2 ? *(const u32x4*)(gp + 1024) : (u32x4){0u, 0u, 0u, 0u}; }
            __builtin_amdgcn_sched_barrier(0);
#pragma unroll
            for (int m = 0; m < 4; ++m) { const size_t row = (size_t)(row0 + ai * 128 + m * 16);
#pragma unroll
                for (int bj = 0; bj < 2; ++bj) {
                    float lc[8], f[8]; unpack8(gc[m][bj], lc);
                    if (br < 2) { float ln[8]; unpack8(gn[m][bj], ln);
#pragma unroll
                        for (int j = 0; j < 8; ++j) f[j] = (1.f + en(ln[j])) * __builtin_amdgcn_rcpf(1.f + en(lc[j]));
                    } else {
#pragma unroll
                        for (int j = 0; j < 8; ++j) f[j] = __builtin_amdgcn_rcpf(1.f + en(lc[j]));
                    }
                    f32x4 v0 = acc[ai][bj][m][0], v1 = acc[ai][bj][m][1];
                    v0[0] *= f[0]; v0[1] *= f[1]; v0[2] *= f[2]; v0[3] *= f[3]; v1[0] *= f[4]; v1[1] *= f[5]; v1[2] *= f[6]; v1[3] *= f[7];
                    if (br == 2) { u32x4 w; w.x = pk2(v0[0], v0[1]); w.y = pk2(v0[2], v0[3]); w.z = pk2(v1[0], v1[1]); w.w = pk2(v1[2], v1[3]);
                        *(u32x4*)(O + row * 1024 + col0 + bj * 128) = w; v0 = (f32x4){0.f, 0.f, 0.f, 0.f}; v1 = v0; }
                    acc[ai][bj][m][0] = v0; acc[ai][bj][m][1] = v1; } }
            __builtin_amdgcn_sched_barrier(0); }
    }
};
struct SchedPlain {
    pg8::TileOrder T; const char* A; const char* B; int K;
    DI bool next(int i, pg8::Unit& u) const { int pm, pn; if (!T.tile(i, pm, pn)) return false; u.pa = A + (size_t)pm * ((size_t)256 * K * 2); u.pb = B + (size_t)pn * ((size_t)256 * K * 2); u.x = pm; u.y = pn; u.z = 0; return true; }
};
struct EpiResid {
    static constexpr bool PERM = false;
    float* X; const float* mod;
    DI void operator()(f32x4 (&acc)[2][2][4][2], const pg8::Unit& u, int wr, int wc, int fr, int fq) const {
        const int row0 = u.x * 256 + wr * 64 + fr, col0 = u.y * 256 + wc * 32 + 4 * fq;
        const float* g1 = mod + (size_t)row_modrow(u.x * 256) * 6144 + 2048 + col0;
        f32x4 gv[2][2];
#pragma unroll
        for (int bj = 0; bj < 2; ++bj)
#pragma unroll
            for (int n = 0; n < 2; ++n) gv[bj][n] = *(const f32x4*)(g1 + bj * 128 + n * 16);
#pragma unroll
        for (int ai = 0; ai < 2; ++ai) {
            f32x4 xv[4][2][2];
#pragma unroll
            for (int m = 0; m < 4; ++m)
#pragma unroll
                for (int bj = 0; bj < 2; ++bj)
#pragma unroll
                    for (int n = 0; n < 2; ++n) xv[m][bj][n] = *(const f32x4*)(X + (size_t)(row0 + ai * 128 + m * 16) * 1024 + col0 + bj * 128 + n * 16);
            __builtin_amdgcn_sched_barrier(0);
#pragma unroll
            for (int m = 0; m < 4; ++m)
#pragma unroll
                for (int bj = 0; bj < 2; ++bj)
#pragma unroll
                    for (int n = 0; n < 2; ++n) *(f32x4*)(X + (size_t)(row0 + ai * 128 + m * 16) * 1024 + col0 + bj * 128 + n * 16) = xv[m][bj][n] + gv[bj][n] * acc[ai][bj][m][n];
            __builtin_amdgcn_sched_barrier(0); }
        ACC_ZERO(acc);
    }
};
struct SchedMoe {
    const LAS int* tab; const char* A; const char* B; const int* list; int nN, c, G; size_t a_tile_bytes, b_exp_bytes; bool gather;
    DI bool next(int i, pg8::Unit& u) const {
        const int T = tab[96], Tq = (T + 7) >> 3, xcd = c & 7, q = i * (G >> 3) + (c >> 3), tl = q / nN, pn = q - tl * nN, t = xcd * Tq + tl;
        if (tl >= Tq || t >= T) return false;
        const int e = tab[128 + t], j = t - tab[64 + e], slot0 = tab[32 + e] + 256 * j;
        u.pa = gather ? A : A + (size_t)slot0 * 2048; u.pb = B + (size_t)e * b_exp_bytes + (size_t)pn * (256 * 1024 * 2); u.x = slot0; u.y = pn; u.z = e | (j << 8); return true;
    }
    DI void rows(const pg8::Unit& u, int R0, int R1, unsigned (&rw)[2]) const {
        const int e = u.z & 255, j = u.z >> 8, cnt = tab[e]; const int* le = list + (size_t)e * NT;
#pragma unroll
        for (int h = 0; h < 2; ++h) { const int i0 = j * 256 + h * 128 + R0, i1 = j * 256 + h * 128 + R1;
            const unsigned r0 = i0 < cnt ? (unsigned)(le[i0] >> 2) : (unsigned)NT, r1 = i1 < cnt ? (unsigned)(le[i1] >> 2) : (unsigned)NT; rw[h] = r0 | (r1 << 16); }
    }
};
struct EpiSwiglu {
    static constexpr bool PERM = true;
    bf16* ACT; const float* bgu;
    DI void operator()(f32x4 (&acc)[2][2][4][2], const pg8::Unit& u, int wr, int wc, int fr, int fq) const {
        const int row0 = u.x + wr * 64 + fr, ch0 = u.y * 128 + wc * 32 + 8 * fq, e = u.z & 255;
        const float* bg = bgu + (size_t)e * 2048 + ch0;
        const f32x4 bg0 = *(const f32x4*)bg, bg1 = *(const f32x4*)(bg + 4), bu0 = *(const f32x4*)(bg + 1024), bu1 = *(const f32x4*)(bg + 1028);
#pragma unroll
        for (int ai = 0; ai < 2; ++ai)
#pragma unroll
            for (int m = 0; m < 4; ++m) {
                const f32x4 g0 = acc[ai][0][m][0] + bg0, g1 = acc[ai][0][m][1] + bg1, u0 = acc[ai][1][m][0] + bu0, u1 = acc[ai][1][m][1] + bu1;
                float o[8];
#pragma unroll
                for (int j = 0; j < 8; ++j) { const float g = fminf(j < 4 ? g0[j & 3] : g1[j & 3], 7.f); const float up = fminf(fmaxf(j < 4 ? u0[j & 3] : u1[j & 3], -7.f), 7.f);
                    o[j] = g * __builtin_amdgcn_rcpf(1.f + __expf(-1.702f * g)) * (up + 1.f); }
                u32x4 w; w.x = pk2(o[0], o[1]); w.y = pk2(o[2], o[3]); w.z = pk2(o[4], o[5]); w.w = pk2(o[6], o[7]);
                *(u32x4*)(ACT + (size_t)(row0 + ai * 128 + m * 16) * 1024 + ch0) = w; }
        ACC_ZERO(acc);
    }
};
struct EpiDown {
    static constexpr bool PERM = true;
    bf16* Y; const float* bd;
    DI void operator()(f32x4 (&acc)[2][2][4][2], const pg8::Unit& u, int wr, int wc, int fr, int fq) const {
        const int row0 = u.x + wr * 64 + fr, col0 = u.y * 256 + wc * 32 + 8 * fq, e = u.z & 255;
        f32x4 bv[2][2];
#pragma unroll
        for (int bj = 0; bj < 2; ++bj)
#pragma unroll
            for (int n = 0; n < 2; ++n) bv[bj][n] = *(const f32x4*)(bd + (size_t)e * 1024 + col0 + bj * 128 + 4 * n);
#pragma unroll
        for (int ai = 0; ai < 2; ++ai)
#pragma unroll
            for (int m = 0; m < 4; ++m) { bf16* rowp = Y + (size_t)(row0 + ai * 128 + m * 16) * 1024 + col0;
#pragma unroll
                for (int bj = 0; bj < 2; ++bj) { const f32x4 v0 = acc[ai][bj][m][0] + bv[bj][0], v1 = acc[ai][bj][m][1] + bv[bj][1];
                    u32x4 w; w.x = pk2(v0[0], v0[1]); w.y = pk2(v0[2], v0[3]); w.z = pk2(v1[0], v1[1]); w.w = pk2(v1[2], v1[3]);
                    *(u32x4*)(rowp + bj * 128) = w; } }
        ACC_ZERO(acc);
    }
};
DI void moe_build_table(Frame& F, const unsigned* cnt  ) {
    LAS int* tab = (LAS int*)(F.lds + LDS_TAB_OFF);
    if (F.tid < 32) tab[F.tid] = (int)__hip_atomic_load(cnt + F.tid * 16, __ATOMIC_RELAXED, __HIP_MEMORY_SCOPE_AGENT);
    __syncthreads();
    if (F.tid == 0) { int pb = 0, tb = 0; for (int e = 0; e < 32; ++e) { const int nt_ = (tab[e] + 255) >> 8; tab[32 + e] = pb; tab[64 + e] = tb; pb += nt_ * 256; tb += nt_; } tab[96] = tb; }
    __syncthreads();
    for (int e = 0; e < 32; ++e) { const int tb = tab[64 + e], nt_ = (tab[e] + 255) >> 8; for (int j = F.tid; j < nt_; j += NTHREADS) tab[128 + tb + j] = e; }
    __syncthreads();
}

DI void transpose_item(const float* W, int K, int N, bf16* WT, int mode, const float* gk, LAS float* scr, int item, int lane) {
    const int nblk = N / 32, kb = item / nblk, nb = item % nblk, k0 = 64 * kb, n0 = 32 * nb;
#pragma unroll 8
    for (int i = 0; i < 32; ++i) { const int kk = 2 * i + (lane >> 5); float v = W[(size_t)(k0 + kk) * N + n0 + (lane & 31)]; if (gk) v *= gk[k0 + kk]; scr[kk * 33 + (lane & 31)] = v; }
    LDS_WAIT(); asm volatile("" ::: "memory");
    int drow0 = n0;
    if (mode == 1) { const int up = n0 >= 1024, ch = n0 - (up ? 1024 : 0); drow0 = (ch >> 7) * 256 + (up ? 128 : 0) + (ch & 127); }
    const int c = lane & 7;
#pragma unroll
    for (int j = 0; j < 4; ++j) { const int n = (lane >> 3) + 8 * j; const LAS float* s = scr + (8 * c) * 33 + n;
        u32x4 o; o.x = pk2(s[0 * 33], s[1 * 33]); o.y = pk2(s[2 * 33], s[3 * 33]); o.z = pk2(s[4 * 33], s[5 * 33]); o.w = pk2(s[6 * 33], s[7 * 33]);
        *(u32x4*)(WT + (size_t)(drow0 + n) * K + k0 + 8 * c) = o; }
    LDS_WAIT(); asm volatile("" ::: "memory");
}
DI void transpose_batch(Frame& F, const float* W, size_t ss, int K, int N, bf16* WT, size_t ds, int nb, int mode, const float* gk, size_t gks) {
    LAS float* scr = (LAS float*)(F.lds + F.wave * 16384);
    const int gw = F.bid * NWAVES + F.wave, NGW = F.G * NWAVES;
    const int per = (K / 64) * (N / 32), total = per * nb;
    for (int it = gw; it < total; it += NGW) { const int b = it / per, r = it - b * per;
        transpose_item(W + (size_t)b * ss, K, N, WT + (size_t)b * ds, mode, gk ? gk + (size_t)b * gks : nullptr, scr, r, F.lane); }
}
DI void phase_prologue(Frame& F, const KA& a) {
    unsigned char* ws = F.ws;
    transpose_batch(F, a.in(I_WIN), (size_t)1024 * DIN, 1024, DIN, (bf16*)(ws + WS_WIN), (size_t)DINP * 1024, 4, 0, nullptr, 0);
    transpose_batch(F, a.in(I_WGU), (size_t)1024 * 2048, 1024, 2048, (bf16*)(ws + WS_WGU), (size_t)2048 * 1024, 128, 1, nullptr, 0);
    transpose_batch(F, a.in(I_WDOWN), (size_t)1024 * 1024, 1024, 1024, (bf16*)(ws + WS_WDN), (size_t)1024 * 1024, 128, 0, nullptr, 0);
    transpose_batch(F, a.in(I_WOUT), (size_t)1024 * 1024, 1024, 1024, (bf16*)(ws + WS_WOUT), (size_t)1024 * 1024, 4, 0, nullptr, 0);
    transpose_batch(F, a.in(I_BRRET), (size_t)512 * 1024, 512, 1024, (bf16*)(ws + WS_WBR), (size_t)3 * 1024 * 512, 4, 0, nullptr, 0);
    transpose_batch(F, a.in(I_BRMLA), (size_t)512 * 1024, 512, 1024, (bf16*)(ws + WS_WBR) + (size_t)1024 * 512, (size_t)3 * 1024 * 512, 4, 0, nullptr, 0);
    transpose_batch(F, a.in(I_BRRWKV), (size_t)512 * 1024, 512, 1024, (bf16*)(ws + WS_WBR) + (size_t)2 * 1024 * 512, (size_t)3 * 1024 * 512, 4, 0, nullptr, 0);
    transpose_batch(F, a.in(I_WUQ), (size_t)256 * 768, 256, 768, (bf16*)(ws + WS_SMALLW + SW_UQ), MiB / 2, 4, 0, a.in(I_MQNG), 256);
    transpose_batch(F, a.in(I_WUKV), (size_t)128 * 1024, 128, 1024, (bf16*)(ws + WS_SMALLW + SW_UKV), MiB / 2, 4, 0, a.in(I_MKVNG), 128);
    for (int l = 0; l < 4; ++l) {
        transpose_batch(F, a.in(I_W2) + (size_t)l * 2 * 64 * 512, (size_t)64 * 512, 64, 512, (bf16*)(ws + WS_SMALLW + l * MiB + SW_W2), (size_t)512 * 64, 2, 0, nullptr, 0);
        transpose_batch(F, a.in(I_A2) + (size_t)l * 2 * 64 * 512, (size_t)64 * 512, 64, 512, (bf16*)(ws + WS_SMALLW + l * MiB + SW_A2), (size_t)512 * 64, 2, 0, nullptr, 0);
    }
    transpose_batch(F, a.in(I_G2), (size_t)128 * 512, 128, 512, (bf16*)(ws + WS_SMALLW + SW_G2), MiB / 2, 4, 0, nullptr, 0);
    const int gt = F.bid * NTHREADS + F.tid, NGT = F.G * NTHREADS;
    for (int i = gt; i < 4 * (DINP - DIN) * 1024 / 8; i += NGT) { const int l = i / ((DINP - DIN) * 128), r = i - l * ((DINP - DIN) * 128);
        *(u32x4*)((bf16*)(ws + WS_WIN) + (size_t)l * DINP * 1024 + (size_t)DIN * 1024 + (size_t)r * 8) = (u32x4){0u, 0u, 0u, 0u}; }
    for (int i = gt; i < 128; i += NGT) *(u32x4*)((bf16*)(ws + WS_H) + (size_t)NT * 1024 + i * 8) = (u32x4){0u, 0u, 0u, 0u};
    { float2* rt = (float2*)(ws + WS_ROPE);
      for (int i = gt; i < 4096 * 32; i += NGT) { const int pos = i >> 5, f = i & 31; const float inv = powf(10000.f, -(float)(2 * f) / 64.f); const float ang = (float)pos * inv; float s, c; sincosf(ang, &s, &c); rt[i] = make_float2(c, s); }
      float2* ax = (float2*)(ws + WS_ROPE_AX);
      for (int i = gt; i < 64 * 8; i += NGT) { const int pos = i >> 3, f = i & 7; const float inv = powf(10000.f, -(float)(2 * f) / 16.f); const float ang = (float)pos * inv; float s, c; sincosf(ang, &s, &c); ax[i] = make_float2(c, s); } }
    { LAS float* sc = (LAS float*)(F.lds);
      LAS float* red = (LAS float*)(F.lds + 65536);
      __syncthreads();
      for (int i = F.tid; i < 9 * 1024; i += NTHREADS) { const int r = i >> 10, k = i & 1023; const float v = r < 8 ? a.in(I_C)[r * 1024 + k] : a.in(I_CCTX)[k]; sc[i] = v / (1.f + __expf(-v)); }
      __syncthreads();
      float* mod = (float*)(ws + WS_MOD);
      for (int it = F.bid; it < 4 * 96; it += F.G) { const int l = it / 96, n = (it - l * 96) * 64 + F.lane;
          const float* w = a.in(I_ADAW) + (size_t)l * 1024 * 6144 + n; float acc[9];
#pragma unroll
          for (int r = 0; r < 9; ++r) acc[r] = 0.f;
          const int kb = F.wave * 128;
#pragma unroll 8
          for (int k = 0; k < 128; ++k) { const float wv = w[(size_t)(kb + k) * 6144];
#pragma unroll
              for (int r = 0; r < 9; ++r) acc[r] += sc[r * 1024 + kb + k] * wv; }
#pragma unroll
          for (int r = 0; r < 9; ++r) red[(F.wave * 9 + r) * 64 + F.lane] = acc[r];
          __syncthreads();
          for (int i = F.tid; i < 9 * 64; i += NTHREADS) { const int r = i >> 6, c = i & 63; float s = 0.f;
#pragma unroll
              for (int w8 = 0; w8 < 8; ++w8) s += red[(w8 * 9 + r) * 64 + c];
              const int nn = (it - l * 96) * 64 + c; mod[((size_t)l * 9 + r) * 6144 + nn] = s + a.in(I_ADAB)[l * 6144 + nn]; }
          __syncthreads(); } }
}

DI void norm_mod_store(const f32x4 (&v)[4], const float* gain, const float* sc, const float* sh, bf16* hrow, int lane) {
    float s = 0.f;
#pragma unroll
    for (int j = 0; j < 4; ++j) s += (v[j].x * v[j].x + v[j].y * v[j].y) + (v[j].z * v[j].z + v[j].w * v[j].w);
    const float rinv = rsqrtf(wave_sum(s) * (1.f / 1024.f) + 1e-6f);
#pragma unroll
    for (int j = 0; j < 4; ++j) { const int c = 256 * j + 4 * lane; const f32x4 g = *(const f32x4*)(gain + c), a = *(const f32x4*)(sc + c), b = *(const f32x4*)(sh + c);
        const f32x4 y = v[j] * rinv * g * (a + 1.f) + b; u32x2 o; o.x = pk2(y.x, y.y); o.y = pk2(y.z, y.w); *(u32x2*)(hrow + c) = o; }
}
DI void phase_init_rows(Frame& F, const KA& a) {
    const int gw = F.bid * NWAVES + F.wave, NGW = F.G * NWAVES;
    float* X = (float*)(F.ws + WS_X); bf16* H = (bf16*)(F.ws + WS_H); const float* mod = (const float*)(F.ws + WS_MOD);
    for (int r = gw; r < NT; r += NGW) { const int b = r / LTOT, p = r - b * LTOT;
        const float* src = p < CTX ? a.in(I_CTX) + ((size_t)b * CTX + p) * 1024 : a.in(I_X) + ((size_t)b * SEQ + (p - CTX)) * 1024;
        f32x4 v[4];
#pragma unroll
        for (int j = 0; j < 4; ++j) { v[j] = *(const f32x4*)(src + 256 * j + 4 * F.lane); *(f32x4*)(X + (size_t)r * 1024 + 256 * j + 4 * F.lane) = v[j]; }
        const float* m = mod + (size_t)(p < CTX ? 8 : b) * 6144;
        norm_mod_store(v, a.in(I_N1G), m + 1024, m, H + (size_t)r * 1024, F.lane); }
}

template <int CTRL> DI float dppf(float v) { return __int_as_float(__builtin_amdgcn_update_dpp(0, __float_as_int(v), CTRL, 0xf, 0xf, false)); }
template <int CTRL> DI int dppi(int v) { return __builtin_amdgcn_update_dpp(0, v, CTRL, 0xf, 0xf, false); }
DI void phase_router(Frame& F, const KA& a, int l) {
    LAS float* T = (LAS float*)(F.lds);
    LAS float* part = (LAS float*)(F.lds + 16 * 1028 * 4);
    LAS int* lcnt = (LAS int*)(F.lds + 16 * 1028 * 4 + 16384 + 2048);
    LAS int* gbase = lcnt + 64;
    const float* X = (const float*)(F.ws + WS_X); bf16* H = (bf16*)(F.ws + WS_H);
    const float* mod = (const float*)(F.ws + WS_MOD) + (size_t)l * 9 * 6144;
    const float* gain = a.in(I_N2G) + l * 1024; const float* wr = a.in(I_WROUTER) + (size_t)l * 1024 * 32; const float* br = a.in(I_BROUTER) + l * 32;
    int* eidx = (int*)(F.ws + WS_TOPK); float* gw = (float*)(F.ws + WS_TOPK) + (size_t)NT * 4; int* rank = (int*)(F.ws + WS_TOPK) + (size_t)NT * 8;
    int* list = (int*)(F.ws + WS_LIST); unsigned* cnt = F.ctl + CW_CNT + l * 32 * 16;
    const int lane = F.lane, w = F.wave, tid = F.tid;
    const bool lastl = l == DEPTH - 1;
    const int nit = lastl ? BATCH * SEQ / 16 : NT / 16;
    const int mi = lane & 15, mq = lane >> 4;
    float b0[32], b1[32];
    { const float* wp = wr + (size_t)(128 * w + 32 * mq) * 32 + mi;
#pragma unroll
      for (int s2 = 0; s2 < 32; ++s2) { b0[s2] = wp[s2 * 32]; b1[s2] = wp[s2 * 32 + 16]; } }
    const int row = tid >> 5, e = tid & 31; const float bre = br[e];
    f32x4 vn[2][4];
    int it = F.bid;
#define RT_R0(it_) (lastl ? ((it_) >> 8) * LTOT + CTX + 16 * ((it_) & 255) : (it_) * 16)
    if (it < nit) { const int r0 = RT_R0(it);
#pragma unroll
        for (int rr = 0; rr < 2; ++rr)
#pragma unroll
            for (int j = 0; j < 4; ++j) vn[rr][j] = *(const f32x4*)(X + (size_t)(r0 + w * 2 + rr) * 1024 + 256 * j + 4 * lane); }
    int pend_e = 0, pend_lr = 0, pend_r = -1, par = 0; float pend_g = 0.f; int gb = 0;
#pragma unroll 1
    for (; it < nit; it += F.G) {
        const int r0 = RT_R0(it);
        __syncthreads();
        if (tid < 32) { if (pend_r >= 0) { const int c = lcnt[(par ^ 1) * 32 + tid]; gb = c ? (int)__hip_atomic_fetch_add(cnt + tid * 16, (unsigned)c, __ATOMIC_RELAXED, __HIP_MEMORY_SCOPE_AGENT) : 0; }
            lcnt[par * 32 + tid] = 0; }
#pragma unroll
        for (int rr = 0; rr < 2; ++rr) { const int lr = w * 2 + rr, r = r0 + lr; const int b = r / LTOT, p = r - b * LTOT; const float* m = mod + (size_t)(p < CTX ? 8 : b) * 6144;
            float s = 0.f;
#pragma unroll
            for (int j = 0; j < 4; ++j) { const f32x4 x = vn[rr][j]; s += (x.x * x.x + x.y * x.y) + (x.z * x.z + x.w * x.w); }
            const float rinv = rsqrtf(wave_sum(s) * (1.f / 1024.f) + 1e-6f);
#pragma unroll
            for (int j = 0; j < 4; ++j) { const int c = 256 * j + 4 * lane; const f32x4 g = *(const f32x4*)(gain + c), sc = *(const f32x4*)(m + 4096 + c), sh = *(const f32x4*)(m + 3072 + c);
                const f32x4 y = vn[rr][j] * rinv * g * (sc + 1.f) + sh; *(LAS f32x4*)(T + lr * 1028 + c) = y;
                u32x2 o; o.x = pk2(y.x, y.y); o.y = pk2(y.z, y.w); *(u32x2*)(H + (size_t)r * 1024 + c) = o; } }
        __syncthreads();
        if (it + F.G < nit) { const int rn = RT_R0(it + F.G);
#pragma unroll
            for (int rr = 0; rr < 2; ++rr)
#pragma unroll
                for (int j = 0; j < 4; ++j) vn[rr][j] = *(const f32x4*)(X + (size_t)(rn + w * 2 + rr) * 1024 + 256 * j + 4 * lane); }
        { f32x4 acc0 = {0.f, 0.f, 0.f, 0.f}, acc1 = acc0;
          const LAS float* tp = T + mi * 1028 + 128 * w + 32 * mq;
          f32x4 a4[8];
#pragma unroll
          for (int s2 = 0; s2 < 8; ++s2) a4[s2] = *(const LAS f32x4*)(tp + 4 * s2);
#pragma unroll
          for (int s2 = 0; s2 < 32; ++s2) { const float av = a4[s2 >> 2][s2 & 3];
              acc0 = __builtin_amdgcn_mfma_f32_16x16x4f32(av, b0[s2], acc0, 0, 0, 0); acc1 = __builtin_amdgcn_mfma_f32_16x16x4f32(av, b1[s2], acc1, 0, 0, 0); }
#pragma unroll
          for (int rg = 0; rg < 4; ++rg) { part[(w * 16 + 4 * mq + rg) * 32 + mi] = acc0[rg]; part[(w * 16 + 4 * mq + rg) * 32 + 16 + mi] = acc1[rg]; } }
        if (tid < 32 && pend_r >= 0) gbase[(par ^ 1) * 32 + tid] = gb;
        __syncthreads();
        { float v = bre;
#pragma unroll
          for (int w8 = 0; w8 < 8; ++w8) v += part[(w8 * 16 + row) * 32 + e];
          int te[4]; float tv[4];
#pragma unroll
          for (int k = 0; k < 4; ++k) { float bv = v; int bi = e;
#define RT_STEP(OV, OI) do { const float ov_ = (OV); const int oi_ = (OI); const bool take_ = ov_ > bv || (ov_ == bv && oi_ < bi); bv = take_ ? ov_ : bv; bi = take_ ? oi_ : bi; } while (0)
              RT_STEP(dppf<0xB1>(bv), dppi<0xB1>(bi)); RT_STEP(dppf<0x4E>(bv), dppi<0x4E>(bi)); RT_STEP(dppf<0x141>(bv), dppi<0x141>(bi)); RT_STEP(dppf<0x140>(bv), dppi<0x140>(bi));
              RT_STEP(sx(bv, 16), __float_as_int(sx(__int_as_float(bi), 16)));
              te[k] = bi; tv[k] = bv; if (e == bi) v = -3.0e38f; }
          const float mx = tv[0]; float den = 0.f;
#pragma unroll
          for (int k = 0; k < 4; ++k) { tv[k] = __expf(tv[k] - mx); den += tv[k]; }
          const float rden = 1.f / den;
          int myk_e = te[0]; float myk_g = tv[0] * rden;
#pragma unroll
          for (int k = 1; k < 4; ++k) { if (e == k) { myk_e = te[k]; myk_g = tv[k] * rden; } }
          int lr = 0;
          if (e < 4) lr = atomicAdd((int*)&lcnt[par * 32 + myk_e], 1);
          if (e < 4 && pend_r >= 0) { const int rk = gbase[(par ^ 1) * 32 + pend_e] + pend_lr; eidx[pend_r * 4 + e] = pend_e; gw[pend_r * 4 + e] = pend_g; rank[pend_r * 4 + e] = rk; list[(size_t)pend_e * NT + rk] = pend_r * 4 + e; }
          pend_e = myk_e; pend_lr = lr; pend_g = myk_g; pend_r = r0 + row; par ^= 1; }
    }
    __syncthreads();
    if (pend_r >= 0) {
        if (tid < 32) { const int c = lcnt[(par ^ 1) * 32 + tid]; gbase[(par ^ 1) * 32 + tid] = c ? (int)__hip_atomic_fetch_add(cnt + tid * 16, (unsigned)c, __ATOMIC_RELAXED, __HIP_MEMORY_SCOPE_AGENT) : 0; }
        __syncthreads();
        if (e < 4) { const int rk = gbase[(par ^ 1) * 32 + pend_e] + pend_lr; eidx[pend_r * 4 + e] = pend_e; gw[pend_r * 4 + e] = pend_g; rank[pend_r * 4 + e] = rk; list[(size_t)pend_e * NT + rk] = pend_r * 4 + e; }
    }
#undef RT_STEP
#undef RT_R0
}

DI void phase_combine(Frame& F, const KA& a, int l) {
    moe_build_table(F, F.ctl + CW_CNT + l * 32 * 16);
    const LAS int* tab = (const LAS int*)(F.lds + LDS_TAB_OFF);
    const int lane = fresh_lane();
    const int gw_ = F.bid * NWAVES + F.wave, NGW = F.G * NWAVES;
    float* X = (float*)(F.ws + WS_X); bf16* H = (bf16*)(F.ws + WS_H); const bf16* Y = (const bf16*)(F.ws + WS_Y);
    const float* mod = (const float*)(F.ws + WS_MOD) + (size_t)l * 9 * 6144;
    const int* eidx = (const int*)(F.ws + WS_TOPK); const float* gw = (const float*)(F.ws + WS_TOPK) + (size_t)NT * 4; const int* rank = (const int*)(F.ws + WS_TOPK) + (size_t)NT * 8;
#pragma unroll 1
    for (int r0 = gw_; r0 < NT; r0 += 2 * NGW) {
        int rr[2], bb[2], pp[2]; bool act[2]; size_t slot[2][4]; float gk[2][4];
#pragma unroll
        for (int u = 0; u < 2; ++u) { rr[u] = r0 + u * NGW; act[u] = rr[u] < NT; if (!act[u]) rr[u] = r0; bb[u] = rr[u] / LTOT; pp[u] = rr[u] - bb[u] * LTOT; if (l == DEPTH - 1 && pp[u] < CTX) act[u] = false;
#pragma unroll
            for (int k = 0; k < 4; ++k) { const int e = eidx[rr[u] * 4 + k]; gk[u][k] = gw[rr[u] * 4 + k]; slot[u][k] = (size_t)(tab[32 + e] + rank[rr[u] * 4 + k]); } }
        f32x4 v[2][4]; u32x2 yv[2][4][4];
#pragma unroll
        for (int u = 0; u < 2; ++u) {
#pragma unroll
            for (int j = 0; j < 4; ++j) v[u][j] = *(const f32x4*)(X + (size_t)rr[u] * 1024 + 256 * j + 4 * lane);
#pragma unroll
            for (int k = 0; k < 4; ++k)
#pragma unroll
                for (int j = 0; j < 4; ++j) yv[u][k][j] = *(const u32x2*)(Y + slot[u][k] * 1024 + 256 * j + 4 * lane); }
#pragma unroll
        for (int u = 0; u < 2; ++u) { if (!act[u]) continue;
            const int mr = pp[u] < CTX ? 8 : bb[u]; const float* g2 = mod + (size_t)mr * 6144 + 5120;
#pragma unroll
            for (int j = 0; j < 4; ++j) { f32x4 acc = {0.f, 0.f, 0.f, 0.f};
#pragma unroll
                for (int k = 0; k < 4; ++k) { const float g = gk[u][k]; const u32x2 y = yv[u][k][j]; acc.x += g * bflo(y.x); acc.y += g * bfhi(y.x); acc.z += g * bflo(y.y); acc.w += g * bfhi(y.y); }
                v[u][j] = v[u][j] + *(const f32x4*)(g2 + 256 * j + 4 * lane) * acc; }
            if (l == DEPTH - 1) {
                float* o = a.out() + ((size_t)bb[u] * SEQ + (pp[u] - CTX)) * 1024;
#pragma unroll
                for (int j = 0; j < 4; ++j) *(f32x4*)(o + 256 * j + 4 * lane) = v[u][j];
            } else {
#pragma unroll
                for (int j = 0; j < 4; ++j) *(f32x4*)(X + (size_t)rr[u] * 1024 + 256 * j + 4 * lane) = v[u][j];
                const float* m = (const float*)(F.ws + WS_MOD) + (size_t)(l + 1) * 9 * 6144 + (size_t)mr * 6144;
                norm_mod_store(v[u], a.in(I_N1G) + (l + 1) * 1024, m + 1024, m, H + (size_t)rr[u] * 1024, lane);
            } }
    }
}

DI int crow16(int i, int h) { return (i & 3) + 8 * (i >> 2) + 4 * h; }
DI int permpos(int p) { return (p & ~12) | ((p & 4) << 1) | ((p & 8) >> 1); }
constexpr int MP_P = 424;
constexpr int MP_SP = 104;
constexpr int MP_SCR = 32 * MP_P * 2;
DI void phase_mla_prep2(Frame& F, const KA& a, int l) {
    const bf16* P = (const bf16*)(F.ws + WS_P);
    const bf16* WUQ = (const bf16*)(F.ws + WS_SMALLW + (size_t)l * MiB + SW_UQ); const bf16* WUKV = (const bf16*)(F.ws + WS_SMALLW + (size_t)l * MiB + SW_UKV);
    bf16* QB = (bf16*)(F.ws + WS_QB); bf16* KB = (bf16*)(F.ws + WS_KB); bf16* VT = (bf16*)(F.ws + WS_VT);
    const float* gq = a.in(I_QKQG) + l * 96; const float* gk = a.in(I_QKKG) + l * 96;
    const float2* ax = (const float2*)(F.ws + WS_ROPE_AX);
    LAS bf16* T = (LAS bf16*)F.lds;
#pragma unroll 1
    for (int it = F.bid; it < NT / 32; it += F.G) {
        const int lane = fresh_lane(); int w = F.wave; asm volatile("" : "+s"(w)); const int tid = w * 64 + lane;
        const int r0 = it * 32, b = r0 / LTOT, p0 = r0 - b * LTOT;
        __syncthreads();
#pragma unroll 1
        for (int q = tid; q < 32 * 52; q += NTHREADS) { const int row = q / 52, pc = q - row * 52; *(LAS u32x4*)(T + row * MP_P + 8 * pc) = *(const u32x4*)(P + (size_t)(r0 + row) * DINP + PC_MQ + 8 * pc); }
        __syncthreads();
        const int hd = w, tok = lane & 31, h = lane >> 5, p = p0 + tok; const bool lat = p >= CTX; const int sl = p - CTX;
        const LAS bf16* trow = T + tok * MP_P;
        LAS bf16* scr = (LAS bf16*)(F.lds + MP_SCR + w * 6656);
        const size_t bhbase = (size_t)(b * 8 + hd) * LTOT + p0;
        { bf16x8 cq[16]; float ssq = 0.f;
#pragma unroll
          for (int s2 = 0; s2 < 16; ++s2) { const u32x4 x = *(const LAS u32x4*)(trow + 16 * s2 + 8 * h); cq[s2] = __builtin_bit_cast(bf16x8, x);
              ssq += bflo(x.x) * bflo(x.x) + bfhi(x.x) * bfhi(x.x) + bflo(x.y) * bflo(x.y) + bfhi(x.y) * bfhi(x.y) + bflo(x.z) * bflo(x.z) + bfhi(x.z) * bfhi(x.z) + bflo(x.w) * bflo(x.w) + bfhi(x.w) * bfhi(x.w); }
          ssq += sx(ssq, 32);
          const float rinq = rsqrtf(ssq * (1.f / 256.f) + 1e-6f);
          float2 cr[4], cc[4];
#pragma unroll
          for (int f = 0; f < 4; ++f) { cr[f] = lat ? ax[(sl >> 6) * 8 + 4 * h + f] : make_float2(1.f, 0.f); cc[f] = lat ? ax[(sl & 63) * 8 + 4 * h + f] : make_float2(1.f, 0.f); }
          f32x16 acc[3];
#pragma unroll
          for (int cb = 0; cb < 3; ++cb) { f32x16 z = zero16(); const bf16* wrow = WUQ + (size_t)(hd * 96 + cb * 32 + tok) * 256 + 8 * h;
              bf16x8 wf[16];
#pragma unroll
              for (int s2 = 0; s2 < 16; ++s2) wf[s2] = *(const bf16x8*)(wrow + 16 * s2);
              __builtin_amdgcn_sched_barrier(0);
#pragma unroll
              for (int s2 = 0; s2 < 16; ++s2) z = __builtin_amdgcn_mfma_f32_32x32x16_bf16(wf[s2], cq[s2], z, 0, 0, 0);
              __builtin_amdgcn_sched_barrier(0);
              acc[cb] = z; }
          float ss = 0.f;
#pragma unroll
          for (int cb = 0; cb < 3; ++cb)
#pragma unroll
              for (int i = 0; i < 16; ++i) { acc[cb][i] *= rinq; ss += acc[cb][i] * acc[cb][i]; }
          ss += sx(ss, 32);
          const float rq = rsqrtf(ss * (1.f / 96.f) + 1e-6f);
#pragma unroll
          for (int cb = 0; cb < 3; ++cb)
#pragma unroll
              for (int i = 0; i < 16; ++i) acc[cb][i] *= rq * gq[cb * 32 + crow16(i, h)];
#pragma unroll
          for (int i = 0; i < 4; ++i) { const float2 c1 = cr[i]; const float x1 = acc[2][i], x2 = acc[2][i + 4]; acc[2][i] = x1 * c1.x - x2 * c1.y; acc[2][i + 4] = x1 * c1.y + x2 * c1.x;
              const float2 c2 = cc[i]; const float y1 = acc[2][8 + i], y2 = acc[2][12 + i]; acc[2][8 + i] = y1 * c2.x - y2 * c2.y; acc[2][12 + i] = y1 * c2.y + y2 * c2.x; }
#pragma unroll
          for (int cb = 0; cb < 3; ++cb)
#pragma unroll
              for (int g = 0; g < 4; ++g) { u32x2 o; o.x = pk2(acc[cb][4 * g], acc[cb][4 * g + 1]); o.y = pk2(acc[cb][4 * g + 2], acc[cb][4 * g + 3]); *(LAS u32x2*)(scr + tok * MP_SP + cb * 32 + 8 * g + 4 * h) = o; }
          LDS_WAIT();
#pragma unroll
          for (int i = 0; i < 6; ++i) { const int q = lane + 64 * i, row = q / 12, pc = q - row * 12; *(u32x4*)(QB + (bhbase + row) * 96 + 8 * pc) = *(const LAS u32x4*)(scr + row * MP_SP + 8 * pc); }
          LDS_WAIT(); }
        { bf16x8 ckv[8]; float ssk = 0.f;
#pragma unroll
          for (int s2 = 0; s2 < 8; ++s2) { const u32x4 x = *(const LAS u32x4*)(trow + 256 + 16 * s2 + 8 * h); ckv[s2] = __builtin_bit_cast(bf16x8, x);
              ssk += bflo(x.x) * bflo(x.x) + bfhi(x.x) * bfhi(x.x) + bflo(x.y) * bflo(x.y) + bfhi(x.y) * bfhi(x.y) + bflo(x.z) * bflo(x.z) + bfhi(x.z) * bfhi(x.z) + bflo(x.w) * bflo(x.w) + bfhi(x.w) * bfhi(x.w); }
          ssk += sx(ssk, 32);
          const float rinkv = rsqrtf(ssk * (1.f / 128.f) + 1e-6f);
          float pe1[8], pe2[8]; float sspe = 0.f;
          { const u32x4 w0 = *(const LAS u32x4*)(trow + 384 + 16 * h), w1 = *(const LAS u32x4*)(trow + 384 + 16 * h + 8);
            unpack8(w0, pe1); unpack8(w1, pe2);
#pragma unroll
            for (int j = 0; j < 8; ++j) sspe += pe1[j] * pe1[j] + pe2[j] * pe2[j];
            sspe += sx(sspe, 32); }
          float2 cs[8];
#pragma unroll
          for (int f = 0; f < 8; ++f) cs[f] = lat ? ax[(h ? (sl & 63) : (sl >> 6)) * 8 + f] : make_float2(1.f, 0.f);
          f32x16 acc[4];
#pragma unroll
          for (int cb = 0; cb < 4; cb += 2) { f32x16 z0 = zero16(), z1 = zero16(); const bf16* wrow = WUKV + (size_t)(hd * 128 + cb * 32 + tok) * 128 + 8 * h;
              bf16x8 wf0[8], wf1[8];
#pragma unroll
              for (int s2 = 0; s2 < 8; ++s2) { wf0[s2] = *(const bf16x8*)(wrow + 16 * s2); wf1[s2] = *(const bf16x8*)(wrow + 32 * 128 + 16 * s2); }
              __builtin_amdgcn_sched_barrier(0);
#pragma unroll
              for (int s2 = 0; s2 < 8; ++s2) { z0 = __builtin_amdgcn_mfma_f32_32x32x16_bf16(wf0[s2], ckv[s2], z0, 0, 0, 0); z1 = __builtin_amdgcn_mfma_f32_32x32x16_bf16(wf1[s2], ckv[s2], z1, 0, 0, 0); }
              __builtin_amdgcn_sched_barrier(0);
              acc[cb] = z0; acc[cb + 1] = z1; }
          float ss = 0.f;
#pragma unroll
          for (int cb = 0; cb < 4; ++cb)
#pragma unroll
              for (int i = 0; i < 16; ++i) { acc[cb][i] *= rinkv; if (cb < 2) ss += acc[cb][i] * acc[cb][i]; }
          ss += sx(ss, 32);
          const float rk = rsqrtf((ss + sspe) * (1.f / 96.f) + 1e-6f);
#pragma unroll
          for (int cb = 0; cb < 2; ++cb)
#pragma unroll
              for (int g = 0; g < 4; ++g) { float o4[4];
#pragma unroll
                  for (int j = 0; j < 4; ++j) o4[j] = acc[cb][4 * g + j] * rk * gk[cb * 32 + 8 * g + 4 * h + j];
                  u32x2 o; o.x = pk2(o4[0], o4[1]); o.y = pk2(o4[2], o4[3]); *(LAS u32x2*)(scr + tok * MP_SP + cb * 32 + 8 * g + 4 * h) = o; }
          { float pe[16];
#pragma unroll
            for (int f = 0; f < 8; ++f) { const float x1 = pe1[f] * rk * gk[64 + 16 * h + f], x2 = pe2[f] * rk * gk[64 + 16 * h + 8 + f];
                pe[f] = x1 * cs[f].x - x2 * cs[f].y; pe[8 + f] = x1 * cs[f].y + x2 * cs[f].x; }
            *(LAS bf16x8*)(scr + tok * MP_SP + 64 + 16 * h) = pack8(pe); *(LAS bf16x8*)(scr + tok * MP_SP + 64 + 16 * h + 8) = pack8(pe + 8); }
          LDS_WAIT();
#pragma unroll
          for (int i = 0; i < 6; ++i) { const int q = lane + 64 * i, row = q / 12, pc = q - row * 12; *(u32x4*)(KB + (bhbase + row) * 96 + 8 * pc) = *(const LAS u32x4*)(scr + row * MP_SP + 8 * pc); }
          LDS_WAIT();
          { const int pt = permpos(tok);
#pragma unroll
            for (int cb = 2; cb < 4; ++cb)
#pragma unroll
                for (int i = 0; i < 16; ++i) scr[((cb - 2) * 32 + crow16(i, h)) * 40 + pt] = f2bf(acc[cb][i]);
            LDS_WAIT();
            bf16* vt = VT + (size_t)(b * 8 + hd) * 64 * LTOT + p0;
#pragma unroll
            for (int i = 0; i < 4; ++i) { const int q = lane + 64 * i, d = q >> 2, pc = q & 3; *(u32x4*)(vt + (size_t)d * LTOT + 8 * pc) = *(const LAS u32x4*)(scr + d * 40 + 8 * pc); }
            LDS_WAIT(); } }
    }
}

constexpr int ATT_KP = 104, ATT_VP = 72;
constexpr int ATT_KBYTES = 64 * ATT_KP * 2, ATT_VBYTES = 64 * ATT_VP * 2;
DI void attn_unit(Frame& F, int b, int hd, int qblk) {
    const bf16* QB = (const bf16*)(F.ws + WS_QB); const bf16* KB = (const bf16*)(F.ws + WS_KB); const bf16* VT = (const bf16*)(F.ws + WS_VT);
    bf16* O = (bf16*)(F.ws + WS_ABR) + (size_t)NT * 512;
    const int q0 = qblk == 0 ? 0 : CTX + 256 * (qblk - 1), ntiles = qblk == 0 ? CTX / 64 : LTOT / 64;
    const int lane = fresh_lane(), ql = lane & 31, h = lane >> 5, w = F.wave, tid = w * 64 + lane;
    const size_t bh = (size_t)(b * 8 + hd);
    LAS bf16* Kt = (LAS bf16*)(F.lds); LAS bf16* Vt = (LAS bf16*)(F.lds + 2 * ATT_KBYTES);
    bf16x8 qf[6];
    { const bf16* qrow = QB + (bh * LTOT + q0 + 32 * w + ql) * 96 + 8 * h;
#pragma unroll
      for (int s = 0; s < 6; ++s) qf[s] = *(const bf16x8*)(qrow + 16 * s); }
    const bf16* kbase = KB + bh * LTOT * 96; const bf16* vbase = VT + bh * 64 * LTOT;
    const int k1 = tid / 12, c1 = tid - k1 * 12, k2 = (512 + tid) / 12, c2 = (512 + tid) - k2 * 12, vd = tid >> 3, vc = tid & 7;
    u32x4 rk1, rk2 = {0u, 0u, 0u, 0u}, rv;
    rk1 = *(const u32x4*)(kbase + (size_t)k1 * 96 + 8 * c1); if (tid < 256) rk2 = *(const u32x4*)(kbase + (size_t)k2 * 96 + 8 * c2); rv = *(const u32x4*)(vbase + (size_t)vd * LTOT + 8 * vc);
    __syncthreads();
    *(LAS u32x4*)(Kt + k1 * ATT_KP + 8 * c1) = rk1; if (tid < 256) *(LAS u32x4*)(Kt + k2 * ATT_KP + 8 * c2) = rk2; *(LAS u32x4*)(Vt + vd * ATT_VP + 8 * vc) = rv;
    __syncthreads();
    float m = -1.0e30f, lsum = 0.f; f32x16 o0, o1;
#pragma unroll
    for (int i = 0; i < 16; ++i) { o0[i] = 0.f; o1[i] = 0.f; }
    const float sc = 0.10206207261596577f * 1.4426950408889634f;
    for (int t = 0; t < ntiles; ++t) {
        const int buf = t & 1; const bool more = t + 1 < ntiles;
        if (more) { const size_t ko = (size_t)(t + 1) * 64; rk1 = *(const u32x4*)(kbase + (ko + k1) * 96 + 8 * c1); if (tid < 256) rk2 = *(const u32x4*)(kbase + (ko + k2) * 96 + 8 * c2); rv = *(const u32x4*)(vbase + (size_t)vd * LTOT + ko + 8 * vc); }
        const LAS bf16* kt = Kt + buf * (64 * ATT_KP); const LAS bf16* vt = Vt + buf * (64 * ATT_VP);
        f32x16 s0, s1;
#pragma unroll
        for (int i = 0; i < 16; ++i) { s0[i] = 0.f; s1[i] = 0.f; }
        bf16x8 kf0[6], kf1[6];
#pragma unroll
        for (int s = 0; s < 6; ++s) { kf0[s] = *(const LAS bf16x8*)(kt + ql * ATT_KP + 16 * s + 8 * h); kf1[s] = *(const LAS bf16x8*)(kt + (32 + ql) * ATT_KP + 16 * s + 8 * h); }
        __builtin_amdgcn_sched_barrier(0);
#pragma unroll
        for (int s = 0; s < 6; ++s) { s0 = __builtin_amdgcn_mfma_f32_32x32x16_bf16(kf0[s], qf[s], s0, 0, 0, 0); s1 = __builtin_amdgcn_mfma_f32_32x32x16_bf16(kf1[s], qf[s], s1, 0, 0, 0); }
        bf16x8 vf0[4], vf1[4];
#pragma unroll
        for (int ks = 0; ks < 4; ++ks) { vf0[ks] = *(const LAS bf16x8*)(vt + ql * ATT_VP + 16 * ks + 8 * h); vf1[ks] = *(const LAS bf16x8*)(vt + (32 + ql) * ATT_VP + 16 * ks + 8 * h); }
        __builtin_amdgcn_sched_barrier(0);
        float mr = -1.0e30f;
#pragma unroll
        for (int i = 0; i < 16; ++i) mr = fmaxf(mr, fmaxf(s0[i], s1[i]));
        mr = fmaxf(mr, sx(mr, 32));
        const float mn = fmaxf(m, mr * sc), alpha = __builtin_amdgcn_exp2f(m - mn); m = mn;
        float rs = 0.f;
#pragma unroll
        for (int i = 0; i < 16; ++i) { s0[i] = __builtin_amdgcn_exp2f(__builtin_fmaf(s0[i], sc, -mn)); s1[i] = __builtin_amdgcn_exp2f(__builtin_fmaf(s1[i], sc, -mn)); rs += s0[i] + s1[i]; }
        lsum = lsum * alpha + rs;
#pragma unroll
        for (int i = 0; i < 16; ++i) { o0[i] *= alpha; o1[i] *= alpha; }
        bf16x8 pf[4];
        { u32x4 x;
          x.x = pk2(s0[0], s0[1]); x.y = pk2(s0[2], s0[3]); x.z = pk2(s0[4], s0[5]); x.w = pk2(s0[6], s0[7]); pf[0] = __builtin_bit_cast(bf16x8, x);
          x.x = pk2(s0[8], s0[9]); x.y = pk2(s0[10], s0[11]); x.z = pk2(s0[12], s0[13]); x.w = pk2(s0[14], s0[15]); pf[1] = __builtin_bit_cast(bf16x8, x);
          x.x = pk2(s1[0], s1[1]); x.y = pk2(s1[2], s1[3]); x.z = pk2(s1[4], s1[5]); x.w = pk2(s1[6], s1[7]); pf[2] = __builtin_bit_cast(bf16x8, x);
          x.x = pk2(s1[8], s1[9]); x.y = pk2(s1[10], s1[11]); x.z = pk2(s1[12], s1[13]); x.w = pk2(s1[14], s1[15]); pf[3] = __builtin_bit_cast(bf16x8, x); }
        __builtin_amdgcn_sched_barrier(0);
#pragma unroll
        for (int ks = 0; ks < 4; ++ks) { o0 = __builtin_amdgcn_mfma_f32_32x32x16_bf16(vf0[ks], pf[ks], o0, 0, 0, 0); o1 = __builtin_amdgcn_mfma_f32_32x32x16_bf16(vf1[ks], pf[ks], o1, 0, 0, 0); }
        if (more) { const int nb = buf ^ 1; LAS bf16* kn = Kt + nb * (64 * ATT_KP); LAS bf16* vn = Vt + nb * (64 * ATT_VP);
            *(LAS u32x4*)(kn + k1 * ATT_KP + 8 * c1) = rk1; if (tid < 256) *(LAS u32x4*)(kn + k2 * ATT_KP + 8 * c2) = rk2; *(LAS u32x4*)(vn + vd * ATT_VP + 8 * vc) = rv; }
        __syncthreads();
    }
    lsum += sx(lsum, 32);
    const float inv = 1.f / lsum;
    bf16* orow = O + ((size_t)b * LTOT + q0 + 32 * w + ql) * 512 + hd * 64 + 4 * h;
#pragma unroll
    for (int g = 0; g < 4; ++g) { u32x2 x; x.x = pk2(o0[4 * g] * inv, o0[4 * g + 1] * inv); x.y = pk2(o0[4 * g + 2] * inv, o0[4 * g + 3] * inv); *(u32x2*)(orow + 8 * g) = x;
        x.x = pk2(o1[4 * g] * inv, o1[4 * g + 1] * inv); x.y = pk2(o1[4 * g + 2] * inv, o1[4 * g + 3] * inv); *(u32x2*)(orow + 32 + 8 * g) = x; }
}

DI void shift_n(const bf16* prow, bool first, bool last, int col, const float* mup, const float* mun, float* out, int n  ) {
    const bf16* pp = first ? prow : prow - DINP; const bf16* pn = last ? prow : prow + DINP; const float fm = first ? 0.f : 1.f, lm = last ? 0.f : 1.f;
    if (n == 8) {
        const u32x4 c = *(const u32x4*)(prow + col), pv = *(const u32x4*)(pp + col), nx = *(const u32x4*)(pn + col);
        const f32x4 mp0 = *(const f32x4*)(mup + col - PC_RW), mp1 = *(const f32x4*)(mup + col - PC_RW + 4), mn0 = *(const f32x4*)(mun + col - PC_RW), mn1 = *(const f32x4*)(mun + col - PC_RW + 4);
        const unsigned cw[4] = {c.x, c.y, c.z, c.w}, pw[4] = {pv.x, pv.y, pv.z, pv.w}, nw[4] = {nx.x, nx.y, nx.z, nx.w};
        const float mp[8] = {mp0.x, mp0.y, mp0.z, mp0.w, mp1.x, mp1.y, mp1.z, mp1.w}, mn[8] = {mn0.x, mn0.y, mn0.z, mn0.w, mn1.x, mn1.y, mn1.z, mn1.w};
#pragma unroll
        for (int j = 0; j < 4; ++j) { const float t0 = bflo(cw[j]), t1 = bfhi(cw[j]);
            out[2 * j] = t0 + mp[2 * j] * (fm * bflo(pw[j]) - t0) + mn[2 * j] * (lm * bflo(nw[j]) - t0);
            out[2 * j + 1] = t1 + mp[2 * j + 1] * (fm * bfhi(pw[j]) - t1) + mn[2 * j + 1] * (lm * bfhi(nw[j]) - t1); }
    } else {
        const u32x2 c = *(const u32x2*)(prow + col), pv = *(const u32x2*)(pp + col), nx = *(const u32x2*)(pn + col);
        const f32x4 mp0 = *(const f32x4*)(mup + col - PC_RW), mn0 = *(const f32x4*)(mun + col - PC_RW);
        const unsigned cw[2] = {c.x, c.y}, pw[2] = {pv.x, pv.y}, nw[2] = {nx.x, nx.y};
        const float mp[4] = {mp0.x, mp0.y, mp0.z, mp0.w}, mn[4] = {mn0.x, mn0.y, mn0.z, mn0.w};
#pragma unroll
        for (int j = 0; j < 2; ++j) { const float t0 = bflo(cw[j]), t1 = bfhi(cw[j]);
            out[2 * j] = t0 + mp[2 * j] * (fm * bflo(pw[j]) - t0) + mn[2 * j] * (lm * bflo(nw[j]) - t0);
            out[2 * j + 1] = t1 + mp[2 * j + 1] * (fm * bfhi(pw[j]) - t1) + mn[2 * j + 1] * (lm * bfhi(nw[j]) - t1); }
    }
}
constexpr int RP_P = 1928;
DI void phase_rwkv_prep2(Frame& F, const KA& a, int l) {
    const bf16* P = (const bf16*)(F.ws + WS_P);
    const bf16* W2T = (const bf16*)(F.ws + WS_SMALLW + (size_t)l * MiB + SW_W2); const bf16* A2T = (const bf16*)(F.ws + WS_SMALLW + (size_t)l * MiB + SW_A2); const bf16* G2T = (const bf16*)(F.ws + WS_SMALLW + (size_t)l * MiB + SW_G2);
    const float* mup = a.in(I_MUP) + l * 1920; const float* mun = a.in(I_MUN) + l * 1920;
    const float* w0 = a.in(I_W0) + l * 1024; const float* a0 = a.in(I_A0) + l * 1024; const float* kkw = a.in(I_KK) + l * 512; const float* kaw = a.in(I_KA) + l * 512;
    bf16* RW = (bf16*)(F.ws + WS_RW); float* LW = (float*)(F.ws + WS_LW);
    const size_t TS = (size_t)NT * 512;
    LAS bf16* T = (LAS bf16*)F.lds;
#pragma unroll 1
    for (int it = (F.bid + 64) % F.G; it < NT / 32; it += F.G) {
        const int lane = fresh_lane(); int w = F.wave; asm volatile("" : "+s"(w)); const int tid = w * 64 + lane;
        const int r0 = it * 32;
        __syncthreads();
        if (tid < 480) { const int pc = tid % 240, rh = tid / 240, row0 = rh * 16, col = PC_RW + 8 * pc;
            const int ra = r0 + row0, ba = ra / LTOT, pa = ra - ba * LTOT;
            u32x4 rowv[18];
#pragma unroll
            for (int j = 0; j < 18; ++j) { const int p = pa - 1 + j; const bool valid = (p >= 0) && (p < LTOT) && ((p < CTX) == (pa < CTX));
                const int pcl = valid ? p : pa; rowv[j] = *(const u32x4*)(P + ((size_t)ba * LTOT + pcl) * DINP + col); if (!valid) rowv[j] = (u32x4){0u, 0u, 0u, 0u}; }
            const f32x4 mp0 = *(const f32x4*)(mup + 8 * pc), mp1 = *(const f32x4*)(mup + 8 * pc + 4), mn0 = *(const f32x4*)(mun + 8 * pc), mn1 = *(const f32x4*)(mun + 8 * pc + 4);
            const float mp[8] = {mp0.x, mp0.y, mp0.z, mp0.w, mp1.x, mp1.y, mp1.z, mp1.w}, mn[8] = {mn0.x, mn0.y, mn0.z, mn0.w, mn1.x, mn1.y, mn1.z, mn1.w};
#pragma unroll
            for (int j = 0; j < 16; ++j) { float pv[8], cv[8], nv[8], v[8]; unpack8(rowv[j], pv); unpack8(rowv[j + 1], cv); unpack8(rowv[j + 2], nv);
#pragma unroll
                for (int e = 0; e < 8; ++e) v[e] = cv[e] + mp[e] * (pv[e] - cv[e]) + mn[e] * (nv[e] - cv[e]);
                if (pc >= 192 && pc < 208) {
#pragma unroll
                    for (int e = 0; e < 8; ++e) v[e] = 2.f * sigmoidf_(2.f * v[e]) - 1.f; }
                else if (pc >= 224) {
#pragma unroll
                    for (int e = 0; e < 8; ++e) v[e] = sigmoidf_(v[e]); }
                *(LAS bf16x8*)(T + (row0 + j) * RP_P + 8 * pc) = pack8(v); } }
        __syncthreads();
        const int hd = w, tok = lane & 31, h = lane >> 5;
        const LAS bf16* trow = T + tok * RP_P;
#define RP_OUT(c0, dst) do { _Pragma("unroll") for (int i_ = 0; i_ < 4; ++i_) { const int row_ = 8 * i_ + (lane >> 3), pc_ = lane & 7; \
            *(u32x4*)((dst) + (size_t)(r0 + row_) * 512 + hd * 64 + 8 * pc_) = *(const LAS u32x4*)(T + row_ * RP_P + (c0) + 8 * pc_); } } while (0)
        bf16x8 wa[2][8], wg[16], wl[2][8];
#define RP_LDW_A(d_) do { _Pragma("unroll") for (int cb_ = 0; cb_ < 2; ++cb_) _Pragma("unroll") for (int s_ = 0; s_ < 4; ++s_) wa[d_][cb_ * 4 + s_] = *(const bf16x8*)(A2T + (size_t)((d_) * 512 + hd * 64 + cb_ * 32 + tok) * 64 + 16 * s_ + 8 * h); } while (0)
#define RP_LDW_L(d_) do { _Pragma("unroll") for (int cb_ = 0; cb_ < 2; ++cb_) _Pragma("unroll") for (int s_ = 0; s_ < 4; ++s_) wl[d_][cb_ * 4 + s_] = *(const bf16x8*)(W2T + (size_t)((d_) * 512 + hd * 64 + cb_ * 32 + tok) * 64 + 16 * s_ + 8 * h); } while (0)
#define RP_LDW_G() do { _Pragma("unroll") for (int cb_ = 0; cb_ < 2; ++cb_) _Pragma("unroll") for (int s_ = 0; s_ < 8; ++s_) wg[cb_ * 8 + s_] = *(const bf16x8*)(G2T + (size_t)(hd * 64 + cb_ * 32 + tok) * 128 + 16 * s_ + 8 * h); } while (0)
        RP_LDW_A(0);
        RP_OUT(hd * 64, RW); RP_OUT(1024 + hd * 64, RW + 3 * TS);
        float kraw[2][16]; float ss = 0.f;
#pragma unroll
        for (int cb = 0; cb < 2; ++cb)
#pragma unroll
            for (int g = 0; g < 4; ++g) { const int ch = hd * 64 + cb * 32 + 8 * g + 4 * h; const u32x2 kw = *(const LAS u32x2*)(trow + 512 + ch);
                kraw[cb][4 * g] = bflo(kw.x); kraw[cb][4 * g + 1] = bfhi(kw.x); kraw[cb][4 * g + 2] = bflo(kw.y); kraw[cb][4 * g + 3] = bfhi(kw.y);
                const f32x4 kk4 = *(const f32x4*)(kkw + ch);
                ss += kraw[cb][4 * g] * kk4.x * kraw[cb][4 * g] * kk4.x + kraw[cb][4 * g + 1] * kk4.y * kraw[cb][4 * g + 1] * kk4.y + kraw[cb][4 * g + 2] * kk4.z * kraw[cb][4 * g + 2] * kk4.z + kraw[cb][4 * g + 3] * kk4.w * kraw[cb][4 * g + 3] * kk4.w; }
        ss += sx(ss, 32);
        const float rkk = rsqrtf(fmaxf(ss, 1e-24f));
        LDS_WAIT();
        LAS bf16* scr3[3] = {T + hd * 64, T + 1024 + hd * 64, T + 512 + hd * 64};
#define RP_TILE_OUT(vals  , dst, NN) do { LAS bf16* scr = scr3[(NN) % 3]; const int sc0_ = ((NN) % 3 == 0 ? 0 : (NN) % 3 == 1 ? 1024 : 512) + hd * 64; _Pragma("unroll") for (int cb_ = 0; cb_ < 2; ++cb_) _Pragma("unroll") for (int g_ = 0; g_ < 4; ++g_) { u32x2 x_; x_[0] = pk2(vals[cb_][4 * g_], vals[cb_][4 * g_ + 1]); x_[1] = pk2(vals[cb_][4 * g_ + 2], vals[cb_][4 * g_ + 3]); \
            *(LAS u32x2*)(scr + tok * RP_P + cb_ * 32 + 8 * g_ + 4 * h) = x_; } LDS_WAIT(); RP_OUT(sc0_, dst); } while (0)
        { float av[2][16], o[2][16];
#pragma unroll
          for (int d = 0; d < 2; ++d) {
              if (d == 0) RP_LDW_A(1); else RP_LDW_G();
#pragma unroll
              for (int cb = 0; cb < 2; ++cb) { f32x16 c = zero16();
                  bf16x8 xf[4];
#pragma unroll
                  for (int s2 = 0; s2 < 4; ++s2) xf[s2] = *(const LAS bf16x8*)(trow + 1664 + 64 * d + 16 * s2 + 8 * h);
                  __builtin_amdgcn_sched_barrier(0);
#pragma unroll
                  for (int s2 = 0; s2 < 4; ++s2) c = __builtin_amdgcn_mfma_f32_32x32x16_bf16(wa[d][cb * 4 + s2], xf[s2], c, 0, 0, 0);
#pragma unroll
                  for (int g = 0; g < 4; ++g) { const f32x4 a4 = *(const f32x4*)(a0 + d * 512 + hd * 64 + cb * 32 + 8 * g + 4 * h);
                      av[cb][4 * g] = sigmoidf_(a4.x + c[4 * g]); av[cb][4 * g + 1] = sigmoidf_(a4.y + c[4 * g + 1]); av[cb][4 * g + 2] = sigmoidf_(a4.z + c[4 * g + 2]); av[cb][4 * g + 3] = sigmoidf_(a4.w + c[4 * g + 3]); } }
              RP_TILE_OUT(av, RW + (size_t)(5 + d) * TS, 2 * d);
#pragma unroll
              for (int cb = 0; cb < 2; ++cb)
#pragma unroll
                  for (int g = 0; g < 4; ++g) { const f32x4 ka4 = *(const f32x4*)(kaw + hd * 64 + cb * 32 + 8 * g + 4 * h);
                      o[cb][4 * g] = kraw[cb][4 * g] * (1.f + (av[cb][4 * g] - 1.f) * ka4.x); o[cb][4 * g + 1] = kraw[cb][4 * g + 1] * (1.f + (av[cb][4 * g + 1] - 1.f) * ka4.y);
                      o[cb][4 * g + 2] = kraw[cb][4 * g + 2] * (1.f + (av[cb][4 * g + 2] - 1.f) * ka4.z); o[cb][4 * g + 3] = kraw[cb][4 * g + 3] * (1.f + (av[cb][4 * g + 3] - 1.f) * ka4.w); }
              RP_TILE_OUT(o, RW + (size_t)(1 + d) * TS, 2 * d + 1); }
#pragma unroll
          for (int cb = 0; cb < 2; ++cb)
#pragma unroll
              for (int g = 0; g < 4; ++g) { const f32x4 kk4 = *(const f32x4*)(kkw + hd * 64 + cb * 32 + 8 * g + 4 * h);
                  o[cb][4 * g] = kraw[cb][4 * g] * kk4.x * rkk; o[cb][4 * g + 1] = kraw[cb][4 * g + 1] * kk4.y * rkk; o[cb][4 * g + 2] = kraw[cb][4 * g + 2] * kk4.z * rkk; o[cb][4 * g + 3] = kraw[cb][4 * g + 3] * kk4.w * rkk; }
          RP_TILE_OUT(o, RW + 4 * TS, 4); }
        { float o[2][16];
#pragma unroll
          for (int cb = 0; cb < 2; ++cb) { f32x16 c = zero16();
              if (cb == 0) RP_LDW_L(0);
              bf16x8 xf[8];
#pragma unroll
              for (int s2 = 0; s2 < 8; ++s2) xf[s2] = *(const LAS bf16x8*)(trow + 1792 + 16 * s2 + 8 * h);
              __builtin_amdgcn_sched_barrier(0);
#pragma unroll
              for (int s2 = 0; s2 < 8; ++s2) c = __builtin_amdgcn_mfma_f32_32x32x16_bf16(wg[cb * 8 + s2], xf[s2], c, 0, 0, 0);
#pragma unroll
              for (int i = 0; i < 16; ++i) o[cb][i] = c[i]; }
          RP_TILE_OUT(o, RW + 7 * TS, 5); }
#pragma unroll
        for (int d = 0; d < 2; ++d)
#pragma unroll
            for (int cb = 0; cb < 2; ++cb) { f32x16 c = zero16();
                if (d == 0 && cb == 0) RP_LDW_L(1);
                bf16x8 xf[4];
#pragma unroll
                for (int s2 = 0; s2 < 4; ++s2) xf[s2] = *(const LAS bf16x8*)(trow + 1536 + 64 * d + 16 * s2 + 8 * h);
                __builtin_amdgcn_sched_barrier(0);
#pragma unroll
                for (int s2 = 0; s2 < 4; ++s2) c = __builtin_amdgcn_mfma_f32_32x32x16_bf16(wl[d][cb * 4 + s2], xf[s2], c, 0, 0, 0);
                LAS float* fs = (LAS float*)scr3[(6 + 2 * d + cb) % 3];
#pragma unroll
                for (int g = 0; g < 4; ++g) { const f32x4 w4 = *(const f32x4*)(w0 + d * 512 + hd * 64 + cb * 32 + 8 * g + 4 * h);
                    *(LAS f32x4*)(fs + tok * (RP_P / 2) + 8 * g + 4 * h) = (f32x4){-0.6065306597f * sigmoidf_(w4.x + c[4 * g]), -0.6065306597f * sigmoidf_(w4.y + c[4 * g + 1]), -0.6065306597f * sigmoidf_(w4.z + c[4 * g + 2]), -0.6065306597f * sigmoidf_(w4.w + c[4 * g + 3])}; }
                LDS_WAIT();
#pragma unroll
                for (int i_ = 0; i_ < 4; ++i_) { const int row_ = 8 * i_ + (lane >> 3), pc_ = lane & 7;
                    *(f32x4*)(LW + (size_t)d * TS + (size_t)(r0 + row_) * 512 + hd * 64 + cb * 32 + 4 * pc_) = *(const LAS f32x4*)(fs + row_ * (RP_P / 2) + 4 * pc_); } }
        LDS_WAIT();
#undef RP_OUT
#undef RP_TILE_OUT
#undef RP_LDW_A
#undef RP_LDW_L
#undef RP_LDW_G
    }
}

constexpr int NCHUNK = LTOT / 64;
constexpr int NCHAIN = BATCH * 8 * 2;
constexpr int RC_P = 72;
constexpr int RC_TILE = 64 * RC_P * 2;
constexpr int RC_LTF = 13 * RC_TILE, RC_EC = RC_LTF + 64 * 65 * 4;
DI int chain_pos(int dir, int n) { return dir == 0 ? n : (n < CTX ? CTX - 1 - n : LTOT - 1 - (n - CTX)); }
DI f32x16 mm_blk(const LAS bf16* A, int mb, const LAS bf16* Bt, int nb, int k0, int ksteps, int lane, f32x16 acc) {
    const int r = lane & 31, h = lane >> 5;
    bf16x8 fa[4], fb[4];
#pragma unroll
    for (int q = 0; q < 4; ++q) if (q < ksteps) { fa[q] = *(const LAS bf16x8*)(A + (mb * 32 + r) * RC_P + k0 + 16 * q + 8 * h); fb[q] = *(const LAS bf16x8*)(Bt + (nb * 32 + r) * RC_P + k0 + 16 * q + 8 * h); }
    __builtin_amdgcn_sched_barrier(0);
#pragma unroll
    for (int q = 0; q < 4; ++q) if (q < ksteps) acc = __builtin_amdgcn_mfma_f32_32x32x16_bf16(fa[q], fb[q], acc, 0, 0, 0);
    return acc;
}
DI void st_tile_T(LAS bf16* tile, int mb, int nb, const f32x16& d, int lane) {
    const int r = lane & 31, h = lane >> 5;
#pragma unroll
    for (int g = 0; g < 4; ++g) { u32x2 x; x.x = pk2(d[4 * g], d[4 * g + 1]); x.y = pk2(d[4 * g + 2], d[4 * g + 3]); *(LAS u32x2*)(tile + (nb * 32 + r) * RC_P + mb * 32 + 8 * g + 4 * h) = x; }
}
constexpr int RC_LTF2 = 13 * RC_TILE, RC_EC2 = RC_LTF2 + 2 * 32 * 36 * 4, RC_ST = RC_EC2 + 256;
static_assert(RC_ST + RC_TILE <= LDS_MISC_OFF, "rwkv chain LDS map");
DI void rwkv_chain_block(Frame& F, int chain) {
    const int w_ = F.wave;
    const int dir = chain & 1, bh = chain >> 1, b = bh >> 3, hd = bh & 7;
    const bf16* RW = (const bf16*)(F.ws + WS_RW); const float* LW = (const float*)(F.ws + WS_LW); const size_t TS = (size_t)NT * 512;
    bf16* Yg = (bf16*)(F.ws + WS_YF) + (size_t)dir * TS + (size_t)b * LTOT * 512 + hd * 64;
    LAS bf16* tiles = (LAS bf16*)F.lds;
#define TILE(i) (tiles + (i) * (RC_TILE / 2))
    LAS float* LTf = (LAS float*)(F.lds + RC_LTF2); LAS float* EC = (LAS float*)(F.lds + RC_EC2); LAS bf16* ST = (LAS bf16*)(F.lds + RC_ST);
    __syncthreads();
    { const int lane0 = fresh_lane(); for (int i = w_ * 64 + lane0; i < RC_TILE / 4; i += NTHREADS) ((LAS unsigned*)ST)[i] = 0u; }
    f32x4 nl0, nl1; u32x4 nr, nk, nv, nkk, na;
#define RC_LOAD(cc) do { const int lane_ = fresh_lane(); const int p_ = chain_pos(dir, 64 * (cc) + lane_); const size_t off_ = ((size_t)b * LTOT + p_) * 512 + hd * 64 + 8 * w; \
        nl0 = *(const f32x4*)(LW + (size_t)dir * TS + off_); nl1 = *(const f32x4*)(LW + (size_t)dir * TS + off_ + 4); nr = *(const u32x4*)(RW + off_); nk = *(const u32x4*)(RW + (size_t)(1 + dir) * TS + off_); \
        nv = *(const u32x4*)(RW + 3 * TS + off_); nkk = *(const u32x4*)(RW + 4 * TS + off_); na = *(const u32x4*)(RW + (size_t)(5 + dir) * TS + off_); } while (0)
    { const int w = w_; RC_LOAD(0); }
#pragma unroll 1
    for (int c = 0; c < NCHUNK; ++c) {
        const int lane = fresh_lane(); int w = w_; asm volatile("" : "+s"(w));
        { const f32x4 l0 = nl0, l1 = nl1; const u32x4 ur = nr, uk = nk, uv = nv, ukk = nkk, ua = na;
          float lw[8] = {l0.x, l0.y, l0.z, l0.w, l1.x, l1.y, l1.z, l1.w}, cw[8];
#pragma unroll
          for (int j = 0; j < 8; ++j) cw[j] = lw[j];
#pragma unroll
          for (int j = 0; j < 8; ++j) cw[j] = dpp_scan64(cw[j]);
          const unsigned rw_[4] = {ur.x, ur.y, ur.z, ur.w}, kw_[4] = {uk.x, uk.y, uk.z, uk.w}, kkw_[4] = {ukk.x, ukk.y, ukk.z, ukk.w}, aw_[4] = {ua.x, ua.y, ua.z, ua.w};
          float At[8], Rt[8], Bt[8], Kt[8];
#pragma unroll
          for (int j = 0; j < 8; ++j) { const float rr = (j & 1) ? bfhi(rw_[j >> 1]) : bflo(rw_[j >> 1]), kk = (j & 1) ? bfhi(kkw_[j >> 1]) : bflo(kkw_[j >> 1]), k = (j & 1) ? bfhi(kw_[j >> 1]) : bflo(kw_[j >> 1]), aa = (j & 1) ? bfhi(aw_[j >> 1]) : bflo(aw_[j >> 1]);
              const float ep = __expf(cw[j]), em = __expf(-cw[j]), epv = __expf(cw[j] - lw[j]);
              At[j] = -kk * epv; Rt[j] = rr * ep; Bt[j] = kk * aa * em; Kt[j] = k * em;
              if (lane == 63) EC[8 * w + j] = ep; }
          const bf16x8 fa = pack8(At), fr_ = pack8(Rt), fb = pack8(Bt), fk = pack8(Kt);
          *(LAS bf16x8*)(TILE(0) + lane * RC_P + 8 * w) = fa; *(LAS bf16x8*)(TILE(1) + lane * RC_P + 8 * w) = fr_; *(LAS bf16x8*)(TILE(2) + lane * RC_P + 8 * w) = fb; *(LAS bf16x8*)(TILE(3) + lane * RC_P + 8 * w) = fk;
          const unsigned vw_[4] = {uv.x, uv.y, uv.z, uv.w};
#pragma unroll
          for (int j = 0; j < 8; ++j) { TILE(4)[(8 * w + j) * RC_P + lane] = (bf16)fa[j]; TILE(5)[(8 * w + j) * RC_P + lane] = (bf16)fb[j]; TILE(6)[(8 * w + j) * RC_P + lane] = (bf16)fk[j];
              TILE(7)[(8 * w + j) * RC_P + lane] = (bf16)((j & 1) ? (vw_[j >> 1] >> 16) : (vw_[j >> 1] & 0xffffu)); } }
        LDS_BARRIER();
        if (c + 1 < NCHUNK) RC_LOAD(c + 1);
        { const int pi = w >> 1, nb = w & 1, r = lane & 31, h = lane >> 5;
          const LAS bf16* Aop = (pi == 0 || pi == 2) ? TILE(2) : TILE(3);
          const LAS bf16* Bop = pi < 2 ? TILE(0) : TILE(1);
          LAS bf16* dst = TILE(8 + pi);
#pragma unroll
          for (int mb = 0; mb < 2; ++mb) { f32x16 d = zero16();
              if (mb <= nb) d = mm_blk(Aop, mb, Bop, nb, 0, 4, lane, d);
#pragma unroll
              for (int i = 0; i < 16; ++i) { const int m = mb * 32 + crow16(i, h), n = nb * 32 + r; const bool keep = pi < 2 ? m < n : m <= n; d[i] = keep ? d[i] : 0.f; }
              st_tile_T(dst, mb, nb, d, lane);
              if (pi == 0 && mb == nb) {
#pragma unroll
                  for (int i = 0; i < 16; ++i) LTf[(mb * 32 + crow16(i, h)) * 36 + r] = d[i]; } } }
        LDS_BARRIER();
        if (w == 0) {
            { const int k = lane >> 4, tl = lane & 15, blk = k >> 1, o16 = (k & 1) * 16;
              float Tr[16];
#pragma unroll
              for (int i = 0; i < 16; ++i) Tr[i] = 0.f;
#pragma unroll
              for (int cc = 15; cc >= 0; --cc) { float a0 = (cc == tl) ? 1.f : 0.f, a1 = 0.f;
                  const LAS float* lrow = LTf + (blk * 32 + o16 + cc) * 36 + o16;
#pragma unroll
                  for (int q4 = (cc + 1) >> 2; q4 < 4; ++q4) { const f32x4 l4 = *(const LAS f32x4*)(lrow + 4 * q4);
#pragma unroll
                      for (int e = 0; e < 4; ++e) { const int s2 = 4 * q4 + e; if (s2 > cc) { if (e & 1) a1 += Tr[s2] * l4[e]; else a0 += Tr[s2] * l4[e]; } } }
                  Tr[cc] = a0 + a1; if ((cc & 3) == 0) asm volatile("" ::: "memory"); }
              unsigned z0; asm volatile("v_mov_b32 %0, 0" : "=v"(z0)); const u32x4 zz = {z0, z0, z0, z0};
              LAS bf16* trow = TILE(12) + lane * RC_P; LAS bf16* ttrow = TILE(0) + lane * RC_P;
#pragma unroll
              for (int g = 0; g < 8; ++g) { *(LAS u32x4*)(trow + 8 * g) = zz; *(LAS u32x4*)(ttrow + 8 * g) = zz; }
              *(LAS bf16x8*)(trow + 16 * k) = pack8(Tr); *(LAS bf16x8*)(trow + 16 * k + 8) = pack8(Tr + 8);
#pragma unroll
              for (int i = 0; i < 16; ++i) TILE(0)[(16 * k + i) * RC_P + lane] = f2bf(Tr[i]); }
            LDS_WAIT();
            { const int r = lane & 31, h = lane >> 5;
#pragma unroll
              for (int blk = 0; blk < 2; ++blk) {
                  f32x16 x = zero16();
                  x = __builtin_amdgcn_mfma_f32_32x32x16_bf16(*(const LAS bf16x8*)(TILE(8) + (32 * blk + r) * RC_P + 32 * blk + 8 * h), *(const LAS bf16x8*)(TILE(0) + (32 * blk + r) * RC_P + 32 * blk + 8 * h), x, 0, 0, 0);
                  st_tile_T(TILE(2), 0, blk, x, lane);
                  LDS_WAIT();
                  f32x16 d = zero16();
                  d = __builtin_amdgcn_mfma_f32_32x32x16_bf16(*(const LAS bf16x8*)(TILE(12) + (32 * blk + r) * RC_P + 32 * blk + 16 + 8 * h), *(const LAS bf16x8*)(TILE(2) + (32 * blk + r) * RC_P + 16 + 8 * h), d, 0, 0, 0);
                  if (r < 16) {
#pragma unroll
                      for (int i = 8; i < 16; ++i) TILE(12)[(32 * blk + crow16(i, h)) * RC_P + 32 * blk + r] = f2bf(d[i]);
                      { u32x2 y0, y1; y0.x = pk2(d[8], d[9]); y0.y = pk2(d[10], d[11]); y1.x = pk2(d[12], d[13]); y1.y = pk2(d[14], d[15]);
                        *(LAS u32x2*)(TILE(0) + (32 * blk + r) * RC_P + 32 * blk + 16 + 4 * h) = y0; *(LAS u32x2*)(TILE(0) + (32 * blk + r) * RC_P + 32 * blk + 24 + 4 * h) = y1; } }
                  LDS_WAIT(); } }
            LDS_WAIT();
            f32x16 m1 = mm_blk(TILE(8), 1, TILE(0), 0, 0, 2, lane, zero16());
            st_tile_T(TILE(2), 0, 0, m1, lane);
            LDS_WAIT();
            { const int r = lane & 31, h = lane >> 5; f32x16 d = zero16();
#pragma unroll
              for (int q = 0; q < 2; ++q) { const bf16x8 a = *(const LAS bf16x8*)(TILE(2) + r * RC_P + 16 * q + 8 * h), bb = *(const LAS bf16x8*)(TILE(12) + (32 + r) * RC_P + 32 + 16 * q + 8 * h);
                  d = __builtin_amdgcn_mfma_f32_32x32x16_bf16(a, bb, d, 0, 0, 0); }
#pragma unroll
              for (int g = 0; g < 4; ++g) { u32x2 x; x.x = pk2(d[4 * g], d[4 * g + 1]); x.y = pk2(d[4 * g + 2], d[4 * g + 3]); *(LAS u32x2*)(TILE(12) + (32 + r) * RC_P + 8 * g + 4 * h) = x; } }
        } else if (w <= 4) {
            const int mb = (w - 1) >> 1, nb = (w - 1) & 1;
            const f32x16 u = mm_blk(TILE(9), mb, TILE(7), nb, 0, 4, lane, zero16());
            st_tile_T(TILE(3), mb, nb, u, lane);
        }
        LDS_BARRIER();
        { const int mb = (w >> 1) & 1, nb = w & 1;
          if (w < 4) { const f32x16 d = mm_blk(TILE(12), mb, TILE(4), nb, 0, 4, lane, zero16()); st_tile_T(TILE(2), mb, nb, d, lane); }
          else { const f32x16 d = mm_blk(TILE(12), mb, TILE(3), nb, 0, 4, lane, zero16()); st_tile_T(TILE(0), mb, nb, d, lane); } }
        LDS_BARRIER();
        const int mb = (w >> 1) & 1, nb = w & 1, r = lane & 31, h = lane >> 5;
        f32x16 cin;
        if (w < 4) {
            f32x16 d = mm_blk(TILE(2), mb, TILE(5), nb, 0, 4, lane, zero16());
#pragma unroll
            for (int i = 0; i < 16; ++i) { const int m = mb * 32 + crow16(i, h), n = nb * 32 + r; d[i] = (d[i] + (m == n ? 1.f : 0.f)) * EC[n]; }
            st_tile_T(TILE(8), mb, nb, d, lane);
            cin = mm_blk(TILE(5), mb, TILE(0), nb, 0, 4, lane, zero16()); cin = mm_blk(TILE(6), mb, TILE(7), nb, 0, 4, lane, cin);
#pragma unroll
            for (int i = 0; i < 16; ++i) cin[i] *= EC[mb * 32 + crow16(i, h)];
        } else {
            f32x16 d = mm_blk(TILE(2), mb, TILE(10), nb, 0, 4, lane, zero16());
#pragma unroll
            for (int i = 0; i < 16; ++i) { const int m = mb * 32 + crow16(i, h), n = nb * 32 + r; d[i] += bf2f(TILE(1)[n * RC_P + m]); }
            st_tile_T(TILE(9), mb, nb, d, lane);
            cin = mm_blk(TILE(10), mb, TILE(0), nb, 0, 4, lane, zero16()); cin = mm_blk(TILE(11), mb, TILE(7), nb, 0, 4, lane, cin);
        }
        LDS_BARRIER();
        if (w < 4) cin = mm_blk(TILE(8), mb, ST, nb, 0, 4, lane, cin);
        else { cin = mm_blk(TILE(9), mb, ST, nb, 0, 4, lane, cin);
#pragma unroll
            for (int i = 0; i < 16; ++i) { const int p = chain_pos(dir, 64 * c + mb * 32 + crow16(i, h)); Yg[(size_t)p * 512 + nb * 32 + r] = f2bf(cin[i]); } }
        LDS_BARRIER();
        if (w < 4) st_tile_T(ST, mb, nb, cin, lane);
    }
#undef RC_LOAD
#undef TILE
}
constexpr int RT_QP = 72, RT_TP = 136;
constexpr int RT_QS = 0, RT_KS = 128 * RT_QP * 2, RT_KT = 2 * 128 * RT_QP * 2, RT_VT = RT_KT + 64 * RT_TP * 2, RT_ST = RT_VT + 128 * RT_TP * 2;
DI void phase_retention_item(Frame& F, const KA& a, int item) {
    const int b = item >> 2, hh = item & 3, w = F.wave;
    const bf16* P = (const bf16*)(F.ws + WS_P); const float2* rt = (const float2*)(F.ws + WS_ROPE);
    bf16* OFB = (bf16*)(F.ws + WS_OF); const size_t TS = (size_t)NT * 512;
    LAS bf16* Qs = (LAS bf16*)(F.lds + RT_QS); LAS bf16* Ks = (LAS bf16*)(F.lds + RT_KS); LAS bf16* KsT = (LAS bf16*)(F.lds + RT_KT); LAS bf16* VsT = (LAS bf16*)(F.lds + RT_VT); LAS bf16* SsT = (LAS bf16*)(F.lds + RT_ST);
    const float lg2g = log2f(1.f - exp2f(-5.f - (float)hh));
    const float gam = exp2f(lg2g), g127 = exp2f(127.f * lg2g), cdec = exp2f(128.f * lg2g);
    const int rb = w >> 1, cbp = w & 1, db = w >> 2, vb = w & 3;
    for (int dir = 0; dir < 2; ++dir) {
        const int lane = fresh_lane(); const int tid = w * 64 + lane, ql = lane & 31, h = lane >> 5;
        f32x16 Sreg;
#pragma unroll
        for (int i = 0; i < 16; ++i) Sreg[i] = 0.f;
        __syncthreads();
        for (int i = tid; i < 128 * RT_QP / 2; i += NTHREADS) ((LAS unsigned*)SsT)[i] = 0u;
        for (int cn = 0; cn < 34; ++cn) {
            int p0; if (cn < 2) p0 = 128 * (dir ? 1 - cn : cn); else p0 = CTX + 128 * (dir ? 33 - cn : cn - 2);
            const bool lat = p0 >= CTX;
            { int tid_o = tid; asm volatile("" : "+v"(tid_o)); const int tok = tid_o >> 2, c = tid_o & 3; const int e = dir ? 127 - tok : tok; const size_t row = (size_t)b * LTOT + p0 + tok; const bf16* prow = P + row * DINP;
              const float sq = exp2f((float)e * lg2g), sk = 0.125f * exp2f(-(float)e * lg2g);
              const u32x4 ql_ = *(const u32x4*)(prow + PC_RQ + hh * 64 + 8 * c), qh_ = *(const u32x4*)(prow + PC_RQ + hh * 64 + 32 + 8 * c);
              const u32x4 kl_ = *(const u32x4*)(prow + PC_RK + hh * 64 + 8 * c), kh_ = *(const u32x4*)(prow + PC_RK + hh * 64 + 32 + 8 * c);
              float qlo[8] = {bflo(ql_.x), bfhi(ql_.x), bflo(ql_.y), bfhi(ql_.y), bflo(ql_.z), bfhi(ql_.z), bflo(ql_.w), bfhi(ql_.w)}, qhi[8] = {bflo(qh_.x), bfhi(qh_.x), bflo(qh_.y), bfhi(qh_.y), bflo(qh_.z), bfhi(qh_.z), bflo(qh_.w), bfhi(qh_.w)};
              float klo[8] = {bflo(kl_.x), bfhi(kl_.x), bflo(kl_.y), bfhi(kl_.y), bflo(kl_.z), bfhi(kl_.z), bflo(kl_.w), bfhi(kl_.w)}, khi[8] = {bflo(kh_.x), bfhi(kh_.x), bflo(kh_.y), bfhi(kh_.y), bflo(kh_.z), bfhi(kh_.z), bflo(kh_.w), bfhi(kh_.w)};
              if (lat) { const float2* ang = rt + (size_t)(p0 - CTX + tok) * 32 + 8 * c;
#pragma unroll
                  for (int j = 0; j < 8; ++j) { const float2 cs = ang[j]; const float a0 = qlo[j], a1 = qhi[j], b0 = klo[j], b1 = khi[j];
                      qlo[j] = a0 * cs.x - a1 * cs.y; qhi[j] = a0 * cs.y + a1 * cs.x; klo[j] = b0 * cs.x - b1 * cs.y; khi[j] = b0 * cs.y + b1 * cs.x; } }
#pragma unroll
              for (int j = 0; j < 8; ++j) { qlo[j] *= sq; qhi[j] *= sq; klo[j] *= sk; khi[j] *= sk; }
              *(LAS bf16x8*)(Qs + tok * RT_QP + 8 * c) = pack8(qlo); *(LAS bf16x8*)(Qs + tok * RT_QP + 32 + 8 * c) = pack8(qhi);
              *(LAS bf16x8*)(Ks + tok * RT_QP + 8 * c) = pack8(klo); *(LAS bf16x8*)(Ks + tok * RT_QP + 32 + 8 * c) = pack8(khi);
              const int pt = permpos(tok);
#pragma unroll
              for (int j = 0; j < 8; ++j) { KsT[(8 * c + j) * RT_TP + pt] = f2bf(klo[j]); KsT[(32 + 8 * c + j) * RT_TP + pt] = f2bf(khi[j]); }
#pragma unroll
              for (int q4 = 0; q4 < 4; ++q4) { const u32x4 vv = *(const u32x4*)(prow + PC_RV + hh * 128 + 32 * c + 8 * q4); const unsigned vw[4] = {vv.x, vv.y, vv.z, vv.w};
#pragma unroll
                  for (int j = 0; j < 4; ++j) { VsT[(32 * c + 8 * q4 + 2 * j) * RT_TP + pt] = (bf16)(vw[j] & 0xffffu); VsT[(32 * c + 8 * q4 + 2 * j + 1) * RT_TP + pt] = (bf16)(vw[j] >> 16); } } }
            __syncthreads();
            f32x16 o0, o1;
#pragma unroll
            for (int i = 0; i < 16; ++i) { o0[i] = 0.f; o1[i] = 0.f; }
            for (int kb = 0; kb < 4; ++kb) {
                if (dir == 0 ? kb > rb : kb < rb) continue;
                f32x16 x;
#pragma unroll
                for (int i = 0; i < 16; ++i) x[i] = 0.f;
#pragma unroll
                for (int s = 0; s < 4; ++s) x = __builtin_amdgcn_mfma_f32_32x32x16_bf16(*(const LAS bf16x8*)(Ks + (kb * 32 + ql) * RT_QP + 16 * s + 8 * h), *(const LAS bf16x8*)(Qs + (rb * 32 + ql) * RT_QP + 16 * s + 8 * h), x, 0, 0, 0);
                if (kb == rb) {
#pragma unroll
                    for (int i = 0; i < 16; ++i) { const int key = crow16(i, h); const bool keep = dir == 0 ? key <= ql : key >= ql; x[i] = keep ? x[i] : 0.f; } }
                float xv[16];
#pragma unroll
                for (int i = 0; i < 16; ++i) xv[i] = x[i];
                const bf16x8 xa0 = pack8(xv), xa1 = pack8(xv + 8);
                const LAS bf16* v0 = VsT + ((2 * cbp) * 32 + ql) * RT_TP + kb * 32 + 8 * h; const LAS bf16* v1 = VsT + ((2 * cbp + 1) * 32 + ql) * RT_TP + kb * 32 + 8 * h;
                o0 = __builtin_amdgcn_mfma_f32_32x32x16_bf16(xa0, *(const LAS bf16x8*)(v0), o0, 0, 0, 0); o0 = __builtin_amdgcn_mfma_f32_32x32x16_bf16(xa1, *(const LAS bf16x8*)(v0 + 16), o0, 0, 0, 0);
                o1 = __builtin_amdgcn_mfma_f32_32x32x16_bf16(xa0, *(const LAS bf16x8*)(v1), o1, 0, 0, 0); o1 = __builtin_amdgcn_mfma_f32_32x32x16_bf16(xa1, *(const LAS bf16x8*)(v1 + 16), o1, 0, 0, 0);
            }
#pragma unroll
            for (int s = 0; s < 4; ++s) { const bf16x8 qa = *(const LAS bf16x8*)(Qs + (rb * 32 + ql) * RT_QP + 16 * s + 8 * h);
                o0 = __builtin_amdgcn_mfma_f32_32x32x16_bf16(qa, *(const LAS bf16x8*)(SsT + ((2 * cbp) * 32 + ql) * RT_QP + 16 * s + 8 * h), o0, 0, 0, 0);
                o1 = __builtin_amdgcn_mfma_f32_32x32x16_bf16(qa, *(const LAS bf16x8*)(SsT + ((2 * cbp + 1) * 32 + ql) * RT_QP + 16 * s + 8 * h), o1, 0, 0, 0); }
            { bf16* op = OFB + (size_t)dir * TS + ((size_t)b * LTOT + p0 + rb * 32) * 512 + hh * 128 + (2 * cbp) * 32 + ql;
#pragma unroll
              for (int i = 0; i < 16; ++i) { op[(size_t)crow16(i, h) * 512] = f2bf(o0[i]); op[(size_t)crow16(i, h) * 512 + 32] = f2bf(o1[i]); } }
            f32x16 u;
#pragma unroll
            for (int i = 0; i < 16; ++i) u[i] = 0.f;
#pragma unroll
            for (int s = 0; s < 8; ++s) u = __builtin_amdgcn_mfma_f32_32x32x16_bf16(*(const LAS bf16x8*)(KsT + (db * 32 + ql) * RT_TP + 16 * s + 8 * h), *(const LAS bf16x8*)(VsT + (vb * 32 + ql) * RT_TP + 16 * s + 8 * h), u, 0, 0, 0);
#pragma unroll
            for (int i = 0; i < 16; ++i) Sreg[i] = cdec * Sreg[i] + g127 * u[i];
            __syncthreads();
#pragma unroll
            for (int g = 0; g < 4; ++g) { u32x2 x; x.x = pk2(gam * Sreg[4 * g], gam * Sreg[4 * g + 1]); x.y = pk2(gam * Sreg[4 * g + 2], gam * Sreg[4 * g + 3]);
                *(LAS u32x2*)(SsT + (vb * 32 + ql) * RT_QP + db * 32 + 8 * g + 4 * h) = x; }
        }
    }
}

DI void phase_mixer_finish(Frame& F, const KA& a, int l) {
    const int lane = fresh_lane(), gw = F.bid * NWAVES + F.wave, NGW = F.G * NWAVES;
    const size_t TS = (size_t)NT * 512;
    const bf16* P = (const bf16*)(F.ws + WS_P); const bf16* OFB = (const bf16*)(F.ws + WS_OF); const bf16* YF = (const bf16*)(F.ws + WS_YF); const bf16* RW = (const bf16*)(F.ws + WS_RW);
    bf16* O0 = (bf16*)(F.ws + WS_ABR); bf16* O2 = O0 + 2 * TS;
    const float* lng = a.in(I_LNXG) + l * 512 + 8 * lane; const float* lnb = a.in(I_LNXB) + l * 512 + 8 * lane; const float* rkw = a.in(I_RK) + l * 512 + 8 * lane;
    float g_[8], b_[8], rk_[8];
    { const f32x4 x0 = *(const f32x4*)lng, x1 = *(const f32x4*)(lng + 4), y0 = *(const f32x4*)lnb, y1 = *(const f32x4*)(lnb + 4), z0 = *(const f32x4*)rkw, z1 = *(const f32x4*)(rkw + 4);
      g_[0] = x0.x; g_[1] = x0.y; g_[2] = x0.z; g_[3] = x0.w; g_[4] = x1.x; g_[5] = x1.y; g_[6] = x1.z; g_[7] = x1.w;
      b_[0] = y0.x; b_[1] = y0.y; b_[2] = y0.z; b_[3] = y0.w; b_[4] = y1.x; b_[5] = y1.y; b_[6] = y1.z; b_[7] = y1.w;
      rk_[0] = z0.x; rk_[1] = z0.y; rk_[2] = z0.z; rk_[3] = z0.w; rk_[4] = z1.x; rk_[5] = z1.y; rk_[6] = z1.z; rk_[7] = z1.w; }
#pragma unroll 1
    for (int r0 = gw; r0 < NT; r0 += 2 * NGW) {
        u32x4 uyf[2], uyb[2], ur[2], ukf[2], ukb[2], uv[2], ug[2], uof[2], uob[2], ugf[2], ugb[2]; size_t oo[2]; bool act[2];
#pragma unroll
        for (int u = 0; u < 2; ++u) { int r = r0 + u * NGW; act[u] = r < NT; if (!act[u]) r = r0; const size_t o = (size_t)r * 512 + 8 * lane; oo[u] = o;
            uyf[u] = *(const u32x4*)(YF + o); uyb[u] = *(const u32x4*)(YF + TS + o); ur[u] = *(const u32x4*)(RW + o); ukf[u] = *(const u32x4*)(RW + TS + o); ukb[u] = *(const u32x4*)(RW + 2 * TS + o);
            uv[u] = *(const u32x4*)(RW + 3 * TS + o); ug[u] = *(const u32x4*)(RW + 7 * TS + o); uof[u] = *(const u32x4*)(OFB + o); uob[u] = *(const u32x4*)(OFB + TS + o);
            ugf[u] = *(const u32x4*)(P + (size_t)r * DINP + PC_RGF + 8 * lane); ugb[u] = *(const u32x4*)(P + (size_t)r * DINP + PC_RGB + 8 * lane); }
        __builtin_amdgcn_sched_barrier(0);
#pragma unroll
        for (int u = 0; u < 2; ++u) { if (!act[u]) continue; const size_t o = oo[u];
            { float yfv[8], ybv[8], s[8]; unpack8(uyf[u], yfv); unpack8(uyb[u], ybv);
#pragma unroll
              for (int j = 0; j < 8; ++j) s[j] = yfv[j] + ybv[j];
              float rr[8], kf[8], kb[8], vv[8], gg[8]; unpack8(ur[u], rr); unpack8(ukf[u], kf); unpack8(ukb[u], kb); unpack8(uv[u], vv); unpack8(ug[u], gg);
              float sm = 0.f, bn = 0.f;
#pragma unroll
              for (int j = 0; j < 8; ++j) { sm += s[j]; bn += rr[j] * (kf[j] + kb[j]) * rk_[j]; }
              sm += sx(sm, 1); sm += sx(sm, 2); sm += sx(sm, 4); bn += sx(bn, 1); bn += sx(bn, 2); bn += sx(bn, 4);
              const float mean = sm * (1.f / 64.f); float vs = 0.f;
#pragma unroll
              for (int j = 0; j < 8; ++j) { s[j] -= mean; vs += s[j] * s[j]; }
              vs += sx(vs, 1); vs += sx(vs, 2); vs += sx(vs, 4);
              const float rstd = rsqrtf(vs * (1.f / 64.f) + 64e-5f);
              float y[8];
#pragma unroll
              for (int j = 0; j < 8; ++j) y[j] = (s[j] * rstd * g_[j] + b_[j] + bn * vv[j]) * gg[j];
              *(bf16x8*)(O2 + o) = pack8(y); }
            { float ff[8], bb[8], gf[8], gb[8]; unpack8(uof[u], ff); unpack8(uob[u], bb); unpack8(ugf[u], gf); unpack8(ugb[u], gb);
              float sf = 0.f, sb = 0.f;
#pragma unroll
              for (int j = 0; j < 8; ++j) { sf += ff[j]; sb += bb[j]; }
#pragma unroll
              for (int o2 = 1; o2 < 16; o2 <<= 1) { sf += sx(sf, o2); sb += sx(sb, o2); }
              const float mf = sf * (1.f / 128.f), mb = sb * (1.f / 128.f); float vf = 0.f, vb = 0.f;
#pragma unroll
              for (int j = 0; j < 8; ++j) { ff[j] -= mf; bb[j] -= mb; vf += ff[j] * ff[j]; vb += bb[j] * bb[j]; }
#pragma unroll
              for (int o2 = 1; o2 < 16; o2 <<= 1) { vf += sx(vf, o2); vb += sx(vb, o2); }
              const float rf = rsqrtf(vf * (1.f / 128.f) + 1e-5f), rb = rsqrtf(vb * (1.f / 128.f) + 1e-5f);
              float y[8];
#pragma unroll
              for (int j = 0; j < 8; ++j) y[j] = ff[j] * rf * (gf[j] * sigmoidf_(gf[j])) + bb[j] * rb * (gb[j] * sigmoidf_(gb[j]));
              *(bf16x8*)(O0 + o) = pack8(y); } }
    }
}

constexpr int N_PHASES = 2 + 10 * DEPTH;
__global__ void __launch_bounds__(NTHREADS, 2) fwd_kernel(Args args) {
    extern __shared__ __attribute__((aligned(16))) unsigned char lds_raw[];
    Frame F;
    F.lds = (LAS unsigned char*)lds_raw;
    F.MISC = (volatile LAS unsigned*)(F.lds + LDS_MISC_OFF);
    F.tid = threadIdx.x; F.lane = F.tid & 63; F.wave = __builtin_amdgcn_readfirstlane(F.tid >> 6);
    F.G = gridDim.x; F.bid = blockIdx.x;
    F.ws = args.ws; F.ctl = (unsigned*)(args.ws + WS_CTL);
    if (F.tid < 32) F.MISC[F.tid] = 0u;
    __syncthreads();
    const int lo = args.ph_lo, hi = args.ph_hi;
    KA ka; ka.kp = (const CAS char*)__builtin_amdgcn_kernarg_segment_ptr();
    const bool multi = (hi - lo) > 1;
    XcdBarrier bar; bar.bar = F.ctl + CW_BAR; bar.x = 0; bar.st = nullptr;
    if (multi) bar = xcd_barrier_post(F.ctl + CW_BAR, F.MISC + 8);
#define IN(k) (lo <= (k) && (k) < hi)
#define OPQ() do { int l_; asm volatile("v_mbcnt_lo_u32_b32 %0, -1, 0\n\tv_mbcnt_hi_u32_b32 %0, -1, %0" : "=v"(l_)); { int b_ = F.bid, w_ = F.wave, g_ = F.G; asm volatile("" : "+s"(b_), "+s"(w_), "+s"(g_)); F.bid = b_; F.wave = w_; F.G = g_; } F.lane = l_; F.tid = F.wave * 64 + l_; \
        const CAS char* kp_ = (const CAS char*)__builtin_amdgcn_kernarg_segment_ptr(); asm volatile("" : "+s"(kp_)); ka.kp = kp_; F.ws = ka.ws(); F.ctl = (unsigned*)(F.ws + WS_CTL); } while (0)
#define SEAM(k) do { if (IN(k) && IN((k) + 1)) xcd_barrier(bar); } while (0)

    if (IN(0)) { OPQ(); phase_prologue(F, ka); } SEAM(0);
    if (IN(1)) { OPQ(); phase_init_rows(F, ka); } SEAM(1);

    for (int l = 0; l < DEPTH; ++l) {
        const int pb = 2 + 10 * l;
        if (IN(pb + 0)) { OPQ(); unsigned char* ws = F.ws;
            SchedInproj S; S.T.init(NT / 256, DINP / 256, F.G, F.bid); S.A = (const char*)(ws + WS_H); S.B = (const char*)(ws + WS_WIN + (size_t)l * 15 * MiB);
            EpiStoreBf16 E{(bf16*)(ws + WS_P), DINP};
            pg8::gemm_phase<EpiStoreBf16, SchedInproj, false>(F.lds, 1024, S, E, F.tid);
        }
        SEAM(pb + 0);
        if (IN(pb + 1)) { OPQ(); phase_mla_prep2(F, ka, l); OPQ(); phase_rwkv_prep2(F, ka, l); }
        SEAM(pb + 1);
#define ATTN_QUEUE(qword, ubeg, uend) do { const int xq_ = F.bid & 7; for (;;) { __syncthreads(); \
            if (F.wave == 0 && fresh_lane() == 0) F.MISC[0] = (unsigned)(ubeg) + __hip_atomic_fetch_add(F.ctl + (qword) + xq_, 1u, __ATOMIC_RELAXED, __HIP_MEMORY_SCOPE_AGENT); \
            __syncthreads(); const int u = (int)F.MISC[0]; if (u >= (uend)) break; \
            if (u < 128) attn_unit(F, u >> 4, xq_, 1 + (u & 15)); else attn_unit(F, u - 128, xq_, 0); } } while (0)
        const int nunits = (l == DEPTH - 1) ? 128 : 136;
        if (IN(pb + 2)) { OPQ();
            if (F.bid < NCHAIN) rwkv_chain_block(F, F.bid);
            else if (F.bid < NCHAIN + 32) phase_retention_item(F, ka, F.bid - NCHAIN);
            OPQ(); ATTN_QUEUE(CW_Q + l * 64, 0, nunits);
        }
        SEAM(pb + 2);
        if (IN(pb + 3)) { OPQ(); phase_mixer_finish(F, ka, l); }
        SEAM(pb + 3);
        if (IN(pb + 4)) { OPQ(); unsigned char* ws = F.ws;
            SchedMerge S; S.T.init(NT / 256, 4, F.G, F.bid, l == DEPTH - 1); S.A = (const char*)(ws + WS_ABR); S.B = (const char*)(ws + WS_WBR + (size_t)l * 3 * MiB);
            EpiMerge E{(const bf16*)(ws + WS_P), (bf16*)(ws + WS_MRG)};
            pg8::gemm_phase<EpiMerge, SchedMerge, false>(F.lds, 512, S, E, F.tid);
        }
        SEAM(pb + 4);
        if (IN(pb + 5)) { OPQ(); unsigned char* ws = F.ws;
            SchedPlain S; S.T.init(NT / 256, 4, F.G, F.bid, l == DEPTH - 1); S.A = (const char*)(ws + WS_MRG); S.B = (const char*)(ws + WS_WOUT + (size_t)l * 2 * MiB); S.K = 1024;
            EpiResid E{(float*)(ws + WS_X), (const float*)(ws + WS_MOD) + (size_t)l * 9 * 6144};
            pg8::gemm_phase<EpiResid, SchedPlain, false>(F.lds, 1024, S, E, F.tid);
        }
        SEAM(pb + 5);
        if (IN(pb + 6)) { OPQ(); phase_router(F, ka, l); }
        SEAM(pb + 6);
        if (IN(pb + 7)) { OPQ(); unsigned char* ws = F.ws;
            moe_build_table(F, F.ctl + CW_CNT + l * 32 * 16);
            SchedMoe S{(const LAS int*)(F.lds + LDS_TAB_OFF), (const char*)(ws + WS_H), (const char*)(ws + WS_WGU + (size_t)l * 128 * MiB), (const int*)(ws + WS_LIST), 8, F.bid, F.G, 0, (size_t)2048 * 1024 * 2, true};
            EpiSwiglu E{(bf16*)(ws + WS_ACT), ka.in(I_BGU) + (size_t)l * 32 * 2048};
            pg8::gemm_phase<EpiSwiglu, SchedMoe, true>(F.lds, 1024, S, E, F.tid);
        }
        SEAM(pb + 7);
        if (IN(pb + 8)) { OPQ(); unsigned char* ws = F.ws;
            moe_build_table(F, F.ctl + CW_CNT + l * 32 * 16);
            SchedMoe S{(const LAS int*)(F.lds + LDS_TAB_OFF), (const char*)(ws + WS_ACT), (const char*)(ws + WS_WDN + (size_t)l * 64 * MiB), (const int*)(ws + WS_LIST), 4, F.bid, F.G, 0, (size_t)1024 * 1024 * 2, false};
            EpiDown E{(bf16*)(ws + WS_Y), ka.in(I_BDOWN) + (size_t)l * 32 * 1024};
            pg8::gemm_phase<EpiDown, SchedMoe, false>(F.lds, 1024, S, E, F.tid);
        }
        SEAM(pb + 8);
        if (IN(pb + 9)) { OPQ(); phase_combine(F, ka, l); }
        SEAM(pb + 9);

    }
#undef IN
#undef SEAM
}

extern "C" void kernel_launch(void* const* d_in, const int* in_sizes, int n_in, void* d_out, int out_size, void* d_ws, size_t ws_size, hipStream_t stream) {
    static int grid = 0;
    if (grid == 0) {
        if (n_in != N_IN || ws_size < WS_END) { fprintf(stderr, "kernel_launch: unexpected n_in %d or ws_size %zu (need %zu)\n", n_in, ws_size, (size_t)WS_END); grid = -1; return; }
        int dev = 0, cus = 0, per_cu = 0;
        hipGetDevice(&dev); hipDeviceGetAttribute(&cus, hipDeviceAttributeMultiprocessorCount, dev);
        if (hipFuncSetAttribute((const void*)fwd_kernel, hipFuncAttributeMaxDynamicSharedMemorySize, LDS_BYTES) != hipSuccess) { fprintf(stderr, "kernel_launch: hipFuncSetAttribute failed\n"); grid = -1; return; }
        if (hipOccupancyMaxActiveBlocksPerMultiprocessor(&per_cu, (const void*)fwd_kernel, NTHREADS, LDS_BYTES) != hipSuccess || per_cu < 1) { fprintf(stderr, "kernel_launch: occupancy query says %d\n", per_cu); }
        (void)hipGetLastError();
        grid = cus > 0 ? cus : 256;
        if (grid > 256) grid = 256;
    }
    if (grid < 0) return;
    (void)in_sizes; (void)out_size;
    hipMemsetAsync((char*)d_ws + WS_CTL, 0, CTL_ZERO_BYTES, stream);
    Args a{};
    for (int i = 0; i < N_IN; ++i) a.in[i] = (const float*)d_in[i];
    a.out = (float*)d_out; a.ws = (unsigned char*)d_ws;
#if MK_ONE_LAUNCH
    a.ph_lo = 0; a.ph_hi = N_PHASES;
    hipLaunchKernelGGL(fwd_kernel, dim3(grid), dim3(NTHREADS), LDS_BYTES, stream, a);
#else
    for (int ph = 0; ph < N_PHASES; ++ph) { a.ph_lo = ph; a.ph_hi = ph + 1; hipLaunchKernelGGL(fwd_kernel, dim3(grid), dim3(NTHREADS), LDS_BYTES, stream, a); }
#endif
    hipError_t le = hipGetLastError();
    if (le != hipSuccess) fprintf(stderr, "kernel_launch: launch failed: %s\n", hipGetErrorName(le));
}
```

```cpp
#include <hip/hip_runtime.h>
#include <cstdio>
#include <cstdint>

#ifndef MK_ONE_LAUNCH
#define MK_ONE_LAUNCH 1
#endif

#define GAS __attribute__((address_space(1)))
#define LAS __attribute__((address_space(3)))
typedef unsigned short bf16;
typedef short bf16x8 __attribute__((ext_vector_type(8)));
typedef float f32x2 __attribute__((ext_vector_type(2)));
typedef float f32x4 __attribute__((ext_vector_type(4)));
typedef float f32x16 __attribute__((ext_vector_type(16)));
typedef unsigned u32x2 __attribute__((ext_vector_type(2)));
typedef unsigned u32x4 __attribute__((ext_vector_type(4)));
typedef __bf16 bf16v2 __attribute__((ext_vector_type(2)));
#define DI __device__ __forceinline__

constexpr int D = 1024, BATCH = 8, SEQ = 4096, CTX = 256, LTOT = SEQ + CTX  , NT = BATCH * LTOT  , DEPTH = 4;
constexpr int DIN = 7456, DINP = 7680;
constexpr int NEXP = 32, TOPK = 4, DEXP = 1024;
constexpr int NSLOT = NT * TOPK + NEXP * 256;
constexpr int PC_RQ = 0, PC_RK = 256, PC_RV = 512, PC_RGF = 1024, PC_RGB = 1536, PC_MQ = 2048, PC_MKV = 2304, PC_MPE = 2432,
              PC_RW = 2464, PC_WR = 2464, PC_WK = 2976, PC_WV = 3488, PC_WHF = 4000, PC_WHB = 4064, PC_AHF = 4128, PC_AHB = 4192, PC_GH = 4256, PC_GATE = 4384;
enum { I_X = 0, I_C, I_CTX, I_CCTX, I_ADAW, I_ADAB, I_N1G, I_N2G, I_WIN, I_MQNG, I_WUQ, I_MKVNG, I_WUKV, I_QKQG, I_QKKG, I_MUP, I_MUN, I_W0, I_W2, I_A0, I_A2, I_G2,
       I_KK, I_KA, I_RK, I_LNXG, I_LNXB, I_BRRET, I_BRMLA, I_BRRWKV, I_WOUT, I_WROUTER, I_BROUTER, I_WGU, I_BGU, I_WDOWN, I_BDOWN, N_IN };

constexpr size_t MiB = 1u << 20;
constexpr size_t WS_CTL = 0, CTL_ZERO_BYTES = 1 * MiB;
constexpr size_t WS_MOD = 1 * MiB;
constexpr size_t WS_ROPE = 2 * MiB;
constexpr size_t WS_ROPE_AX = 3 * MiB;
constexpr size_t WS_SMALLW = 4 * MiB;
constexpr size_t SW_UQ = 0, SW_UKV = 393216, SW_W2 = 655360, SW_A2 = 786432, SW_G2 = 917504;
constexpr size_t WS_WBR = 8 * MiB;
constexpr size_t WS_WOUT = 20 * MiB;
constexpr size_t WS_WIN = 28 * MiB;
constexpr size_t WS_WGU = 88 * MiB;
constexpr size_t WS_WDN = 600 * MiB;
constexpr size_t WS_X = 856 * MiB;
constexpr size_t WS_H = 992 * MiB;
constexpr size_t WS_P = 1062 * MiB;
constexpr size_t WS_QB = 1572 * MiB;
constexpr size_t WS_KB = 1623 * MiB;
constexpr size_t WS_VT = 1674 * MiB;
constexpr size_t WS_RW = 1708 * MiB;
constexpr size_t RW_STRIDE = (size_t)NT * 512 * 2;
constexpr size_t WS_LW = 1980 * MiB;
constexpr size_t WS_YF = 2116 * MiB;
constexpr size_t WS_OF = 2252 * MiB;
constexpr size_t WS_ABR = 2388 * MiB;
constexpr size_t WS_MRG = 2490 * MiB;
constexpr size_t WS_TOPK = 2558 * MiB;
constexpr size_t WS_LIST = 2560 * MiB;
constexpr size_t WS_ACT = 2565 * MiB;
constexpr size_t WS_Y = 2853 * MiB;
constexpr size_t WS_END = 3141 * MiB;
constexpr int CW_TMO = 0, CW_BAR = 4096, CW_CNT = 8192  , CW_Q = 12288  ;

DI unsigned pk2(float lo, float hi) { f32x2 v = {lo, hi}; bf16v2 r = __builtin_convertvector(v, bf16v2); return __builtin_bit_cast(unsigned, r); }
DI bf16 f2bf(float f) { return (bf16)(pk2(f, 0.f) & 0xffffu); }
DI float bf2f(unsigned short b) { return __uint_as_float(((unsigned)b) << 16); }
DI float bflo(unsigned w) { return __uint_as_float(w << 16); }
DI float bfhi(unsigned w) { return __uint_as_float(w & 0xffff0000u); }
DI int fresh_lane() { int l_; asm volatile("v_mbcnt_lo_u32_b32 %0, -1, 0\n\tv_mbcnt_hi_u32_b32 %0, -1, %0" : "=v"(l_)); return l_; }
DI bf16x8 pack8(const float* v) { u32x4 x; x.x = pk2(v[0], v[1]); x.y = pk2(v[2], v[3]); x.z = pk2(v[4], v[5]); x.w = pk2(v[6], v[7]); return __builtin_bit_cast(bf16x8, x); }
DI float sx(float v, int mask) { const int l = fresh_lane(); return __int_as_float(__builtin_amdgcn_ds_bpermute((l ^ mask) << 2, __float_as_int(v))); }
DI float sup(float v, int d) { const int l = fresh_lane(); return __int_as_float(__builtin_amdgcn_ds_bpermute((l - d) << 2, __float_as_int(v))); }
DI float dpp_scan64(float x) {
    float t;
    t = __int_as_float(__builtin_amdgcn_update_dpp(0, __float_as_int(x), 0x111, 0xf, 0xf, false)); x += t;
    t = __int_as_float(__builtin_amdgcn_update_dpp(0, __float_as_int(x), 0x112, 0xf, 0xf, false)); x += t;
    t = __int_as_float(__builtin_amdgcn_update_dpp(0, __float_as_int(x), 0x114, 0xf, 0xf, false)); x += t;
    t = __int_as_float(__builtin_amdgcn_update_dpp(0, __float_as_int(x), 0x118, 0xf, 0xf, false)); x += t;
    t = __int_as_float(__builtin_amdgcn_update_dpp(0, __float_as_int(x), 0x142, 0xa, 0xf, false)); x += t;
    t = __int_as_float(__builtin_amdgcn_update_dpp(0, __float_as_int(x), 0x143, 0xc, 0xf, false)); x += t;
    return x;
}
DI float wave_sum(float v) {
#pragma unroll
    for (int o = 1; o < 64; o <<= 1) v += sx(v, o);
    return v;
}
DI void unpack8(const u32x4& w, float* o) { o[0] = bflo(w.x); o[1] = bfhi(w.x); o[2] = bflo(w.y); o[3] = bfhi(w.y); o[4] = bflo(w.z); o[5] = bfhi(w.z); o[6] = bflo(w.w); o[7] = bfhi(w.w); }
DI f32x16 zero16() { f32x16 z; for (int i = 0; i < 16; ++i) z[i] = 0.f; return z; }
DI float sigmoidf_(float x) { return __builtin_amdgcn_rcpf(1.f + __expf(-x)); }
#define LDS_WAIT() asm volatile("s_waitcnt lgkmcnt(0)" ::: "memory")
#define VM_WAIT() asm volatile("s_waitcnt vmcnt(0)" ::: "memory")
#define LDS_BARRIER() do { asm volatile("s_waitcnt lgkmcnt(0)" ::: "memory"); __builtin_amdgcn_s_barrier(); asm volatile("" ::: "memory"); } while (0)

#define XB_TMO      128
#define XB_XCNT(j)  (256  + 64 * (j))
#define XB_XSUB(j)  (1280 + 64 * (j))
#define XB_XGEN(j)  (2304 + 64 * (j))
#define XB_TOP      3328
#define XB_TOPGEN   3392
#define XCD_BAR_WORDS 3456
#define XB_SPIN_CAP (1u << 22)

__device__ __forceinline__ unsigned xb_ld(unsigned* p)              { return __hip_atomic_load(p, __ATOMIC_RELAXED, __HIP_MEMORY_SCOPE_AGENT); }
__device__ __forceinline__ unsigned xb_add(unsigned* p, unsigned v) { return __hip_atomic_fetch_add(p, v, __ATOMIC_RELAXED, __HIP_MEMORY_SCOPE_AGENT); }
__device__ __forceinline__ unsigned xb_xcc_id() { return (unsigned)__builtin_amdgcn_s_getreg((3 << 11) | 20) & 0xFu; }
#define XB_SPIN(cond, bar) do { unsigned _sp = 0; while (cond) { __builtin_amdgcn_s_sleep(1); \
    if ((++_sp & 255u) == 0u) { if (xb_ld(&(bar)[XB_TMO])) break; if (_sp > XB_SPIN_CAP) { atomicAdd(&(bar)[XB_TMO], 1u); break; } } } } while (0)

struct XcdBarrier { unsigned* bar; unsigned x; volatile LAS unsigned* st; };

__device__ __forceinline__ XcdBarrier xcd_barrier_post(unsigned* bar, volatile LAS unsigned* st) {
    XcdBarrier b; b.bar = bar; b.x = xb_xcc_id(); b.st = st;
    if (threadIdx.x == 0) (void)xb_add(&bar[XB_XCNT(b.x)], 1u);
    return b;
}
__device__ __forceinline__ void xcd_barrier_complete(unsigned* bar, unsigned x, unsigned& nloc, unsigned& nx) {
    const unsigned G = gridDim.x * gridDim.y * gridDim.z;
    unsigned sum, cnt, mine, sp = 0u;
    for (;;) {
        sum = 0u; cnt = 0u; mine = 0u;
#pragma unroll
        for (unsigned j = 0; j < 16; ++j) { const unsigned c = xb_ld(&bar[XB_XCNT(j)]); sum += c; cnt += (c > 0u) ? 1u : 0u; mine = (j == x) ? c : mine; }
        if (sum == G) break;
        __builtin_amdgcn_s_sleep(1);
        if ((++sp & 255u) == 0u) { if (xb_ld(&bar[XB_TMO])) break; if (sp > XB_SPIN_CAP) { atomicAdd(&bar[XB_TMO], 1u); break; } }
    }
    nloc = mine > 0u ? mine : 1u; nx = cnt > 0u ? cnt : 1u;
}
__device__ __forceinline__ void xcd_barrier(const XcdBarrier& b) {
    asm volatile("s_waitcnt vmcnt(0)" ::: "memory");
    __syncthreads();
    if (threadIdx.x == 0) {
        unsigned* bar = b.bar;
        __builtin_amdgcn_s_waitcnt(0);
        unsigned nloc = b.st[0], nx = b.st[1];
        if (nloc == 0u) { xcd_barrier_complete(bar, b.x, nloc, nx); b.st[0] = nloc; b.st[1] = nx; }
        const unsigned old = xb_add(&bar[XB_XSUB(b.x)], 1u);
        const unsigned gen = old / nloc;
        if (old + 1u == (gen + 1u) * nloc) {
            __builtin_amdgcn_fence(__ATOMIC_RELEASE, "agent");
            asm volatile("s_waitcnt vmcnt(0)" ::: "memory");
            const unsigned og = xb_add(&bar[XB_TOP], 1u);
            const unsigned tg = og / nx;
            if (og + 1u == (tg + 1u) * nx) xb_add(&bar[XB_TOPGEN], 1u);
            else XB_SPIN(xb_ld(&bar[XB_TOPGEN]) == tg, bar);
            __builtin_amdgcn_fence(__ATOMIC_ACQUIRE, "agent");
            xb_add(&bar[XB_XGEN(b.x)], 1u);
            asm volatile("s_waitcnt vmcnt(0)" ::: "memory");
        } else {
            XB_SPIN(xb_ld(&bar[XB_XGEN(b.x)]) == gen, bar);
            __builtin_amdgcn_fence(__ATOMIC_ACQUIRE, "agent");
            asm volatile("s_waitcnt vmcnt(0)" ::: "memory");
        }
    }
    __syncthreads();
}

namespace pg8 {
constexpr int BM = 256, BK = 64, HALF = 128, HTB = HALF * BK * 2, STAGE_BYTES = 8 * HTB;
__host__ __device__ __forceinline__ int lds_byte(int r, int c) { const int st = (r >> 4) * 2 + (c >> 5), rr = r & 15, cc = c & 31, ob = rr * 64 + cc * 2; return st * 1024 + (ob ^ (((ob >> 9) & 1) << 5)); }
__host__ __device__ __forceinline__ void stage_rc(int b, int& R, int& C) { const int st = b / 1024, sb = b % 1024, swz = sb ^ (((sb >> 9) & 1) << 5); R = (st >> 1) * 16 + swz / 64; C = (st & 1) * 32 + (swz % 64) / 2; }
__host__ __device__ __forceinline__ int perm32(int rho) { const int n = rho >> 4, i = rho & 15; return 8 * (i >> 2) + 4 * n + (i & 3); }

struct Unit { const char* pa; const char* pb; int x, y, z; };

struct TileOrder {
    int nM, nN, nwg, G, c; bool skipctx;
    DI void init(int nM_, int nN_, int G_, int c_, bool skipctx_ = false) { skipctx = skipctx_; nM = skipctx_ ? nM_ - BATCH : nM_; nN = nN_; nwg = nM * nN; G = G_; c = c_; }
    DI bool tile(int i, int& pm, int& pn) const {
        const long L = (long)i * G + c; if (L >= nwg) return false;
        int wgid = (int)L; { const int q = nwg / 8, r = nwg % 8, xcd = wgid % 8, off = wgid / 8; wgid = (xcd < r ? xcd * (q + 1) : r * (q + 1) + (xcd - r) * q) + off; }
        const int nig = 8 * nN, gid = wgid / nig, fm = gid * 8, gsz = (nM - fm) < 8 ? (nM - fm) : 8;
        pm = fm + ((wgid % nig) % gsz); pn = (wgid % nig) / gsz; if (skipctx) pm = pm + pm / 16 + 1; return true;
    }
};

DI unsigned cvt_pk_bf16(float lo, float hi) { return pk2(lo, hi); }

template <class Epi, class Sched, bool GATHER>
__device__ __forceinline__ void gemm_phase(LAS unsigned char* lds, const int K, const Sched& S, const Epi& E, const int tid) {
    const int wid = __builtin_amdgcn_readfirstlane(tid >> 6), lane = tid & 63, wr = wid >> 2, wc = wid & 3, fr = lane & 15, fq = lane >> 4;
    const int nt = K / BK;
    unsigned voffA[2], voffB[2]; int stR[2];
#pragma unroll
    for (int i = 0; i < 2; ++i) { int R, C; stage_rc(tid * 16 + i * 8192, R, C); const int Rb = Epi::PERM ? ((R & ~31) + perm32(R & 31)) : R;
        voffA[i] = GATHER ? (unsigned)(C * 2) : (unsigned)(R * K + C) * 2u; voffB[i] = (unsigned)(Rb * K + C) * 2u; stR[i] = R; }
    const size_t kstep = (size_t)(BK * 2);
    const size_t hstep = (size_t)HALF * K * 2;
    const unsigned ldsw = (unsigned)wid * 1024u;
    const int aoff = lds_byte(wr * 64 + fr, fq * 8), boff = lds_byte(wc * 32 + fr, fq * 8);
#define PG8_SA(b, h) (((b) * 2 + (h)) * HTB)
#define PG8_SB(b, h) ((4 + (b) * 2 + (h)) * HTB)
#define PG8_STAGE(bufoff, gbase, voff) do { _Pragma("unroll") for (int _i = 0; _i < 2; ++_i) \
        __builtin_amdgcn_global_load_lds((const unsigned*)((const char*)(gbase) + (voff)[_i]), (LAS unsigned*)(lds + (bufoff) + ldsw + _i * 8192), 16, 0, 0); } while (0)
#define PG8_STAGE_A(bufoff, gbase, h, rw) do { if constexpr (GATHER) { _Pragma("unroll") for (int _i = 0; _i < 2; ++_i) { \
            const unsigned _row = ((rw)[h] >> (16 * _i)) & 0xffffu; \
            __builtin_amdgcn_global_load_lds((const unsigned*)((const char*)(gbase) + (size_t)_row * (size_t)(K * 2) + voffA[_i]), (LAS unsigned*)(lds + (bufoff) + ldsw + _i * 8192), 16, 0, 0); } } \
        else { PG8_STAGE(bufoff, (const char*)(gbase) + (h) * hstep, voffA); } } while (0)
#define PG8_LDA(dst, b, h) do { _Pragma("unroll") for (int m = 0; m < 4; ++m) _Pragma("unroll") for (int k = 0; k < 2; ++k) dst[m][k] = *(const LAS bf16x8*)(lds + PG8_SA(b, h) + aoff + m * 2048 + k * 1024); } while (0)
#define PG8_LDB(dst, b, h) do { _Pragma("unroll") for (int n = 0; n < 2; ++n) _Pragma("unroll") for (int k = 0; k < 2; ++k) dst[n][k] = *(const LAS bf16x8*)(lds + PG8_SB(b, h) + boff + n * 2048 + k * 1024); } while (0)
#define PG8_MMA(ai, bj, At, Bt) do { __builtin_amdgcn_s_setprio(1); _Pragma("unroll") for (int m = 0; m < 4; ++m) _Pragma("unroll") for (int n = 0; n < 2; ++n) _Pragma("unroll") for (int k = 0; k < 2; ++k) \
        acc[ai][bj][m][n] = __builtin_amdgcn_mfma_f32_16x16x32_bf16(Bt[n][k], At[m][k], acc[ai][bj][m][n], 0, 0, 0); __builtin_amdgcn_s_setprio(0); } while (0)
#define PG8_WAIT_V(n) asm volatile("s_waitcnt vmcnt(" #n ")" ::: "memory")
#define PG8_WAIT_L(n) asm volatile("s_waitcnt lgkmcnt(" #n ")" ::: "memory")
#define PG8_BAR __builtin_amdgcn_s_barrier()
#define PG8_SCHED __builtin_amdgcn_sched_barrier(0)
    Unit cur, nxt; int ui = 0;
    if (!S.next(0, cur)) return;
    f32x4 acc[2][2][4][2];
#pragma unroll
    for (int a = 0; a < 2; ++a)
#pragma unroll
        for (int b = 0; b < 2; ++b)
#pragma unroll
            for (int m = 0; m < 4; ++m)
#pragma unroll
                for (int n = 0; n < 2; ++n) acc[a][b][m][n] = (f32x4){0.f, 0.f, 0.f, 0.f};
    bf16x8 At[4][2], B0[2][2], B1[2][2];
    const char* cA = cur.pa; const char* cB = cur.pb;
    unsigned rwc[2] = {0u, 0u}, rwn[2] = {0u, 0u};
    if constexpr (GATHER) S.rows(cur, stR[0], stR[1], rwc);
    PG8_STAGE(PG8_SB(0, 0), cB, voffB); PG8_STAGE(PG8_SB(0, 1), cB + hstep, voffB); PG8_STAGE_A(PG8_SA(0, 0), cA, 0, rwc); PG8_STAGE_A(PG8_SA(0, 1), cA, 1, rwc);
    if (wr == 1) PG8_BAR;
    PG8_WAIT_V(2); PG8_BAR;
    PG8_STAGE(PG8_SB(1, 0), cB + kstep, voffB); PG8_STAGE_A(PG8_SA(1, 0), cA + kstep, 0, rwc); PG8_STAGE(PG8_SB(1, 1), cB + hstep + kstep, voffB);
    PG8_WAIT_V(6); PG8_BAR;
    for (;;) {
        const bool has_next = S.next(ui + 1, nxt);
        const char* nA = has_next ? nxt.pa : cA; const char* nB = has_next ? nxt.pb : cB;
        if constexpr (GATHER) { if (has_next) S.rows(nxt, stR[0], stR[1], rwn); else { rwn[0] = rwc[0]; rwn[1] = rwc[1]; } }
        for (int t = 0; t < nt; t += 2) {
            const bool last = (t == nt - 2);
            const char* a1 = cA + (size_t)(t + 1) * kstep;
            const char* a2 = last ? nA : cA + (size_t)(t + 2) * kstep; const char* b2 = last ? nB : cB + (size_t)(t + 2) * kstep;
            const char* a3 = a2 + kstep; const char* b3 = b2 + kstep;
            unsigned rw2[2]; rw2[0] = last ? rwn[0] : rwc[0]; rw2[1] = last ? rwn[1] : rwc[1];
            PG8_LDB(B0, 0, 0); PG8_LDB(B1, 0, 1); PG8_SCHED; PG8_LDA(At, 0, 0); PG8_STAGE_A(PG8_SA(1, 1), a1, 1, rwc);
            PG8_WAIT_V(8); PG8_WAIT_L(0); PG8_BAR; PG8_MMA(0, 0, At, B0); PG8_MMA(0, 1, At, B1); PG8_BAR; PG8_SCHED;
            PG8_LDA(At, 0, 1); PG8_STAGE(PG8_SB(0, 0), b2, voffB); PG8_STAGE(PG8_SB(0, 1), b2 + hstep, voffB); PG8_STAGE_A(PG8_SA(0, 0), a2, 0, rw2);
            PG8_WAIT_V(8); PG8_WAIT_L(0); PG8_BAR; PG8_MMA(1, 0, At, B0); PG8_MMA(1, 1, At, B1); PG8_BAR; PG8_SCHED;
            PG8_LDB(B0, 1, 0); PG8_LDB(B1, 1, 1); PG8_SCHED; PG8_LDA(At, 1, 0); PG8_STAGE_A(PG8_SA(0, 1), a2, 1, rw2);
            PG8_WAIT_V(8); PG8_WAIT_L(0); PG8_BAR; PG8_MMA(0, 0, At, B0); PG8_MMA(0, 1, At, B1); PG8_BAR; PG8_SCHED;
            PG8_LDA(At, 1, 1); PG8_STAGE(PG8_SB(1, 0), b3, voffB); PG8_STAGE(PG8_SB(1, 1), b3 + hstep, voffB); PG8_STAGE_A(PG8_SA(1, 0), a3, 0, rw2);
            PG8_WAIT_V(8); PG8_WAIT_L(0); PG8_BAR; PG8_MMA(1, 0, At, B0); PG8_MMA(1, 1, At, B1); PG8_BAR; PG8_SCHED;
        }
        if (wr == 0) PG8_BAR;
        { int l2_; asm volatile("v_mbcnt_lo_u32_b32 %0, -1, 0\n\tv_mbcnt_hi_u32_b32 %0, -1, %0" : "=v"(l2_));
          E(acc, cur, wr, wc, l2_ & 15, l2_ >> 4); }
        if (!has_next) break;
        cur = nxt; cA = nA; cB = nB; ++ui;
        if constexpr (GATHER) { rwc[0] = rwn[0]; rwc[1] = rwn[1]; }
        if (wr == 1) PG8_BAR;
    }
    PG8_WAIT_V(0);
    PG8_BAR;
#undef PG8_SA
#undef PG8_SB
#undef PG8_STAGE
#undef PG8_STAGE_A
#undef PG8_LDA
#undef PG8_LDB
#undef PG8_MMA
#undef PG8_WAIT_V
#undef PG8_WAIT_L
#undef PG8_BAR
#undef PG8_SCHED
}
#define ACC_ZERO(acc) do { _Pragma("unroll") for (int a_ = 0; a_ < 2; ++a_) _Pragma("unroll") for (int b_ = 0; b_ < 2; ++b_) _Pragma("unroll") for (int m_ = 0; m_ < 4; ++m_) _Pragma("unroll") for (int n_ = 0; n_ < 2; ++n_) \
        acc[a_][b_][m_][n_] = (f32x4){0.f, 0.f, 0.f, 0.f}; } while (0)
}

constexpr int NWAVES = 8, NTHREADS = 512;
constexpr int RING_BYTES = 131072;
constexpr int LDS_TAB_OFF = RING_BYTES;
constexpr int LDS_MISC_OFF = RING_BYTES + 8192;
constexpr int LDS_BYTES = 147456;

struct Args { const float* in[N_IN]; float* out; unsigned char* ws; int ph_lo, ph_hi; };

#define CAS __attribute__((address_space(4)))
struct KA { const CAS char* kp;
    DI const float* in(int i) const { return *(const float* const CAS*)(kp + 8 * i); }
    DI float* out() const { return *(float* const CAS*)(kp + 8 * N_IN); }
    DI unsigned char* ws() const { return *(unsigned char* const CAS*)(kp + 8 * N_IN + 8); } };
struct Frame {
    LAS unsigned char* lds;
    volatile LAS unsigned* MISC;
    unsigned* ctl;
    unsigned char* ws;
    int tid, lane, wave, G, bid;
};

DI int row_modrow(int r) { const int b = r / LTOT, p = r - b * LTOT; return p < CTX ? 8 : b; }

struct SchedInproj {
    pg8::TileOrder T; const char* A; const char* B;
    DI bool next(int i, pg8::Unit& u) const { int pm, pn; if (!T.tile(i, pm, pn)) return false; u.pa = A + (size_t)pm * (256 * 1024 * 2); u.pb = B + (size_t)pn * (256 * 1024 * 2); u.x = pm; u.y = pn; u.z = 0; return true; }
};
struct EpiStoreBf16 {
    static constexpr bool PERM = true;
    bf16* O; int ldc;
    DI void operator()(f32x4 (&acc)[2][2][4][2], const pg8::Unit& u, int wr, int wc, int fr, int fq) const {
        const int row0 = u.x * 256 + wr * 64 + fr, col0 = u.y * 256 + wc * 32 + 8 * fq;
#pragma unroll
        for (int ai = 0; ai < 2; ++ai)
#pragma unroll
            for (int m = 0; m < 4; ++m) { bf16* rowp = O + (size_t)(row0 + ai * 128 + m * 16) * ldc + col0;
#pragma unroll
                for (int bj = 0; bj < 2; ++bj) { const f32x4 v0 = acc[ai][bj][m][0], v1 = acc[ai][bj][m][1];
                    u32x4 w; w.x = pk2(v0[0], v0[1]); w.y = pk2(v0[2], v0[3]); w.z = pk2(v1[0], v1[1]); w.w = pk2(v1[2], v1[3]);
                    *(u32x4*)(rowp + bj * 128) = w; } }
        ACC_ZERO(acc);
    }
};
struct SchedMerge {
    pg8::TileOrder T; const char* A; const char* B;
    DI bool next(int i, pg8::Unit& u) const { const int ti = i / 3, br = i - ti * 3; int pm, pn; if (!T.tile(ti, pm, pn)) return false;
        u.pa = A + (size_t)br * ((size_t)NT * 512 * 2) + (size_t)pm * (256 * 512 * 2); u.pb = B + (size_t)br * (1024 * 512 * 2) + (size_t)pn * (256 * 512 * 2); u.x = pm; u.y = pn; u.z = br; return true; }
};
struct EpiMerge {
    static constexpr bool PERM = true;
    const bf16* P; bf16* O;
    static DI float en(float x) { return __builtin_amdgcn_exp2f(fminf(x * -1.4426950408889634f, 43.28f)); }
    DI void operator()(f32x4 (&acc)[2][2][4][2], const pg8::Unit& u, int wr, int wc, int fr, int fq) const {
        const int row0 = u.x * 256 + wr * 64 + fr, col0 = u.y * 256 + wc * 32 + 8 * fq, br = u.z;
#pragma unroll
        for (int ai = 0; ai < 2; ++ai) {
            u32x4 gc[4][2], gn[4][2];
#pragma unroll
            for (int m = 0; m < 4; ++m)
#pragma unroll
                for (int bj = 0; bj < 2; ++bj) { const bf16* gp = P + (size_t)(row0 + ai * 128 + m * 16) * DINP + PC_GATE + br * 1024 + col0 + bj * 128;
                    gc[m][bj] = *(const u32x4*)gp; gn[m][bj] = br < 2 ? *(const u32x4*)(gp + 1024) : (u32x4){0u, 0u, 0u, 0u}; }
            __builtin_amdgcn_sched_barrier(0);
#pragma unroll
            for (int m = 0; m < 4; ++m) { const size_t row = (size_t)(row0 + ai * 128 + m * 16);
#pragma unroll
                for (int bj = 0; bj < 2; ++bj) {
                    float lc[8], f[8]; unpack8(gc[m][bj], lc);
                    if (br < 2) { float ln[8]; unpack8(gn[m][bj], ln);
#pragma unroll
                        for (int j = 0; j < 8; ++j) f[j] = (1.f + en(ln[j])) * __builtin_amdgcn_rcpf(1.f + en(lc[j]));
                    } else {
#pragma unroll
                        for (int j = 0; j < 8; ++j) f[j] = __builtin_amdgcn_rcpf(1.f + en(lc[j]));
                    }
                    f32x4 v0 = acc[ai][bj][m][0], v1 = acc[ai][bj][m][1];
                    v0[0] *= f[0]; v0[1] *= f[1]; v0[2] *= f[2]; v0[3] *= f[3]; v1[0] *= f[4]; v1[1] *= f[5]; v1[2] *= f[6]; v1[3] *= f[7];
                    if (br == 2) { u32x4 w; w.x = pk2(v0[0], v0[1]); w.y = pk2(v0[2], v0[3]); w.z = pk2(v1[0], v1[1]); w.w = pk2(v1[2], v1[3]);
                        *(u32x4*)(O + row * 1024 + col0 + bj * 128) = w; v0 = (f32x4){0.f, 0.f, 0.f, 0.f}; v1 = v0; }
                    acc[ai][bj][m][0] = v0; acc[ai][bj][m][1] = v1; } }
            __builtin_amdgcn_sched_barrier(0); }
    }
};
struct SchedPlain {
    pg8::TileOrder T; const char* A; const char* B; int K;
    DI bool next(int i, pg8::Unit& u) const { int pm, pn; if (!T.tile(i, pm, pn)) return false; u.pa = A + (size_t)pm * ((size_t)256 * K * 2); u.pb = B + (size_t)pn * ((size_t)256 * K * 2); u.x = pm; u.y = pn; u.z = 0; return true; }
};
struct EpiResid {
    static constexpr bool PERM = false;
    float* X; const float* mod;
    DI void operator()(f32x4 (&acc)[2][2][4][2], const pg8::Unit& u, int wr, int wc, int fr, int fq) const {
        const int row0 = u.x * 256 + wr * 64 + fr, col0 = u.y * 256 + wc * 32 + 4 * fq;
        const float* g1 = mod + (size_t)row_modrow(u.x * 256) * 6144 + 2048 + col0;
        f32x4 gv[2][2];
#pragma unroll
        for (int bj = 0; bj < 2; ++bj)
#pragma unroll
            for (int n = 0; n < 2; ++n) gv[bj][n] = *(const f32x4*)(g1 + bj * 128 + n * 16);
#pragma unroll
        for (int ai = 0; ai < 2; ++ai) {
            f32x4 xv[4][2][2];
#pragma unroll
            for (int m = 0; m < 4; ++m)
#pragma unroll
                for (int bj = 0; bj < 2; ++bj)
#pragma unroll
                    for (int n = 0; n < 2; ++n) xv[m][bj][n] = *(const f32x4*)(X + (size_t)(row0 + ai * 128 + m * 16) * 1024 + col0 + bj * 128 + n * 16);
            __builtin_amdgcn_sched_barrier(0);
#pragma unroll
            for (int m = 0; m < 4; ++m)
#pragma unroll
                for (int bj = 0; bj < 2; ++bj)
#pragma unroll
                    for (int n = 0; n < 2; ++n) *(f32x4*)(X + (size_t)(row0 + ai * 128 + m * 16) * 1024 + col0 + bj * 128 + n * 16) = xv[m][bj][n] + gv[bj][n] * acc[ai][bj][m][n];
            __builtin_amdgcn_sched_barrier(0); }
        ACC_ZERO(acc);
    }
};
struct SchedMoe {
    const LAS int* tab; const char* A; const char* B; const int* list; int nN, c, G; size_t a_tile_bytes, b_exp_bytes; bool gather;
    DI bool next(int i, pg8::Unit& u) const {
        const int T = tab[96], Tq = (T + 7) >> 3, xcd = c & 7, q = i * (G >> 3) + (c >> 3), tl = q / nN, pn = q - tl * nN, t = xcd * Tq + tl;
        if (tl >= Tq || t >= T) return false;
        const int e = tab[128 + t], j = t - tab[64 + e], slot0 = tab[32 + e] + 256 * j;
        u.pa = gather ? A : A + (size_t)slot0 * 2048; u.pb = B + (size_t)e * b_exp_bytes + (size_t)pn * (256 * 1024 * 2); u.x = slot0; u.y = pn; u.z = e | (j << 8); return true;
    }
    DI void rows(const pg8::Unit& u, int R0, int R1, unsigned (&rw)[2]) const {
        const int e = u.z & 255, j = u.z >> 8, cnt = tab[e]; const int* le = list + (size_t)e * NT;
#pragma unroll
        for (int h = 0; h < 2; ++h) { const int i0 = j * 256 + h * 128 + R0, i1 = j * 256 + h * 128 + R1;
            const unsigned r0 = i0 < cnt ? (unsigned)(le[i0] >> 2) : (unsigned)NT, r1 = i1 < cnt ? (unsigned)(le[i1] >> 2) : (unsigned)NT; rw[h] = r0 | (r1 << 16); }
    }
};
struct EpiSwiglu {
    static constexpr bool PERM = true;
    bf16* ACT; const float* bgu;
    DI void operator()(f32x4 (&acc)[2][2][4][2], const pg8::Unit& u, int wr, int wc, int fr, int fq) const {
        const int row0 = u.x + wr * 64 + fr, ch0 = u.y * 128 + wc * 32 + 8 * fq, e = u.z & 255;
        const float* bg = bgu + (size_t)e * 2048 + ch0;
        const f32x4 bg0 = *(const f32x4*)bg, bg1 = *(const f32x4*)(bg + 4), bu0 = *(const f32x4*)(bg + 1024), bu1 = *(const f32x4*)(bg + 1028);
#pragma unroll
        for (int ai = 0; ai < 2; ++ai)
#pragma unroll
            for (int m = 0; m < 4; ++m) {
                const f32x4 g0 = acc[ai][0][m][0] + bg0, g1 = acc[ai][0][m][1] + bg1, u0 = acc[ai][1][m][0] + bu0, u1 = acc[ai][1][m][1] + bu1;
                float o[8];
#pragma unroll
                for (int j = 0; j < 8; ++j) { const float g = fminf(j < 4 ? g0[j & 3] : g1[j & 3], 7.f); const float up = fminf(fmaxf(j < 4 ? u0[j & 3] : u1[j & 3], -7.f), 7.f);
                    o[j] = g * __builtin_amdgcn_rcpf(1.f + __expf(-1.702f * g)) * (up + 1.f); }
                u32x4 w; w.x = pk2(o[0], o[1]); w.y = pk2(o[2], o[3]); w.z = pk2(o[4], o[5]); w.w = pk2(o[6], o[7]);
                *(u32x4*)(ACT + (size_t)(row0 + ai * 128 + m * 16) * 1024 + ch0) = w; }
        ACC_ZERO(acc);
    }
};
struct EpiDown {
    static constexpr bool PERM = true;
    bf16* Y; const float* bd;
    DI void operator()(f32x4 (&acc)[2][2][4][2], const pg8::Unit& u, int wr, int wc, int fr, int fq) const {
        const int row0 = u.x + wr * 64 + fr, col0 = u.y * 256 + wc * 32 + 8 * fq, e = u.z & 255;
        f32x4 bv[2][2];
#pragma unroll
        for (int bj = 0; bj < 2; ++bj)
#pragma unroll
            for (int n = 0; n < 2; ++n) bv[bj][n] = *(const f32x4*)(bd + (size_t)e * 1024 + col0 + bj * 128 + 4 * n);
#pragma unroll
        for (int ai = 0; ai < 2; ++ai)
#pragma unroll
            for (int m = 0; m < 4; ++m) { bf16* rowp = Y + (size_t)(row0 + ai * 128 + m * 16) * 1024 + col0;
#pragma unroll
                for (int bj = 0; bj < 2; ++bj) { const f32x4 v0 = acc[ai][bj][m][0] + bv[bj][0], v1 = acc[ai][bj][m][1] + bv[bj][1];
                    u32x4 w; w.x = pk2(v0[0], v0[1]); w.y = pk2(v0[2], v0[3]); w.z = pk2(v1[0], v1[1]); w.w = pk2(v1[2], v1[3]);
                    *(u32x4*)(rowp + bj * 128) = w; } }
        ACC_ZERO(acc);
    }
};
DI void moe_build_table(Frame& F, const unsigned* cnt  ) {
    LAS int* tab = (LAS int*)(F.lds + LDS_TAB_OFF);
    if (F.tid < 32) tab[F.tid] = (int)__hip_atomic_load(cnt + F.tid * 16, __ATOMIC_RELAXED, __HIP_MEMORY_SCOPE_AGENT);
    __syncthreads();
    if (F.tid == 0) { int pb = 0, tb = 0; for (int e = 0; e < 32; ++e) { const int nt_ = (tab[e] + 255) >> 8; tab[32 + e] = pb; tab[64 + e] = tb; pb += nt_ * 256; tb += nt_; } tab[96] = tb; }
    __syncthreads();
    for (int e = 0; e < 32; ++e) { const int tb = tab[64 + e], nt_ = (tab[e] + 255) >> 8; for (int j = F.tid; j < nt_; j += NTHREADS) tab[128 + tb + j] = e; }
    __syncthreads();
}

DI void transpose_item(const float* W, int K, int N, bf16* WT, int mode, const float* gk, LAS float* scr, int item, int lane) {
    const int nblk = N / 32, kb = item / nblk, nb = item % nblk, k0 = 64 * kb, n0 = 32 * nb;
#pragma unroll 8
    for (int i = 0; i < 32; ++i) { const int kk = 2 * i + (lane >> 5); float v = W[(size_t)(k0 + kk) * N + n0 + (lane & 31)]; if (gk) v *= gk[k0 + kk]; scr[kk * 33 + (lane & 31)] = v; }
    LDS_WAIT(); asm volatile("" ::: "memory");
    int drow0 = n0;
    if (mode == 1) { const int up = n0 >= 1024, ch = n0 - (up ? 1024 : 0); drow0 = (ch >> 7) * 256 + (up ? 128 : 0) + (ch & 127); }
    const int c = lane & 7;
#pragma unroll
    for (int j = 0; j < 4; ++j) { const int n = (lane >> 3) + 8 * j; const LAS float* s = scr + (8 * c) * 33 + n;
        u32x4 o; o.x = pk2(s[0 * 33], s[1 * 33]); o.y = pk2(s[2 * 33], s[3 * 33]); o.z = pk2(s[4 * 33], s[5 * 33]); o.w = pk2(s[6 * 33], s[7 * 33]);
        *(u32x4*)(WT + (size_t)(drow0 + n) * K + k0 + 8 * c) = o; }
    LDS_WAIT(); asm volatile("" ::: "memory");
}
DI void transpose_batch(Frame& F, const float* W, size_t ss, int K, int N, bf16* WT, size_t ds, int nb, int mode, const float* gk, size_t gks) {
    LAS float* scr = (LAS float*)(F.lds + F.wave * 16384);
    const int gw = F.bid * NWAVES + F.wave, NGW = F.G * NWAVES;
    const int per = (K / 64) * (N / 32), total = per * nb;
    for (int it = gw; it < total; it += NGW) { const int b = it / per, r = it - b * per;
        transpose_item(W + (size_t)b * ss, K, N, WT + (size_t)b * ds, mode, gk ? gk + (size_t)b * gks : nullptr, scr, r, F.lane); }
}
DI void phase_prologue(Frame& F, const KA& a) {
    unsigned char* ws = F.ws;
    transpose_batch(F, a.in(I_WIN), (size_t)1024 * DIN, 1024, DIN, (bf16*)(ws + WS_WIN), (size_t)DINP * 1024, 4, 0, nullptr, 0);
    transpose_batch(F, a.in(I_WGU), (size_t)1024 * 2048, 1024, 2048, (bf16*)(ws + WS_WGU), (size_t)2048 * 1024, 128, 1, nullptr, 0);
    transpose_batch(F, a.in(I_WDOWN), (size_t)1024 * 1024, 1024, 1024, (bf16*)(ws + WS_WDN), (size_t)1024 * 1024, 128, 0, nullptr, 0);
    transpose_batch(F, a.in(I_WOUT), (size_t)1024 * 1024, 1024, 1024, (bf16*)(ws + WS_WOUT), (size_t)1024 * 1024, 4, 0, nullptr, 0);
    transpose_batch(F, a.in(I_BRRET), (size_t)512 * 1024, 512, 1024, (bf16*)(ws + WS_WBR), (size_t)3 * 1024 * 512, 4, 0, nullptr, 0);
    transpose_batch(F, a.in(I_BRMLA), (size_t)512 * 1024, 512, 1024, (bf16*)(ws + WS_WBR) + (size_t)1024 * 512, (size_t)3 * 1024 * 512, 4, 0, nullptr, 0);
    transpose_batch(F, a.in(I_BRRWKV), (size_t)512 * 1024, 512, 1024, (bf16*)(ws + WS_WBR) + (size_t)2 * 1024 * 512, (size_t)3 * 1024 * 512, 4, 0, nullptr, 0);
    transpose_batch(F, a.in(I_WUQ), (size_t)256 * 768, 256, 768, (bf16*)(ws + WS_SMALLW + SW_UQ), MiB / 2, 4, 0, a.in(I_MQNG), 256);
    transpose_batch(F, a.in(I_WUKV), (size_t)128 * 1024, 128, 1024, (bf16*)(ws + WS_SMALLW + SW_UKV), MiB / 2, 4, 0, a.in(I_MKVNG), 128);
    for (int l = 0; l < 4; ++l) {
        transpose_batch(F, a.in(I_W2) + (size_t)l * 2 * 64 * 512, (size_t)64 * 512, 64, 512, (bf16*)(ws + WS_SMALLW + l * MiB + SW_W2), (size_t)512 * 64, 2, 0, nullptr, 0);
        transpose_batch(F, a.in(I_A2) + (size_t)l * 2 * 64 * 512, (size_t)64 * 512, 64, 512, (bf16*)(ws + WS_SMALLW + l * MiB + SW_A2), (size_t)512 * 64, 2, 0, nullptr, 0);
    }
    transpose_batch(F, a.in(I_G2), (size_t)128 * 512, 128, 512, (bf16*)(ws + WS_SMALLW + SW_G2), MiB / 2, 4, 0, nullptr, 0);
    const int gt = F.bid * NTHREADS + F.tid, NGT = F.G * NTHREADS;
    for (int i = gt; i < 4 * (DINP - DIN) * 1024 / 8; i += NGT) { const int l = i / ((DINP - DIN) * 128), r = i - l * ((DINP - DIN) * 128);
        *(u32x4*)((bf16*)(ws + WS_WIN) + (size_t)l * DINP * 1024 + (size_t)DIN * 1024 + (size_t)r * 8) = (u32x4){0u, 0u, 0u, 0u}; }
    for (int i = gt; i < 128; i += NGT) *(u32x4*)((bf16*)(ws + WS_H) + (size_t)NT * 1024 + i * 8) = (u32x4){0u, 0u, 0u, 0u};
    { float2* rt = (float2*)(ws + WS_ROPE);
      for (int i = gt; i < 4096 * 32; i += NGT) { const int pos = i >> 5, f = i & 31; const float inv = powf(10000.f, -(float)(2 * f) / 64.f); const float ang = (float)pos * inv; float s, c; sincosf(ang, &s, &c); rt[i] = make_float2(c, s); }
      float2* ax = (float2*)(ws + WS_ROPE_AX);
      for (int i = gt; i < 64 * 8; i += NGT) { const int pos = i >> 3, f = i & 7; const float inv = powf(10000.f, -(float)(2 * f) / 16.f); const float ang = (float)pos * inv; float s, c; sincosf(ang, &s, &c); ax[i] = make_float2(c, s); } }
    { LAS float* sc = (LAS float*)(F.lds);
      LAS float* red = (LAS float*)(F.lds + 65536);
      __syncthreads();
      for (int i = F.tid; i < 9 * 1024; i += NTHREADS) { const int r = i >> 10, k = i & 1023; const float v = r < 8 ? a.in(I_C)[r * 1024 + k] : a.in(I_CCTX)[k]; sc[i] = v / (1.f + __expf(-v)); }
      __syncthreads();
      float* mod = (float*)(ws + WS_MOD);
      for (int it = F.bid; it < 4 * 96; it += F.G) { const int l = it / 96, n = (it - l * 96) * 64 + F.lane;
          const float* w = a.in(I_ADAW) + (size_t)l * 1024 * 6144 + n; float acc[9];
#pragma unroll
          for (int r = 0; r < 9; ++r) acc[r] = 0.f;
          const int kb = F.wave * 128;
#pragma unroll 8
          for (int k = 0; k < 128; ++k) { const float wv = w[(size_t)(kb + k) * 6144];
#pragma unroll
              for (int r = 0; r < 9; ++r) acc[r] += sc[r * 1024 + kb + k] * wv; }
#pragma unroll
          for (int r = 0; r < 9; ++r) red[(F.wave * 9 + r) * 64 + F.lane] = acc[r];
          __syncthreads();
          for (int i = F.tid; i < 9 * 64; i += NTHREADS) { const int r = i >> 6, c = i & 63; float s = 0.f;
#pragma unroll
              for (int w8 = 0; w8 < 8; ++w8) s += red[(w8 * 9 + r) * 64 + c];
              const int nn = (it - l * 96) * 64 + c; mod[((size_t)l * 9 + r) * 6144 + nn] = s + a.in(I_ADAB)[l * 6144 + nn]; }
          __syncthreads(); } }
}

DI void norm_mod_store(const f32x4 (&v)[4], const float* gain, const float* sc, const float* sh, bf16* hrow, int lane) {
    float s = 0.f;
#pragma unroll
    for (int j = 0; j < 4; ++j) s += (v[j].x * v[j].x + v[j].y * v[j].y) + (v[j].z * v[j].z + v[j].w * v[j].w);
    const float rinv = rsqrtf(wave_sum(s) * (1.f / 1024.f) + 1e-6f);
#pragma unroll
    for (int j = 0; j < 4; ++j) { const int c = 256 * j + 4 * lane; const f32x4 g = *(const f32x4*)(gain + c), a = *(const f32x4*)(sc + c), b = *(const f32x4*)(sh + c);
        const f32x4 y = v[j] * rinv * g * (a + 1.f) + b; u32x2 o; o.x = pk2(y.x, y.y); o.y = pk2(y.z, y.w); *(u32x2*)(hrow + c) = o; }
}
DI void phase_init_rows(Frame& F, const KA& a) {
    const int gw = F.bid * NWAVES + F.wave, NGW = F.G * NWAVES;
    float* X = (float*)(F.ws + WS_X); bf16* H = (bf16*)(F.ws + WS_H); const float* mod = (const float*)(F.ws + WS_MOD);
    for (int r = gw; r < NT; r += NGW) { const int b = r / LTOT, p = r - b * LTOT;
        const float* src = p < CTX ? a.in(I_CTX) + ((size_t)b * CTX + p) * 1024 : a.in(I_X) + ((size_t)b * SEQ + (p - CTX)) * 1024;
        f32x4 v[4];
#pragma unroll
        for (int j = 0; j < 4; ++j) { v[j] = *(const f32x4*)(src + 256 * j + 4 * F.lane); *(f32x4*)(X + (size_t)r * 1024 + 256 * j + 4 * F.lane) = v[j]; }
        const float* m = mod + (size_t)(p < CTX ? 8 : b) * 6144;
        norm_mod_store(v, a.in(I_N1G), m + 1024, m, H + (size_t)r * 1024, F.lane); }
}

template <int CTRL> DI float dppf(float v) { return __int_as_float(__builtin_amdgcn_update_dpp(0, __float_as_int(v), CTRL, 0xf, 0xf, false)); }
template <int CTRL> DI int dppi(int v) { return __builtin_amdgcn_update_dpp(0, v, CTRL, 0xf, 0xf, false); }
DI void phase_router(Frame& F, const KA& a, int l) {
    LAS float* T = (LAS float*)(F.lds);
    LAS float* part = (LAS float*)(F.lds + 16 * 1028 * 4);
    LAS int* lcnt = (LAS int*)(F.lds + 16 * 1028 * 4 + 16384 + 2048);
    LAS int* gbase = lcnt + 64;
    const float* X = (const float*)(F.ws + WS_X); bf16* H = (bf16*)(F.ws + WS_H);
    const float* mod = (const float*)(F.ws + WS_MOD) + (size_t)l * 9 * 6144;
    const float* gain = a.in(I_N2G) + l * 1024; const float* wr = a.in(I_WROUTER) + (size_t)l * 1024 * 32; const float* br = a.in(I_BROUTER) + l * 32;
    int* eidx = (int*)(F.ws + WS_TOPK); float* gw = (float*)(F.ws + WS_TOPK) + (size_t)NT * 4; int* rank = (int*)(F.ws + WS_TOPK) + (size_t)NT * 8;
    int* list = (int*)(F.ws + WS_LIST); unsigned* cnt = F.ctl + CW_CNT + l * 32 * 16;
    const int lane = F.lane, w = F.wave, tid = F.tid;
    const bool lastl = l == DEPTH - 1;
    const int nit = lastl ? BATCH * SEQ / 16 : NT / 16;
    const int mi = lane & 15, mq = lane >> 4;
    float b0[32], b1[32];
    { const float* wp = wr + (size_t)(128 * w + 32 * mq) * 32 + mi;
#pragma unroll
      for (int s2 = 0; s2 < 32; ++s2) { b0[s2] = wp[s2 * 32]; b1[s2] = wp[s2 * 32 + 16]; } }
    const int row = tid >> 5, e = tid & 31; const float bre = br[e];
    f32x4 vn[2][4];
    int it = F.bid;
#define RT_R0(it_) (lastl ? ((it_) >> 8) * LTOT + CTX + 16 * ((it_) & 255) : (it_) * 16)
    if (it < nit) { const int r0 = RT_R0(it);
#pragma unroll
        for (int rr = 0; rr < 2; ++rr)
#pragma unroll
            for (int j = 0; j < 4; ++j) vn[rr][j] = *(const f32x4*)(X + (size_t)(r0 + w * 2 + rr) * 1024 + 256 * j + 4 * lane); }
    int pend_e = 0, pend_lr = 0, pend_r = -1, par = 0; float pend_g = 0.f; int gb = 0;
#pragma unroll 1
    for (; it < nit; it += F.G) {
        const int r0 = RT_R0(it);
        LDS_BARRIER();
        if (tid < 32) { if (pend_r >= 0) { const int c = lcnt[(par ^ 1) * 32 + tid]; gb = c ? (int)__hip_atomic_fetch_add(cnt + tid * 16, (unsigned)c, __ATOMIC_RELAXED, __HIP_MEMORY_SCOPE_AGENT) : 0; }
            lcnt[par * 32 + tid] = 0; }
#pragma unroll
        for (int rr = 0; rr < 2; ++rr) { const int lr = w * 2 + rr, r = r0 + lr; const int b = r / LTOT, p = r - b * LTOT; const float* m = mod + (size_t)(p < CTX ? 8 : b) * 6144;
            float s = 0.f;
#pragma unroll
            for (int j = 0; j < 4; ++j) { const f32x4 x = vn[rr][j]; s += (x.x * x.x + x.y * x.y) + (x.z * x.z + x.w * x.w); }
            const float rinv = rsqrtf(wave_sum(s) * (1.f / 1024.f) + 1e-6f);
#pragma unroll
            for (int j = 0; j < 4; ++j) { const int c = 256 * j + 4 * lane; const f32x4 g = *(const f32x4*)(gain + c), sc = *(const f32x4*)(m + 4096 + c), sh = *(const f32x4*)(m + 3072 + c);
                const f32x4 y = vn[rr][j] * rinv * g * (sc + 1.f) + sh; *(LAS f32x4*)(T + lr * 1028 + c) = y;
                u32x2 o; o.x = pk2(y.x, y.y); o.y = pk2(y.z, y.w); *(u32x2*)(H + (size_t)r * 1024 + c) = o; } }
        LDS_BARRIER();
        if (it + F.G < nit) { const int rn = RT_R0(it + F.G);
#pragma unroll
            for (int rr = 0; rr < 2; ++rr)
#pragma unroll
                for (int j = 0; j < 4; ++j) vn[rr][j] = *(const f32x4*)(X + (size_t)(rn + w * 2 + rr) * 1024 + 256 * j + 4 * lane); }
        { f32x4 acc0 = {0.f, 0.f, 0.f, 0.f}, acc1 = acc0;
          const LAS float* tp = T + mi * 1028 + 128 * w + 32 * mq;
          f32x4 a4[8];
#pragma unroll
          for (int s2 = 0; s2 < 8; ++s2) a4[s2] = *(const LAS f32x4*)(tp + 4 * s2);
#pragma unroll
          for (int s2 = 0; s2 < 32; ++s2) { const float av = a4[s2 >> 2][s2 & 3];
              acc0 = __builtin_amdgcn_mfma_f32_16x16x4f32(av, b0[s2], acc0, 0, 0, 0); acc1 = __builtin_amdgcn_mfma_f32_16x16x4f32(av, b1[s2], acc1, 0, 0, 0); }
#pragma unroll
          for (int rg = 0; rg < 4; ++rg) { part[(w * 16 + 4 * mq + rg) * 32 + mi] = acc0[rg]; part[(w * 16 + 4 * mq + rg) * 32 + 16 + mi] = acc1[rg]; } }
        if (tid < 32 && pend_r >= 0) gbase[(par ^ 1) * 32 + tid] = gb;
        LDS_BARRIER();
        { float v = bre;
#pragma unroll
          for (int w8 = 0; w8 < 8; ++w8) v += part[(w8 * 16 + row) * 32 + e];
          int te[4]; float tv[4];
#pragma unroll
          for (int k = 0; k < 4; ++k) { float bv = v; int bi = e;
#define RT_STEP(OV, OI) do { const float ov_ = (OV); const int oi_ = (OI); const bool take_ = ov_ > bv || (ov_ == bv && oi_ < bi); bv = take_ ? ov_ : bv; bi = take_ ? oi_ : bi; } while (0)
              RT_STEP(dppf<0xB1>(bv), dppi<0xB1>(bi)); RT_STEP(dppf<0x4E>(bv), dppi<0x4E>(bi)); RT_STEP(dppf<0x141>(bv), dppi<0x141>(bi)); RT_STEP(dppf<0x140>(bv), dppi<0x140>(bi));
              RT_STEP(sx(bv, 16), __float_as_int(sx(__int_as_float(bi), 16)));
              te[k] = bi; tv[k] = bv; if (e == bi) v = -3.0e38f; }
          const float mx = tv[0]; float den = 0.f;
#pragma unroll
          for (int k = 0; k < 4; ++k) { tv[k] = __expf(tv[k] - mx); den += tv[k]; }
          const float rden = 1.f / den;
          int myk_e = te[0]; float myk_g = tv[0] * rden;
#pragma unroll
          for (int k = 1; k < 4; ++k) { if (e == k) { myk_e = te[k]; myk_g = tv[k] * rden; } }
          int lr = 0;
          if (e < 4) lr = atomicAdd((int*)&lcnt[par * 32 + myk_e], 1);
          if (e < 4 && pend_r >= 0) { const int rk = gbase[(par ^ 1) * 32 + pend_e] + pend_lr; eidx[pend_r * 4 + e] = pend_e; gw[pend_r * 4 + e] = pend_g; rank[pend_r * 4 + e] = rk; list[(size_t)pend_e * NT + rk] = pend_r * 4 + e; }
          pend_e = myk_e; pend_lr = lr; pend_g = myk_g; pend_r = r0 + row; par ^= 1; }
    }
    LDS_BARRIER();
    if (pend_r >= 0) {
        if (tid < 32) { const int c = lcnt[(par ^ 1) * 32 + tid]; gbase[(par ^ 1) * 32 + tid] = c ? (int)__hip_atomic_fetch_add(cnt + tid * 16, (unsigned)c, __ATOMIC_RELAXED, __HIP_MEMORY_SCOPE_AGENT) : 0; }
        LDS_BARRIER();
        if (e < 4) { const int rk = gbase[(par ^ 1) * 32 + pend_e] + pend_lr; eidx[pend_r * 4 + e] = pend_e; gw[pend_r * 4 + e] = pend_g; rank[pend_r * 4 + e] = rk; list[(size_t)pend_e * NT + rk] = pend_r * 4 + e; }
    }
#undef RT_STEP
#undef RT_R0
}

DI void phase_combine(Frame& F, const KA& a, int l) {
    moe_build_table(F, F.ctl + CW_CNT + l * 32 * 16);
    const LAS int* tab = (const LAS int*)(F.lds + LDS_TAB_OFF);
    const int lane = fresh_lane();
    const int gw_ = F.bid * NWAVES + F.wave, NGW = F.G * NWAVES;
    float* X = (float*)(F.ws + WS_X); bf16* H = (bf16*)(F.ws + WS_H); const bf16* Y = (const bf16*)(F.ws + WS_Y);
    const float* mod = (const float*)(F.ws + WS_MOD) + (size_t)l * 9 * 6144;
    const int* eidx = (const int*)(F.ws + WS_TOPK); const float* gw = (const float*)(F.ws + WS_TOPK) + (size_t)NT * 4; const int* rank = (const int*)(F.ws + WS_TOPK) + (size_t)NT * 8;
#pragma unroll 1
    for (int r0 = gw_; r0 < NT; r0 += 2 * NGW) {
        int rr[2], bb[2], pp[2]; bool act[2]; size_t slot[2][4]; float gk[2][4];
#pragma unroll
        for (int u = 0; u < 2; ++u) { rr[u] = r0 + u * NGW; act[u] = rr[u] < NT; if (!act[u]) rr[u] = r0; bb[u] = rr[u] / LTOT; pp[u] = rr[u] - bb[u] * LTOT; if (l == DEPTH - 1 && pp[u] < CTX) act[u] = false;
#pragma unroll
            for (int k = 0; k < 4; ++k) { const int e = eidx[rr[u] * 4 + k]; gk[u][k] = gw[rr[u] * 4 + k]; slot[u][k] = (size_t)(tab[32 + e] + rank[rr[u] * 4 + k]); } }
        f32x4 v[2][4]; u32x2 yv[2][4][4];
#pragma unroll
        for (int u = 0; u < 2; ++u) {
#pragma unroll
            for (int j = 0; j < 4; ++j) v[u][j] = *(const f32x4*)(X + (size_t)rr[u] * 1024 + 256 * j + 4 * lane);
#pragma unroll
            for (int k = 0; k < 4; ++k)
#pragma unroll
                for (int j = 0; j < 4; ++j) yv[u][k][j] = *(const u32x2*)(Y + slot[u][k] * 1024 + 256 * j + 4 * lane); }
#pragma unroll
        for (int u = 0; u < 2; ++u) { if (!act[u]) continue;
            const int mr = pp[u] < CTX ? 8 : bb[u]; const float* g2 = mod + (size_t)mr * 6144 + 5120;
#pragma unroll
            for (int j = 0; j < 4; ++j) { f32x4 acc = {0.f, 0.f, 0.f, 0.f};
#pragma unroll
                for (int k = 0; k < 4; ++k) { const float g = gk[u][k]; const u32x2 y = yv[u][k][j]; acc.x += g * bflo(y.x); acc.y += g * bfhi(y.x); acc.z += g * bflo(y.y); acc.w += g * bfhi(y.y); }
                v[u][j] = v[u][j] + *(const f32x4*)(g2 + 256 * j + 4 * lane) * acc; }
            if (l == DEPTH - 1) {
                float* o = a.out() + ((size_t)bb[u] * SEQ + (pp[u] - CTX)) * 1024;
#pragma unroll
                for (int j = 0; j < 4; ++j) *(f32x4*)(o + 256 * j + 4 * lane) = v[u][j];
            } else {
#pragma unroll
                for (int j = 0; j < 4; ++j) *(f32x4*)(X + (size_t)rr[u] * 1024 + 256 * j + 4 * lane) = v[u][j];
                const float* m = (const float*)(F.ws + WS_MOD) + (size_t)(l + 1) * 9 * 6144 + (size_t)mr * 6144;
                norm_mod_store(v[u], a.in(I_N1G) + (l + 1) * 1024, m + 1024, m, H + (size_t)rr[u] * 1024, lane);
            } }
    }
}

DI int crow16(int i, int h) { return (i & 3) + 8 * (i >> 2) + 4 * h; }
DI int permpos(int p) { return (p & ~12) | ((p & 4) << 1) | ((p & 8) >> 1); }
constexpr int MP_P = 424;
constexpr int MP_SP = 104;
constexpr int MP_SCR = 32 * MP_P * 2;
DI void phase_mla_prep2(Frame& F, const KA& a, int l) {
    const bf16* P = (const bf16*)(F.ws + WS_P);
    const bf16* WUQ = (const bf16*)(F.ws + WS_SMALLW + (size_t)l * MiB + SW_UQ); const bf16* WUKV = (const bf16*)(F.ws + WS_SMALLW + (size_t)l * MiB + SW_UKV);
    bf16* QB = (bf16*)(F.ws + WS_QB); bf16* KB = (bf16*)(F.ws + WS_KB); bf16* VT = (bf16*)(F.ws + WS_VT);
    const float* gq = a.in(I_QKQG) + l * 96; const float* gk = a.in(I_QKKG) + l * 96;
    const float2* ax = (const float2*)(F.ws + WS_ROPE_AX);
    LAS bf16* T = (LAS bf16*)F.lds;
#pragma unroll 1
    for (int it = F.bid; it < NT / 32; it += F.G) {
        const int lane = fresh_lane(); int w = F.wave; asm volatile("" : "+s"(w)); const int tid = w * 64 + lane;
        const int r0 = it * 32, b = r0 / LTOT, p0 = r0 - b * LTOT;
        __syncthreads();
#pragma unroll 1
        for (int q = tid; q < 32 * 52; q += NTHREADS) { const int row = q / 52, pc = q - row * 52; *(LAS u32x4*)(T + row * MP_P + 8 * pc) = *(const u32x4*)(P + (size_t)(r0 + row) * DINP + PC_MQ + 8 * pc); }
        __syncthreads();
        const int hd = w, tok = lane & 31, h = lane >> 5, p = p0 + tok; const bool lat = p >= CTX; const int sl = p - CTX;
        const LAS bf16* trow = T + tok * MP_P;
        LAS bf16* scr = (LAS bf16*)(F.lds + MP_SCR + w * 6656);
        const size_t bhbase = (size_t)(b * 8 + hd) * LTOT + p0;
        { bf16x8 cq[16]; float ssq = 0.f;
#pragma unroll
          for (int s2 = 0; s2 < 16; ++s2) { const u32x4 x = *(const LAS u32x4*)(trow + 16 * s2 + 8 * h); cq[s2] = __builtin_bit_cast(bf16x8, x);
              ssq += bflo(x.x) * bflo(x.x) + bfhi(x.x) * bfhi(x.x) + bflo(x.y) * bflo(x.y) + bfhi(x.y) * bfhi(x.y) + bflo(x.z) * bflo(x.z) + bfhi(x.z) * bfhi(x.z) + bflo(x.w) * bflo(x.w) + bfhi(x.w) * bfhi(x.w); }
          ssq += sx(ssq, 32);
          const float rinq = rsqrtf(ssq * (1.f / 256.f) + 1e-6f);
          float2 cr[4], cc[4];
#pragma unroll
          for (int f = 0; f < 4; ++f) { cr[f] = lat ? ax[(sl >> 6) * 8 + 4 * h + f] : make_float2(1.f, 0.f); cc[f] = lat ? ax[(sl & 63) * 8 + 4 * h + f] : make_float2(1.f, 0.f); }
          f32x16 acc[3];
#pragma unroll
          for (int cb = 0; cb < 3; ++cb) { f32x16 z = zero16(); const bf16* wrow = WUQ + (size_t)(hd * 96 + cb * 32 + tok) * 256 + 8 * h;
              bf16x8 wf[16];
#pragma unroll
              for (int s2 = 0; s2 < 16; ++s2) wf[s2] = *(const bf16x8*)(wrow + 16 * s2);
              __builtin_amdgcn_sched_barrier(0);
#pragma unroll
              for (int s2 = 0; s2 < 16; ++s2) z = __builtin_amdgcn_mfma_f32_32x32x16_bf16(wf[s2], cq[s2], z, 0, 0, 0);
              __builtin_amdgcn_sched_barrier(0);
              acc[cb] = z; }
          float ss = 0.f;
#pragma unroll
          for (int cb = 0; cb < 3; ++cb)
#pragma unroll
              for (int i = 0; i < 16; ++i) { acc[cb][i] *= rinq; ss += acc[cb][i] * acc[cb][i]; }
          ss += sx(ss, 32);
          const float rq = rsqrtf(ss * (1.f / 96.f) + 1e-6f);
#pragma unroll
          for (int cb = 0; cb < 3; ++cb)
#pragma unroll
              for (int i = 0; i < 16; ++i) acc[cb][i] *= rq * gq[cb * 32 + crow16(i, h)];
#pragma unroll
          for (int i = 0; i < 4; ++i) { const float2 c1 = cr[i]; const float x1 = acc[2][i], x2 = acc[2][i + 4]; acc[2][i] = x1 * c1.x - x2 * c1.y; acc[2][i + 4] = x1 * c1.y + x2 * c1.x;
              const float2 c2 = cc[i]; const float y1 = acc[2][8 + i], y2 = acc[2][12 + i]; acc[2][8 + i] = y1 * c2.x - y2 * c2.y; acc[2][12 + i] = y1 * c2.y + y2 * c2.x; }
#pragma unroll
          for (int cb = 0; cb < 3; ++cb)
#pragma unroll
              for (int g = 0; g < 4; ++g) { u32x2 o; o.x = pk2(acc[cb][4 * g], acc[cb][4 * g + 1]); o.y = pk2(acc[cb][4 * g + 2], acc[cb][4 * g + 3]); *(LAS u32x2*)(scr + tok * MP_SP + cb * 32 + 8 * g + 4 * h) = o; }
          LDS_WAIT();
#pragma unroll
          for (int i = 0; i < 6; ++i) { const int q = lane + 64 * i, row = q / 12, pc = q - row * 12; *(u32x4*)(QB + (bhbase + row) * 96 + 8 * pc) = *(const LAS u32x4*)(scr + row * MP_SP + 8 * pc); }
          LDS_WAIT(); }
        { bf16x8 ckv[8]; float ssk = 0.f;
#pragma unroll
          for (int s2 = 0; s2 < 8; ++s2) { const u32x4 x = *(const LAS u32x4*)(trow + 256 + 16 * s2 + 8 * h); ckv[s2] = __builtin_bit_cast(bf16x8, x);
              ssk += bflo(x.x) * bflo(x.x) + bfhi(x.x) * bfhi(x.x) + bflo(x.y) * bflo(x.y) + bfhi(x.y) * bfhi(x.y) + bflo(x.z) * bflo(x.z) + bfhi(x.z) * bfhi(x.z) + bflo(x.w) * bflo(x.w) + bfhi(x.w) * bfhi(x.w); }
          ssk += sx(ssk, 32);
          const float rinkv = rsqrtf(ssk * (1.f / 128.f) + 1e-6f);
          float pe1[8], pe2[8]; float sspe = 0.f;
          { const u32x4 w0 = *(const LAS u32x4*)(trow + 384 + 16 * h), w1 = *(const LAS u32x4*)(trow + 384 + 16 * h + 8);
            unpack8(w0, pe1); unpack8(w1, pe2);
#pragma unroll
            for (int j = 0; j < 8; ++j) sspe += pe1[j] * pe1[j] + pe2[j] * pe2[j];
            sspe += sx(sspe, 32); }
          float2 cs[8];
#pragma unroll
          for (int f = 0; f < 8; ++f) cs[f] = lat ? ax[(h ? (sl & 63) : (sl >> 6)) * 8 + f] : make_float2(1.f, 0.f);
          f32x16 acc[4];
#pragma unroll
          for (int cb = 0; cb < 4; cb += 2) { f32x16 z0 = zero16(), z1 = zero16(); const bf16* wrow = WUKV + (size_t)(hd * 128 + cb * 32 + tok) * 128 + 8 * h;
              bf16x8 wf0[8], wf1[8];
#pragma unroll
              for (int s2 = 0; s2 < 8; ++s2) { wf0[s2] = *(const bf16x8*)(wrow + 16 * s2); wf1[s2] = *(const bf16x8*)(wrow + 32 * 128 + 16 * s2); }
              __builtin_amdgcn_sched_barrier(0);
#pragma unroll
              for (int s2 = 0; s2 < 8; ++s2) { z0 = __builtin_amdgcn_mfma_f32_32x32x16_bf16(wf0[s2], ckv[s2], z0, 0, 0, 0); z1 = __builtin_amdgcn_mfma_f32_32x32x16_bf16(wf1[s2], ckv[s2], z1, 0, 0, 0); }
              __builtin_amdgcn_sched_barrier(0);
              acc[cb] = z0; acc[cb + 1] = z1; }
          float ss = 0.f;
#pragma unroll
          for (int cb = 0; cb < 4; ++cb)
#pragma unroll
              for (int i = 0; i < 16; ++i) { acc[cb][i] *= rinkv; if (cb < 2) ss += acc[cb][i] * acc[cb][i]; }
          ss += sx(ss, 32);
          const float rk = rsqrtf((ss + sspe) * (1.f / 96.f) + 1e-6f);
#pragma unroll
          for (int cb = 0; cb < 2; ++cb)
#pragma unroll
              for (int g = 0; g < 4; ++g) { float o4[4];
#pragma unroll
                  for (int j = 0; j < 4; ++j) o4[j] = acc[cb][4 * g + j] * rk * gk[cb * 32 + 8 * g + 4 * h + j];
                  u32x2 o; o.x = pk2(o4[0], o4[1]); o.y = pk2(o4[2], o4[3]); *(LAS u32x2*)(scr + tok * MP_SP + cb * 32 + 8 * g + 4 * h) = o; }
          { float pe[16];
#pragma unroll
            for (int f = 0; f < 8; ++f) { const float x1 = pe1[f] * rk * gk[64 + 16 * h + f], x2 = pe2[f] * rk * gk[64 + 16 * h + 8 + f];
                pe[f] = x1 * cs[f].x - x2 * cs[f].y; pe[8 + f] = x1 * cs[f].y + x2 * cs[f].x; }
            *(LAS bf16x8*)(scr + tok * MP_SP + 64 + 16 * h) = pack8(pe); *(LAS bf16x8*)(scr + tok * MP_SP + 64 + 16 * h + 8) = pack8(pe + 8); }
          LDS_WAIT();
#pragma unroll
          for (int i = 0; i < 6; ++i) { const int q = lane + 64 * i, row = q / 12, pc = q - row * 12; *(u32x4*)(KB + (bhbase + row) * 96 + 8 * pc) = *(const LAS u32x4*)(scr + row * MP_SP + 8 * pc); }
          LDS_WAIT();
          { const int pt = permpos(tok);
#pragma unroll
            for (int cb = 2; cb < 4; ++cb)
#pragma unroll
                for (int i = 0; i < 16; ++i) scr[((cb - 2) * 32 + crow16(i, h)) * 40 + pt] = f2bf(acc[cb][i]);
            LDS_WAIT();
            bf16* vt = VT + (size_t)(b * 8 + hd) * 64 * LTOT + p0;
#pragma unroll
            for (int i = 0; i < 4; ++i) { const int q = lane + 64 * i, d = q >> 2, pc = q & 3; *(u32x4*)(vt + (size_t)d * LTOT + 8 * pc) = *(const LAS u32x4*)(scr + d * 40 + 8 * pc); }
            LDS_WAIT(); } }
    }
}

constexpr int ATT_KP = 104, ATT_VP = 72;
constexpr int ATT_KBYTES = 64 * ATT_KP * 2, ATT_VBYTES = 64 * ATT_VP * 2;
DI void attn_unit(Frame& F, int b, int hd, int qblk) {
    const bf16* QB = (const bf16*)(F.ws + WS_QB); const bf16* KB = (const bf16*)(F.ws + WS_KB); const bf16* VT = (const bf16*)(F.ws + WS_VT);
    bf16* O = (bf16*)(F.ws + WS_ABR) + (size_t)NT * 512;
    const int q0 = qblk == 0 ? 0 : CTX + 256 * (qblk - 1), ntiles = qblk == 0 ? CTX / 64 : LTOT / 64;
    const int lane = fresh_lane(), ql = lane & 31, h = lane >> 5, w = F.wave, tid = w * 64 + lane;
    const size_t bh = (size_t)(b * 8 + hd);
    LAS bf16* Kt = (LAS bf16*)(F.lds); LAS bf16* Vt = (LAS bf16*)(F.lds + 2 * ATT_KBYTES);
    bf16x8 qf[6];
    { const bf16* qrow = QB + (bh * LTOT + q0 + 32 * w + ql) * 96 + 8 * h;
#pragma unroll
      for (int s = 0; s < 6; ++s) qf[s] = *(const bf16x8*)(qrow + 16 * s); }
    const bf16* kbase = KB + bh * LTOT * 96; const bf16* vbase = VT + bh * 64 * LTOT;
    const int k1 = tid / 12, c1 = tid - k1 * 12, k2 = (512 + tid) / 12, c2 = (512 + tid) - k2 * 12, vd = tid >> 3, vc = tid & 7;
    u32x4 rk1, rk2 = {0u, 0u, 0u, 0u}, rv;
    rk1 = *(const u32x4*)(kbase + (size_t)k1 * 96 + 8 * c1); if (tid < 256) rk2 = *(const u32x4*)(kbase + (size_t)k2 * 96 + 8 * c2); rv = *(const u32x4*)(vbase + (size_t)vd * LTOT + 8 * vc);
    __syncthreads();
    *(LAS u32x4*)(Kt + k1 * ATT_KP + 8 * c1) = rk1; if (tid < 256) *(LAS u32x4*)(Kt + k2 * ATT_KP + 8 * c2) = rk2; *(LAS u32x4*)(Vt + vd * ATT_VP + 8 * vc) = rv;
    __syncthreads();
    float m = -1.0e30f, lsum = 0.f; f32x16 o0, o1;
#pragma unroll
    for (int i = 0; i < 16; ++i) { o0[i] = 0.f; o1[i] = 0.f; }
    const float sc = 0.10206207261596577f * 1.4426950408889634f;
    for (int t = 0; t < ntiles; ++t) {
        const int buf = t & 1; const bool more = t + 1 < ntiles;
        if (more) { const size_t ko = (size_t)(t + 1) * 64; rk1 = *(const u32x4*)(kbase + (ko + k1) * 96 + 8 * c1); if (tid < 256) rk2 = *(const u32x4*)(kbase + (ko + k2) * 96 + 8 * c2); rv = *(const u32x4*)(vbase + (size_t)vd * LTOT + ko + 8 * vc); }
        const LAS bf16* kt = Kt + buf * (64 * ATT_KP); const LAS bf16* vt = Vt + buf * (64 * ATT_VP);
        f32x16 s0, s1;
#pragma unroll
        for (int i = 0; i < 16; ++i) { s0[i] = 0.f; s1[i] = 0.f; }
        bf16x8 kf0[6], kf1[6];
#pragma unroll
        for (int s = 0; s < 6; ++s) { kf0[s] = *(const LAS bf16x8*)(kt + ql * ATT_KP + 16 * s + 8 * h); kf1[s] = *(const LAS bf16x8*)(kt + (32 + ql) * ATT_KP + 16 * s + 8 * h); }
        __builtin_amdgcn_sched_barrier(0);
#pragma unroll
        for (int s = 0; s < 6; ++s) { s0 = __builtin_amdgcn_mfma_f32_32x32x16_bf16(kf0[s], qf[s], s0, 0, 0, 0); s1 = __builtin_amdgcn_mfma_f32_32x32x16_bf16(kf1[s], qf[s], s1, 0, 0, 0); }
        bf16x8 vf0[4], vf1[4];
#pragma unroll
        for (int ks = 0; ks < 4; ++ks) { vf0[ks] = *(const LAS bf16x8*)(vt + ql * ATT_VP + 16 * ks + 8 * h); vf1[ks] = *(const LAS bf16x8*)(vt + (32 + ql) * ATT_VP + 16 * ks + 8 * h); }
        __builtin_amdgcn_sched_barrier(0);
        float mr = -1.0e30f;
#pragma unroll
        for (int i = 0; i < 16; ++i) mr = fmaxf(mr, fmaxf(s0[i], s1[i]));
        mr = fmaxf(mr, sx(mr, 32));
        const float mn = fmaxf(m, mr * sc), alpha = __builtin_amdgcn_exp2f(m - mn); m = mn;
        float rs = 0.f;
#pragma unroll
        for (int i = 0; i < 16; ++i) { s0[i] = __builtin_amdgcn_exp2f(__builtin_fmaf(s0[i], sc, -mn)); s1[i] = __builtin_amdgcn_exp2f(__builtin_fmaf(s1[i], sc, -mn)); rs += s0[i] + s1[i]; }
        lsum = lsum * alpha + rs;
#pragma unroll
        for (int i = 0; i < 16; ++i) { o0[i] *= alpha; o1[i] *= alpha; }
        bf16x8 pf[4];
        { u32x4 x;
          x.x = pk2(s0[0], s0[1]); x.y = pk2(s0[2], s0[3]); x.z = pk2(s0[4], s0[5]); x.w = pk2(s0[6], s0[7]); pf[0] = __builtin_bit_cast(bf16x8, x);
          x.x = pk2(s0[8], s0[9]); x.y = pk2(s0[10], s0[11]); x.z = pk2(s0[12], s0[13]); x.w = pk2(s0[14], s0[15]); pf[1] = __builtin_bit_cast(bf16x8, x);
          x.x = pk2(s1[0], s1[1]); x.y = pk2(s1[2], s1[3]); x.z = pk2(s1[4], s1[5]); x.w = pk2(s1[6], s1[7]); pf[2] = __builtin_bit_cast(bf16x8, x);
          x.x = pk2(s1[8], s1[9]); x.y = pk2(s1[10], s1[11]); x.z = pk2(s1[12], s1[13]); x.w = pk2(s1[14], s1[15]); pf[3] = __builtin_bit_cast(bf16x8, x); }
        __builtin_amdgcn_sched_barrier(0);
#pragma unroll
        for (int ks = 0; ks < 4; ++ks) { o0 = __builtin_amdgcn_mfma_f32_32x32x16_bf16(vf0[ks], pf[ks], o0, 0, 0, 0); o1 = __builtin_amdgcn_mfma_f32_32x32x16_bf16(vf1[ks], pf[ks], o1, 0, 0, 0); }
        if (more) { const int nb = buf ^ 1; LAS bf16* kn = Kt + nb * (64 * ATT_KP); LAS bf16* vn = Vt + nb * (64 * ATT_VP);
            *(LAS u32x4*)(kn + k1 * ATT_KP + 8 * c1) = rk1; if (tid < 256) *(LAS u32x4*)(kn + k2 * ATT_KP + 8 * c2) = rk2; *(LAS u32x4*)(vn + vd * ATT_VP + 8 * vc) = rv; }
        __syncthreads();
    }
    lsum += sx(lsum, 32);
    const float inv = 1.f / lsum;
    bf16* orow = O + ((size_t)b * LTOT + q0 + 32 * w + ql) * 512 + hd * 64 + 4 * h;
#pragma unroll
    for (int g = 0; g < 4; ++g) { u32x2 x; x.x = pk2(o0[4 * g] * inv, o0[4 * g + 1] * inv); x.y = pk2(o0[4 * g + 2] * inv, o0[4 * g + 3] * inv); *(u32x2*)(orow + 8 * g) = x;
        x.x = pk2(o1[4 * g] * inv, o1[4 * g + 1] * inv); x.y = pk2(o1[4 * g + 2] * inv, o1[4 * g + 3] * inv); *(u32x2*)(orow + 32 + 8 * g) = x; }
}

DI void shift_n(const bf16* prow, bool first, bool last, int col, const float* mup, const float* mun, float* out, int n  ) {
    const bf16* pp = first ? prow : prow - DINP; const bf16* pn = last ? prow : prow + DINP; const float fm = first ? 0.f : 1.f, lm = last ? 0.f : 1.f;
    if (n == 8) {
        const u32x4 c = *(const u32x4*)(prow + col), pv = *(const u32x4*)(pp + col), nx = *(const u32x4*)(pn + col);
        const f32x4 mp0 = *(const f32x4*)(mup + col - PC_RW), mp1 = *(const f32x4*)(mup + col - PC_RW + 4), mn0 = *(const f32x4*)(mun + col - PC_RW), mn1 = *(const f32x4*)(mun + col - PC_RW + 4);
        const unsigned cw[4] = {c.x, c.y, c.z, c.w}, pw[4] = {pv.x, pv.y, pv.z, pv.w}, nw[4] = {nx.x, nx.y, nx.z, nx.w};
        const float mp[8] = {mp0.x, mp0.y, mp0.z, mp0.w, mp1.x, mp1.y, mp1.z, mp1.w}, mn[8] = {mn0.x, mn0.y, mn0.z, mn0.w, mn1.x, mn1.y, mn1.z, mn1.w};
#pragma unroll
        for (int j = 0; j < 4; ++j) { const float t0 = bflo(cw[j]), t1 = bfhi(cw[j]);
            out[2 * j] = t0 + mp[2 * j] * (fm * bflo(pw[j]) - t0) + mn[2 * j] * (lm * bflo(nw[j]) - t0);
            out[2 * j + 1] = t1 + mp[2 * j + 1] * (fm * bfhi(pw[j]) - t1) + mn[2 * j + 1] * (lm * bfhi(nw[j]) - t1); }
    } else {
        const u32x2 c = *(const u32x2*)(prow + col), pv = *(const u32x2*)(pp + col), nx = *(const u32x2*)(pn + col);
        const f32x4 mp0 = *(const f32x4*)(mup + col - PC_RW), mn0 = *(const f32x4*)(mun + col - PC_RW);
        const unsigned cw[2] = {c.x, c.y}, pw[2] = {pv.x, pv.y}, nw[2] = {nx.x, nx.y};
        const float mp[4] = {mp0.x, mp0.y, mp0.z, mp0.w}, mn[4] = {mn0.x, mn0.y, mn0.z, mn0.w};
#pragma unroll
        for (int j = 0; j < 2; ++j) { const float t0 = bflo(cw[j]), t1 = bfhi(cw[j]);
            out[2 * j] = t0 + mp[2 * j] * (fm * bflo(pw[j]) - t0) + mn[2 * j] * (lm * bflo(nw[j]) - t0);
            out[2 * j + 1] = t1 + mp[2 * j + 1] * (fm * bfhi(pw[j]) - t1) + mn[2 * j + 1] * (lm * bfhi(nw[j]) - t1); }
    }
}
constexpr int RP_P = 1928;
DI void phase_rwkv_prep2(Frame& F, const KA& a, int l) {
    const bf16* P = (const bf16*)(F.ws + WS_P);
    const bf16* W2T = (const bf16*)(F.ws + WS_SMALLW + (size_t)l * MiB + SW_W2); const bf16* A2T = (const bf16*)(F.ws + WS_SMALLW + (size_t)l * MiB + SW_A2); const bf16* G2T = (const bf16*)(F.ws + WS_SMALLW + (size_t)l * MiB + SW_G2);
    const float* mup = a.in(I_MUP) + l * 1920; const float* mun = a.in(I_MUN) + l * 1920;
    const float* w0 = a.in(I_W0) + l * 1024; const float* a0 = a.in(I_A0) + l * 1024; const float* kkw = a.in(I_KK) + l * 512; const float* kaw = a.in(I_KA) + l * 512;
    bf16* RW = (bf16*)(F.ws + WS_RW); float* LW = (float*)(F.ws + WS_LW);
    const size_t TS = (size_t)NT * 512;
    LAS bf16* T = (LAS bf16*)F.lds;
#pragma unroll 1
    for (int it = (F.bid + 64) % F.G; it < NT / 32; it += F.G) {
        const int lane = fresh_lane(); int w = F.wave; asm volatile("" : "+s"(w)); const int tid = w * 64 + lane;
        const int r0 = it * 32;
        __syncthreads();
        if (tid < 480) { const int pc = tid % 240, rh = tid / 240, row0 = rh * 16, col = PC_RW + 8 * pc;
            const int ra = r0 + row0, ba = ra / LTOT, pa = ra - ba * LTOT;
            u32x4 rowv[18];
#pragma unroll
            for (int j = 0; j < 18; ++j) { const int p = pa - 1 + j; const bool valid = (p >= 0) && (p < LTOT) && ((p < CTX) == (pa < CTX));
                const int pcl = valid ? p : pa; rowv[j] = *(const u32x4*)(P + ((size_t)ba * LTOT + pcl) * DINP + col); if (!valid) rowv[j] = (u32x4){0u, 0u, 0u, 0u}; }
            const f32x4 mp0 = *(const f32x4*)(mup + 8 * pc), mp1 = *(const f32x4*)(mup + 8 * pc + 4), mn0 = *(const f32x4*)(mun + 8 * pc), mn1 = *(const f32x4*)(mun + 8 * pc + 4);
            const float mp[8] = {mp0.x, mp0.y, mp0.z, mp0.w, mp1.x, mp1.y, mp1.z, mp1.w}, mn[8] = {mn0.x, mn0.y, mn0.z, mn0.w, mn1.x, mn1.y, mn1.z, mn1.w};
#pragma unroll
            for (int j = 0; j < 16; ++j) { float pv[8], cv[8], nv[8], v[8]; unpack8(rowv[j], pv); unpack8(rowv[j + 1], cv); unpack8(rowv[j + 2], nv);
#pragma unroll
                for (int e = 0; e < 8; ++e) v[e] = cv[e] + mp[e] * (pv[e] - cv[e]) + mn[e] * (nv[e] - cv[e]);
                if (pc >= 192 && pc < 208) {
#pragma unroll
                    for (int e = 0; e < 8; ++e) v[e] = 2.f * sigmoidf_(2.f * v[e]) - 1.f; }
                else if (pc >= 224) {
#pragma unroll
                    for (int e = 0; e < 8; ++e) v[e] = sigmoidf_(v[e]); }
                *(LAS bf16x8*)(T + (row0 + j) * RP_P + 8 * pc) = pack8(v); } }
        __syncthreads();
        const int hd = w, tok = lane & 31, h = lane >> 5;
        const LAS bf16* trow = T + tok * RP_P;
#define RP_OUT(c0, dst) do { _Pragma("unroll") for (int i_ = 0; i_ < 4; ++i_) { const int row_ = 8 * i_ + (lane >> 3), pc_ = lane & 7; \
            *(u32x4*)((dst) + (size_t)(r0 + row_) * 512 + hd * 64 + 8 * pc_) = *(const LAS u32x4*)(T + row_ * RP_P + (c0) + 8 * pc_); } } while (0)
        bf16x8 wa[2][8], wg[16], wl[2][8];
#define RP_LDW_A(d_) do { _Pragma("unroll") for (int cb_ = 0; cb_ < 2; ++cb_) _Pragma("unroll") for (int s_ = 0; s_ < 4; ++s_) wa[d_][cb_ * 4 + s_] = *(const bf16x8*)(A2T + (size_t)((d_) * 512 + hd * 64 + cb_ * 32 + tok) * 64 + 16 * s_ + 8 * h); } while (0)
#define RP_LDW_L(d_) do { _Pragma("unroll") for (int cb_ = 0; cb_ < 2; ++cb_) _Pragma("unroll") for (int s_ = 0; s_ < 4; ++s_) wl[d_][cb_ * 4 + s_] = *(const bf16x8*)(W2T + (size_t)((d_) * 512 + hd * 64 + cb_ * 32 + tok) * 64 + 16 * s_ + 8 * h); } while (0)
#define RP_LDW_G() do { _Pragma("unroll") for (int cb_ = 0; cb_ < 2; ++cb_) _Pragma("unroll") for (int s_ = 0; s_ < 8; ++s_) wg[cb_ * 8 + s_] = *(const bf16x8*)(G2T + (size_t)(hd * 64 + cb_ * 32 + tok) * 128 + 16 * s_ + 8 * h); } while (0)
        RP_LDW_A(0);
        RP_OUT(hd * 64, RW); RP_OUT(1024 + hd * 64, RW + 3 * TS);
        float kraw[2][16]; float ss = 0.f;
#pragma unroll
        for (int cb = 0; cb < 2; ++cb)
#pragma unroll
            for (int g = 0; g < 4; ++g) { const int ch = hd * 64 + cb * 32 + 8 * g + 4 * h; const u32x2 kw = *(const LAS u32x2*)(trow + 512 + ch);
                kraw[cb][4 * g] = bflo(kw.x); kraw[cb][4 * g + 1] = bfhi(kw.x); kraw[cb][4 * g + 2] = bflo(kw.y); kraw[cb][4 * g + 3] = bfhi(kw.y);
                const f32x4 kk4 = *(const f32x4*)(kkw + ch);
                ss += kraw[cb][4 * g] * kk4.x * kraw[cb][4 * g] * kk4.x + kraw[cb][4 * g + 1] * kk4.y * kraw[cb][4 * g + 1] * kk4.y + kraw[cb][4 * g + 2] * kk4.z * kraw[cb][4 * g + 2] * kk4.z + kraw[cb][4 * g + 3] * kk4.w * kraw[cb][4 * g + 3] * kk4.w; }
        ss += sx(ss, 32);
        const float rkk = rsqrtf(fmaxf(ss, 1e-24f));
        LDS_WAIT();
        LAS bf16* scr3[3] = {T + hd * 64, T + 1024 + hd * 64, T + 512 + hd * 64};
#define RP_TILE_OUT(vals  , dst, NN) do { LAS bf16* scr = scr3[(NN) % 3]; const int sc0_ = ((NN) % 3 == 0 ? 0 : (NN) % 3 == 1 ? 1024 : 512) + hd * 64; _Pragma("unroll") for (int cb_ = 0; cb_ < 2; ++cb_) _Pragma("unroll") for (int g_ = 0; g_ < 4; ++g_) { u32x2 x_; x_[0] = pk2(vals[cb_][4 * g_], vals[cb_][4 * g_ + 1]); x_[1] = pk2(vals[cb_][4 * g_ + 2], vals[cb_][4 * g_ + 3]); \
            *(LAS u32x2*)(scr + tok * RP_P + cb_ * 32 + 8 * g_ + 4 * h) = x_; } LDS_WAIT(); RP_OUT(sc0_, dst); } while (0)
        { float av[2][16], o[2][16];
#pragma unroll
          for (int d = 0; d < 2; ++d) {
              if (d == 0) RP_LDW_A(1); else RP_LDW_G();
#pragma unroll
              for (int cb = 0; cb < 2; ++cb) { f32x16 c = zero16();
                  bf16x8 xf[4];
#pragma unroll
                  for (int s2 = 0; s2 < 4; ++s2) xf[s2] = *(const LAS bf16x8*)(trow + 1664 + 64 * d + 16 * s2 + 8 * h);
                  __builtin_amdgcn_sched_barrier(0);
#pragma unroll
                  for (int s2 = 0; s2 < 4; ++s2) c = __builtin_amdgcn_mfma_f32_32x32x16_bf16(wa[d][cb * 4 + s2], xf[s2], c, 0, 0, 0);
#pragma unroll
                  for (int g = 0; g < 4; ++g) { const f32x4 a4 = *(const f32x4*)(a0 + d * 512 + hd * 64 + cb * 32 + 8 * g + 4 * h);
                      av[cb][4 * g] = sigmoidf_(a4.x + c[4 * g]); av[cb][4 * g + 1] = sigmoidf_(a4.y + c[4 * g + 1]); av[cb][4 * g + 2] = sigmoidf_(a4.z + c[4 * g + 2]); av[cb][4 * g + 3] = sigmoidf_(a4.w + c[4 * g + 3]); } }
              RP_TILE_OUT(av, RW + (size_t)(5 + d) * TS, 2 * d);
#pragma unroll
              for (int cb = 0; cb < 2; ++cb)
#pragma unroll
                  for (int g = 0; g < 4; ++g) { const f32x4 ka4 = *(const f32x4*)(kaw + hd * 64 + cb * 32 + 8 * g + 4 * h);
                      o[cb][4 * g] = kraw[cb][4 * g] * (1.f + (av[cb][4 * g] - 1.f) * ka4.x); o[cb][4 * g + 1] = kraw[cb][4 * g + 1] * (1.f + (av[cb][4 * g + 1] - 1.f) * ka4.y);
                      o[cb][4 * g + 2] = kraw[cb][4 * g + 2] * (1.f + (av[cb][4 * g + 2] - 1.f) * ka4.z); o[cb][4 * g + 3] = kraw[cb][4 * g + 3] * (1.f + (av[cb][4 * g + 3] - 1.f) * ka4.w); }
              RP_TILE_OUT(o, RW + (size_t)(1 + d) * TS, 2 * d + 1); }
#pragma unroll
          for (int cb = 0; cb < 2; ++cb)
#pragma unroll
              for (int g = 0; g < 4; ++g) { const f32x4 kk4 = *(const f32x4*)(kkw + hd * 64 + cb * 32 + 8 * g + 4 * h);
                  o[cb][4 * g] = kraw[cb][4 * g] * kk4.x * rkk; o[cb][4 * g + 1] = kraw[cb][4 * g + 1] * kk4.y * rkk; o[cb][4 * g + 2] = kraw[cb][4 * g + 2] * kk4.z * rkk; o[cb][4 * g + 3] = kraw[cb][4 * g + 3] * kk4.w * rkk; }
          RP_TILE_OUT(o, RW + 4 * TS, 4); }
        { float o[2][16];
#pragma unroll
          for (int cb = 0; cb < 2; ++cb) { f32x16 c = zero16();
              if (cb == 0) RP_LDW_L(0);
              bf16x8 xf[8];
#pragma unroll
              for (int s2 = 0; s2 < 8; ++s2) xf[s2] = *(const LAS bf16x8*)(trow + 1792 + 16 * s2 + 8 * h);
              __builtin_amdgcn_sched_barrier(0);
#pragma unroll
              for (int s2 = 0; s2 < 8; ++s2) c = __builtin_amdgcn_mfma_f32_32x32x16_bf16(wg[cb * 8 + s2], xf[s2], c, 0, 0, 0);
#pragma unroll
              for (int i = 0; i < 16; ++i) o[cb][i] = c[i]; }
          RP_TILE_OUT(o, RW + 7 * TS, 5); }
#pragma unroll
        for (int d = 0; d < 2; ++d)
#pragma unroll
            for (int cb = 0; cb < 2; ++cb) { f32x16 c = zero16();
                if (d == 0 && cb == 0) RP_LDW_L(1);
                bf16x8 xf[4];
#pragma unroll
                for (int s2 = 0; s2 < 4; ++s2) xf[s2] = *(const LAS bf16x8*)(trow + 1536 + 64 * d + 16 * s2 + 8 * h);
                __builtin_amdgcn_sched_barrier(0);
#pragma unroll
                for (int s2 = 0; s2 < 4; ++s2) c = __builtin_amdgcn_mfma_f32_32x32x16_bf16(wl[d][cb * 4 + s2], xf[s2], c, 0, 0, 0);
                LAS float* fs = (LAS float*)scr3[(6 + 2 * d + cb) % 3];
#pragma unroll
                for (int g = 0; g < 4; ++g) { const f32x4 w4 = *(const f32x4*)(w0 + d * 512 + hd * 64 + cb * 32 + 8 * g + 4 * h);
                    *(LAS f32x4*)(fs + tok * (RP_P / 2) + 8 * g + 4 * h) = (f32x4){-0.6065306597f * sigmoidf_(w4.x + c[4 * g]), -0.6065306597f * sigmoidf_(w4.y + c[4 * g + 1]), -0.6065306597f * sigmoidf_(w4.z + c[4 * g + 2]), -0.6065306597f * sigmoidf_(w4.w + c[4 * g + 3])}; }
                LDS_WAIT();
#pragma unroll
                for (int i_ = 0; i_ < 4; ++i_) { const int row_ = 8 * i_ + (lane >> 3), pc_ = lane & 7;
                    *(f32x4*)(LW + (size_t)d * TS + (size_t)(r0 + row_) * 512 + hd * 64 + cb * 32 + 4 * pc_) = *(const LAS f32x4*)(fs + row_ * (RP_P / 2) + 4 * pc_); } }
        LDS_WAIT();
#undef RP_OUT
#undef RP_TILE_OUT
#undef RP_LDW_A
#undef RP_LDW_L
#undef RP_LDW_G
    }
}

constexpr int NCHUNK = LTOT / 64;
constexpr int NCHAIN = BATCH * 8 * 2;
constexpr int RC_P = 72;
constexpr int RC_TILE = 64 * RC_P * 2;
constexpr int RC_LTF = 13 * RC_TILE, RC_EC = RC_LTF + 64 * 65 * 4;
DI int chain_pos(int dir, int n) { return dir == 0 ? n : (n < CTX ? CTX - 1 - n : LTOT - 1 - (n - CTX)); }
DI f32x16 mm_blk(const LAS bf16* A, int mb, const LAS bf16* Bt, int nb, int k0, int ksteps, int lane, f32x16 acc) {
    const int r = lane & 31, h = lane >> 5;
    bf16x8 fa[4], fb[4];
#pragma unroll
    for (int q = 0; q < 4; ++q) if (q < ksteps) { fa[q] = *(const LAS bf16x8*)(A + (mb * 32 + r) * RC_P + k0 + 16 * q + 8 * h); fb[q] = *(const LAS bf16x8*)(Bt + (nb * 32 + r) * RC_P + k0 + 16 * q + 8 * h); }
    __builtin_amdgcn_sched_barrier(0);
#pragma unroll
    for (int q = 0; q < 4; ++q) if (q < ksteps) acc = __builtin_amdgcn_mfma_f32_32x32x16_bf16(fa[q], fb[q], acc, 0, 0, 0);
    return acc;
}
DI void st_tile_T(LAS bf16* tile, int mb, int nb, const f32x16& d, int lane) {
    const int r = lane & 31, h = lane >> 5;
#pragma unroll
    for (int g = 0; g < 4; ++g) { u32x2 x; x.x = pk2(d[4 * g], d[4 * g + 1]); x.y = pk2(d[4 * g + 2], d[4 * g + 3]); *(LAS u32x2*)(tile + (nb * 32 + r) * RC_P + mb * 32 + 8 * g + 4 * h) = x; }
}
constexpr int RC_LTF2 = 13 * RC_TILE, RC_EC2 = RC_LTF2 + 2 * 32 * 36 * 4, RC_ST = RC_EC2 + 256;
static_assert(RC_ST + RC_TILE <= LDS_MISC_OFF, "rwkv chain LDS map");
DI void rwkv_chain_block(Frame& F, int chain) {
    const int w_ = F.wave;
    const int dir = chain & 1, bh = chain >> 1, b = bh >> 3, hd = bh & 7;
    const bf16* RW = (const bf16*)(F.ws + WS_RW); const float* LW = (const float*)(F.ws + WS_LW); const size_t TS = (size_t)NT * 512;
    bf16* Yg = (bf16*)(F.ws + WS_YF) + (size_t)dir * TS + (size_t)b * LTOT * 512 + hd * 64;
    LAS bf16* tiles = (LAS bf16*)F.lds;
#define TILE(i) (tiles + (i) * (RC_TILE / 2))
    LAS float* LTf = (LAS float*)(F.lds + RC_LTF2); LAS float* EC = (LAS float*)(F.lds + RC_EC2); LAS bf16* ST = (LAS bf16*)(F.lds + RC_ST);
    __syncthreads();
    { const int lane0 = fresh_lane(); for (int i = w_ * 64 + lane0; i < RC_TILE / 4; i += NTHREADS) ((LAS unsigned*)ST)[i] = 0u; }
    f32x4 nl0, nl1; u32x4 nr, nk, nv, nkk, na;
#define RC_LOAD(cc) do { const int lane_ = fresh_lane(); const int p_ = chain_pos(dir, 64 * (cc) + lane_); const size_t off_ = ((size_t)b * LTOT + p_) * 512 + hd * 64 + 8 * w; \
        nl0 = *(const f32x4*)(LW + (size_t)dir * TS + off_); nl1 = *(const f32x4*)(LW + (size_t)dir * TS + off_ + 4); nr = *(const u32x4*)(RW + off_); nk = *(const u32x4*)(RW + (size_t)(1 + dir) * TS + off_); \
        nv = *(const u32x4*)(RW + 3 * TS + off_); nkk = *(const u32x4*)(RW + 4 * TS + off_); na = *(const u32x4*)(RW + (size_t)(5 + dir) * TS + off_); } while (0)
    { const int w = w_; RC_LOAD(0); }
#pragma unroll 1
    for (int c = 0; c < NCHUNK; ++c) {
        const int lane = fresh_lane(); int w = w_; asm volatile("" : "+s"(w));
        { const f32x4 l0 = nl0, l1 = nl1; const u32x4 ur = nr, uk = nk, uv = nv, ukk = nkk, ua = na;
          float lw[8] = {l0.x, l0.y, l0.z, l0.w, l1.x, l1.y, l1.z, l1.w}, cw[8];
#pragma unroll
          for (int j = 0; j < 8; ++j) cw[j] = lw[j];
#pragma unroll
          for (int j = 0; j < 8; ++j) cw[j] = dpp_scan64(cw[j]);
          const unsigned rw_[4] = {ur.x, ur.y, ur.z, ur.w}, kw_[4] = {uk.x, uk.y, uk.z, uk.w}, kkw_[4] = {ukk.x, ukk.y, ukk.z, ukk.w}, aw_[4] = {ua.x, ua.y, ua.z, ua.w};
          float At[8], Rt[8], Bt[8], Kt[8];
#pragma unroll
          for (int j = 0; j < 8; ++j) { const float rr = (j & 1) ? bfhi(rw_[j >> 1]) : bflo(rw_[j >> 1]), kk = (j & 1) ? bfhi(kkw_[j >> 1]) : bflo(kkw_[j >> 1]), k = (j & 1) ? bfhi(kw_[j >> 1]) : bflo(kw_[j >> 1]), aa = (j & 1) ? bfhi(aw_[j >> 1]) : bflo(aw_[j >> 1]);
              const float ep = __expf(cw[j]), em = __expf(-cw[j]), epv = __expf(cw[j] - lw[j]);
              At[j] = -kk * epv; Rt[j] = rr * ep; Bt[j] = kk * aa * em; Kt[j] = k * em;
              if (lane == 63) EC[8 * w + j] = ep; }
          const bf16x8 fa = pack8(At), fr_ = pack8(Rt), fb = pack8(Bt), fk = pack8(Kt);
          *(LAS bf16x8*)(TILE(0) + lane * RC_P + 8 * w) = fa; *(LAS bf16x8*)(TILE(1) + lane * RC_P + 8 * w) = fr_; *(LAS bf16x8*)(TILE(2) + lane * RC_P + 8 * w) = fb; *(LAS bf16x8*)(TILE(3) + lane * RC_P + 8 * w) = fk;
          const unsigned vw_[4] = {uv.x, uv.y, uv.z, uv.w};
#pragma unroll
          for (int j = 0; j < 8; ++j) { TILE(4)[(8 * w + j) * RC_P + lane] = (bf16)fa[j]; TILE(5)[(8 * w + j) * RC_P + lane] = (bf16)fb[j]; TILE(6)[(8 * w + j) * RC_P + lane] = (bf16)fk[j];
              TILE(7)[(8 * w + j) * RC_P + lane] = (bf16)((j & 1) ? (vw_[j >> 1] >> 16) : (vw_[j >> 1] & 0xffffu)); } }
        LDS_BARRIER();
        if (c + 1 < NCHUNK) RC_LOAD(c + 1);
        { const int pi = w >> 1, nb = w & 1, r = lane & 31, h = lane >> 5;
          const LAS bf16* Aop = (pi == 0 || pi == 2) ? TILE(2) : TILE(3);
          const LAS bf16* Bop = pi < 2 ? TILE(0) : TILE(1);
          LAS bf16* dst = TILE(8 + pi);
#pragma unroll
          for (int mb = 0; mb < 2; ++mb) { f32x16 d = zero16();
              if (mb <= nb) d = mm_blk(Aop, mb, Bop, nb, 0, 4, lane, d);
#pragma unroll
              for (int i = 0; i < 16; ++i) { const int m = mb * 32 + crow16(i, h), n = nb * 32 + r; const bool keep = pi < 2 ? m < n : m <= n; d[i] = keep ? d[i] : 0.f; }
              st_tile_T(dst, mb, nb, d, lane);
              if (pi == 0 && mb == nb) {
#pragma unroll
                  for (int i = 0; i < 16; ++i) LTf[(mb * 32 + crow16(i, h)) * 36 + r] = d[i]; } } }
        LDS_BARRIER();
        if (w == 0) {
            { const int k = lane >> 4, tl = lane & 15, blk = k >> 1, o16 = (k & 1) * 16;
              float Tr[16];
#pragma unroll
              for (int i = 0; i < 16; ++i) Tr[i] = 0.f;
#pragma unroll
              for (int cc = 15; cc >= 0; --cc) { float a0 = (cc == tl) ? 1.f : 0.f, a1 = 0.f;
                  const LAS float* lrow = LTf + (blk * 32 + o16 + cc) * 36 + o16;
#pragma unroll
                  for (int q4 = (cc + 1) >> 2; q4 < 4; ++q4) { const f32x4 l4 = *(const LAS f32x4*)(lrow + 4 * q4);
#pragma unroll
                      for (int e = 0; e < 4; ++e) { const int s2 = 4 * q4 + e; if (s2 > cc) { if (e & 1) a1 += Tr[s2] * l4[e]; else a0 += Tr[s2] * l4[e]; } } }
                  Tr[cc] = a0 + a1; if ((cc & 3) == 0) asm volatile("" ::: "memory"); }
              unsigned z0; asm volatile("v_mov_b32 %0, 0" : "=v"(z0)); const u32x4 zz = {z0, z0, z0, z0};
              LAS bf16* trow = TILE(12) + lane * RC_P; LAS bf16* ttrow = TILE(0) + lane * RC_P;
#pragma unroll
              for (int g = 0; g < 8; ++g) { *(LAS u32x4*)(trow + 8 * g) = zz; *(LAS u32x4*)(ttrow + 8 * g) = zz; }
              *(LAS bf16x8*)(trow + 16 * k) = pack8(Tr); *(LAS bf16x8*)(trow + 16 * k + 8) = pack8(Tr + 8);
#pragma unroll
              for (int i = 0; i < 16; ++i) TILE(0)[(16 * k + i) * RC_P + lane] = f2bf(Tr[i]); }
            LDS_WAIT();
            { const int r = lane & 31, h = lane >> 5;
#pragma unroll
              for (int blk = 0; blk < 2; ++blk) {
                  f32x16 x = zero16();
                  x = __builtin_amdgcn_mfma_f32_32x32x16_bf16(*(const LAS bf16x8*)(TILE(8) + (32 * blk + r) * RC_P + 32 * blk + 8 * h), *(const LAS bf16x8*)(TILE(0) + (32 * blk + r) * RC_P + 32 * blk + 8 * h), x, 0, 0, 0);
                  st_tile_T(TILE(2), 0, blk, x, lane);
                  LDS_WAIT();
                  f32x16 d = zero16();
                  d = __builtin_amdgcn_mfma_f32_32x32x16_bf16(*(const LAS bf16x8*)(TILE(12) + (32 * blk + r) * RC_P + 32 * blk + 16 + 8 * h), *(const LAS bf16x8*)(TILE(2) + (32 * blk + r) * RC_P + 16 + 8 * h), d, 0, 0, 0);
                  if (r < 16) {
#pragma unroll
                      for (int i = 8; i < 16; ++i) TILE(12)[(32 * blk + crow16(i, h)) * RC_P + 32 * blk + r] = f2bf(d[i]);
                      { u32x2 y0, y1; y0.x = pk2(d[8], d[9]); y0.y = pk2(d[10], d[11]); y1.x = pk2(d[12], d[13]); y1.y = pk2(d[14], d[15]);
                        *(LAS u32x2*)(TILE(0) + (32 * blk + r) * RC_P + 32 * blk + 16 + 4 * h) = y0; *(LAS u32x2*)(TILE(0) + (32 * blk + r) * RC_P + 32 * blk + 24 + 4 * h) = y1; } }
                  LDS_WAIT(); } }
            LDS_WAIT();
            f32x16 m1 = mm_blk(TILE(8), 1, TILE(0), 0, 0, 2, lane, zero16());
            st_tile_T(TILE(2), 0, 0, m1, lane);
            LDS_WAIT();
            { const int r = lane & 31, h = lane >> 5; f32x16 d = zero16();
#pragma unroll
              for (int q = 0; q < 2; ++q) { const bf16x8 a = *(const LAS bf16x8*)(TILE(2) + r * RC_P + 16 * q + 8 * h), bb = *(const LAS bf16x8*)(TILE(12) + (32 + r) * RC_P + 32 + 16 * q + 8 * h);
                  d = __builtin_amdgcn_mfma_f32_32x32x16_bf16(a, bb, d, 0, 0, 0); }
#pragma unroll
              for (int g = 0; g < 4; ++g) { u32x2 x; x.x = pk2(d[4 * g], d[4 * g + 1]); x.y = pk2(d[4 * g + 2], d[4 * g + 3]); *(LAS u32x2*)(TILE(12) + (32 + r) * RC_P + 8 * g + 4 * h) = x; } }
        } else if (w <= 4) {
            const int mb = (w - 1) >> 1, nb = (w - 1) & 1;
            const f32x16 u = mm_blk(TILE(9), mb, TILE(7), nb, 0, 4, lane, zero16());
            st_tile_T(TILE(3), mb, nb, u, lane);
        }
        LDS_BARRIER();
        { const int mb = (w >> 1) & 1, nb = w & 1;
          if (w < 4) { const f32x16 d = mm_blk(TILE(12), mb, TILE(4), nb, 0, 4, lane, zero16()); st_tile_T(TILE(2), mb, nb, d, lane); }
          else { const f32x16 d = mm_blk(TILE(12), mb, TILE(3), nb, 0, 4, lane, zero16()); st_tile_T(TILE(0), mb, nb, d, lane); } }
        LDS_BARRIER();
        const int mb = (w >> 1) & 1, nb = w & 1, r = lane & 31, h = lane >> 5;
        f32x16 cin;
        if (w < 4) {
            f32x16 d = mm_blk(TILE(2), mb, TILE(5), nb, 0, 4, lane, zero16());
#pragma unroll
            for (int i = 0; i < 16; ++i) { const int m = mb * 32 + crow16(i, h), n = nb * 32 + r; d[i] = (d[i] + (m == n ? 1.f : 0.f)) * EC[n]; }
            st_tile_T(TILE(8), mb, nb, d, lane);
            cin = mm_blk(TILE(5), mb, TILE(0), nb, 0, 4, lane, zero16()); cin = mm_blk(TILE(6), mb, TILE(7), nb, 0, 4, lane, cin);
#pragma unroll
            for (int i = 0; i < 16; ++i) cin[i] *= EC[mb * 32 + crow16(i, h)];
        } else {
            f32x16 d = mm_blk(TILE(2), mb, TILE(10), nb, 0, 4, lane, zero16());
#pragma unroll
            for (int i = 0; i < 16; ++i) { const int m = mb * 32 + crow16(i, h), n = nb * 32 + r; d[i] += bf2f(TILE(1)[n * RC_P + m]); }
            st_tile_T(TILE(9), mb, nb, d, lane);
            cin = mm_blk(TILE(10), mb, TILE(0), nb, 0, 4, lane, zero16()); cin = mm_blk(TILE(11), mb, TILE(7), nb, 0, 4, lane, cin);
        }
        LDS_BARRIER();
        if (w < 4) cin = mm_blk(TILE(8), mb, ST, nb, 0, 4, lane, cin);
        else { cin = mm_blk(TILE(9), mb, ST, nb, 0, 4, lane, cin);
#pragma unroll
            for (int i = 0; i < 16; ++i) { const int p = chain_pos(dir, 64 * c + mb * 32 + crow16(i, h)); Yg[(size_t)p * 512 + nb * 32 + r] = f2bf(cin[i]); } }
        LDS_BARRIER();
        if (w < 4) st_tile_T(ST, mb, nb, cin, lane);
    }
#undef RC_LOAD
#undef TILE
}
constexpr int RT_QP = 72, RT_TP = 136;
constexpr int RT_QS = 0, RT_KS = 128 * RT_QP * 2, RT_KT = 2 * 128 * RT_QP * 2, RT_VT = RT_KT + 64 * RT_TP * 2, RT_ST = RT_VT + 128 * RT_TP * 2;
DI void phase_retention_item(Frame& F, const KA& a, int item) {
    const int b = item >> 2, hh = item & 3, w = F.wave;
    const bf16* P = (const bf16*)(F.ws + WS_P); const float2* rt = (const float2*)(F.ws + WS_ROPE);
    bf16* OFB = (bf16*)(F.ws + WS_OF); const size_t TS = (size_t)NT * 512;
    LAS bf16* Qs = (LAS bf16*)(F.lds + RT_QS); LAS bf16* Ks = (LAS bf16*)(F.lds + RT_KS); LAS bf16* KsT = (LAS bf16*)(F.lds + RT_KT); LAS bf16* VsT = (LAS bf16*)(F.lds + RT_VT); LAS bf16* SsT = (LAS bf16*)(F.lds + RT_ST);
    const float lg2g = log2f(1.f - exp2f(-5.f - (float)hh));
    const float gam = exp2f(lg2g), g127 = exp2f(127.f * lg2g), cdec = exp2f(128.f * lg2g);
    const int rb = w >> 1, cbp = w & 1, db = w >> 2, vb = w & 3;
    for (int dir = 0; dir < 2; ++dir) {
        const int lane = fresh_lane(); const int tid = w * 64 + lane, ql = lane & 31, h = lane >> 5;
        f32x16 Sreg;
#pragma unroll
        for (int i = 0; i < 16; ++i) Sreg[i] = 0.f;
        __syncthreads();
        for (int i = tid; i < 128 * RT_QP / 2; i += NTHREADS) ((LAS unsigned*)SsT)[i] = 0u;
        for (int cn = 0; cn < 34; ++cn) {
            int p0; if (cn < 2) p0 = 128 * (dir ? 1 - cn : cn); else p0 = CTX + 128 * (dir ? 33 - cn : cn - 2);
            const bool lat = p0 >= CTX;
            { int tid_o = tid; asm volatile("" : "+v"(tid_o)); const int tok = tid_o >> 2, c = tid_o & 3; const int e = dir ? 127 - tok : tok; const size_t row = (size_t)b * LTOT + p0 + tok; const bf16* prow = P + row * DINP;
              const float sq = exp2f((float)e * lg2g), sk = 0.125f * exp2f(-(float)e * lg2g);
              const u32x4 ql_ = *(const u32x4*)(prow + PC_RQ + hh * 64 + 8 * c), qh_ = *(const u32x4*)(prow + PC_RQ + hh * 64 + 32 + 8 * c);
              const u32x4 kl_ = *(const u32x4*)(prow + PC_RK + hh * 64 + 8 * c), kh_ = *(const u32x4*)(prow + PC_RK + hh * 64 + 32 + 8 * c);
              float qlo[8] = {bflo(ql_.x), bfhi(ql_.x), bflo(ql_.y), bfhi(ql_.y), bflo(ql_.z), bfhi(ql_.z), bflo(ql_.w), bfhi(ql_.w)}, qhi[8] = {bflo(qh_.x), bfhi(qh_.x), bflo(qh_.y), bfhi(qh_.y), bflo(qh_.z), bfhi(qh_.z), bflo(qh_.w), bfhi(qh_.w)};
              float klo[8] = {bflo(kl_.x), bfhi(kl_.x), bflo(kl_.y), bfhi(kl_.y), bflo(kl_.z), bfhi(kl_.z), bflo(kl_.w), bfhi(kl_.w)}, khi[8] = {bflo(kh_.x), bfhi(kh_.x), bflo(kh_.y), bfhi(kh_.y), bflo(kh_.z), bfhi(kh_.z), bflo(kh_.w), bfhi(kh_.w)};
              if (lat) { const float2* ang = rt + (size_t)(p0 - CTX + tok) * 32 + 8 * c;
#pragma unroll
                  for (int j = 0; j < 8; ++j) { const float2 cs = ang[j]; const float a0 = qlo[j], a1 = qhi[j], b0 = klo[j], b1 = khi[j];
                      qlo[j] = a0 * cs.x - a1 * cs.y; qhi[j] = a0 * cs.y + a1 * cs.x; klo[j] = b0 * cs.x - b1 * cs.y; khi[j] = b0 * cs.y + b1 * cs.x; } }
#pragma unroll
              for (int j = 0; j < 8; ++j) { qlo[j] *= sq; qhi[j] *= sq; klo[j] *= sk; khi[j] *= sk; }
              *(LAS bf16x8*)(Qs + tok * RT_QP + 8 * c) = pack8(qlo); *(LAS bf16x8*)(Qs + tok * RT_QP + 32 + 8 * c) = pack8(qhi);
              *(LAS bf16x8*)(Ks + tok * RT_QP + 8 * c) = pack8(klo); *(LAS bf16x8*)(Ks + tok * RT_QP + 32 + 8 * c) = pack8(khi);
              const int pt = permpos(tok);
#pragma unroll
              for (int j = 0; j < 8; ++j) { KsT[(8 * c + j) * RT_TP + pt] = f2bf(klo[j]); KsT[(32 + 8 * c + j) * RT_TP + pt] = f2bf(khi[j]); }
#pragma unroll
              for (int q4 = 0; q4 < 4; ++q4) { const u32x4 vv = *(const u32x4*)(prow + PC_RV + hh * 128 + 32 * c + 8 * q4); const unsigned vw[4] = {vv.x, vv.y, vv.z, vv.w};
#pragma unroll
                  for (int j = 0; j < 4; ++j) { VsT[(32 * c + 8 * q4 + 2 * j) * RT_TP + pt] = (bf16)(vw[j] & 0xffffu); VsT[(32 * c + 8 * q4 + 2 * j + 1) * RT_TP + pt] = (bf16)(vw[j] >> 16); } } }
            __syncthreads();
            f32x16 o0, o1;
#pragma unroll
            for (int i = 0; i < 16; ++i) { o0[i] = 0.f; o1[i] = 0.f; }
            for (int kb = 0; kb < 4; ++kb) {
                if (dir == 0 ? kb > rb : kb < rb) continue;
                f32x16 x;
#pragma unroll
                for (int i = 0; i < 16; ++i) x[i] = 0.f;
#pragma unroll
                for (int s = 0; s < 4; ++s) x = __builtin_amdgcn_mfma_f32_32x32x16_bf16(*(const LAS bf16x8*)(Ks + (kb * 32 + ql) * RT_QP + 16 * s + 8 * h), *(const LAS bf16x8*)(Qs + (rb * 32 + ql) * RT_QP + 16 * s + 8 * h), x, 0, 0, 0);
                if (kb == rb) {
#pragma unroll
                    for (int i = 0; i < 16; ++i) { const int key = crow16(i, h); const bool keep = dir == 0 ? key <= ql : key >= ql; x[i] = keep ? x[i] : 0.f; } }
                float xv[16];
#pragma unroll
                for (int i = 0; i < 16; ++i) xv[i] = x[i];
                const bf16x8 xa0 = pack8(xv), xa1 = pack8(xv + 8);
                const LAS bf16* v0 = VsT + ((2 * cbp) * 32 + ql) * RT_TP + kb * 32 + 8 * h; const LAS bf16* v1 = VsT + ((2 * cbp + 1) * 32 + ql) * RT_TP + kb * 32 + 8 * h;
                o0 = __builtin_amdgcn_mfma_f32_32x32x16_bf16(xa0, *(const LAS bf16x8*)(v0), o0, 0, 0, 0); o0 = __builtin_amdgcn_mfma_f32_32x32x16_bf16(xa1, *(const LAS bf16x8*)(v0 + 16), o0, 0, 0, 0);
                o1 = __builtin_amdgcn_mfma_f32_32x32x16_bf16(xa0, *(const LAS bf16x8*)(v1), o1, 0, 0, 0); o1 = __builtin_amdgcn_mfma_f32_32x32x16_bf16(xa1, *(const LAS bf16x8*)(v1 + 16), o1, 0, 0, 0);
            }
#pragma unroll
            for (int s = 0; s < 4; ++s) { const bf16x8 qa = *(const LAS bf16x8*)(Qs + (rb * 32 + ql) * RT_QP + 16 * s + 8 * h);
                o0 = __builtin_amdgcn_mfma_f32_32x32x16_bf16(qa, *(const LAS bf16x8*)(SsT + ((2 * cbp) * 32 + ql) * RT_QP + 16 * s + 8 * h), o0, 0, 0, 0);
                o1 = __builtin_amdgcn_mfma_f32_32x32x16_bf16(qa, *(const LAS bf16x8*)(SsT + ((2 * cbp + 1) * 32 + ql) * RT_QP + 16 * s + 8 * h), o1, 0, 0, 0); }
            { bf16* op = OFB + (size_t)dir * TS + ((size_t)b * LTOT + p0 + rb * 32) * 512 + hh * 128 + (2 * cbp) * 32 + ql;
#pragma unroll
              for (int i = 0; i < 16; ++i) { op[(size_t)crow16(i, h) * 512] = f2bf(o0[i]); op[(size_t)crow16(i, h) * 512 + 32] = f2bf(o1[i]); } }
            f32x16 u;
#pragma unroll
            for (int i = 0; i < 16; ++i) u[i] = 0.f;
#pragma unroll
            for (int s = 0; s < 8; ++s) u = __builtin_amdgcn_mfma_f32_32x32x16_bf16(*(const LAS bf16x8*)(KsT + (db * 32 + ql) * RT_TP + 16 * s + 8 * h), *(const LAS bf16x8*)(VsT + (vb * 32 + ql) * RT_TP + 16 * s + 8 * h), u, 0, 0, 0);
#pragma unroll
            for (int i = 0; i < 16; ++i) Sreg[i] = cdec * Sreg[i] + g127 * u[i];
            __syncthreads();
#pragma unroll
            for (int g = 0; g < 4; ++g) { u32x2 x; x.x = pk2(gam * Sreg[4 * g], gam * Sreg[4 * g + 1]); x.y = pk2(gam * Sreg[4 * g + 2], gam * Sreg[4 * g + 3]);
                *(LAS u32x2*)(SsT + (vb * 32 + ql) * RT_QP + db * 32 + 8 * g + 4 * h) = x; }
        }
    }
}

DI void phase_mixer_finish(Frame& F, const KA& a, int l) {
    const int lane = fresh_lane(), gw = F.bid * NWAVES + F.wave, NGW = F.G * NWAVES;
    const size_t TS = (size_t)NT * 512;
    const bf16* P = (const bf16*)(F.ws + WS_P); const bf16* OFB = (const bf16*)(F.ws + WS_OF); const bf16* YF = (const bf16*)(F.ws + WS_YF); const bf16* RW = (const bf16*)(F.ws + WS_RW);
    bf16* O0 = (bf16*)(F.ws + WS_ABR); bf16* O2 = O0 + 2 * TS;
    const float* lng = a.in(I_LNXG) + l * 512 + 8 * lane; const float* lnb = a.in(I_LNXB) + l * 512 + 8 * lane; const float* rkw = a.in(I_RK) + l * 512 + 8 * lane;
    float g_[8], b_[8], rk_[8];
    { const f32x4 x0 = *(const f32x4*)lng, x1 = *(const f32x4*)(lng + 4), y0 = *(const f32x4*)lnb, y1 = *(const f32x4*)(lnb + 4), z0 = *(const f32x4*)rkw, z1 = *(const f32x4*)(rkw + 4);
      g_[0] = x0.x; g_[1] = x0.y; g_[2] = x0.z; g_[3] = x0.w; g_[4] = x1.x; g_[5] = x1.y; g_[6] = x1.z; g_[7] = x1.w;
      b_[0] = y0.x; b_[1] = y0.y; b_[2] = y0.z; b_[3] = y0.w; b_[4] = y1.x; b_[5] = y1.y; b_[6] = y1.z; b_[7] = y1.w;
      rk_[0] = z0.x; rk_[1] = z0.y; rk_[2] = z0.z; rk_[3] = z0.w; rk_[4] = z1.x; rk_[5] = z1.y; rk_[6] = z1.z; rk_[7] = z1.w; }
#pragma unroll 1
    for (int r0 = gw; r0 < NT; r0 += 2 * NGW) {
        u32x4 uyf[2], uyb[2], ur[2], ukf[2], ukb[2], uv[2], ug[2], uof[2], uob[2], ugf[2], ugb[2]; size_t oo[2]; bool act[2];
#pragma unroll
        for (int u = 0; u < 2; ++u) { int r = r0 + u * NGW; act[u] = r < NT; if (!act[u]) r = r0; const size_t o = (size_t)r * 512 + 8 * lane; oo[u] = o;
            uyf[u] = *(const u32x4*)(YF + o); uyb[u] = *(const u32x4*)(YF + TS + o); ur[u] = *(const u32x4*)(RW + o); ukf[u] = *(const u32x4*)(RW + TS + o); ukb[u] = *(const u32x4*)(RW + 2 * TS + o);
            uv[u] = *(const u32x4*)(RW + 3 * TS + o); ug[u] = *(const u32x4*)(RW + 7 * TS + o); uof[u] = *(const u32x4*)(OFB + o); uob[u] = *(const u32x4*)(OFB + TS + o);
            ugf[u] = *(const u32x4*)(P + (size_t)r * DINP + PC_RGF + 8 * lane); ugb[u] = *(const u32x4*)(P + (size_t)r * DINP + PC_RGB + 8 * lane); }
        __builtin_amdgcn_sched_barrier(0);
#pragma unroll
        for (int u = 0; u < 2; ++u) { if (!act[u]) continue; const size_t o = oo[u];
            { float yfv[8], ybv[8], s[8]; unpack8(uyf[u], yfv); unpack8(uyb[u], ybv);
#pragma unroll
              for (int j = 0; j < 8; ++j) s[j] = yfv[j] + ybv[j];
              float rr[8], kf[8], kb[8], vv[8], gg[8]; unpack8(ur[u], rr); unpack8(ukf[u], kf); unpack8(ukb[u], kb); unpack8(uv[u], vv); unpack8(ug[u], gg);
              float sm = 0.f, bn = 0.f;
#pragma unroll
              for (int j = 0; j < 8; ++j) { sm += s[j]; bn += rr[j] * (kf[j] + kb[j]) * rk_[j]; }
              sm += sx(sm, 1); sm += sx(sm, 2); sm += sx(sm, 4); bn += sx(bn, 1); bn += sx(bn, 2); bn += sx(bn, 4);
              const float mean = sm * (1.f / 64.f); float vs = 0.f;
#pragma unroll
              for (int j = 0; j < 8; ++j) { s[j] -= mean; vs += s[j] * s[j]; }
              vs += sx(vs, 1); vs += sx(vs, 2); vs += sx(vs, 4);
              const float rstd = rsqrtf(vs * (1.f / 64.f) + 64e-5f);
              float y[8];
#pragma unroll
              for (int j = 0; j < 8; ++j) y[j] = (s[j] * rstd * g_[j] + b_[j] + bn * vv[j]) * gg[j];
              *(bf16x8*)(O2 + o) = pack8(y); }
            { float ff[8], bb[8], gf[8], gb[8]; unpack8(uof[u], ff); unpack8(uob[u], bb); unpack8(ugf[u], gf); unpack8(ugb[u], gb);
              float sf = 0.f, sb = 0.f;
#pragma unroll
              for (int j = 0; j < 8; ++j) { sf += ff[j]; sb += bb[j]; }
#pragma unroll
              for (int o2 = 1; o2 < 16; o2 <<= 1) { sf += sx(sf, o2); sb += sx(sb, o2); }
              const float mf = sf * (1.f / 128.f), mb = sb * (1.f / 128.f); float vf = 0.f, vb = 0.f;
#pragma unroll
              for (int j = 0; j < 8; ++j) { ff[j] -= mf; bb[j] -= mb; vf += ff[j] * ff[j]; vb += bb[j] * bb[j]; }
#pragma unroll
              for (int o2 = 1; o2 < 16; o2 <<= 1) { vf += sx(vf, o2); vb += sx(vb, o2); }
              const float rf = rsqrtf(vf * (1.f / 128.f) + 1e-5f), rb = rsqrtf(vb * (1.f / 128.f) + 1e-5f);
              float y[8];
#pragma unroll
              for (int j = 0; j < 8; ++j) y[j] = ff[j] * rf * (gf[j] * sigmoidf_(gf[j])) + bb[j] * rb * (gb[j] * sigmoidf_(gb[j]));
              *(bf16x8*)(O0 + o) = pack8(y); } }
    }
}

constexpr int N_PHASES = 2 + 10 * DEPTH;
__global__ void __launch_bounds__(NTHREADS, 2) fwd_kernel(Args args) {
    extern __shared__ __attribute__((aligned(16))) unsigned char lds_raw[];
    Frame F;
    F.lds = (LAS unsigned char*)lds_raw;
    F.MISC = (volatile LAS unsigned*)(F.lds + LDS_MISC_OFF);
    F.tid = threadIdx.x; F.lane = F.tid & 63; F.wave = __builtin_amdgcn_readfirstlane(F.tid >> 6);
    F.G = gridDim.x; F.bid = blockIdx.x;
    F.ws = args.ws; F.ctl = (unsigned*)(args.ws + WS_CTL);
    if (F.tid < 32) F.MISC[F.tid] = 0u;
    __syncthreads();
    const int lo = args.ph_lo, hi = args.ph_hi;
    KA ka; ka.kp = (const CAS char*)__builtin_amdgcn_kernarg_segment_ptr();
    const bool multi = (hi - lo) > 1;
    XcdBarrier bar; bar.bar = F.ctl + CW_BAR; bar.x = 0; bar.st = nullptr;
    if (multi) bar = xcd_barrier_post(F.ctl + CW_BAR, F.MISC + 8);
#define IN(k) (lo <= (k) && (k) < hi)
#define OPQ() do { int l_; asm volatile("v_mbcnt_lo_u32_b32 %0, -1, 0\n\tv_mbcnt_hi_u32_b32 %0, -1, %0" : "=v"(l_)); { int b_ = F.bid, w_ = F.wave, g_ = F.G; asm volatile("" : "+s"(b_), "+s"(w_), "+s"(g_)); F.bid = b_; F.wave = w_; F.G = g_; } F.lane = l_; F.tid = F.wave * 64 + l_; \
        const CAS char* kp_ = (const CAS char*)__builtin_amdgcn_kernarg_segment_ptr(); asm volatile("" : "+s"(kp_)); ka.kp = kp_; F.ws = ka.ws(); F.ctl = (unsigned*)(F.ws + WS_CTL); } while (0)
#define SEAM(k) do { if (IN(k) && IN((k) + 1)) xcd_barrier(bar); } while (0)

    if (IN(0)) { OPQ(); phase_prologue(F, ka); } SEAM(0);
    if (IN(1)) { OPQ(); phase_init_rows(F, ka); } SEAM(1);

    for (int l = 0; l < DEPTH; ++l) {
        const int pb = 2 + 10 * l;
        if (IN(pb + 0)) { OPQ(); unsigned char* ws = F.ws;
            SchedInproj S; S.T.init(NT / 256, DINP / 256, F.G, F.bid); S.A = (const char*)(ws + WS_H); S.B = (const char*)(ws + WS_WIN + (size_t)l * 15 * MiB);
            EpiStoreBf16 E{(bf16*)(ws + WS_P), DINP};
            pg8::gemm_phase<EpiStoreBf16, SchedInproj, false>(F.lds, 1024, S, E, F.tid);
        }
        SEAM(pb + 0);
        if (IN(pb + 1)) { OPQ(); phase_mla_prep2(F, ka, l); OPQ(); phase_rwkv_prep2(F, ka, l); }
        SEAM(pb + 1);
#define ATTN_QUEUE(qword, ubeg, uend) do { const int xq_ = F.bid & 7; for (;;) { __syncthreads(); \
            if (F.wave == 0 && fresh_lane() == 0) F.MISC[0] = (unsigned)(ubeg) + __hip_atomic_fetch_add(F.ctl + (qword) + xq_, 1u, __ATOMIC_RELAXED, __HIP_MEMORY_SCOPE_AGENT); \
            __syncthreads(); const int u = (int)F.MISC[0]; if (u >= (uend)) break; \
            if (u < 128) attn_unit(F, u >> 4, xq_, 1 + (u & 15)); else attn_unit(F, u - 128, xq_, 0); } } while (0)
        const int nunits = (l == DEPTH - 1) ? 128 : 136;
        if (IN(pb + 2)) { OPQ();
            if (F.bid < NCHAIN) rwkv_chain_block(F, F.bid);
            else if (F.bid < NCHAIN + 32) phase_retention_item(F, ka, F.bid - NCHAIN);
            OPQ(); ATTN_QUEUE(CW_Q + l * 64, 0, nunits);
        }
        SEAM(pb + 2);
        if (IN(pb + 3)) { OPQ(); phase_mixer_finish(F, ka, l); }
        SEAM(pb + 3);
        if (IN(pb + 4)) { OPQ(); unsigned char* ws = F.ws;
            SchedMerge S; S.T.init(NT / 256, 4, F.G, F.bid, l == DEPTH - 1); S.A = (const char*)(ws + WS_ABR); S.B = (const char*)(ws + WS_WBR + (size_t)l * 3 * MiB);
            EpiMerge E{(const bf16*)(ws + WS_P), (bf16*)(ws + WS_MRG)};
            pg8::gemm_phase<EpiMerge, SchedMerge, false>(F.lds, 512, S, E, F.tid);
        }
        SEAM(pb + 4);
        if (IN(pb + 5)) { OPQ(); unsigned char* ws = F.ws;
            SchedPlain S; S.T.init(NT / 256, 4, F.G, F.bid, l == DEPTH - 1); S.A = (const char*)(ws + WS_MRG); S.B = (const char*)(ws + WS_WOUT + (size_t)l * 2 * MiB); S.K = 1024;
            EpiResid E{(float*)(ws + WS_X), (const float*)(ws + WS_MOD) + (size_t)l * 9 * 6144};
            pg8::gemm_phase<EpiResid, SchedPlain, false>(F.lds, 1024, S, E, F.tid);
        }
        SEAM(pb + 5);
        if (IN(pb + 6)) { OPQ(); phase_router(F, ka, l); }
        SEAM(pb + 6);
        if (IN(pb + 7)) { OPQ(); unsigned char* ws = F.ws;
            moe_build_table(F, F.ctl + CW_CNT + l * 32 * 16);
            SchedMoe S{(const LAS int*)(F.lds + LDS_TAB_OFF), (const char*)(ws + WS_H), (const char*)(ws + WS_WGU + (size_t)l * 128 * MiB), (const int*)(ws + WS_LIST), 8, F.bid, F.G, 0, (size_t)2048 * 1024 * 2, true};
            EpiSwiglu E{(bf16*)(ws + WS_ACT), ka.in(I_BGU) + (size_t)l * 32 * 2048};
            pg8::gemm_phase<EpiSwiglu, SchedMoe, true>(F.lds, 1024, S, E, F.tid);
        }
        SEAM(pb + 7);
        if (IN(pb + 8)) { OPQ(); unsigned char* ws = F.ws;
            moe_build_table(F, F.ctl + CW_CNT + l * 32 * 16);
            SchedMoe S{(const LAS int*)(F.lds + LDS_TAB_OFF), (const char*)(ws + WS_ACT), (const char*)(ws + WS_WDN + (size_t)l * 64 * MiB), (const int*)(ws + WS_LIST), 4, F.bid, F.G, 0, (size_t)1024 * 1024 * 2, false};
            EpiDown E{(bf16*)(ws + WS_Y), ka.in(I_BDOWN) + (size_t)l * 32 * 1024};
            pg8::gemm_phase<EpiDown, SchedMoe, false>(F.lds, 1024, S, E, F.tid);
        }
        SEAM(pb + 8);
        if (IN(pb + 9)) { OPQ(); phase_combine(F, ka, l); }
        SEAM(pb + 9);

    }
#undef IN
#undef SEAM
}

extern "C" void kernel_launch(void* const* d_in, const int* in_sizes, int n_in, void* d_out, int out_size, void* d_ws, size_t ws_size, hipStream_t stream) {
    static int grid = 0;
    if (grid == 0) {
        if (n_in != N_IN || ws_size < WS_END) { fprintf(stderr, "kernel_launch: unexpected n_in %d or ws_size %zu (need %zu)\n", n_in, ws_size, (size_t)WS_END); grid = -1; return; }
        int dev = 0, cus = 0, per_cu = 0;
        hipGetDevice(&dev); hipDeviceGetAttribute(&cus, hipDeviceAttributeMultiprocessorCount, dev);
        if (hipFuncSetAttribute((const void*)fwd_kernel, hipFuncAttributeMaxDynamicSharedMemorySize, LDS_BYTES) != hipSuccess) { fprintf(stderr, "kernel_launch: hipFuncSetAttribute failed\n"); grid = -1; return; }
        if (hipOccupancyMaxActiveBlocksPerMultiprocessor(&per_cu, (const void*)fwd_kernel, NTHREADS, LDS_BYTES) != hipSuccess || per_cu < 1) { fprintf(stderr, "kernel_launch: occupancy query says %d\n", per_cu); }
        (void)hipGetLastError();
        grid = cus > 0 ? cus : 256;
        if (grid > 256) grid = 256;
    }
    if (grid < 0) return;
    (void)in_sizes; (void)out_size;
    hipMemsetAsync((char*)d_ws + WS_CTL, 0, CTL_ZERO_BYTES, stream);
    Args a{};
    for (int i = 0; i < N_IN; ++i) a.in[i] = (const float*)d_in[i];
    a.out = (float*)d_out; a.ws = (unsigned char*)d_ws;
#if MK_ONE_LAUNCH
    a.ph_lo = 0; a.ph_hi = N_PHASES;
    hipLaunchKernelGGL(fwd_kernel, dim3(grid), dim3(NTHREADS), LDS_BYTES, stream, a);
#else
    for (int ph = 0; ph < N_PHASES; ++ph) { a.ph_lo = ph; a.ph_hi = ph + 1; hipLaunchKernelGGL(fwd_kernel, dim3(grid), dim3(NTHREADS), LDS_BYTES, stream, a); }
#endif
    hipError_t le = hipGetLastError();
    if (le != hipSuccess) fprintf(stderr, "kernel_launch: launch failed: %s\n", hipGetErrorName(le));
}
```

```cpp
#include <hip/hip_runtime.h>
#include <cstdio>
#include <cstdint>

#ifndef MK_ONE_LAUNCH
#define MK_ONE_LAUNCH 1
#endif

#define GAS __attribute__((address_space(1)))
#define LAS __attribute__((address_space(3)))
typedef unsigned short bf16;
typedef short bf16x8 __attribute__((ext_vector_type(8)));
typedef float f32x2 __attribute__((ext_vector_type(2)));
typedef float f32x4 __attribute__((ext_vector_type(4)));
typedef float f32x16 __attribute__((ext_vector_type(16)));
typedef unsigned u32x2 __attribute__((ext_vector_type(2)));
typedef unsigned u32x4 __attribute__((ext_vector_type(4)));
typedef __bf16 bf16v2 __attribute__((ext_vector_type(2)));
#define DI __device__ __forceinline__

constexpr int D = 1024, BATCH = 8, SEQ = 4096, CTX = 256, LTOT = SEQ + CTX  , NT = BATCH * LTOT  , DEPTH = 4;
constexpr int DIN = 7456, DINP = 7680;
constexpr int NEXP = 32, TOPK = 4, DEXP = 1024;
constexpr int NSLOT = NT * TOPK + NEXP * 256;
constexpr int PC_RQ = 0, PC_RK = 256, PC_RV = 512, PC_RGF = 1024, PC_RGB = 1536, PC_MQ = 2048, PC_MKV = 2304, PC_MPE = 2432,
              PC_RW = 2464, PC_WR = 2464, PC_WK = 2976, PC_WV = 3488, PC_WHF = 4000, PC_WHB = 4064, PC_AHF = 4128, PC_AHB = 4192, PC_GH = 4256, PC_GATE = 4384;
enum { I_X = 0, I_C, I_CTX, I_CCTX, I_ADAW, I_ADAB, I_N1G, I_N2G, I_WIN, I_MQNG, I_WUQ, I_MKVNG, I_WUKV, I_QKQG, I_QKKG, I_MUP, I_MUN, I_W0, I_W2, I_A0, I_A2, I_G2,
       I_KK, I_KA, I_RK, I_LNXG, I_LNXB, I_BRRET, I_BRMLA, I_BRRWKV, I_WOUT, I_WROUTER, I_BROUTER, I_WGU, I_BGU, I_WDOWN, I_BDOWN, N_IN };

constexpr size_t MiB = 1u << 20;
constexpr size_t WS_CTL = 0, CTL_ZERO_BYTES = 1 * MiB;
constexpr size_t WS_MOD = 1 * MiB;
constexpr size_t WS_ROPE = 2 * MiB;
constexpr size_t WS_ROPE_AX = 3 * MiB;
constexpr size_t WS_SMALLW = 4 * MiB;
constexpr size_t SW_UQ = 0, SW_UKV = 393216, SW_W2 = 655360, SW_A2 = 786432, SW_G2 = 917504;
constexpr size_t WS_WBR = 8 * MiB;
constexpr size_t WS_WOUT = 20 * MiB;
constexpr size_t WS_WIN = 28 * MiB;
constexpr size_t WS_WGU = 88 * MiB;
constexpr size_t WS_WDN = 600 * MiB;
constexpr size_t WS_X = 856 * MiB;
constexpr size_t WS_H = 992 * MiB;
constexpr size_t WS_P = 1062 * MiB;
constexpr size_t WS_QB = 1572 * MiB;
constexpr size_t WS_KB = 1623 * MiB;
constexpr size_t WS_VT = 1674 * MiB;
constexpr size_t WS_RW = 1708 * MiB;
constexpr size_t RW_STRIDE = (size_t)NT * 512 * 2;
constexpr size_t WS_LW = 1980 * MiB;
constexpr size_t WS_YF = 2116 * MiB;
constexpr size_t WS_OF = 2252 * MiB;
constexpr size_t WS_ABR = 2388 * MiB;
constexpr size_t WS_MRG = 2490 * MiB;
constexpr size_t WS_TOPK = 2558 * MiB;
constexpr size_t WS_LIST = 2560 * MiB;
constexpr size_t WS_ACT = 2565 * MiB;
constexpr size_t WS_Y = 2853 * MiB;
constexpr size_t WS_END = 3141 * MiB;
constexpr int CW_TMO = 0, CW_BAR = 4096, CW_CNT = 8192  , CW_Q = 12288  ;

DI unsigned pk2(float lo, float hi) { f32x2 v = {lo, hi}; bf16v2 r = __builtin_convertvector(v, bf16v2); return __builtin_bit_cast(unsigned, r); }
DI bf16 f2bf(float f) { return (bf16)(pk2(f, 0.f) & 0xffffu); }
DI float bf2f(unsigned short b) { return __uint_as_float(((unsigned)b) << 16); }
DI float bflo(unsigned w) { return __uint_as_float(w << 16); }
DI float bfhi(unsigned w) { return __uint_as_float(w & 0xffff0000u); }
DI int fresh_lane() { int l_; asm volatile("v_mbcnt_lo_u32_b32 %0, -1, 0\n\tv_mbcnt_hi_u32_b32 %0, -1, %0" : "=v"(l_)); return l_; }
DI bf16x8 pack8(const float* v) { u32x4 x; x.x = pk2(v[0], v[1]); x.y = pk2(v[2], v[3]); x.z = pk2(v[4], v[5]); x.w = pk2(v[6], v[7]); return __builtin_bit_cast(bf16x8, x); }
DI float sx(float v, int mask) { const int l = fresh_lane(); return __int_as_float(__builtin_amdgcn_ds_bpermute((l ^ mask) << 2, __float_as_int(v))); }
DI float sup(float v, int d) { const int l = fresh_lane(); return __int_as_float(__builtin_amdgcn_ds_bpermute((l - d) << 2, __float_as_int(v))); }
DI float dpp_scan64(float x) {
    float t;
    t = __int_as_float(__builtin_amdgcn_update_dpp(0, __float_as_int(x), 0x111, 0xf, 0xf, false)); x += t;
    t = __int_as_float(__builtin_amdgcn_update_dpp(0, __float_as_int(x), 0x112, 0xf, 0xf, false)); x += t;
    t = __int_as_float(__builtin_amdgcn_update_dpp(0, __float_as_int(x), 0x114, 0xf, 0xf, false)); x += t;
    t = __int_as_float(__builtin_amdgcn_update_dpp(0, __float_as_int(x), 0x118, 0xf, 0xf, false)); x += t;
    t = __int_as_float(__builtin_amdgcn_update_dpp(0, __float_as_int(x), 0x142, 0xa, 0xf, false)); x += t;
    t = __int_as_float(__builtin_amdgcn_update_dpp(0, __float_as_int(x), 0x143, 0xc, 0xf, false)); x += t;
    return x;
}
DI float wave_sum(float v) {
#pragma unroll
    for (int o = 1; o < 64; o <<= 1) v += sx(v, o);
    return v;
}
DI void unpack8(const u32x4& w, float* o) { o[0] = bflo(w.x); o[1] = bfhi(w.x); o[2] = bflo(w.y); o[3] = bfhi(w.y); o[4] = bflo(w.z); o[5] = bfhi(w.z); o[6] = bflo(w.w); o[7] = bfhi(w.w); }
DI f32x16 zero16() { f32x16 z; for (int i = 0; i < 16; ++i) z[i] = 0.f; return z; }
DI float sigmoidf_(float x) { return __builtin_amdgcn_rcpf(1.f + __expf(-x)); }
#define LDS_WAIT() asm volatile("s_waitcnt lgkmcnt(0)" ::: "memory")
#define VM_WAIT() asm volatile("s_waitcnt vmcnt(0)" ::: "memory")
#define LDS_BARRIER() do { asm volatile("s_waitcnt lgkmcnt(0)" ::: "memory"); __builtin_amdgcn_s_barrier(); asm volatile("" ::: "memory"); } while (0)

#define XB_TMO      128
#define XB_XCNT(j)  (256  + 64 * (j))
#define XB_XSUB(j)  (1280 + 64 * (j))
#define XB_XGEN(j)  (2304 + 64 * (j))
#define XB_TOP      3328
#define XB_TOPGEN   3392
#define XCD_BAR_WORDS 3456
#define XB_SPIN_CAP (1u << 22)

__device__ __forceinline__ unsigned xb_ld(unsigned* p)              { return __hip_atomic_load(p, __ATOMIC_RELAXED, __HIP_MEMORY_SCOPE_AGENT); }
__device__ __forceinline__ unsigned xb_add(unsigned* p, unsigned v) { return __hip_atomic_fetch_add(p, v, __ATOMIC_RELAXED, __HIP_MEMORY_SCOPE_AGENT); }
__device__ __forceinline__ unsigned xb_xcc_id() { return (unsigned)__builtin_amdgcn_s_getreg((3 << 11) | 20) & 0xFu; }
#define XB_SPIN(cond, bar) do { unsigned _sp = 0; while (cond) { __builtin_amdgcn_s_sleep(1); \
    if ((++_sp & 255u) == 0u) { if (xb_ld(&(bar)[XB_TMO])) break; if (_sp > XB_SPIN_CAP) { atomicAdd(&(bar)[XB_TMO], 1u); break; } } } } while (0)

struct XcdBarrier { unsigned* bar; unsigned x; volatile LAS unsigned* st; };

__device__ __forceinline__ XcdBarrier xcd_barrier_post(unsigned* bar, volatile LAS unsigned* st) {
    XcdBarrier b; b.bar = bar; b.x = xb_xcc_id(); b.st = st;
    if (threadIdx.x == 0) (void)xb_add(&bar[XB_XCNT(b.x)], 1u);
    return b;
}
__device__ __forceinline__ void xcd_barrier_complete(unsigned* bar, unsigned x, unsigned& nloc, unsigned& nx) {
    const unsigned G = gridDim.x * gridDim.y * gridDim.z;
    unsigned sum, cnt, mine, sp = 0u;
    for (;;) {
        sum = 0u; cnt = 0u; mine = 0u;
#pragma unroll
        for (unsigned j = 0; j < 16; ++j) { const unsigned c = xb_ld(&bar[XB_XCNT(j)]); sum += c; cnt += (c > 0u) ? 1u : 0u; mine = (j == x) ? c : mine; }
        if (sum == G) break;
        __builtin_amdgcn_s_sleep(1);
        if ((++sp & 255u) == 0u) { if (xb_ld(&bar[XB_TMO])) break; if (sp > XB_SPIN_CAP) { atomicAdd(&bar[XB_TMO], 1u); break; } }
    }
    nloc = mine > 0u ? mine : 1u; nx = cnt > 0u ? cnt : 1u;
}
__device__ __forceinline__ void xcd_barrier(const XcdBarrier& b) {
    asm volatile("s_waitcnt vmcnt(0)" ::: "memory");
    __syncthreads();
    if (threadIdx.x == 0) {
        unsigned* bar = b.bar;
        __builtin_amdgcn_s_waitcnt(0);
        unsigned nloc = b.st[0], nx = b.st[1];
        if (nloc == 0u) { xcd_barrier_complete(bar, b.x, nloc, nx); b.st[0] = nloc; b.st[1] = nx; }
        const unsigned old = xb_add(&bar[XB_XSUB(b.x)], 1u);
        const unsigned gen = old / nloc;
        if (old + 1u == (gen + 1u) * nloc) {
            __builtin_amdgcn_fence(__ATOMIC_RELEASE, "agent");
            asm volatile("s_waitcnt vmcnt(0)" ::: "memory");
            const unsigned og = xb_add(&bar[XB_TOP], 1u);
            const unsigned tg = og / nx;
            if (og + 1u == (tg + 1u) * nx) xb_add(&bar[XB_TOPGEN], 1u);
            else XB_SPIN(xb_ld(&bar[XB_TOPGEN]) == tg, bar);
            __builtin_amdgcn_fence(__ATOMIC_ACQUIRE, "agent");
            xb_add(&bar[XB_XGEN(b.x)], 1u);
            asm volatile("s_waitcnt vmcnt(0)" ::: "memory");
        } else {
            XB_SPIN(xb_ld(&bar[XB_XGEN(b.x)]) == gen, bar);
            __builtin_amdgcn_fence(__ATOMIC_ACQUIRE, "agent");
            asm volatile("s_waitcnt vmcnt(0)" ::: "memory");
        }
    }
    __syncthreads();
}

namespace pg8 {
constexpr int BM = 256, BK = 64, HALF = 128, HTB = HALF * BK * 2, STAGE_BYTES = 8 * HTB;
__host__ __device__ __forceinline__ int lds_byte(int r, int c) { const int st = (r >> 4) * 2 + (c >> 5), rr = r & 15, cc = c & 31, ob = rr * 64 + cc * 2; return st * 1024 + (ob ^ (((ob >> 9) & 1) << 5)); }
__host__ __device__ __forceinline__ void stage_rc(int b, int& R, int& C) { const int st = b / 1024, sb = b % 1024, swz = sb ^ (((sb >> 9) & 1) << 5); R = (st >> 1) * 16 + swz / 64; C = (st & 1) * 32 + (swz % 64) / 2; }
__host__ __device__ __forceinline__ int perm32(int rho) { const int n = rho >> 4, i = rho & 15; return 8 * (i >> 2) + 4 * n + (i & 3); }

struct Unit { const char* pa; const char* pb; int x, y, z; };

struct TileOrder {
    int nM, nN, nwg, G, c; bool skipctx;
    DI void init(int nM_, int nN_, int G_, int c_, bool skipctx_ = false) { skipctx = skipctx_; nM = skipctx_ ? nM_ - BATCH : nM_; nN = nN_; nwg = nM * nN; G = G_; c = c_; }
    DI bool tile(int i, int& pm, int& pn) const {
        const long L = (long)i * G + c; if (L >= nwg) return false;
        int wgid = (int)L; { const int q = nwg / 8, r = nwg % 8, xcd = wgid % 8, off = wgid / 8; wgid = (xcd < r ? xcd * (q + 1) : r * (q + 1) + (xcd - r) * q) + off; }
        const int nig = 8 * nN, gid = wgid / nig, fm = gid * 8, gsz = (nM - fm) < 8 ? (nM - fm) : 8;
        pm = fm + ((wgid % nig) % gsz); pn = (wgid % nig) / gsz; if (skipctx) pm = pm + pm / 16 + 1; return true;
    }
};

DI unsigned cvt_pk_bf16(float lo, float hi) { return pk2(lo, hi); }

template <class Epi, class Sched, bool GATHER>
__device__ __forceinline__ void gemm_phase(LAS unsigned char* lds, const int K, const Sched& S, const Epi& E, const int tid) {
    const int wid = __builtin_amdgcn_readfirstlane(tid >> 6), lane = tid & 63, wr = wid >> 2, wc = wid & 3, fr = lane & 15, fq = lane >> 4;
    const int nt = K / BK;
    unsigned voffA[2], voffB[2]; int stR[2];
#pragma unroll
    for (int i = 0; i < 2; ++i) { int R, C; stage_rc(tid * 16 + i * 8192, R, C); const int Rb = Epi::PERM ? ((R & ~31) + perm32(R & 31)) : R;
        voffA[i] = GATHER ? (unsigned)(C * 2) : (unsigned)(R * K + C) * 2u; voffB[i] = (unsigned)(Rb * K + C) * 2u; stR[i] = R; }
    const size_t kstep = (size_t)(BK * 2);
    const size_t hstep = (size_t)HALF * K * 2;
    const unsigned ldsw = (unsigned)wid * 1024u;
    const int aoff = lds_byte(wr * 64 + fr, fq * 8), boff = lds_byte(wc * 32 + fr, fq * 8);
#define PG8_SA(b, h) (((b) * 2 + (h)) * HTB)
#define PG8_SB(b, h) ((4 + (b) * 2 + (h)) * HTB)
#define PG8_STAGE(bufoff, gbase, voff) do { _Pragma("unroll") for (int _i = 0; _i < 2; ++_i) \
        __builtin_amdgcn_global_load_lds((const unsigned*)((const char*)(gbase) + (voff)[_i]), (LAS unsigned*)(lds + (bufoff) + ldsw + _i * 8192), 16, 0, 0); } while (0)
#define PG8_STAGE_A(bufoff, gbase, h, rw) do { if constexpr (GATHER) { _Pragma("unroll") for (int _i = 0; _i < 2; ++_i) { \
            const unsigned _row = ((rw)[h] >> (16 * _i)) & 0xffffu; \
            __builtin_amdgcn_global_load_lds((const unsigned*)((const char*)(gbase) + (size_t)_row * (size_t)(K * 2) + voffA[_i]), (LAS unsigned*)(lds + (bufoff) + ldsw + _i * 8192), 16, 0, 0); } } \
        else { PG8_STAGE(bufoff, (const char*)(gbase) + (h) * hstep, voffA); } } while (0)
#define PG8_LDA(dst, b, h) do { _Pragma("unroll") for (int m = 0; m < 4; ++m) _Pragma("unroll") for (int k = 0; k < 2; ++k) dst[m][k] = *(const LAS bf16x8*)(lds + PG8_SA(b, h) + aoff + m * 2048 + k * 1024); } while (0)
#define PG8_LDB(dst, b, h) do { _Pragma("unroll") for (int n = 0; n < 2; ++n) _Pragma("unroll") for (int k = 0; k < 2; ++k) dst[n][k] = *(const LAS bf16x8*)(lds + PG8_SB(b, h) + boff + n * 2048 + k * 1024); } while (0)
#define PG8_MMA(ai, bj, At, Bt) do { __builtin_amdgcn_s_setprio(1); _Pragma("unroll") for (int m = 0; m < 4; ++m) _Pragma("unroll") for (int n = 0; n < 2; ++n) _Pragma("unroll") for (int k = 0; k < 2; ++k) \
        acc[ai][bj][m][n] = __builtin_amdgcn_mfma_f32_16x16x32_bf16(Bt[n][k], At[m][k], acc[ai][bj][m][n], 0, 0, 0); __builtin_amdgcn_s_setprio(0); } while (0)
#define PG8_WAIT_V(n) asm volatile("s_waitcnt vmcnt(" #n ")" ::: "memory")
#define PG8_WAIT_L(n) asm volatile("s_waitcnt lgkmcnt(" #n ")" ::: "memory")
#define PG8_BAR __builtin_amdgcn_s_barrier()
#define PG8_SCHED __builtin_amdgcn_sched_barrier(0)
    Unit cur, nxt; int ui = 0;
    if (!S.next(0, cur)) return;
    f32x4 acc[2][2][4][2];
#pragma unroll
    for (int a = 0; a < 2; ++a)
#pragma unroll
        for (int b = 0; b < 2; ++b)
#pragma unroll
            for (int m = 0; m < 4; ++m)
#pragma unroll
                for (int n = 0; n < 2; ++n) acc[a][b][m][n] = (f32x4){0.f, 0.f, 0.f, 0.f};
    bf16x8 At[4][2], B0[2][2], B1[2][2];
    const char* cA = cur.pa; const char* cB = cur.pb;
    unsigned rwc[2] = {0u, 0u}, rwn[2] = {0u, 0u};
    if constexpr (GATHER) S.rows(cur, stR[0], stR[1], rwc);
    PG8_STAGE(PG8_SB(0, 0), cB, voffB); PG8_STAGE(PG8_SB(0, 1), cB + hstep, voffB); PG8_STAGE_A(PG8_SA(0, 0), cA, 0, rwc); PG8_STAGE_A(PG8_SA(0, 1), cA, 1, rwc);
    if (wr == 1) PG8_BAR;
    PG8_WAIT_V(2); PG8_BAR;
    PG8_STAGE(PG8_SB(1, 0), cB + kstep, voffB); PG8_STAGE_A(PG8_SA(1, 0), cA + kstep, 0, rwc); PG8_STAGE(PG8_SB(1, 1), cB + hstep + kstep, voffB);
    PG8_WAIT_V(6); PG8_BAR;
    for (;;) {
        const bool has_next = S.next(ui + 1, nxt);
        const char* nA = has_next ? nxt.pa : cA; const char* nB = has_next ? nxt.pb : cB;
        if constexpr (GATHER) { if (has_next) S.rows(nxt, stR[0], stR[1], rwn); else { rwn[0] = rwc[0]; rwn[1] = rwc[1]; } }
        for (int t = 0; t < nt; t += 2) {
            const bool last = (t == nt - 2);
            const char* a1 = cA + (size_t)(t + 1) * kstep;
            const char* a2 = last ? nA : cA + (size_t)(t + 2) * kstep; const char* b2 = last ? nB : cB + (size_t)(t + 2) * kstep;
            const char* a3 = a2 + kstep; const char* b3 = b2 + kstep;
            unsigned rw2[2]; rw2[0] = last ? rwn[0] : rwc[0]; rw2[1] = last ? rwn[1] : rwc[1];
            PG8_LDB(B0, 0, 0); PG8_LDB(B1, 0, 1); PG8_SCHED; PG8_LDA(At, 0, 0); PG8_STAGE_A(PG8_SA(1, 1), a1, 1, rwc);
            PG8_WAIT_V(8); PG8_WAIT_L(0); PG8_BAR; PG8_MMA(0, 0, At, B0); PG8_MMA(0, 1, At, B1); PG8_BAR; PG8_SCHED;
            PG8_LDA(At, 0, 1); PG8_STAGE(PG8_SB(0, 0), b2, voffB); PG8_STAGE(PG8_SB(0, 1), b2 + hstep, voffB); PG8_STAGE_A(PG8_SA(0, 0), a2, 0, rw2);
            PG8_WAIT_V(8); PG8_WAIT_L(0); PG8_BAR; PG8_MMA(1, 0, At, B0); PG8_MMA(1, 1, At, B1); PG8_BAR; PG8_SCHED;
            PG8_LDB(B0, 1, 0); PG8_LDB(B1, 1, 1); PG8_SCHED; PG8_LDA(At, 1, 0); PG8_STAGE_A(PG8_SA(0, 1), a2, 1, rw2);
            PG8_WAIT_V(8); PG8_WAIT_L(0); PG8_BAR; PG8_MMA(0, 0, At, B0); PG8_MMA(0, 1, At, B1); PG8_BAR; PG8_SCHED;
            PG8_LDA(At, 1, 1); PG8_STAGE(PG8_SB(1, 0), b3, voffB); PG8_STAGE(PG8_SB(1, 1), b3 + hstep, voffB); PG8_STAGE_A(PG8_SA(1, 0), a3, 0, rw2);
            PG8_WAIT_V(8); PG8_WAIT_L(0); PG8_BAR; PG8_MMA(1, 0, At, B0); PG8_MMA(1, 1, At, B1); PG8_BAR; PG8_SCHED;
        }
        if (wr == 0) PG8_BAR;
        { int l2_; asm volatile("v_mbcnt_lo_u32_b32 %0, -1, 0\n\tv_mbcnt_hi_u32_b32 %0, -1, %0" : "=v"(l2_));
          E(acc, cur, wr, wc, l2_ & 15, l2_ >> 4); }
        if (!has_next) break;
        cur = nxt; cA = nA; cB = nB; ++ui;
        if constexpr (GATHER) { rwc[0] = rwn[0]; rwc[1] = rwn[1]; }
        if (wr == 1) PG8_BAR;
    }
    PG8_WAIT_V(0);
    PG8_BAR;
#undef PG8_SA
#undef PG8_SB
#undef PG8_STAGE
#undef PG8_STAGE_A
#undef PG8_LDA
#undef PG8_LDB
#undef PG8_MMA
#undef PG8_WAIT_V
#undef PG8_WAIT_L
#undef PG8_BAR
#undef PG8_SCHED
}
#define ACC_ZERO(acc) do { _Pragma("unroll") for (int a_ = 0; a_ < 2; ++a_) _Pragma("unroll") for (int b_ = 0; b_ < 2; ++b_) _Pragma("unroll") for (int m_ = 0; m_ < 4; ++m_) _Pragma("unroll") for (int n_ = 0; n_ < 2; ++n_) \
        acc[a_][b_][m_][n_] = (f32x4){0.f, 0.f, 0.f, 0.f}; } while (0)
}

constexpr int NWAVES = 8, NTHREADS = 512;
constexpr int RING_BYTES = 131072;
constexpr int LDS_TAB_OFF = RING_BYTES;
constexpr int LDS_MISC_OFF = RING_BYTES + 8192;
constexpr int LDS_BYTES = 147456;

struct Args { const float* in[N_IN]; float* out; unsigned char* ws; int ph_lo, ph_hi; };

#define CAS __attribute__((address_space(4)))
struct KA { const CAS char* kp;
    DI const float* in(int i) const { return *(const float* const CAS*)(kp + 8 * i); }
    DI float* out() const { return *(float* const CAS*)(kp + 8 * N_IN); }
    DI unsigned char* ws() const { return *(unsigned char* const CAS*)(kp + 8 * N_IN + 8); } };
struct Frame {
    LAS unsigned char* lds;
    volatile LAS unsigned* MISC;
    unsigned* ctl;
    unsigned char* ws;
    int tid, lane, wave, G, bid;
};

DI int row_modrow(int r) { const int b = r / LTOT, p = r - b * LTOT; return p < CTX ? 8 : b; }

struct SchedInproj {
    pg8::TileOrder T; const char* A; const char* B;
    DI bool next(int i, pg8::Unit& u) const { int pm, pn; if (!T.tile(i, pm, pn)) return false; u.pa = A + (size_t)pm * (256 * 1024 * 2); u.pb = B + (size_t)pn * (256 * 1024 * 2); u.x = pm; u.y = pn; u.z = 0; return true; }
};
struct EpiStoreBf16 {
    static constexpr bool PERM = true;
    bf16* O; int ldc;
    DI void operator()(f32x4 (&acc)[2][2][4][2], const pg8::Unit& u, int wr, int wc, int fr, int fq) const {
        const int row0 = u.x * 256 + wr * 64 + fr, col0 = u.y * 256 + wc * 32 + 8 * fq;
#pragma unroll
        for (int ai = 0; ai < 2; ++ai)
#pragma unroll
            for (int m = 0; m < 4; ++m) { bf16* rowp = O + (size_t)(row0 + ai * 128 + m * 16) * ldc + col0;
#pragma unroll
                for (int bj = 0; bj < 2; ++bj) { const f32x4 v0 = acc[ai][bj][m][0], v1 = acc[ai][bj][m][1];
                    u32x4 w; w.x = pk2(v0[0], v0[1]); w.y = pk2(v0[2], v0[3]); w.z = pk2(v1[0], v1[1]); w.w = pk2(v1[2], v1[3]);
                    *(u32x4*)(rowp + bj * 128) = w; } }
        ACC_ZERO(acc);
    }
};
struct SchedMerge {
    pg8::TileOrder T; const char* A; const char* B;
    DI bool next(int i, pg8::Unit& u) const { const int ti = i / 3, br = i - ti * 3; int pm, pn; if (!T.tile(ti, pm, pn)) return false;
        u.pa = A + (size_t)br * ((size_t)NT * 512 * 2) + (size_t)pm * (256 * 512 * 2); u.pb = B + (size_t)br * (1024 * 512 * 2) + (size_t)pn * (256 * 512 * 2); u.x = pm; u.y = pn; u.z = br; return true; }
};
struct EpiMerge {
    static constexpr bool PERM = true;
    const bf16* P; bf16* O;
    static DI float en(float x) { return __builtin_amdgcn_exp2f(fminf(x * -1.4426950408889634f, 43.28f)); }
    DI void operator()(f32x4 (&acc)[2][2][4][2], const pg8::Unit& u, int wr, int wc, int fr, int fq) const {
        const int row0 = u.x * 256 + wr * 64 + fr, col0 = u.y * 256 + wc * 32 + 8 * fq, br = u.z;
#pragma unroll
        for (int ai = 0; ai < 2; ++ai) {
            u32x4 gc[4][2], gn[4][2];
#pragma unroll
            for (int m = 0; m < 4; ++m)
#pragma unroll
                for (int bj = 0; bj < 2; ++bj) { const bf16* gp = P + (size_t)(row0 + ai * 128 + m * 16) * DINP + PC_GATE + br * 1024 + col0 + bj * 128;
                    gc[m][bj] = *(const u32x4*)gp; gn[m][bj] = br < 2 ? *(const u32x4*)(gp + 1024) : (u32x4){0u, 0u, 0u, 0u}; }
            __builtin_amdgcn_sched_barrier(0);
#pragma unroll
            for (int m = 0; m < 4; ++m) { const size_t row = (size_t)(row0 + ai * 128 + m * 16);
#pragma unroll
                for (int bj = 0; bj < 2; ++bj) {
                    float lc[8], f[8]; unpack8(gc[m][bj], lc);
                    if (br < 2) { float ln[8]; unpack8(gn[m][bj], ln);
#pragma unroll
                        for (int j = 0; j < 8; ++j) f[j] = (1.f + en(ln[j])) * __builtin_amdgcn_rcpf(1.f + en(lc[j]));
                    } else {
#pragma unroll
                        for (int j = 0; j < 8; ++j) f[j] = __builtin_amdgcn_rcpf(1.f + en(lc[j]));
                    }
                    f32x4 v0 = acc[ai][bj][m][0], v1 = acc[ai][bj][m][1];
                    v0[0] *= f[0]; v0[1] *= f[1]; v0[2] *= f[2]; v0[3] *= f[3]; v1[0] *= f[4]; v1[1] *= f[5]; v1[2] *= f[6]; v1[3] *= f[7];
                    if (br == 2) { u32x4 w; w.x = pk2(v0[0], v0[1]); w.y = pk2(v0[2], v0[3]); w.z = pk2(v1[0], v1[1]); w.w = pk2(v1[2], v1[3]);
                        *(u32x4*)(O + row * 1024 + col0 + bj * 128) = w; v0 = (f32x4){0.f, 0.f, 0.f, 0.f}; v1 = v0; }
                    acc[ai][bj][m][0] = v0; acc[ai][bj][m][1] = v1; } }
            __builtin_amdgcn_sched_barrier(0); }
    }
};
struct SchedPlain {
    pg8::TileOrder T; const char* A; const char* B; int K;
    DI bool next(int i, pg8::Unit& u) const { int pm, pn; if (!T.tile(i, pm, pn)) return false; u.pa = A + (size_t)pm * ((size_t)256 * K * 2); u.pb = B + (size_t)pn * ((size_t)256 * K * 2); u.x = pm; u.y = pn; u.z = 0; return true; }
};
struct EpiResid {
    static constexpr bool PERM = false;
    float* X; const float* mod;
    DI void operator()(f32x4 (&acc)[2][2][4][2], const pg8::Unit& u, int wr, int wc, int fr, int fq) const {
        const int row0 = u.x * 256 + wr * 64 + fr, col0 = u.y * 256 + wc * 32 + 4 * fq;
        const float* g1 = mod + (size_t)row_modrow(u.x * 256) * 6144 + 2048 + col0;
        f32x4 gv[2][2];
#pragma unroll
        for (int bj = 0; bj < 2; ++bj)
#pragma unroll
            for (int n = 0; n < 2; ++n) gv[bj][n] = *(const f32x4*)(g1 + bj * 128 + n * 16);
#pragma unroll
        for (int ai = 0; ai < 2; ++ai) {
            f32x4 xv[4][2][2];
#pragma unroll
            for (int m = 0; m < 4; ++m)
#pragma unroll
                for (int bj = 0; bj < 2; ++bj)
#pragma unroll
                    for (int n = 0; n < 2; ++n) xv[m][bj][n] = *(const f32x4*)(X + (size_t)(row0 + ai * 128 + m * 16) * 1024 + col0 + bj * 128 + n * 16);
            __builtin_amdgcn_sched_barrier(0);
#pragma unroll
            for (int m = 0; m < 4; ++m)
#pragma unroll
                for (int bj = 0; bj < 2; ++bj)
#pragma unroll
                    for (int n = 0; n < 2; ++n) *(f32x4*)(X + (size_t)(row0 + ai * 128 + m * 16) * 1024 + col0 + bj * 128 + n * 16) = xv[m][bj][n] + gv[bj][n] * acc[ai][bj][m][n];
            __builtin_amdgcn_sched_barrier(0); }
        ACC_ZERO(acc);
    }
};
struct SchedMoe {
    const LAS int* tab; const char* A; const char* B; const int* list; int nN, c, G; size_t a_tile_bytes, b_exp_bytes; bool gather;
    DI bool next(int i, pg8::Unit& u) const {
        const int T = tab[96], Tq = (T + 7) >> 3, xcd = c & 7, q = i * (G >> 3) + (c >> 3), tl = q / nN, pn = q - tl * nN, t = xcd * Tq + tl;
        if (tl >= Tq || t >= T) return false;
        const int e = tab[128 + t], j = t - tab[64 + e], slot0 = tab[32 + e] + 256 * j;
        u.pa = gather ? A : A + (size_t)slot0 * 2048; u.pb = B + (size_t)e * b_exp_bytes + (size_t)pn * (256 * 1024 * 2); u.x = slot0; u.y = pn; u.z = e | (j << 8); return true;
    }
    DI void rows(const pg8::Unit& u, int R0, int R1, unsigned (&rw)[2]) const {
        const int e = u.z & 255, j = u.z >> 8, cnt = tab[e]; const int* le = list + (size_t)e * NT;
#pragma unroll
        for (int h = 0; h < 2; ++h) { const int i0 = j * 256 + h * 128 + R0, i1 = j * 256 + h * 128 + R1;
            const unsigned r0 = i0 < cnt ? (unsigned)(le[i0] >> 2) : (unsigned)NT, r1 = i1 < cnt ? (unsigned)(le[i1] >> 2) : (unsigned)NT; rw[h] = r0 | (r1 << 16); }
    }
};
struct EpiSwiglu {
    static constexpr bool PERM = true;
    bf16* ACT; const float* bgu;
    DI void operator()(f32x4 (&acc)[2][2][4][2], const pg8::Unit& u, int wr, int wc, int fr, int fq) const {
        const int row0 = u.x + wr * 64 + fr, ch0 = u.y * 128 + wc * 32 + 8 * fq, e = u.z & 255;
        const float* bg = bgu + (size_t)e * 2048 + ch0;
        const f32x4 bg0 = *(const f32x4*)bg, bg1 = *(const f32x4*)(bg + 4), bu0 = *(const f32x4*)(bg + 1024), bu1 = *(const f32x4*)(bg + 1028);
#pragma unroll
        for (int ai = 0; ai < 2; ++ai)
#pragma unroll
            for (int m = 0; m < 4; ++m) {
                const f32x4 g0 = acc[ai][0][m][0] + bg0, g1 = acc[ai][0][m][1] + bg1, u0 = acc[ai][1][m][0] + bu0, u1 = acc[ai][1][m][1] + bu1;
                float o[8];
#pragma unroll
                for (int j = 0; j < 8; ++j) { const float g = fminf(j < 4 ? g0[j & 3] : g1[j & 3], 7.f); const float up = fminf(fmaxf(j < 4 ? u0[j & 3] : u1[j & 3], -7.f), 7.f);
                    o[j] = g * __builtin_amdgcn_rcpf(1.f + __expf(-1.702f * g)) * (up + 1.f); }
                u32x4 w; w.x = pk2(o[0], o[1]); w.y = pk2(o[2], o[3]); w.z = pk2(o[4], o[5]); w.w = pk2(o[6], o[7]);
                *(u32x4*)(ACT + (size_t)(row0 + ai * 128 + m * 16) * 1024 + ch0) = w; }
        ACC_ZERO(acc);
    }
};
struct EpiDown {
    static constexpr bool PERM = true;
    bf16* Y; const float* bd;
    DI void operator()(f32x4 (&acc)[2][2][4][2], const pg8::Unit& u, int wr, int wc, int fr, int fq) const {
        const int row0 = u.x + wr * 64 + fr, col0 = u.y * 256 + wc * 32 + 8 * fq, e = u.z & 255;
        f32x4 bv[2][2];
#pragma unroll
        for (int bj = 0; bj < 2; ++bj)
#pragma unroll
            for (int n = 0; n < 2; ++n) bv[bj][n] = *(const f32x4*)(bd + (size_t)e * 1024 + col0 + bj * 128 + 4 * n);
#pragma unroll
        for (int ai = 0; ai < 2; ++ai)
#pragma unroll
            for (int m = 0; m < 4; ++m) { bf16* rowp = Y + (size_t)(row0 + ai * 128 + m * 16) * 1024 + col0;
#pragma unroll
                for (int bj = 0; bj < 2; ++bj) { const f32x4 v0 = acc[ai][bj][m][0] + bv[bj][0], v1 = acc[ai][bj][m][1] + bv[bj][1];
                    u32x4 w; w.x = pk2(v0[0], v0[1]); w.y = pk2(v0[2], v0[3]); w.z = pk2(v1[0], v1[1]); w.w = pk2(v1[2], v1[3]);
                    *(u32x4*)(rowp + bj * 128) = w; } }
        ACC_ZERO(acc);
    }
};
DI void moe_build_table(Frame& F, const unsigned* cnt  ) {
    LAS int* tab = (LAS int*)(F.lds + LDS_TAB_OFF);
    if (F.tid < 32) tab[F.tid] = (int)__hip_atomic_load(cnt + F.tid * 16, __ATOMIC_RELAXED, __HIP_MEMORY_SCOPE_AGENT);
    __syncthreads();
    if (F.tid == 0) { int pb = 0, tb = 0; for (int e = 0; e < 32; ++e) { const int nt_ = (tab[e] + 255) >> 8; tab[32 + e] = pb; tab[64 + e] = tb; pb += nt_ * 256; tb += nt_; } tab[96] = tb; }
    __syncthreads();
    for (int e = 0; e < 32; ++e) { const int tb = tab[64 + e], nt_ = (tab[e] + 255) >> 8; for (int j = F.tid; j < nt_; j += NTHREADS) tab[128 + tb + j] = e; }
    __syncthreads();
}

DI void transpose_item(const float* W, int K, int N, bf16* WT, int mode, const float* gk, LAS float* scr, int item, int lane) {
    const int nblk = N / 32, kb = item / nblk, nb = item % nblk, k0 = 64 * kb, n0 = 32 * nb;
#pragma unroll 8
    for (int i = 0; i < 32; ++i) { const int kk = 2 * i + (lane >> 5); float v = W[(size_t)(k0 + kk) * N + n0 + (lane & 31)]; if (gk) v *= gk[k0 + kk]; scr[kk * 33 + (lane & 31)] = v; }
    LDS_WAIT(); asm volatile("" ::: "memory");
    int drow0 = n0;
    if (mode == 1) { const int up = n0 >= 1024, ch = n0 - (up ? 1024 : 0); drow0 = (ch >> 7) * 256 + (up ? 128 : 0) + (ch & 127); }
    const int c = lane & 7;
#pragma unroll
    for (int j = 0; j < 4; ++j) { const int n = (lane >> 3) + 8 * j; const LAS float* s = scr + (8 * c) * 33 + n;
        u32x4 o; o.x = pk2(s[0 * 33], s[1 * 33]); o.y = pk2(s[2 * 33], s[3 * 33]); o.z = pk2(s[4 * 33], s[5 * 33]); o.w = pk2(s[6 * 33], s[7 * 33]);
        *(u32x4*)(WT + (size_t)(drow0 + n) * K + k0 + 8 * c) = o; }
    LDS_WAIT(); asm volatile("" ::: "memory");
}
DI void transpose_batch(Frame& F, const float* W, size_t ss, int K, int N, bf16* WT, size_t ds, int nb, int mode, const float* gk, size_t gks) {
    LAS float* scr = (LAS float*)(F.lds + F.wave * 16384);
    const int gw = F.bid * NWAVES + F.wave, NGW = F.G * NWAVES;
    const int per = (K / 64) * (N / 32), total = per * nb;
    for (int it = gw; it < total; it += NGW) { const int b = it / per, r = it - b * per;
        transpose_item(W + (size_t)b * ss, K, N, WT + (size_t)b * ds, mode, gk ? gk + (size_t)b * gks : nullptr, scr, r, F.lane); }
}
DI void phase_prologue(Frame& F, const KA& a) {
    unsigned char* ws = F.ws;
    transpose_batch(F, a.in(I_WIN), (size_t)1024 * DIN, 1024, DIN, (bf16*)(ws + WS_WIN), (size_t)DINP * 1024, 4, 0, nullptr, 0);
    transpose_batch(F, a.in(I_WGU), (size_t)1024 * 2048, 1024, 2048, (bf16*)(ws + WS_WGU), (size_t)2048 * 1024, 128, 1, nullptr, 0);
    transpose_batch(F, a.in(I_WDOWN), (size_t)1024 * 1024, 1024, 1024, (bf16*)(ws + WS_WDN), (size_t)1024 * 1024, 128, 0, nullptr, 0);
    transpose_batch(F, a.in(I_WOUT), (size_t)1024 * 1024, 1024, 1024, (bf16*)(ws + WS_WOUT), (size_t)1024 * 1024, 4, 0, nullptr, 0);
    transpose_batch(F, a.in(I_BRRET), (size_t)512 * 1024, 512, 1024, (bf16*)(ws + WS_WBR), (size_t)3 * 1024 * 512, 4, 0, nullptr, 0);
    transpose_batch(F, a.in(I_BRMLA), (size_t)512 * 1024, 512, 1024, (bf16*)(ws + WS_WBR) + (size_t)1024 * 512, (size_t)3 * 1024 * 512, 4, 0, nullptr, 0);
    transpose_batch(F, a.in(I_BRRWKV), (size_t)512 * 1024, 512, 1024, (bf16*)(ws + WS_WBR) + (size_t)2 * 1024 * 512, (size_t)3 * 1024 * 512, 4, 0, nullptr, 0);
    transpose_batch(F, a.in(I_WUQ), (size_t)256 * 768, 256, 768, (bf16*)(ws + WS_SMALLW + SW_UQ), MiB / 2, 4, 0, a.in(I_MQNG), 256);
    transpose_batch(F, a.in(I_WUKV), (size_t)128 * 1024, 128, 1024, (bf16*)(ws + WS_SMALLW + SW_UKV), MiB / 2, 4, 0, a.in(I_MKVNG), 128);
    for (int l = 0; l < 4; ++l) {
        transpose_batch(F, a.in(I_W2) + (size_t)l * 2 * 64 * 512, (size_t)64 * 512, 64, 512, (bf16*)(ws + WS_SMALLW + l * MiB + SW_W2), (size_t)512 * 64, 2, 0, nullptr, 0);
        transpose_batch(F, a.in(I_A2) + (size_t)l * 2 * 64 * 512, (size_t)64 * 512, 64, 512, (bf16*)(ws + WS_SMALLW + l * MiB + SW_A2), (size_t)512 * 64, 2, 0, nullptr, 0);
    }
    transpose_batch(F, a.in(I_G2), (size_t)128 * 512, 128, 512, (bf16*)(ws + WS_SMALLW + SW_G2), MiB / 2, 4, 0, nullptr, 0);
    const int gt = F.bid * NTHREADS + F.tid, NGT = F.G * NTHREADS;
    for (int i = gt; i < 4 * (DINP - DIN) * 1024 / 8; i += NGT) { const int l = i / ((DINP - DIN) * 128), r = i - l * ((DINP - DIN) * 128);
        *(u32x4*)((bf16*)(ws + WS_WIN) + (size_t)l * DINP * 1024 + (size_t)DIN * 1024 + (size_t)r * 8) = (u32x4){0u, 0u, 0u, 0u}; }
    for (int i = gt; i < 128; i += NGT) *(u32x4*)((bf16*)(ws + WS_H) + (size_t)NT * 1024 + i * 8) = (u32x4){0u, 0u, 0u, 0u};
    { float2* rt = (float2*)(ws + WS_ROPE);
      for (int i = gt; i < 4096 * 32; i += NGT) { const int pos = i >> 5, f = i & 31; const float inv = powf(10000.f, -(float)(2 * f) / 64.f); const float ang = (float)pos * inv; float s, c; sincosf(ang, &s, &c); rt[i] = make_float2(c, s); }
      float2* ax = (float2*)(ws + WS_ROPE_AX);
      for (int i = gt; i < 64 * 8; i += NGT) { const int pos = i >> 3, f = i & 7; const float inv = powf(10000.f, -(float)(2 * f) / 16.f); const float ang = (float)pos * inv; float s, c; sincosf(ang, &s, &c); ax[i] = make_float2(c, s); } }
    { LAS float* sc = (LAS float*)(F.lds);
      LAS float* red = (LAS float*)(F.lds + 65536);
      __syncthreads();
      for (int i = F.tid; i < 9 * 1024; i += NTHREADS) { const int r = i >> 10, k = i & 1023; const float v = r < 8 ? a.in(I_C)[r * 1024 + k] : a.in(I_CCTX)[k]; sc[i] = v / (1.f + __expf(-v)); }
      __syncthreads();
      float* mod = (float*)(ws + WS_MOD);
      for (int it = F.bid; it < 4 * 96; it += F.G) { const int l = it / 96, n = (it - l * 96) * 64 + F.lane;
          const float* w = a.in(I_ADAW) + (size_t)l * 1024 * 6144 + n; float acc[9];
#pragma unroll
          for (int r = 0; r < 9; ++r) acc[r] = 0.f;
          const int kb = F.wave * 128;
#pragma unroll 8
          for (int k = 0; k < 128; ++k) { const float wv = w[(size_t)(kb + k) * 6144];
#pragma unroll
              for (int r = 0; r < 9; ++r) acc[r] += sc[r * 1024 + kb + k] * wv; }
#pragma unroll
          for (int r = 0; r < 9; ++r) red[(F.wave * 9 + r) * 64 + F.lane] = acc[r];
          __syncthreads();
          for (int i = F.tid; i < 9 * 64; i += NTHREADS) { const int r = i >> 6, c = i & 63; float s = 0.f;
#pragma unroll
              for (int w8 = 0; w8 < 8; ++w8) s += red[(w8 * 9 + r) * 64 + c];
              const int nn = (it - l * 96) * 64 + c; mod[((size_t)l * 9 + r) * 6144 + nn] = s + a.in(I_ADAB)[l * 6144 + nn]; }
          __syncthreads(); } }
}

DI void norm_mod_store(const f32x4 (&v)[4], const float* gain, const float* sc, const float* sh, bf16* hrow, int lane) {
    float s = 0.f;
#pragma unroll
    for (int j = 0; j < 4; ++j) s += (v[j].x * v[j].x + v[j].y * v[j].y) + (v[j].z * v[j].z + v[j].w * v[j].w);
    const float rinv = rsqrtf(wave_sum(s) * (1.f / 1024.f) + 1e-6f);
#pragma unroll
    for (int j = 0; j < 4; ++j) { const int c = 256 * j + 4 * lane; const f32x4 g = *(const f32x4*)(gain + c), a = *(const f32x4*)(sc + c), b = *(const f32x4*)(sh + c);
        const f32x4 y = v[j] * rinv * g * (a + 1.f) + b; u32x2 o; o.x = pk2(y.x, y.y); o.y = pk2(y.z, y.w); *(u32x2*)(hrow + c) = o; }
}
DI void phase_init_rows(Frame& F, const KA& a) {
    const int gw = F.bid * NWAVES + F.wave, NGW = F.G * NWAVES;
    float* X = (float*)(F.ws + WS_X); bf16* H = (bf16*)(F.ws + WS_H); const float* mod = (const float*)(F.ws + WS_MOD);
    for (int r = gw; r < NT; r += NGW) { const int b = r / LTOT, p = r - b * LTOT;
        const float* src = p < CTX ? a.in(I_CTX) + ((size_t)b * CTX + p) * 1024 : a.in(I_X) + ((size_t)b * SEQ + (p - CTX)) * 1024;
        f32x4 v[4];
#pragma unroll
        for (int j = 0; j < 4; ++j) { v[j] = *(const f32x4*)(src + 256 * j + 4 * F.lane); *(f32x4*)(X + (size_t)r * 1024 + 256 * j + 4 * F.lane) = v[j]; }
        const float* m = mod + (size_t)(p < CTX ? 8 : b) * 6144;
        norm_mod_store(v, a.in(I_N1G), m + 1024, m, H + (size_t)r * 1024, F.lane); }
}

template <int CTRL> DI float dppf(float v) { return __int_as_float(__builtin_amdgcn_update_dpp(0, __float_as_int(v), CTRL, 0xf, 0xf, false)); }
template <int CTRL> DI int dppi(int v) { return __builtin_amdgcn_update_dpp(0, v, CTRL, 0xf, 0xf, false); }
DI void phase_router(Frame& F, const KA& a, int l) {
    LAS float* T = (LAS float*)(F.lds);
    LAS float* part = (LAS float*)(F.lds + 16 * 1028 * 4);
    LAS int* lcnt = (LAS int*)(F.lds + 16 * 1028 * 4 + 16384 + 2048);
    LAS int* gbase = lcnt + 64;
    const float* X = (const float*)(F.ws + WS_X); bf16* H = (bf16*)(F.ws + WS_H);
    const float* mod = (const float*)(F.ws + WS_MOD) + (size_t)l * 9 * 6144;
    const float* gain = a.in(I_N2G) + l * 1024; const float* wr = a.in(I_WROUTER) + (size_t)l * 1024 * 32; const float* br = a.in(I_BROUTER) + l * 32;
    int* eidx = (int*)(F.ws + WS_TOPK); float* gw = (float*)(F.ws + WS_TOPK) + (size_t)NT * 4; int* rank = (int*)(F.ws + WS_TOPK) + (size_t)NT * 8;
    int* list = (int*)(F.ws + WS_LIST); unsigned* cnt = F.ctl + CW_CNT + l * 32 * 16;
    const int lane = F.lane, w = F.wave, tid = F.tid;
    const bool lastl = l == DEPTH - 1;
    const int nit = lastl ? BATCH * SEQ / 16 : NT / 16;
    const int mi = lane & 15, mq = lane >> 4;
    float b0[32], b1[32];
    { const float* wp = wr + (size_t)(128 * w + 32 * mq) * 32 + mi;
#pragma unroll
      for (int s2 = 0; s2 < 32; ++s2) { b0[s2] = wp[s2 * 32]; b1[s2] = wp[s2 * 32 + 16]; } }
    const int row = tid >> 5, e = tid & 31; const float bre = br[e];
    f32x4 vn[2][4];
    int it = F.bid;
#define RT_R0(it_) (lastl ? ((it_) >> 8) * LTOT + CTX + 16 * ((it_) & 255) : (it_) * 16)
    if (it < nit) { const int r0 = RT_R0(it);
#pragma unroll
        for (int rr = 0; rr < 2; ++rr)
#pragma unroll
            for (int j = 0; j < 4; ++j) vn[rr][j] = *(const f32x4*)(X + (size_t)(r0 + w * 2 + rr) * 1024 + 256 * j + 4 * lane); }
    int pend_e = 0, pend_lr = 0, pend_r = -1, par = 0; float pend_g = 0.f; int gb = 0;
#pragma unroll 1
    for (; it < nit; it += F.G) {
        const int r0 = RT_R0(it);
        LDS_BARRIER();
        if (tid < 32) { if (pend_r >= 0) { const int c = lcnt[(par ^ 1) * 32 + tid]; gb = c ? (int)__hip_atomic_fetch_add(cnt + tid * 16, (unsigned)c, __ATOMIC_RELAXED, __HIP_MEMORY_SCOPE_AGENT) : 0; }
            lcnt[par * 32 + tid] = 0; }
#pragma unroll
        for (int rr = 0; rr < 2; ++rr) { const int lr = w * 2 + rr, r = r0 + lr; const int b = r / LTOT, p = r - b * LTOT; const float* m = mod + (size_t)(p < CTX ? 8 : b) * 6144;
            float s = 0.f;
#pragma unroll
            for (int j = 0; j < 4; ++j) { const f32x4 x = vn[rr][j]; s += (x.x * x.x + x.y * x.y) + (x.z * x.z + x.w * x.w); }
            const float rinv = rsqrtf(wave_sum(s) * (1.f / 1024.f) + 1e-6f);
#pragma unroll
            for (int j = 0; j < 4; ++j) { const int c = 256 * j + 4 * lane; const f32x4 g = *(const f32x4*)(gain + c), sc = *(const f32x4*)(m + 4096 + c), sh = *(const f32x4*)(m + 3072 + c);
                const f32x4 y = vn[rr][j] * rinv * g * (sc + 1.f) + sh; *(LAS f32x4*)(T + lr * 1028 + c) = y;
                u32x2 o; o.x = pk2(y.x, y.y); o.y = pk2(y.z, y.w); *(u32x2*)(H + (size_t)r * 1024 + c) = o; } }
        LDS_BARRIER();
        if (it + F.G < nit) { const int rn = RT_R0(it + F.G);
#pragma unroll
            for (int rr = 0; rr < 2; ++rr)
#pragma unroll
                for (int j = 0; j < 4; ++j) vn[rr][j] = *(const f32x4*)(X + (size_t)(rn + w * 2 + rr) * 1024 + 256 * j + 4 * lane); }
        { f32x4 acc0 = {0.f, 0.f, 0.f, 0.f}, acc1 = acc0;
          const LAS float* tp = T + mi * 1028 + 128 * w + 32 * mq;
          f32x4 a4[8];
#pragma unroll
          for (int s2 = 0; s2 < 8; ++s2) a4[s2] = *(const LAS f32x4*)(tp + 4 * s2);
#pragma unroll
          for (int s2 = 0; s2 < 32; ++s2) { const float av = a4[s2 >> 2][s2 & 3];
              acc0 = __builtin_amdgcn_mfma_f32_16x16x4f32(av, b0[s2], acc0, 0, 0, 0); acc1 = __builtin_amdgcn_mfma_f32_16x16x4f32(av, b1[s2], acc1, 0, 0, 0); }
#pragma unroll
          for (int rg = 0; rg < 4; ++rg) { part[(w * 16 + 4 * mq + rg) * 32 + mi] = acc0[rg]; part[(w * 16 + 4 * mq + rg) * 32 + 16 + mi] = acc1[rg]; } }
        if (tid < 32 && pend_r >= 0) gbase[(par ^ 1) * 32 + tid] = gb;
        LDS_BARRIER();
        { float v = bre;
#pragma unroll
          for (int w8 = 0; w8 < 8; ++w8) v += part[(w8 * 16 + row) * 32 + e];
          int te[4]; float tv[4];
#pragma unroll
          for (int k = 0; k < 4; ++k) { float bv = v; int bi = e;
#define RT_STEP(OV, OI) do { const float ov_ = (OV); const int oi_ = (OI); const bool take_ = ov_ > bv || (ov_ == bv && oi_ < bi); bv = take_ ? ov_ : bv; bi = take_ ? oi_ : bi; } while (0)
              RT_STEP(dppf<0xB1>(bv), dppi<0xB1>(bi)); RT_STEP(dppf<0x4E>(bv), dppi<0x4E>(bi)); RT_STEP(dppf<0x141>(bv), dppi<0x141>(bi)); RT_STEP(dppf<0x140>(bv), dppi<0x140>(bi));
              RT_STEP(sx(bv, 16), __float_as_int(sx(__int_as_float(bi), 16)));
              te[k] = bi; tv[k] = bv; if (e == bi) v = -3.0e38f; }
          const float mx = tv[0]; float den = 0.f;
#pragma unroll
          for (int k = 0; k < 4; ++k) { tv[k] = __expf(tv[k] - mx); den += tv[k]; }
          const float rden = 1.f / den;
          int myk_e = te[0]; float myk_g = tv[0] * rden;
#pragma unroll
          for (int k = 1; k < 4; ++k) { if (e == k) { myk_e = te[k]; myk_g = tv[k] * rden; } }
          int lr = 0;
          if (e < 4) lr = atomicAdd((int*)&lcnt[par * 32 + myk_e], 1);
          if (e < 4 && pend_r >= 0) { const int rk = gbase[(par ^ 1) * 32 + pend_e] + pend_lr; eidx[pend_r * 4 + e] = pend_e; gw[pend_r * 4 + e] = pend_g; rank[pend_r * 4 + e] = rk; list[(size_t)pend_e * NT + rk] = pend_r * 4 + e; }
          pend_e = myk_e; pend_lr = lr; pend_g = myk_g; pend_r = r0 + row; par ^= 1; }
    }
    LDS_BARRIER();
    if (pend_r >= 0) {
        if (tid < 32) { const int c = lcnt[(par ^ 1) * 32 + tid]; gbase[(par ^ 1) * 32 + tid] = c ? (int)__hip_atomic_fetch_add(cnt + tid * 16, (unsigned)c, __ATOMIC_RELAXED, __HIP_MEMORY_SCOPE_AGENT) : 0; }
        LDS_BARRIER();
        if (e < 4) { const int rk = gbase[(par ^ 1) * 32 + pend_e] + pend_lr; eidx[pend_r * 4 + e] = pend_e; gw[pend_r * 4 + e] = pend_g; rank[pend_r * 4 + e] = rk; list[(size_t)pend_e * NT + rk] = pend_r * 4 + e; }
    }
#undef RT_STEP
#undef RT_R0
}

DI void phase_combine(Frame& F, const KA& a, int l) {
    moe_build_table(F, F.ctl + CW_CNT + l * 32 * 16);
    const LAS int* tab = (const LAS int*)(F.lds + LDS_TAB_OFF);
    const int lane = fresh_lane();
    const int gw_ = F.bid * NWAVES + F.wave, NGW = F.G * NWAVES;
    float* X = (float*)(F.ws + WS_X); bf16* H = (bf16*)(F.ws + WS_H); const bf16* Y = (const bf16*)(F.ws + WS_Y);
    const float* mod = (const float*)(F.ws + WS_MOD) + (size_t)l * 9 * 6144;
    const int* eidx = (const int*)(F.ws + WS_TOPK); const float* gw = (const float*)(F.ws + WS_TOPK) + (size_t)NT * 4; const int* rank = (const int*)(F.ws + WS_TOPK) + (size_t)NT * 8;
#pragma unroll 1
    for (int r0 = gw_; r0 < NT; r0 += 2 * NGW) {
        int rr[2], bb[2], pp[2]; bool act[2]; size_t slot[2][4]; float gk[2][4];
#pragma unroll
        for (int u = 0; u < 2; ++u) { rr[u] = r0 + u * NGW; act[u] = rr[u] < NT; if (!act[u]) rr[u] = r0; bb[u] = rr[u] / LTOT; pp[u] = rr[u] - bb[u] * LTOT; if (l == DEPTH - 1 && pp[u] < CTX) act[u] = false;
#pragma unroll
            for (int k = 0; k < 4; ++k) { const int e = eidx[rr[u] * 4 + k]; gk[u][k] = gw[rr[u] * 4 + k]; slot[u][k] = (size_t)(tab[32 + e] + rank[rr[u] * 4 + k]); } }
        f32x4 v[2][4]; u32x2 yv[2][4][4];
#pragma unroll
        for (int u = 0; u < 2; ++u) {
#pragma unroll
            for (int j = 0; j < 4; ++j) v[u][j] = *(const f32x4*)(X + (size_t)rr[u] * 1024 + 256 * j + 4 * lane);
#pragma unroll
            for (int k = 0; k < 4; ++k)
#pragma unroll
                for (int j = 0; j < 4; ++j) yv[u][k][j] = *(const u32x2*)(Y + slot[u][k] * 1024 + 256 * j + 4 * lane); }
#pragma unroll
        for (int u = 0; u < 2; ++u) { if (!act[u]) continue;
            const int mr = pp[u] < CTX ? 8 : bb[u]; const float* g2 = mod + (size_t)mr * 6144 + 5120;
#pragma unroll
            for (int j = 0; j < 4; ++j) { f32x4 acc = {0.f, 0.f, 0.f, 0.f};
#pragma unroll
                for (int k = 0; k < 4; ++k) { const float g = gk[u][k]; const u32x2 y = yv[u][k][j]; acc.x += g * bflo(y.x); acc.y += g * bfhi(y.x); acc.z += g * bflo(y.y); acc.w += g * bfhi(y.y); }
                v[u][j] = v[u][j] + *(const f32x4*)(g2 + 256 * j + 4 * lane) * acc; }
            if (l == DEPTH - 1) {
                float* o = a.out() + ((size_t)bb[u] * SEQ + (pp[u] - CTX)) * 1024;
#pragma unroll
                for (int j = 0; j < 4; ++j) *(f32x4*)(o + 256 * j + 4 * lane) = v[u][j];
            } else {
#pragma unroll
                for (int j = 0; j < 4; ++j) *(f32x4*)(X + (size_t)rr[u] * 1024 + 256 * j + 4 * lane) = v[u][j];
                const float* m = (const float*)(F.ws + WS_MOD) + (size_t)(l + 1) * 9 * 6144 + (size_t)mr * 6144;
                norm_mod_store(v[u], a.in(I_N1G) + (l + 1) * 1024, m + 1024, m, H + (size_t)rr[u] * 1024, lane);
            } }
    }
}

DI int crow16(int i, int h) { return (i & 3) + 8 * (i >> 2) + 4 * h; }
DI int permpos(int p) { return (p & ~12) | ((p & 4) << 1) | ((p & 8) >> 1); }
constexpr int MP_P = 424;
constexpr int MP_SP = 104;
constexpr int MP_SCR = 32 * MP_P * 2;
DI void phase_mla_prep2(Frame& F, const KA& a, int l) {
    const bf16* P = (const bf16*)(F.ws + WS_P);
    const bf16* WUQ = (const bf16*)(F.ws + WS_SMALLW + (size_t)l * MiB + SW_UQ); const bf16* WUKV = (const bf16*)(F.ws + WS_SMALLW + (size_t)l * MiB + SW_UKV);
    bf16* QB = (bf16*)(F.ws + WS_QB); bf16* KB = (bf16*)(F.ws + WS_KB); bf16* VT = (bf16*)(F.ws + WS_VT);
    const float* gq = a.in(I_QKQG) + l * 96; const float* gk = a.in(I_QKKG) + l * 96;
    const float2* ax = (const float2*)(F.ws + WS_ROPE_AX);
    LAS bf16* T = (LAS bf16*)F.lds;
    u32x4 pre[4];
#define MP_PREFETCH(it_) do { const int tq_ = F.wave * 64 + fresh_lane(); _Pragma("unroll") for (int j_ = 0; j_ < 4; ++j_) { const int q_ = tq_ + NTHREADS * j_; if (q_ < 32 * 52) { const int row_ = q_ / 52, pc_ = q_ - row_ * 52; \
            pre[j_] = *(const u32x4*)(P + (size_t)((it_) * 32 + row_) * DINP + PC_MQ + 8 * pc_); } } } while (0)
    if (F.bid < NT / 32) MP_PREFETCH(F.bid);
#pragma unroll 1
    for (int it = F.bid; it < NT / 32; it += F.G) {
        const int lane = fresh_lane(); int w = F.wave; asm volatile("" : "+s"(w)); const int tid = w * 64 + lane;
        const int r0 = it * 32, b = r0 / LTOT, p0 = r0 - b * LTOT;
        LDS_BARRIER();
#pragma unroll
        for (int j = 0; j < 4; ++j) { const int q = tid + NTHREADS * j; if (q < 32 * 52) { const int row = q / 52, pc = q - row * 52; *(LAS u32x4*)(T + row * MP_P + 8 * pc) = pre[j]; } }
        LDS_BARRIER();
        const int hd = w, tok = lane & 31, h = lane >> 5, p = p0 + tok; const bool lat = p >= CTX; const int sl = p - CTX;
        const LAS bf16* trow = T + tok * MP_P;
        LAS bf16* scr = (LAS bf16*)(F.lds + MP_SCR + w * 6656);
        const size_t bhbase = (size_t)(b * 8 + hd) * LTOT + p0;
        { bf16x8 cq[16]; float ssq = 0.f;
#pragma unroll
          for (int s2 = 0; s2 < 16; ++s2) { const u32x4 x = *(const LAS u32x4*)(trow + 16 * s2 + 8 * h); cq[s2] = __builtin_bit_cast(bf16x8, x);
              ssq += bflo(x.x) * bflo(x.x) + bfhi(x.x) * bfhi(x.x) + bflo(x.y) * bflo(x.y) + bfhi(x.y) * bfhi(x.y) + bflo(x.z) * bflo(x.z) + bfhi(x.z) * bfhi(x.z) + bflo(x.w) * bflo(x.w) + bfhi(x.w) * bfhi(x.w); }
          ssq += sx(ssq, 32);
          const float rinq = rsqrtf(ssq * (1.f / 256.f) + 1e-6f);
          float2 cr[4], cc[4];
#pragma unroll
          for (int f = 0; f < 4; ++f) { cr[f] = lat ? ax[(sl >> 6) * 8 + 4 * h + f] : make_float2(1.f, 0.f); cc[f] = lat ? ax[(sl & 63) * 8 + 4 * h + f] : make_float2(1.f, 0.f); }
          f32x16 acc[3];
#pragma unroll
          for (int cb = 0; cb < 3; ++cb) { f32x16 z = zero16(); const bf16* wrow = WUQ + (size_t)(hd * 96 + cb * 32 + tok) * 256 + 8 * h;
              bf16x8 wf[16];
#pragma unroll
              for (int s2 = 0; s2 < 16; ++s2) wf[s2] = *(const bf16x8*)(wrow + 16 * s2);
              __builtin_amdgcn_sched_barrier(0);
#pragma unroll
              for (int s2 = 0; s2 < 16; ++s2) z = __builtin_amdgcn_mfma_f32_32x32x16_bf16(wf[s2], cq[s2], z, 0, 0, 0);
              __builtin_amdgcn_sched_barrier(0);
              acc[cb] = z; }
          float ss = 0.f;
#pragma unroll
          for (int cb = 0; cb < 3; ++cb)
#pragma unroll
              for (int i = 0; i < 16; ++i) { acc[cb][i] *= rinq; ss += acc[cb][i] * acc[cb][i]; }
          ss += sx(ss, 32);
          const float rq = rsqrtf(ss * (1.f / 96.f) + 1e-6f);
#pragma unroll
          for (int cb = 0; cb < 3; ++cb)
#pragma unroll
              for (int i = 0; i < 16; ++i) acc[cb][i] *= rq * gq[cb * 32 + crow16(i, h)];
#pragma unroll
          for (int i = 0; i < 4; ++i) { const float2 c1 = cr[i]; const float x1 = acc[2][i], x2 = acc[2][i + 4]; acc[2][i] = x1 * c1.x - x2 * c1.y; acc[2][i + 4] = x1 * c1.y + x2 * c1.x;
              const float2 c2 = cc[i]; const float y1 = acc[2][8 + i], y2 = acc[2][12 + i]; acc[2][8 + i] = y1 * c2.x - y2 * c2.y; acc[2][12 + i] = y1 * c2.y + y2 * c2.x; }
#pragma unroll
          for (int cb = 0; cb < 3; ++cb)
#pragma unroll
              for (int g = 0; g < 4; ++g) { u32x2 o; o.x = pk2(acc[cb][4 * g], acc[cb][4 * g + 1]); o.y = pk2(acc[cb][4 * g + 2], acc[cb][4 * g + 3]); *(LAS u32x2*)(scr + tok * MP_SP + cb * 32 + 8 * g + 4 * h) = o; }
          LDS_WAIT();
#pragma unroll
          for (int i = 0; i < 6; ++i) { const int q = lane + 64 * i, row = q / 12, pc = q - row * 12; *(u32x4*)(QB + (bhbase + row) * 96 + 8 * pc) = *(const LAS u32x4*)(scr + row * MP_SP + 8 * pc); }
          LDS_WAIT(); }
        { bf16x8 ckv[8]; float ssk = 0.f;
#pragma unroll
          for (int s2 = 0; s2 < 8; ++s2) { const u32x4 x = *(const LAS u32x4*)(trow + 256 + 16 * s2 + 8 * h); ckv[s2] = __builtin_bit_cast(bf16x8, x);
              ssk += bflo(x.x) * bflo(x.x) + bfhi(x.x) * bfhi(x.x) + bflo(x.y) * bflo(x.y) + bfhi(x.y) * bfhi(x.y) + bflo(x.z) * bflo(x.z) + bfhi(x.z) * bfhi(x.z) + bflo(x.w) * bflo(x.w) + bfhi(x.w) * bfhi(x.w); }
          ssk += sx(ssk, 32);
          const float rinkv = rsqrtf(ssk * (1.f / 128.f) + 1e-6f);
          float pe1[8], pe2[8]; float sspe = 0.f;
          { const u32x4 w0 = *(const LAS u32x4*)(trow + 384 + 16 * h), w1 = *(const LAS u32x4*)(trow + 384 + 16 * h + 8);
            unpack8(w0, pe1); unpack8(w1, pe2);
#pragma unroll
            for (int j = 0; j < 8; ++j) sspe += pe1[j] * pe1[j] + pe2[j] * pe2[j];
            sspe += sx(sspe, 32); }
          float2 cs[8];
#pragma unroll
          for (int f = 0; f < 8; ++f) cs[f] = lat ? ax[(h ? (sl & 63) : (sl >> 6)) * 8 + f] : make_float2(1.f, 0.f);
          f32x16 acc[4];
#pragma unroll
          for (int cb = 0; cb < 4; cb += 2) { f32x16 z0 = zero16(), z1 = zero16(); const bf16* wrow = WUKV + (size_t)(hd * 128 + cb * 32 + tok) * 128 + 8 * h;
              bf16x8 wf0[8], wf1[8];
#pragma unroll
              for (int s2 = 0; s2 < 8; ++s2) { wf0[s2] = *(const bf16x8*)(wrow + 16 * s2); wf1[s2] = *(const bf16x8*)(wrow + 32 * 128 + 16 * s2); }
              __builtin_amdgcn_sched_barrier(0);
#pragma unroll
              for (int s2 = 0; s2 < 8; ++s2) { z0 = __builtin_amdgcn_mfma_f32_32x32x16_bf16(wf0[s2], ckv[s2], z0, 0, 0, 0); z1 = __builtin_amdgcn_mfma_f32_32x32x16_bf16(wf1[s2], ckv[s2], z1, 0, 0, 0); }
              __builtin_amdgcn_sched_barrier(0);
              acc[cb] = z0; acc[cb + 1] = z1; }
          if (it + F.G < NT / 32) MP_PREFETCH(it + F.G);
          float ss = 0.f;
#pragma unroll
          for (int cb = 0; cb < 4; ++cb)
#pragma unroll
              for (int i = 0; i < 16; ++i) { acc[cb][i] *= rinkv; if (cb < 2) ss += acc[cb][i] * acc[cb][i]; }
          ss += sx(ss, 32);
          const float rk = rsqrtf((ss + sspe) * (1.f / 96.f) + 1e-6f);
#pragma unroll
          for (int cb = 0; cb < 2; ++cb)
#pragma unroll
              for (int g = 0; g < 4; ++g) { float o4[4];
#pragma unroll
                  for (int j = 0; j < 4; ++j) o4[j] = acc[cb][4 * g + j] * rk * gk[cb * 32 + 8 * g + 4 * h + j];
                  u32x2 o; o.x = pk2(o4[0], o4[1]); o.y = pk2(o4[2], o4[3]); *(LAS u32x2*)(scr + tok * MP_SP + cb * 32 + 8 * g + 4 * h) = o; }
          { float pe[16];
#pragma unroll
            for (int f = 0; f < 8; ++f) { const float x1 = pe1[f] * rk * gk[64 + 16 * h + f], x2 = pe2[f] * rk * gk[64 + 16 * h + 8 + f];
                pe[f] = x1 * cs[f].x - x2 * cs[f].y; pe[8 + f] = x1 * cs[f].y + x2 * cs[f].x; }
            *(LAS bf16x8*)(scr + tok * MP_SP + 64 + 16 * h) = pack8(pe); *(LAS bf16x8*)(scr + tok * MP_SP + 64 + 16 * h + 8) = pack8(pe + 8); }
          LDS_WAIT();
#pragma unroll
          for (int i = 0; i < 6; ++i) { const int q = lane + 64 * i, row = q / 12, pc = q - row * 12; *(u32x4*)(KB + (bhbase + row) * 96 + 8 * pc) = *(const LAS u32x4*)(scr + row * MP_SP + 8 * pc); }
          LDS_WAIT();
          { const int pt = permpos(tok);
#pragma unroll
            for (int cb = 2; cb < 4; ++cb)
#pragma unroll
                for (int i = 0; i < 16; ++i) scr[((cb - 2) * 32 + crow16(i, h)) * 40 + pt] = f2bf(acc[cb][i]);
            LDS_WAIT();
            bf16* vt = VT + (size_t)(b * 8 + hd) * 64 * LTOT + p0;
#pragma unroll
            for (int i = 0; i < 4; ++i) { const int q = lane + 64 * i, d = q >> 2, pc = q & 3; *(u32x4*)(vt + (size_t)d * LTOT + 8 * pc) = *(const LAS u32x4*)(scr + d * 40 + 8 * pc); }
            LDS_WAIT(); } }
    }
}
#undef MP_PREFETCH

constexpr int ATT_KP = 104, ATT_VP = 72;
constexpr int ATT_KBYTES = 64 * ATT_KP * 2, ATT_VBYTES = 64 * ATT_VP * 2;
DI void attn_unit(Frame& F, int b, int hd, int qblk) {
    const bf16* QB = (const bf16*)(F.ws + WS_QB); const bf16* KB = (const bf16*)(F.ws + WS_KB); const bf16* VT = (const bf16*)(F.ws + WS_VT);
    bf16* O = (bf16*)(F.ws + WS_ABR) + (size_t)NT * 512;
    const int q0 = qblk == 0 ? 0 : CTX + 256 * (qblk - 1), ntiles = qblk == 0 ? CTX / 64 : LTOT / 64;
    const int lane = fresh_lane(), ql = lane & 31, h = lane >> 5, w = F.wave, tid = w * 64 + lane;
    const size_t bh = (size_t)(b * 8 + hd);
    LAS bf16* Kt = (LAS bf16*)(F.lds); LAS bf16* Vt = (LAS bf16*)(F.lds + 2 * ATT_KBYTES);
    bf16x8 qf[6];
    { const bf16* qrow = QB + (bh * LTOT + q0 + 32 * w + ql) * 96 + 8 * h;
#pragma unroll
      for (int s = 0; s < 6; ++s) qf[s] = *(const bf16x8*)(qrow + 16 * s); }
    const bf16* kbase = KB + bh * LTOT * 96; const bf16* vbase = VT + bh * 64 * LTOT;
    const int k1 = tid / 12, c1 = tid - k1 * 12, k2 = (512 + tid) / 12, c2 = (512 + tid) - k2 * 12, vd = tid >> 3, vc = tid & 7;
    u32x4 rk1, rk2 = {0u, 0u, 0u, 0u}, rv;
    rk1 = *(const u32x4*)(kbase + (size_t)k1 * 96 + 8 * c1); if (tid < 256) rk2 = *(const u32x4*)(kbase + (size_t)k2 * 96 + 8 * c2); rv = *(const u32x4*)(vbase + (size_t)vd * LTOT + 8 * vc);
    __syncthreads();
    *(LAS u32x4*)(Kt + k1 * ATT_KP + 8 * c1) = rk1; if (tid < 256) *(LAS u32x4*)(Kt + k2 * ATT_KP + 8 * c2) = rk2; *(LAS u32x4*)(Vt + vd * ATT_VP + 8 * vc) = rv;
    __syncthreads();
    float m = -1.0e30f, lsum = 0.f; f32x16 o0, o1;
#pragma unroll
    for (int i = 0; i < 16; ++i) { o0[i] = 0.f; o1[i] = 0.f; }
    const float sc = 0.10206207261596577f * 1.4426950408889634f;
    for (int t = 0; t < ntiles; ++t) {
        const int buf = t & 1; const bool more = t + 1 < ntiles;
        if (more) { const size_t ko = (size_t)(t + 1) * 64; rk1 = *(const u32x4*)(kbase + (ko + k1) * 96 + 8 * c1); if (tid < 256) rk2 = *(const u32x4*)(kbase + (ko + k2) * 96 + 8 * c2); rv = *(const u32x4*)(vbase + (size_t)vd * LTOT + ko + 8 * vc); }
        const LAS bf16* kt = Kt + buf * (64 * ATT_KP); const LAS bf16* vt = Vt + buf * (64 * ATT_VP);
        f32x16 s0, s1;
#pragma unroll
        for (int i = 0; i < 16; ++i) { s0[i] = 0.f; s1[i] = 0.f; }
        bf16x8 kf0[6], kf1[6];
#pragma unroll
        for (int s = 0; s < 6; ++s) { kf0[s] = *(const LAS bf16x8*)(kt + ql * ATT_KP + 16 * s + 8 * h); kf1[s] = *(const LAS bf16x8*)(kt + (32 + ql) * ATT_KP + 16 * s + 8 * h); }
        __builtin_amdgcn_sched_barrier(0);
#pragma unroll
        for (int s = 0; s < 6; ++s) { s0 = __builtin_amdgcn_mfma_f32_32x32x16_bf16(kf0[s], qf[s], s0, 0, 0, 0); s1 = __builtin_amdgcn_mfma_f32_32x32x16_bf16(kf1[s], qf[s], s1, 0, 0, 0); }
        bf16x8 vf0[4], vf1[4];
#pragma unroll
        for (int ks = 0; ks < 4; ++ks) { vf0[ks] = *(const LAS bf16x8*)(vt + ql * ATT_VP + 16 * ks + 8 * h); vf1[ks] = *(const LAS bf16x8*)(vt + (32 + ql) * ATT_VP + 16 * ks + 8 * h); }
        __builtin_amdgcn_sched_barrier(0);
        float mr = -1.0e30f;
#pragma unroll
        for (int i = 0; i < 16; ++i) mr = fmaxf(mr, fmaxf(s0[i], s1[i]));
        mr = fmaxf(mr, sx(mr, 32));
        const float mn = fmaxf(m, mr * sc), alpha = __builtin_amdgcn_exp2f(m - mn); m = mn;
        float rs = 0.f;
#pragma unroll
        for (int i = 0; i < 16; ++i) { s0[i] = __builtin_amdgcn_exp2f(__builtin_fmaf(s0[i], sc, -mn)); s1[i] = __builtin_amdgcn_exp2f(__builtin_fmaf(s1[i], sc, -mn)); rs += s0[i] + s1[i]; }
        lsum = lsum * alpha + rs;
#pragma unroll
        for (int i = 0; i < 16; ++i) { o0[i] *= alpha; o1[i] *= alpha; }
        bf16x8 pf[4];
        { u32x4 x;
          x.x = pk2(s0[0], s0[1]); x.y = pk2(s0[2], s0[3]); x.z = pk2(s0[4], s0[5]); x.w = pk2(s0[6], s0[7]); pf[0] = __builtin_bit_cast(bf16x8, x);
          x.x = pk2(s0[8], s0[9]); x.y = pk2(s0[10], s0[11]); x.z = pk2(s0[12], s0[13]); x.w = pk2(s0[14], s0[15]); pf[1] = __builtin_bit_cast(bf16x8, x);
          x.x = pk2(s1[0], s1[1]); x.y = pk2(s1[2], s1[3]); x.z = pk2(s1[4], s1[5]); x.w = pk2(s1[6], s1[7]); pf[2] = __builtin_bit_cast(bf16x8, x);
          x.x = pk2(s1[8], s1[9]); x.y = pk2(s1[10], s1[11]); x.z = pk2(s1[12], s1[13]); x.w = pk2(s1[14], s1[15]); pf[3] = __builtin_bit_cast(bf16x8, x); }
        __builtin_amdgcn_sched_barrier(0);
#pragma unroll
        for (int ks = 0; ks < 4; ++ks) { o0 = __builtin_amdgcn_mfma_f32_32x32x16_bf16(vf0[ks], pf[ks], o0, 0, 0, 0); o1 = __builtin_amdgcn_mfma_f32_32x32x16_bf16(vf1[ks], pf[ks], o1, 0, 0, 0); }
        if (more) { const int nb = buf ^ 1; LAS bf16* kn = Kt + nb * (64 * ATT_KP); LAS bf16* vn = Vt + nb * (64 * ATT_VP);
            *(LAS u32x4*)(kn + k1 * ATT_KP + 8 * c1) = rk1; if (tid < 256) *(LAS u32x4*)(kn + k2 * ATT_KP + 8 * c2) = rk2; *(LAS u32x4*)(vn + vd * ATT_VP + 8 * vc) = rv; }
        __syncthreads();
    }
    lsum += sx(lsum, 32);
    const float inv = 1.f / lsum;
    bf16* orow = O + ((size_t)b * LTOT + q0 + 32 * w + ql) * 512 + hd * 64 + 4 * h;
#pragma unroll
    for (int g = 0; g < 4; ++g) { u32x2 x; x.x = pk2(o0[4 * g] * inv, o0[4 * g + 1] * inv); x.y = pk2(o0[4 * g + 2] * inv, o0[4 * g + 3] * inv); *(u32x2*)(orow + 8 * g) = x;
        x.x = pk2(o1[4 * g] * inv, o1[4 * g + 1] * inv); x.y = pk2(o1[4 * g + 2] * inv, o1[4 * g + 3] * inv); *(u32x2*)(orow + 32 + 8 * g) = x; }
}

DI void shift_n(const bf16* prow, bool first, bool last, int col, const float* mup, const float* mun, float* out, int n  ) {
    const bf16* pp = first ? prow : prow - DINP; const bf16* pn = last ? prow : prow + DINP; const float fm = first ? 0.f : 1.f, lm = last ? 0.f : 1.f;
    if (n == 8) {
        const u32x4 c = *(const u32x4*)(prow + col), pv = *(const u32x4*)(pp + col), nx = *(const u32x4*)(pn + col);
        const f32x4 mp0 = *(const f32x4*)(mup + col - PC_RW), mp1 = *(const f32x4*)(mup + col - PC_RW + 4), mn0 = *(const f32x4*)(mun + col - PC_RW), mn1 = *(const f32x4*)(mun + col - PC_RW + 4);
        const unsigned cw[4] = {c.x, c.y, c.z, c.w}, pw[4] = {pv.x, pv.y, pv.z, pv.w}, nw[4] = {nx.x, nx.y, nx.z, nx.w};
        const float mp[8] = {mp0.x, mp0.y, mp0.z, mp0.w, mp1.x, mp1.y, mp1.z, mp1.w}, mn[8] = {mn0.x, mn0.y, mn0.z, mn0.w, mn1.x, mn1.y, mn1.z, mn1.w};
#pragma unroll
        for (int j = 0; j < 4; ++j) { const float t0 = bflo(cw[j]), t1 = bfhi(cw[j]);
            out[2 * j] = t0 + mp[2 * j] * (fm * bflo(pw[j]) - t0) + mn[2 * j] * (lm * bflo(nw[j]) - t0);
            out[2 * j + 1] = t1 + mp[2 * j + 1] * (fm * bfhi(pw[j]) - t1) + mn[2 * j + 1] * (lm * bfhi(nw[j]) - t1); }
    } else {
        const u32x2 c = *(const u32x2*)(prow + col), pv = *(const u32x2*)(pp + col), nx = *(const u32x2*)(pn + col);
        const f32x4 mp0 = *(const f32x4*)(mup + col - PC_RW), mn0 = *(const f32x4*)(mun + col - PC_RW);
        const unsigned cw[2] = {c.x, c.y}, pw[2] = {pv.x, pv.y}, nw[2] = {nx.x, nx.y};
        const float mp[4] = {mp0.x, mp0.y, mp0.z, mp0.w}, mn[4] = {mn0.x, mn0.y, mn0.z, mn0.w};
#pragma unroll
        for (int j = 0; j < 2; ++j) { const float t0 = bflo(cw[j]), t1 = bfhi(cw[j]);
            out[2 * j] = t0 + mp[2 * j] * (fm * bflo(pw[j]) - t0) + mn[2 * j] * (lm * bflo(nw[j]) - t0);
            out[2 * j + 1] = t1 + mp[2 * j + 1] * (fm * bfhi(pw[j]) - t1) + mn[2 * j + 1] * (lm * bfhi(nw[j]) - t1); }
    }
}
constexpr int RP_P = 1928;
DI void phase_rwkv_prep2(Frame& F, const KA& a, int l) {
    const bf16* P = (const bf16*)(F.ws + WS_P);
    const bf16* W2T = (const bf16*)(F.ws + WS_SMALLW + (size_t)l * MiB + SW_W2); const bf16* A2T = (const bf16*)(F.ws + WS_SMALLW + (size_t)l * MiB + SW_A2); const bf16* G2T = (const bf16*)(F.ws + WS_SMALLW + (size_t)l * MiB + SW_G2);
    const float* mup = a.in(I_MUP) + l * 1920; const float* mun = a.in(I_MUN) + l * 1920;
    const float* w0 = a.in(I_W0) + l * 1024; const float* a0 = a.in(I_A0) + l * 1024; const float* kkw = a.in(I_KK) + l * 512; const float* kaw = a.in(I_KA) + l * 512;
    bf16* RW = (bf16*)(F.ws + WS_RW); float* LW = (float*)(F.ws + WS_LW);
    const size_t TS = (size_t)NT * 512;
    LAS bf16* T = (LAS bf16*)F.lds;
#pragma unroll 1
    for (int it = (F.bid + 64) % F.G; it < NT / 32; it += F.G) {
        const int lane = fresh_lane(); int w = F.wave; asm volatile("" : "+s"(w)); const int tid = w * 64 + lane;
        const int r0 = it * 32;
        __syncthreads();
        if (tid < 480) { const int pc = tid % 240, rh = tid / 240, row0 = rh * 16, col = PC_RW + 8 * pc;
            const int ra = r0 + row0, ba = ra / LTOT, pa = ra - ba * LTOT;
            u32x4 rowv[18];
#pragma unroll
            for (int j = 0; j < 18; ++j) { const int p = pa - 1 + j; const bool valid = (p >= 0) && (p < LTOT) && ((p < CTX) == (pa < CTX));
                const int pcl = valid ? p : pa; rowv[j] = *(const u32x4*)(P + ((size_t)ba * LTOT + pcl) * DINP + col); if (!valid) rowv[j] = (u32x4){0u, 0u, 0u, 0u}; }
            const f32x4 mp0 = *(const f32x4*)(mup + 8 * pc), mp1 = *(const f32x4*)(mup + 8 * pc + 4), mn0 = *(const f32x4*)(mun + 8 * pc), mn1 = *(const f32x4*)(mun + 8 * pc + 4);
            const float mp[8] = {mp0.x, mp0.y, mp0.z, mp0.w, mp1.x, mp1.y, mp1.z, mp1.w}, mn[8] = {mn0.x, mn0.y, mn0.z, mn0.w, mn1.x, mn1.y, mn1.z, mn1.w};
#pragma unroll
            for (int j = 0; j < 16; ++j) { float pv[8], cv[8], nv[8], v[8]; unpack8(rowv[j], pv); unpack8(rowv[j + 1], cv); unpack8(rowv[j + 2], nv);
#pragma unroll
                for (int e = 0; e < 8; ++e) v[e] = cv[e] + mp[e] * (pv[e] - cv[e]) + mn[e] * (nv[e] - cv[e]);
                if (pc >= 192 && pc < 208) {
#pragma unroll
                    for (int e = 0; e < 8; ++e) v[e] = 2.f * sigmoidf_(2.f * v[e]) - 1.f; }
                else if (pc >= 224) {
#pragma unroll
                    for (int e = 0; e < 8; ++e) v[e] = sigmoidf_(v[e]); }
                *(LAS bf16x8*)(T + (row0 + j) * RP_P + 8 * pc) = pack8(v); } }
        __syncthreads();
        const int hd = w, tok = lane & 31, h = lane >> 5;
        const LAS bf16* trow = T + tok * RP_P;
#define RP_OUT(c0, dst) do { _Pragma("unroll") for (int i_ = 0; i_ < 4; ++i_) { const int row_ = 8 * i_ + (lane >> 3), pc_ = lane & 7; \
            *(u32x4*)((dst) + (size_t)(r0 + row_) * 512 + hd * 64 + 8 * pc_) = *(const LAS u32x4*)(T + row_ * RP_P + (c0) + 8 * pc_); } } while (0)
        bf16x8 wa[2][8], wg[16], wl[2][8];
#define RP_LDW_A(d_) do { _Pragma("unroll") for (int cb_ = 0; cb_ < 2; ++cb_) _Pragma("unroll") for (int s_ = 0; s_ < 4; ++s_) wa[d_][cb_ * 4 + s_] = *(const bf16x8*)(A2T + (size_t)((d_) * 512 + hd * 64 + cb_ * 32 + tok) * 64 + 16 * s_ + 8 * h); } while (0)
#define RP_LDW_L(d_) do { _Pragma("unroll") for (int cb_ = 0; cb_ < 2; ++cb_) _Pragma("unroll") for (int s_ = 0; s_ < 4; ++s_) wl[d_][cb_ * 4 + s_] = *(const bf16x8*)(W2T + (size_t)((d_) * 512 + hd * 64 + cb_ * 32 + tok) * 64 + 16 * s_ + 8 * h); } while (0)
#define RP_LDW_G() do { _Pragma("unroll") for (int cb_ = 0; cb_ < 2; ++cb_) _Pragma("unroll") for (int s_ = 0; s_ < 8; ++s_) wg[cb_ * 8 + s_] = *(const bf16x8*)(G2T + (size_t)(hd * 64 + cb_ * 32 + tok) * 128 + 16 * s_ + 8 * h); } while (0)
        RP_LDW_A(0);
        RP_OUT(hd * 64, RW); RP_OUT(1024 + hd * 64, RW + 3 * TS);
        float kraw[2][16]; float ss = 0.f;
#pragma unroll
        for (int cb = 0; cb < 2; ++cb)
#pragma unroll
            for (int g = 0; g < 4; ++g) { const int ch = hd * 64 + cb * 32 + 8 * g + 4 * h; const u32x2 kw = *(const LAS u32x2*)(trow + 512 + ch);
                kraw[cb][4 * g] = bflo(kw.x); kraw[cb][4 * g + 1] = bfhi(kw.x); kraw[cb][4 * g + 2] = bflo(kw.y); kraw[cb][4 * g + 3] = bfhi(kw.y);
                const f32x4 kk4 = *(const f32x4*)(kkw + ch);
                ss += kraw[cb][4 * g] * kk4.x * kraw[cb][4 * g] * kk4.x + kraw[cb][4 * g + 1] * kk4.y * kraw[cb][4 * g + 1] * kk4.y + kraw[cb][4 * g + 2] * kk4.z * kraw[cb][4 * g + 2] * kk4.z + kraw[cb][4 * g + 3] * kk4.w * kraw[cb][4 * g + 3] * kk4.w; }
        ss += sx(ss, 32);
        const float rkk = rsqrtf(fmaxf(ss, 1e-24f));
        LDS_WAIT();
        LAS bf16* scr3[3] = {T + hd * 64, T + 1024 + hd * 64, T + 512 + hd * 64};
#define RP_TILE_OUT(vals  , dst, NN) do { LAS bf16* scr = scr3[(NN) % 3]; const int sc0_ = ((NN) % 3 == 0 ? 0 : (NN) % 3 == 1 ? 1024 : 512) + hd * 64; _Pragma("unroll") for (int cb_ = 0; cb_ < 2; ++cb_) _Pragma("unroll") for (int g_ = 0; g_ < 4; ++g_) { u32x2 x_; x_[0] = pk2(vals[cb_][4 * g_], vals[cb_][4 * g_ + 1]); x_[1] = pk2(vals[cb_][4 * g_ + 2], vals[cb_][4 * g_ + 3]); \
            *(LAS u32x2*)(scr + tok * RP_P + cb_ * 32 + 8 * g_ + 4 * h) = x_; } LDS_WAIT(); RP_OUT(sc0_, dst); } while (0)
        { float av[2][16], o[2][16];
#pragma unroll
          for (int d = 0; d < 2; ++d) {
              if (d == 0) RP_LDW_A(1); else RP_LDW_G();
#pragma unroll
              for (int cb = 0; cb < 2; ++cb) { f32x16 c = zero16();
                  bf16x8 xf[4];
#pragma unroll
                  for (int s2 = 0; s2 < 4; ++s2) xf[s2] = *(const LAS bf16x8*)(trow + 1664 + 64 * d + 16 * s2 + 8 * h);
                  __builtin_amdgcn_sched_barrier(0);
#pragma unroll
                  for (int s2 = 0; s2 < 4; ++s2) c = __builtin_amdgcn_mfma_f32_32x32x16_bf16(wa[d][cb * 4 + s2], xf[s2], c, 0, 0, 0);
#pragma unroll
                  for (int g = 0; g < 4; ++g) { const f32x4 a4 = *(const f32x4*)(a0 + d * 512 + hd * 64 + cb * 32 + 8 * g + 4 * h);
                      av[cb][4 * g] = sigmoidf_(a4.x + c[4 * g]); av[cb][4 * g + 1] = sigmoidf_(a4.y + c[4 * g + 1]); av[cb][4 * g + 2] = sigmoidf_(a4.z + c[4 * g + 2]); av[cb][4 * g + 3] = sigmoidf_(a4.w + c[4 * g + 3]); } }
              RP_TILE_OUT(av, RW + (size_t)(5 + d) * TS, 2 * d);
#pragma unroll
              for (int cb = 0; cb < 2; ++cb)
#pragma unroll
                  for (int g = 0; g < 4; ++g) { const f32x4 ka4 = *(const f32x4*)(kaw + hd * 64 + cb * 32 + 8 * g + 4 * h);
                      o[cb][4 * g] = kraw[cb][4 * g] * (1.f + (av[cb][4 * g] - 1.f) * ka4.x); o[cb][4 * g + 1] = kraw[cb][4 * g + 1] * (1.f + (av[cb][4 * g + 1] - 1.f) * ka4.y);
                      o[cb][4 * g + 2] = kraw[cb][4 * g + 2] * (1.f + (av[cb][4 * g + 2] - 1.f) * ka4.z); o[cb][4 * g + 3] = kraw[cb][4 * g + 3] * (1.f + (av[cb][4 * g + 3] - 1.f) * ka4.w); }
              RP_TILE_OUT(o, RW + (size_t)(1 + d) * TS, 2 * d + 1); }
#pragma unroll
          for (int cb = 0; cb < 2; ++cb)
#pragma unroll
              for (int g = 0; g < 4; ++g) { const f32x4 kk4 = *(const f32x4*)(kkw + hd * 64 + cb * 32 + 8 * g + 4 * h);
                  o[cb][4 * g] = kraw[cb][4 * g] * kk4.x * rkk; o[cb][4 * g + 1] = kraw[cb][4 * g + 1] * kk4.y * rkk; o[cb][4 * g + 2] = kraw[cb][4 * g + 2] * kk4.z * rkk; o[cb][4 * g + 3] = kraw[cb][4 * g + 3] * kk4.w * rkk; }
          RP_TILE_OUT(o, RW + 4 * TS, 4); }
        { float o[2][16];
#pragma unroll
          for (int cb = 0; cb < 2; ++cb) { f32x16 c = zero16();
              if (cb == 0) RP_LDW_L(0);
              bf16x8 xf[8];
#pragma unroll
              for (int s2 = 0; s2 < 8; ++s2) xf[s2] = *(const LAS bf16x8*)(trow + 1792 + 16 * s2 + 8 * h);
              __builtin_amdgcn_sched_barrier(0);
#pragma unroll
              for (int s2 = 0; s2 < 8; ++s2) c = __builtin_amdgcn_mfma_f32_32x32x16_bf16(wg[cb * 8 + s2], xf[s2], c, 0, 0, 0);
#pragma unroll
              for (int i = 0; i < 16; ++i) o[cb][i] = c[i]; }
          RP_TILE_OUT(o, RW + 7 * TS, 5); }
#pragma unroll
        for (int d = 0; d < 2; ++d)
#pragma unroll
            for (int cb = 0; cb < 2; ++cb) { f32x16 c = zero16();
                if (d == 0 && cb == 0) RP_LDW_L(1);
                bf16x8 xf[4];
#pragma unroll
                for (int s2 = 0; s2 < 4; ++s2) xf[s2] = *(const LAS bf16x8*)(trow + 1536 + 64 * d + 16 * s2 + 8 * h);
                __builtin_amdgcn_sched_barrier(0);
#pragma unroll
                for (int s2 = 0; s2 < 4; ++s2) c = __builtin_amdgcn_mfma_f32_32x32x16_bf16(wl[d][cb * 4 + s2], xf[s2], c, 0, 0, 0);
                LAS float* fs = (LAS float*)scr3[(6 + 2 * d + cb) % 3];
#pragma unroll
                for (int g = 0; g < 4; ++g) { const f32x4 w4 = *(const f32x4*)(w0 + d * 512 + hd * 64 + cb * 32 + 8 * g + 4 * h);
                    *(LAS f32x4*)(fs + tok * (RP_P / 2) + 8 * g + 4 * h) = (f32x4){-0.6065306597f * sigmoidf_(w4.x + c[4 * g]), -0.6065306597f * sigmoidf_(w4.y + c[4 * g + 1]), -0.6065306597f * sigmoidf_(w4.z + c[4 * g + 2]), -0.6065306597f * sigmoidf_(w4.w + c[4 * g + 3])}; }
                LDS_WAIT();
#pragma unroll
                for (int i_ = 0; i_ < 4; ++i_) { const int row_ = 8 * i_ + (lane >> 3), pc_ = lane & 7;
                    *(f32x4*)(LW + (size_t)d * TS + (size_t)(r0 + row_) * 512 + hd * 64 + cb * 32 + 4 * pc_) = *(const LAS f32x4*)(fs + row_ * (RP_P / 2) + 4 * pc_); } }
        LDS_WAIT();
#undef RP_OUT
#undef RP_TILE_OUT
#undef RP_LDW_A
#undef RP_LDW_L
#undef RP_LDW_G
    }
}

constexpr int NCHUNK = LTOT / 64;
constexpr int NCHAIN = BATCH * 8 * 2;
constexpr int RC_P = 72;
constexpr int RC_TILE = 64 * RC_P * 2;
constexpr int RC_LTF = 13 * RC_TILE, RC_EC = RC_LTF + 64 * 65 * 4;
DI int chain_pos(int dir, int n) { return dir == 0 ? n : (n < CTX ? CTX - 1 - n : LTOT - 1 - (n - CTX)); }
DI f32x16 mm_blk(const LAS bf16* A, int mb, const LAS bf16* Bt, int nb, int k0, int ksteps, int lane, f32x16 acc) {
    const int r = lane & 31, h = lane >> 5;
    bf16x8 fa[4], fb[4];
#pragma unroll
    for (int q = 0; q < 4; ++q) if (q < ksteps) { fa[q] = *(const LAS bf16x8*)(A + (mb * 32 + r) * RC_P + k0 + 16 * q + 8 * h); fb[q] = *(const LAS bf16x8*)(Bt + (nb * 32 + r) * RC_P + k0 + 16 * q + 8 * h); }
    __builtin_amdgcn_sched_barrier(0);
#pragma unroll
    for (int q = 0; q < 4; ++q) if (q < ksteps) acc = __builtin_amdgcn_mfma_f32_32x32x16_bf16(fa[q], fb[q], acc, 0, 0, 0);
    return acc;
}
DI void st_tile_T(LAS bf16* tile, int mb, int nb, const f32x16& d, int lane) {
    const int r = lane & 31, h = lane >> 5;
#pragma unroll
    for (int g = 0; g < 4; ++g) { u32x2 x; x.x = pk2(d[4 * g], d[4 * g + 1]); x.y = pk2(d[4 * g + 2], d[4 * g + 3]); *(LAS u32x2*)(tile + (nb * 32 + r) * RC_P + mb * 32 + 8 * g + 4 * h) = x; }
}
constexpr int RC_LTF2 = 13 * RC_TILE, RC_EC2 = RC_LTF2 + 2 * 32 * 36 * 4, RC_ST = RC_EC2 + 256;
static_assert(RC_ST + RC_TILE <= LDS_MISC_OFF, "rwkv chain LDS map");
DI void rwkv_chain_block(Frame& F, int chain) {
    const int w_ = F.wave;
    const int dir = chain & 1, bh = chain >> 1, b = bh >> 3, hd = bh & 7;
    const bf16* RW = (const bf16*)(F.ws + WS_RW); const float* LW = (const float*)(F.ws + WS_LW); const size_t TS = (size_t)NT * 512;
    bf16* Yg = (bf16*)(F.ws + WS_YF) + (size_t)dir * TS + (size_t)b * LTOT * 512 + hd * 64;
    LAS bf16* tiles = (LAS bf16*)F.lds;
#define TILE(i) (tiles + (i) * (RC_TILE / 2))
    LAS float* LTf = (LAS float*)(F.lds + RC_LTF2); LAS float* EC = (LAS float*)(F.lds + RC_EC2); LAS bf16* ST = (LAS bf16*)(F.lds + RC_ST);
    __syncthreads();
    { const int lane0 = fresh_lane(); for (int i = w_ * 64 + lane0; i < RC_TILE / 4; i += NTHREADS) ((LAS unsigned*)ST)[i] = 0u; }
    f32x4 nl0, nl1; u32x4 nr, nk, nv, nkk, na;
#define RC_LOAD(cc) do { const int lane_ = fresh_lane(); const int p_ = chain_pos(dir, 64 * (cc) + lane_); const size_t off_ = ((size_t)b * LTOT + p_) * 512 + hd * 64 + 8 * w; \
        nl0 = *(const f32x4*)(LW + (size_t)dir * TS + off_); nl1 = *(const f32x4*)(LW + (size_t)dir * TS + off_ + 4); nr = *(const u32x4*)(RW + off_); nk = *(const u32x4*)(RW + (size_t)(1 + dir) * TS + off_); \
        nv = *(const u32x4*)(RW + 3 * TS + off_); nkk = *(const u32x4*)(RW + 4 * TS + off_); na = *(const u32x4*)(RW + (size_t)(5 + dir) * TS + off_); } while (0)
    { const int w = w_; RC_LOAD(0); }
#pragma unroll 1
    for (int c = 0; c < NCHUNK; ++c) {
        const int lane = fresh_lane(); int w = w_; asm volatile("" : "+s"(w));
        { const f32x4 l0 = nl0, l1 = nl1; const u32x4 ur = nr, uk = nk, uv = nv, ukk = nkk, ua = na;
          float lw[8] = {l0.x, l0.y, l0.z, l0.w, l1.x, l1.y, l1.z, l1.w}, cw[8];
#pragma unroll
          for (int j = 0; j < 8; ++j) cw[j] = lw[j];
#pragma unroll
          for (int j = 0; j < 8; ++j) cw[j] = dpp_scan64(cw[j]);
          const unsigned rw_[4] = {ur.x, ur.y, ur.z, ur.w}, kw_[4] = {uk.x, uk.y, uk.z, uk.w}, kkw_[4] = {ukk.x, ukk.y, ukk.z, ukk.w}, aw_[4] = {ua.x, ua.y, ua.z, ua.w};
          float At[8], Rt[8], Bt[8], Kt[8];
#pragma unroll
          for (int j = 0; j < 8; ++j) { const float rr = (j & 1) ? bfhi(rw_[j >> 1]) : bflo(rw_[j >> 1]), kk = (j & 1) ? bfhi(kkw_[j >> 1]) : bflo(kkw_[j >> 1]), k = (j & 1) ? bfhi(kw_[j >> 1]) : bflo(kw_[j >> 1]), aa = (j & 1) ? bfhi(aw_[j >> 1]) : bflo(aw_[j >> 1]);
              const float ep = __expf(cw[j]), em = __expf(-cw[j]), epv = __expf(cw[j] - lw[j]);
              At[j] = -kk * epv; Rt[j] = rr * ep; Bt[j] = kk * aa * em; Kt[j] = k * em;
              if (lane == 63) EC[8 * w + j] = ep; }
          const bf16x8 fa = pack8(At), fr_ = pack8(Rt), fb = pack8(Bt), fk = pack8(Kt);
          *(LAS bf16x8*)(TILE(0) + lane * RC_P + 8 * w) = fa; *(LAS bf16x8*)(TILE(1) + lane * RC_P + 8 * w) = fr_; *(LAS bf16x8*)(TILE(2) + lane * RC_P + 8 * w) = fb; *(LAS bf16x8*)(TILE(3) + lane * RC_P + 8 * w) = fk;
          const unsigned vw_[4] = {uv.x, uv.y, uv.z, uv.w};
#pragma unroll
          for (int j = 0; j < 8; ++j) { TILE(4)[(8 * w + j) * RC_P + lane] = (bf16)fa[j]; TILE(5)[(8 * w + j) * RC_P + lane] = (bf16)fb[j]; TILE(6)[(8 * w + j) * RC_P + lane] = (bf16)fk[j];
              TILE(7)[(8 * w + j) * RC_P + lane] = (bf16)((j & 1) ? (vw_[j >> 1] >> 16) : (vw_[j >> 1] & 0xffffu)); } }
        LDS_BARRIER();
        if (c + 1 < NCHUNK) RC_LOAD(c + 1);
        { const int pi = w >> 1, nb = w & 1, r = lane & 31, h = lane >> 5;
          const LAS bf16* Aop = (pi == 0 || pi == 2) ? TILE(2) : TILE(3);
          const LAS bf16* Bop = pi < 2 ? TILE(0) : TILE(1);
          LAS bf16* dst = TILE(8 + pi);
#pragma unroll
          for (int mb = 0; mb < 2; ++mb) { f32x16 d = zero16();
              if (mb <= nb) d = mm_blk(Aop, mb, Bop, nb, 0, 4, lane, d);
#pragma unroll
              for (int i = 0; i < 16; ++i) { const int m = mb * 32 + crow16(i, h), n = nb * 32 + r; const bool keep = pi < 2 ? m < n : m <= n; d[i] = keep ? d[i] : 0.f; }
              st_tile_T(dst, mb, nb, d, lane);
              if (pi == 0 && mb == nb) {
#pragma unroll
                  for (int i = 0; i < 16; ++i) LTf[(mb * 32 + crow16(i, h)) * 36 + r] = d[i]; } } }
        LDS_BARRIER();
        if (w == 0) {
            { const int k = lane >> 4, tl = lane & 15, blk = k >> 1, o16 = (k & 1) * 16;
              float Tr[16];
#pragma unroll
              for (int i = 0; i < 16; ++i) Tr[i] = 0.f;
#pragma unroll
              for (int cc = 15; cc >= 0; --cc) { float a0 = (cc == tl) ? 1.f : 0.f, a1 = 0.f;
                  const LAS float* lrow = LTf + (blk * 32 + o16 + cc) * 36 + o16;
#pragma unroll
                  for (int q4 = (cc + 1) >> 2; q4 < 4; ++q4) { const f32x4 l4 = *(const LAS f32x4*)(lrow + 4 * q4);
#pragma unroll
                      for (int e = 0; e < 4; ++e) { const int s2 = 4 * q4 + e; if (s2 > cc) { if (e & 1) a1 += Tr[s2] * l4[e]; else a0 += Tr[s2] * l4[e]; } } }
                  Tr[cc] = a0 + a1; if ((cc & 3) == 0) asm volatile("" ::: "memory"); }
              unsigned z0; asm volatile("v_mov_b32 %0, 0" : "=v"(z0)); const u32x4 zz = {z0, z0, z0, z0};
              LAS bf16* trow = TILE(12) + lane * RC_P; LAS bf16* ttrow = TILE(0) + lane * RC_P;
#pragma unroll
              for (int g = 0; g < 8; ++g) { *(LAS u32x4*)(trow + 8 * g) = zz; *(LAS u32x4*)(ttrow + 8 * g) = zz; }
              *(LAS bf16x8*)(trow + 16 * k) = pack8(Tr); *(LAS bf16x8*)(trow + 16 * k + 8) = pack8(Tr + 8);
#pragma unroll
              for (int i = 0; i < 16; ++i) TILE(0)[(16 * k + i) * RC_P + lane] = f2bf(Tr[i]); }
            LDS_WAIT();
            { const int r = lane & 31, h = lane >> 5;
#pragma unroll
              for (int blk = 0; blk < 2; ++blk) {
                  f32x16 x = zero16();
                  x = __builtin_amdgcn_mfma_f32_32x32x16_bf16(*(const LAS bf16x8*)(TILE(8) + (32 * blk + r) * RC_P + 32 * blk + 8 * h), *(const LAS bf16x8*)(TILE(0) + (32 * blk + r) * RC_P + 32 * blk + 8 * h), x, 0, 0, 0);
                  st_tile_T(TILE(2), 0, blk, x, lane);
                  LDS_WAIT();
                  f32x16 d = zero16();
                  d = __builtin_amdgcn_mfma_f32_32x32x16_bf16(*(const LAS bf16x8*)(TILE(12) + (32 * blk + r) * RC_P + 32 * blk + 16 + 8 * h), *(const LAS bf16x8*)(TILE(2) + (32 * blk + r) * RC_P + 16 + 8 * h), d, 0, 0, 0);
                  if (r < 16) {
#pragma unroll
                      for (int i = 8; i < 16; ++i) TILE(12)[(32 * blk + crow16(i, h)) * RC_P + 32 * blk + r] = f2bf(d[i]);
                      { u32x2 y0, y1; y0.x = pk2(d[8], d[9]); y0.y = pk2(d[10], d[11]); y1.x = pk2(d[12], d[13]); y1.y = pk2(d[14], d[15]);
                        *(LAS u32x2*)(TILE(0) + (32 * blk + r) * RC_P + 32 * blk + 16 + 4 * h) = y0; *(LAS u32x2*)(TILE(0) + (32 * blk + r) * RC_P + 32 * blk + 24 + 4 * h) = y1; } }
                  LDS_WAIT(); } }
            LDS_WAIT();
            f32x16 m1 = mm_blk(TILE(8), 1, TILE(0), 0, 0, 2, lane, zero16());
            st_tile_T(TILE(2), 0, 0, m1, lane);
            LDS_WAIT();
            { const int r = lane & 31, h = lane >> 5; f32x16 d = zero16();
#pragma unroll
              for (int q = 0; q < 2; ++q) { const bf16x8 a = *(const LAS bf16x8*)(TILE(2) + r * RC_P + 16 * q + 8 * h), bb = *(const LAS bf16x8*)(TILE(12) + (32 + r) * RC_P + 32 + 16 * q + 8 * h);
                  d = __builtin_amdgcn_mfma_f32_32x32x16_bf16(a, bb, d, 0, 0, 0); }
#pragma unroll
              for (int g = 0; g < 4; ++g) { u32x2 x; x.x = pk2(d[4 * g], d[4 * g + 1]); x.y = pk2(d[4 * g + 2], d[4 * g + 3]); *(LAS u32x2*)(TILE(12) + (32 + r) * RC_P + 8 * g + 4 * h) = x; } }
        } else if (w <= 4) {
            const int mb = (w - 1) >> 1, nb = (w - 1) & 1;
            const f32x16 u = mm_blk(TILE(9), mb, TILE(7), nb, 0, 4, lane, zero16());
            st_tile_T(TILE(3), mb, nb, u, lane);
        }
        LDS_BARRIER();
        { const int mb = (w >> 1) & 1, nb = w & 1;
          if (w < 4) { const f32x16 d = mm_blk(TILE(12), mb, TILE(4), nb, 0, 4, lane, zero16()); st_tile_T(TILE(2), mb, nb, d, lane); }
          else { const f32x16 d = mm_blk(TILE(12), mb, TILE(3), nb, 0, 4, lane, zero16()); st_tile_T(TILE(0), mb, nb, d, lane); } }
        LDS_BARRIER();
        const int mb = (w >> 1) & 1, nb = w & 1, r = lane & 31, h = lane >> 5;
        f32x16 cin;
        if (w < 4) {
            f32x16 d = mm_blk(TILE(2), mb, TILE(5), nb, 0, 4, lane, zero16());
#pragma unroll
            for (int i = 0; i < 16; ++i) { const int m = mb * 32 + crow16(i, h), n = nb * 32 + r; d[i] = (d[i] + (m == n ? 1.f : 0.f)) * EC[n]; }
            st_tile_T(TILE(8), mb, nb, d, lane);
            cin = mm_blk(TILE(5), mb, TILE(0), nb, 0, 4, lane, zero16()); cin = mm_blk(TILE(6), mb, TILE(7), nb, 0, 4, lane, cin);
#pragma unroll
            for (int i = 0; i < 16; ++i) cin[i] *= EC[mb * 32 + crow16(i, h)];
        } else {
            f32x16 d = mm_blk(TILE(2), mb, TILE(10), nb, 0, 4, lane, zero16());
#pragma unroll
            for (int i = 0; i < 16; ++i) { const int m = mb * 32 + crow16(i, h), n = nb * 32 + r; d[i] += bf2f(TILE(1)[n * RC_P + m]); }
            st_tile_T(TILE(9), mb, nb, d, lane);
            cin = mm_blk(TILE(10), mb, TILE(0), nb, 0, 4, lane, zero16()); cin = mm_blk(TILE(11), mb, TILE(7), nb, 0, 4, lane, cin);
        }
        LDS_BARRIER();
        if (w < 4) cin = mm_blk(TILE(8), mb, ST, nb, 0, 4, lane, cin);
        else { cin = mm_blk(TILE(9), mb, ST, nb, 0, 4, lane, cin);
#pragma unroll
            for (int i = 0; i < 16; ++i) { const int p = chain_pos(dir, 64 * c + mb * 32 + crow16(i, h)); Yg[(size_t)p * 512 + nb * 32 + r] = f2bf(cin[i]); } }
        LDS_BARRIER();
        if (w < 4) st_tile_T(ST, mb, nb, cin, lane);
    }
#undef RC_LOAD
#undef TILE
}
constexpr int RT_QP = 72, RT_TP = 136;
constexpr int RT_QS = 0, RT_KS = 128 * RT_QP * 2, RT_KT = 2 * 128 * RT_QP * 2, RT_VT = RT_KT + 64 * RT_TP * 2, RT_ST = RT_VT + 128 * RT_TP * 2;
DI void phase_retention_item(Frame& F, const KA& a, int item) {
    const int b = item >> 2, hh = item & 3, w = F.wave;
    const bf16* P = (const bf16*)(F.ws + WS_P); const float2* rt = (const float2*)(F.ws + WS_ROPE);
    bf16* OFB = (bf16*)(F.ws + WS_OF); const size_t TS = (size_t)NT * 512;
    LAS bf16* Qs = (LAS bf16*)(F.lds + RT_QS); LAS bf16* Ks = (LAS bf16*)(F.lds + RT_KS); LAS bf16* KsT = (LAS bf16*)(F.lds + RT_KT); LAS bf16* VsT = (LAS bf16*)(F.lds + RT_VT); LAS bf16* SsT = (LAS bf16*)(F.lds + RT_ST);
    const float lg2g = log2f(1.f - exp2f(-5.f - (float)hh));
    const float gam = exp2f(lg2g), g127 = exp2f(127.f * lg2g), cdec = exp2f(128.f * lg2g);
    const int rb = w >> 1, cbp = w & 1, db = w >> 2, vb = w & 3;
    for (int dir = 0; dir < 2; ++dir) {
        const int lane = fresh_lane(); const int tid = w * 64 + lane, ql = lane & 31, h = lane >> 5;
        f32x16 Sreg;
#pragma unroll
        for (int i = 0; i < 16; ++i) Sreg[i] = 0.f;
        __syncthreads();
        for (int i = tid; i < 128 * RT_QP / 2; i += NTHREADS) ((LAS unsigned*)SsT)[i] = 0u;
        for (int cn = 0; cn < 34; ++cn) {
            int p0; if (cn < 2) p0 = 128 * (dir ? 1 - cn : cn); else p0 = CTX + 128 * (dir ? 33 - cn : cn - 2);
            const bool lat = p0 >= CTX;
            { int tid_o = tid; asm volatile("" : "+v"(tid_o)); const int tok = tid_o >> 2, c = tid_o & 3; const int e = dir ? 127 - tok : tok; const size_t row = (size_t)b * LTOT + p0 + tok; const bf16* prow = P + row * DINP;
              const float sq = exp2f((float)e * lg2g), sk = 0.125f * exp2f(-(float)e * lg2g);
              const u32x4 ql_ = *(const u32x4*)(prow + PC_RQ + hh * 64 + 8 * c), qh_ = *(const u32x4*)(prow + PC_RQ + hh * 64 + 32 + 8 * c);
              const u32x4 kl_ = *(const u32x4*)(prow + PC_RK + hh * 64 + 8 * c), kh_ = *(const u32x4*)(prow + PC_RK + hh * 64 + 32 + 8 * c);
              float qlo[8] = {bflo(ql_.x), bfhi(ql_.x), bflo(ql_.y), bfhi(ql_.y), bflo(ql_.z), bfhi(ql_.z), bflo(ql_.w), bfhi(ql_.w)}, qhi[8] = {bflo(qh_.x), bfhi(qh_.x), bflo(qh_.y), bfhi(qh_.y), bflo(qh_.z), bfhi(qh_.z), bflo(qh_.w), bfhi(qh_.w)};
              float klo[8] = {bflo(kl_.x), bfhi(kl_.x), bflo(kl_.y), bfhi(kl_.y), bflo(kl_.z), bfhi(kl_.z), bflo(kl_.w), bfhi(kl_.w)}, khi[8] = {bflo(kh_.x), bfhi(kh_.x), bflo(kh_.y), bfhi(kh_.y), bflo(kh_.z), bfhi(kh_.z), bflo(kh_.w), bfhi(kh_.w)};
              if (lat) { const float2* ang = rt + (size_t)(p0 - CTX + tok) * 32 + 8 * c;
#pragma unroll
                  for (int j = 0; j < 8; ++j) { const float2 cs = ang[j]; const float a0 = qlo[j], a1 = qhi[j], b0 = klo[j], b1 = khi[j];
                      qlo[j] = a0 * cs.x - a1 * cs.y; qhi[j] = a0 * cs.y + a1 * cs.x; klo[j] = b0 * cs.x - b1 * cs.y; khi[j] = b0 * cs.y + b1 * cs.x; } }
#pragma unroll
              for (int j = 0; j < 8; ++j) { qlo[j] *= sq; qhi[j] *= sq; klo[j] *= sk; khi[j] *= sk; }
              *(LAS bf16x8*)(Qs + tok * RT_QP + 8 * c) = pack8(qlo); *(LAS bf16x8*)(Qs + tok * RT_QP + 32 + 8 * c) = pack8(qhi);
              *(LAS bf16x8*)(Ks + tok * RT_QP + 8 * c) = pack8(klo); *(LAS bf16x8*)(Ks + tok * RT_QP + 32 + 8 * c) = pack8(khi);
              const int pt = permpos(tok);
#pragma unroll
              for (int j = 0; j < 8; ++j) { KsT[(8 * c + j) * RT_TP + pt] = f2bf(klo[j]); KsT[(32 + 8 * c + j) * RT_TP + pt] = f2bf(khi[j]); }
#pragma unroll
              for (int q4 = 0; q4 < 4; ++q4) { const u32x4 vv = *(const u32x4*)(prow + PC_RV + hh * 128 + 32 * c + 8 * q4); const unsigned vw[4] = {vv.x, vv.y, vv.z, vv.w};
#pragma unroll
                  for (int j = 0; j < 4; ++j) { VsT[(32 * c + 8 * q4 + 2 * j) * RT_TP + pt] = (bf16)(vw[j] & 0xffffu); VsT[(32 * c + 8 * q4 + 2 * j + 1) * RT_TP + pt] = (bf16)(vw[j] >> 16); } } }
            __syncthreads();
            f32x16 o0, o1;
#pragma unroll
            for (int i = 0; i < 16; ++i) { o0[i] = 0.f; o1[i] = 0.f; }
            for (int kb = 0; kb < 4; ++kb) {
                if (dir == 0 ? kb > rb : kb < rb) continue;
                f32x16 x;
#pragma unroll
                for (int i = 0; i < 16; ++i) x[i] = 0.f;
#pragma unroll
                for (int s = 0; s < 4; ++s) x = __builtin_amdgcn_mfma_f32_32x32x16_bf16(*(const LAS bf16x8*)(Ks + (kb * 32 + ql) * RT_QP + 16 * s + 8 * h), *(const LAS bf16x8*)(Qs + (rb * 32 + ql) * RT_QP + 16 * s + 8 * h), x, 0, 0, 0);
                if (kb == rb) {
#pragma unroll
                    for (int i = 0; i < 16; ++i) { const int key = crow16(i, h); const bool keep = dir == 0 ? key <= ql : key >= ql; x[i] = keep ? x[i] : 0.f; } }
                float xv[16];
#pragma unroll
                for (int i = 0; i < 16; ++i) xv[i] = x[i];
                const bf16x8 xa0 = pack8(xv), xa1 = pack8(xv + 8);
                const LAS bf16* v0 = VsT + ((2 * cbp) * 32 + ql) * RT_TP + kb * 32 + 8 * h; const LAS bf16* v1 = VsT + ((2 * cbp + 1) * 32 + ql) * RT_TP + kb * 32 + 8 * h;
                o0 = __builtin_amdgcn_mfma_f32_32x32x16_bf16(xa0, *(const LAS bf16x8*)(v0), o0, 0, 0, 0); o0 = __builtin_amdgcn_mfma_f32_32x32x16_bf16(xa1, *(const LAS bf16x8*)(v0 + 16), o0, 0, 0, 0);
                o1 = __builtin_amdgcn_mfma_f32_32x32x16_bf16(xa0, *(const LAS bf16x8*)(v1), o1, 0, 0, 0); o1 = __builtin_amdgcn_mfma_f32_32x32x16_bf16(xa1, *(const LAS bf16x8*)(v1 + 16), o1, 0, 0, 0);
            }
#pragma unroll
            for (int s = 0; s < 4; ++s) { const bf16x8 qa = *(const LAS bf16x8*)(Qs + (rb * 32 + ql) * RT_QP + 16 * s + 8 * h);
                o0 = __builtin_amdgcn_mfma_f32_32x32x16_bf16(qa, *(const LAS bf16x8*)(SsT + ((2 * cbp) * 32 + ql) * RT_QP + 16 * s + 8 * h), o0, 0, 0, 0);
                o1 = __builtin_amdgcn_mfma_f32_32x32x16_bf16(qa, *(const LAS bf16x8*)(SsT + ((2 * cbp + 1) * 32 + ql) * RT_QP + 16 * s + 8 * h), o1, 0, 0, 0); }
            { bf16* op = OFB + (size_t)dir * TS + ((size_t)b * LTOT + p0 + rb * 32) * 512 + hh * 128 + (2 * cbp) * 32 + ql;
#pragma unroll
              for (int i = 0; i < 16; ++i) { op[(size_t)crow16(i, h) * 512] = f2bf(o0[i]); op[(size_t)crow16(i, h) * 512 + 32] = f2bf(o1[i]); } }
            f32x16 u;
#pragma unroll
            for (int i = 0; i < 16; ++i) u[i] = 0.f;
#pragma unroll
            for (int s = 0; s < 8; ++s) u = __builtin_amdgcn_mfma_f32_32x32x16_bf16(*(const LAS bf16x8*)(KsT + (db * 32 + ql) * RT_TP + 16 * s + 8 * h), *(const LAS bf16x8*)(VsT + (vb * 32 + ql) * RT_TP + 16 * s + 8 * h), u, 0, 0, 0);
#pragma unroll
            for (int i = 0; i < 16; ++i) Sreg[i] = cdec * Sreg[i] + g127 * u[i];
            __syncthreads();
#pragma unroll
            for (int g = 0; g < 4; ++g) { u32x2 x; x.x = pk2(gam * Sreg[4 * g], gam * Sreg[4 * g + 1]); x.y = pk2(gam * Sreg[4 * g + 2], gam * Sreg[4 * g + 3]);
                *(LAS u32x2*)(SsT + (vb * 32 + ql) * RT_QP + db * 32 + 8 * g + 4 * h) = x; }
        }
    }
}

DI void phase_mixer_finish(Frame& F, const KA& a, int l) {
    const int lane = fresh_lane(), gw = F.bid * NWAVES + F.wave, NGW = F.G * NWAVES;
    const size_t TS = (size_t)NT * 512;
    const bf16* P = (const bf16*)(F.ws + WS_P); const bf16* OFB = (const bf16*)(F.ws + WS_OF); const bf16* YF = (const bf16*)(F.ws + WS_YF); const bf16* RW = (const bf16*)(F.ws + WS_RW);
    bf16* O0 = (bf16*)(F.ws + WS_ABR); bf16* O2 = O0 + 2 * TS;
    const float* lng = a.in(I_LNXG) + l * 512 + 8 * lane; const float* lnb = a.in(I_LNXB) + l * 512 + 8 * lane; const float* rkw = a.in(I_RK) + l * 512 + 8 * lane;
    float g_[8], b_[8], rk_[8];
    { const f32x4 x0 = *(const f32x4*)lng, x1 = *(const f32x4*)(lng + 4), y0 = *(const f32x4*)lnb, y1 = *(const f32x4*)(lnb + 4), z0 = *(const f32x4*)rkw, z1 = *(const f32x4*)(rkw + 4);
      g_[0] = x0.x; g_[1] = x0.y; g_[2] = x0.z; g_[3] = x0.w; g_[4] = x1.x; g_[5] = x1.y; g_[6] = x1.z; g_[7] = x1.w;
      b_[0] = y0.x; b_[1] = y0.y; b_[2] = y0.z; b_[3] = y0.w; b_[4] = y1.x; b_[5] = y1.y; b_[6] = y1.z; b_[7] = y1.w;
      rk_[0] = z0.x; rk_[1] = z0.y; rk_[2] = z0.z; rk_[3] = z0.w; rk_[4] = z1.x; rk_[5] = z1.y; rk_[6] = z1.z; rk_[7] = z1.w; }
#pragma unroll 1
    for (int r0 = gw; r0 < NT; r0 += 2 * NGW) {
        u32x4 uyf[2], uyb[2], ur[2], ukf[2], ukb[2], uv[2], ug[2], uof[2], uob[2], ugf[2], ugb[2]; size_t oo[2]; bool act[2];
#pragma unroll
        for (int u = 0; u < 2; ++u) { int r = r0 + u * NGW; act[u] = r < NT; if (!act[u]) r = r0; const size_t o = (size_t)r * 512 + 8 * lane; oo[u] = o;
            uyf[u] = *(const u32x4*)(YF + o); uyb[u] = *(const u32x4*)(YF + TS + o); ur[u] = *(const u32x4*)(RW + o); ukf[u] = *(const u32x4*)(RW + TS + o); ukb[u] = *(const u32x4*)(RW + 2 * TS + o);
            uv[u] = *(const u32x4*)(RW + 3 * TS + o); ug[u] = *(const u32x4*)(RW + 7 * TS + o); uof[u] = *(const u32x4*)(OFB + o); uob[u] = *(const u32x4*)(OFB + TS + o);
            ugf[u] = *(const u32x4*)(P + (size_t)r * DINP + PC_RGF + 8 * lane); ugb[u] = *(const u32x4*)(P + (size_t)r * DINP + PC_RGB + 8 * lane); }
        __builtin_amdgcn_sched_barrier(0);
#pragma unroll
        for (int u = 0; u < 2; ++u) { if (!act[u]) continue; const size_t o = oo[u];
            { float yfv[8], ybv[8], s[8]; unpack8(uyf[u], yfv); unpack8(uyb[u], ybv);
#pragma unroll
              for (int j = 0; j < 8; ++j) s[j] = yfv[j] + ybv[j];
              float rr[8], kf[8], kb[8], vv[8], gg[8]; unpack8(ur[u], rr); unpack8(ukf[u], kf); unpack8(ukb[u], kb); unpack8(uv[u], vv); unpack8(ug[u], gg);
              float sm = 0.f, bn = 0.f;
#pragma unroll
              for (int j = 0; j < 8; ++j) { sm += s[j]; bn += rr[j] * (kf[j] + kb[j]) * rk_[j]; }
              sm += sx(sm, 1); sm += sx(sm, 2); sm += sx(sm, 4); bn += sx(bn, 1); bn += sx(bn, 2); bn += sx(bn, 4);
              const float mean = sm * (1.f / 64.f); float vs = 0.f;
#pragma unroll
              for (int j = 0; j < 8; ++j) { s[j] -= mean; vs += s[j] * s[j]; }
              vs += sx(vs, 1); vs += sx(vs, 2); vs += sx(vs, 4);
              const float rstd = rsqrtf(vs * (1.f / 64.f) + 64e-5f);
              float y[8];
#pragma unroll
              for (int j = 0; j < 8; ++j) y[j] = (s[j] * rstd * g_[j] + b_[j] + bn * vv[j]) * gg[j];
              *(bf16x8*)(O2 + o) = pack8(y); }
            { float ff[8], bb[8], gf[8], gb[8]; unpack8(uof[u], ff); unpack8(uob[u], bb); unpack8(ugf[u], gf); unpack8(ugb[u], gb);
              float sf = 0.f, sb = 0.f;
#pragma unroll
              for (int j = 0; j < 8; ++j) { sf += ff[j]; sb += bb[j]; }
#pragma unroll
              for (int o2 = 1; o2 < 16; o2 <<= 1) { sf += sx(sf, o2); sb += sx(sb, o2); }
              const float mf = sf * (1.f / 128.f), mb = sb * (1.f / 128.f); float vf = 0.f, vb = 0.f;
#pragma unroll
              for (int j = 0; j < 8; ++j) { ff[j] -= mf; bb[j] -= mb; vf += ff[j] * ff[j]; vb += bb[j] * bb[j]; }
#pragma unroll
              for (int o2 = 1; o2 < 16; o2 <<= 1) { vf += sx(vf, o2); vb += sx(vb, o2); }
              const float rf = rsqrtf(vf * (1.f / 128.f) + 1e-5f), rb = rsqrtf(vb * (1.f / 128.f) + 1e-5f);
              float y[8];
#pragma unroll
              for (int j = 0; j < 8; ++j) y[j] = ff[j] * rf * (gf[j] * sigmoidf_(gf[j])) + bb[j] * rb * (gb[j] * sigmoidf_(gb[j]));
              *(bf16x8*)(O0 + o) = pack8(y); } }
    }
}

constexpr int N_PHASES = 2 + 10 * DEPTH;
__global__ void __launch_bounds__(NTHREADS, 2) fwd_kernel(Args args) {
    extern __shared__ __attribute__((aligned(16))) unsigned char lds_raw[];
    Frame F;
    F.lds = (LAS unsigned char*)lds_raw;
    F.MISC = (volatile LAS unsigned*)(F.lds + LDS_MISC_OFF);
    F.tid = threadIdx.x; F.lane = F.tid & 63; F.wave = __builtin_amdgcn_readfirstlane(F.tid >> 6);
    F.G = gridDim.x; F.bid = blockIdx.x;
    F.ws = args.ws; F.ctl = (unsigned*)(args.ws + WS_CTL);
    if (F.tid < 32) F.MISC[F.tid] = 0u;
    __syncthreads();
    const int lo = args.ph_lo, hi = args.ph_hi;
    KA ka; ka.kp = (const CAS char*)__builtin_amdgcn_kernarg_segment_ptr();
    const bool multi = (hi - lo) > 1;
    XcdBarrier bar; bar.bar = F.ctl + CW_BAR; bar.x = 0; bar.st = nullptr;
    if (multi) bar = xcd_barrier_post(F.ctl + CW_BAR, F.MISC + 8);
#define IN(k) (lo <= (k) && (k) < hi)
#define OPQ() do { int l_; asm volatile("v_mbcnt_lo_u32_b32 %0, -1, 0\n\tv_mbcnt_hi_u32_b32 %0, -1, %0" : "=v"(l_)); { int b_ = F.bid, w_ = F.wave, g_ = F.G; asm volatile("" : "+s"(b_), "+s"(w_), "+s"(g_)); F.bid = b_; F.wave = w_; F.G = g_; } F.lane = l_; F.tid = F.wave * 64 + l_; \
        const CAS char* kp_ = (const CAS char*)__builtin_amdgcn_kernarg_segment_ptr(); asm volatile("" : "+s"(kp_)); ka.kp = kp_; F.ws = ka.ws(); F.ctl = (unsigned*)(F.ws + WS_CTL); } while (0)
#define SEAM(k) do { if (IN(k) && IN((k) + 1)) xcd_barrier(bar); } while (0)

    if (IN(0)) { OPQ(); phase_prologue(F, ka); } SEAM(0);
    if (IN(1)) { OPQ(); phase_init_rows(F, ka); } SEAM(1);

    for (int l = 0; l < DEPTH; ++l) {
        const int pb = 2 + 10 * l;
        if (IN(pb + 0)) { OPQ(); unsigned char* ws = F.ws;
            SchedInproj S; S.T.init(NT / 256, DINP / 256, F.G, F.bid); S.A = (const char*)(ws + WS_H); S.B = (const char*)(ws + WS_WIN + (size_t)l * 15 * MiB);
            EpiStoreBf16 E{(bf16*)(ws + WS_P), DINP};
            pg8::gemm_phase<EpiStoreBf16, SchedInproj, false>(F.lds, 1024, S, E, F.tid);
        }
        SEAM(pb + 0);
        if (IN(pb + 1)) { OPQ(); phase_mla_prep2(F, ka, l); OPQ(); phase_rwkv_prep2(F, ka, l); }
        SEAM(pb + 1);
#define ATTN_QUEUE(qword, ubeg, uend) do { const int xq_ = F.bid & 7; for (;;) { __syncthreads(); \
            if (F.wave == 0 && fresh_lane() == 0) F.MISC[0] = (unsigned)(ubeg) + __hip_atomic_fetch_add(F.ctl + (qword) + xq_, 1u, __ATOMIC_RELAXED, __HIP_MEMORY_SCOPE_AGENT); \
            __syncthreads(); const int u = (int)F.MISC[0]; if (u >= (uend)) break; \
            if (u < 128) attn_unit(F, u >> 4, xq_, 1 + (u & 15)); else attn_unit(F, u - 128, xq_, 0); } } while (0)
        const int nunits = (l == DEPTH - 1) ? 128 : 136;
        if (IN(pb + 2)) { OPQ();
            if (F.bid < NCHAIN) rwkv_chain_block(F, F.bid);
            else if (F.bid < NCHAIN + 32) phase_retention_item(F, ka, F.bid - NCHAIN);
            OPQ(); ATTN_QUEUE(CW_Q + l * 64, 0, nunits);
        }
        SEAM(pb + 2);
        if (IN(pb + 3)) { OPQ(); phase_mixer_finish(F, ka, l); }
        SEAM(pb + 3);
        if (IN(pb + 4)) { OPQ(); unsigned char* ws = F.ws;
            SchedMerge S; S.T.init(NT / 256, 4, F.G, F.bid, l == DEPTH - 1); S.A = (const char*)(ws + WS_ABR); S.B = (const char*)(ws + WS_WBR + (size_t)l * 3 * MiB);
            EpiMerge E{(const bf16*)(ws + WS_P), (bf16*)(ws + WS_MRG)};
            pg8::gemm_phase<EpiMerge, SchedMerge, false>(F.lds, 512, S, E, F.tid);
        }
        SEAM(pb + 4);
        if (IN(pb + 5)) { OPQ(); unsigned char* ws = F.ws;
            SchedPlain S; S.T.init(NT / 256, 4, F.G, F.bid, l == DEPTH - 1); S.A = (const char*)(ws + WS_MRG); S.B = (const char*)(ws + WS_WOUT + (size_t)l * 2 * MiB); S.K = 1024;
            EpiResid E{(float*)(ws + WS_X), (const float*)(ws + WS_MOD) + (size_t)l * 9 * 6144};
            pg8::gemm_phase<EpiResid, SchedPlain, false>(F.lds, 1024, S, E, F.tid);
        }
        SEAM(pb + 5);
        if (IN(pb + 6)) { OPQ(); phase_router(F, ka, l); }
        SEAM(pb + 6);
        if (IN(pb + 7)) { OPQ(); unsigned char* ws = F.ws;
            moe_build_table(F, F.ctl + CW_CNT + l * 32 * 16);
            SchedMoe S{(const LAS int*)(F.lds + LDS_TAB_OFF), (const char*)(ws + WS_H), (const char*)(ws + WS_WGU + (size_t)l * 128 * MiB), (const int*)(ws + WS_LIST), 8, F.bid, F.G, 0, (size_t)2048 * 1024 * 2, true};
            EpiSwiglu E{(bf16*)(ws + WS_ACT), ka.in(I_BGU) + (size_t)l * 32 * 2048};
            pg8::gemm_phase<EpiSwiglu, SchedMoe, true>(F.lds, 1024, S, E, F.tid);
        }
        SEAM(pb + 7);
        if (IN(pb + 8)) { OPQ(); unsigned char* ws = F.ws;
            moe_build_table(F, F.ctl + CW_CNT + l * 32 * 16);
            SchedMoe S{(const LAS int*)(F.lds + LDS_TAB_OFF), (const char*)(ws + WS_ACT), (const char*)(ws + WS_WDN + (size_t)l * 64 * MiB), (const int*)(ws + WS_LIST), 4, F.bid, F.G, 0, (size_t)1024 * 1024 * 2, false};
            EpiDown E{(bf16*)(ws + WS_Y), ka.in(I_BDOWN) + (size_t)l * 32 * 1024};
            pg8::gemm_phase<EpiDown, SchedMoe, false>(F.lds, 1024, S, E, F.tid);
        }
        SEAM(pb + 8);
        if (IN(pb + 9)) { OPQ(); phase_combine(F, ka, l); }
        SEAM(pb + 9);

    }
#undef IN
#undef SEAM
}

extern "C" void kernel_launch(void* const* d_in, const int* in_sizes, int n_in, void* d_out, int out_size, void* d_ws, size_t ws_size, hipStream_t stream) {
    static int grid = 0;
    if (grid == 0) {
        if (n_in != N_IN || ws_size < WS_END) { fprintf(stderr, "kernel_launch: unexpected n_in %d or ws_size %zu (need %zu)\n", n_in, ws_size, (size_t)WS_END); grid = -1; return; }
        int dev = 0, cus = 0, per_cu = 0;
        hipGetDevice(&dev); hipDeviceGetAttribute(&cus, hipDeviceAttributeMultiprocessorCount, dev);
        if (hipFuncSetAttribute((const void*)fwd_kernel, hipFuncAttributeMaxDynamicSharedMemorySize, LDS_BYTES) != hipSuccess) { fprintf(stderr, "kernel_launch: hipFuncSetAttribute failed\n"); grid = -1; return; }
        if (hipOccupancyMaxActiveBlocksPerMultiprocessor(&per_cu, (const void*)fwd_kernel, NTHREADS, LDS_BYTES) != hipSuccess || per_cu < 1) { fprintf(stderr, "kernel_launch: occupancy query says %d\n", per_cu); }
        (void)hipGetLastError();
        grid = cus > 0 ? cus : 256;
        if (grid > 256) grid = 256;
    }
    if (grid < 0) return;
    (void)in_sizes; (void)out_size;
    hipMemsetAsync((char*)d_ws + WS_CTL, 0, CTL_ZERO_BYTES, stream);
    Args a{};
    for (int i = 0; i < N_IN; ++i) a.in[i] = (const float*)d_in[i];
    a.out = (float*)d_out; a.ws = (unsigned char*)d_ws;
#if MK_ONE_LAUNCH
    a.ph_lo = 0; a.ph_hi = N_PHASES;
    hipLaunchKernelGGL(fwd_kernel, dim3(grid), dim3(NTHREADS), LDS_BYTES, stream, a);
#else
    for (int ph = 0; ph < N_PHASES; ++ph) { a.ph_lo = ph; a.ph_hi = ph + 1; hipLaunchKernelGGL(fwd_kernel, dim3(grid), dim3(NTHREADS), LDS_BYTES, stream, a); }
#endif
    hipError_t le = hipGetLastError();
    if (le != hipSuccess) fprintf(stderr, "kernel_launch: launch failed: %s\n", hipGetErrorName(le));
}
```

```cpp
#include <hip/hip_runtime.h>
#include <cstdio>
#include <cstdint>

#ifndef MK_ONE_LAUNCH
#define MK_ONE_LAUNCH 1
#endif

#define GAS __attribute__((address_space(1)))
#define LAS __attribute__((address_space(3)))
typedef unsigned short bf16;
typedef short bf16x8 __attribute__((ext_vector_type(8)));
typedef float f32x2 __attribute__((ext_vector_type(2)));
typedef float f32x4 __attribute__((ext_vector_type(4)));
typedef float f32x16 __attribute__((ext_vector_type(16)));
typedef unsigned u32x2 __attribute__((ext_vector_type(2)));
typedef unsigned u32x4 __attribute__((ext_vector_type(4)));
typedef __bf16 bf16v2 __attribute__((ext_vector_type(2)));
#define DI __device__ __forceinline__

constexpr int D = 1024, BATCH = 8, SEQ = 4096, CTX = 256, LTOT = SEQ + CTX  , NT = BATCH * LTOT  , DEPTH = 4;
constexpr int DIN = 7456, DINP = 7680;
constexpr int NEXP = 32, TOPK = 4, DEXP = 1024;
constexpr int NSLOT = NT * TOPK + NEXP * 256;
constexpr int PC_RQ = 0, PC_RK = 256, PC_RV = 512, PC_RGF = 1024, PC_RGB = 1536, PC_MQ = 2048, PC_MKV = 2304, PC_MPE = 2432,
              PC_RW = 2464, PC_WR = 2464, PC_WK = 2976, PC_WV = 3488, PC_WHF = 4000, PC_WHB = 4064, PC_AHF = 4128, PC_AHB = 4192, PC_GH = 4256, PC_GATE = 4384;
enum { I_X = 0, I_C, I_CTX, I_CCTX, I_ADAW, I_ADAB, I_N1G, I_N2G, I_WIN, I_MQNG, I_WUQ, I_MKVNG, I_WUKV, I_QKQG, I_QKKG, I_MUP, I_MUN, I_W0, I_W2, I_A0, I_A2, I_G2,
       I_KK, I_KA, I_RK, I_LNXG, I_LNXB, I_BRRET, I_BRMLA, I_BRRWKV, I_WOUT, I_WROUTER, I_BROUTER, I_WGU, I_BGU, I_WDOWN, I_BDOWN, N_IN };

constexpr size_t MiB = 1u << 20;
constexpr size_t WS_CTL = 0, CTL_ZERO_BYTES = 1 * MiB;
constexpr size_t WS_MOD = 1 * MiB;
constexpr size_t WS_ROPE = 2 * MiB;
constexpr size_t WS_ROPE_AX = 3 * MiB;
constexpr size_t WS_SMALLW = 4 * MiB;
constexpr size_t SW_UQ = 0, SW_UKV = 393216, SW_W2 = 655360, SW_A2 = 786432, SW_G2 = 917504;
constexpr size_t WS_WBR = 8 * MiB;
constexpr size_t WS_WOUT = 20 * MiB;
constexpr size_t WS_WIN = 28 * MiB;
constexpr size_t WS_WGU = 88 * MiB;
constexpr size_t WS_WDN = 600 * MiB;
constexpr size_t WS_X = 856 * MiB;
constexpr size_t WS_H = 992 * MiB;
constexpr size_t WS_P = 1062 * MiB;
constexpr size_t WS_QB = 1572 * MiB;
constexpr size_t WS_KB = 1623 * MiB;
constexpr size_t WS_VT = 1674 * MiB;
constexpr size_t WS_RW = 1708 * MiB;
constexpr size_t RW_STRIDE = (size_t)NT * 512 * 2;
constexpr size_t WS_LW = 1980 * MiB;
constexpr size_t WS_YF = 2116 * MiB;
constexpr size_t WS_OF = 2252 * MiB;
constexpr size_t WS_ABR = 2388 * MiB;
constexpr size_t WS_MRG = 2490 * MiB;
constexpr size_t WS_TOPK = 2558 * MiB;
constexpr size_t WS_LIST = 2560 * MiB;
constexpr size_t WS_ACT = 2565 * MiB;
constexpr size_t WS_Y = 2853 * MiB;
constexpr size_t WS_END = 3141 * MiB;
constexpr int CW_TMO = 0, CW_BAR = 4096, CW_CNT = 8192  , CW_Q = 12288  ;

DI unsigned pk2(float lo, float hi) { f32x2 v = {lo, hi}; bf16v2 r = __builtin_convertvector(v, bf16v2); return __builtin_bit_cast(unsigned, r); }
DI bf16 f2bf(float f) { return (bf16)(pk2(f, 0.f) & 0xffffu); }
DI float bf2f(unsigned short b) { return __uint_as_float(((unsigned)b) << 16); }
DI float bflo(unsigned w) { return __uint_as_float(w << 16); }
DI float bfhi(unsigned w) { return __uint_as_float(w & 0xffff0000u); }
DI int fresh_lane() { int l_; asm volatile("v_mbcnt_lo_u32_b32 %0, -1, 0\n\tv_mbcnt_hi_u32_b32 %0, -1, %0" : "=v"(l_)); return l_; }
DI bf16x8 pack8(const float* v) { u32x4 x; x.x = pk2(v[0], v[1]); x.y = pk2(v[2], v[3]); x.z = pk2(v[4], v[5]); x.w = pk2(v[6], v[7]); return __builtin_bit_cast(bf16x8, x); }
DI float sx(float v, int mask) { const int l = fresh_lane(); return __int_as_float(__builtin_amdgcn_ds_bpermute((l ^ mask) << 2, __float_as_int(v))); }
DI float sup(float v, int d) { const int l = fresh_lane(); return __int_as_float(__builtin_amdgcn_ds_bpermute((l - d) << 2, __float_as_int(v))); }
DI float dpp_scan64(float x) {
    float t;
    t = __int_as_float(__builtin_amdgcn_update_dpp(0, __float_as_int(x), 0x111, 0xf, 0xf, false)); x += t;
    t = __int_as_float(__builtin_amdgcn_update_dpp(0, __float_as_int(x), 0x112, 0xf, 0xf, false)); x += t;
    t = __int_as_float(__builtin_amdgcn_update_dpp(0, __float_as_int(x), 0x114, 0xf, 0xf, false)); x += t;
    t = __int_as_float(__builtin_amdgcn_update_dpp(0, __float_as_int(x), 0x118, 0xf, 0xf, false)); x += t;
    t = __int_as_float(__builtin_amdgcn_update_dpp(0, __float_as_int(x), 0x142, 0xa, 0xf, false)); x += t;
    t = __int_as_float(__builtin_amdgcn_update_dpp(0, __float_as_int(x), 0x143, 0xc, 0xf, false)); x += t;
    return x;
}
DI float wave_sum(float v) {
#pragma unroll
    for (int o = 1; o < 64; o <<= 1) v += sx(v, o);
    return v;
}
DI void unpack8(const u32x4& w, float* o) { o[0] = bflo(w.x); o[1] = bfhi(w.x); o[2] = bflo(w.y); o[3] = bfhi(w.y); o[4] = bflo(w.z); o[5] = bfhi(w.z); o[6] = bflo(w.w); o[7] = bfhi(w.w); }
DI f32x16 zero16() { f32x16 z; for (int i = 0; i < 16; ++i) z[i] = 0.f; return z; }
DI float sigmoidf_(float x) { return __builtin_amdgcn_rcpf(1.f + __expf(-x)); }
#define LDS_WAIT() asm volatile("s_waitcnt lgkmcnt(0)" ::: "memory")
#define VM_WAIT() asm volatile("s_waitcnt vmcnt(0)" ::: "memory")
#define LDS_BARRIER() do { asm volatile("s_waitcnt lgkmcnt(0)" ::: "memory"); __builtin_amdgcn_s_barrier(); asm volatile("" ::: "memory"); } while (0)

#define XB_TMO      128
#define XB_XCNT(j)  (256  + 64 * (j))
#define XB_XSUB(j)  (1280 + 64 * (j))
#define XB_XGEN(j)  (2304 + 64 * (j))
#define XB_TOP      3328
#define XB_TOPGEN   3392
#define XCD_BAR_WORDS 3456
#define XB_SPIN_CAP (1u << 22)

__device__ __forceinline__ unsigned xb_ld(unsigned* p)              { return __hip_atomic_load(p, __ATOMIC_RELAXED, __HIP_MEMORY_SCOPE_AGENT); }
__device__ __forceinline__ unsigned xb_add(unsigned* p, unsigned v) { return __hip_atomic_fetch_add(p, v, __ATOMIC_RELAXED, __HIP_MEMORY_SCOPE_AGENT); }
__device__ __forceinline__ unsigned xb_xcc_id() { return (unsigned)__builtin_amdgcn_s_getreg((3 << 11) | 20) & 0xFu; }
#define XB_SPIN(cond, bar) do { unsigned _sp = 0; while (cond) { __builtin_amdgcn_s_sleep(1); \
    if ((++_sp & 255u) == 0u) { if (xb_ld(&(bar)[XB_TMO])) break; if (_sp > XB_SPIN_CAP) { atomicAdd(&(bar)[XB_TMO], 1u); break; } } } } while (0)

struct XcdBarrier { unsigned* bar; unsigned x; volatile LAS unsigned* st; };

__device__ __forceinline__ XcdBarrier xcd_barrier_post(unsigned* bar, volatile LAS unsigned* st) {
    XcdBarrier b; b.bar = bar; b.x = xb_xcc_id(); b.st = st;
    if (threadIdx.x == 0) (void)xb_add(&bar[XB_XCNT(b.x)], 1u);
    return b;
}
__device__ __forceinline__ void xcd_barrier_complete(unsigned* bar, unsigned x, unsigned& nloc, unsigned& nx) {
    const unsigned G = gridDim.x * gridDim.y * gridDim.z;
    unsigned sum, cnt, mine, sp = 0u;
    for (;;) {
        sum = 0u; cnt = 0u; mine = 0u;
#pragma unroll
        for (unsigned j = 0; j < 16; ++j) { const unsigned c = xb_ld(&bar[XB_XCNT(j)]); sum += c; cnt += (c > 0u) ? 1u : 0u; mine = (j == x) ? c : mine; }
        if (sum == G) break;
        __builtin_amdgcn_s_sleep(1);
        if ((++sp & 255u) == 0u) { if (xb_ld(&bar[XB_TMO])) break; if (sp > XB_SPIN_CAP) { atomicAdd(&bar[XB_TMO], 1u); break; } }
    }
    nloc = mine > 0u ? mine : 1u; nx = cnt > 0u ? cnt : 1u;
}
__device__ __forceinline__ void xcd_barrier(const XcdBarrier& b) {
    asm volatile("s_waitcnt vmcnt(0)" ::: "memory");
    __syncthreads();
    if (threadIdx.x == 0) {
        unsigned* bar = b.bar;
        __builtin_amdgcn_s_waitcnt(0);
        unsigned nloc = b.st[0], nx = b.st[1];
        if (nloc == 0u) { xcd_barrier_complete(bar, b.x, nloc, nx); b.st[0] = nloc; b.st[1] = nx; }
        const unsigned old = xb_add(&bar[XB_XSUB(b.x)], 1u);
        const unsigned gen = old / nloc;
        if (old + 1u == (gen + 1u) * nloc) {
            __builtin_amdgcn_fence(__ATOMIC_RELEASE, "agent");
            asm volatile("s_waitcnt vmcnt(0)" ::: "memory");
            const unsigned og = xb_add(&bar[XB_TOP], 1u);
            const unsigned tg = og / nx;
            if (og + 1u == (tg + 1u) * nx) xb_add(&bar[XB_TOPGEN], 1u);
            else XB_SPIN(xb_ld(&bar[XB_TOPGEN]) == tg, bar);
            __builtin_amdgcn_fence(__ATOMIC_ACQUIRE, "agent");
            xb_add(&bar[XB_XGEN(b.x)], 1u);
            asm volatile("s_waitcnt vmcnt(0)" ::: "memory");
        } else {
            XB_SPIN(xb_ld(&bar[XB_XGEN(b.x)]) == gen, bar);
            __builtin_amdgcn_fence(__ATOMIC_ACQUIRE, "agent");
            asm volatile("s_waitcnt vmcnt(0)" ::: "memory");
        }
    }
    __syncthreads();
}

namespace pg8 {
constexpr int BM = 256, BK = 64, HALF = 128, HTB = HALF * BK * 2, STAGE_BYTES = 8 * HTB;
__host__ __device__ __forceinline__ int lds_byte(int r, int c) { const int st = (r >> 4) * 2 + (c >> 5), rr = r & 15, cc = c & 31, ob = rr * 64 + cc * 2; return st * 1024 + (ob ^ (((ob >> 9) & 1) << 5)); }
__host__ __device__ __forceinline__ void stage_rc(int b, int& R, int& C) { const int st = b / 1024, sb = b % 1024, swz = sb ^ (((sb >> 9) & 1) << 5); R = (st >> 1) * 16 + swz / 64; C = (st & 1) * 32 + (swz % 64) / 2; }
__host__ __device__ __forceinline__ int perm32(int rho) { const int n = rho >> 4, i = rho & 15; return 8 * (i >> 2) + 4 * n + (i & 3); }

struct Unit { const char* pa; const char* pb; int x, y, z; };

struct TileOrder {
    int nM, nN, nwg, G, c; bool skipctx;
    DI void init(int nM_, int nN_, int G_, int c_, bool skipctx_ = false) { skipctx = skipctx_; nM = skipctx_ ? nM_ - BATCH : nM_; nN = nN_; nwg = nM * nN; G = G_; c = c_; }
    DI bool tile(int i, int& pm, int& pn) const {
        const long L = (long)i * G + c; if (L >= nwg) return false;
        int wgid = (int)L; { const int q = nwg / 8, r = nwg % 8, xcd = wgid % 8, off = wgid / 8; wgid = (xcd < r ? xcd * (q + 1) : r * (q + 1) + (xcd - r) * q) + off; }
        const int nig = 8 * nN, gid = wgid / nig, fm = gid * 8, gsz = (nM - fm) < 8 ? (nM - fm) : 8;
        pm = fm + ((wgid % nig) % gsz); pn = (wgid % nig) / gsz; if (skipctx) pm = pm + pm / 16 + 1; return true;
    }
};

DI unsigned cvt_pk_bf16(float lo, float hi) { return pk2(lo, hi); }

template <class Epi, class Sched, bool GATHER>
__device__ __forceinline__ void gemm_phase(LAS unsigned char* lds, const int K, const Sched& S, const Epi& E, const int tid) {
    const int wid = __builtin_amdgcn_readfirstlane(tid >> 6), lane = tid & 63, wr = wid >> 2, wc = wid & 3, fr = lane & 15, fq = lane >> 4;
    const int nt = K / BK;
    unsigned voffA[2], voffB[2]; int stR[2];
#pragma unroll
    for (int i = 0; i < 2; ++i) { int R, C; stage_rc(tid * 16 + i * 8192, R, C); const int Rb = Epi::PERM ? ((R & ~31) + perm32(R & 31)) : R;
        voffA[i] = GATHER ? (unsigned)(C * 2) : (unsigned)(R * K + C) * 2u; voffB[i] = (unsigned)(Rb * K + C) * 2u; stR[i] = R; }
    const size_t kstep = (size_t)(BK * 2);
    const size_t hstep = (size_t)HALF * K * 2;
    const unsigned ldsw = (unsigned)wid * 1024u;
    const int aoff = lds_byte(wr * 64 + fr, fq * 8), boff = lds_byte(wc * 32 + fr, fq * 8);
#define PG8_SA(b, h) (((b) * 2 + (h)) * HTB)
#define PG8_SB(b, h) ((4 + (b) * 2 + (h)) * HTB)
#define PG8_STAGE(bufoff, gbase, voff) do { _Pragma("unroll") for (int _i = 0; _i < 2; ++_i) \
        __builtin_amdgcn_global_load_lds((const unsigned*)((const char*)(gbase) + (voff)[_i]), (LAS unsigned*)(lds + (bufoff) + ldsw + _i * 8192), 16, 0, 0); } while (0)
#define PG8_STAGE_A(bufoff, gbase, h, rw) do { if constexpr (GATHER) { _Pragma("unroll") for (int _i = 0; _i < 2; ++_i) { \
            const unsigned _row = ((rw)[h] >> (16 * _i)) & 0xffffu; \
            __builtin_amdgcn_global_load_lds((const unsigned*)((const char*)(gbase) + (size_t)_row * (size_t)(K * 2) + voffA[_i]), (LAS unsigned*)(lds + (bufoff) + ldsw + _i * 8192), 16, 0, 0); } } \
        else { PG8_STAGE(bufoff, (const char*)(gbase) + (h) * hstep, voffA); } } while (0)
#define PG8_LDA(dst, b, h) do { _Pragma("unroll") for (int m = 0; m < 4; ++m) _Pragma("unroll") for (int k = 0; k < 2; ++k) dst[m][k] = *(const LAS bf16x8*)(lds + PG8_SA(b, h) + aoff + m * 2048 + k * 1024); } while (0)
#define PG8_LDB(dst, b, h) do { _Pragma("unroll") for (int n = 0; n < 2; ++n) _Pragma("unroll") for (int k = 0; k < 2; ++k) dst[n][k] = *(const LAS bf16x8*)(lds + PG8_SB(b, h) + boff + n * 2048 + k * 1024); } while (0)
#define PG8_MMA(ai, bj, At, Bt) do { __builtin_amdgcn_s_setprio(1); _Pragma("unroll") for (int m = 0; m < 4; ++m) _Pragma("unroll") for (int n = 0; n < 2; ++n) _Pragma("unroll") for (int k = 0; k < 2; ++k) \
        acc[ai][bj][m][n] = __builtin_amdgcn_mfma_f32_16x16x32_bf16(Bt[n][k], At[m][k], acc[ai][bj][m][n], 0, 0, 0); __builtin_amdgcn_s_setprio(0); } while (0)
#define PG8_WAIT_V(n) asm volatile("s_waitcnt vmcnt(" #n ")" ::: "memory")
#define PG8_WAIT_L(n) asm volatile("s_waitcnt lgkmcnt(" #n ")" ::: "memory")
#define PG8_BAR __builtin_amdgcn_s_barrier()
#define PG8_SCHED __builtin_amdgcn_sched_barrier(0)
    Unit cur, nxt; int ui = 0;
    if (!S.next(0, cur)) return;
    f32x4 acc[2][2][4][2];
#pragma unroll
    for (int a = 0; a < 2; ++a)
#pragma unroll
        for (int b = 0; b < 2; ++b)
#pragma unroll
            for (int m = 0; m < 4; ++m)
#pragma unroll
                for (int n = 0; n < 2; ++n) acc[a][b][m][n] = (f32x4){0.f, 0.f, 0.f, 0.f};
    bf16x8 At[4][2], B0[2][2], B1[2][2];
    const char* cA = cur.pa; const char* cB = cur.pb;
    unsigned rwc[2] = {0u, 0u}, rwn[2] = {0u, 0u};
    if constexpr (GATHER) S.rows(cur, stR[0], stR[1], rwc);
    PG8_STAGE(PG8_SB(0, 0), cB, voffB); PG8_STAGE(PG8_SB(0, 1), cB + hstep, voffB); PG8_STAGE_A(PG8_SA(0, 0), cA, 0, rwc); PG8_STAGE_A(PG8_SA(0, 1), cA, 1, rwc);
    if (wr == 1) PG8_BAR;
    PG8_WAIT_V(2); PG8_BAR;
    PG8_STAGE(PG8_SB(1, 0), cB + kstep, voffB); PG8_STAGE_A(PG8_SA(1, 0), cA + kstep, 0, rwc); PG8_STAGE(PG8_SB(1, 1), cB + hstep + kstep, voffB);
    PG8_WAIT_V(6); PG8_BAR;
    for (;;) {
        const bool has_next = S.next(ui + 1, nxt);
        const char* nA = has_next ? nxt.pa : cA; const char* nB = has_next ? nxt.pb : cB;
        if constexpr (GATHER) { if (has_next) S.rows(nxt, stR[0], stR[1], rwn); else { rwn[0] = rwc[0]; rwn[1] = rwc[1]; } }
        for (int t = 0; t < nt; t += 2) {
            const bool last = (t == nt - 2);
            const char* a1 = cA + (size_t)(t + 1) * kstep;
            const char* a2 = last ? nA : cA + (size_t)(t + 2) * kstep; const char* b2 = last ? nB : cB + (size_t)(t + 2) * kstep;
            const char* a3 = a2 + kstep; const char* b3 = b2 + kstep;
            unsigned rw2[2]; rw2[0] = last ? rwn[0] : rwc[0]; rw2[1] = last ? rwn[1] : rwc[1];
            PG8_LDB(B0, 0, 0); PG8_LDB(B1, 0, 1); PG8_SCHED; PG8_LDA(At, 0, 0); PG8_STAGE_A(PG8_SA(1, 1), a1, 1, rwc);
            PG8_WAIT_V(8); PG8_WAIT_L(0); PG8_BAR; PG8_MMA(0, 0, At, B0); PG8_MMA(0, 1, At, B1); PG8_BAR; PG8_SCHED;
            PG8_LDA(At, 0, 1); PG8_STAGE(PG8_SB(0, 0), b2, voffB); PG8_STAGE(PG8_SB(0, 1), b2 + hstep, voffB); PG8_STAGE_A(PG8_SA(0, 0), a2, 0, rw2);
            PG8_WAIT_V(8); PG8_WAIT_L(0); PG8_BAR; PG8_MMA(1, 0, At, B0); PG8_MMA(1, 1, At, B1); PG8_BAR; PG8_SCHED;
            PG8_LDB(B0, 1, 0); PG8_LDB(B1, 1, 1); PG8_SCHED; PG8_LDA(At, 1, 0); PG8_STAGE_A(PG8_SA(0, 1), a2, 1, rw2);
            PG8_WAIT_V(8); PG8_WAIT_L(0); PG8_BAR; PG8_MMA(0, 0, At, B0); PG8_MMA(0, 1, At, B1); PG8_BAR; PG8_SCHED;
            PG8_LDA(At, 1, 1); PG8_STAGE(PG8_SB(1, 0), b3, voffB); PG8_STAGE(PG8_SB(1, 1), b3 + hstep, voffB); PG8_STAGE_A(PG8_SA(1, 0), a3, 0, rw2);
            PG8_WAIT_V(8); PG8_WAIT_L(0); PG8_BAR; PG8_MMA(1, 0, At, B0); PG8_MMA(1, 1, At, B1); PG8_BAR; PG8_SCHED;
        }
        if (wr == 0) PG8_BAR;
        { int l2_; asm volatile("v_mbcnt_lo_u32_b32 %0, -1, 0\n\tv_mbcnt_hi_u32_b32 %0, -1, %0" : "=v"(l2_));
          E(acc, cur, wr, wc, l2_ & 15, l2_ >> 4); }
        if (!has_next) break;
        cur = nxt; cA = nA; cB = nB; ++ui;
        if constexpr (GATHER) { rwc[0] = rwn[0]; rwc[1] = rwn[1]; }
        if (wr == 1) PG8_BAR;
    }
    PG8_WAIT_V(0);
    PG8_BAR;
#undef PG8_SA
#undef PG8_SB
#undef PG8_STAGE
#undef PG8_STAGE_A
#undef PG8_LDA
#undef PG8_LDB
#undef PG8_MMA
#undef PG8_WAIT_V
#undef PG8_WAIT_L
#undef PG8_BAR
#undef PG8_SCHED
}
#define ACC_ZERO(acc) do { _Pragma("unroll") for (int a_ = 0; a_ < 2; ++a_) _Pragma("unroll") for (int b_ = 0; b_ < 2; ++b_) _Pragma("unroll") for (int m_ = 0; m_ < 4; ++m_) _Pragma("unroll") for (int n_ = 0; n_ < 2; ++n_) \
        acc[a_][b_][m_][n_] = (f32x4){0.f, 0.f, 0.f, 0.f}; } while (0)
}

constexpr int NWAVES = 8, NTHREADS = 512;
constexpr int RING_BYTES = 131072;
constexpr int LDS_TAB_OFF = RING_BYTES;
constexpr int LDS_MISC_OFF = RING_BYTES + 8192;
constexpr int LDS_BYTES = 147456;

struct Args { const float* in[N_IN]; float* out; unsigned char* ws; int ph_lo, ph_hi; };

#define CAS __attribute__((address_space(4)))
struct KA { const CAS char* kp;
    DI const float* in(int i) const { return *(const float* const CAS*)(kp + 8 * i); }
    DI float* out() const { return *(float* const CAS*)(kp + 8 * N_IN); }
    DI unsigned char* ws() const { return *(unsigned char* const CAS*)(kp + 8 * N_IN + 8); } };
struct Frame {
    LAS unsigned char* lds;
    volatile LAS unsigned* MISC;
    unsigned* ctl;
    unsigned char* ws;
    int tid, lane, wave, G, bid;
};

DI int row_modrow(int r) { const int b = r / LTOT, p = r - b * LTOT; return p < CTX ? 8 : b; }

struct SchedInproj {
    pg8::TileOrder T; const char* A; const char* B;
    DI bool next(int i, pg8::Unit& u) const { int pm, pn; if (!T.tile(i, pm, pn)) return false; u.pa = A + (size_t)pm * (256 * 1024 * 2); u.pb = B + (size_t)pn * (256 * 1024 * 2); u.x = pm; u.y = pn; u.z = 0; return true; }
};
struct EpiStoreBf16 {
    static constexpr bool PERM = true;
    bf16* O; int ldc;
    DI void operator()(f32x4 (&acc)[2][2][4][2], const pg8::Unit& u, int wr, int wc, int fr, int fq) const {
        const int row0 = u.x * 256 + wr * 64 + fr, col0 = u.y * 256 + wc * 32 + 8 * fq;
#pragma unroll
        for (int ai = 0; ai < 2; ++ai)
#pragma unroll
            for (int m = 0; m < 4; ++m) { bf16* rowp = O + (size_t)(row0 + ai * 128 + m * 16) * ldc + col0;
#pragma unroll
                for (int bj = 0; bj < 2; ++bj) { const f32x4 v0 = acc[ai][bj][m][0], v1 = acc[ai][bj][m][1];
                    u32x4 w; w.x = pk2(v0[0], v0[1]); w.y = pk2(v0[2], v0[3]); w.z = pk2(v1[0], v1[1]); w.w = pk2(v1[2], v1[3]);
                    *(u32x4*)(rowp + bj * 128) = w; } }
        ACC_ZERO(acc);
    }
};
struct SchedMerge {
    pg8::TileOrder T; const char* A; const char* B;
    DI bool next(int i, pg8::Unit& u) const { const int ti = i / 3, br = i - ti * 3; int pm, pn; if (!T.tile(ti, pm, pn)) return false;
        u.pa = A + (size_t)br * ((size_t)NT * 512 * 2) + (size_t)pm * (256 * 512 * 2); u.pb = B + (size_t)br * (1024 * 512 * 2) + (size_t)pn * (256 * 512 * 2); u.x = pm; u.y = pn; u.z = br; return true; }
};
struct EpiMerge {
    static constexpr bool PERM = true;
    const bf16* P; bf16* O;
    static DI float en(float x) { return __builtin_amdgcn_exp2f(fminf(x * -1.4426950408889634f, 43.28f)); }
    DI void operator()(f32x4 (&acc)[2][2][4][2], const pg8::Unit& u, int wr, int wc, int fr, int fq) const {
        const int row0 = u.x * 256 + wr * 64 + fr, col0 = u.y * 256 + wc * 32 + 8 * fq, br = u.z;
#pragma unroll
        for (int ai = 0; ai < 2; ++ai) {
            u32x4 gc[4][2], gn[4][2];
#pragma unroll
            for (int m = 0; m < 4; ++m)
#pragma unroll
                for (int bj = 0; bj < 2; ++bj) { const bf16* gp = P + (size_t)(row0 + ai * 128 + m * 16) * DINP + PC_GATE + br * 1024 + col0 + bj * 128;
                    gc[m][bj] = *(const u32x4*)gp; gn[m][bj] = br < 2 ? *(const u32x4*)(gp + 1024) : (u32x4){0u, 0u, 0u, 0u}; }
            __builtin_amdgcn_sched_barrier(0);
#pragma unroll
            for (int m = 0; m < 4; ++m) { const size_t row = (size_t)(row0 + ai * 128 + m * 16);
#pragma unroll
                for (int bj = 0; bj < 2; ++bj) {
                    float lc[8], f[8]; unpack8(gc[m][bj], lc);
                    if (br < 2) { float ln[8]; unpack8(gn[m][bj], ln);
#pragma unroll
                        for (int j = 0; j < 8; ++j) f[j] = (1.f + en(ln[j])) * __builtin_amdgcn_rcpf(1.f + en(lc[j]));
                    } else {
#pragma unroll
                        for (int j = 0; j < 8; ++j) f[j] = __builtin_amdgcn_rcpf(1.f + en(lc[j]));
                    }
                    f32x4 v0 = acc[ai][bj][m][0], v1 = acc[ai][bj][m][1];
                    v0[0] *= f[0]; v0[1] *= f[1]; v0[2] *= f[2]; v0[3] *= f[3]; v1[0] *= f[4]; v1[1] *= f[5]; v1[2] *= f[6]; v1[3] *= f[7];
                    if (br == 2) { u32x4 w; w.x = pk2(v0[0], v0[1]); w.y = pk2(v0[2], v0[3]); w.z = pk2(v1[0], v1[1]); w.w = pk2(v1[2], v1[3]);
                        *(u32x4*)(O + row * 1024 + col0 + bj * 128) = w; v0 = (f32x4){0.f, 0.f, 0.f, 0.f}; v1 = v0; }
                    acc[ai][bj][m][0] = v0; acc[ai][bj][m][1] = v1; } }
            __builtin_amdgcn_sched_barrier(0); }
    }
};
struct SchedPlain {
    pg8::TileOrder T; const char* A; const char* B; int K;
    DI bool next(int i, pg8::Unit& u) const { int pm, pn; if (!T.tile(i, pm, pn)) return false; u.pa = A + (size_t)pm * ((size_t)256 * K * 2); u.pb = B + (size_t)pn * ((size_t)256 * K * 2); u.x = pm; u.y = pn; u.z = 0; return true; }
};
struct EpiResid {
    static constexpr bool PERM = false;
    float* X; const float* mod;
    DI void operator()(f32x4 (&acc)[2][2][4][2], const pg8::Unit& u, int wr, int wc, int fr, int fq) const {
        const int row0 = u.x * 256 + wr * 64 + fr, col0 = u.y * 256 + wc * 32 + 4 * fq;
        const float* g1 = mod + (size_t)row_modrow(u.x * 256) * 6144 + 2048 + col0;
        f32x4 gv[2][2];
#pragma unroll
        for (int bj = 0; bj < 2; ++bj)
#pragma unroll
            for (int n = 0; n < 2; ++n) gv[bj][n] = *(const f32x4*)(g1 + bj * 128 + n * 16);
#pragma unroll
        for (int ai = 0; ai < 2; ++ai) {
            f32x4 xv[4][2][2];
#pragma unroll
            for (int m = 0; m < 4; ++m)
#pragma unroll
                for (int bj = 0; bj < 2; ++bj)
#pragma unroll
                    for (int n = 0; n < 2; ++n) xv[m][bj][n] = *(const f32x4*)(X + (size_t)(row0 + ai * 128 + m * 16) * 1024 + col0 + bj * 128 + n * 16);
            __builtin_amdgcn_sched_barrier(0);
#pragma unroll
            for (int m = 0; m < 4; ++m)
#pragma unroll
                for (int bj = 0; bj < 2; ++bj)
#pragma unroll
                    for (int n = 0; n < 2; ++n) *(f32x4*)(X + (size_t)(row0 + ai * 128 + m * 16) * 1024 + col0 + bj * 128 + n * 16) = xv[m][bj][n] + gv[bj][n] * acc[ai][bj][m][n];
            __builtin_amdgcn_sched_barrier(0); }
        ACC_ZERO(acc);
    }
};
struct SchedMoe {
    const LAS int* tab; const char* A; const char* B; const int* list; int nN, c, G; size_t a_tile_bytes, b_exp_bytes; bool gather;
    DI bool next(int i, pg8::Unit& u) const {
        const int T = tab[96], Tq = (T + 7) >> 3, xcd = c & 7, q = i * (G >> 3) + (c >> 3), tl = q / nN, pn = q - tl * nN, t = xcd * Tq + tl;
        if (tl >= Tq || t >= T) return false;
        const int e = tab[128 + t], j = t - tab[64 + e], slot0 = tab[32 + e] + 256 * j;
        u.pa = gather ? A : A + (size_t)slot0 * 2048; u.pb = B + (size_t)e * b_exp_bytes + (size_t)pn * (256 * 1024 * 2); u.x = slot0; u.y = pn; u.z = e | (j << 8); return true;
    }
    DI void rows(const pg8::Unit& u, int R0, int R1, unsigned (&rw)[2]) const {
        const int e = u.z & 255, j = u.z >> 8, cnt = tab[e]; const int* le = list + (size_t)e * NT;
#pragma unroll
        for (int h = 0; h < 2; ++h) { const int i0 = j * 256 + h * 128 + R0, i1 = j * 256 + h * 128 + R1;
            const unsigned r0 = i0 < cnt ? (unsigned)(le[i0] >> 2) : (unsigned)NT, r1 = i1 < cnt ? (unsigned)(le[i1] >> 2) : (unsigned)NT; rw[h] = r0 | (r1 << 16); }
    }
};
struct EpiSwiglu {
    static constexpr bool PERM = true;
    bf16* ACT; const float* bgu;
    DI void operator()(f32x4 (&acc)[2][2][4][2], const pg8::Unit& u, int wr, int wc, int fr, int fq) const {
        const int row0 = u.x + wr * 64 + fr, ch0 = u.y * 128 + wc * 32 + 8 * fq, e = u.z & 255;
        const float* bg = bgu + (size_t)e * 2048 + ch0;
        const f32x4 bg0 = *(const f32x4*)bg, bg1 = *(const f32x4*)(bg + 4), bu0 = *(const f32x4*)(bg + 1024), bu1 = *(const f32x4*)(bg + 1028);
#pragma unroll
        for (int ai = 0; ai < 2; ++ai)
#pragma unroll
            for (int m = 0; m < 4; ++m) {
                const f32x4 g0 = acc[ai][0][m][0] + bg0, g1 = acc[ai][0][m][1] + bg1, u0 = acc[ai][1][m][0] + bu0, u1 = acc[ai][1][m][1] + bu1;
                float o[8];
#pragma unroll
                for (int j = 0; j < 8; ++j) { const float g = fminf(j < 4 ? g0[j & 3] : g1[j & 3], 7.f); const float up = fminf(fmaxf(j < 4 ? u0[j & 3] : u1[j & 3], -7.f), 7.f);
                    o[j] = g * __builtin_amdgcn_rcpf(1.f + __expf(-1.702f * g)) * (up + 1.f); }
                u32x4 w; w.x = pk2(o[0], o[1]); w.y = pk2(o[2], o[3]); w.z = pk2(o[4], o[5]); w.w = pk2(o[6], o[7]);
                *(u32x4*)(ACT + (size_t)(row0 + ai * 128 + m * 16) * 1024 + ch0) = w; }
        ACC_ZERO(acc);
    }
};
struct EpiDown {
    static constexpr bool PERM = true;
    bf16* Y; const float* bd;
    DI void operator()(f32x4 (&acc)[2][2][4][2], const pg8::Unit& u, int wr, int wc, int fr, int fq) const {
        const int row0 = u.x + wr * 64 + fr, col0 = u.y * 256 + wc * 32 + 8 * fq, e = u.z & 255;
        f32x4 bv[2][2];
#pragma unroll
        for (int bj = 0; bj < 2; ++bj)
#pragma unroll
            for (int n = 0; n < 2; ++n) bv[bj][n] = *(const f32x4*)(bd + (size_t)e * 1024 + col0 + bj * 128 + 4 * n);
#pragma unroll
        for (int ai = 0; ai < 2; ++ai)
#pragma unroll
            for (int m = 0; m < 4; ++m) { bf16* rowp = Y + (size_t)(row0 + ai * 128 + m * 16) * 1024 + col0;
#pragma unroll
                for (int bj = 0; bj < 2; ++bj) { const f32x4 v0 = acc[ai][bj][m][0] + bv[bj][0], v1 = acc[ai][bj][m][1] + bv[bj][1];
                    u32x4 w; w.x = pk2(v0[0], v0[1]); w.y = pk2(v0[2], v0[3]); w.z = pk2(v1[0], v1[1]); w.w = pk2(v1[2], v1[3]);
                    *(u32x4*)(rowp + bj * 128) = w; } }
        ACC_ZERO(acc);
    }
};
DI void moe_build_table(Frame& F, const unsigned* cnt  ) {
    LAS int* tab = (LAS int*)(F.lds + LDS_TAB_OFF);
    if (F.tid < 32) tab[F.tid] = (int)__hip_atomic_load(cnt + F.tid * 16, __ATOMIC_RELAXED, __HIP_MEMORY_SCOPE_AGENT);
    __syncthreads();
    if (F.tid == 0) { int pb = 0, tb = 0; for (int e = 0; e < 32; ++e) { const int nt_ = (tab[e] + 255) >> 8; tab[32 + e] = pb; tab[64 + e] = tb; pb += nt_ * 256; tb += nt_; } tab[96] = tb; }
    __syncthreads();
    for (int e = 0; e < 32; ++e) { const int tb = tab[64 + e], nt_ = (tab[e] + 255) >> 8; for (int j = F.tid; j < nt_; j += NTHREADS) tab[128 + tb + j] = e; }
    __syncthreads();
}

DI void transpose_item(const float* W, int K, int N, bf16* WT, int mode, const float* gk, LAS float* scr, int item, int lane) {
    const int nblk = N / 32, kb = item / nblk, nb = item % nblk, k0 = 64 * kb, n0 = 32 * nb;
#pragma unroll 8
    for (int i = 0; i < 32; ++i) { const int kk = 2 * i + (lane >> 5); float v = W[(size_t)(k0 + kk) * N + n0 + (lane & 31)]; if (gk) v *= gk[k0 + kk]; scr[kk * 33 + (lane & 31)] = v; }
    LDS_WAIT(); asm volatile("" ::: "memory");
    int drow0 = n0;
    if (mode == 1) { const int up = n0 >= 1024, ch = n0 - (up ? 1024 : 0); drow0 = (ch >> 7) * 256 + (up ? 128 : 0) + (ch & 127); }
    const int c = lane & 7;
#pragma unroll
    for (int j = 0; j < 4; ++j) { const int n = (lane >> 3) + 8 * j; const LAS float* s = scr + (8 * c) * 33 + n;
        u32x4 o; o.x = pk2(s[0 * 33], s[1 * 33]); o.y = pk2(s[2 * 33], s[3 * 33]); o.z = pk2(s[4 * 33], s[5 * 33]); o.w = pk2(s[6 * 33], s[7 * 33]);
        *(u32x4*)(WT + (size_t)(drow0 + n) * K + k0 + 8 * c) = o; }
    LDS_WAIT(); asm volatile("" ::: "memory");
}
DI void transpose_batch(Frame& F, const float* W, size_t ss, int K, int N, bf16* WT, size_t ds, int nb, int mode, const float* gk, size_t gks) {
    LAS float* scr = (LAS float*)(F.lds + F.wave * 16384);
    const int gw = F.bid * NWAVES + F.wave, NGW = F.G * NWAVES;
    const int per = (K / 64) * (N / 32), total = per * nb;
    for (int it = gw; it < total; it += NGW) { const int b = it / per, r = it - b * per;
        transpose_item(W + (size_t)b * ss, K, N, WT + (size_t)b * ds, mode, gk ? gk + (size_t)b * gks : nullptr, scr, r, F.lane); }
}
DI void phase_prologue(Frame& F, const KA& a) {
    unsigned char* ws = F.ws;
    transpose_batch(F, a.in(I_WIN), (size_t)1024 * DIN, 1024, DIN, (bf16*)(ws + WS_WIN), (size_t)DINP * 1024, 4, 0, nullptr, 0);
    transpose_batch(F, a.in(I_WGU), (size_t)1024 * 2048, 1024, 2048, (bf16*)(ws + WS_WGU), (size_t)2048 * 1024, 128, 1, nullptr, 0);
    transpose_batch(F, a.in(I_WDOWN), (size_t)1024 * 1024, 1024, 1024, (bf16*)(ws + WS_WDN), (size_t)1024 * 1024, 128, 0, nullptr, 0);
    transpose_batch(F, a.in(I_WOUT), (size_t)1024 * 1024, 1024, 1024, (bf16*)(ws + WS_WOUT), (size_t)1024 * 1024, 4, 0, nullptr, 0);
    transpose_batch(F, a.in(I_BRRET), (size_t)512 * 1024, 512, 1024, (bf16*)(ws + WS_WBR), (size_t)3 * 1024 * 512, 4, 0, nullptr, 0);
    transpose_batch(F, a.in(I_BRMLA), (size_t)512 * 1024, 512, 1024, (bf16*)(ws + WS_WBR) + (size_t)1024 * 512, (size_t)3 * 1024 * 512, 4, 0, nullptr, 0);
    transpose_batch(F, a.in(I_BRRWKV), (size_t)512 * 1024, 512, 1024, (bf16*)(ws + WS_WBR) + (size_t)2 * 1024 * 512, (size_t)3 * 1024 * 512, 4, 0, nullptr, 0);
    transpose_batch(F, a.in(I_WUQ), (size_t)256 * 768, 256, 768, (bf16*)(ws + WS_SMALLW + SW_UQ), MiB / 2, 4, 0, a.in(I_MQNG), 256);
    transpose_batch(F, a.in(I_WUKV), (size_t)128 * 1024, 128, 1024, (bf16*)(ws + WS_SMALLW + SW_UKV), MiB / 2, 4, 0, a.in(I_MKVNG), 128);
    for (int l = 0; l < 4; ++l) {
        transpose_batch(F, a.in(I_W2) + (size_t)l * 2 * 64 * 512, (size_t)64 * 512, 64, 512, (bf16*)(ws + WS_SMALLW + l * MiB + SW_W2), (size_t)512 * 64, 2, 0, nullptr, 0);
        transpose_batch(F, a.in(I_A2) + (size_t)l * 2 * 64 * 512, (size_t)64 * 512, 64, 512, (bf16*)(ws + WS_SMALLW + l * MiB + SW_A2), (size_t)512 * 64, 2, 0, nullptr, 0);
    }
    transpose_batch(F, a.in(I_G2), (size_t)128 * 512, 128, 512, (bf16*)(ws + WS_SMALLW + SW_G2), MiB / 2, 4, 0, nullptr, 0);
    const int gt = F.bid * NTHREADS + F.tid, NGT = F.G * NTHREADS;
    for (int i = gt; i < 4 * (DINP - DIN) * 1024 / 8; i += NGT) { const int l = i / ((DINP - DIN) * 128), r = i - l * ((DINP - DIN) * 128);
        *(u32x4*)((bf16*)(ws + WS_WIN) + (size_t)l * DINP * 1024 + (size_t)DIN * 1024 + (size_t)r * 8) = (u32x4){0u, 0u, 0u, 0u}; }
    for (int i = gt; i < 128; i += NGT) *(u32x4*)((bf16*)(ws + WS_H) + (size_t)NT * 1024 + i * 8) = (u32x4){0u, 0u, 0u, 0u};
    { float2* rt = (float2*)(ws + WS_ROPE);
      for (int i = gt; i < 4096 * 32; i += NGT) { const int pos = i >> 5, f = i & 31; const float inv = powf(10000.f, -(float)(2 * f) / 64.f); const float ang = (float)pos * inv; float s, c; sincosf(ang, &s, &c); rt[i] = make_float2(c, s); }
      float2* ax = (float2*)(ws + WS_ROPE_AX);
      for (int i = gt; i < 64 * 8; i += NGT) { const int pos = i >> 3, f = i & 7; const float inv = powf(10000.f, -(float)(2 * f) / 16.f); const float ang = (float)pos * inv; float s, c; sincosf(ang, &s, &c); ax[i] = make_float2(c, s); } }
    { LAS float* sc = (LAS float*)(F.lds);
      LAS float* red = (LAS float*)(F.lds + 65536);
      __syncthreads();
      for (int i = F.tid; i < 9 * 1024; i += NTHREADS) { const int r = i >> 10, k = i & 1023; const float v = r < 8 ? a.in(I_C)[r * 1024 + k] : a.in(I_CCTX)[k]; sc[i] = v / (1.f + __expf(-v)); }
      __syncthreads();
      float* mod = (float*)(ws + WS_MOD);
      for (int it = F.bid; it < 4 * 96; it += F.G) { const int l = it / 96, n = (it - l * 96) * 64 + F.lane;
          const float* w = a.in(I_ADAW) + (size_t)l * 1024 * 6144 + n; float acc[9];
#pragma unroll
          for (int r = 0; r < 9; ++r) acc[r] = 0.f;
          const int kb = F.wave * 128;
#pragma unroll 8
          for (int k = 0; k < 128; ++k) { const float wv = w[(size_t)(kb + k) * 6144];
#pragma unroll
              for (int r = 0; r < 9; ++r) acc[r] += sc[r * 1024 + kb + k] * wv; }
#pragma unroll
          for (int r = 0; r < 9; ++r) red[(F.wave * 9 + r) * 64 + F.lane] = acc[r];
          __syncthreads();
          for (int i = F.tid; i < 9 * 64; i += NTHREADS) { const int r = i >> 6, c = i & 63; float s = 0.f;
#pragma unroll
              for (int w8 = 0; w8 < 8; ++w8) s += red[(w8 * 9 + r) * 64 + c];
              const int nn = (it - l * 96) * 64 + c; mod[((size_t)l * 9 + r) * 6144 + nn] = s + a.in(I_ADAB)[l * 6144 + nn]; }
          __syncthreads(); } }
}

DI void norm_mod_store(const f32x4 (&v)[4], const float* gain, const float* sc, const float* sh, bf16* hrow, int lane) {
    float s = 0.f;
#pragma unroll
    for (int j = 0; j < 4; ++j) s += (v[j].x * v[j].x + v[j].y * v[j].y) + (v[j].z * v[j].z + v[j].w * v[j].w);
    const float rinv = rsqrtf(wave_sum(s) * (1.f / 1024.f) + 1e-6f);
#pragma unroll
    for (int j = 0; j < 4; ++j) { const int c = 256 * j + 4 * lane; const f32x4 g = *(const f32x4*)(gain + c), a = *(const f32x4*)(sc + c), b = *(const f32x4*)(sh + c);
        const f32x4 y = v[j] * rinv * g * (a + 1.f) + b; u32x2 o; o.x = pk2(y.x, y.y); o.y = pk2(y.z, y.w); *(u32x2*)(hrow + c) = o; }
}
DI void phase_init_rows(Frame& F, const KA& a) {
    const int gw = F.bid * NWAVES + F.wave, NGW = F.G * NWAVES;
    float* X = (float*)(F.ws + WS_X); bf16* H = (bf16*)(F.ws + WS_H); const float* mod = (const float*)(F.ws + WS_MOD);
    for (int r = gw; r < NT; r += NGW) { const int b = r / LTOT, p = r - b * LTOT;
        const float* src = p < CTX ? a.in(I_CTX) + ((size_t)b * CTX + p) * 1024 : a.in(I_X) + ((size_t)b * SEQ + (p - CTX)) * 1024;
        f32x4 v[4];
#pragma unroll
        for (int j = 0; j < 4; ++j) { v[j] = *(const f32x4*)(src + 256 * j + 4 * F.lane); *(f32x4*)(X + (size_t)r * 1024 + 256 * j + 4 * F.lane) = v[j]; }
        const float* m = mod + (size_t)(p < CTX ? 8 : b) * 6144;
        norm_mod_store(v, a.in(I_N1G), m + 1024, m, H + (size_t)r * 1024, F.lane); }
}

template <int CTRL> DI float dppf(float v) { return __int_as_float(__builtin_amdgcn_update_dpp(0, __float_as_int(v), CTRL, 0xf, 0xf, false)); }
template <int CTRL> DI int dppi(int v) { return __builtin_amdgcn_update_dpp(0, v, CTRL, 0xf, 0xf, false); }
DI void phase_router(Frame& F, const KA& a, int l) {
    LAS float* T = (LAS float*)(F.lds);
    LAS float* part = (LAS float*)(F.lds + 16 * 1028 * 4);
    LAS int* lcnt = (LAS int*)(F.lds + 16 * 1028 * 4 + 16384 + 2048);
    LAS int* gbase = lcnt + 64;
    const float* X = (const float*)(F.ws + WS_X); bf16* H = (bf16*)(F.ws + WS_H);
    const float* mod = (const float*)(F.ws + WS_MOD) + (size_t)l * 9 * 6144;
    const float* gain = a.in(I_N2G) + l * 1024; const float* wr = a.in(I_WROUTER) + (size_t)l * 1024 * 32; const float* br = a.in(I_BROUTER) + l * 32;
    int* eidx = (int*)(F.ws + WS_TOPK); float* gw = (float*)(F.ws + WS_TOPK) + (size_t)NT * 4; int* rank = (int*)(F.ws + WS_TOPK) + (size_t)NT * 8;
    int* list = (int*)(F.ws + WS_LIST); unsigned* cnt = F.ctl + CW_CNT + l * 32 * 16;
    const int lane = F.lane, w = F.wave, tid = F.tid;
    const bool lastl = l == DEPTH - 1;
    const int nit = lastl ? BATCH * SEQ / 16 : NT / 16;
    const int mi = lane & 15, mq = lane >> 4;
    float b0[32], b1[32];
    { const float* wp = wr + (size_t)(128 * w + 32 * mq) * 32 + mi;
#pragma unroll
      for (int s2 = 0; s2 < 32; ++s2) { b0[s2] = wp[s2 * 32]; b1[s2] = wp[s2 * 32 + 16]; } }
    const int row = tid >> 5, e = tid & 31; const float bre = br[e];
    f32x4 vn[2][4], scn[4], shn[4], gv[4];
#pragma unroll
    for (int j = 0; j < 4; ++j) gv[j] = *(const f32x4*)(gain + 256 * j + 4 * lane);
    int it = F.bid;
#define RT_R0(it_) (lastl ? ((it_) >> 8) * LTOT + CTX + 16 * ((it_) & 255) : (it_) * 16)
#define RT_MOD(r0_) (mod + (size_t)((((r0_) % LTOT) < CTX) ? 8 : (r0_) / LTOT) * 6144)
    if (it < nit) { const int r0 = RT_R0(it); const float* m = RT_MOD(r0);
#pragma unroll
        for (int rr = 0; rr < 2; ++rr)
#pragma unroll
            for (int j = 0; j < 4; ++j) vn[rr][j] = *(const f32x4*)(X + (size_t)(r0 + w * 2 + rr) * 1024 + 256 * j + 4 * lane);
#pragma unroll
        for (int j = 0; j < 4; ++j) { scn[j] = *(const f32x4*)(m + 4096 + 256 * j + 4 * lane); shn[j] = *(const f32x4*)(m + 3072 + 256 * j + 4 * lane); } }
    int pend_e = 0, pend_lr = 0, pend_r = -1, par = 0; float pend_g = 0.f; int gb = 0;
#pragma unroll 1
    for (; it < nit; it += F.G) {
        const int r0 = RT_R0(it);
        LDS_BARRIER();
        if (tid < 32) { if (pend_r >= 0) { const int c = lcnt[(par ^ 1) * 32 + tid]; gb = c ? (int)__hip_atomic_fetch_add(cnt + tid * 16, (unsigned)c, __ATOMIC_RELAXED, __HIP_MEMORY_SCOPE_AGENT) : 0; }
            lcnt[par * 32 + tid] = 0; }
#pragma unroll
        for (int rr = 0; rr < 2; ++rr) { const int lr = w * 2 + rr, r = r0 + lr;
            float s = 0.f;
#pragma unroll
            for (int j = 0; j < 4; ++j) { const f32x4 x = vn[rr][j]; s += (x.x * x.x + x.y * x.y) + (x.z * x.z + x.w * x.w); }
            const float rinv = rsqrtf(wave_sum(s) * (1.f / 1024.f) + 1e-6f);
#pragma unroll
            for (int j = 0; j < 4; ++j) { const int c = 256 * j + 4 * lane; const f32x4 g = gv[j], sc = scn[j], sh = shn[j];
                const f32x4 y = vn[rr][j] * rinv * g * (sc + 1.f) + sh; *(LAS f32x4*)(T + lr * 1028 + c) = y;
                u32x2 o; o.x = pk2(y.x, y.y); o.y = pk2(y.z, y.w); *(u32x2*)(H + (size_t)r * 1024 + c) = o; } }
        LDS_BARRIER();
        if (it + F.G < nit) { const int rn = RT_R0(it + F.G); const float* m = RT_MOD(rn);
#pragma unroll
            for (int rr = 0; rr < 2; ++rr)
#pragma unroll
                for (int j = 0; j < 4; ++j) vn[rr][j] = *(const f32x4*)(X + (size_t)(rn + w * 2 + rr) * 1024 + 256 * j + 4 * lane);
#pragma unroll
            for (int j = 0; j < 4; ++j) { scn[j] = *(const f32x4*)(m + 4096 + 256 * j + 4 * lane); shn[j] = *(const f32x4*)(m + 3072 + 256 * j + 4 * lane); } }
        { f32x4 acc0 = {0.f, 0.f, 0.f, 0.f}, acc1 = acc0;
          const LAS float* tp = T + mi * 1028 + 128 * w + 32 * mq;
          f32x4 a4[8];
#pragma unroll
          for (int s2 = 0; s2 < 8; ++s2) a4[s2] = *(const LAS f32x4*)(tp + 4 * s2);
#pragma unroll
          for (int s2 = 0; s2 < 32; ++s2) { const float av = a4[s2 >> 2][s2 & 3];
              acc0 = __builtin_amdgcn_mfma_f32_16x16x4f32(av, b0[s2], acc0, 0, 0, 0); acc1 = __builtin_amdgcn_mfma_f32_16x16x4f32(av, b1[s2], acc1, 0, 0, 0); }
#pragma unroll
          for (int rg = 0; rg < 4; ++rg) { part[(w * 16 + 4 * mq + rg) * 32 + mi] = acc0[rg]; part[(w * 16 + 4 * mq + rg) * 32 + 16 + mi] = acc1[rg]; } }
        if (tid < 32 && pend_r >= 0) gbase[(par ^ 1) * 32 + tid] = gb;
        LDS_BARRIER();
        { float v = bre;
#pragma unroll
          for (int w8 = 0; w8 < 8; ++w8) v += part[(w8 * 16 + row) * 32 + e];
          int te[4]; float tv[4];
#pragma unroll
          for (int k = 0; k < 4; ++k) { float bv = v; int bi = e;
#define RT_STEP(OV, OI) do { const float ov_ = (OV); const int oi_ = (OI); const bool take_ = ov_ > bv || (ov_ == bv && oi_ < bi); bv = take_ ? ov_ : bv; bi = take_ ? oi_ : bi; } while (0)
              RT_STEP(dppf<0xB1>(bv), dppi<0xB1>(bi)); RT_STEP(dppf<0x4E>(bv), dppi<0x4E>(bi)); RT_STEP(dppf<0x141>(bv), dppi<0x141>(bi)); RT_STEP(dppf<0x140>(bv), dppi<0x140>(bi));
              RT_STEP(sx(bv, 16), __float_as_int(sx(__int_as_float(bi), 16)));
              te[k] = bi; tv[k] = bv; if (e == bi) v = -3.0e38f; }
          const float mx = tv[0]; float den = 0.f;
#pragma unroll
          for (int k = 0; k < 4; ++k) { tv[k] = __expf(tv[k] - mx); den += tv[k]; }
          const float rden = 1.f / den;
          int myk_e = te[0]; float myk_g = tv[0] * rden;
#pragma unroll
          for (int k = 1; k < 4; ++k) { if (e == k) { myk_e = te[k]; myk_g = tv[k] * rden; } }
          int lr = 0;
          if (e < 4) lr = atomicAdd((int*)&lcnt[par * 32 + myk_e], 1);
          if (e < 4 && pend_r >= 0) { const int rk = gbase[(par ^ 1) * 32 + pend_e] + pend_lr; eidx[pend_r * 4 + e] = pend_e; gw[pend_r * 4 + e] = pend_g; rank[pend_r * 4 + e] = rk; list[(size_t)pend_e * NT + rk] = pend_r * 4 + e; }
          pend_e = myk_e; pend_lr = lr; pend_g = myk_g; pend_r = r0 + row; par ^= 1; }
    }
    LDS_BARRIER();
    if (pend_r >= 0) {
        if (tid < 32) { const int c = lcnt[(par ^ 1) * 32 + tid]; gbase[(par ^ 1) * 32 + tid] = c ? (int)__hip_atomic_fetch_add(cnt + tid * 16, (unsigned)c, __ATOMIC_RELAXED, __HIP_MEMORY_SCOPE_AGENT) : 0; }
        LDS_BARRIER();
        if (e < 4) { const int rk = gbase[(par ^ 1) * 32 + pend_e] + pend_lr; eidx[pend_r * 4 + e] = pend_e; gw[pend_r * 4 + e] = pend_g; rank[pend_r * 4 + e] = rk; list[(size_t)pend_e * NT + rk] = pend_r * 4 + e; }
    }
#undef RT_STEP
#undef RT_R0
#undef RT_MOD
}

DI void phase_combine(Frame& F, const KA& a, int l) {
    moe_build_table(F, F.ctl + CW_CNT + l * 32 * 16);
    const LAS int* tab = (const LAS int*)(F.lds + LDS_TAB_OFF);
    const int lane = fresh_lane();
    const int gw_ = F.bid * NWAVES + F.wave, NGW = F.G * NWAVES;
    float* X = (float*)(F.ws + WS_X); bf16* H = (bf16*)(F.ws + WS_H); const bf16* Y = (const bf16*)(F.ws + WS_Y);
    const float* mod = (const float*)(F.ws + WS_MOD) + (size_t)l * 9 * 6144;
    const int* eidx = (const int*)(F.ws + WS_TOPK); const float* gw = (const float*)(F.ws + WS_TOPK) + (size_t)NT * 4; const int* rank = (const int*)(F.ws + WS_TOPK) + (size_t)NT * 8;
#pragma unroll 1
    for (int r0 = gw_; r0 < NT; r0 += 2 * NGW) {
        int rr[2], bb[2], pp[2]; bool act[2]; size_t slot[2][4]; float gk[2][4];
#pragma unroll
        for (int u = 0; u < 2; ++u) { rr[u] = r0 + u * NGW; act[u] = rr[u] < NT; if (!act[u]) rr[u] = r0; bb[u] = rr[u] / LTOT; pp[u] = rr[u] - bb[u] * LTOT; if (l == DEPTH - 1 && pp[u] < CTX) act[u] = false;
#pragma unroll
            for (int k = 0; k < 4; ++k) { const int e = eidx[rr[u] * 4 + k]; gk[u][k] = gw[rr[u] * 4 + k]; slot[u][k] = (size_t)(tab[32 + e] + rank[rr[u] * 4 + k]); } }
        f32x4 v[2][4]; u32x2 yv[2][4][4];
#pragma unroll
        for (int u = 0; u < 2; ++u) {
#pragma unroll
            for (int j = 0; j < 4; ++j) v[u][j] = *(const f32x4*)(X + (size_t)rr[u] * 1024 + 256 * j + 4 * lane);
#pragma unroll
            for (int k = 0; k < 4; ++k)
#pragma unroll
                for (int j = 0; j < 4; ++j) yv[u][k][j] = *(const u32x2*)(Y + slot[u][k] * 1024 + 256 * j + 4 * lane); }
#pragma unroll
        for (int u = 0; u < 2; ++u) { if (!act[u]) continue;
            const int mr = pp[u] < CTX ? 8 : bb[u]; const float* g2 = mod + (size_t)mr * 6144 + 5120;
#pragma unroll
            for (int j = 0; j < 4; ++j) { f32x4 acc = {0.f, 0.f, 0.f, 0.f};
#pragma unroll
                for (int k = 0; k < 4; ++k) { const float g = gk[u][k]; const u32x2 y = yv[u][k][j]; acc.x += g * bflo(y.x); acc.y += g * bfhi(y.x); acc.z += g * bflo(y.y); acc.w += g * bfhi(y.y); }
                v[u][j] = v[u][j] + *(const f32x4*)(g2 + 256 * j + 4 * lane) * acc; }
            if (l == DEPTH - 1) {
                float* o = a.out() + ((size_t)bb[u] * SEQ + (pp[u] - CTX)) * 1024;
#pragma unroll
                for (int j = 0; j < 4; ++j) *(f32x4*)(o + 256 * j + 4 * lane) = v[u][j];
            } else {
#pragma unroll
                for (int j = 0; j < 4; ++j) *(f32x4*)(X + (size_t)rr[u] * 1024 + 256 * j + 4 * lane) = v[u][j];
                const float* m = (const float*)(F.ws + WS_MOD) + (size_t)(l + 1) * 9 * 6144 + (size_t)mr * 6144;
                norm_mod_store(v[u], a.in(I_N1G) + (l + 1) * 1024, m + 1024, m, H + (size_t)rr[u] * 1024, lane);
            } }
    }
}

DI int crow16(int i, int h) { return (i & 3) + 8 * (i >> 2) + 4 * h; }
DI int permpos(int p) { return (p & ~12) | ((p & 4) << 1) | ((p & 8) >> 1); }
constexpr int MP_P = 424;
constexpr int MP_SP = 104;
constexpr int MP_SCR = 32 * MP_P * 2;
DI void phase_mla_prep2(Frame& F, const KA& a, int l) {
    const bf16* P = (const bf16*)(F.ws + WS_P);
    const bf16* WUQ = (const bf16*)(F.ws + WS_SMALLW + (size_t)l * MiB + SW_UQ); const bf16* WUKV = (const bf16*)(F.ws + WS_SMALLW + (size_t)l * MiB + SW_UKV);
    bf16* QB = (bf16*)(F.ws + WS_QB); bf16* KB = (bf16*)(F.ws + WS_KB); bf16* VT = (bf16*)(F.ws + WS_VT);
    const float* gq = a.in(I_QKQG) + l * 96; const float* gk = a.in(I_QKKG) + l * 96;
    const float2* ax = (const float2*)(F.ws + WS_ROPE_AX);
    LAS bf16* T = (LAS bf16*)F.lds;
    u32x4 pre[4];
#define MP_PREFETCH(it_) do { const int tq_ = F.wave * 64 + fresh_lane(); _Pragma("unroll") for (int j_ = 0; j_ < 4; ++j_) { const int q_ = tq_ + NTHREADS * j_; if (q_ < 32 * 52) { const int row_ = q_ / 52, pc_ = q_ - row_ * 52; \
            pre[j_] = *(const u32x4*)(P + (size_t)((it_) * 32 + row_) * DINP + PC_MQ + 8 * pc_); } } } while (0)
    if (F.bid < NT / 32) MP_PREFETCH(F.bid);
#pragma unroll 1
    for (int it = F.bid; it < NT / 32; it += F.G) {
        const int lane = fresh_lane(); int w = F.wave; asm volatile("" : "+s"(w)); const int tid = w * 64 + lane;
        const int r0 = it * 32, b = r0 / LTOT, p0 = r0 - b * LTOT;
        LDS_BARRIER();
#pragma unroll
        for (int j = 0; j < 4; ++j) { const int q = tid + NTHREADS * j; if (q < 32 * 52) { const int row = q / 52, pc = q - row * 52; *(LAS u32x4*)(T + row * MP_P + 8 * pc) = pre[j]; } }
        LDS_BARRIER();
        const int hd = w, tok = lane & 31, h = lane >> 5, p = p0 + tok; const bool lat = p >= CTX; const int sl = p - CTX;
        const LAS bf16* trow = T + tok * MP_P;
        LAS bf16* scr = (LAS bf16*)(F.lds + MP_SCR + w * 6656);
        const size_t bhbase = (size_t)(b * 8 + hd) * LTOT + p0;
        { bf16x8 cq[16]; float ssq = 0.f;
#pragma unroll
          for (int s2 = 0; s2 < 16; ++s2) { const u32x4 x = *(const LAS u32x4*)(trow + 16 * s2 + 8 * h); cq[s2] = __builtin_bit_cast(bf16x8, x);
              ssq += bflo(x.x) * bflo(x.x) + bfhi(x.x) * bfhi(x.x) + bflo(x.y) * bflo(x.y) + bfhi(x.y) * bfhi(x.y) + bflo(x.z) * bflo(x.z) + bfhi(x.z) * bfhi(x.z) + bflo(x.w) * bflo(x.w) + bfhi(x.w) * bfhi(x.w); }
          ssq += sx(ssq, 32);
          const float rinq = rsqrtf(ssq * (1.f / 256.f) + 1e-6f);
          float2 cr[4], cc[4];
#pragma unroll
          for (int f = 0; f < 4; ++f) { cr[f] = lat ? ax[(sl >> 6) * 8 + 4 * h + f] : make_float2(1.f, 0.f); cc[f] = lat ? ax[(sl & 63) * 8 + 4 * h + f] : make_float2(1.f, 0.f); }
          f32x16 acc[3];
#pragma unroll
          for (int cb = 0; cb < 3; ++cb) { f32x16 z = zero16(); const bf16* wrow = WUQ + (size_t)(hd * 96 + cb * 32 + tok) * 256 + 8 * h;
              bf16x8 wf[16];
#pragma unroll
              for (int s2 = 0; s2 < 16; ++s2) wf[s2] = *(const bf16x8*)(wrow + 16 * s2);
              __builtin_amdgcn_sched_barrier(0);
#pragma unroll
              for (int s2 = 0; s2 < 16; ++s2) z = __builtin_amdgcn_mfma_f32_32x32x16_bf16(wf[s2], cq[s2], z, 0, 0, 0);
              __builtin_amdgcn_sched_barrier(0);
              acc[cb] = z; }
          float ss = 0.f;
#pragma unroll
          for (int cb = 0; cb < 3; ++cb)
#pragma unroll
              for (int i = 0; i < 16; ++i) { acc[cb][i] *= rinq; ss += acc[cb][i] * acc[cb][i]; }
          ss += sx(ss, 32);
          const float rq = rsqrtf(ss * (1.f / 96.f) + 1e-6f);
#pragma unroll
          for (int cb = 0; cb < 3; ++cb)
#pragma unroll
              for (int i = 0; i < 16; ++i) acc[cb][i] *= rq * gq[cb * 32 + crow16(i, h)];
#pragma unroll
          for (int i = 0; i < 4; ++i) { const float2 c1 = cr[i]; const float x1 = acc[2][i], x2 = acc[2][i + 4]; acc[2][i] = x1 * c1.x - x2 * c1.y; acc[2][i + 4] = x1 * c1.y + x2 * c1.x;
              const float2 c2 = cc[i]; const float y1 = acc[2][8 + i], y2 = acc[2][12 + i]; acc[2][8 + i] = y1 * c2.x - y2 * c2.y; acc[2][12 + i] = y1 * c2.y + y2 * c2.x; }
#pragma unroll
          for (int cb = 0; cb < 3; ++cb)
#pragma unroll
              for (int g = 0; g < 4; ++g) { u32x2 o; o.x = pk2(acc[cb][4 * g], acc[cb][4 * g + 1]); o.y = pk2(acc[cb][4 * g + 2], acc[cb][4 * g + 3]); *(LAS u32x2*)(scr + tok * MP_SP + cb * 32 + 8 * g + 4 * h) = o; }
          LDS_WAIT();
#pragma unroll
          for (int i = 0; i < 6; ++i) { const int q = lane + 64 * i, row = q / 12, pc = q - row * 12; *(u32x4*)(QB + (bhbase + row) * 96 + 8 * pc) = *(const LAS u32x4*)(scr + row * MP_SP + 8 * pc); }
          LDS_WAIT(); }
        { bf16x8 ckv[8]; float ssk = 0.f;
#pragma unroll
          for (int s2 = 0; s2 < 8; ++s2) { const u32x4 x = *(const LAS u32x4*)(trow + 256 + 16 * s2 + 8 * h); ckv[s2] = __builtin_bit_cast(bf16x8, x);
              ssk += bflo(x.x) * bflo(x.x) + bfhi(x.x) * bfhi(x.x) + bflo(x.y) * bflo(x.y) + bfhi(x.y) * bfhi(x.y) + bflo(x.z) * bflo(x.z) + bfhi(x.z) * bfhi(x.z) + bflo(x.w) * bflo(x.w) + bfhi(x.w) * bfhi(x.w); }
          ssk += sx(ssk, 32);
          const float rinkv = rsqrtf(ssk * (1.f / 128.f) + 1e-6f);
          float pe1[8], pe2[8]; float sspe = 0.f;
          { const u32x4 w0 = *(const LAS u32x4*)(trow + 384 + 16 * h), w1 = *(const LAS u32x4*)(trow + 384 + 16 * h + 8);
            unpack8(w0, pe1); unpack8(w1, pe2);
#pragma unroll
            for (int j = 0; j < 8; ++j) sspe += pe1[j] * pe1[j] + pe2[j] * pe2[j];
            sspe += sx(sspe, 32); }
          float2 cs[8];
#pragma unroll
          for (int f = 0; f < 8; ++f) cs[f] = lat ? ax[(h ? (sl & 63) : (sl >> 6)) * 8 + f] : make_float2(1.f, 0.f);
          f32x16 acc[4];
#pragma unroll
          for (int cb = 0; cb < 4; cb += 2) { f32x16 z0 = zero16(), z1 = zero16(); const bf16* wrow = WUKV + (size_t)(hd * 128 + cb * 32 + tok) * 128 + 8 * h;
              bf16x8 wf0[8], wf1[8];
#pragma unroll
              for (int s2 = 0; s2 < 8; ++s2) { wf0[s2] = *(const bf16x8*)(wrow + 16 * s2); wf1[s2] = *(const bf16x8*)(wrow + 32 * 128 + 16 * s2); }
              __builtin_amdgcn_sched_barrier(0);
#pragma unroll
              for (int s2 = 0; s2 < 8; ++s2) { z0 = __builtin_amdgcn_mfma_f32_32x32x16_bf16(wf0[s2], ckv[s2], z0, 0, 0, 0); z1 = __builtin_amdgcn_mfma_f32_32x32x16_bf16(wf1[s2], ckv[s2], z1, 0, 0, 0); }
              __builtin_amdgcn_sched_barrier(0);
              acc[cb] = z0; acc[cb + 1] = z1; }
          if (it + F.G < NT / 32) MP_PREFETCH(it + F.G);
          float ss = 0.f;
#pragma unroll
          for (int cb = 0; cb < 4; ++cb)
#pragma unroll
              for (int i = 0; i < 16; ++i) { acc[cb][i] *= rinkv; if (cb < 2) ss += acc[cb][i] * acc[cb][i]; }
          ss += sx(ss, 32);
          const float rk = rsqrtf((ss + sspe) * (1.f / 96.f) + 1e-6f);
#pragma unroll
          for (int cb = 0; cb < 2; ++cb)
#pragma unroll
              for (int g = 0; g < 4; ++g) { float o4[4];
#pragma unroll
                  for (int j = 0; j < 4; ++j) o4[j] = acc[cb][4 * g + j] * rk * gk[cb * 32 + 8 * g + 4 * h + j];
                  u32x2 o; o.x = pk2(o4[0], o4[1]); o.y = pk2(o4[2], o4[3]); *(LAS u32x2*)(scr + tok * MP_SP + cb * 32 + 8 * g + 4 * h) = o; }
          { float pe[16];
#pragma unroll
            for (int f = 0; f < 8; ++f) { const float x1 = pe1[f] * rk * gk[64 + 16 * h + f], x2 = pe2[f] * rk * gk[64 + 16 * h + 8 + f];
                pe[f] = x1 * cs[f].x - x2 * cs[f].y; pe[8 + f] = x1 * cs[f].y + x2 * cs[f].x; }
            *(LAS bf16x8*)(scr + tok * MP_SP + 64 + 16 * h) = pack8(pe); *(LAS bf16x8*)(scr + tok * MP_SP + 64 + 16 * h + 8) = pack8(pe + 8); }
          LDS_WAIT();
#pragma unroll
          for (int i = 0; i < 6; ++i) { const int q = lane + 64 * i, row = q / 12, pc = q - row * 12; *(u32x4*)(KB + (bhbase + row) * 96 + 8 * pc) = *(const LAS u32x4*)(scr + row * MP_SP + 8 * pc); }
          LDS_WAIT();
          { const int pt = permpos(tok);
#pragma unroll
            for (int cb = 2; cb < 4; ++cb)
#pragma unroll
                for (int i = 0; i < 16; ++i) scr[((cb - 2) * 32 + crow16(i, h)) * 40 + pt] = f2bf(acc[cb][i]);
            LDS_WAIT();
            bf16* vt = VT + (size_t)(b * 8 + hd) * 64 * LTOT + p0;
#pragma unroll
            for (int i = 0; i < 4; ++i) { const int q = lane + 64 * i, d = q >> 2, pc = q & 3; *(u32x4*)(vt + (size_t)d * LTOT + 8 * pc) = *(const LAS u32x4*)(scr + d * 40 + 8 * pc); }
            LDS_WAIT(); } }
    }
}
#undef MP_PREFETCH

constexpr int ATT_KP = 104, ATT_VP = 72;
constexpr int ATT_KBYTES = 64 * ATT_KP * 2, ATT_VBYTES = 64 * ATT_VP * 2;
DI void attn_unit(Frame& F, int b, int hd, int qblk) {
    const bf16* QB = (const bf16*)(F.ws + WS_QB); const bf16* KB = (const bf16*)(F.ws + WS_KB); const bf16* VT = (const bf16*)(F.ws + WS_VT);
    bf16* O = (bf16*)(F.ws + WS_ABR) + (size_t)NT * 512;
    const int q0 = qblk == 0 ? 0 : CTX + 256 * (qblk - 1), ntiles = qblk == 0 ? CTX / 64 : LTOT / 64;
    const int lane = fresh_lane(), ql = lane & 31, h = lane >> 5, w = F.wave, tid = w * 64 + lane;
    const size_t bh = (size_t)(b * 8 + hd);
    LAS bf16* Kt = (LAS bf16*)(F.lds); LAS bf16* Vt = (LAS bf16*)(F.lds + 2 * ATT_KBYTES);
    bf16x8 qf[6];
    { const bf16* qrow = QB + (bh * LTOT + q0 + 32 * w + ql) * 96 + 8 * h;
#pragma unroll
      for (int s = 0; s < 6; ++s) qf[s] = *(const bf16x8*)(qrow + 16 * s); }
    const bf16* kbase = KB + bh * LTOT * 96; const bf16* vbase = VT + bh * 64 * LTOT;
    const int k1 = tid / 12, c1 = tid - k1 * 12, k2 = (512 + tid) / 12, c2 = (512 + tid) - k2 * 12, vd = tid >> 3, vc = tid & 7;
    u32x4 rk1, rk2 = {0u, 0u, 0u, 0u}, rv;
    rk1 = *(const u32x4*)(kbase + (size_t)k1 * 96 + 8 * c1); if (tid < 256) rk2 = *(const u32x4*)(kbase + (size_t)k2 * 96 + 8 * c2); rv = *(const u32x4*)(vbase + (size_t)vd * LTOT + 8 * vc);
    __syncthreads();
    *(LAS u32x4*)(Kt + k1 * ATT_KP + 8 * c1) = rk1; if (tid < 256) *(LAS u32x4*)(Kt + k2 * ATT_KP + 8 * c2) = rk2; *(LAS u32x4*)(Vt + vd * ATT_VP + 8 * vc) = rv;
    __syncthreads();
    float m = -1.0e30f, lsum = 0.f; f32x16 o0, o1;
#pragma unroll
    for (int i = 0; i < 16; ++i) { o0[i] = 0.f; o1[i] = 0.f; }
    const float sc = 0.10206207261596577f * 1.4426950408889634f;
    for (int t = 0; t < ntiles; ++t) {
        const int buf = t & 1; const bool more = t + 1 < ntiles;
        if (more) { const size_t ko = (size_t)(t + 1) * 64; rk1 = *(const u32x4*)(kbase + (ko + k1) * 96 + 8 * c1); if (tid < 256) rk2 = *(const u32x4*)(kbase + (ko + k2) * 96 + 8 * c2); rv = *(const u32x4*)(vbase + (size_t)vd * LTOT + ko + 8 * vc); }
        const LAS bf16* kt = Kt + buf * (64 * ATT_KP); const LAS bf16* vt = Vt + buf * (64 * ATT_VP);
        f32x16 s0, s1;
#pragma unroll
        for (int i = 0; i < 16; ++i) { s0[i] = 0.f; s1[i] = 0.f; }
        bf16x8 kf0[6], kf1[6];
#pragma unroll
        for (int s = 0; s < 6; ++s) { kf0[s] = *(const LAS bf16x8*)(kt + ql * ATT_KP + 16 * s + 8 * h); kf1[s] = *(const LAS bf16x8*)(kt + (32 + ql) * ATT_KP + 16 * s + 8 * h); }
        __builtin_amdgcn_sched_barrier(0);
#pragma unroll
        for (int s = 0; s < 6; ++s) { s0 = __builtin_amdgcn_mfma_f32_32x32x16_bf16(kf0[s], qf[s], s0, 0, 0, 0); s1 = __builtin_amdgcn_mfma_f32_32x32x16_bf16(kf1[s], qf[s], s1, 0, 0, 0); }
        bf16x8 vf0[4], vf1[4];
#pragma unroll
        for (int ks = 0; ks < 4; ++ks) { vf0[ks] = *(const LAS bf16x8*)(vt + ql * ATT_VP + 16 * ks + 8 * h); vf1[ks] = *(const LAS bf16x8*)(vt + (32 + ql) * ATT_VP + 16 * ks + 8 * h); }
        __builtin_amdgcn_sched_barrier(0);
        float mr = -1.0e30f;
#pragma unroll
        for (int i = 0; i < 16; ++i) mr = fmaxf(mr, fmaxf(s0[i], s1[i]));
        mr = fmaxf(mr, sx(mr, 32));
        const float mn = fmaxf(m, mr * sc), alpha = __builtin_amdgcn_exp2f(m - mn); m = mn;
        float rs = 0.f;
#pragma unroll
        for (int i = 0; i < 16; ++i) { s0[i] = __builtin_amdgcn_exp2f(__builtin_fmaf(s0[i], sc, -mn)); s1[i] = __builtin_amdgcn_exp2f(__builtin_fmaf(s1[i], sc, -mn)); rs += s0[i] + s1[i]; }
        lsum = lsum * alpha + rs;
#pragma unroll
        for (int i = 0; i < 16; ++i) { o0[i] *= alpha; o1[i] *= alpha; }
        bf16x8 pf[4];
        { u32x4 x;
          x.x = pk2(s0[0], s0[1]); x.y = pk2(s0[2], s0[3]); x.z = pk2(s0[4], s0[5]); x.w = pk2(s0[6], s0[7]); pf[0] = __builtin_bit_cast(bf16x8, x);
          x.x = pk2(s0[8], s0[9]); x.y = pk2(s0[10], s0[11]); x.z = pk2(s0[12], s0[13]); x.w = pk2(s0[14], s0[15]); pf[1] = __builtin_bit_cast(bf16x8, x);
          x.x = pk2(s1[0], s1[1]); x.y = pk2(s1[2], s1[3]); x.z = pk2(s1[4], s1[5]); x.w = pk2(s1[6], s1[7]); pf[2] = __builtin_bit_cast(bf16x8, x);
          x.x = pk2(s1[8], s1[9]); x.y = pk2(s1[10], s1[11]); x.z = pk2(s1[12], s1[13]); x.w = pk2(s1[14], s1[15]); pf[3] = __builtin_bit_cast(bf16x8, x); }
        __builtin_amdgcn_sched_barrier(0);
#pragma unroll
        for (int ks = 0; ks < 4; ++ks) { o0 = __builtin_amdgcn_mfma_f32_32x32x16_bf16(vf0[ks], pf[ks], o0, 0, 0, 0); o1 = __builtin_amdgcn_mfma_f32_32x32x16_bf16(vf1[ks], pf[ks], o1, 0, 0, 0); }
        if (more) { const int nb = buf ^ 1; LAS bf16* kn = Kt + nb * (64 * ATT_KP); LAS bf16* vn = Vt + nb * (64 * ATT_VP);
            *(LAS u32x4*)(kn + k1 * ATT_KP + 8 * c1) = rk1; if (tid < 256) *(LAS u32x4*)(kn + k2 * ATT_KP + 8 * c2) = rk2; *(LAS u32x4*)(vn + vd * ATT_VP + 8 * vc) = rv; }
        __syncthreads();
    }
    lsum += sx(lsum, 32);
    const float inv = 1.f / lsum;
    bf16* orow = O + ((size_t)b * LTOT + q0 + 32 * w + ql) * 512 + hd * 64 + 4 * h;
#pragma unroll
    for (int g = 0; g < 4; ++g) { u32x2 x; x.x = pk2(o0[4 * g] * inv, o0[4 * g + 1] * inv); x.y = pk2(o0[4 * g + 2] * inv, o0[4 * g + 3] * inv); *(u32x2*)(orow + 8 * g) = x;
        x.x = pk2(o1[4 * g] * inv, o1[4 * g + 1] * inv); x.y = pk2(o1[4 * g + 2] * inv, o1[4 * g + 3] * inv); *(u32x2*)(orow + 32 + 8 * g) = x; }
}

DI void shift_n(const bf16* prow, bool first, bool last, int col, const float* mup, const float* mun, float* out, int n  ) {
    const bf16* pp = first ? prow : prow - DINP; const bf16* pn = last ? prow : prow + DINP; const float fm = first ? 0.f : 1.f, lm = last ? 0.f : 1.f;
    if (n == 8) {
        const u32x4 c = *(const u32x4*)(prow + col), pv = *(const u32x4*)(pp + col), nx = *(const u32x4*)(pn + col);
        const f32x4 mp0 = *(const f32x4*)(mup + col - PC_RW), mp1 = *(const f32x4*)(mup + col - PC_RW + 4), mn0 = *(const f32x4*)(mun + col - PC_RW), mn1 = *(const f32x4*)(mun + col - PC_RW + 4);
        const unsigned cw[4] = {c.x, c.y, c.z, c.w}, pw[4] = {pv.x, pv.y, pv.z, pv.w}, nw[4] = {nx.x, nx.y, nx.z, nx.w};
        const float mp[8] = {mp0.x, mp0.y, mp0.z, mp0.w, mp1.x, mp1.y, mp1.z, mp1.w}, mn[8] = {mn0.x, mn0.y, mn0.z, mn0.w, mn1.x, mn1.y, mn1.z, mn1.w};
#pragma unroll
        for (int j = 0; j < 4; ++j) { const float t0 = bflo(cw[j]), t1 = bfhi(cw[j]);
            out[2 * j] = t0 + mp[2 * j] * (fm * bflo(pw[j]) - t0) + mn[2 * j] * (lm * bflo(nw[j]) - t0);
            out[2 * j + 1] = t1 + mp[2 * j + 1] * (fm * bfhi(pw[j]) - t1) + mn[2 * j + 1] * (lm * bfhi(nw[j]) - t1); }
    } else {
        const u32x2 c = *(const u32x2*)(prow + col), pv = *(const u32x2*)(pp + col), nx = *(const u32x2*)(pn + col);
        const f32x4 mp0 = *(const f32x4*)(mup + col - PC_RW), mn0 = *(const f32x4*)(mun + col - PC_RW);
        const unsigned cw[2] = {c.x, c.y}, pw[2] = {pv.x, pv.y}, nw[2] = {nx.x, nx.y};
        const float mp[4] = {mp0.x, mp0.y, mp0.z, mp0.w}, mn[4] = {mn0.x, mn0.y, mn0.z, mn0.w};
#pragma unroll
        for (int j = 0; j < 2; ++j) { const float t0 = bflo(cw[j]), t1 = bfhi(cw[j]);
            out[2 * j] = t0 + mp[2 * j] * (fm * bflo(pw[j]) - t0) + mn[2 * j] * (lm * bflo(nw[j]) - t0);
            out[2 * j + 1] = t1 + mp[2 * j + 1] * (fm * bfhi(pw[j]) - t1) + mn[2 * j + 1] * (lm * bfhi(nw[j]) - t1); }
    }
}
constexpr int RP_P = 1928;
DI void phase_rwkv_prep2(Frame& F, const KA& a, int l) {
    const bf16* P = (const bf16*)(F.ws + WS_P);
    const bf16* W2T = (const bf16*)(F.ws + WS_SMALLW + (size_t)l * MiB + SW_W2); const bf16* A2T = (const bf16*)(F.ws + WS_SMALLW + (size_t)l * MiB + SW_A2); const bf16* G2T = (const bf16*)(F.ws + WS_SMALLW + (size_t)l * MiB + SW_G2);
    const float* mup = a.in(I_MUP) + l * 1920; const float* mun = a.in(I_MUN) + l * 1920;
    const float* w0 = a.in(I_W0) + l * 1024; const float* a0 = a.in(I_A0) + l * 1024; const float* kkw = a.in(I_KK) + l * 512; const float* kaw = a.in(I_KA) + l * 512;
    bf16* RW = (bf16*)(F.ws + WS_RW); float* LW = (float*)(F.ws + WS_LW);
    const size_t TS = (size_t)NT * 512;
    LAS bf16* T = (LAS bf16*)F.lds;
#pragma unroll 1
    for (int it = (F.bid + 64) % F.G; it < NT / 32; it += F.G) {
        const int lane = fresh_lane(); int w = F.wave; asm volatile("" : "+s"(w)); const int tid = w * 64 + lane;
        const int r0 = it * 32;
        __syncthreads();
        if (tid < 480) { const int pc = tid % 240, rh = tid / 240, row0 = rh * 16, col = PC_RW + 8 * pc;
            const int ra = r0 + row0, ba = ra / LTOT, pa = ra - ba * LTOT;
            u32x4 rowv[18];
#pragma unroll
            for (int j = 0; j < 18; ++j) { const int p = pa - 1 + j; const bool valid = (p >= 0) && (p < LTOT) && ((p < CTX) == (pa < CTX));
                const int pcl = valid ? p : pa; rowv[j] = *(const u32x4*)(P + ((size_t)ba * LTOT + pcl) * DINP + col); if (!valid) rowv[j] = (u32x4){0u, 0u, 0u, 0u}; }
            const f32x4 mp0 = *(const f32x4*)(mup + 8 * pc), mp1 = *(const f32x4*)(mup + 8 * pc + 4), mn0 = *(const f32x4*)(mun + 8 * pc), mn1 = *(const f32x4*)(mun + 8 * pc + 4);
            const float mp[8] = {mp0.x, mp0.y, mp0.z, mp0.w, mp1.x, mp1.y, mp1.z, mp1.w}, mn[8] = {mn0.x, mn0.y, mn0.z, mn0.w, mn1.x, mn1.y, mn1.z, mn1.w};
#pragma unroll
            for (int j = 0; j < 16; ++j) { float pv[8], cv[8], nv[8], v[8]; unpack8(rowv[j], pv); unpack8(rowv[j + 1], cv); unpack8(rowv[j + 2], nv);
#pragma unroll
                for (int e = 0; e < 8; ++e) v[e] = cv[e] + mp[e] * (pv[e] - cv[e]) + mn[e] * (nv[e] - cv[e]);
                if (pc >= 192 && pc < 208) {
#pragma unroll
                    for (int e = 0; e < 8; ++e) v[e] = 2.f * sigmoidf_(2.f * v[e]) - 1.f; }
                else if (pc >= 224) {
#pragma unroll
                    for (int e = 0; e < 8; ++e) v[e] = sigmoidf_(v[e]); }
                *(LAS bf16x8*)(T + (row0 + j) * RP_P + 8 * pc) = pack8(v); } }
        __syncthreads();
        const int hd = w, tok = lane & 31, h = lane >> 5;
        const LAS bf16* trow = T + tok * RP_P;
#define RP_OUT(c0, dst) do { _Pragma("unroll") for (int i_ = 0; i_ < 4; ++i_) { const int row_ = 8 * i_ + (lane >> 3), pc_ = lane & 7; \
            *(u32x4*)((dst) + (size_t)(r0 + row_) * 512 + hd * 64 + 8 * pc_) = *(const LAS u32x4*)(T + row_ * RP_P + (c0) + 8 * pc_); } } while (0)
        bf16x8 wa[2][8], wg[16], wl[2][8];
#define RP_LDW_A(d_) do { _Pragma("unroll") for (int cb_ = 0; cb_ < 2; ++cb_) _Pragma("unroll") for (int s_ = 0; s_ < 4; ++s_) wa[d_][cb_ * 4 + s_] = *(const bf16x8*)(A2T + (size_t)((d_) * 512 + hd * 64 + cb_ * 32 + tok) * 64 + 16 * s_ + 8 * h); } while (0)
#define RP_LDW_L(d_) do { _Pragma("unroll") for (int cb_ = 0; cb_ < 2; ++cb_) _Pragma("unroll") for (int s_ = 0; s_ < 4; ++s_) wl[d_][cb_ * 4 + s_] = *(const bf16x8*)(W2T + (size_t)((d_) * 512 + hd * 64 + cb_ * 32 + tok) * 64 + 16 * s_ + 8 * h); } while (0)
#define RP_LDW_G() do { _Pragma("unroll") for (int cb_ = 0; cb_ < 2; ++cb_) _Pragma("unroll") for (int s_ = 0; s_ < 8; ++s_) wg[cb_ * 8 + s_] = *(const bf16x8*)(G2T + (size_t)(hd * 64 + cb_ * 32 + tok) * 128 + 16 * s_ + 8 * h); } while (0)
        RP_LDW_A(0);
        RP_OUT(hd * 64, RW); RP_OUT(1024 + hd * 64, RW + 3 * TS);
        float kraw[2][16]; float ss = 0.f;
#pragma unroll
        for (int cb = 0; cb < 2; ++cb)
#pragma unroll
            for (int g = 0; g < 4; ++g) { const int ch = hd * 64 + cb * 32 + 8 * g + 4 * h; const u32x2 kw = *(const LAS u32x2*)(trow + 512 + ch);
                kraw[cb][4 * g] = bflo(kw.x); kraw[cb][4 * g + 1] = bfhi(kw.x); kraw[cb][4 * g + 2] = bflo(kw.y); kraw[cb][4 * g + 3] = bfhi(kw.y);
                const f32x4 kk4 = *(const f32x4*)(kkw + ch);
                ss += kraw[cb][4 * g] * kk4.x * kraw[cb][4 * g] * kk4.x + kraw[cb][4 * g + 1] * kk4.y * kraw[cb][4 * g + 1] * kk4.y + kraw[cb][4 * g + 2] * kk4.z * kraw[cb][4 * g + 2] * kk4.z + kraw[cb][4 * g + 3] * kk4.w * kraw[cb][4 * g + 3] * kk4.w; }
        ss += sx(ss, 32);
        const float rkk = rsqrtf(fmaxf(ss, 1e-24f));
        LDS_WAIT();
        LAS bf16* scr3[3] = {T + hd * 64, T + 1024 + hd * 64, T + 512 + hd * 64};
#define RP_TILE_OUT(vals  , dst, NN) do { LAS bf16* scr = scr3[(NN) % 3]; const int sc0_ = ((NN) % 3 == 0 ? 0 : (NN) % 3 == 1 ? 1024 : 512) + hd * 64; _Pragma("unroll") for (int cb_ = 0; cb_ < 2; ++cb_) _Pragma("unroll") for (int g_ = 0; g_ < 4; ++g_) { u32x2 x_; x_[0] = pk2(vals[cb_][4 * g_], vals[cb_][4 * g_ + 1]); x_[1] = pk2(vals[cb_][4 * g_ + 2], vals[cb_][4 * g_ + 3]); \
            *(LAS u32x2*)(scr + tok * RP_P + cb_ * 32 + 8 * g_ + 4 * h) = x_; } LDS_WAIT(); RP_OUT(sc0_, dst); } while (0)
        { float av[2][16], o[2][16];
#pragma unroll
          for (int d = 0; d < 2; ++d) {
              if (d == 0) RP_LDW_A(1); else RP_LDW_G();
#pragma unroll
              for (int cb = 0; cb < 2; ++cb) { f32x16 c = zero16();
                  bf16x8 xf[4];
#pragma unroll
                  for (int s2 = 0; s2 < 4; ++s2) xf[s2] = *(const LAS bf16x8*)(trow + 1664 + 64 * d + 16 * s2 + 8 * h);
                  __builtin_amdgcn_sched_barrier(0);
#pragma unroll
                  for (int s2 = 0; s2 < 4; ++s2) c = __builtin_amdgcn_mfma_f32_32x32x16_bf16(wa[d][cb * 4 + s2], xf[s2], c, 0, 0, 0);
#pragma unroll
                  for (int g = 0; g < 4; ++g) { const f32x4 a4 = *(const f32x4*)(a0 + d * 512 + hd * 64 + cb * 32 + 8 * g + 4 * h);
                      av[cb][4 * g] = sigmoidf_(a4.x + c[4 * g]); av[cb][4 * g + 1] = sigmoidf_(a4.y + c[4 * g + 1]); av[cb][4 * g + 2] = sigmoidf_(a4.z + c[4 * g + 2]); av[cb][4 * g + 3] = sigmoidf_(a4.w + c[4 * g + 3]); } }
              RP_TILE_OUT(av, RW + (size_t)(5 + d) * TS, 2 * d);
#pragma unroll
              for (int cb = 0; cb < 2; ++cb)
#pragma unroll
                  for (int g = 0; g < 4; ++g) { const f32x4 ka4 = *(const f32x4*)(kaw + hd * 64 + cb * 32 + 8 * g + 4 * h);
                      o[cb][4 * g] = kraw[cb][4 * g] * (1.f + (av[cb][4 * g] - 1.f) * ka4.x); o[cb][4 * g + 1] = kraw[cb][4 * g + 1] * (1.f + (av[cb][4 * g + 1] - 1.f) * ka4.y);
                      o[cb][4 * g + 2] = kraw[cb][4 * g + 2] * (1.f + (av[cb][4 * g + 2] - 1.f) * ka4.z); o[cb][4 * g + 3] = kraw[cb][4 * g + 3] * (1.f + (av[cb][4 * g + 3] - 1.f) * ka4.w); }
              RP_TILE_OUT(o, RW + (size_t)(1 + d) * TS, 2 * d + 1); }
#pragma unroll
          for (int cb = 0; cb < 2; ++cb)
#pragma unroll
              for (int g = 0; g < 4; ++g) { const f32x4 kk4 = *(const f32x4*)(kkw + hd * 64 + cb * 32 + 8 * g + 4 * h);
                  o[cb][4 * g] = kraw[cb][4 * g] * kk4.x * rkk; o[cb][4 * g + 1] = kraw[cb][4 * g + 1] * kk4.y * rkk; o[cb][4 * g + 2] = kraw[cb][4 * g + 2] * kk4.z * rkk; o[cb][4 * g + 3] = kraw[cb][4 * g + 3] * kk4.w * rkk; }
          RP_TILE_OUT(o, RW + 4 * TS, 4); }
        { float o[2][16];
#pragma unroll
          for (int cb = 0; cb < 2; ++cb) { f32x16 c = zero16();
              if (cb == 0) RP_LDW_L(0);
              bf16x8 xf[8];
#pragma unroll
              for (int s2 = 0; s2 < 8; ++s2) xf[s2] = *(const LAS bf16x8*)(trow + 1792 + 16 * s2 + 8 * h);
              __builtin_amdgcn_sched_barrier(0);
#pragma unroll
              for (int s2 = 0; s2 < 8; ++s2) c = __builtin_amdgcn_mfma_f32_32x32x16_bf16(wg[cb * 8 + s2], xf[s2], c, 0, 0, 0);
#pragma unroll
              for (int i = 0; i < 16; ++i) o[cb][i] = c[i]; }
          RP_TILE_OUT(o, RW + 7 * TS, 5); }
#pragma unroll
        for (int d = 0; d < 2; ++d)
#pragma unroll
            for (int cb = 0; cb < 2; ++cb) { f32x16 c = zero16();
                if (d == 0 && cb == 0) RP_LDW_L(1);
                bf16x8 xf[4];
#pragma unroll
                for (int s2 = 0; s2 < 4; ++s2) xf[s2] = *(const LAS bf16x8*)(trow + 1536 + 64 * d + 16 * s2 + 8 * h);
                __builtin_amdgcn_sched_barrier(0);
#pragma unroll
                for (int s2 = 0; s2 < 4; ++s2) c = __builtin_amdgcn_mfma_f32_32x32x16_bf16(wl[d][cb * 4 + s2], xf[s2], c, 0, 0, 0);
                LAS float* fs = (LAS float*)scr3[(6 + 2 * d + cb) % 3];
#pragma unroll
                for (int g = 0; g < 4; ++g) { const f32x4 w4 = *(const f32x4*)(w0 + d * 512 + hd * 64 + cb * 32 + 8 * g + 4 * h);
                    *(LAS f32x4*)(fs + tok * (RP_P / 2) + 8 * g + 4 * h) = (f32x4){-0.6065306597f * sigmoidf_(w4.x + c[4 * g]), -0.6065306597f * sigmoidf_(w4.y + c[4 * g + 1]), -0.6065306597f * sigmoidf_(w4.z + c[4 * g + 2]), -0.6065306597f * sigmoidf_(w4.w + c[4 * g + 3])}; }
                LDS_WAIT();
#pragma unroll
                for (int i_ = 0; i_ < 4; ++i_) { const int row_ = 8 * i_ + (lane >> 3), pc_ = lane & 7;
                    *(f32x4*)(LW + (size_t)d * TS + (size_t)(r0 + row_) * 512 + hd * 64 + cb * 32 + 4 * pc_) = *(const LAS f32x4*)(fs + row_ * (RP_P / 2) + 4 * pc_); } }
        LDS_WAIT();
#undef RP_OUT
#undef RP_TILE_OUT
#undef RP_LDW_A
#undef RP_LDW_L
#undef RP_LDW_G
    }
}

constexpr int NCHUNK = LTOT / 64;
constexpr int NCHAIN = BATCH * 8 * 2;
constexpr int RC_P = 72;
constexpr int RC_TILE = 64 * RC_P * 2;
constexpr int RC_LTF = 13 * RC_TILE, RC_EC = RC_LTF + 64 * 65 * 4;
DI int chain_pos(int dir, int n) { return dir == 0 ? n : (n < CTX ? CTX - 1 - n : LTOT - 1 - (n - CTX)); }
DI f32x16 mm_blk(const LAS bf16* A, int mb, const LAS bf16* Bt, int nb, int k0, int ksteps, int lane, f32x16 acc) {
    const int r = lane & 31, h = lane >> 5;
    bf16x8 fa[4], fb[4];
#pragma unroll
    for (int q = 0; q < 4; ++q) if (q < ksteps) { fa[q] = *(const LAS bf16x8*)(A + (mb * 32 + r) * RC_P + k0 + 16 * q + 8 * h); fb[q] = *(const LAS bf16x8*)(Bt + (nb * 32 + r) * RC_P + k0 + 16 * q + 8 * h); }
    __builtin_amdgcn_sched_barrier(0);
#pragma unroll
    for (int q = 0; q < 4; ++q) if (q < ksteps) acc = __builtin_amdgcn_mfma_f32_32x32x16_bf16(fa[q], fb[q], acc, 0, 0, 0);
    return acc;
}
DI void st_tile_T(LAS bf16* tile, int mb, int nb, const f32x16& d, int lane) {
    const int r = lane & 31, h = lane >> 5;
#pragma unroll
    for (int g = 0; g < 4; ++g) { u32x2 x; x.x = pk2(d[4 * g], d[4 * g + 1]); x.y = pk2(d[4 * g + 2], d[4 * g + 3]); *(LAS u32x2*)(tile + (nb * 32 + r) * RC_P + mb * 32 + 8 * g + 4 * h) = x; }
}
constexpr int RC_LTF2 = 13 * RC_TILE, RC_EC2 = RC_LTF2 + 2 * 32 * 36 * 4, RC_ST = RC_EC2 + 256;
static_assert(RC_ST + RC_TILE <= LDS_MISC_OFF, "rwkv chain LDS map");
DI void rwkv_chain_block(Frame& F, int chain) {
    const int w_ = F.wave;
    const int dir = chain & 1, bh = chain >> 1, b = bh >> 3, hd = bh & 7;
    const bf16* RW = (const bf16*)(F.ws + WS_RW); const float* LW = (const float*)(F.ws + WS_LW); const size_t TS = (size_t)NT * 512;
    bf16* Yg = (bf16*)(F.ws + WS_YF) + (size_t)dir * TS + (size_t)b * LTOT * 512 + hd * 64;
    LAS bf16* tiles = (LAS bf16*)F.lds;
#define TILE(i) (tiles + (i) * (RC_TILE / 2))
    LAS float* LTf = (LAS float*)(F.lds + RC_LTF2); LAS float* EC = (LAS float*)(F.lds + RC_EC2); LAS bf16* ST = (LAS bf16*)(F.lds + RC_ST);
    __syncthreads();
    { const int lane0 = fresh_lane(); for (int i = w_ * 64 + lane0; i < RC_TILE / 4; i += NTHREADS) ((LAS unsigned*)ST)[i] = 0u; }
    f32x4 nl0, nl1; u32x4 nr, nk, nv, nkk, na;
#define RC_LOAD(cc) do { const int lane_ = fresh_lane(); const int p_ = chain_pos(dir, 64 * (cc) + lane_); const size_t off_ = ((size_t)b * LTOT + p_) * 512 + hd * 64 + 8 * w; \
        nl0 = *(const f32x4*)(LW + (size_t)dir * TS + off_); nl1 = *(const f32x4*)(LW + (size_t)dir * TS + off_ + 4); nr = *(const u32x4*)(RW + off_); nk = *(const u32x4*)(RW + (size_t)(1 + dir) * TS + off_); \
        nv = *(const u32x4*)(RW + 3 * TS + off_); nkk = *(const u32x4*)(RW + 4 * TS + off_); na = *(const u32x4*)(RW + (size_t)(5 + dir) * TS + off_); } while (0)
    { const int w = w_; RC_LOAD(0); }
#pragma unroll 1
    for (int c = 0; c < NCHUNK; ++c) {
        const int lane = fresh_lane(); int w = w_; asm volatile("" : "+s"(w));
        { const f32x4 l0 = nl0, l1 = nl1; const u32x4 ur = nr, uk = nk, uv = nv, ukk = nkk, ua = na;
          float lw[8] = {l0.x, l0.y, l0.z, l0.w, l1.x, l1.y, l1.z, l1.w}, cw[8];
#pragma unroll
          for (int j = 0; j < 8; ++j) cw[j] = lw[j];
#pragma unroll
          for (int j = 0; j < 8; ++j) cw[j] = dpp_scan64(cw[j]);
          const unsigned rw_[4] = {ur.x, ur.y, ur.z, ur.w}, kw_[4] = {uk.x, uk.y, uk.z, uk.w}, kkw_[4] = {ukk.x, ukk.y, ukk.z, ukk.w}, aw_[4] = {ua.x, ua.y, ua.z, ua.w};
          float At[8], Rt[8], Bt[8], Kt[8];
#pragma unroll
          for (int j = 0; j < 8; ++j) { const float rr = (j & 1) ? bfhi(rw_[j >> 1]) : bflo(rw_[j >> 1]), kk = (j & 1) ? bfhi(kkw_[j >> 1]) : bflo(kkw_[j >> 1]), k = (j & 1) ? bfhi(kw_[j >> 1]) : bflo(kw_[j >> 1]), aa = (j & 1) ? bfhi(aw_[j >> 1]) : bflo(aw_[j >> 1]);
              const float ep = __expf(cw[j]), em = __expf(-cw[j]), epv = __expf(cw[j] - lw[j]);
              At[j] = -kk * epv; Rt[j] = rr * ep; Bt[j] = kk * aa * em; Kt[j] = k * em;
              if (lane == 63) EC[8 * w + j] = ep; }
          const bf16x8 fa = pack8(At), fr_ = pack8(Rt), fb = pack8(Bt), fk = pack8(Kt);
          *(LAS bf16x8*)(TILE(0) + lane * RC_P + 8 * w) = fa; *(LAS bf16x8*)(TILE(1) + lane * RC_P + 8 * w) = fr_; *(LAS bf16x8*)(TILE(2) + lane * RC_P + 8 * w) = fb; *(LAS bf16x8*)(TILE(3) + lane * RC_P + 8 * w) = fk;
          const unsigned vw_[4] = {uv.x, uv.y, uv.z, uv.w};
#pragma unroll
          for (int j = 0; j < 8; ++j) { TILE(4)[(8 * w + j) * RC_P + lane] = (bf16)fa[j]; TILE(5)[(8 * w + j) * RC_P + lane] = (bf16)fb[j]; TILE(6)[(8 * w + j) * RC_P + lane] = (bf16)fk[j];
              TILE(7)[(8 * w + j) * RC_P + lane] = (bf16)((j & 1) ? (vw_[j >> 1] >> 16) : (vw_[j >> 1] & 0xffffu)); } }
        LDS_BARRIER();
        if (c + 1 < NCHUNK) RC_LOAD(c + 1);
        { const int pi = w >> 1, nb = w & 1, r = lane & 31, h = lane >> 5;
          const LAS bf16* Aop = (pi == 0 || pi == 2) ? TILE(2) : TILE(3);
          const LAS bf16* Bop = pi < 2 ? TILE(0) : TILE(1);
          LAS bf16* dst = TILE(8 + pi);
#pragma unroll
          for (int mb = 0; mb < 2; ++mb) { f32x16 d = zero16();
              if (mb <= nb) d = mm_blk(Aop, mb, Bop, nb, 0, 4, lane, d);
#pragma unroll
              for (int i = 0; i < 16; ++i) { const int m = mb * 32 + crow16(i, h), n = nb * 32 + r; const bool keep = pi < 2 ? m < n : m <= n; d[i] = keep ? d[i] : 0.f; }
              st_tile_T(dst, mb, nb, d, lane);
              if (pi == 0 && mb == nb) {
#pragma unroll
                  for (int i = 0; i < 16; ++i) LTf[(mb * 32 + crow16(i, h)) * 36 + r] = d[i]; } } }
        LDS_BARRIER();
        if (w == 0) {
            { const int k = lane >> 4, tl = lane & 15, blk = k >> 1, o16 = (k & 1) * 16;
              float Tr[16];
#pragma unroll
              for (int i = 0; i < 16; ++i) Tr[i] = 0.f;
#pragma unroll
              for (int cc = 15; cc >= 0; --cc) { float a0 = (cc == tl) ? 1.f : 0.f, a1 = 0.f;
                  const LAS float* lrow = LTf + (blk * 32 + o16 + cc) * 36 + o16;
#pragma unroll
                  for (int q4 = (cc + 1) >> 2; q4 < 4; ++q4) { const f32x4 l4 = *(const LAS f32x4*)(lrow + 4 * q4);
#pragma unroll
                      for (int e = 0; e < 4; ++e) { const int s2 = 4 * q4 + e; if (s2 > cc) { if (e & 1) a1 += Tr[s2] * l4[e]; else a0 += Tr[s2] * l4[e]; } } }
                  Tr[cc] = a0 + a1; if ((cc & 3) == 0) asm volatile("" ::: "memory"); }
              unsigned z0; asm volatile("v_mov_b32 %0, 0" : "=v"(z0)); const u32x4 zz = {z0, z0, z0, z0};
              LAS bf16* trow = TILE(12) + lane * RC_P; LAS bf16* ttrow = TILE(0) + lane * RC_P;
#pragma unroll
              for (int g = 0; g < 8; ++g) { *(LAS u32x4*)(trow + 8 * g) = zz; *(LAS u32x4*)(ttrow + 8 * g) = zz; }
              *(LAS bf16x8*)(trow + 16 * k) = pack8(Tr); *(LAS bf16x8*)(trow + 16 * k + 8) = pack8(Tr + 8);
#pragma unroll
              for (int i = 0; i < 16; ++i) TILE(0)[(16 * k + i) * RC_P + lane] = f2bf(Tr[i]); }
            LDS_WAIT();
            { const int r = lane & 31, h = lane >> 5;
#pragma unroll
              for (int blk = 0; blk < 2; ++blk) {
                  f32x16 x = zero16();
                  x = __builtin_amdgcn_mfma_f32_32x32x16_bf16(*(const LAS bf16x8*)(TILE(8) + (32 * blk + r) * RC_P + 32 * blk + 8 * h), *(const LAS bf16x8*)(TILE(0) + (32 * blk + r) * RC_P + 32 * blk + 8 * h), x, 0, 0, 0);
                  st_tile_T(TILE(2), 0, blk, x, lane);
                  LDS_WAIT();
                  f32x16 d = zero16();
                  d = __builtin_amdgcn_mfma_f32_32x32x16_bf16(*(const LAS bf16x8*)(TILE(12) + (32 * blk + r) * RC_P + 32 * blk + 16 + 8 * h), *(const LAS bf16x8*)(TILE(2) + (32 * blk + r) * RC_P + 16 + 8 * h), d, 0, 0, 0);
                  if (r < 16) {
#pragma unroll
                      for (int i = 8; i < 16; ++i) TILE(12)[(32 * blk + crow16(i, h)) * RC_P + 32 * blk + r] = f2bf(d[i]);
                      { u32x2 y0, y1; y0.x = pk2(d[8], d[9]); y0.y = pk2(d[10], d[11]); y1.x = pk2(d[12], d[13]); y1.y = pk2(d[14], d[15]);
                        *(LAS u32x2*)(TILE(0) + (32 * blk + r) * RC_P + 32 * blk + 16 + 4 * h) = y0; *(LAS u32x2*)(TILE(0) + (32 * blk + r) * RC_P + 32 * blk + 24 + 4 * h) = y1; } }
                  LDS_WAIT(); } }
            LDS_WAIT();
            f32x16 m1 = mm_blk(TILE(8), 1, TILE(0), 0, 0, 2, lane, zero16());
            st_tile_T(TILE(2), 0, 0, m1, lane);
            LDS_WAIT();
            { const int r = lane & 31, h = lane >> 5; f32x16 d = zero16();
#pragma unroll
              for (int q = 0; q < 2; ++q) { const bf16x8 a = *(const LAS bf16x8*)(TILE(2) + r * RC_P + 16 * q + 8 * h), bb = *(const LAS bf16x8*)(TILE(12) + (32 + r) * RC_P + 32 + 16 * q + 8 * h);
                  d = __builtin_amdgcn_mfma_f32_32x32x16_bf16(a, bb, d, 0, 0, 0); }
#pragma unroll
              for (int g = 0; g < 4; ++g) { u32x2 x; x.x = pk2(d[4 * g], d[4 * g + 1]); x.y = pk2(d[4 * g + 2], d[4 * g + 3]); *(LAS u32x2*)(TILE(12) + (32 + r) * RC_P + 8 * g + 4 * h) = x; } }
        } else if (w <= 4) {
            const int mb = (w - 1) >> 1, nb = (w - 1) & 1;
            const f32x16 u = mm_blk(TILE(9), mb, TILE(7), nb, 0, 4, lane, zero16());
            st_tile_T(TILE(3), mb, nb, u, lane);
        }
        LDS_BARRIER();
        { const int mb = (w >> 1) & 1, nb = w & 1;
          if (w < 4) { const f32x16 d = mm_blk(TILE(12), mb, TILE(4), nb, 0, 4, lane, zero16()); st_tile_T(TILE(2), mb, nb, d, lane); }
          else { const f32x16 d = mm_blk(TILE(12), mb, TILE(3), nb, 0, 4, lane, zero16()); st_tile_T(TILE(0), mb, nb, d, lane); } }
        LDS_BARRIER();
        const int mb = (w >> 1) & 1, nb = w & 1, r = lane & 31, h = lane >> 5;
        f32x16 cin;
        if (w < 4) {
            f32x16 d = mm_blk(TILE(2), mb, TILE(5), nb, 0, 4, lane, zero16());
#pragma unroll
            for (int i = 0; i < 16; ++i) { const int m = mb * 32 + crow16(i, h), n = nb * 32 + r; d[i] = (d[i] + (m == n ? 1.f : 0.f)) * EC[n]; }
            st_tile_T(TILE(8), mb, nb, d, lane);
            cin = mm_blk(TILE(5), mb, TILE(0), nb, 0, 4, lane, zero16()); cin = mm_blk(TILE(6), mb, TILE(7), nb, 0, 4, lane, cin);
#pragma unroll
            for (int i = 0; i < 16; ++i) cin[i] *= EC[mb * 32 + crow16(i, h)];
        } else {
            f32x16 d = mm_blk(TILE(2), mb, TILE(10), nb, 0, 4, lane, zero16());
#pragma unroll
            for (int i = 0; i < 16; ++i) { const int m = mb * 32 + crow16(i, h), n = nb * 32 + r; d[i] += bf2f(TILE(1)[n * RC_P + m]); }
            st_tile_T(TILE(9), mb, nb, d, lane);
            cin = mm_blk(TILE(10), mb, TILE(0), nb, 0, 4, lane, zero16()); cin = mm_blk(TILE(11), mb, TILE(7), nb, 0, 4, lane, cin);
        }
        LDS_BARRIER();
        if (w < 4) cin = mm_blk(TILE(8), mb, ST, nb, 0, 4, lane, cin);
        else { cin = mm_blk(TILE(9), mb, ST, nb, 0, 4, lane, cin);
#pragma unroll
            for (int i = 0; i < 16; ++i) { const int p = chain_pos(dir, 64 * c + mb * 32 + crow16(i, h)); Yg[(size_t)p * 512 + nb * 32 + r] = f2bf(cin[i]); } }
        LDS_BARRIER();
        if (w < 4) st_tile_T(ST, mb, nb, cin, lane);
    }
#undef RC_LOAD
#undef TILE
}
constexpr int RT_QP = 72, RT_TP = 136;
constexpr int RT_QS = 0, RT_KS = 128 * RT_QP * 2, RT_KT = 2 * 128 * RT_QP * 2, RT_VT = RT_KT + 64 * RT_TP * 2, RT_ST = RT_VT + 128 * RT_TP * 2;
DI void phase_retention_item(Frame& F, const KA& a, int item) {
    const int b = item >> 2, hh = item & 3, w = F.wave;
    const bf16* P = (const bf16*)(F.ws + WS_P); const float2* rt = (const float2*)(F.ws + WS_ROPE);
    bf16* OFB = (bf16*)(F.ws + WS_OF); const size_t TS = (size_t)NT * 512;
    LAS bf16* Qs = (LAS bf16*)(F.lds + RT_QS); LAS bf16* Ks = (LAS bf16*)(F.lds + RT_KS); LAS bf16* KsT = (LAS bf16*)(F.lds + RT_KT); LAS bf16* VsT = (LAS bf16*)(F.lds + RT_VT); LAS bf16* SsT = (LAS bf16*)(F.lds + RT_ST);
    const float lg2g = log2f(1.f - exp2f(-5.f - (float)hh));
    const float gam = exp2f(lg2g), g127 = exp2f(127.f * lg2g), cdec = exp2f(128.f * lg2g);
    const int rb = w >> 1, cbp = w & 1, db = w >> 2, vb = w & 3;
    for (int dir = 0; dir < 2; ++dir) {
        const int lane = fresh_lane(); const int tid = w * 64 + lane, ql = lane & 31, h = lane >> 5;
        f32x16 Sreg;
#pragma unroll
        for (int i = 0; i < 16; ++i) Sreg[i] = 0.f;
        __syncthreads();
        for (int i = tid; i < 128 * RT_QP / 2; i += NTHREADS) ((LAS unsigned*)SsT)[i] = 0u;
        for (int cn = 0; cn < 34; ++cn) {
            int p0; if (cn < 2) p0 = 128 * (dir ? 1 - cn : cn); else p0 = CTX + 128 * (dir ? 33 - cn : cn - 2);
            const bool lat = p0 >= CTX;
            { int tid_o = tid; asm volatile("" : "+v"(tid_o)); const int tok = tid_o >> 2, c = tid_o & 3; const int e = dir ? 127 - tok : tok; const size_t row = (size_t)b * LTOT + p0 + tok; const bf16* prow = P + row * DINP;
              const float sq = exp2f((float)e * lg2g), sk = 0.125f * exp2f(-(float)e * lg2g);
              const u32x4 ql_ = *(const u32x4*)(prow + PC_RQ + hh * 64 + 8 * c), qh_ = *(const u32x4*)(prow + PC_RQ + hh * 64 + 32 + 8 * c);
              const u32x4 kl_ = *(const u32x4*)(prow + PC_RK + hh * 64 + 8 * c), kh_ = *(const u32x4*)(prow + PC_RK + hh * 64 + 32 + 8 * c);
              float qlo[8] = {bflo(ql_.x), bfhi(ql_.x), bflo(ql_.y), bfhi(ql_.y), bflo(ql_.z), bfhi(ql_.z), bflo(ql_.w), bfhi(ql_.w)}, qhi[8] = {bflo(qh_.x), bfhi(qh_.x), bflo(qh_.y), bfhi(qh_.y), bflo(qh_.z), bfhi(qh_.z), bflo(qh_.w), bfhi(qh_.w)};
              float klo[8] = {bflo(kl_.x), bfhi(kl_.x), bflo(kl_.y), bfhi(kl_.y), bflo(kl_.z), bfhi(kl_.z), bflo(kl_.w), bfhi(kl_.w)}, khi[8] = {bflo(kh_.x), bfhi(kh_.x), bflo(kh_.y), bfhi(kh_.y), bflo(kh_.z), bfhi(kh_.z), bflo(kh_.w), bfhi(kh_.w)};
              if (lat) { const float2* ang = rt + (size_t)(p0 - CTX + tok) * 32 + 8 * c;
#pragma unroll
                  for (int j = 0; j < 8; ++j) { const float2 cs = ang[j]; const float a0 = qlo[j], a1 = qhi[j], b0 = klo[j], b1 = khi[j];
                      qlo[j] = a0 * cs.x - a1 * cs.y; qhi[j] = a0 * cs.y + a1 * cs.x; klo[j] = b0 * cs.x - b1 * cs.y; khi[j] = b0 * cs.y + b1 * cs.x; } }
#pragma unroll
              for (int j = 0; j < 8; ++j) { qlo[j] *= sq; qhi[j] *= sq; klo[j] *= sk; khi[j] *= sk; }
              *(LAS bf16x8*)(Qs + tok * RT_QP + 8 * c) = pack8(qlo); *(LAS bf16x8*)(Qs + tok * RT_QP + 32 + 8 * c) = pack8(qhi);
              *(LAS bf16x8*)(Ks + tok * RT_QP + 8 * c) = pack8(klo); *(LAS bf16x8*)(Ks + tok * RT_QP + 32 + 8 * c) = pack8(khi);
              const int pt = permpos(tok);
#pragma unroll
              for (int j = 0; j < 8; ++j) { KsT[(8 * c + j) * RT_TP + pt] = f2bf(klo[j]); KsT[(32 + 8 * c + j) * RT_TP + pt] = f2bf(khi[j]); }
#pragma unroll
              for (int q4 = 0; q4 < 4; ++q4) { const u32x4 vv = *(const u32x4*)(prow + PC_RV + hh * 128 + 32 * c + 8 * q4); const unsigned vw[4] = {vv.x, vv.y, vv.z, vv.w};
#pragma unroll
                  for (int j = 0; j < 4; ++j) { VsT[(32 * c + 8 * q4 + 2 * j) * RT_TP + pt] = (bf16)(vw[j] & 0xffffu); VsT[(32 * c + 8 * q4 + 2 * j + 1) * RT_TP + pt] = (bf16)(vw[j] >> 16); } } }
            __syncthreads();
            f32x16 o0, o1;
#pragma unroll
            for (int i = 0; i < 16; ++i) { o0[i] = 0.f; o1[i] = 0.f; }
            for (int kb = 0; kb < 4; ++kb) {
                if (dir == 0 ? kb > rb : kb < rb) continue;
                f32x16 x;
#pragma unroll
                for (int i = 0; i < 16; ++i) x[i] = 0.f;
#pragma unroll
                for (int s = 0; s < 4; ++s) x = __builtin_amdgcn_mfma_f32_32x32x16_bf16(*(const LAS bf16x8*)(Ks + (kb * 32 + ql) * RT_QP + 16 * s + 8 * h), *(const LAS bf16x8*)(Qs + (rb * 32 + ql) * RT_QP + 16 * s + 8 * h), x, 0, 0, 0);
                if (kb == rb) {
#pragma unroll
                    for (int i = 0; i < 16; ++i) { const int key = crow16(i, h); const bool keep = dir == 0 ? key <= ql : key >= ql; x[i] = keep ? x[i] : 0.f; } }
                float xv[16];
#pragma unroll
                for (int i = 0; i < 16; ++i) xv[i] = x[i];
                const bf16x8 xa0 = pack8(xv), xa1 = pack8(xv + 8);
                const LAS bf16* v0 = VsT + ((2 * cbp) * 32 + ql) * RT_TP + kb * 32 + 8 * h; const LAS bf16* v1 = VsT + ((2 * cbp + 1) * 32 + ql) * RT_TP + kb * 32 + 8 * h;
                o0 = __builtin_amdgcn_mfma_f32_32x32x16_bf16(xa0, *(const LAS bf16x8*)(v0), o0, 0, 0, 0); o0 = __builtin_amdgcn_mfma_f32_32x32x16_bf16(xa1, *(const LAS bf16x8*)(v0 + 16), o0, 0, 0, 0);
                o1 = __builtin_amdgcn_mfma_f32_32x32x16_bf16(xa0, *(const LAS bf16x8*)(v1), o1, 0, 0, 0); o1 = __builtin_amdgcn_mfma_f32_32x32x16_bf16(xa1, *(const LAS bf16x8*)(v1 + 16), o1, 0, 0, 0);
            }
#pragma unroll
            for (int s = 0; s < 4; ++s) { const bf16x8 qa = *(const LAS bf16x8*)(Qs + (rb * 32 + ql) * RT_QP + 16 * s + 8 * h);
                o0 = __builtin_amdgcn_mfma_f32_32x32x16_bf16(qa, *(const LAS bf16x8*)(SsT + ((2 * cbp) * 32 + ql) * RT_QP + 16 * s + 8 * h), o0, 0, 0, 0);
                o1 = __builtin_amdgcn_mfma_f32_32x32x16_bf16(qa, *(const LAS bf16x8*)(SsT + ((2 * cbp + 1) * 32 + ql) * RT_QP + 16 * s + 8 * h), o1, 0, 0, 0); }
            { bf16* op = OFB + (size_t)dir * TS + ((size_t)b * LTOT + p0 + rb * 32) * 512 + hh * 128 + (2 * cbp) * 32 + ql;
#pragma unroll
              for (int i = 0; i < 16; ++i) { op[(size_t)crow16(i, h) * 512] = f2bf(o0[i]); op[(size_t)crow16(i, h) * 512 + 32] = f2bf(o1[i]); } }
            f32x16 u;
#pragma unroll
            for (int i = 0; i < 16; ++i) u[i] = 0.f;
#pragma unroll
            for (int s = 0; s < 8; ++s) u = __builtin_amdgcn_mfma_f32_32x32x16_bf16(*(const LAS bf16x8*)(KsT + (db * 32 + ql) * RT_TP + 16 * s + 8 * h), *(const LAS bf16x8*)(VsT + (vb * 32 + ql) * RT_TP + 16 * s + 8 * h), u, 0, 0, 0);
#pragma unroll
            for (int i = 0; i < 16; ++i) Sreg[i] = cdec * Sreg[i] + g127 * u[i];
            __syncthreads();
#pragma unroll
            for (int g = 0; g < 4; ++g) { u32x2 x; x.x = pk2(gam * Sreg[4 * g], gam * Sreg[4 * g + 1]); x.y = pk2(gam * Sreg[4 * g + 2], gam * Sreg[4 * g + 3]);
                *(LAS u32x2*)(SsT + (vb * 32 + ql) * RT_QP + db * 32 + 8 * g + 4 * h) = x; }
        }
    }
}

DI void phase_mixer_finish(Frame& F, const KA& a, int l) {
    const int lane = fresh_lane(), gw = F.bid * NWAVES + F.wave, NGW = F.G * NWAVES;
    const size_t TS = (size_t)NT * 512;
    const bf16* P = (const bf16*)(F.ws + WS_P); const bf16* OFB = (const bf16*)(F.ws + WS_OF); const bf16* YF = (const bf16*)(F.ws + WS_YF); const bf16* RW = (const bf16*)(F.ws + WS_RW);
    bf16* O0 = (bf16*)(F.ws + WS_ABR); bf16* O2 = O0 + 2 * TS;
    const float* lng = a.in(I_LNXG) + l * 512 + 8 * lane; const float* lnb = a.in(I_LNXB) + l * 512 + 8 * lane; const float* rkw = a.in(I_RK) + l * 512 + 8 * lane;
    float g_[8], b_[8], rk_[8];
    { const f32x4 x0 = *(const f32x4*)lng, x1 = *(const f32x4*)(lng + 4), y0 = *(const f32x4*)lnb, y1 = *(const f32x4*)(lnb + 4), z0 = *(const f32x4*)rkw, z1 = *(const f32x4*)(rkw + 4);
      g_[0] = x0.x; g_[1] = x0.y; g_[2] = x0.z; g_[3] = x0.w; g_[4] = x1.x; g_[5] = x1.y; g_[6] = x1.z; g_[7] = x1.w;
      b_[0] = y0.x; b_[1] = y0.y; b_[2] = y0.z; b_[3] = y0.w; b_[4] = y1.x; b_[5] = y1.y; b_[6] = y1.z; b_[7] = y1.w;
      rk_[0] = z0.x; rk_[1] = z0.y; rk_[2] = z0.z; rk_[3] = z0.w; rk_[4] = z1.x; rk_[5] = z1.y; rk_[6] = z1.z; rk_[7] = z1.w; }
#pragma unroll 1
    for (int r0 = gw; r0 < NT; r0 += 2 * NGW) {
        u32x4 uyf[2], uyb[2], ur[2], ukf[2], ukb[2], uv[2], ug[2], uof[2], uob[2], ugf[2], ugb[2]; size_t oo[2]; bool act[2];
#pragma unroll
        for (int u = 0; u < 2; ++u) { int r = r0 + u * NGW; act[u] = r < NT; if (!act[u]) r = r0; const size_t o = (size_t)r * 512 + 8 * lane; oo[u] = o;
            uyf[u] = *(const u32x4*)(YF + o); uyb[u] = *(const u32x4*)(YF + TS + o); ur[u] = *(const u32x4*)(RW + o); ukf[u] = *(const u32x4*)(RW + TS + o); ukb[u] = *(const u32x4*)(RW + 2 * TS + o);
            uv[u] = *(const u32x4*)(RW + 3 * TS + o); ug[u] = *(const u32x4*)(RW + 7 * TS + o); uof[u] = *(const u32x4*)(OFB + o); uob[u] = *(const u32x4*)(OFB + TS + o);
            ugf[u] = *(const u32x4*)(P + (size_t)r * DINP + PC_RGF + 8 * lane); ugb[u] = *(const u32x4*)(P + (size_t)r * DINP + PC_RGB + 8 * lane); }
        __builtin_amdgcn_sched_barrier(0);
#pragma unroll
        for (int u = 0; u < 2; ++u) { if (!act[u]) continue; const size_t o = oo[u];
            { float yfv[8], ybv[8], s[8]; unpack8(uyf[u], yfv); unpack8(uyb[u], ybv);
#pragma unroll
              for (int j = 0; j < 8; ++j) s[j] = yfv[j] + ybv[j];
              float rr[8], kf[8], kb[8], vv[8], gg[8]; unpack8(ur[u], rr); unpack8(ukf[u], kf); unpack8(ukb[u], kb); unpack8(uv[u], vv); unpack8(ug[u], gg);
              float sm = 0.f, bn = 0.f;
#pragma unroll
              for (int j = 0; j < 8; ++j) { sm += s[j]; bn += rr[j] * (kf[j] + kb[j]) * rk_[j]; }
              sm += sx(sm, 1); sm += sx(sm, 2); sm += sx(sm, 4); bn += sx(bn, 1); bn += sx(bn, 2); bn += sx(bn, 4);
              const float mean = sm * (1.f / 64.f); float vs = 0.f;
#pragma unroll
              for (int j = 0; j < 8; ++j) { s[j] -= mean; vs += s[j] * s[j]; }
              vs += sx(vs, 1); vs += sx(vs, 2); vs += sx(vs, 4);
              const float rstd = rsqrtf(vs * (1.f / 64.f) + 64e-5f);
              float y[8];
#pragma unroll
              for (int j = 0; j < 8; ++j) y[j] = (s[j] * rstd * g_[j] + b_[j] + bn * vv[j]) * gg[j];
              *(bf16x8*)(O2 + o) = pack8(y); }
            { float ff[8], bb[8], gf[8], gb[8]; unpack8(uof[u], ff); unpack8(uob[u], bb); unpack8(ugf[u], gf); unpack8(ugb[u], gb);
              float sf = 0.f, sb = 0.f;
#pragma unroll
              for (int j = 0; j < 8; ++j) { sf += ff[j]; sb += bb[j]; }
#pragma unroll
              for (int o2 = 1; o2 < 16; o2 <<= 1) { sf += sx(sf, o2); sb += sx(sb, o2); }
              const float mf = sf * (1.f / 128.f), mb = sb * (1.f / 128.f); float vf = 0.f, vb = 0.f;
#pragma unroll
              for (int j = 0; j < 8; ++j) { ff[j] -= mf; bb[j] -= mb; vf += ff[j] * ff[j]; vb += bb[j] * bb[j]; }
#pragma unroll
              for (int o2 = 1; o2 < 16; o2 <<= 1) { vf += sx(vf, o2); vb += sx(vb, o2); }
              const float rf = rsqrtf(vf * (1.f / 128.f) + 1e-5f), rb = rsqrtf(vb * (1.f / 128.f) + 1e-5f);
              float y[8];
#pragma unroll
              for (int j = 0; j < 8; ++j) y[j] = ff[j] * rf * (gf[j] * sigmoidf_(gf[j])) + bb[j] * rb * (gb[j] * sigmoidf_(gb[j]));
              *(bf16x8*)(O0 + o) = pack8(y); } }
    }
}

constexpr int N_PHASES = 2 + 10 * DEPTH;
__global__ void __launch_bounds__(NTHREADS, 2) fwd_kernel(Args args) {
    extern __shared__ __attribute__((aligned(16))) unsigned char lds_raw[];
    Frame F;
    F.lds = (LAS unsigned char*)lds_raw;
    F.MISC = (volatile LAS unsigned*)(F.lds + LDS_MISC_OFF);
    F.tid = threadIdx.x; F.lane = F.tid & 63; F.wave = __builtin_amdgcn_readfirstlane(F.tid >> 6);
    F.G = gridDim.x; F.bid = blockIdx.x;
    F.ws = args.ws; F.ctl = (unsigned*)(args.ws + WS_CTL);
    if (F.tid < 32) F.MISC[F.tid] = 0u;
    __syncthreads();
    const int lo = args.ph_lo, hi = args.ph_hi;
    KA ka; ka.kp = (const CAS char*)__builtin_amdgcn_kernarg_segment_ptr();
    const bool multi = (hi - lo) > 1;
    XcdBarrier bar; bar.bar = F.ctl + CW_BAR; bar.x = 0; bar.st = nullptr;
    if (multi) bar = xcd_barrier_post(F.ctl + CW_BAR, F.MISC + 8);
#define IN(k) (lo <= (k) && (k) < hi)
#define OPQ() do { int l_; asm volatile("v_mbcnt_lo_u32_b32 %0, -1, 0\n\tv_mbcnt_hi_u32_b32 %0, -1, %0" : "=v"(l_)); { int b_ = F.bid, w_ = F.wave, g_ = F.G; asm volatile("" : "+s"(b_), "+s"(w_), "+s"(g_)); F.bid = b_; F.wave = w_; F.G = g_; } F.lane = l_; F.tid = F.wave * 64 + l_; \
        const CAS char* kp_ = (const CAS char*)__builtin_amdgcn_kernarg_segment_ptr(); asm volatile("" : "+s"(kp_)); ka.kp = kp_; F.ws = ka.ws(); F.ctl = (unsigned*)(F.ws + WS_CTL); } while (0)
#define SEAM(k) do { if (IN(k) && IN((k) + 1)) xcd_barrier(bar); } while (0)

    if (IN(0)) { OPQ(); phase_prologue(F, ka); } SEAM(0);
    if (IN(1)) { OPQ(); phase_init_rows(F, ka); } SEAM(1);

    for (int l = 0; l < DEPTH; ++l) {
        const int pb = 2 + 10 * l;
        if (IN(pb + 0)) { OPQ(); unsigned char* ws = F.ws;
            SchedInproj S; S.T.init(NT / 256, DINP / 256, F.G, F.bid); S.A = (const char*)(ws + WS_H); S.B = (const char*)(ws + WS_WIN + (size_t)l * 15 * MiB);
            EpiStoreBf16 E{(bf16*)(ws + WS_P), DINP};
            pg8::gemm_phase<EpiStoreBf16, SchedInproj, false>(F.lds, 1024, S, E, F.tid);
        }
        SEAM(pb + 0);
        if (IN(pb + 1)) { OPQ(); phase_mla_prep2(F, ka, l); OPQ(); phase_rwkv_prep2(F, ka, l); }
        SEAM(pb + 1);
#define ATTN_QUEUE(qword, ubeg, uend) do { const int xq_ = F.bid & 7; for (;;) { __syncthreads(); \
            if (F.wave == 0 && fresh_lane() == 0) F.MISC[0] = (unsigned)(ubeg) + __hip_atomic_fetch_add(F.ctl + (qword) + xq_, 1u, __ATOMIC_RELAXED, __HIP_MEMORY_SCOPE_AGENT); \
            __syncthreads(); const int u = (int)F.MISC[0]; if (u >= (uend)) break; \
            if (u < 128) attn_unit(F, u >> 4, xq_, 1 + (u & 15)); else attn_unit(F, u - 128, xq_, 0); } } while (0)
        const int nunits = (l == DEPTH - 1) ? 128 : 136;
        if (IN(pb + 2)) { OPQ();
            if (F.bid < NCHAIN) rwkv_chain_block(F, F.bid);
            else if (F.bid < NCHAIN + 32) phase_retention_item(F, ka, F.bid - NCHAIN);
            OPQ(); ATTN_QUEUE(CW_Q + l * 64, 0, nunits);
        }
        SEAM(pb + 2);
        if (IN(pb + 3)) { OPQ(); phase_mixer_finish(F, ka, l); }
        SEAM(pb + 3);
        if (IN(pb + 4)) { OPQ(); unsigned char* ws = F.ws;
            SchedMerge S; S.T.init(NT / 256, 4, F.G, F.bid, l == DEPTH - 1); S.A = (const char*)(ws + WS_ABR); S.B = (const char*)(ws + WS_WBR + (size_t)l * 3 * MiB);
            EpiMerge E{(const bf16*)(ws + WS_P), (bf16*)(ws + WS_MRG)};
            pg8::gemm_phase<EpiMerge, SchedMerge, false>(F.lds, 512, S, E, F.tid);
        }
        SEAM(pb + 4);
        if (IN(pb + 5)) { OPQ(); unsigned char* ws = F.ws;
            SchedPlain S; S.T.init(NT / 256, 4, F.G, F.bid, l == DEPTH - 1); S.A = (const char*)(ws + WS_MRG); S.B = (const char*)(ws + WS_WOUT + (size_t)l * 2 * MiB); S.K = 1024;
            EpiResid E{(float*)(ws + WS_X), (const float*)(ws + WS_MOD) + (size_t)l * 9 * 6144};
            pg8::gemm_phase<EpiResid, SchedPlain, false>(F.lds, 1024, S, E, F.tid);
        }
        SEAM(pb + 5);
        if (IN(pb + 6)) { OPQ(); phase_router(F, ka, l); }
        SEAM(pb + 6);
        if (IN(pb + 7)) { OPQ(); unsigned char* ws = F.ws;
            moe_build_table(F, F.ctl + CW_CNT + l * 32 * 16);
            SchedMoe S{(const LAS int*)(F.lds + LDS_TAB_OFF), (const char*)(ws + WS_H), (const char*)(ws + WS_WGU + (size_t)l * 128 * MiB), (const int*)(ws + WS_LIST), 8, F.bid, F.G, 0, (size_t)2048 * 1024 * 2, true};
            EpiSwiglu E{(bf16*)(ws + WS_ACT), ka.in(I_BGU) + (size_t)l * 32 * 2048};
            pg8::gemm_phase<EpiSwiglu, SchedMoe, true>(F.lds, 1024, S, E, F.tid);
        }
        SEAM(pb + 7);
        if (IN(pb + 8)) { OPQ(); unsigned char* ws = F.ws;
            moe_build_table(F, F.ctl + CW_CNT + l * 32 * 16);
            SchedMoe S{(const LAS int*)(F.lds + LDS_TAB_OFF), (const char*)(ws + WS_ACT), (const char*)(ws + WS_WDN + (size_t)l * 64 * MiB), (const int*)(ws + WS_LIST), 4, F.bid, F.G, 0, (size_t)1024 * 1024 * 2, false};
            EpiDown E{(bf16*)(ws + WS_Y), ka.in(I_BDOWN) + (size_t)l * 32 * 1024};
            pg8::gemm_phase<EpiDown, SchedMoe, false>(F.lds, 1024, S, E, F.tid);
        }
        SEAM(pb + 8);
        if (IN(pb + 9)) { OPQ(); phase_combine(F, ka, l); }
        SEAM(pb + 9);

    }
#undef IN
#undef SEAM
}

extern "C" void kernel_launch(void* const* d_in, const int* in_sizes, int n_in, void* d_out, int out_size, void* d_ws, size_t ws_size, hipStream_t stream) {
    static int grid = 0;
    if (grid == 0) {
        if (n_in != N_IN || ws_size < WS_END) { fprintf(stderr, "kernel_launch: unexpected n_in %d or ws_size %zu (need %zu)\n", n_in, ws_size, (size_t)WS_END); grid = -1; return; }
        int dev = 0, cus = 0, per_cu = 0;
        hipGetDevice(&dev); hipDeviceGetAttribute(&cus, hipDeviceAttributeMultiprocessorCount, dev);
        if (hipFuncSetAttribute((const void*)fwd_kernel, hipFuncAttributeMaxDynamicSharedMemorySize, LDS_BYTES) != hipSuccess) { fprintf(stderr, "kernel_launch: hipFuncSetAttribute failed\n"); grid = -1; return; }
        if (hipOccupancyMaxActiveBlocksPerMultiprocessor(&per_cu, (const void*)fwd_kernel, NTHREADS, LDS_BYTES) != hipSuccess || per_cu < 1) { fprintf(stderr, "kernel_launch: occupancy query says %d\n", per_cu); }
        (void)hipGetLastError();
        grid = cus > 0 ? cus : 256;
        if (grid > 256) grid = 256;
    }
    if (grid < 0) return;
    (void)in_sizes; (void)out_size;
    hipMemsetAsync((char*)d_ws + WS_CTL, 0, CTL_ZERO_BYTES, stream);
    Args a{};
    for (int i = 0; i < N_IN; ++i) a.in[i] = (const float*)d_in[i];
    a.out = (float*)d_out; a.ws = (unsigned char*)d_ws;
#if MK_ONE_LAUNCH
    a.ph_lo = 0; a.ph_hi = N_PHASES;
    hipLaunchKernelGGL(fwd_kernel, dim3(grid), dim3(NTHREADS), LDS_BYTES, stream, a);
#else
    for (int ph = 0; ph < N_PHASES; ++ph) { a.ph_lo = ph; a.ph_hi = ph + 1; hipLaunchKernelGGL(fwd_kernel, dim3(grid), dim3(NTHREADS), LDS_BYTES, stream, a); }
#endif
    hipError_t le = hipGetLastError();
    if (le != hipSuccess) fprintf(stderr, "kernel_launch: launch failed: %s\n", hipGetErrorName(le));
}
```

```cpp
#include <hip/hip_runtime.h>
#include <cstdio>
#include <cstdint>

#ifndef MK_ONE_LAUNCH
#define MK_ONE_LAUNCH 1
#endif

#define GAS __attribute__((address_space(1)))
#define LAS __attribute__((address_space(3)))
typedef unsigned short bf16;
typedef short bf16x8 __attribute__((ext_vector_type(8)));
typedef float f32x2 __attribute__((ext_vector_type(2)));
typedef float f32x4 __attribute__((ext_vector_type(4)));
typedef float f32x16 __attribute__((ext_vector_type(16)));
typedef unsigned u32x2 __attribute__((ext_vector_type(2)));
typedef unsigned u32x4 __attribute__((ext_vector_type(4)));
typedef __bf16 bf16v2 __attribute__((ext_vector_type(2)));
#define DI __device__ __forceinline__

constexpr int D = 1024, BATCH = 8, SEQ = 4096, CTX = 256, LTOT = SEQ + CTX  , NT = BATCH * LTOT  , DEPTH = 4;
constexpr int DIN = 7456, DINP = 7680;
constexpr int NEXP = 32, TOPK = 4, DEXP = 1024;
constexpr int NSLOT = NT * TOPK + NEXP * 256;
constexpr int PC_RQ = 0, PC_RK = 256, PC_RV = 512, PC_RGF = 1024, PC_RGB = 1536, PC_MQ = 2048, PC_MKV = 2304, PC_MPE = 2432,
              PC_RW = 2464, PC_WR = 2464, PC_WK = 2976, PC_WV = 3488, PC_WHF = 4000, PC_WHB = 4064, PC_AHF = 4128, PC_AHB = 4192, PC_GH = 4256, PC_GATE = 4384;
enum { I_X = 0, I_C, I_CTX, I_CCTX, I_ADAW, I_ADAB, I_N1G, I_N2G, I_WIN, I_MQNG, I_WUQ, I_MKVNG, I_WUKV, I_QKQG, I_QKKG, I_MUP, I_MUN, I_W0, I_W2, I_A0, I_A2, I_G2,
       I_KK, I_KA, I_RK, I_LNXG, I_LNXB, I_BRRET, I_BRMLA, I_BRRWKV, I_WOUT, I_WROUTER, I_BROUTER, I_WGU, I_BGU, I_WDOWN, I_BDOWN, N_IN };

constexpr size_t MiB = 1u << 20;
constexpr size_t WS_CTL = 0, CTL_ZERO_BYTES = 1 * MiB;
constexpr size_t WS_MOD = 1 * MiB;
constexpr size_t WS_ROPE = 2 * MiB;
constexpr size_t WS_ROPE_AX = 3 * MiB;
constexpr size_t WS_SMALLW = 4 * MiB;
constexpr size_t SW_UQ = 0, SW_UKV = 393216, SW_W2 = 655360, SW_A2 = 786432, SW_G2 = 917504;
constexpr size_t WS_WBR = 8 * MiB;
constexpr size_t WS_WOUT = 20 * MiB;
constexpr size_t WS_WIN = 28 * MiB;
constexpr size_t WS_WGU = 88 * MiB;
constexpr size_t WS_WDN = 600 * MiB;
constexpr size_t WS_X = 856 * MiB;
constexpr size_t WS_H = 992 * MiB;
constexpr size_t WS_P = 1062 * MiB;
constexpr size_t WS_QB = 1572 * MiB;
constexpr size_t WS_KB = 1623 * MiB;
constexpr size_t WS_VT = 1674 * MiB;
constexpr size_t WS_RW = 1708 * MiB;
constexpr size_t RW_STRIDE = (size_t)NT * 512 * 2;
constexpr size_t WS_LW = 1980 * MiB;
constexpr size_t WS_YF = 2116 * MiB;
constexpr size_t WS_OF = 2252 * MiB;
constexpr size_t WS_ABR = 2388 * MiB;
constexpr size_t WS_MRG = 2490 * MiB;
constexpr size_t WS_TOPK = 2558 * MiB;
constexpr size_t WS_LIST = 2560 * MiB;
constexpr size_t WS_ACT = 2565 * MiB;
constexpr size_t WS_Y = 2853 * MiB;
constexpr size_t WS_END = 3141 * MiB;
constexpr int CW_SOFF = 128;
constexpr float ATT_QSC = 0.10206207261596577f * 1.4426950408889634f;
constexpr int CW_TMO = 0, CW_BAR = 4096, CW_CNT = 8192  , CW_Q = 12288  ;

DI unsigned pk2(float lo, float hi) { f32x2 v = {lo, hi}; bf16v2 r = __builtin_convertvector(v, bf16v2); return __builtin_bit_cast(unsigned, r); }
DI bf16 f2bf(float f) { return (bf16)(pk2(f, 0.f) & 0xffffu); }
DI float bf2f(unsigned short b) { return __uint_as_float(((unsigned)b) << 16); }
DI float bflo(unsigned w) { return __uint_as_float(w << 16); }
DI float bfhi(unsigned w) { return __uint_as_float(w & 0xffff0000u); }
DI f32x4 xcvt(u32x2 w) { return (f32x4){bflo(w.x), bfhi(w.x), bflo(w.y), bfhi(w.y)}; }
DI u32x2 xpack(f32x4 v) { u32x2 w; w.x = pk2(v.x, v.y); w.y = pk2(v.z, v.w); return w; }
DI int fresh_lane() { int l_; asm volatile("v_mbcnt_lo_u32_b32 %0, -1, 0\n\tv_mbcnt_hi_u32_b32 %0, -1, %0" : "=v"(l_)); return l_; }
DI bf16x8 pack8(const float* v) { u32x4 x; x.x = pk2(v[0], v[1]); x.y = pk2(v[2], v[3]); x.z = pk2(v[4], v[5]); x.w = pk2(v[6], v[7]); return __builtin_bit_cast(bf16x8, x); }
DI float sx(float v, int mask) { const int l = fresh_lane(); return __int_as_float(__builtin_amdgcn_ds_bpermute((l ^ mask) << 2, __float_as_int(v))); }
DI float sup(float v, int d) { const int l = fresh_lane(); return __int_as_float(__builtin_amdgcn_ds_bpermute((l - d) << 2, __float_as_int(v))); }
DI float dpp_scan64(float x) {
    float t;
    t = __int_as_float(__builtin_amdgcn_update_dpp(0, __float_as_int(x), 0x111, 0xf, 0xf, false)); x += t;
    t = __int_as_float(__builtin_amdgcn_update_dpp(0, __float_as_int(x), 0x112, 0xf, 0xf, false)); x += t;
    t = __int_as_float(__builtin_amdgcn_update_dpp(0, __float_as_int(x), 0x114, 0xf, 0xf, false)); x += t;
    t = __int_as_float(__builtin_amdgcn_update_dpp(0, __float_as_int(x), 0x118, 0xf, 0xf, false)); x += t;
    t = __int_as_float(__builtin_amdgcn_update_dpp(0, __float_as_int(x), 0x142, 0xa, 0xf, false)); x += t;
    t = __int_as_float(__builtin_amdgcn_update_dpp(0, __float_as_int(x), 0x143, 0xc, 0xf, false)); x += t;
    return x;
}
DI float wave_sum(float v) {
#pragma unroll
    for (int o = 1; o < 64; o <<= 1) v += sx(v, o);
    return v;
}
DI void unpack8(const u32x4& w, float* o) { o[0] = bflo(w.x); o[1] = bfhi(w.x); o[2] = bflo(w.y); o[3] = bfhi(w.y); o[4] = bflo(w.z); o[5] = bfhi(w.z); o[6] = bflo(w.w); o[7] = bfhi(w.w); }
DI f32x16 zero16() { f32x16 z; for (int i = 0; i < 16; ++i) z[i] = 0.f; return z; }
DI float sigmoidf_(float x) { return __builtin_amdgcn_rcpf(1.f + __expf(-x)); }
#define LDS_WAIT() asm volatile("s_waitcnt lgkmcnt(0)" ::: "memory")
#define VM_WAIT() asm volatile("s_waitcnt vmcnt(0)" ::: "memory")
#define LDS_BARRIER() do { asm volatile("s_waitcnt lgkmcnt(0)" ::: "memory"); __builtin_amdgcn_s_barrier(); asm volatile("" ::: "memory"); } while (0)

#define XB_TMO      128
#define XB_XCNT(j)  (256  + 64 * (j))
#define XB_XSUB(j)  (1280 + 64 * (j))
#define XB_XGEN(j)  (2304 + 64 * (j))
#define XB_TOP      3328
#define XB_TOPGEN   3392
#define XCD_BAR_WORDS 3456
#define XB_SPIN_CAP (1u << 22)

__device__ __forceinline__ unsigned xb_ld(unsigned* p)              { return __hip_atomic_load(p, __ATOMIC_RELAXED, __HIP_MEMORY_SCOPE_AGENT); }
__device__ __forceinline__ unsigned xb_add(unsigned* p, unsigned v) { return __hip_atomic_fetch_add(p, v, __ATOMIC_RELAXED, __HIP_MEMORY_SCOPE_AGENT); }
__device__ __forceinline__ unsigned xb_xcc_id() { return (unsigned)__builtin_amdgcn_s_getreg((3 << 11) | 20) & 0xFu; }
#define XB_SPIN(cond, bar) do { unsigned _sp = 0; while (cond) { __builtin_amdgcn_s_sleep(1); \
    if ((++_sp & 255u) == 0u) { if (xb_ld(&(bar)[XB_TMO])) break; if (_sp > XB_SPIN_CAP) { atomicAdd(&(bar)[XB_TMO], 1u); break; } } } } while (0)

struct XcdBarrier { unsigned* bar; unsigned x; volatile LAS unsigned* st; };

__device__ __forceinline__ XcdBarrier xcd_barrier_post(unsigned* bar, volatile LAS unsigned* st) {
    XcdBarrier b; b.bar = bar; b.x = xb_xcc_id(); b.st = st;
    if (threadIdx.x == 0) (void)xb_add(&bar[XB_XCNT(b.x)], 1u);
    return b;
}
__device__ __forceinline__ void xcd_barrier_complete(unsigned* bar, unsigned x, unsigned& nloc, unsigned& nx) {
    const unsigned G = gridDim.x * gridDim.y * gridDim.z;
    unsigned sum, cnt, mine, sp = 0u;
    for (;;) {
        sum = 0u; cnt = 0u; mine = 0u;
#pragma unroll
        for (unsigned j = 0; j < 16; ++j) { const unsigned c = xb_ld(&bar[XB_XCNT(j)]); sum += c; cnt += (c > 0u) ? 1u : 0u; mine = (j == x) ? c : mine; }
        if (sum == G) break;
        __builtin_amdgcn_s_sleep(1);
        if ((++sp & 255u) == 0u) { if (xb_ld(&bar[XB_TMO])) break; if (sp > XB_SPIN_CAP) { atomicAdd(&bar[XB_TMO], 1u); break; } }
    }
    nloc = mine > 0u ? mine : 1u; nx = cnt > 0u ? cnt : 1u;
}
__device__ __forceinline__ void xcd_barrier(const XcdBarrier& b) {
    asm volatile("s_waitcnt vmcnt(0)" ::: "memory");
    __syncthreads();
    if (threadIdx.x == 0) {
        unsigned* bar = b.bar;
        __builtin_amdgcn_s_waitcnt(0);
        unsigned nloc = b.st[0], nx = b.st[1];
        if (nloc == 0u) { xcd_barrier_complete(bar, b.x, nloc, nx); b.st[0] = nloc; b.st[1] = nx; }
        const unsigned old = xb_add(&bar[XB_XSUB(b.x)], 1u);
        const unsigned gen = old / nloc;
        if (old + 1u == (gen + 1u) * nloc) {
            __builtin_amdgcn_fence(__ATOMIC_RELEASE, "agent");
            asm volatile("s_waitcnt vmcnt(0)" ::: "memory");
            const unsigned og = xb_add(&bar[XB_TOP], 1u);
            const unsigned tg = og / nx;
            if (og + 1u == (tg + 1u) * nx) xb_add(&bar[XB_TOPGEN], 1u);
            else XB_SPIN(xb_ld(&bar[XB_TOPGEN]) == tg, bar);
            __builtin_amdgcn_fence(__ATOMIC_ACQUIRE, "agent");
            xb_add(&bar[XB_XGEN(b.x)], 1u);
            asm volatile("s_waitcnt vmcnt(0)" ::: "memory");
        } else {
            XB_SPIN(xb_ld(&bar[XB_XGEN(b.x)]) == gen, bar);
            __builtin_amdgcn_fence(__ATOMIC_ACQUIRE, "agent");
            asm volatile("s_waitcnt vmcnt(0)" ::: "memory");
        }
    }
    __syncthreads();
}

namespace pg8 {
constexpr int BM = 256, BK = 64, HALF = 128, HTB = HALF * BK * 2, STAGE_BYTES = 8 * HTB;
__host__ __device__ __forceinline__ int lds_byte(int r, int c) { const int st = (r >> 4) * 2 + (c >> 5), rr = r & 15, cc = c & 31, ob = rr * 64 + cc * 2; return st * 1024 + (ob ^ (((ob >> 9) & 1) << 5)); }
__host__ __device__ __forceinline__ void stage_rc(int b, int& R, int& C) { const int st = b / 1024, sb = b % 1024, swz = sb ^ (((sb >> 9) & 1) << 5); R = (st >> 1) * 16 + swz / 64; C = (st & 1) * 32 + (swz % 64) / 2; }
__host__ __device__ __forceinline__ int perm32(int rho) { const int n = rho >> 4, i = rho & 15; return 8 * (i >> 2) + 4 * n + (i & 3); }

struct Unit { const char* pa; const char* pb; int x, y, z; };

struct TileOrder {
    int nM, nN, nwg, G, c; bool skipctx;
    DI void init(int nM_, int nN_, int G_, int c_, bool skipctx_ = false) { skipctx = skipctx_; nM = skipctx_ ? nM_ - BATCH : nM_; nN = nN_; nwg = nM * nN; G = G_; c = c_; }
    DI bool tile(int i, int& pm, int& pn) const {
        const long L = (long)i * G + c; if (L >= nwg) return false;
        int wgid = (int)L; { const int q = nwg / 8, r = nwg % 8, xcd = wgid % 8, off = wgid / 8; wgid = (xcd < r ? xcd * (q + 1) : r * (q + 1) + (xcd - r) * q) + off; }
        const int nig = 8 * nN, gid = wgid / nig, fm = gid * 8, gsz = (nM - fm) < 8 ? (nM - fm) : 8;
        pm = fm + ((wgid % nig) % gsz); pn = (wgid % nig) / gsz; if (skipctx) pm = pm + pm / 16 + 1; return true;
    }
};

DI unsigned cvt_pk_bf16(float lo, float hi) { return pk2(lo, hi); }

template <class Epi, class Sched, bool GATHER>
__device__ __forceinline__ void gemm_phase(LAS unsigned char* lds, const int K, const Sched& S, const Epi& E, const int tid) {
    const int wid = __builtin_amdgcn_readfirstlane(tid >> 6), lane = tid & 63, wr = wid >> 2, wc = wid & 3, fr = lane & 15, fq = lane >> 4;
    const int nt = K / BK;
    unsigned voffA[2], voffB[2]; int stR[2];
#pragma unroll
    for (int i = 0; i < 2; ++i) { int R, C; stage_rc(tid * 16 + i * 8192, R, C); const int Rb = Epi::PERM ? ((R & ~31) + perm32(R & 31)) : R;
        voffA[i] = GATHER ? (unsigned)(C * 2) : (unsigned)(R * K + C) * 2u; voffB[i] = (unsigned)(Rb * K + C) * 2u; stR[i] = R; }
    const size_t kstep = (size_t)(BK * 2);
    const size_t hstep = (size_t)HALF * K * 2;
    const unsigned ldsw = (unsigned)wid * 1024u;
    const int aoff = lds_byte(wr * 64 + fr, fq * 8), boff = lds_byte(wc * 32 + fr, fq * 8);
#define PG8_SA(b, h) (((b) * 2 + (h)) * HTB)
#define PG8_SB(b, h) ((4 + (b) * 2 + (h)) * HTB)
#define PG8_STAGE(bufoff, gbase, voff) do { _Pragma("unroll") for (int _i = 0; _i < 2; ++_i) \
        __builtin_amdgcn_global_load_lds((const unsigned*)((const char*)(gbase) + (voff)[_i]), (LAS unsigned*)(lds + (bufoff) + ldsw + _i * 8192), 16, 0, 0); } while (0)
#define PG8_STAGE_A(bufoff, gbase, h, rw) do { if constexpr (GATHER) { _Pragma("unroll") for (int _i = 0; _i < 2; ++_i) { \
            const unsigned _row = ((rw)[h] >> (16 * _i)) & 0xffffu; \
            __builtin_amdgcn_global_load_lds((const unsigned*)((const char*)(gbase) + (size_t)_row * (size_t)(K * 2) + voffA[_i]), (LAS unsigned*)(lds + (bufoff) + ldsw + _i * 8192), 16, 0, 0); } } \
        else { PG8_STAGE(bufoff, (const char*)(gbase) + (h) * hstep, voffA); } } while (0)
#define PG8_LDA(dst, b, h) do { _Pragma("unroll") for (int m = 0; m < 4; ++m) _Pragma("unroll") for (int k = 0; k < 2; ++k) dst[m][k] = *(const LAS bf16x8*)(lds + PG8_SA(b, h) + aoff + m * 2048 + k * 1024); } while (0)
#define PG8_LDB(dst, b, h) do { _Pragma("unroll") for (int n = 0; n < 2; ++n) _Pragma("unroll") for (int k = 0; k < 2; ++k) dst[n][k] = *(const LAS bf16x8*)(lds + PG8_SB(b, h) + boff + n * 2048 + k * 1024); } while (0)
#define PG8_MMA(ai, bj, At, Bt) do { __builtin_amdgcn_s_setprio(1); _Pragma("unroll") for (int m = 0; m < 4; ++m) _Pragma("unroll") for (int n = 0; n < 2; ++n) _Pragma("unroll") for (int k = 0; k < 2; ++k) \
        acc[ai][bj][m][n] = __builtin_amdgcn_mfma_f32_16x16x32_bf16(Bt[n][k], At[m][k], acc[ai][bj][m][n], 0, 0, 0); __builtin_amdgcn_s_setprio(0); } while (0)
#define PG8_WAIT_V(n) asm volatile("s_waitcnt vmcnt(" #n ")" ::: "memory")
#define PG8_WAIT_L(n) asm volatile("s_waitcnt lgkmcnt(" #n ")" ::: "memory")
#define PG8_BAR __builtin_amdgcn_s_barrier()
#define PG8_SCHED __builtin_amdgcn_sched_barrier(0)
    Unit cur, nxt; int ui = 0;
    if (!S.next(0, cur)) return;
    f32x4 acc[2][2][4][2];
#pragma unroll
    for (int a = 0; a < 2; ++a)
#pragma unroll
        for (int b = 0; b < 2; ++b)
#pragma unroll
            for (int m = 0; m < 4; ++m)
#pragma unroll
                for (int n = 0; n < 2; ++n) acc[a][b][m][n] = (f32x4){0.f, 0.f, 0.f, 0.f};
    bf16x8 At[4][2], B0[2][2], B1[2][2];
    const char* cA = cur.pa; const char* cB = cur.pb;
    unsigned rwc[2] = {0u, 0u}, rwn[2] = {0u, 0u};
    if constexpr (GATHER) S.rows(cur, stR[0], stR[1], rwc);
    PG8_STAGE(PG8_SB(0, 0), cB, voffB); PG8_STAGE(PG8_SB(0, 1), cB + hstep, voffB); PG8_STAGE_A(PG8_SA(0, 0), cA, 0, rwc); PG8_STAGE_A(PG8_SA(0, 1), cA, 1, rwc);
    if (wr == 1) PG8_BAR;
    PG8_WAIT_V(2); PG8_BAR;
    PG8_STAGE(PG8_SB(1, 0), cB + kstep, voffB); PG8_STAGE_A(PG8_SA(1, 0), cA + kstep, 0, rwc); PG8_STAGE(PG8_SB(1, 1), cB + hstep + kstep, voffB);
    PG8_WAIT_V(6); PG8_BAR;
    for (;;) {
        const bool has_next = S.next(ui + 1, nxt);
        const char* nA = has_next ? nxt.pa : cA; const char* nB = has_next ? nxt.pb : cB;
        if constexpr (GATHER) { if (has_next) S.rows(nxt, stR[0], stR[1], rwn); else { rwn[0] = rwc[0]; rwn[1] = rwc[1]; } }
        for (int t = 0; t < nt; t += 2) {
            const bool last = (t == nt - 2);
            const char* a1 = cA + (size_t)(t + 1) * kstep;
            const char* a2 = last ? nA : cA + (size_t)(t + 2) * kstep; const char* b2 = last ? nB : cB + (size_t)(t + 2) * kstep;
            const char* a3 = a2 + kstep; const char* b3 = b2 + kstep;
            unsigned rw2[2]; rw2[0] = last ? rwn[0] : rwc[0]; rw2[1] = last ? rwn[1] : rwc[1];
            PG8_LDB(B0, 0, 0); PG8_LDB(B1, 0, 1); PG8_SCHED; PG8_LDA(At, 0, 0); PG8_STAGE_A(PG8_SA(1, 1), a1, 1, rwc);
            PG8_WAIT_V(8); PG8_WAIT_L(0); PG8_BAR; PG8_MMA(0, 0, At, B0); PG8_MMA(0, 1, At, B1); PG8_BAR; PG8_SCHED;
            PG8_LDA(At, 0, 1); PG8_STAGE(PG8_SB(0, 0), b2, voffB); PG8_STAGE(PG8_SB(0, 1), b2 + hstep, voffB); PG8_STAGE_A(PG8_SA(0, 0), a2, 0, rw2);
            PG8_WAIT_V(8); PG8_WAIT_L(0); PG8_BAR; PG8_MMA(1, 0, At, B0); PG8_MMA(1, 1, At, B1); PG8_BAR; PG8_SCHED;
            PG8_LDB(B0, 1, 0); PG8_LDB(B1, 1, 1); PG8_SCHED; PG8_LDA(At, 1, 0); PG8_STAGE_A(PG8_SA(0, 1), a2, 1, rw2);
            PG8_WAIT_V(8); PG8_WAIT_L(0); PG8_BAR; PG8_MMA(0, 0, At, B0); PG8_MMA(0, 1, At, B1); PG8_BAR; PG8_SCHED;
            PG8_LDA(At, 1, 1); PG8_STAGE(PG8_SB(1, 0), b3, voffB); PG8_STAGE(PG8_SB(1, 1), b3 + hstep, voffB); PG8_STAGE_A(PG8_SA(1, 0), a3, 0, rw2);
            PG8_WAIT_V(8); PG8_WAIT_L(0); PG8_BAR; PG8_MMA(1, 0, At, B0); PG8_MMA(1, 1, At, B1); PG8_BAR; PG8_SCHED;
        }
        if (wr == 0) PG8_BAR;
        { int l2_; asm volatile("v_mbcnt_lo_u32_b32 %0, -1, 0\n\tv_mbcnt_hi_u32_b32 %0, -1, %0" : "=v"(l2_));
          E(acc, cur, wr, wc, l2_ & 15, l2_ >> 4); }
        if (!has_next) break;
        cur = nxt; cA = nA; cB = nB; ++ui;
        if constexpr (GATHER) { rwc[0] = rwn[0]; rwc[1] = rwn[1]; }
        if (wr == 1) PG8_BAR;
    }
    PG8_WAIT_V(0);
    PG8_BAR;
#undef PG8_SA
#undef PG8_SB
#undef PG8_STAGE
#undef PG8_STAGE_A
#undef PG8_LDA
#undef PG8_LDB
#undef PG8_MMA
#undef PG8_WAIT_V
#undef PG8_WAIT_L
#undef PG8_BAR
#undef PG8_SCHED
}
#define ACC_ZERO(acc) do { _Pragma("unroll") for (int a_ = 0; a_ < 2; ++a_) _Pragma("unroll") for (int b_ = 0; b_ < 2; ++b_) _Pragma("unroll") for (int m_ = 0; m_ < 4; ++m_) _Pragma("unroll") for (int n_ = 0; n_ < 2; ++n_) \
        acc[a_][b_][m_][n_] = (f32x4){0.f, 0.f, 0.f, 0.f}; } while (0)
}

constexpr int NWAVES = 8, NTHREADS = 512;
constexpr int RING_BYTES = 131072;
constexpr int LDS_TAB_OFF = RING_BYTES;
constexpr int LDS_MISC_OFF = RING_BYTES + 8192;
constexpr int LDS_BYTES = 147456;

struct Args { const float* in[N_IN]; float* out; unsigned char* ws; int ph_lo, ph_hi; };

#define CAS __attribute__((address_space(4)))
struct KA { const CAS char* kp;
    DI const float* in(int i) const { return *(const float* const CAS*)(kp + 8 * i); }
    DI float* out() const { return *(float* const CAS*)(kp + 8 * N_IN); }
    DI unsigned char* ws() const { return *(unsigned char* const CAS*)(kp + 8 * N_IN + 8); } };
struct Frame {
    LAS unsigned char* lds;
    volatile LAS unsigned* MISC;
    unsigned* ctl;
    unsigned char* ws;
    int tid, lane, wave, G, bid;
};

DI int row_modrow(int r) { const int b = r / LTOT, p = r - b * LTOT; return p < CTX ? 8 : b; }

struct SchedInproj {
    pg8::TileOrder T; const char* A; const char* B;
    DI bool next(int i, pg8::Unit& u) const { int pm, pn; if (!T.tile(i, pm, pn)) return false; u.pa = A + (size_t)pm * (256 * 1024 * 2); u.pb = B + (size_t)pn * (256 * 1024 * 2); u.x = pm; u.y = pn; u.z = 0; return true; }
};
struct EpiStoreBf16 {
    static constexpr bool PERM = true;
    bf16* O; int ldc;
    DI void operator()(f32x4 (&acc)[2][2][4][2], const pg8::Unit& u, int wr, int wc, int fr, int fq) const {
        const int row0 = u.x * 256 + wr * 64 + fr, col0 = u.y * 256 + wc * 32 + 8 * fq;
#pragma unroll
        for (int ai = 0; ai < 2; ++ai)
#pragma unroll
            for (int m = 0; m < 4; ++m) { bf16* rowp = O + (size_t)(row0 + ai * 128 + m * 16) * ldc + col0;
#pragma unroll
                for (int bj = 0; bj < 2; ++bj) { const f32x4 v0 = acc[ai][bj][m][0], v1 = acc[ai][bj][m][1];
                    u32x4 w; w.x = pk2(v0[0], v0[1]); w.y = pk2(v0[2], v0[3]); w.z = pk2(v1[0], v1[1]); w.w = pk2(v1[2], v1[3]);
                    *(u32x4*)(rowp + bj * 128) = w; } }
        ACC_ZERO(acc);
    }
};
struct SchedMerge {
    pg8::TileOrder T; const char* A; const char* B;
    DI bool next(int i, pg8::Unit& u) const { const int ti = i / 3, br = i - ti * 3; int pm, pn; if (!T.tile(ti, pm, pn)) return false;
        u.pa = A + (size_t)br * ((size_t)NT * 512 * 2) + (size_t)pm * (256 * 512 * 2); u.pb = B + (size_t)br * (1024 * 512 * 2) + (size_t)pn * (256 * 512 * 2); u.x = pm; u.y = pn; u.z = br; return true; }
};
struct EpiMerge {
    static constexpr bool PERM = true;
    const bf16* P; bf16* O;
    static DI float en(float x) { return __builtin_amdgcn_exp2f(fminf(x * -1.4426950408889634f, 43.28f)); }
    DI void operator()(f32x4 (&acc)[2][2][4][2], const pg8::Unit& u, int wr, int wc, int fr, int fq) const {
        const int row0 = u.x * 256 + wr * 64 + fr, col0 = u.y * 256 + wc * 32 + 8 * fq, br = u.z;
#pragma unroll
        for (int ai = 0; ai < 2; ++ai) {
            u32x4 gc[4][2], gn[4][2];
#pragma unroll
            for (int m = 0; m < 4; ++m)
#pragma unroll
                for (int bj = 0; bj < 2; ++bj) { const bf16* gp = P + (size_t)(row0 + ai * 128 + m * 16) * DINP + PC_GATE + br * 1024 + col0 + bj * 128;
                    gc[m][bj] = *(const u32x4*)gp; gn[m][bj] = br < 2 ? *(const u32x4*)(gp + 1024) : (u32x4){0u, 0u, 0u, 0u}; }
            __builtin_amdgcn_sched_barrier(0);
#pragma unroll
            for (int m = 0; m < 4; ++m) { const size_t row = (size_t)(row0 + ai * 128 + m * 16);
#pragma unroll
                for (int bj = 0; bj < 2; ++bj) {
                    float lc[8], f[8]; unpack8(gc[m][bj], lc);
                    if (br < 2) { float ln[8]; unpack8(gn[m][bj], ln);
#pragma unroll
                        for (int j = 0; j < 8; ++j) f[j] = (1.f + en(ln[j])) * __builtin_amdgcn_rcpf(1.f + en(lc[j]));
                    } else {
#pragma unroll
                        for (int j = 0; j < 8; ++j) f[j] = __builtin_amdgcn_rcpf(1.f + en(lc[j]));
                    }
                    f32x4 v0 = acc[ai][bj][m][0], v1 = acc[ai][bj][m][1];
                    v0[0] *= f[0]; v0[1] *= f[1]; v0[2] *= f[2]; v0[3] *= f[3]; v1[0] *= f[4]; v1[1] *= f[5]; v1[2] *= f[6]; v1[3] *= f[7];
                    if (br == 2) { u32x4 w; w.x = pk2(v0[0], v0[1]); w.y = pk2(v0[2], v0[3]); w.z = pk2(v1[0], v1[1]); w.w = pk2(v1[2], v1[3]);
                        *(u32x4*)(O + row * 1024 + col0 + bj * 128) = w; v0 = (f32x4){0.f, 0.f, 0.f, 0.f}; v1 = v0; }
                    acc[ai][bj][m][0] = v0; acc[ai][bj][m][1] = v1; } }
            __builtin_amdgcn_sched_barrier(0); }
    }
};
struct SchedPlain {
    pg8::TileOrder T; const char* A; const char* B; int K;
    DI bool next(int i, pg8::Unit& u) const { int pm, pn; if (!T.tile(i, pm, pn)) return false; u.pa = A + (size_t)pm * ((size_t)256 * K * 2); u.pb = B + (size_t)pn * ((size_t)256 * K * 2); u.x = pm; u.y = pn; u.z = 0; return true; }
};
struct EpiResid {
    static constexpr bool PERM = true;
    bf16* X; const float* mod;
    DI void operator()(f32x4 (&acc)[2][2][4][2], const pg8::Unit& u, int wr, int wc, int fr, int fq) const {
        const int row0 = u.x * 256 + wr * 64 + fr, col0 = u.y * 256 + wc * 32 + 8 * fq;
        const float* g1 = mod + (size_t)row_modrow(u.x * 256) * 6144 + 2048 + col0;
        f32x4 gv[2][2];
#pragma unroll
        for (int bj = 0; bj < 2; ++bj)
#pragma unroll
            for (int n = 0; n < 2; ++n) gv[bj][n] = *(const f32x4*)(g1 + bj * 128 + n * 4);
#pragma unroll
        for (int ai = 0; ai < 2; ++ai) {
            u32x4 xv[4][2];
#pragma unroll
            for (int m = 0; m < 4; ++m)
#pragma unroll
                for (int bj = 0; bj < 2; ++bj) xv[m][bj] = *(const u32x4*)(X + (size_t)(row0 + ai * 128 + m * 16) * 1024 + col0 + bj * 128);
            __builtin_amdgcn_sched_barrier(0);
#pragma unroll
            for (int m = 0; m < 4; ++m)
#pragma unroll
                for (int bj = 0; bj < 2; ++bj) { const u32x4 x = xv[m][bj];
                    const u32x2 lo = xpack(xcvt((u32x2){x.x, x.y}) + gv[bj][0] * acc[ai][bj][m][0]), hi = xpack(xcvt((u32x2){x.z, x.w}) + gv[bj][1] * acc[ai][bj][m][1]);
                    *(u32x4*)(X + (size_t)(row0 + ai * 128 + m * 16) * 1024 + col0 + bj * 128) = (u32x4){lo.x, lo.y, hi.x, hi.y}; }
            __builtin_amdgcn_sched_barrier(0); }
        ACC_ZERO(acc);
    }
};
struct SchedMoe {
    const LAS int* tab; const char* A; const char* B; const int* list; int nN, c, G; size_t a_tile_bytes, b_exp_bytes; bool gather;
    DI bool next(int i, pg8::Unit& u) const {
        const int T = tab[96], Tq = (T + 7) >> 3, xcd = c & 7, q = i * (G >> 3) + (c >> 3), tl = q / nN, pn = q - tl * nN, t = xcd * Tq + tl;
        if (tl >= Tq || t >= T) return false;
        const int e = tab[128 + t], j = t - tab[64 + e], slot0 = tab[32 + e] + 256 * j;
        u.pa = gather ? A : A + (size_t)slot0 * 2048; u.pb = B + (size_t)e * b_exp_bytes + (size_t)pn * (256 * 1024 * 2); u.x = slot0; u.y = pn; u.z = e | (j << 8); return true;
    }
    DI void rows(const pg8::Unit& u, int R0, int R1, unsigned (&rw)[2]) const {
        const int e = u.z & 255, j = u.z >> 8, cnt = tab[e]; const int* le = list + (size_t)e * NT;
#pragma unroll
        for (int h = 0; h < 2; ++h) { const int i0 = j * 256 + h * 128 + R0, i1 = j * 256 + h * 128 + R1;
            const unsigned r0 = i0 < cnt ? (unsigned)(le[i0] >> 2) : (unsigned)NT, r1 = i1 < cnt ? (unsigned)(le[i1] >> 2) : (unsigned)NT; rw[h] = r0 | (r1 << 16); }
    }
};
struct EpiSwiglu {
    static constexpr bool PERM = true;
    bf16* ACT; const float* bgu;
    DI void operator()(f32x4 (&acc)[2][2][4][2], const pg8::Unit& u, int wr, int wc, int fr, int fq) const {
        const int row0 = u.x + wr * 64 + fr, ch0 = u.y * 128 + wc * 32 + 8 * fq, e = u.z & 255;
        const float* bg = bgu + (size_t)e * 2048 + ch0;
        const f32x4 bg0 = *(const f32x4*)bg, bg1 = *(const f32x4*)(bg + 4), bu0 = *(const f32x4*)(bg + 1024), bu1 = *(const f32x4*)(bg + 1028);
#pragma unroll
        for (int ai = 0; ai < 2; ++ai)
#pragma unroll
            for (int m = 0; m < 4; ++m) {
                const f32x4 g0 = acc[ai][0][m][0] + bg0, g1 = acc[ai][0][m][1] + bg1, u0 = acc[ai][1][m][0] + bu0, u1 = acc[ai][1][m][1] + bu1;
                float o[8];
#pragma unroll
                for (int j = 0; j < 8; ++j) { const float g = fminf(j < 4 ? g0[j & 3] : g1[j & 3], 7.f); const float up = fminf(fmaxf(j < 4 ? u0[j & 3] : u1[j & 3], -7.f), 7.f);
                    o[j] = g * __builtin_amdgcn_rcpf(1.f + __expf(-1.702f * g)) * (up + 1.f); }
                u32x4 w; w.x = pk2(o[0], o[1]); w.y = pk2(o[2], o[3]); w.z = pk2(o[4], o[5]); w.w = pk2(o[6], o[7]);
                *(u32x4*)(ACT + (size_t)(row0 + ai * 128 + m * 16) * 1024 + ch0) = w; }
        ACC_ZERO(acc);
    }
};
struct EpiDown {
    static constexpr bool PERM = true;
    bf16* Y; const float* bd;
    DI void operator()(f32x4 (&acc)[2][2][4][2], const pg8::Unit& u, int wr, int wc, int fr, int fq) const {
        const int row0 = u.x + wr * 64 + fr, col0 = u.y * 256 + wc * 32 + 8 * fq, e = u.z & 255;
        f32x4 bv[2][2];
#pragma unroll
        for (int bj = 0; bj < 2; ++bj)
#pragma unroll
            for (int n = 0; n < 2; ++n) bv[bj][n] = *(const f32x4*)(bd + (size_t)e * 1024 + col0 + bj * 128 + 4 * n);
#pragma unroll
        for (int ai = 0; ai < 2; ++ai)
#pragma unroll
            for (int m = 0; m < 4; ++m) { bf16* rowp = Y + (size_t)(row0 + ai * 128 + m * 16) * 1024 + col0;
#pragma unroll
                for (int bj = 0; bj < 2; ++bj) { const f32x4 v0 = acc[ai][bj][m][0] + bv[bj][0], v1 = acc[ai][bj][m][1] + bv[bj][1];
                    u32x4 w; w.x = pk2(v0[0], v0[1]); w.y = pk2(v0[2], v0[3]); w.z = pk2(v1[0], v1[1]); w.w = pk2(v1[2], v1[3]);
                    *(u32x4*)(rowp + bj * 128) = w; } }
        ACC_ZERO(acc);
    }
};
DI void moe_build_table(Frame& F, const unsigned* cnt  ) {
    LAS int* tab = (LAS int*)(F.lds + LDS_TAB_OFF);
    if (F.tid < 32) tab[F.tid] = (int)__hip_atomic_load(cnt + F.tid * 16, __ATOMIC_RELAXED, __HIP_MEMORY_SCOPE_AGENT);
    __syncthreads();
    if (F.tid == 0) { int pb = 0, tb = 0; for (int e = 0; e < 32; ++e) { const int nt_ = (tab[e] + 255) >> 8; tab[32 + e] = pb; tab[64 + e] = tb; pb += nt_ * 256; tb += nt_; } tab[96] = tb; }
    __syncthreads();
    for (int e = 0; e < 32; ++e) { const int tb = tab[64 + e], nt_ = (tab[e] + 255) >> 8; for (int j = F.tid; j < nt_; j += NTHREADS) tab[128 + tb + j] = e; }
    __syncthreads();
}

DI void transpose_item(const float* W, int K, int N, bf16* WT, int mode, const float* gk, LAS float* scr, int item, int lane) {
    const int nblk = N / 32, kb = item / nblk, nb = item % nblk, k0 = 64 * kb, n0 = 32 * nb;
#pragma unroll 8
    for (int i = 0; i < 32; ++i) { const int kk = 2 * i + (lane >> 5); float v = W[(size_t)(k0 + kk) * N + n0 + (lane & 31)]; if (gk) v *= gk[k0 + kk]; scr[kk * 33 + (lane & 31)] = v; }
    LDS_WAIT(); asm volatile("" ::: "memory");
    int drow0 = n0;
    if (mode == 1) { const int up = n0 >= 1024, ch = n0 - (up ? 1024 : 0); drow0 = (ch >> 7) * 256 + (up ? 128 : 0) + (ch & 127); }
    const int c = lane & 7;
#pragma unroll
    for (int j = 0; j < 4; ++j) { const int n = (lane >> 3) + 8 * j; const LAS float* s = scr + (8 * c) * 33 + n;
        u32x4 o; o.x = pk2(s[0 * 33], s[1 * 33]); o.y = pk2(s[2 * 33], s[3 * 33]); o.z = pk2(s[4 * 33], s[5 * 33]); o.w = pk2(s[6 * 33], s[7 * 33]);
        *(u32x4*)(WT + (size_t)(drow0 + n) * K + k0 + 8 * c) = o; }
    LDS_WAIT(); asm volatile("" ::: "memory");
}
DI void transpose_batch(Frame& F, const float* W, size_t ss, int K, int N, bf16* WT, size_t ds, int nb, int mode, const float* gk, size_t gks) {
    LAS float* scr = (LAS float*)(F.lds + F.wave * 12288);
    const int gw = F.bid * (NWAVES - 1) + F.wave, NGW = F.G * (NWAVES - 1);
    const int per = (K / 64) * (N / 32), total = per * nb;
    for (int it = gw; it < total; it += NGW) { const int b = it / per, r = it - b * per;
        transpose_item(W + (size_t)b * ss, K, N, WT + (size_t)b * ds, mode, gk ? gk + (size_t)b * gks : nullptr, scr, r, F.lane); }
}
DI void phase_prologue(Frame& F, const KA& a) {
    unsigned char* ws = F.ws;
    LAS float* sc = (LAS float*)(F.lds + 7 * 12288);
    for (int i = F.tid; i < 9 * 1024; i += NTHREADS) { const int r = i >> 10, k = i & 1023; const float v = r < 8 ? a.in(I_C)[r * 1024 + k] : a.in(I_CCTX)[k]; sc[i] = v / (1.f + __expf(-v)); }
    __syncthreads();
    if (F.wave == NWAVES - 1) {
        float* mod = (float*)(ws + WS_MOD); const int lane = F.lane;
#pragma unroll 1
        for (int it = F.bid; it < 4 * 96; it += F.G) { const int l = it / 96, n = (it - l * 96) * 64 + lane;
            const float* w = a.in(I_ADAW) + (size_t)l * 1024 * 6144 + n; float acc[9];
#pragma unroll
            for (int r = 0; r < 9; ++r) acc[r] = 0.f;
#pragma unroll 1
            for (int k0 = 0; k0 < 1024; k0 += 16) { float wv[16];
#pragma unroll
                for (int k = 0; k < 16; ++k) wv[k] = w[(size_t)(k0 + k) * 6144];
#pragma unroll
                for (int r = 0; r < 9; ++r)
#pragma unroll
                    for (int k4 = 0; k4 < 4; ++k4) { const f32x4 s4 = *(const LAS f32x4*)(sc + r * 1024 + k0 + 4 * k4); acc[r] += s4.x * wv[4 * k4] + s4.y * wv[4 * k4 + 1] + s4.z * wv[4 * k4 + 2] + s4.w * wv[4 * k4 + 3]; } }
#pragma unroll
            for (int r = 0; r < 9; ++r) mod[((size_t)l * 9 + r) * 6144 + n] = acc[r] + a.in(I_ADAB)[l * 6144 + n]; }
        return; }
    transpose_batch(F, a.in(I_WIN), (size_t)1024 * DIN, 1024, DIN, (bf16*)(ws + WS_WIN), (size_t)DINP * 1024, 4, 0, nullptr, 0);
    transpose_batch(F, a.in(I_WGU), (size_t)1024 * 2048, 1024, 2048, (bf16*)(ws + WS_WGU), (size_t)2048 * 1024, 128, 1, nullptr, 0);
    transpose_batch(F, a.in(I_WDOWN), (size_t)1024 * 1024, 1024, 1024, (bf16*)(ws + WS_WDN), (size_t)1024 * 1024, 128, 0, nullptr, 0);
    transpose_batch(F, a.in(I_WOUT), (size_t)1024 * 1024, 1024, 1024, (bf16*)(ws + WS_WOUT), (size_t)1024 * 1024, 4, 0, nullptr, 0);
    transpose_batch(F, a.in(I_BRRET), (size_t)512 * 1024, 512, 1024, (bf16*)(ws + WS_WBR), (size_t)3 * 1024 * 512, 4, 0, nullptr, 0);
    transpose_batch(F, a.in(I_BRMLA), (size_t)512 * 1024, 512, 1024, (bf16*)(ws + WS_WBR) + (size_t)1024 * 512, (size_t)3 * 1024 * 512, 4, 0, nullptr, 0);
    transpose_batch(F, a.in(I_BRRWKV), (size_t)512 * 1024, 512, 1024, (bf16*)(ws + WS_WBR) + (size_t)2 * 1024 * 512, (size_t)3 * 1024 * 512, 4, 0, nullptr, 0);
    transpose_batch(F, a.in(I_WUQ), (size_t)256 * 768, 256, 768, (bf16*)(ws + WS_SMALLW + SW_UQ), MiB / 2, 4, 0, a.in(I_MQNG), 256);
    transpose_batch(F, a.in(I_WUKV), (size_t)128 * 1024, 128, 1024, (bf16*)(ws + WS_SMALLW + SW_UKV), MiB / 2, 4, 0, a.in(I_MKVNG), 128);
    for (int l = 0; l < 4; ++l) {
        transpose_batch(F, a.in(I_W2) + (size_t)l * 2 * 64 * 512, (size_t)64 * 512, 64, 512, (bf16*)(ws + WS_SMALLW + l * MiB + SW_W2), (size_t)512 * 64, 2, 0, nullptr, 0);
        transpose_batch(F, a.in(I_A2) + (size_t)l * 2 * 64 * 512, (size_t)64 * 512, 64, 512, (bf16*)(ws + WS_SMALLW + l * MiB + SW_A2), (size_t)512 * 64, 2, 0, nullptr, 0);
    }
    transpose_batch(F, a.in(I_G2), (size_t)128 * 512, 128, 512, (bf16*)(ws + WS_SMALLW + SW_G2), MiB / 2, 4, 0, nullptr, 0);
    if (F.bid == 0 && F.tid < DEPTH) { const float* gq_ = a.in(I_QKQG) + F.tid * 96; const float* gk_ = a.in(I_QKKG) + F.tid * 96; float mq = 0.f, mk = 0.f;
        for (int i = 0; i < 96; ++i) { mq = fmaxf(mq, fabsf(gq_[i])); mk = fmaxf(mk, fabsf(gk_[i])); }
        ((float*)F.ctl)[CW_SOFF + F.tid] = 1.02f * 96.f * ATT_QSC * mq * mk; }
    const int gt = F.bid * (NTHREADS - 64) + F.tid, NGT = F.G * (NTHREADS - 64);
    for (int i = gt; i < 4 * (DINP - DIN) * 1024 / 8; i += NGT) { const int l = i / ((DINP - DIN) * 128), r = i - l * ((DINP - DIN) * 128);
        *(u32x4*)((bf16*)(ws + WS_WIN) + (size_t)l * DINP * 1024 + (size_t)DIN * 1024 + (size_t)r * 8) = (u32x4){0u, 0u, 0u, 0u}; }
    for (int i = gt; i < 128; i += NGT) *(u32x4*)((bf16*)(ws + WS_H) + (size_t)NT * 1024 + i * 8) = (u32x4){0u, 0u, 0u, 0u};
    { float2* rt = (float2*)(ws + WS_ROPE);
      for (int i = gt; i < 4096 * 32; i += NGT) { const int pos = i >> 5, f = i & 31; const float inv = powf(10000.f, -(float)(2 * f) / 64.f); const float ang = (float)pos * inv; float s, c; sincosf(ang, &s, &c); rt[i] = make_float2(c, s); }
      float2* ax = (float2*)(ws + WS_ROPE_AX);
      for (int i = gt; i < 64 * 8; i += NGT) { const int pos = i >> 3, f = i & 7; const float inv = powf(10000.f, -(float)(2 * f) / 16.f); const float ang = (float)pos * inv; float s, c; sincosf(ang, &s, &c); ax[i] = make_float2(c, s); } }
}

DI void norm_mod_store(const f32x4 (&v)[4], const float* gain, const float* sc, const float* sh, bf16* hrow, int lane) {
    float s = 0.f;
#pragma unroll
    for (int j = 0; j < 4; ++j) s += (v[j].x * v[j].x + v[j].y * v[j].y) + (v[j].z * v[j].z + v[j].w * v[j].w);
    const float rinv = rsqrtf(wave_sum(s) * (1.f / 1024.f) + 1e-6f);
#pragma unroll
    for (int j = 0; j < 4; ++j) { const int c = 256 * j + 4 * lane; const f32x4 g = *(const f32x4*)(gain + c), a = *(const f32x4*)(sc + c), b = *(const f32x4*)(sh + c);
        const f32x4 y = v[j] * rinv * g * (a + 1.f) + b; u32x2 o; o.x = pk2(y.x, y.y); o.y = pk2(y.z, y.w); *(u32x2*)(hrow + c) = o; }
}
DI void phase_init_rows(Frame& F, const KA& a) {
    const int gw = F.bid * NWAVES + F.wave, NGW = F.G * NWAVES;
    bf16* X = (bf16*)(F.ws + WS_X); bf16* H = (bf16*)(F.ws + WS_H); const float* mod = (const float*)(F.ws + WS_MOD);
    for (int r = gw; r < NT; r += NGW) { const int b = r / LTOT, p = r - b * LTOT;
        const float* src = p < CTX ? a.in(I_CTX) + ((size_t)b * CTX + p) * 1024 : a.in(I_X) + ((size_t)b * SEQ + (p - CTX)) * 1024;
        f32x4 v[4];
#pragma unroll
        for (int j = 0; j < 4; ++j) { v[j] = *(const f32x4*)(src + 256 * j + 4 * F.lane); *(u32x2*)(X + (size_t)r * 1024 + 256 * j + 4 * F.lane) = xpack(v[j]); }
        const float* m = mod + (size_t)(p < CTX ? 8 : b) * 6144;
        norm_mod_store(v, a.in(I_N1G), m + 1024, m, H + (size_t)r * 1024, F.lane); }
}

template <int CTRL> DI float dppf(float v) { return __int_as_float(__builtin_amdgcn_update_dpp(0, __float_as_int(v), CTRL, 0xf, 0xf, false)); }
template <int CTRL> DI int dppi(int v) { return __builtin_amdgcn_update_dpp(0, v, CTRL, 0xf, 0xf, false); }
DI void phase_router(Frame& F, const KA& a, int l) {
    LAS float* T = (LAS float*)(F.lds);
    LAS float* part = (LAS float*)(F.lds + 16 * 1028 * 4);
    LAS int* lcnt = (LAS int*)(F.lds + 16 * 1028 * 4 + 16384 + 2048);
    LAS int* gbase = lcnt + 64;
    const bf16* X = (const bf16*)(F.ws + WS_X); bf16* H = (bf16*)(F.ws + WS_H);
    const float* mod = (const float*)(F.ws + WS_MOD) + (size_t)l * 9 * 6144;
    const float* gain = a.in(I_N2G) + l * 1024; const float* wr = a.in(I_WROUTER) + (size_t)l * 1024 * 32; const float* br = a.in(I_BROUTER) + l * 32;
    int* eidx = (int*)(F.ws + WS_TOPK); float* gw = (float*)(F.ws + WS_TOPK) + (size_t)NT * 4; int* rank = (int*)(F.ws + WS_TOPK) + (size_t)NT * 8;
    int* list = (int*)(F.ws + WS_LIST); unsigned* cnt = F.ctl + CW_CNT + l * 32 * 16;
    const int lane = F.lane, w = F.wave, tid = F.tid;
    const bool lastl = l == DEPTH - 1;
    const int nit = lastl ? BATCH * SEQ / 16 : NT / 16;
    const int mi = lane & 15, mq = lane >> 4;
    float b0[32], b1[32];
    { const float* wp = wr + (size_t)(128 * w + 32 * mq) * 32 + mi;
#pragma unroll
      for (int s2 = 0; s2 < 32; ++s2) { b0[s2] = wp[s2 * 32]; b1[s2] = wp[s2 * 32 + 16]; } }
    const int row = tid >> 5, e = tid & 31; const float bre = br[e];
    u32x2 vn[2][4]; f32x4 scn[4], shn[4], gv[4];
#pragma unroll
    for (int j = 0; j < 4; ++j) gv[j] = *(const f32x4*)(gain + 256 * j + 4 * lane);
    int it = F.bid;
#define RT_R0(it_) (lastl ? ((it_) >> 8) * LTOT + CTX + 16 * ((it_) & 255) : (it_) * 16)
#define RT_MOD(r0_) (mod + (size_t)((((r0_) % LTOT) < CTX) ? 8 : (r0_) / LTOT) * 6144)
    if (it < nit) { const int r0 = RT_R0(it); const float* m = RT_MOD(r0);
#pragma unroll
        for (int rr = 0; rr < 2; ++rr)
#pragma unroll
            for (int j = 0; j < 4; ++j) vn[rr][j] = *(const u32x2*)(X + (size_t)(r0 + w * 2 + rr) * 1024 + 256 * j + 4 * lane);
#pragma unroll
        for (int j = 0; j < 4; ++j) { scn[j] = *(const f32x4*)(m + 4096 + 256 * j + 4 * lane); shn[j] = *(const f32x4*)(m + 3072 + 256 * j + 4 * lane); } }
    int pend_e = 0, pend_lr = 0, pend_r = -1, par = 0; float pend_g = 0.f; int gb = 0;
#pragma unroll 1
    for (; it < nit; it += F.G) {
        const int r0 = RT_R0(it);
        LDS_BARRIER();
        if (tid < 32) { if (pend_r >= 0) { const int c = lcnt[(par ^ 1) * 32 + tid]; gb = c ? (int)__hip_atomic_fetch_add(cnt + tid * 16, (unsigned)c, __ATOMIC_RELAXED, __HIP_MEMORY_SCOPE_AGENT) : 0; }
            lcnt[par * 32 + tid] = 0; }
#pragma unroll
        for (int rr = 0; rr < 2; ++rr) { const int lr = w * 2 + rr, r = r0 + lr;
            float s = 0.f;
#pragma unroll
            for (int j = 0; j < 4; ++j) { const f32x4 x = xcvt(vn[rr][j]); s += (x.x * x.x + x.y * x.y) + (x.z * x.z + x.w * x.w); }
            const float rinv = rsqrtf(wave_sum(s) * (1.f / 1024.f) + 1e-6f);
#pragma unroll
            for (int j = 0; j < 4; ++j) { const int c = 256 * j + 4 * lane; const f32x4 g = gv[j], sc = scn[j], sh = shn[j];
                const f32x4 y = xcvt(vn[rr][j]) * rinv * g * (sc + 1.f) + sh; *(LAS f32x4*)(T + lr * 1028 + c) = y;
                u32x2 o; o.x = pk2(y.x, y.y); o.y = pk2(y.z, y.w); *(u32x2*)(H + (size_t)r * 1024 + c) = o; } }
        LDS_BARRIER();
        if (it + F.G < nit) { const int rn = RT_R0(it + F.G); const float* m = RT_MOD(rn);
#pragma unroll
            for (int rr = 0; rr < 2; ++rr)
#pragma unroll
                for (int j = 0; j < 4; ++j) vn[rr][j] = *(const u32x2*)(X + (size_t)(rn + w * 2 + rr) * 1024 + 256 * j + 4 * lane);
#pragma unroll
            for (int j = 0; j < 4; ++j) { scn[j] = *(const f32x4*)(m + 4096 + 256 * j + 4 * lane); shn[j] = *(const f32x4*)(m + 3072 + 256 * j + 4 * lane); } }
        { f32x4 acc0 = {0.f, 0.f, 0.f, 0.f}, acc1 = acc0;
          const LAS float* tp = T + mi * 1028 + 128 * w + 32 * mq;
          f32x4 a4[8];
#pragma unroll
          for (int s2 = 0; s2 < 8; ++s2) a4[s2] = *(const LAS f32x4*)(tp + 4 * s2);
#pragma unroll
          for (int s2 = 0; s2 < 32; ++s2) { const float av = a4[s2 >> 2][s2 & 3];
              acc0 = __builtin_amdgcn_mfma_f32_16x16x4f32(av, b0[s2], acc0, 0, 0, 0); acc1 = __builtin_amdgcn_mfma_f32_16x16x4f32(av, b1[s2], acc1, 0, 0, 0); }
#pragma unroll
          for (int rg = 0; rg < 4; ++rg) { part[(w * 16 + 4 * mq + rg) * 32 + mi] = acc0[rg]; part[(w * 16 + 4 * mq + rg) * 32 + 16 + mi] = acc1[rg]; } }
        if (tid < 32 && pend_r >= 0) gbase[(par ^ 1) * 32 + tid] = gb;
        LDS_BARRIER();
        { float v = bre;
#pragma unroll
          for (int w8 = 0; w8 < 8; ++w8) v += part[(w8 * 16 + row) * 32 + e];
          int te[4]; float tv[4];
#pragma unroll
          for (int k = 0; k < 4; ++k) { float bv = v; int bi = e;
#define RT_STEP(OV, OI) do { const float ov_ = (OV); const int oi_ = (OI); const bool take_ = ov_ > bv || (ov_ == bv && oi_ < bi); bv = take_ ? ov_ : bv; bi = take_ ? oi_ : bi; } while (0)
              RT_STEP(dppf<0xB1>(bv), dppi<0xB1>(bi)); RT_STEP(dppf<0x4E>(bv), dppi<0x4E>(bi)); RT_STEP(dppf<0x141>(bv), dppi<0x141>(bi)); RT_STEP(dppf<0x140>(bv), dppi<0x140>(bi));
              RT_STEP(sx(bv, 16), __float_as_int(sx(__int_as_float(bi), 16)));
              te[k] = bi; tv[k] = bv; if (e == bi) v = -3.0e38f; }
          const float mx = tv[0]; float den = 0.f;
#pragma unroll
          for (int k = 0; k < 4; ++k) { tv[k] = __expf(tv[k] - mx); den += tv[k]; }
          const float rden = 1.f / den;
          int myk_e = te[0]; float myk_g = tv[0] * rden;
#pragma unroll
          for (int k = 1; k < 4; ++k) { if (e == k) { myk_e = te[k]; myk_g = tv[k] * rden; } }
          int lr = 0;
          if (e < 4) lr = atomicAdd((int*)&lcnt[par * 32 + myk_e], 1);
          if (e < 4 && pend_r >= 0) { const int rk = gbase[(par ^ 1) * 32 + pend_e] + pend_lr; eidx[pend_r * 4 + e] = pend_e; gw[pend_r * 4 + e] = pend_g; rank[pend_r * 4 + e] = rk; list[(size_t)pend_e * NT + rk] = pend_r * 4 + e; }
          pend_e = myk_e; pend_lr = lr; pend_g = myk_g; pend_r = r0 + row; par ^= 1; }
    }
    LDS_BARRIER();
    if (pend_r >= 0) {
        if (tid < 32) { const int c = lcnt[(par ^ 1) * 32 + tid]; gbase[(par ^ 1) * 32 + tid] = c ? (int)__hip_atomic_fetch_add(cnt + tid * 16, (unsigned)c, __ATOMIC_RELAXED, __HIP_MEMORY_SCOPE_AGENT) : 0; }
        LDS_BARRIER();
        if (e < 4) { const int rk = gbase[(par ^ 1) * 32 + pend_e] + pend_lr; eidx[pend_r * 4 + e] = pend_e; gw[pend_r * 4 + e] = pend_g; rank[pend_r * 4 + e] = rk; list[(size_t)pend_e * NT + rk] = pend_r * 4 + e; }
    }
#undef RT_STEP
#undef RT_R0
#undef RT_MOD
}

DI void phase_combine(Frame& F, const KA& a, int l, bool have_table) {
    if (!have_table) moe_build_table(F, F.ctl + CW_CNT + l * 32 * 16);
    const LAS int* tab = (const LAS int*)(F.lds + LDS_TAB_OFF);
    const int lane = fresh_lane();
    const int gw_ = F.bid * NWAVES + F.wave, NGW = F.G * NWAVES;
    bf16* X = (bf16*)(F.ws + WS_X); bf16* H = (bf16*)(F.ws + WS_H); const bf16* Y = (const bf16*)(F.ws + WS_Y);
    const float* mod = (const float*)(F.ws + WS_MOD) + (size_t)l * 9 * 6144;
    const int* eidx = (const int*)(F.ws + WS_TOPK); const float* gw = (const float*)(F.ws + WS_TOPK) + (size_t)NT * 4; const int* rank = (const int*)(F.ws + WS_TOPK) + (size_t)NT * 8;
#pragma unroll 1
    for (int r0 = gw_; r0 < NT; r0 += 2 * NGW) {
        int rr[2], bb[2], pp[2]; bool act[2]; size_t slot[2][4]; float gk[2][4];
#pragma unroll
        for (int u = 0; u < 2; ++u) { rr[u] = r0 + u * NGW; act[u] = rr[u] < NT; if (!act[u]) rr[u] = r0; bb[u] = rr[u] / LTOT; pp[u] = rr[u] - bb[u] * LTOT; if (l == DEPTH - 1 && pp[u] < CTX) act[u] = false;
#pragma unroll
            for (int k = 0; k < 4; ++k) { const int e = eidx[rr[u] * 4 + k]; gk[u][k] = gw[rr[u] * 4 + k]; slot[u][k] = (size_t)(tab[32 + e] + rank[rr[u] * 4 + k]); } }
        f32x4 v[2][4]; u32x2 xr[2][4], yv[2][4][4];
#pragma unroll
        for (int u = 0; u < 2; ++u) {
#pragma unroll
            for (int j = 0; j < 4; ++j) xr[u][j] = *(const u32x2*)(X + (size_t)rr[u] * 1024 + 256 * j + 4 * lane);
#pragma unroll
            for (int k = 0; k < 4; ++k)
#pragma unroll
                for (int j = 0; j < 4; ++j) yv[u][k][j] = *(const u32x2*)(Y + slot[u][k] * 1024 + 256 * j + 4 * lane); }
#pragma unroll
        for (int u = 0; u < 2; ++u) { if (!act[u]) continue;
            const int mr = pp[u] < CTX ? 8 : bb[u]; const float* g2 = mod + (size_t)mr * 6144 + 5120;
#pragma unroll
            for (int j = 0; j < 4; ++j) { f32x4 acc = {0.f, 0.f, 0.f, 0.f};
#pragma unroll
                for (int k = 0; k < 4; ++k) { const float g = gk[u][k]; const u32x2 y = yv[u][k][j]; acc.x += g * bflo(y.x); acc.y += g * bfhi(y.x); acc.z += g * bflo(y.y); acc.w += g * bfhi(y.y); }
                v[u][j] = xcvt(xr[u][j]) + *(const f32x4*)(g2 + 256 * j + 4 * lane) * acc; }
            if (l == DEPTH - 1) {
                float* o = a.out() + ((size_t)bb[u] * SEQ + (pp[u] - CTX)) * 1024;
#pragma unroll
                for (int j = 0; j < 4; ++j) *(f32x4*)(o + 256 * j + 4 * lane) = v[u][j];
            } else {
#pragma unroll
                for (int j = 0; j < 4; ++j) *(u32x2*)(X + (size_t)rr[u] * 1024 + 256 * j + 4 * lane) = xpack(v[u][j]);
                const float* m = (const float*)(F.ws + WS_MOD) + (size_t)(l + 1) * 9 * 6144 + (size_t)mr * 6144;
                norm_mod_store(v[u], a.in(I_N1G) + (l + 1) * 1024, m + 1024, m, H + (size_t)rr[u] * 1024, lane);
            } }
    }
}

DI int crow16(int i, int h) { return (i & 3) + 8 * (i >> 2) + 4 * h; }
DI int permpos(int p) { return (p & ~12) | ((p & 4) << 1) | ((p & 8) >> 1); }
constexpr int MP_P = 424;
constexpr int MP_SP = 104;
constexpr int MP_SCR = 32 * MP_P * 2;
DI void phase_mla_prep2(Frame& F, const KA& a, int l) {
    const bf16* P = (const bf16*)(F.ws + WS_P);
    const bf16* WUQ = (const bf16*)(F.ws + WS_SMALLW + (size_t)l * MiB + SW_UQ); const bf16* WUKV = (const bf16*)(F.ws + WS_SMALLW + (size_t)l * MiB + SW_UKV);
    bf16* QB = (bf16*)(F.ws + WS_QB); bf16* KB = (bf16*)(F.ws + WS_KB); bf16* VT = (bf16*)(F.ws + WS_VT);
    const float* gq = a.in(I_QKQG) + l * 96; const float* gk = a.in(I_QKKG) + l * 96;
    const float2* ax = (const float2*)(F.ws + WS_ROPE_AX);
    LAS bf16* T = (LAS bf16*)F.lds;
    u32x4 pre[4];
#define MP_PREFETCH(it_) do { const int tq_ = F.wave * 64 + fresh_lane(); _Pragma("unroll") for (int j_ = 0; j_ < 4; ++j_) { int q_ = tq_ + NTHREADS * j_; q_ = q_ < 32 * 52 ? q_ : q_ - 32 * 52; const int row_ = q_ / 52, pc_ = q_ - row_ * 52; \
            pre[j_] = *(const u32x4*)(P + (size_t)((it_) * 32 + row_) * DINP + PC_MQ + 8 * pc_); } } while (0)
    const bool deal = F.G == 256; const int nstr = deal ? (F.bid >= 192 ? 3 : 4) : (NT / 32 - F.bid + F.G - 1) / F.G, nitem = nstr + ((deal && F.bid < 128) ? 1 : 0);
#define MP_ITEM(k_) ((k_) < nstr ? F.bid + F.G * (k_) : 960 + F.bid)
    if (nitem > 0) MP_PREFETCH(MP_ITEM(0));
#pragma unroll 1
    for (int kit = 0; kit < nitem; ++kit) { const int it = MP_ITEM(kit);
        const int lane = fresh_lane(); int w = F.wave; asm volatile("" : "+s"(w)); const int tid = w * 64 + lane;
        const int r0 = it * 32, b = r0 / LTOT, p0 = r0 - b * LTOT;
        LDS_BARRIER();
#pragma unroll
        for (int j = 0; j < 4; ++j) { int q = tid + NTHREADS * j; q = q < 32 * 52 ? q : q - 32 * 52; const int row = q / 52, pc = q - row * 52; *(LAS u32x4*)(T + row * MP_P + 8 * pc) = pre[j]; }
        LDS_BARRIER();
        const int hd = w, tok = lane & 31, h = lane >> 5, p = p0 + tok; const bool lat = p >= CTX; const int sl = p - CTX;
        const LAS bf16* trow = T + tok * MP_P;
        LAS bf16* scr = (LAS bf16*)(F.lds + MP_SCR + w * 6656);
        const size_t bhbase = (size_t)(b * 8 + hd) * LTOT + p0;
        { bf16x8 cq[16]; float ssq = 0.f;
#pragma unroll
          for (int s2 = 0; s2 < 16; ++s2) { const u32x4 x = *(const LAS u32x4*)(trow + 16 * s2 + 8 * h); cq[s2] = __builtin_bit_cast(bf16x8, x);
              ssq += bflo(x.x) * bflo(x.x) + bfhi(x.x) * bfhi(x.x) + bflo(x.y) * bflo(x.y) + bfhi(x.y) * bfhi(x.y) + bflo(x.z) * bflo(x.z) + bfhi(x.z) * bfhi(x.z) + bflo(x.w) * bflo(x.w) + bfhi(x.w) * bfhi(x.w); }
          ssq += sx(ssq, 32);
          const float rinq = rsqrtf(ssq * (1.f / 256.f) + 1e-6f);
          float2 cr[4], cc[4];
#pragma unroll
          for (int f = 0; f < 4; ++f) { cr[f] = lat ? ax[(sl >> 6) * 8 + 4 * h + f] : make_float2(1.f, 0.f); cc[f] = lat ? ax[(sl & 63) * 8 + 4 * h + f] : make_float2(1.f, 0.f); }
          f32x16 acc[3];
#pragma unroll
          for (int cb = 0; cb < 3; ++cb) { f32x16 z = zero16(); const bf16* wrow = WUQ + (size_t)(hd * 96 + cb * 32 + tok) * 256 + 8 * h;
              bf16x8 wf[16];
#pragma unroll
              for (int s2 = 0; s2 < 16; ++s2) wf[s2] = *(const bf16x8*)(wrow + 16 * s2);
              __builtin_amdgcn_sched_barrier(0);
#pragma unroll
              for (int s2 = 0; s2 < 16; ++s2) z = __builtin_amdgcn_mfma_f32_32x32x16_bf16(wf[s2], cq[s2], z, 0, 0, 0);
              __builtin_amdgcn_sched_barrier(0);
              acc[cb] = z; }
          float ss = 0.f;
#pragma unroll
          for (int cb = 0; cb < 3; ++cb)
#pragma unroll
              for (int i = 0; i < 16; ++i) { acc[cb][i] *= rinq; ss += acc[cb][i] * acc[cb][i]; }
          ss += sx(ss, 32);
          const float rq = rsqrtf(ss * (1.f / 96.f) + 1e-6f);
#pragma unroll
          for (int cb = 0; cb < 3; ++cb)
#pragma unroll
              for (int i = 0; i < 16; ++i) acc[cb][i] *= (rq * ATT_QSC) * gq[cb * 32 + crow16(i, h)];
#pragma unroll
          for (int i = 0; i < 4; ++i) { const float2 c1 = cr[i]; const float x1 = acc[2][i], x2 = acc[2][i + 4]; acc[2][i] = x1 * c1.x - x2 * c1.y; acc[2][i + 4] = x1 * c1.y + x2 * c1.x;
              const float2 c2 = cc[i]; const float y1 = acc[2][8 + i], y2 = acc[2][12 + i]; acc[2][8 + i] = y1 * c2.x - y2 * c2.y; acc[2][12 + i] = y1 * c2.y + y2 * c2.x; }
#pragma unroll
          for (int cb = 0; cb < 3; ++cb)
#pragma unroll
              for (int g = 0; g < 4; ++g) { u32x2 o; o.x = pk2(acc[cb][4 * g], acc[cb][4 * g + 1]); o.y = pk2(acc[cb][4 * g + 2], acc[cb][4 * g + 3]); *(LAS u32x2*)(scr + tok * MP_SP + cb * 32 + 8 * g + 4 * h) = o; }
          LDS_WAIT();
#pragma unroll
          for (int i = 0; i < 6; ++i) { const int q = lane + 64 * i, row = q / 12, pc = q - row * 12; *(u32x4*)(QB + (bhbase + row) * 96 + 8 * pc) = *(const LAS u32x4*)(scr + row * MP_SP + 8 * pc); }
          LDS_WAIT(); }
        { bf16x8 ckv[8]; float ssk = 0.f;
#pragma unroll
          for (int s2 = 0; s2 < 8; ++s2) { const u32x4 x = *(const LAS u32x4*)(trow + 256 + 16 * s2 + 8 * h); ckv[s2] = __builtin_bit_cast(bf16x8, x);
              ssk += bflo(x.x) * bflo(x.x) + bfhi(x.x) * bfhi(x.x) + bflo(x.y) * bflo(x.y) + bfhi(x.y) * bfhi(x.y) + bflo(x.z) * bflo(x.z) + bfhi(x.z) * bfhi(x.z) + bflo(x.w) * bflo(x.w) + bfhi(x.w) * bfhi(x.w); }
          ssk += sx(ssk, 32);
          const float rinkv = rsqrtf(ssk * (1.f / 128.f) + 1e-6f);
          float pe1[8], pe2[8]; float sspe = 0.f;
          { const u32x4 w0 = *(const LAS u32x4*)(trow + 384 + 16 * h), w1 = *(const LAS u32x4*)(trow + 384 + 16 * h + 8);
            unpack8(w0, pe1); unpack8(w1, pe2);
#pragma unroll
            for (int j = 0; j < 8; ++j) sspe += pe1[j] * pe1[j] + pe2[j] * pe2[j];
            sspe += sx(sspe, 32); }
          float2 cs[8];
#pragma unroll
          for (int f = 0; f < 8; ++f) cs[f] = lat ? ax[(h ? (sl & 63) : (sl >> 6)) * 8 + f] : make_float2(1.f, 0.f);
          f32x16 acc[4];
#pragma unroll
          for (int cb = 0; cb < 4; cb += 2) { f32x16 z0 = zero16(), z1 = zero16(); const bf16* wrow = WUKV + (size_t)(hd * 128 + cb * 32 + tok) * 128 + 8 * h;
              bf16x8 wf0[8], wf1[8];
#pragma unroll
              for (int s2 = 0; s2 < 8; ++s2) { wf0[s2] = *(const bf16x8*)(wrow + 16 * s2); wf1[s2] = *(const bf16x8*)(wrow + 32 * 128 + 16 * s2); }
              __builtin_amdgcn_sched_barrier(0);
#pragma unroll
              for (int s2 = 0; s2 < 8; ++s2) { z0 = __builtin_amdgcn_mfma_f32_32x32x16_bf16(wf0[s2], ckv[s2], z0, 0, 0, 0); z1 = __builtin_amdgcn_mfma_f32_32x32x16_bf16(wf1[s2], ckv[s2], z1, 0, 0, 0); }
              __builtin_amdgcn_sched_barrier(0);
              acc[cb] = z0; acc[cb + 1] = z1; }
          if (kit + 1 < nitem) MP_PREFETCH(MP_ITEM(kit + 1));
          float ss = 0.f;
#pragma unroll
          for (int cb = 0; cb < 4; ++cb)
#pragma unroll
              for (int i = 0; i < 16; ++i) { acc[cb][i] *= rinkv; if (cb < 2) ss += acc[cb][i] * acc[cb][i]; }
          ss += sx(ss, 32);
          const float rk = rsqrtf((ss + sspe) * (1.f / 96.f) + 1e-6f);
#pragma unroll
          for (int cb = 0; cb < 2; ++cb)
#pragma unroll
              for (int g = 0; g < 4; ++g) { float o4[4];
#pragma unroll
                  for (int j = 0; j < 4; ++j) o4[j] = acc[cb][4 * g + j] * rk * gk[cb * 32 + 8 * g + 4 * h + j];
                  u32x2 o; o.x = pk2(o4[0], o4[1]); o.y = pk2(o4[2], o4[3]); *(LAS u32x2*)(scr + tok * MP_SP + cb * 32 + 8 * g + 4 * h) = o; }
          { float pe[16];
#pragma unroll
            for (int f = 0; f < 8; ++f) { const float x1 = pe1[f] * rk * gk[64 + 16 * h + f], x2 = pe2[f] * rk * gk[64 + 16 * h + 8 + f];
                pe[f] = x1 * cs[f].x - x2 * cs[f].y; pe[8 + f] = x1 * cs[f].y + x2 * cs[f].x; }
            *(LAS bf16x8*)(scr + tok * MP_SP + 64 + 16 * h) = pack8(pe); *(LAS bf16x8*)(scr + tok * MP_SP + 64 + 16 * h + 8) = pack8(pe + 8); }
          LDS_WAIT();
#pragma unroll
          for (int i = 0; i < 6; ++i) { const int q = lane + 64 * i, row = q / 12, pc = q - row * 12; *(u32x4*)(KB + (bhbase + row) * 96 + 8 * pc) = *(const LAS u32x4*)(scr + row * MP_SP + 8 * pc); }
          LDS_WAIT();
          { const int pt = permpos(tok);
#pragma unroll
            for (int cb = 2; cb < 4; ++cb)
#pragma unroll
                for (int i = 0; i < 16; ++i) scr[((cb - 2) * 32 + crow16(i, h)) * 40 + pt] = f2bf(acc[cb][i]);
            LDS_WAIT();
            bf16* vt = VT + (size_t)(b * 8 + hd) * 64 * LTOT + p0;
#pragma unroll
            for (int i = 0; i < 4; ++i) { const int q = lane + 64 * i, d = q >> 2, pc = q & 3; *(u32x4*)(vt + (size_t)d * LTOT + 8 * pc) = *(const LAS u32x4*)(scr + d * 40 + 8 * pc); }
            LDS_WAIT(); } }
    }
}
#undef MP_PREFETCH
#undef MP_ITEM

constexpr int ATT_KP = 104, ATT_VP = 72;
constexpr int ATT_KBYTES = 64 * ATT_KP * 2, ATT_VBYTES = 64 * ATT_VP * 2;
DI float vmax3(float a, float b, float c) { float r; asm("v_max3_f32 %0, %1, %2, %3" : "=v"(r) : "v"(a), "v"(b), "v"(c)); return r; }
DI float vmax2(float a, float b) { float r; asm("v_max_f32 %0, %1, %2" : "=v"(r) : "v"(a), "v"(b)); return r; }
DI void attn_unit(Frame& F, int b, int hd, int qblk, int l) {
    const bf16* QB = (const bf16*)(F.ws + WS_QB); const bf16* KB = (const bf16*)(F.ws + WS_KB); const bf16* VT = (const bf16*)(F.ws + WS_VT);
    bf16* O = (bf16*)(F.ws + WS_ABR) + (size_t)NT * 512;
    const int q0 = qblk == 0 ? 0 : CTX + 256 * (qblk - 1), ntiles = qblk == 0 ? CTX / 64 : LTOT / 64;
    const int lane = fresh_lane(), ql = lane & 31, h = lane >> 5, w = F.wave, tid = w * 64 + lane;
    const size_t bh = (size_t)(b * 8 + hd);
    LAS bf16* Kt = (LAS bf16*)(F.lds); LAS bf16* Vt = (LAS bf16*)(F.lds + 2 * ATT_KBYTES);
    bf16x8 qf[6];
    { const bf16* qrow = QB + (bh * LTOT + q0 + 32 * w + ql) * 96 + 8 * h;
#pragma unroll
      for (int s = 0; s < 6; ++s) qf[s] = *(const bf16x8*)(qrow + 16 * s); }
    const bf16* kbase = KB + bh * LTOT * 96; const bf16* vbase = VT + bh * 64 * LTOT;
    const int k1 = tid / 12, c1 = tid - k1 * 12, k2 = (512 + tid) / 12, c2 = (512 + tid) - k2 * 12, vd = tid >> 3, vc = tid & 7;
    u32x4 rk1, rk2 = {0u, 0u, 0u, 0u}, rv;
    rk1 = *(const u32x4*)(kbase + (size_t)k1 * 96 + 8 * c1); if (tid < 256) rk2 = *(const u32x4*)(kbase + (size_t)k2 * 96 + 8 * c2); rv = *(const u32x4*)(vbase + (size_t)vd * LTOT + 8 * vc);
    __syncthreads();
    *(LAS u32x4*)(Kt + k1 * ATT_KP + 8 * c1) = rk1; if (tid < 256) *(LAS u32x4*)(Kt + k2 * ATT_KP + 8 * c2) = rk2; *(LAS u32x4*)(Vt + vd * ATT_VP + 8 * vc) = rv;
    __syncthreads();
    float lsum = 0.f; f32x16 o0, o1, cinit;
    const float noff = -__hip_atomic_load((const float*)F.ctl + CW_SOFF + l, __ATOMIC_RELAXED, __HIP_MEMORY_SCOPE_AGENT);
#pragma unroll
    for (int i = 0; i < 16; ++i) { o0[i] = 0.f; o1[i] = 0.f; cinit[i] = noff; }
    for (int t = 0; t < ntiles; ++t) {
        const int buf = t & 1; const bool more = t + 1 < ntiles;
        if (more) { const size_t ko = (size_t)(t + 1) * 64; rk1 = *(const u32x4*)(kbase + (ko + k1) * 96 + 8 * c1); if (tid < 256) rk2 = *(const u32x4*)(kbase + (ko + k2) * 96 + 8 * c2); rv = *(const u32x4*)(vbase + (size_t)vd * LTOT + ko + 8 * vc); }
        const LAS bf16* kt = Kt + buf * (64 * ATT_KP); const LAS bf16* vt = Vt + buf * (64 * ATT_VP);
        f32x16 s0, s1;
        bf16x8 kf0[6], kf1[6];
#pragma unroll
        for (int s = 0; s < 6; ++s) { kf0[s] = *(const LAS bf16x8*)(kt + ql * ATT_KP + 16 * s + 8 * h); kf1[s] = *(const LAS bf16x8*)(kt + (32 + ql) * ATT_KP + 16 * s + 8 * h); }
        __builtin_amdgcn_sched_barrier(0);
#pragma unroll
        for (int s = 0; s < 6; ++s) { s0 = __builtin_amdgcn_mfma_f32_32x32x16_bf16(kf0[s], qf[s], s == 0 ? cinit : s0, 0, 0, 0); s1 = __builtin_amdgcn_mfma_f32_32x32x16_bf16(kf1[s], qf[s], s == 0 ? cinit : s1, 0, 0, 0); }
        bf16x8 vf0[4], vf1[4];
#pragma unroll
        for (int ks = 0; ks < 4; ++ks) { vf0[ks] = *(const LAS bf16x8*)(vt + ql * ATT_VP + 16 * ks + 8 * h); vf1[ks] = *(const LAS bf16x8*)(vt + (32 + ql) * ATT_VP + 16 * ks + 8 * h); }
        __builtin_amdgcn_sched_barrier(0);
        float rs = 0.f;
#pragma unroll
        for (int i = 0; i < 16; ++i) { s0[i] = __builtin_amdgcn_exp2f(s0[i]); s1[i] = __builtin_amdgcn_exp2f(s1[i]); rs += s0[i] + s1[i]; }
        lsum += rs;
        bf16x8 pf[4];
        { u32x4 x;
          x.x = pk2(s0[0], s0[1]); x.y = pk2(s0[2], s0[3]); x.z = pk2(s0[4], s0[5]); x.w = pk2(s0[6], s0[7]); pf[0] = __builtin_bit_cast(bf16x8, x);
          x.x = pk2(s0[8], s0[9]); x.y = pk2(s0[10], s0[11]); x.z = pk2(s0[12], s0[13]); x.w = pk2(s0[14], s0[15]); pf[1] = __builtin_bit_cast(bf16x8, x);
          x.x = pk2(s1[0], s1[1]); x.y = pk2(s1[2], s1[3]); x.z = pk2(s1[4], s1[5]); x.w = pk2(s1[6], s1[7]); pf[2] = __builtin_bit_cast(bf16x8, x);
          x.x = pk2(s1[8], s1[9]); x.y = pk2(s1[10], s1[11]); x.z = pk2(s1[12], s1[13]); x.w = pk2(s1[14], s1[15]); pf[3] = __builtin_bit_cast(bf16x8, x); }
        __builtin_amdgcn_sched_barrier(0);
#pragma unroll
        for (int ks = 0; ks < 4; ++ks) { o0 = __builtin_amdgcn_mfma_f32_32x32x16_bf16(vf0[ks], pf[ks], o0, 0, 0, 0); o1 = __builtin_amdgcn_mfma_f32_32x32x16_bf16(vf1[ks], pf[ks], o1, 0, 0, 0); }
        if (more) { const int nb = buf ^ 1; LAS bf16* kn = Kt + nb * (64 * ATT_KP); LAS bf16* vn = Vt + nb * (64 * ATT_VP);
            *(LAS u32x4*)(kn + k1 * ATT_KP + 8 * c1) = rk1; if (tid < 256) *(LAS u32x4*)(kn + k2 * ATT_KP + 8 * c2) = rk2; *(LAS u32x4*)(vn + vd * ATT_VP + 8 * vc) = rv; }
        __syncthreads();
    }
    lsum += sx(lsum, 32);
    const float inv = 1.f / lsum;
    bf16* orow = O + ((size_t)b * LTOT + q0 + 32 * w + ql) * 512 + hd * 64 + 4 * h;
#pragma unroll
    for (int g = 0; g < 4; ++g) { u32x2 x; x.x = pk2(o0[4 * g] * inv, o0[4 * g + 1] * inv); x.y = pk2(o0[4 * g + 2] * inv, o0[4 * g + 3] * inv); *(u32x2*)(orow + 8 * g) = x;
        x.x = pk2(o1[4 * g] * inv, o1[4 * g + 1] * inv); x.y = pk2(o1[4 * g + 2] * inv, o1[4 * g + 3] * inv); *(u32x2*)(orow + 32 + 8 * g) = x; }
}

DI void shift_n(const bf16* prow, bool first, bool last, int col, const float* mup, const float* mun, float* out, int n  ) {
    const bf16* pp = first ? prow : prow - DINP; const bf16* pn = last ? prow : prow + DINP; const float fm = first ? 0.f : 1.f, lm = last ? 0.f : 1.f;
    if (n == 8) {
        const u32x4 c = *(const u32x4*)(prow + col), pv = *(const u32x4*)(pp + col), nx = *(const u32x4*)(pn + col);
        const f32x4 mp0 = *(const f32x4*)(mup + col - PC_RW), mp1 = *(const f32x4*)(mup + col - PC_RW + 4), mn0 = *(const f32x4*)(mun + col - PC_RW), mn1 = *(const f32x4*)(mun + col - PC_RW + 4);
        const unsigned cw[4] = {c.x, c.y, c.z, c.w}, pw[4] = {pv.x, pv.y, pv.z, pv.w}, nw[4] = {nx.x, nx.y, nx.z, nx.w};
        const float mp[8] = {mp0.x, mp0.y, mp0.z, mp0.w, mp1.x, mp1.y, mp1.z, mp1.w}, mn[8] = {mn0.x, mn0.y, mn0.z, mn0.w, mn1.x, mn1.y, mn1.z, mn1.w};
#pragma unroll
        for (int j = 0; j < 4; ++j) { const float t0 = bflo(cw[j]), t1 = bfhi(cw[j]);
            out[2 * j] = t0 + mp[2 * j] * (fm * bflo(pw[j]) - t0) + mn[2 * j] * (lm * bflo(nw[j]) - t0);
            out[2 * j + 1] = t1 + mp[2 * j + 1] * (fm * bfhi(pw[j]) - t1) + mn[2 * j + 1] * (lm * bfhi(nw[j]) - t1); }
    } else {
        const u32x2 c = *(const u32x2*)(prow + col), pv = *(const u32x2*)(pp + col), nx = *(const u32x2*)(pn + col);
        const f32x4 mp0 = *(const f32x4*)(mup + col - PC_RW), mn0 = *(const f32x4*)(mun + col - PC_RW);
        const unsigned cw[2] = {c.x, c.y}, pw[2] = {pv.x, pv.y}, nw[2] = {nx.x, nx.y};
        const float mp[4] = {mp0.x, mp0.y, mp0.z, mp0.w}, mn[4] = {mn0.x, mn0.y, mn0.z, mn0.w};
#pragma unroll
        for (int j = 0; j < 2; ++j) { const float t0 = bflo(cw[j]), t1 = bfhi(cw[j]);
            out[2 * j] = t0 + mp[2 * j] * (fm * bflo(pw[j]) - t0) + mn[2 * j] * (lm * bflo(nw[j]) - t0);
            out[2 * j + 1] = t1 + mp[2 * j + 1] * (fm * bfhi(pw[j]) - t1) + mn[2 * j + 1] * (lm * bfhi(nw[j]) - t1); }
    }
}
constexpr int RP_P = 1928;
DI void phase_rwkv_prep2(Frame& F, const KA& a, int l) {
    const bf16* P = (const bf16*)(F.ws + WS_P);
    const bf16* W2T = (const bf16*)(F.ws + WS_SMALLW + (size_t)l * MiB + SW_W2); const bf16* A2T = (const bf16*)(F.ws + WS_SMALLW + (size_t)l * MiB + SW_A2); const bf16* G2T = (const bf16*)(F.ws + WS_SMALLW + (size_t)l * MiB + SW_G2);
    const float* mup = a.in(I_MUP) + l * 1920; const float* mun = a.in(I_MUN) + l * 1920;
    const float* w0 = a.in(I_W0) + l * 1024; const float* a0 = a.in(I_A0) + l * 1024; const float* kkw = a.in(I_KK) + l * 512; const float* kaw = a.in(I_KA) + l * 512;
    bf16* RW = (bf16*)(F.ws + WS_RW); bf16* LW = (bf16*)(F.ws + WS_LW);
    const size_t TS = (size_t)NT * 512;
    LAS bf16* T = (LAS bf16*)F.lds;
#pragma unroll 1
    for (int it = (F.bid + 64) % F.G; it < NT / 32; it += F.G) {
        const int lane = fresh_lane(); int w = F.wave; asm volatile("" : "+s"(w)); const int tid = w * 64 + lane;
        const int r0 = it * 32;
        __syncthreads();
        if (tid < 480) { const int pc = tid % 240, rh = tid / 240, row0 = rh * 16, col = PC_RW + 8 * pc;
            const int ra = r0 + row0, ba = ra / LTOT, pa = ra - ba * LTOT;
            u32x4 rowv[18];
#pragma unroll
            for (int j = 0; j < 18; ++j) { const int p = pa - 1 + j; const bool valid = (p >= 0) && (p < LTOT) && ((p < CTX) == (pa < CTX));
                const int pcl = valid ? p : pa; rowv[j] = *(const u32x4*)(P + ((size_t)ba * LTOT + pcl) * DINP + col); if (!valid) rowv[j] = (u32x4){0u, 0u, 0u, 0u}; }
            const f32x4 mp0 = *(const f32x4*)(mup + 8 * pc), mp1 = *(const f32x4*)(mup + 8 * pc + 4), mn0 = *(const f32x4*)(mun + 8 * pc), mn1 = *(const f32x4*)(mun + 8 * pc + 4);
            const float mp[8] = {mp0.x, mp0.y, mp0.z, mp0.w, mp1.x, mp1.y, mp1.z, mp1.w}, mn[8] = {mn0.x, mn0.y, mn0.z, mn0.w, mn1.x, mn1.y, mn1.z, mn1.w};
#pragma unroll
            for (int j = 0; j < 16; ++j) { float pv[8], cv[8], nv[8], v[8]; unpack8(rowv[j], pv); unpack8(rowv[j + 1], cv); unpack8(rowv[j + 2], nv);
#pragma unroll
                for (int e = 0; e < 8; ++e) v[e] = cv[e] + mp[e] * (pv[e] - cv[e]) + mn[e] * (nv[e] - cv[e]);
                if (pc >= 192 && pc < 208) {
#pragma unroll
                    for (int e = 0; e < 8; ++e) v[e] = 2.f * sigmoidf_(2.f * v[e]) - 1.f; }
                else if (pc >= 224) {
#pragma unroll
                    for (int e = 0; e < 8; ++e) v[e] = sigmoidf_(v[e]); }
                *(LAS bf16x8*)(T + (row0 + j) * RP_P + 8 * pc) = pack8(v); } }
        __syncthreads();
        const int hd = w, tok = lane & 31, h = lane >> 5;
        const LAS bf16* trow = T + tok * RP_P;
#define RP_OUT(c0, dst) do { _Pragma("unroll") for (int i_ = 0; i_ < 4; ++i_) { const int row_ = 8 * i_ + (lane >> 3), pc_ = lane & 7; \
            *(u32x4*)((dst) + (size_t)(r0 + row_) * 512 + hd * 64 + 8 * pc_) = *(const LAS u32x4*)(T + row_ * RP_P + (c0) + 8 * pc_); } } while (0)
        bf16x8 wa[2][8], wg[16], wl[2][8];
#define RP_LDW_A(d_) do { _Pragma("unroll") for (int cb_ = 0; cb_ < 2; ++cb_) _Pragma("unroll") for (int s_ = 0; s_ < 4; ++s_) wa[d_][cb_ * 4 + s_] = *(const bf16x8*)(A2T + (size_t)((d_) * 512 + hd * 64 + cb_ * 32 + tok) * 64 + 16 * s_ + 8 * h); } while (0)
#define RP_LDW_L(d_) do { _Pragma("unroll") for (int cb_ = 0; cb_ < 2; ++cb_) _Pragma("unroll") for (int s_ = 0; s_ < 4; ++s_) wl[d_][cb_ * 4 + s_] = *(const bf16x8*)(W2T + (size_t)((d_) * 512 + hd * 64 + cb_ * 32 + tok) * 64 + 16 * s_ + 8 * h); } while (0)
#define RP_LDW_G() do { _Pragma("unroll") for (int cb_ = 0; cb_ < 2; ++cb_) _Pragma("unroll") for (int s_ = 0; s_ < 8; ++s_) wg[cb_ * 8 + s_] = *(const bf16x8*)(G2T + (size_t)(hd * 64 + cb_ * 32 + tok) * 128 + 16 * s_ + 8 * h); } while (0)
        RP_LDW_A(0);
        RP_OUT(hd * 64, RW); RP_OUT(1024 + hd * 64, RW + 3 * TS);
        float kraw[2][16]; float ss = 0.f;
#pragma unroll
        for (int cb = 0; cb < 2; ++cb)
#pragma unroll
            for (int g = 0; g < 4; ++g) { const int ch = hd * 64 + cb * 32 + 8 * g + 4 * h; const u32x2 kw = *(const LAS u32x2*)(trow + 512 + ch);
                kraw[cb][4 * g] = bflo(kw.x); kraw[cb][4 * g + 1] = bfhi(kw.x); kraw[cb][4 * g + 2] = bflo(kw.y); kraw[cb][4 * g + 3] = bfhi(kw.y);
                const f32x4 kk4 = *(const f32x4*)(kkw + ch);
                ss += kraw[cb][4 * g] * kk4.x * kraw[cb][4 * g] * kk4.x + kraw[cb][4 * g + 1] * kk4.y * kraw[cb][4 * g + 1] * kk4.y + kraw[cb][4 * g + 2] * kk4.z * kraw[cb][4 * g + 2] * kk4.z + kraw[cb][4 * g + 3] * kk4.w * kraw[cb][4 * g + 3] * kk4.w; }
        ss += sx(ss, 32);
        const float rkk = rsqrtf(fmaxf(ss, 1e-24f));
        LDS_WAIT();
        LAS bf16* scr3[3] = {T + hd * 64, T + 1024 + hd * 64, T + 512 + hd * 64};
#define RP_TILE_OUT(vals  , dst, NN) do { LAS bf16* scr = scr3[(NN) % 3]; const int sc0_ = ((NN) % 3 == 0 ? 0 : (NN) % 3 == 1 ? 1024 : 512) + hd * 64; _Pragma("unroll") for (int cb_ = 0; cb_ < 2; ++cb_) _Pragma("unroll") for (int g_ = 0; g_ < 4; ++g_) { u32x2 x_; x_[0] = pk2(vals[cb_][4 * g_], vals[cb_][4 * g_ + 1]); x_[1] = pk2(vals[cb_][4 * g_ + 2], vals[cb_][4 * g_ + 3]); \
            *(LAS u32x2*)(scr + tok * RP_P + cb_ * 32 + 8 * g_ + 4 * h) = x_; } LDS_WAIT(); RP_OUT(sc0_, dst); } while (0)
        { float av[2][16], o[2][16];
#pragma unroll
          for (int d = 0; d < 2; ++d) {
              if (d == 0) RP_LDW_A(1); else RP_LDW_G();
#pragma unroll
              for (int cb = 0; cb < 2; ++cb) { f32x16 c = zero16();
                  bf16x8 xf[4];
#pragma unroll
                  for (int s2 = 0; s2 < 4; ++s2) xf[s2] = *(const LAS bf16x8*)(trow + 1664 + 64 * d + 16 * s2 + 8 * h);
                  __builtin_amdgcn_sched_barrier(0);
#pragma unroll
                  for (int s2 = 0; s2 < 4; ++s2) c = __builtin_amdgcn_mfma_f32_32x32x16_bf16(wa[d][cb * 4 + s2], xf[s2], c, 0, 0, 0);
#pragma unroll
                  for (int g = 0; g < 4; ++g) { const f32x4 a4 = *(const f32x4*)(a0 + d * 512 + hd * 64 + cb * 32 + 8 * g + 4 * h);
                      av[cb][4 * g] = sigmoidf_(a4.x + c[4 * g]); av[cb][4 * g + 1] = sigmoidf_(a4.y + c[4 * g + 1]); av[cb][4 * g + 2] = sigmoidf_(a4.z + c[4 * g + 2]); av[cb][4 * g + 3] = sigmoidf_(a4.w + c[4 * g + 3]); } }
              RP_TILE_OUT(av, RW + (size_t)(5 + d) * TS, 2 * d);
#pragma unroll
              for (int cb = 0; cb < 2; ++cb)
#pragma unroll
                  for (int g = 0; g < 4; ++g) { const f32x4 ka4 = *(const f32x4*)(kaw + hd * 64 + cb * 32 + 8 * g + 4 * h);
                      o[cb][4 * g] = kraw[cb][4 * g] * (1.f + (av[cb][4 * g] - 1.f) * ka4.x); o[cb][4 * g + 1] = kraw[cb][4 * g + 1] * (1.f + (av[cb][4 * g + 1] - 1.f) * ka4.y);
                      o[cb][4 * g + 2] = kraw[cb][4 * g + 2] * (1.f + (av[cb][4 * g + 2] - 1.f) * ka4.z); o[cb][4 * g + 3] = kraw[cb][4 * g + 3] * (1.f + (av[cb][4 * g + 3] - 1.f) * ka4.w); }
              RP_TILE_OUT(o, RW + (size_t)(1 + d) * TS, 2 * d + 1); }
#pragma unroll
          for (int cb = 0; cb < 2; ++cb)
#pragma unroll
              for (int g = 0; g < 4; ++g) { const f32x4 kk4 = *(const f32x4*)(kkw + hd * 64 + cb * 32 + 8 * g + 4 * h);
                  o[cb][4 * g] = kraw[cb][4 * g] * kk4.x * rkk; o[cb][4 * g + 1] = kraw[cb][4 * g + 1] * kk4.y * rkk; o[cb][4 * g + 2] = kraw[cb][4 * g + 2] * kk4.z * rkk; o[cb][4 * g + 3] = kraw[cb][4 * g + 3] * kk4.w * rkk; }
          RP_TILE_OUT(o, RW + 4 * TS, 4); }
        { float o[2][16];
#pragma unroll
          for (int cb = 0; cb < 2; ++cb) { f32x16 c = zero16();
              if (cb == 0) RP_LDW_L(0);
              bf16x8 xf[8];
#pragma unroll
              for (int s2 = 0; s2 < 8; ++s2) xf[s2] = *(const LAS bf16x8*)(trow + 1792 + 16 * s2 + 8 * h);
              __builtin_amdgcn_sched_barrier(0);
#pragma unroll
              for (int s2 = 0; s2 < 8; ++s2) c = __builtin_amdgcn_mfma_f32_32x32x16_bf16(wg[cb * 8 + s2], xf[s2], c, 0, 0, 0);
#pragma unroll
              for (int i = 0; i < 16; ++i) o[cb][i] = c[i]; }
          RP_TILE_OUT(o, RW + 7 * TS, 5); }
#pragma unroll
        for (int d = 0; d < 2; ++d) { float lwv[2][16];
#pragma unroll
            for (int cb = 0; cb < 2; ++cb) { f32x16 c = zero16();
                if (d == 0 && cb == 0) RP_LDW_L(1);
                bf16x8 xf[4];
#pragma unroll
                for (int s2 = 0; s2 < 4; ++s2) xf[s2] = *(const LAS bf16x8*)(trow + 1536 + 64 * d + 16 * s2 + 8 * h);
                __builtin_amdgcn_sched_barrier(0);
#pragma unroll
                for (int s2 = 0; s2 < 4; ++s2) c = __builtin_amdgcn_mfma_f32_32x32x16_bf16(wl[d][cb * 4 + s2], xf[s2], c, 0, 0, 0);
#pragma unroll
                for (int g = 0; g < 4; ++g) { const f32x4 w4 = *(const f32x4*)(w0 + d * 512 + hd * 64 + cb * 32 + 8 * g + 4 * h);
                    lwv[cb][4 * g] = -0.6065306597f * sigmoidf_(w4.x + c[4 * g]); lwv[cb][4 * g + 1] = -0.6065306597f * sigmoidf_(w4.y + c[4 * g + 1]);
                    lwv[cb][4 * g + 2] = -0.6065306597f * sigmoidf_(w4.z + c[4 * g + 2]); lwv[cb][4 * g + 3] = -0.6065306597f * sigmoidf_(w4.w + c[4 * g + 3]); } }
            RP_TILE_OUT(lwv, LW + (size_t)d * TS, 6 + d); }
        LDS_WAIT();
#undef RP_OUT
#undef RP_TILE_OUT
#undef RP_LDW_A
#undef RP_LDW_L
#undef RP_LDW_G
    }
}

constexpr int NCHUNK = LTOT / 64;
constexpr int NCHAIN = BATCH * 8 * 2;
constexpr int RC_P = 72;
constexpr int RC_TILE = 64 * RC_P * 2;
constexpr int RC_LTF = 13 * RC_TILE, RC_EC = RC_LTF + 64 * 65 * 4;
DI int chain_pos(int dir, int n) { return dir == 0 ? n : (n < CTX ? CTX - 1 - n : LTOT - 1 - (n - CTX)); }
DI f32x16 mm_blk(const LAS bf16* A, int mb, const LAS bf16* Bt, int nb, int k0, int ksteps, int lane, f32x16 acc) {
    const int r = lane & 31, h = lane >> 5;
    bf16x8 fa[4], fb[4];
#pragma unroll
    for (int q = 0; q < 4; ++q) if (q < ksteps) { fa[q] = *(const LAS bf16x8*)(A + (mb * 32 + r) * RC_P + k0 + 16 * q + 8 * h); fb[q] = *(const LAS bf16x8*)(Bt + (nb * 32 + r) * RC_P + k0 + 16 * q + 8 * h); }
    __builtin_amdgcn_sched_barrier(0);
#pragma unroll
    for (int q = 0; q < 4; ++q) if (q < ksteps) acc = __builtin_amdgcn_mfma_f32_32x32x16_bf16(fa[q], fb[q], acc, 0, 0, 0);
    return acc;
}
DI void st_tile_T(LAS bf16* tile, int mb, int nb, const f32x16& d, int lane) {
    const int r = lane & 31, h = lane >> 5;
#pragma unroll
    for (int g = 0; g < 4; ++g) { u32x2 x; x.x = pk2(d[4 * g], d[4 * g + 1]); x.y = pk2(d[4 * g + 2], d[4 * g + 3]); *(LAS u32x2*)(tile + (nb * 32 + r) * RC_P + mb * 32 + 8 * g + 4 * h) = x; }
}
constexpr int RC_LTF2 = 13 * RC_TILE, RC_EC2 = RC_LTF2 + 2 * 32 * 36 * 4, RC_ST = RC_EC2 + 256;
static_assert(RC_ST + RC_TILE <= LDS_MISC_OFF, "rwkv chain LDS map");
DI void rc_stage0(LAS bf16* tiles, LAS float* EC, int lane, int w, u32x4 ulw, u32x4 ur, u32x4 uk, u32x4 uv, u32x4 ukk, u32x4 ua) {
#define TILE(i) (tiles + (i) * (RC_TILE / 2))
        {
          float lw[8], cw[8]; unpack8(ulw, lw);
#pragma unroll
          for (int j = 0; j < 8; ++j) cw[j] = lw[j];
#pragma unroll
          for (int j = 0; j < 8; ++j) cw[j] = dpp_scan64(cw[j]);
          const unsigned rw_[4] = {ur.x, ur.y, ur.z, ur.w}, kw_[4] = {uk.x, uk.y, uk.z, uk.w}, kkw_[4] = {ukk.x, ukk.y, ukk.z, ukk.w}, aw_[4] = {ua.x, ua.y, ua.z, ua.w};
          float At[8], Rt[8], Bt[8], Kt[8];
#pragma unroll
          for (int j = 0; j < 8; ++j) { const float rr = (j & 1) ? bfhi(rw_[j >> 1]) : bflo(rw_[j >> 1]), kk = (j & 1) ? bfhi(kkw_[j >> 1]) : bflo(kkw_[j >> 1]), k = (j & 1) ? bfhi(kw_[j >> 1]) : bflo(kw_[j >> 1]), aa = (j & 1) ? bfhi(aw_[j >> 1]) : bflo(aw_[j >> 1]);
              const float ep = __expf(cw[j]), em = __expf(-cw[j]), epv = __expf(cw[j] - lw[j]);
              At[j] = -kk * epv; Rt[j] = rr * ep; Bt[j] = kk * aa * em; Kt[j] = k * em;
              if (lane == 63) EC[8 * w + j] = ep; }
          const bf16x8 fa = pack8(At), fr_ = pack8(Rt), fb = pack8(Bt), fk = pack8(Kt);
          *(LAS bf16x8*)(TILE(0) + lane * RC_P + 8 * w) = fa; *(LAS bf16x8*)(TILE(1) + lane * RC_P + 8 * w) = fr_; *(LAS bf16x8*)(TILE(2) + lane * RC_P + 8 * w) = fb; *(LAS bf16x8*)(TILE(3) + lane * RC_P + 8 * w) = fk;
          const unsigned vw_[4] = {uv.x, uv.y, uv.z, uv.w};
#pragma unroll
          for (int j = 0; j < 8; ++j) { TILE(4)[(8 * w + j) * RC_P + lane] = (bf16)fa[j]; TILE(5)[(8 * w + j) * RC_P + lane] = (bf16)fb[j]; TILE(6)[(8 * w + j) * RC_P + lane] = (bf16)fk[j];
              TILE(7)[(8 * w + j) * RC_P + lane] = (bf16)((j & 1) ? (vw_[j >> 1] >> 16) : (vw_[j >> 1] & 0xffffu)); } }
#undef TILE
}
DI void rwkv_chain_block(Frame& F, int chain) {
    const int w_ = F.wave;
    const int dir = chain & 1, bh = chain >> 1, b = bh >> 3, hd = bh & 7;
    const bf16* RW = (const bf16*)(F.ws + WS_RW); const bf16* LW = (const bf16*)(F.ws + WS_LW); const size_t TS = (size_t)NT * 512;
    bf16* Yg = (bf16*)(F.ws + WS_YF) + (size_t)dir * TS + (size_t)b * LTOT * 512 + hd * 64;
    LAS bf16* tiles = (LAS bf16*)F.lds;
#define TILE(i) (tiles + (i) * (RC_TILE / 2))
    LAS float* LTf = (LAS float*)(F.lds + RC_LTF2); LAS float* EC = (LAS float*)(F.lds + RC_EC2); LAS bf16* ST = (LAS bf16*)(F.lds + RC_ST);
    __syncthreads();
    { const int lane0 = fresh_lane(); for (int i = w_ * 64 + lane0; i < RC_TILE / 4; i += NTHREADS) ((LAS unsigned*)ST)[i] = 0u; }
    u32x4 nlw, nr, nk, nv, nkk, na;
#define RC_LOAD(cc) do { const int lane_ = fresh_lane(); const int p_ = chain_pos(dir, 64 * (cc) + lane_); const size_t off_ = ((size_t)b * LTOT + p_) * 512 + hd * 64 + 8 * w; \
        nlw = *(const u32x4*)(LW + (size_t)dir * TS + off_); nr = *(const u32x4*)(RW + off_); nk = *(const u32x4*)(RW + (size_t)(1 + dir) * TS + off_); \
        nv = *(const u32x4*)(RW + 3 * TS + off_); nkk = *(const u32x4*)(RW + 4 * TS + off_); na = *(const u32x4*)(RW + (size_t)(5 + dir) * TS + off_); } while (0)
    { const int w = w_; RC_LOAD(0); }
    rc_stage0(tiles, EC, fresh_lane(), w_, nlw, nr, nk, nv, nkk, na);
    LDS_BARRIER();
#pragma unroll 1
    for (int c = 0; c < NCHUNK; ++c) {
        const int lane = fresh_lane(); int w = w_; asm volatile("" : "+s"(w));
        if (c + 1 < NCHUNK) RC_LOAD(c + 1);
        { const int pi = w >> 1, nb = w & 1, r = lane & 31, h = lane >> 5;
          const LAS bf16* Aop = (pi == 0 || pi == 2) ? TILE(2) : TILE(3);
          const LAS bf16* Bop = pi < 2 ? TILE(0) : TILE(1);
          LAS bf16* dst = TILE(8 + pi);
#pragma unroll
          for (int mb = 0; mb < 2; ++mb) { f32x16 d = zero16();
              if (mb <= nb) d = mm_blk(Aop, mb, Bop, nb, 0, 4, lane, d);
#pragma unroll
              for (int i = 0; i < 16; ++i) { const int m = mb * 32 + crow16(i, h), n = nb * 32 + r; const bool keep = pi < 2 ? m < n : m <= n; d[i] = keep ? d[i] : 0.f; }
              st_tile_T(dst, mb, nb, d, lane);
              if (pi == 0 && mb == nb) {
#pragma unroll
                  for (int i = 0; i < 16; ++i) LTf[(mb * 32 + crow16(i, h)) * 36 + r] = d[i]; } } }
        LDS_BARRIER();
        if (w == 0) {
            { const int k = lane >> 4, tl = lane & 15, blk = k >> 1, o16 = (k & 1) * 16;
              float Tr[16];
#pragma unroll
              for (int i = 0; i < 16; ++i) Tr[i] = 0.f;
#pragma unroll
              for (int cc = 15; cc >= 0; --cc) { float a0 = (cc == tl) ? 1.f : 0.f, a1 = 0.f;
                  const LAS float* lrow = LTf + (blk * 32 + o16 + cc) * 36 + o16;
#pragma unroll
                  for (int q4 = (cc + 1) >> 2; q4 < 4; ++q4) { const f32x4 l4 = *(const LAS f32x4*)(lrow + 4 * q4);
#pragma unroll
                      for (int e = 0; e < 4; ++e) { const int s2 = 4 * q4 + e; if (s2 > cc) { if (e & 1) a1 += Tr[s2] * l4[e]; else a0 += Tr[s2] * l4[e]; } } }
                  Tr[cc] = a0 + a1; if ((cc & 3) == 0) asm volatile("" ::: "memory"); }
              unsigned z0; asm volatile("v_mov_b32 %0, 0" : "=v"(z0)); const u32x4 zz = {z0, z0, z0, z0};
              LAS bf16* trow = TILE(12) + lane * RC_P; LAS bf16* ttrow = TILE(0) + lane * RC_P;
#pragma unroll
              for (int g = 0; g < 8; ++g) { *(LAS u32x4*)(trow + 8 * g) = zz; *(LAS u32x4*)(ttrow + 8 * g) = zz; }
              *(LAS bf16x8*)(trow + 16 * k) = pack8(Tr); *(LAS bf16x8*)(trow + 16 * k + 8) = pack8(Tr + 8);
#pragma unroll
              for (int i = 0; i < 16; ++i) TILE(0)[(16 * k + i) * RC_P + lane] = f2bf(Tr[i]); }
            LDS_WAIT();
            { const int r = lane & 31, h = lane >> 5;
#pragma unroll
              for (int blk = 0; blk < 2; ++blk) {
                  f32x16 x = zero16();
                  x = __builtin_amdgcn_mfma_f32_32x32x16_bf16(*(const LAS bf16x8*)(TILE(8) + (32 * blk + r) * RC_P + 32 * blk + 8 * h), *(const LAS bf16x8*)(TILE(0) + (32 * blk + r) * RC_P + 32 * blk + 8 * h), x, 0, 0, 0);
                  st_tile_T(TILE(2), 0, blk, x, lane);
                  LDS_WAIT();
                  f32x16 d = zero16();
                  d = __builtin_amdgcn_mfma_f32_32x32x16_bf16(*(const LAS bf16x8*)(TILE(12) + (32 * blk + r) * RC_P + 32 * blk + 16 + 8 * h), *(const LAS bf16x8*)(TILE(2) + (32 * blk + r) * RC_P + 16 + 8 * h), d, 0, 0, 0);
                  if (r < 16) {
#pragma unroll
                      for (int i = 8; i < 16; ++i) TILE(12)[(32 * blk + crow16(i, h)) * RC_P + 32 * blk + r] = f2bf(d[i]);
                      { u32x2 y0, y1; y0.x = pk2(d[8], d[9]); y0.y = pk2(d[10], d[11]); y1.x = pk2(d[12], d[13]); y1.y = pk2(d[14], d[15]);
                        *(LAS u32x2*)(TILE(0) + (32 * blk + r) * RC_P + 32 * blk + 16 + 4 * h) = y0; *(LAS u32x2*)(TILE(0) + (32 * blk + r) * RC_P + 32 * blk + 24 + 4 * h) = y1; } }
                  LDS_WAIT(); } }
            LDS_WAIT();
            f32x16 m1 = mm_blk(TILE(8), 1, TILE(0), 0, 0, 2, lane, zero16());
            st_tile_T(TILE(2), 0, 0, m1, lane);
            LDS_WAIT();
            { const int r = lane & 31, h = lane >> 5; f32x16 d = zero16();
#pragma unroll
              for (int q = 0; q < 2; ++q) { const bf16x8 a = *(const LAS bf16x8*)(TILE(2) + r * RC_P + 16 * q + 8 * h), bb = *(const LAS bf16x8*)(TILE(12) + (32 + r) * RC_P + 32 + 16 * q + 8 * h);
                  d = __builtin_amdgcn_mfma_f32_32x32x16_bf16(a, bb, d, 0, 0, 0); }
#pragma unroll
              for (int g = 0; g < 4; ++g) { u32x2 x; x.x = pk2(d[4 * g], d[4 * g + 1]); x.y = pk2(d[4 * g + 2], d[4 * g + 3]); *(LAS u32x2*)(TILE(12) + (32 + r) * RC_P + 8 * g + 4 * h) = x; } }
        } else if (w <= 4) {
            const int mb = (w - 1) >> 1, nb = (w - 1) & 1;
            const f32x16 u = mm_blk(TILE(9), mb, TILE(7), nb, 0, 4, lane, zero16());
            st_tile_T(TILE(3), mb, nb, u, lane);
        }
        LDS_BARRIER();
        { const int mb = (w >> 1) & 1, nb = w & 1;
          if (w < 4) { const f32x16 d = mm_blk(TILE(12), mb, TILE(4), nb, 0, 4, lane, zero16()); st_tile_T(TILE(2), mb, nb, d, lane); }
          else { const f32x16 d = mm_blk(TILE(12), mb, TILE(3), nb, 0, 4, lane, zero16()); st_tile_T(TILE(0), mb, nb, d, lane); } }
        LDS_BARRIER();
        const int mb = (w >> 1) & 1, nb = w & 1, r = lane & 31, h = lane >> 5;
        f32x16 cin;
        if (w < 4) {
            f32x16 d = mm_blk(TILE(2), mb, TILE(5), nb, 0, 4, lane, zero16());
#pragma unroll
            for (int i = 0; i < 16; ++i) { const int m = mb * 32 + crow16(i, h), n = nb * 32 + r; d[i] = (d[i] + (m == n ? 1.f : 0.f)) * EC[n]; }
            st_tile_T(TILE(8), mb, nb, d, lane);
            cin = mm_blk(TILE(5), mb, TILE(0), nb, 0, 4, lane, zero16()); cin = mm_blk(TILE(6), mb, TILE(7), nb, 0, 4, lane, cin);
#pragma unroll
            for (int i = 0; i < 16; ++i) cin[i] *= EC[mb * 32 + crow16(i, h)];
        } else {
            f32x16 d = mm_blk(TILE(2), mb, TILE(10), nb, 0, 4, lane, zero16());
#pragma unroll
            for (int i = 0; i < 16; ++i) { const int m = mb * 32 + crow16(i, h), n = nb * 32 + r; d[i] += bf2f(TILE(1)[n * RC_P + m]); }
            st_tile_T(TILE(9), mb, nb, d, lane);
            cin = mm_blk(TILE(10), mb, TILE(0), nb, 0, 4, lane, zero16()); cin = mm_blk(TILE(11), mb, TILE(7), nb, 0, 4, lane, cin);
        }
        LDS_BARRIER();
        if (w < 4) cin = mm_blk(TILE(8), mb, ST, nb, 0, 4, lane, cin);
        else { cin = mm_blk(TILE(9), mb, ST, nb, 0, 4, lane, cin);
#pragma unroll
            for (int i = 0; i < 16; ++i) { const int p = chain_pos(dir, 64 * c + mb * 32 + crow16(i, h)); Yg[(size_t)p * 512 + nb * 32 + r] = f2bf(cin[i]); } }
        if (c + 1 < NCHUNK) rc_stage0(tiles, EC, lane, w, nlw, nr, nk, nv, nkk, na);
        LDS_BARRIER();
        if (w < 4) st_tile_T(ST, mb, nb, cin, lane);
    }
#undef RC_LOAD
#undef TILE
}
constexpr int RT_QP = 72, RT_TP = 136;
constexpr int RT_QS = 0, RT_KS = 128 * RT_QP * 2, RT_KT = 2 * 128 * RT_QP * 2, RT_VT = RT_KT + 64 * RT_TP * 2, RT_ST = RT_VT + 128 * RT_TP * 2;
DI void phase_retention_item(Frame& F, const KA& a, int item) {
    const int b = item >> 2, hh = item & 3, w = F.wave;
    const bf16* P = (const bf16*)(F.ws + WS_P); const float2* rt = (const float2*)(F.ws + WS_ROPE);
    bf16* OFB = (bf16*)(F.ws + WS_OF); const size_t TS = (size_t)NT * 512;
    LAS bf16* Qs = (LAS bf16*)(F.lds + RT_QS); LAS bf16* Ks = (LAS bf16*)(F.lds + RT_KS); LAS bf16* KsT = (LAS bf16*)(F.lds + RT_KT); LAS bf16* VsT = (LAS bf16*)(F.lds + RT_VT); LAS bf16* SsT = (LAS bf16*)(F.lds + RT_ST);
    const float lg2g = log2f(1.f - exp2f(-5.f - (float)hh));
    const float gam = exp2f(lg2g), g127 = exp2f(127.f * lg2g), cdec = exp2f(128.f * lg2g);
    const int rb = w >> 1, cbp = w & 1, db = w >> 2, vb = w & 3;
    for (int dir = 0; dir < 2; ++dir) {
        const int lane = fresh_lane(); const int tid = w * 64 + lane, ql = lane & 31, h = lane >> 5;
        f32x16 Sreg;
#pragma unroll
        for (int i = 0; i < 16; ++i) Sreg[i] = 0.f;
        __syncthreads();
        for (int i = tid; i < 128 * RT_QP / 2; i += NTHREADS) ((LAS unsigned*)SsT)[i] = 0u;
        for (int cn = 0; cn < 34; ++cn) {
            int p0; if (cn < 2) p0 = 128 * (dir ? 1 - cn : cn); else p0 = CTX + 128 * (dir ? 33 - cn : cn - 2);
            const bool lat = p0 >= CTX;
            { int tid_o = tid; asm volatile("" : "+v"(tid_o)); const int tok = tid_o >> 2, c = tid_o & 3; const int e = dir ? 127 - tok : tok; const size_t row = (size_t)b * LTOT + p0 + tok; const bf16* prow = P + row * DINP;
              const float sq = exp2f((float)e * lg2g), sk = 0.125f * exp2f(-(float)e * lg2g);
              const u32x4 ql_ = *(const u32x4*)(prow + PC_RQ + hh * 64 + 8 * c), qh_ = *(const u32x4*)(prow + PC_RQ + hh * 64 + 32 + 8 * c);
              const u32x4 kl_ = *(const u32x4*)(prow + PC_RK + hh * 64 + 8 * c), kh_ = *(const u32x4*)(prow + PC_RK + hh * 64 + 32 + 8 * c);
              float qlo[8] = {bflo(ql_.x), bfhi(ql_.x), bflo(ql_.y), bfhi(ql_.y), bflo(ql_.z), bfhi(ql_.z), bflo(ql_.w), bfhi(ql_.w)}, qhi[8] = {bflo(qh_.x), bfhi(qh_.x), bflo(qh_.y), bfhi(qh_.y), bflo(qh_.z), bfhi(qh_.z), bflo(qh_.w), bfhi(qh_.w)};
              float klo[8] = {bflo(kl_.x), bfhi(kl_.x), bflo(kl_.y), bfhi(kl_.y), bflo(kl_.z), bfhi(kl_.z), bflo(kl_.w), bfhi(kl_.w)}, khi[8] = {bflo(kh_.x), bfhi(kh_.x), bflo(kh_.y), bfhi(kh_.y), bflo(kh_.z), bfhi(kh_.z), bflo(kh_.w), bfhi(kh_.w)};
              if (lat) { const float2* ang = rt + (size_t)(p0 - CTX + tok) * 32 + 8 * c;
#pragma unroll
                  for (int j = 0; j < 8; ++j) { const float2 cs = ang[j]; const float a0 = qlo[j], a1 = qhi[j], b0 = klo[j], b1 = khi[j];
                      qlo[j] = a0 * cs.x - a1 * cs.y; qhi[j] = a0 * cs.y + a1 * cs.x; klo[j] = b0 * cs.x - b1 * cs.y; khi[j] = b0 * cs.y + b1 * cs.x; } }
#pragma unroll
              for (int j = 0; j < 8; ++j) { qlo[j] *= sq; qhi[j] *= sq; klo[j] *= sk; khi[j] *= sk; }
              *(LAS bf16x8*)(Qs + tok * RT_QP + 8 * c) = pack8(qlo); *(LAS bf16x8*)(Qs + tok * RT_QP + 32 + 8 * c) = pack8(qhi);
              *(LAS bf16x8*)(Ks + tok * RT_QP + 8 * c) = pack8(klo); *(LAS bf16x8*)(Ks + tok * RT_QP + 32 + 8 * c) = pack8(khi);
              const int pt = permpos(tok);
#pragma unroll
              for (int j = 0; j < 8; ++j) { KsT[(8 * c + j) * RT_TP + pt] = f2bf(klo[j]); KsT[(32 + 8 * c + j) * RT_TP + pt] = f2bf(khi[j]); }
#pragma unroll
              for (int q4 = 0; q4 < 4; ++q4) { const u32x4 vv = *(const u32x4*)(prow + PC_RV + hh * 128 + 32 * c + 8 * q4); const unsigned vw[4] = {vv.x, vv.y, vv.z, vv.w};
#pragma unroll
                  for (int j = 0; j < 4; ++j) { VsT[(32 * c + 8 * q4 + 2 * j) * RT_TP + pt] = (bf16)(vw[j] & 0xffffu); VsT[(32 * c + 8 * q4 + 2 * j + 1) * RT_TP + pt] = (bf16)(vw[j] >> 16); } } }
            __syncthreads();
            f32x16 o0, o1;
#pragma unroll
            for (int i = 0; i < 16; ++i) { o0[i] = 0.f; o1[i] = 0.f; }
            for (int kb = 0; kb < 4; ++kb) {
                if (dir == 0 ? kb > rb : kb < rb) continue;
                f32x16 x;
#pragma unroll
                for (int i = 0; i < 16; ++i) x[i] = 0.f;
#pragma unroll
                for (int s = 0; s < 4; ++s) x = __builtin_amdgcn_mfma_f32_32x32x16_bf16(*(const LAS bf16x8*)(Ks + (kb * 32 + ql) * RT_QP + 16 * s + 8 * h), *(const LAS bf16x8*)(Qs + (rb * 32 + ql) * RT_QP + 16 * s + 8 * h), x, 0, 0, 0);
                if (kb == rb) {
#pragma unroll
                    for (int i = 0; i < 16; ++i) { const int key = crow16(i, h); const bool keep = dir == 0 ? key <= ql : key >= ql; x[i] = keep ? x[i] : 0.f; } }
                float xv[16];
#pragma unroll
                for (int i = 0; i < 16; ++i) xv[i] = x[i];
                const bf16x8 xa0 = pack8(xv), xa1 = pack8(xv + 8);
                const LAS bf16* v0 = VsT + ((2 * cbp) * 32 + ql) * RT_TP + kb * 32 + 8 * h; const LAS bf16* v1 = VsT + ((2 * cbp + 1) * 32 + ql) * RT_TP + kb * 32 + 8 * h;
                o0 = __builtin_amdgcn_mfma_f32_32x32x16_bf16(xa0, *(const LAS bf16x8*)(v0), o0, 0, 0, 0); o0 = __builtin_amdgcn_mfma_f32_32x32x16_bf16(xa1, *(const LAS bf16x8*)(v0 + 16), o0, 0, 0, 0);
                o1 = __builtin_amdgcn_mfma_f32_32x32x16_bf16(xa0, *(const LAS bf16x8*)(v1), o1, 0, 0, 0); o1 = __builtin_amdgcn_mfma_f32_32x32x16_bf16(xa1, *(const LAS bf16x8*)(v1 + 16), o1, 0, 0, 0);
            }
#pragma unroll
            for (int s = 0; s < 4; ++s) { const bf16x8 qa = *(const LAS bf16x8*)(Qs + (rb * 32 + ql) * RT_QP + 16 * s + 8 * h);
                o0 = __builtin_amdgcn_mfma_f32_32x32x16_bf16(qa, *(const LAS bf16x8*)(SsT + ((2 * cbp) * 32 + ql) * RT_QP + 16 * s + 8 * h), o0, 0, 0, 0);
                o1 = __builtin_amdgcn_mfma_f32_32x32x16_bf16(qa, *(const LAS bf16x8*)(SsT + ((2 * cbp + 1) * 32 + ql) * RT_QP + 16 * s + 8 * h), o1, 0, 0, 0); }
            { bf16* op = OFB + (size_t)dir * TS + ((size_t)b * LTOT + p0 + rb * 32) * 512 + hh * 128 + (2 * cbp) * 32 + ql;
#pragma unroll
              for (int i = 0; i < 16; ++i) { op[(size_t)crow16(i, h) * 512] = f2bf(o0[i]); op[(size_t)crow16(i, h) * 512 + 32] = f2bf(o1[i]); } }
            f32x16 u;
#pragma unroll
            for (int i = 0; i < 16; ++i) u[i] = 0.f;
#pragma unroll
            for (int s = 0; s < 8; ++s) u = __builtin_amdgcn_mfma_f32_32x32x16_bf16(*(const LAS bf16x8*)(KsT + (db * 32 + ql) * RT_TP + 16 * s + 8 * h), *(const LAS bf16x8*)(VsT + (vb * 32 + ql) * RT_TP + 16 * s + 8 * h), u, 0, 0, 0);
#pragma unroll
            for (int i = 0; i < 16; ++i) Sreg[i] = cdec * Sreg[i] + g127 * u[i];
            __syncthreads();
#pragma unroll
            for (int g = 0; g < 4; ++g) { u32x2 x; x.x = pk2(gam * Sreg[4 * g], gam * Sreg[4 * g + 1]); x.y = pk2(gam * Sreg[4 * g + 2], gam * Sreg[4 * g + 3]);
                *(LAS u32x2*)(SsT + (vb * 32 + ql) * RT_QP + db * 32 + 8 * g + 4 * h) = x; }
        }
    }
}

DI void phase_mixer_finish(Frame& F, const KA& a, int l) {
    const int lane = fresh_lane(), gw = F.bid * NWAVES + F.wave, NGW = F.G * NWAVES;
    const size_t TS = (size_t)NT * 512;
    const bf16* P = (const bf16*)(F.ws + WS_P); const bf16* OFB = (const bf16*)(F.ws + WS_OF); const bf16* YF = (const bf16*)(F.ws + WS_YF); const bf16* RW = (const bf16*)(F.ws + WS_RW);
    bf16* O0 = (bf16*)(F.ws + WS_ABR); bf16* O2 = O0 + 2 * TS;
    const float* lng = a.in(I_LNXG) + l * 512 + 8 * lane; const float* lnb = a.in(I_LNXB) + l * 512 + 8 * lane; const float* rkw = a.in(I_RK) + l * 512 + 8 * lane;
    float g_[8], b_[8], rk_[8];
    { const f32x4 x0 = *(const f32x4*)lng, x1 = *(const f32x4*)(lng + 4), y0 = *(const f32x4*)lnb, y1 = *(const f32x4*)(lnb + 4), z0 = *(const f32x4*)rkw, z1 = *(const f32x4*)(rkw + 4);
      g_[0] = x0.x; g_[1] = x0.y; g_[2] = x0.z; g_[3] = x0.w; g_[4] = x1.x; g_[5] = x1.y; g_[6] = x1.z; g_[7] = x1.w;
      b_[0] = y0.x; b_[1] = y0.y; b_[2] = y0.z; b_[3] = y0.w; b_[4] = y1.x; b_[5] = y1.y; b_[6] = y1.z; b_[7] = y1.w;
      rk_[0] = z0.x; rk_[1] = z0.y; rk_[2] = z0.z; rk_[3] = z0.w; rk_[4] = z1.x; rk_[5] = z1.y; rk_[6] = z1.z; rk_[7] = z1.w; }
#pragma unroll 1
    for (int r0 = gw; r0 < NT; r0 += 2 * NGW) {
        u32x4 uyf[2], uyb[2], ur[2], ukf[2], ukb[2], uv[2], ug[2], uof[2], uob[2], ugf[2], ugb[2]; size_t oo[2]; bool act[2];
#pragma unroll
        for (int u = 0; u < 2; ++u) { int r = r0 + u * NGW; act[u] = r < NT; if (!act[u]) r = r0; const size_t o = (size_t)r * 512 + 8 * lane; oo[u] = o;
            uyf[u] = *(const u32x4*)(YF + o); uyb[u] = *(const u32x4*)(YF + TS + o); ur[u] = *(const u32x4*)(RW + o); ukf[u] = *(const u32x4*)(RW + TS + o); ukb[u] = *(const u32x4*)(RW + 2 * TS + o);
            uv[u] = *(const u32x4*)(RW + 3 * TS + o); ug[u] = *(const u32x4*)(RW + 7 * TS + o); uof[u] = *(const u32x4*)(OFB + o); uob[u] = *(const u32x4*)(OFB + TS + o);
            ugf[u] = *(const u32x4*)(P + (size_t)r * DINP + PC_RGF + 8 * lane); ugb[u] = *(const u32x4*)(P + (size_t)r * DINP + PC_RGB + 8 * lane); }
        __builtin_amdgcn_sched_barrier(0);
#pragma unroll
        for (int u = 0; u < 2; ++u) { if (!act[u]) continue; const size_t o = oo[u];
            { float yfv[8], ybv[8], s[8]; unpack8(uyf[u], yfv); unpack8(uyb[u], ybv);
#pragma unroll
              for (int j = 0; j < 8; ++j) s[j] = yfv[j] + ybv[j];
              float rr[8], kf[8], kb[8], vv[8], gg[8]; unpack8(ur[u], rr); unpack8(ukf[u], kf); unpack8(ukb[u], kb); unpack8(uv[u], vv); unpack8(ug[u], gg);
              float sm = 0.f, bn = 0.f;
#pragma unroll
              for (int j = 0; j < 8; ++j) { sm += s[j]; bn += rr[j] * (kf[j] + kb[j]) * rk_[j]; }
              sm += sx(sm, 1); sm += sx(sm, 2); sm += sx(sm, 4); bn += sx(bn, 1); bn += sx(bn, 2); bn += sx(bn, 4);
              const float mean = sm * (1.f / 64.f); float vs = 0.f;
#pragma unroll
              for (int j = 0; j < 8; ++j) { s[j] -= mean; vs += s[j] * s[j]; }
              vs += sx(vs, 1); vs += sx(vs, 2); vs += sx(vs, 4);
              const float rstd = rsqrtf(vs * (1.f / 64.f) + 64e-5f);
              float y[8];
#pragma unroll
              for (int j = 0; j < 8; ++j) y[j] = (s[j] * rstd * g_[j] + b_[j] + bn * vv[j]) * gg[j];
              *(bf16x8*)(O2 + o) = pack8(y); }
            { float ff[8], bb[8], gf[8], gb[8]; unpack8(uof[u], ff); unpack8(uob[u], bb); unpack8(ugf[u], gf); unpack8(ugb[u], gb);
              float sf = 0.f, sb = 0.f;
#pragma unroll
              for (int j = 0; j < 8; ++j) { sf += ff[j]; sb += bb[j]; }
#pragma unroll
              for (int o2 = 1; o2 < 16; o2 <<= 1) { sf += sx(sf, o2); sb += sx(sb, o2); }
              const float mf = sf * (1.f / 128.f), mb = sb * (1.f / 128.f); float vf = 0.f, vb = 0.f;
#pragma unroll
              for (int j = 0; j < 8; ++j) { ff[j] -= mf; bb[j] -= mb; vf += ff[j] * ff[j]; vb += bb[j] * bb[j]; }
#pragma unroll
              for (int o2 = 1; o2 < 16; o2 <<= 1) { vf += sx(vf, o2); vb += sx(vb, o2); }
              const float rf = rsqrtf(vf * (1.f / 128.f) + 1e-5f), rb = rsqrtf(vb * (1.f / 128.f) + 1e-5f);
              float y[8];
#pragma unroll
              for (int j = 0; j < 8; ++j) y[j] = ff[j] * rf * (gf[j] * sigmoidf_(gf[j])) + bb[j] * rb * (gb[j] * sigmoidf_(gb[j]));
              *(bf16x8*)(O0 + o) = pack8(y); } }
    }
}

constexpr int N_PHASES = 2 + 10 * DEPTH;
__global__ void __launch_bounds__(NTHREADS, 2) fwd_kernel(Args args) {
    extern __shared__ __attribute__((aligned(16))) unsigned char lds_raw[];
    Frame F;
    F.lds = (LAS unsigned char*)lds_raw;
    F.MISC = (volatile LAS unsigned*)(F.lds + LDS_MISC_OFF);
    F.tid = threadIdx.x; F.lane = F.tid & 63; F.wave = __builtin_amdgcn_readfirstlane(F.tid >> 6);
    F.G = gridDim.x; F.bid = blockIdx.x;
    F.ws = args.ws; F.ctl = (unsigned*)(args.ws + WS_CTL);
    if (F.tid < 32) F.MISC[F.tid] = 0u;
    __syncthreads();
    const int lo = args.ph_lo, hi = args.ph_hi;
    KA ka; ka.kp = (const CAS char*)__builtin_amdgcn_kernarg_segment_ptr();
    const bool multi = (hi - lo) > 1;
    XcdBarrier bar; bar.bar = F.ctl + CW_BAR; bar.x = 0; bar.st = nullptr;
    if (multi) bar = xcd_barrier_post(F.ctl + CW_BAR, F.MISC + 8);
#define IN(k) (lo <= (k) && (k) < hi)
#define OPQ() do { int l_; asm volatile("v_mbcnt_lo_u32_b32 %0, -1, 0\n\tv_mbcnt_hi_u32_b32 %0, -1, %0" : "=v"(l_)); { int b_ = F.bid, w_ = F.wave, g_ = F.G; asm volatile("" : "+s"(b_), "+s"(w_), "+s"(g_)); F.bid = b_; F.wave = w_; F.G = g_; } F.lane = l_; F.tid = F.wave * 64 + l_; \
        const CAS char* kp_ = (const CAS char*)__builtin_amdgcn_kernarg_segment_ptr(); asm volatile("" : "+s"(kp_)); ka.kp = kp_; F.ws = ka.ws(); F.ctl = (unsigned*)(F.ws + WS_CTL); } while (0)
#define SEAM(k) do { if (IN(k) && IN((k) + 1)) xcd_barrier(bar); } while (0)

    if (IN(0)) { OPQ(); phase_prologue(F, ka); } SEAM(0);
    if (IN(1)) { OPQ(); phase_init_rows(F, ka); } SEAM(1);

    for (int l = 0; l < DEPTH; ++l) {
        const int pb = 2 + 10 * l;
        if (IN(pb + 0)) { OPQ(); unsigned char* ws = F.ws;
            SchedInproj S; S.T.init(NT / 256, DINP / 256, F.G, F.bid); S.A = (const char*)(ws + WS_H); S.B = (const char*)(ws + WS_WIN + (size_t)l * 15 * MiB);
            EpiStoreBf16 E{(bf16*)(ws + WS_P), DINP};
            pg8::gemm_phase<EpiStoreBf16, SchedInproj, false>(F.lds, 1024, S, E, F.tid);
        }
        SEAM(pb + 0);
        if (IN(pb + 1)) { OPQ(); phase_mla_prep2(F, ka, l); OPQ(); phase_rwkv_prep2(F, ka, l); }
        SEAM(pb + 1);
#define ATTN_QUEUE(qword, ubeg, uend) do { const int xq_ = F.bid & 7; for (;;) { __syncthreads(); \
            if (F.wave == 0 && fresh_lane() == 0) F.MISC[0] = (unsigned)(ubeg) + __hip_atomic_fetch_add(F.ctl + (qword) + xq_, 1u, __ATOMIC_RELAXED, __HIP_MEMORY_SCOPE_AGENT); \
            __syncthreads(); const int u = (int)F.MISC[0]; if (u >= (uend)) break; \
            if (u < 128) attn_unit(F, u >> 4, xq_, 1 + (u & 15), l); else attn_unit(F, u - 128, xq_, 0, l); } } while (0)
        const int nunits = (l == DEPTH - 1) ? 128 : 136;
        if (IN(pb + 2)) { OPQ();
            if (F.bid < NCHAIN) rwkv_chain_block(F, F.bid);
            else if (F.bid < NCHAIN + 32) phase_retention_item(F, ka, F.bid - NCHAIN);
            OPQ(); ATTN_QUEUE(CW_Q + l * 64, 0, nunits);
        }
        SEAM(pb + 2);
        if (IN(pb + 3)) { OPQ(); phase_mixer_finish(F, ka, l); }
        SEAM(pb + 3);
        if (IN(pb + 4)) { OPQ(); unsigned char* ws = F.ws;
            SchedMerge S; S.T.init(NT / 256, 4, F.G, F.bid, l == DEPTH - 1); S.A = (const char*)(ws + WS_ABR); S.B = (const char*)(ws + WS_WBR + (size_t)l * 3 * MiB);
            EpiMerge E{(const bf16*)(ws + WS_P), (bf16*)(ws + WS_MRG)};
            pg8::gemm_phase<EpiMerge, SchedMerge, false>(F.lds, 512, S, E, F.tid);
        }
        SEAM(pb + 4);
        if (IN(pb + 5)) { OPQ(); unsigned char* ws = F.ws;
            SchedPlain S; S.T.init(NT / 256, 4, F.G, F.bid, l == DEPTH - 1); S.A = (const char*)(ws + WS_MRG); S.B = (const char*)(ws + WS_WOUT + (size_t)l * 2 * MiB); S.K = 1024;
            EpiResid E{(bf16*)(ws + WS_X), (const float*)(ws + WS_MOD) + (size_t)l * 9 * 6144};
            pg8::gemm_phase<EpiResid, SchedPlain, false>(F.lds, 1024, S, E, F.tid);
        }
        SEAM(pb + 5);
        if (IN(pb + 6)) { OPQ(); phase_router(F, ka, l); }
        SEAM(pb + 6);
        if (IN(pb + 7)) { OPQ(); unsigned char* ws = F.ws;
            moe_build_table(F, F.ctl + CW_CNT + l * 32 * 16);
            SchedMoe S{(const LAS int*)(F.lds + LDS_TAB_OFF), (const char*)(ws + WS_H), (const char*)(ws + WS_WGU + (size_t)l * 128 * MiB), (const int*)(ws + WS_LIST), 8, F.bid, F.G, 0, (size_t)2048 * 1024 * 2, true};
            EpiSwiglu E{(bf16*)(ws + WS_ACT), ka.in(I_BGU) + (size_t)l * 32 * 2048};
            pg8::gemm_phase<EpiSwiglu, SchedMoe, true>(F.lds, 1024, S, E, F.tid);
        }
        SEAM(pb + 7);
        if (IN(pb + 8)) { OPQ(); unsigned char* ws = F.ws;
            if (!IN(pb + 7)) moe_build_table(F, F.ctl + CW_CNT + l * 32 * 16);
            SchedMoe S{(const LAS int*)(F.lds + LDS_TAB_OFF), (const char*)(ws + WS_ACT), (const char*)(ws + WS_WDN + (size_t)l * 64 * MiB), (const int*)(ws + WS_LIST), 4, F.bid, F.G, 0, (size_t)1024 * 1024 * 2, false};
            EpiDown E{(bf16*)(ws + WS_Y), ka.in(I_BDOWN) + (size_t)l * 32 * 1024};
            pg8::gemm_phase<EpiDown, SchedMoe, false>(F.lds, 1024, S, E, F.tid);
        }
        SEAM(pb + 8);
        if (IN(pb + 9)) { OPQ(); phase_combine(F, ka, l, IN(pb + 7)); }
        SEAM(pb + 9);

    }
#undef IN
#undef SEAM
}

extern "C" void kernel_launch(void* const* d_in, const int* in_sizes, int n_in, void* d_out, int out_size, void* d_ws, size_t ws_size, hipStream_t stream) {
    static int grid = 0;
    if (grid == 0) {
        if (n_in != N_IN || ws_size < WS_END) { fprintf(stderr, "kernel_launch: unexpected n_in %d or ws_size %zu (need %zu)\n", n_in, ws_size, (size_t)WS_END); grid = -1; return; }
        int dev = 0, cus = 0, per_cu = 0;
        hipGetDevice(&dev); hipDeviceGetAttribute(&cus, hipDeviceAttributeMultiprocessorCount, dev);
        if (hipFuncSetAttribute((const void*)fwd_kernel, hipFuncAttributeMaxDynamicSharedMemorySize, LDS_BYTES) != hipSuccess) { fprintf(stderr, "kernel_launch: hipFuncSetAttribute failed\n"); grid = -1; return; }
        if (hipOccupancyMaxActiveBlocksPerMultiprocessor(&per_cu, (const void*)fwd_kernel, NTHREADS, LDS_BYTES) != hipSuccess || per_cu < 1) { fprintf(stderr, "kernel_launch: occupancy query says %d\n", per_cu); }
        (void)hipGetLastError();
        grid = cus > 0 ? cus : 256;
        if (grid > 256) grid = 256;
    }
    if (grid < 0) return;
    (void)in_sizes; (void)out_size;
    hipMemsetAsync((char*)d_ws + WS_CTL, 0, CTL_ZERO_BYTES, stream);
    Args a{};
    for (int i = 0; i < N_IN; ++i) a.in[i] = (const float*)d_in[i];
    a.out = (float*)d_out; a.ws = (unsigned char*)d_ws;
#if MK_ONE_LAUNCH
    a.ph_lo = 0; a.ph_hi = N_PHASES;
    hipLaunchKernelGGL(fwd_kernel, dim3(grid), dim3(NTHREADS), LDS_BYTES, stream, a);
#else
    for (int ph = 0; ph < N_PHASES; ++ph) { a.ph_lo = ph; a.ph_hi = ph + 1; hipLaunchKernelGGL(fwd_kernel, dim3(grid), dim3(NTHREADS), LDS_BYTES, stream, a); }
#endif
    hipError_t le = hipGetLastError();
    if (le != hipSuccess) fprintf(stderr, "kernel_launch: launch failed: %s\n", hipGetErrorName(le));
}
```
